# Optimizing an MI355X kernel written in HIP

```python
import math
import jax, jax.numpy as jnp
from jax import lax
import numpy as np

D_MODEL = 1024
BATCH = 8
SEQ = 2048
DEPTH = 2

CHUNK = 64
MEM_LEN = 256
Q_BLOCK = 128
RMS_EPS = 1e-6

DA_HEADS = 8
DA_QK_DIM = 64
DA_V_DIM = 2 * DA_QK_DIM
DA_QK_WIDTH = DA_HEADS * 2 * DA_QK_DIM
DA_WIDTH = DA_HEADS * DA_V_DIM

POOL_WINDOWS = (2, 4, 8, 16)
POOL_GROUPS = 4
POOL_GROUP_DIM = 128
POOL_WIDTH = POOL_GROUPS * POOL_GROUP_DIM

MEM_HEADS = 4
MEM_HEAD_DIM = 128
MEM_WIDTH = MEM_HEADS * MEM_HEAD_DIM

N_BRANCHES = 3
IN_WIDTH = 2 * DA_QK_WIDTH + DA_WIDTH + POOL_WIDTH + MEM_WIDTH

D_FF_DENSE = 2816
N_EXPERTS = 8
TOP_K = 2
D_FF_EXPERT = 3584
N_DENSE = (DEPTH + 1) // 2
N_MOE = DEPTH // 2

kernel_name = "hybrid_diffattn_pool_memxattn_moe"


def rmsnorm(x, g):
    xf = x.astype(jnp.float32)
    xf = xf * lax.rsqrt(jnp.mean(xf * xf, axis=-1, keepdims=True) + RMS_EPS)
    return xf.astype(x.dtype) * g


def alibi_slopes(n_heads):
    return np.array([2.0 ** (-8.0 * (h + 1) / n_heads) for h in range(n_heads)], dtype=np.float32)


def lambda_init(layer):
    return 0.8 - 0.6 * math.exp(-0.3 * layer)


def diff_attention(q, k, v, lam):
    S = q.shape[1]
    scale = DA_QK_DIM ** -0.5
    slopes = jnp.asarray(alibi_slopes(DA_HEADS))[:, None, None, None]
    outs = []
    for i in range(S // Q_BLOCK):
        q0 = i * Q_BLOCK
        kv_len = q0 + Q_BLOCK
        qb = q[:, q0:kv_len]
        kb = k[:, :kv_len]
        vb = v[:, :kv_len]
        s = jnp.einsum('bqhmd,bkhmd->bhmqk', qb, kb,
                       preferred_element_type=jnp.float32) * scale
        q_pos = jnp.arange(q0, kv_len)
        k_pos = jnp.arange(kv_len)
        allowed = (k_pos // CHUNK)[None, :] <= (q_pos // CHUNK)[:, None]
        dist = jnp.abs(q_pos[:, None] - k_pos[None, :]).astype(jnp.float32)
        s = jnp.where(allowed, s - slopes * dist, -1e30)
        p = jax.nn.softmax(s, axis=-1)
        attn = p[:, :, 0] - lam.astype(jnp.float32) * p[:, :, 1]
        outs.append(jnp.einsum('bhqk,bkhd->bqhd', attn.astype(vb.dtype), vb))
    return jnp.concatenate(outs, axis=1)


def pool_mixer(p, w_grp, scale):
    B, S, _ = p.shape
    pg = p.reshape(B, S, POOL_GROUPS, POOL_GROUP_DIM).astype(jnp.float32)
    cum = lax.cumsum(pg, axis=1)
    cum_pad = jnp.concatenate([jnp.zeros_like(cum[:, :1]), cum], axis=1)
    t = jnp.arange(S)
    pooled = []
    for g, w in enumerate(POOL_WINDOWS):
        lo = jnp.maximum(t + 1 - w, 0)
        cnt = (t + 1 - lo).astype(jnp.float32)[None, :, None]
        pooled.append((cum[:, :, g] - cum_pad[:, lo, g]) / cnt)
    pooled = jnp.stack(pooled, axis=2)
    d = (pooled - pg).astype(p.dtype)
    y = jnp.einsum('bsgc,gcd->bsgd', d, w_grp)
    return y.reshape(B, S, POOL_WIDTH) * scale


def mem_attention(q, mem_h, w_mem_kv, g_q, g_k):
    B, S, _ = q.shape
    M = mem_h.shape[1]
    kv = mem_h @ w_mem_kv
    k = rmsnorm(kv[..., :MEM_WIDTH].reshape(B, M, MEM_HEADS, MEM_HEAD_DIM), g_k)
    v = kv[..., MEM_WIDTH:].reshape(B, M, MEM_HEADS, MEM_HEAD_DIM)
    q = rmsnorm(q.reshape(B, S, MEM_HEADS, MEM_HEAD_DIM), g_q)
    s = jnp.einsum('bqhd,bkhd->bhqk', q, k,
                   preferred_element_type=jnp.float32) * (MEM_HEAD_DIM ** -0.5)
    p = jax.nn.softmax(s, axis=-1).astype(v.dtype)
    return jnp.einsum('bhqk,bkhd->bqhd', p, v).reshape(B, S, MEM_WIDTH)


def swiglu(h, w1, w3, w2):
    return (jax.nn.silu(h @ w1) * (h @ w3)) @ w2


def moe_swiglu(h, w_router, w1, w3, w2):
    B, S, D = h.shape
    ht = h.reshape(B * S, D)
    logits = (ht @ w_router).astype(jnp.float32)
    vals, idx = lax.top_k(logits, TOP_K)
    gates = jax.nn.softmax(vals, axis=-1).astype(h.dtype)
    comb = jnp.einsum('tk,tke->te', gates, jax.nn.one_hot(idx, N_EXPERTS, dtype=h.dtype))
    out = jnp.zeros_like(ht)
    for e in range(N_EXPERTS):
        out = out + comb[:, e:e + 1] * swiglu(ht, w1[e], w3[e], w2[e])
    return out.reshape(B, S, D)


def setup_inputs(seed: int = 0) -> dict:
    key = jax.random.key(seed)
    ks = iter(jax.random.split(key, 40))

    def nrm(shape, scale):
        return jax.random.normal(next(ks), shape, jnp.float32) * scale

    def gain(shape):
        return 1.0 + nrm(shape, 0.1)

    D = D_MODEL
    return {
        "x": nrm((BATCH, SEQ, D), 1.0),
        "mem": nrm((BATCH, MEM_LEN, D), 1.0),
        "norm_mix": gain((DEPTH, D)),
        "norm_mem": gain((DEPTH, D)),
        "norm_ffn": gain((DEPTH, D)),
        "w_in": nrm((DEPTH, D, IN_WIDTH), D ** -0.5),
        "w_gate": nrm((DEPTH, D, N_BRANCHES * D), D ** -0.5),
        "b_gate": nrm((DEPTH, N_BRANCHES * D), 0.1),
        "da_q_norm": gain((DEPTH, 2, DA_QK_DIM)),
        "da_k_norm": gain((DEPTH, 2, DA_QK_DIM)),
        "da_lam_q1": nrm((DEPTH, DA_QK_DIM), 0.1),
        "da_lam_k1": nrm((DEPTH, DA_QK_DIM), 0.1),
        "da_lam_q2": nrm((DEPTH, DA_QK_DIM), 0.1),
        "da_lam_k2": nrm((DEPTH, DA_QK_DIM), 0.1),
        "da_out_norm": gain((DEPTH, DA_V_DIM)),
        "pool_w": nrm((DEPTH, POOL_GROUPS, POOL_GROUP_DIM, POOL_GROUP_DIM), POOL_GROUP_DIM ** -0.5),
        "pool_scale": gain((DEPTH, POOL_WIDTH)),
        "mem_q_norm": gain((DEPTH, MEM_HEAD_DIM)),
        "mem_k_norm": gain((DEPTH, MEM_HEAD_DIM)),
        "w_mem_kv": nrm((DEPTH, D, 2 * MEM_WIDTH), D ** -0.5),
        "w_br_da": nrm((DEPTH, DA_WIDTH, D), DA_WIDTH ** -0.5),
        "w_br_pool": nrm((DEPTH, POOL_WIDTH, D), POOL_WIDTH ** -0.5),
        "w_br_mem": nrm((DEPTH, MEM_WIDTH, D), MEM_WIDTH ** -0.5),
        "w_out": nrm((DEPTH, D, D), D ** -0.5),
        "ffn_w1": nrm((N_DENSE, D, D_FF_DENSE), D ** -0.5),
        "ffn_w3": nrm((N_DENSE, D, D_FF_DENSE), D ** -0.5),
        "ffn_w2": nrm((N_DENSE, D_FF_DENSE, D), D_FF_DENSE ** -0.5),
        "moe_router": nrm((N_MOE, D, N_EXPERTS), D ** -0.5),
        "moe_w1": nrm((N_MOE, N_EXPERTS, D, D_FF_EXPERT), D ** -0.5),
        "moe_w3": nrm((N_MOE, N_EXPERTS, D, D_FF_EXPERT), D ** -0.5),
        "moe_w2": nrm((N_MOE, N_EXPERTS, D_FF_EXPERT, D), D_FF_EXPERT ** -0.5),
    }


def reference(x, mem, norm_mix, norm_mem, norm_ffn, w_in, w_gate, b_gate,
              da_q_norm, da_k_norm, da_lam_q1, da_lam_k1, da_lam_q2, da_lam_k2, da_out_norm,
              pool_w, pool_scale, mem_q_norm, mem_k_norm, w_mem_kv,
              w_br_da, w_br_pool, w_br_mem, w_out,
              ffn_w1, ffn_w3, ffn_w2, moe_router, moe_w1, moe_w3, moe_w2):
    B, S, D = x.shape
    c_q = DA_QK_WIDTH
    c_k = c_q + DA_QK_WIDTH
    c_v = c_k + DA_WIDTH
    c_p = c_v + POOL_WIDTH
    for l in range(DEPTH):
        h = rmsnorm(x, norm_mix[l])
        proj = h @ w_in[l]
        q = rmsnorm(proj[..., :c_q].reshape(B, S, DA_HEADS, 2, DA_QK_DIM), da_q_norm[l])
        k = rmsnorm(proj[..., c_q:c_k].reshape(B, S, DA_HEADS, 2, DA_QK_DIM), da_k_norm[l])
        v = proj[..., c_k:c_v].reshape(B, S, DA_HEADS, DA_V_DIM)
        p_in = proj[..., c_v:c_p]
        mq = proj[..., c_p:]

        lam_0 = lambda_init(l)
        lam = (jnp.exp(jnp.sum(da_lam_q1[l] * da_lam_k1[l]))
               - jnp.exp(jnp.sum(da_lam_q2[l] * da_lam_k2[l])) + lam_0)
        o_da = diff_attention(q, k, v, lam)
        o_da = (rmsnorm(o_da, da_out_norm[l]) * (1.0 - lam_0)).reshape(B, S, DA_WIDTH)

        o_pool = pool_mixer(p_in, pool_w[l], pool_scale[l])
        o_mem = mem_attention(mq, rmsnorm(mem, norm_mem[l]), w_mem_kv[l], mem_q_norm[l], mem_k_norm[l])

        gates = jax.nn.sigmoid(h @ w_gate[l] + b_gate[l]).reshape(B, S, N_BRANCHES, D)
        merged = (gates[:, :, 0] * (o_da @ w_br_da[l])
                  + gates[:, :, 1] * (o_pool @ w_br_pool[l])
                  + gates[:, :, 2] * (o_mem @ w_br_mem[l]))
        x = x + merged @ w_out[l]

        h2 = rmsnorm(x, norm_ffn[l])
        if l % 2 == 0:
            j = l // 2
            x = x + swiglu(h2, ffn_w1[j], ffn_w3[j], ffn_w2[j])
        else:
            j = l // 2
            x = x + moe_swiglu(h2, moe_router[j], moe_w1[j], moe_w3[j], moe_w2[j])
    return x
```

```cpp
#include <hip/hip_runtime.h>
#include <cstdio>
#include <cstdint>
#define MK_N_LAUNCHES 1
#ifndef USE_I8
#define USE_I8 1
#endif
#ifndef I8_A
#define I8_A 1
#endif
#ifndef I8_E
#define I8_E 1
#endif
#ifndef REP_MEM
#define REP_MEM 1
#endif
#ifndef REP_D
#define REP_D 1
#endif
#ifndef REP_F
#define REP_F 1
#endif
#ifndef REP_Z
#define REP_Z 1
#endif
#ifndef REP_E
#define REP_E 1
#endif
#ifndef REP_DN
#define REP_DN 1
#endif
#ifndef REP_MG
#define REP_MG 1
#endif
#ifndef REP_POOL
#define REP_POOL 1
#endif
#ifndef REP_GA
#define REP_GA 1
#endif
#ifndef REP_PRO
#define REP_PRO 1
#endif
#ifndef REP_A
#define REP_A 1
#endif
#ifndef REP_DA
#define REP_DA 1
#endif
#ifndef REP_C
#define REP_C 1
#endif
#ifndef REP_UP
#define REP_UP 1
#endif

constexpr int NWAVES = 8, NTHR = 512;
constexpr int T = 16384, D = 1024, SEQ = 2048, NBATCH = 8, MEML = 256;
constexpr int NGEMM1 = 7168, FFD = 2816, FFE = 3584, NEXP = 8;
constexpr float LOG2E = 1.4426950408889634f;
constexpr float QSCALE = 0.125f * LOG2E;
constexpr float MEMSCALE = 0.08838834764831845f * LOG2E;
#ifndef MK_N_LAUNCHES
#define MK_N_LAUNCHES 1
#endif
constexpr int NPH = 22;
constexpr int MOE_CH = 45, MOE_CHL = 46;

constexpr size_t MiB = 1u << 20;
constexpr size_t CTL_ZERO_BYTES = 1 * MiB;
constexpr size_t WS_SS = 1 * MiB;
constexpr size_t WS_MQSS = 2 * MiB;
constexpr size_t WS_SSM = 2 * MiB + 512 * 1024;
constexpr size_t WS_TOKE = WS_SSM + 128 * 1024;
constexpr size_t WS_TOKP = WS_TOKE + 128 * 1024;
constexpr size_t WS_TOKG = WS_TOKP + 128 * 1024;
constexpr size_t WS_TOKR = WS_TOKG + 128 * 1024;
constexpr size_t WS_SC = WS_TOKR + 64 * 1024;
constexpr size_t WS_XGRS = WS_SC + 4096;
constexpr size_t WS_PARAM = 3 * MiB + 256 * 1024;
constexpr int PB_BGATE = 0, PB_GQ = 6144, PB_GK = 6400, PB_GOUT = 6656, PB_POOLS = 6912, PB_MQN = 7936, PB_MKN = 8192, PB_GFFN1 = 8448, PB_WR = 9472, PB_POOLW = 17664, PB_END = 17664 + 131072;
constexpr size_t WS_W1T = 4 * MiB;
constexpr size_t WS_WMEMKV = 32 * MiB;
constexpr size_t WS_WBRDA = 36 * MiB;
constexpr size_t WS_WBRPOOL = 40 * MiB;
constexpr size_t WS_WBRMEM = 42 * MiB;
constexpr size_t WS_WOUT = 44 * MiB;
constexpr size_t WS_WFF13 = 48 * MiB;
constexpr size_t WS_WFF2 = 59 * MiB;
constexpr size_t WS_SW = WS_WFF13 + 6 * MiB;
constexpr int SW_G1 = 0, SW_FF = 2 * 7168, SW_MOE = SW_FF + 2 * 2816, SW_END = SW_MOE + 8 * 2 * 3584;
constexpr size_t SW_BYTES = (size_t)SW_END * 4;
constexpr size_t WS_WMOE13 = 65 * MiB;
constexpr size_t WS_XS = WS_WMOE13 + 56 * MiB;
constexpr size_t WS_WMOE2 = 177 * MiB;
constexpr size_t WS_XB = 233 * MiB;
constexpr size_t WS_QX = WS_XB, WS_SA = 1 * MiB;
constexpr size_t WS_MEMKV = 265 * MiB;
constexpr size_t WS_R = 273 * MiB;
constexpr size_t WS_Q = WS_R, WS_K = WS_R + 32 * MiB, WS_V = WS_R + 64 * MiB, WS_P = WS_R + 96 * MiB, WS_MQ = WS_R + 112 * MiB, WS_OPOOL = WS_R + 128 * MiB, WS_G = WS_R + 144 * MiB, WS_MEMBF = WS_R + 240 * MiB, WS_POOLWT = WS_R + 244 * MiB;
constexpr size_t WS_MF = WS_K, WS_X1B = WS_K, WS_HFF = WS_R + 144 * MiB;
constexpr size_t WS_XGY = WS_MEMKV;
constexpr size_t WS_Y = WS_XGY + 34 * MiB;
constexpr size_t WS_HCH = WS_Y + 68 * MiB, HCH_BYTES = (size_t)MOE_CHL * 256 * 7168;
constexpr size_t WS_END = 529 * MiB;
static_assert(WS_XGRS + 34816 * 4 <= WS_PARAM && WS_PARAM + (size_t)PB_END * 4 <= WS_W1T && WS_HCH + 2 * HCH_BYTES <= WS_END && WS_SW + SW_BYTES <= WS_WFF2, "d_ws map");
constexpr int CW_CNT = 64;
constexpr int CW_BAR = 4096;

constexpr int RING_BYTES = 131072;
constexpr int RS_OFF = 131072, RS_UNITS = 16;
constexpr int TEXP_OFF = RS_OFF + RS_UNITS * 1024;
constexpr int LDS_BYTES = 155648;
constexpr int MISC_OFF = LDS_BYTES - 256;

namespace pg8 {
#define PG8_LAS __attribute__((address_space(3)))
typedef unsigned short bf16_t;
typedef short bf16x8 __attribute__((ext_vector_type(8)));
typedef float f32x4 __attribute__((ext_vector_type(4)));
typedef unsigned u32x4 __attribute__((ext_vector_type(4)));
constexpr int BM = 256, BK = 64, HALF = 128, HTB = HALF * BK * 2  , STAGE_BYTES = 8 * HTB, NXCD = 8, WGM = 8;

__host__ __device__ __forceinline__ int lds_byte(int r, int c) { const int st = (r >> 4) * 2 + (c >> 5), rr = r & 15, cc = c & 31, ob = rr * 64 + cc * 2; return st * 1024 + (ob ^ (((ob >> 9) & 1) << 5)); }
__host__ __device__ __forceinline__ void stage_rc(int b, int& R, int& C) { const int st = b / 1024, sb = b % 1024, swz = sb ^ (((sb >> 9) & 1) << 5); R = (st >> 1) * 16 + swz / 64; C = (st & 1) * 32 + (swz % 64) / 2; }
__host__ __device__ __forceinline__ int perm32(int rho) { const int n = rho >> 4, i = rho & 15; return 8 * (i >> 2) + 4 * n + (i & 3); }

struct Unit { int pm, pn, idx; };
struct Gemm { const bf16_t* A; const bf16_t* Bt; int M, N, K; };

struct StaticOrder {
    int nM, nN, nwg, G, c, wgm;
    __host__ __device__ void init(int M, int N, int G_, int c_) { nM = M / BM; nN = N / BM; nwg = nM * nN; G = G_; c = c_; wgm = WGM; }
    __host__ __device__ bool next(int i, Unit& u) const {
        const long L = (long)i * G + c; if (L >= nwg) return false;
        int wgid = (int)L; { const int q = nwg / NXCD, r = nwg % NXCD, xcd = wgid % NXCD, off = wgid / NXCD; wgid = (xcd < r ? xcd * (q + 1) : r * (q + 1) + (xcd - r) * q) + off; }
        const int nig = wgm * nN, gid = wgid / nig, fm = gid * wgm, gsz = (nM - fm) < wgm ? (nM - fm) : wgm;
        u.pm = fm + ((wgid % nig) % gsz); u.pn = (wgid % nig) / gsz; u.idx = i; return true;
    }
    __device__ __forceinline__ const char* bptr(const Gemm& g, const Unit& u, size_t tstep) const { return (const char*)g.Bt + (size_t)u.pn * tstep; }
    __device__ __forceinline__ const char* aptr(const Gemm& g, const Unit& u, size_t tstep) const { return (const char*)g.A + (size_t)u.pm * tstep; }
    __device__ __forceinline__ void a_ready(const Unit&) const {}
    __device__ __forceinline__ void done(const Unit&) const {}
};


typedef float f32x2 __attribute__((ext_vector_type(2)));
typedef __bf16 bf16x2_t __attribute__((ext_vector_type(2)));
__device__ __forceinline__ unsigned pk_bf16(float lo, float hi) { f32x2 v = {lo, hi}; bf16x2_t b = __builtin_convertvector(v, bf16x2_t); return __builtin_bit_cast(unsigned, b); }
__device__ __forceinline__ u32x4 pk8(const f32x4 a, const f32x4 b) { u32x4 w; w.x = pk_bf16(a[0], a[1]); w.y = pk_bf16(a[2], a[3]); w.z = pk_bf16(b[0], b[1]); w.w = pk_bf16(b[2], b[3]); return w; }
__device__ __forceinline__ float bf_lo(unsigned w) { return __builtin_bit_cast(float, w << 16); }
__device__ __forceinline__ float bf_hi(unsigned w) { return __builtin_bit_cast(float, w & 0xffff0000u); }
__device__ __forceinline__ float sigmoid_f(float x) { return __builtin_amdgcn_rcpf(1.0f + __builtin_amdgcn_exp2f(-1.4426950408889634f * x)); }
constexpr float RMS_EPS = 1e-6f;
typedef int i32x4 __attribute__((ext_vector_type(4)));
template <bool I8> __device__ __forceinline__ f32x4 mma16(const bf16x8 a, const bf16x8 b, const f32x4 c) {
    if constexpr (I8) return __builtin_bit_cast(f32x4, __builtin_amdgcn_mfma_i32_16x16x64_i8(__builtin_bit_cast(i32x4, a), __builtin_bit_cast(i32x4, b), __builtin_bit_cast(i32x4, c), 0, 0, 0));
    else return __builtin_amdgcn_mfma_f32_16x16x32_bf16(a, b, c, 0, 0, 0);
}
template <bool I8> __device__ __forceinline__ f32x4 accf(const f32x4 a) {
    if constexpr (I8) { const i32x4 v = __builtin_bit_cast(i32x4, a); return (f32x4){(float)v[0], (float)v[1], (float)v[2], (float)v[3]}; } else return a;
}


struct Sched2 : StaticOrder {
    const float* rsrc; int rmode;
    int rrow0;
    PG8_LAS float* rtab;
    const PG8_LAS int* texp; size_t estride; int t0;
    int rng, rng_start, rng_cnt;
    const bf16_t* A2; const bf16_t* B2; int chain;
    __device__ __forceinline__ void init2(int M, int N, int G_, int c_, PG8_LAS float* tab) { init(M, N, G_, c_); rsrc = nullptr; rmode = 0; rrow0 = 0; rtab = tab; texp = nullptr; estride = 0; t0 = 0; A2 = nullptr; B2 = nullptr; chain = 0; rng = 0; rng_start = 0; rng_cnt = 0; }
    __device__ __forceinline__ bool next(int i, Unit& u) const {
        if (rng != 0) { if (i >= rng_cnt) return false; const int q = rng_start + i; u.pm = q / nN; u.pn = q - u.pm * nN; u.idx = i; return true; }
        if (chain == 0) return StaticOrder::next(i, u); if (i >= chain || !StaticOrder::next(0, u)) return false; u.idx = i; return true; }
    __device__ __forceinline__ const char* aptr(const Gemm& g, const Unit& u, size_t tstep) const { return (const char*)((chain != 0 && u.idx == 1) ? A2 : g.A) + (size_t)u.pm * tstep; }
    __device__ __forceinline__ const char* bptr(const Gemm& g, const Unit& u, size_t tstep) const {
        const char* b = (const char*)((chain != 0 && u.idx == 1) ? B2 : g.Bt) + (size_t)u.pn * tstep;
        if (texp) b += (size_t)texp[t0 + u.pm] * estride;
        return b;
    }
    __device__ __forceinline__ void a_ready(const Unit&) const {}
    __device__ __forceinline__ void prep() const {
        if (rmode == 0) return;
        int tid = threadIdx.x; asm volatile("" : "+v"(tid));
        if (tid < 256) {
            Unit u;
#pragma unroll 1
            for (int i = 0; i < 16 && next(i, u); ++i) {
                const size_t row = (size_t)rrow0 + (size_t)u.pm * 256 + tid; float sc;
                if (rmode == 1) { const f32x4* p = (const f32x4*)(rsrc + row * 16); const f32x4 a = p[0], b = p[1], c = p[2], d = p[3];
                    const float s = ((a[0] + a[1]) + (a[2] + a[3])) + ((b[0] + b[1]) + (b[2] + b[3])) + ((c[0] + c[1]) + (c[2] + c[3])) + ((d[0] + d[1]) + (d[2] + d[3]));
                    sc = __builtin_amdgcn_rsqf(s * (1.0f / 1024.0f) + RMS_EPS); }
                else sc = rsrc[row];
                rtab[i * 256 + tid] = sc;
            }
        }
    }
    __device__ __forceinline__ void done(const Unit&) const {}
};

template <bool RS> struct EpiStore {
    static constexpr bool PERM = false, AFTER_DRAIN = false, I8 = false;
    bf16_t* O; int ldc; const PG8_LAS float* rs;
    __device__ __forceinline__ void operator()(const f32x4 (&acc)[2][2][4][2], const Unit& u, int wr, int wc, int fr, int fq) const {
        const int rl = wr * 64 + fr; const size_t row0 = (size_t)u.pm * BM + rl; const int col0 = u.pn * BM + 64 * wc + 8 * fq;
#pragma unroll
        for (int ai = 0; ai < 2; ++ai)
#pragma unroll
            for (int m = 0; m < 4; ++m) { const float sc = RS ? rs[u.idx * 256 + rl + ai * HALF + m * 16] : 1.f; bf16_t* rowp = O + (row0 + ai * HALF + m * 16) * ldc + col0;
#pragma unroll
                for (int bj = 0; bj < 2; ++bj) *(u32x4*)(rowp + 32 * bj) = pk8(acc[ai][bj][m][0] * sc, acc[ai][bj][m][1] * sc); }
    }
};

template <bool I8_> struct EpiA {
    static constexpr bool PERM = false, AFTER_DRAIN = false, I8 = I8_;
    unsigned char* ws; int l; const PG8_LAS float* rs;
    __device__ __forceinline__ void operator()(const f32x4 (&acc)[2][2][4][2], const Unit& u, int wr, int wc, int fr, int fq) const {
        const int pn = u.pn, rl = wr * 64 + fr; const size_t row0 = (size_t)u.pm * BM + rl; const PG8_LAS float* rsp = rs + u.idx * 256 + rl;
        const float* prm = (const float*)(ws + WS_PARAM);
        f32x4 cw[2][2];
#pragma unroll
        for (int bj = 0; bj < 2; ++bj)
#pragma unroll
            for (int n = 0; n < 2; ++n) { if constexpr (I8_) cw[bj][n] = *(const f32x4*)((const float*)(ws + WS_SW) + SW_G1 + l * 7168 + pn * 256 + 64 * wc + 32 * bj + 8 * fq + 4 * n) * (1.0f / 127.0f); else cw[bj][n] = (f32x4){1.f, 1.f, 1.f, 1.f}; }
#define EA_V(ai, bj, m, n) (accf<I8_>(acc[ai][bj][m][n]) * cw[bj][n])
        if (pn < 8) {
            const bool isq = pn < 4; const float* gg = prm + (isq ? PB_GQ : PB_GK) + l * 128 + (wc & 1) * 64 + 8 * fq; const float mul = isq ? QSCALE : 1.f;
            f32x4 gv[2][2];
#pragma unroll
            for (int bj = 0; bj < 2; ++bj)
#pragma unroll
                for (int n = 0; n < 2; ++n) gv[bj][n] = *(const f32x4*)(gg + 32 * bj + 4 * n);
            bf16_t* base = (bf16_t*)(ws + (isq ? WS_Q : WS_K)) + (pn & 3) * 256 + 64 * wc + 8 * fq;
#pragma unroll
            for (int ai = 0; ai < 2; ++ai)
#pragma unroll
                for (int m = 0; m < 4; ++m) { const float sc = rsp[ai * HALF + m * 16];
                    f32x4 v[2][2]; float ss = 0.f;
#pragma unroll
                    for (int bj = 0; bj < 2; ++bj)
#pragma unroll
                        for (int n = 0; n < 2; ++n) { v[bj][n] = EA_V(ai, bj, m, n) * sc; const f32x4 x = v[bj][n]; ss += (x[0] * x[0] + x[1] * x[1]) + (x[2] * x[2] + x[3] * x[3]); }
                    ss += __shfl_xor(ss, 16); ss += __shfl_xor(ss, 32);
                    const float r = __builtin_amdgcn_rsqf(ss * (1.0f / 64.0f) + RMS_EPS) * mul;
                    bf16_t* rowp = base + (row0 + ai * HALF + m * 16) * 1024;
#pragma unroll
                    for (int bj = 0; bj < 2; ++bj) *(u32x4*)(rowp + 32 * bj) = pk8(v[bj][0] * gv[bj][0] * r, v[bj][1] * gv[bj][1] * r); }
        } else if (pn < 14) {
            bf16_t* base; int ldc;
            if (pn < 12) { base = (bf16_t*)(ws + WS_V) + (pn - 8) * 256; ldc = 1024; } else { base = (bf16_t*)(ws + WS_P) + (pn - 12) * 256; ldc = 512; }
            base += 64 * wc + 8 * fq;
#pragma unroll
            for (int ai = 0; ai < 2; ++ai)
#pragma unroll
                for (int m = 0; m < 4; ++m) { const float sc = rsp[ai * HALF + m * 16]; bf16_t* rowp = base + (row0 + ai * HALF + m * 16) * ldc;
#pragma unroll
                    for (int bj = 0; bj < 2; ++bj) *(u32x4*)(rowp + 32 * bj) = pk8(EA_V(ai, bj, m, 0) * sc, EA_V(ai, bj, m, 1) * sc); }
        } else if (pn < 16) {
            bf16_t* base = (bf16_t*)(ws + WS_MQ) + (pn - 14) * 256 + 64 * wc + 8 * fq; float* mqss = (float*)(ws + WS_MQSS);
#pragma unroll
            for (int ai = 0; ai < 2; ++ai)
#pragma unroll
                for (int m = 0; m < 4; ++m) { const float sc = rsp[ai * HALF + m * 16]; const size_t row = row0 + ai * HALF + m * 16; bf16_t* rowp = base + row * 512; float ss = 0.f;
#pragma unroll
                    for (int bj = 0; bj < 2; ++bj) { const f32x4 a = EA_V(ai, bj, m, 0) * sc, b = EA_V(ai, bj, m, 1) * sc;
                        ss += ((a[0] * a[0] + a[1] * a[1]) + (a[2] * a[2] + a[3] * a[3])) + ((b[0] * b[0] + b[1] * b[1]) + (b[2] * b[2] + b[3] * b[3]));
                        *(u32x4*)(rowp + 32 * bj) = pk8(a, b); }
                    ss += __shfl_xor(ss, 16); ss += __shfl_xor(ss, 32);
                    if (fq == 0) mqss[row * 8 + (pn - 14) * 4 + wc] = ss; }
        } else {
            const int gcol = (pn - 16) * 256 + 64 * wc + 8 * fq; unsigned char* base = (unsigned char*)(ws + WS_G) + gcol; const float* bgate = prm + PB_BGATE + l * 3072 + gcol;
            f32x4 bv[2][2];
#pragma unroll
            for (int bj = 0; bj < 2; ++bj)
#pragma unroll
                for (int n = 0; n < 2; ++n) bv[bj][n] = *(const f32x4*)(bgate + 32 * bj + 4 * n);
#pragma unroll
            for (int ai = 0; ai < 2; ++ai)
#pragma unroll
                for (int m = 0; m < 4; ++m) { const float sc = rsp[ai * HALF + m * 16]; unsigned char* rowp = base + (row0 + ai * HALF + m * 16) * 3072;
#pragma unroll
                    for (int bj = 0; bj < 2; ++bj) { f32x4 a = EA_V(ai, bj, m, 0) * sc + bv[bj][0], b = EA_V(ai, bj, m, 1) * sc + bv[bj][1];
#pragma unroll
                        for (int j = 0; j < 4; ++j) { a[j] = sigmoid_f(a[j]) * 255.0f + 0.5f; b[j] = sigmoid_f(b[j]) * 255.0f + 0.5f; }
                        const unsigned w0 = (unsigned)a[0] | ((unsigned)a[1] << 8) | ((unsigned)a[2] << 16) | ((unsigned)a[3] << 24), w1 = (unsigned)b[0] | ((unsigned)b[1] << 8) | ((unsigned)b[2] << 16) | ((unsigned)b[3] << 24);
                        *(unsigned long long*)(rowp + 32 * bj) = (unsigned long long)w0 | ((unsigned long long)w1 << 32); } }
        }
    }
};
#undef EA_V

struct EpiBr0 {
    static constexpr bool PERM = false, AFTER_DRAIN = false, I8 = false;
    unsigned char* ws;
    __device__ __forceinline__ void operator()(const f32x4 (&acc)[2][2][4][2], const Unit& u, int wr, int wc, int fr, int fq) const {
        const size_t row0 = (size_t)u.pm * BM + wr * 64 + fr; const int col0 = u.pn * BM + 64 * wc + 8 * fq;
        const unsigned char* G = (const unsigned char*)(ws + WS_G); bf16_t* MFb = (bf16_t*)(ws + WS_MF);
#pragma unroll
        for (int ai = 0; ai < 2; ++ai) { unsigned long long gw[4][2];
#pragma unroll
            for (int m = 0; m < 4; ++m)
#pragma unroll
                for (int bj = 0; bj < 2; ++bj) gw[m][bj] = *(const unsigned long long*)(G + (row0 + ai * HALF + m * 16) * 3072 + col0 + 32 * bj);
#pragma unroll
            for (int m = 0; m < 4; ++m) { const size_t row = row0 + ai * HALF + m * 16;
#pragma unroll
                for (int bj = 0; bj < 2; ++bj) { const int col = col0 + 32 * bj;
                    const unsigned glo = (unsigned)gw[m][bj], ghi = (unsigned)(gw[m][bj] >> 32);
                    const f32x4 g0 = (f32x4){(float)(glo & 255u), (float)((glo >> 8) & 255u), (float)((glo >> 16) & 255u), (float)(glo >> 24)} * (1.0f / 255.0f), g1 = (f32x4){(float)(ghi & 255u), (float)((ghi >> 8) & 255u), (float)((ghi >> 16) & 255u), (float)(ghi >> 24)} * (1.0f / 255.0f);
                    *(u32x4*)(MFb + row * 1024 + col) = pk8(acc[ai][bj][m][0] * g0, acc[ai][bj][m][1] * g1); } } }
    }
};
struct EpiBrC {
    static constexpr bool PERM = false, AFTER_DRAIN = false, I8 = false;
    unsigned char* ws;
    __device__ __forceinline__ void operator()(const f32x4 (&acc)[2][2][4][2], const Unit& u, int wr, int wc, int fr, int fq) const {
        const size_t row0 = (size_t)u.pm * BM + wr * 64 + fr; const int col0 = u.pn * BM + 64 * wc + 8 * fq;
        const unsigned char* G = (const unsigned char*)(ws + WS_G) + (1 + u.idx) * 1024; const bf16_t* MFb = (const bf16_t*)(ws + WS_MF); bf16_t* O = (bf16_t*)(ws + (u.idx == 0 ? WS_MF : WS_Q));
#pragma unroll
        for (int ai = 0; ai < 2; ++ai) { unsigned long long gw[4][2]; u32x4 mw[4][2];
#pragma unroll
            for (int m = 0; m < 4; ++m)
#pragma unroll
                for (int bj = 0; bj < 2; ++bj) { const size_t row = row0 + ai * HALF + m * 16; const int col = col0 + 32 * bj;
                    gw[m][bj] = *(const unsigned long long*)(G + row * 3072 + col); mw[m][bj] = *(const u32x4*)(MFb + row * 1024 + col); }
#pragma unroll
            for (int m = 0; m < 4; ++m) { const size_t row = row0 + ai * HALF + m * 16;
#pragma unroll
                for (int bj = 0; bj < 2; ++bj) { const int col = col0 + 32 * bj;
                    const unsigned glo = (unsigned)gw[m][bj], ghi = (unsigned)(gw[m][bj] >> 32); const u32x4 w = mw[m][bj];
                    const f32x4 g0 = (f32x4){(float)(glo & 255u), (float)((glo >> 8) & 255u), (float)((glo >> 16) & 255u), (float)(glo >> 24)} * (1.0f / 255.0f), g1 = (f32x4){(float)(ghi & 255u), (float)((ghi >> 8) & 255u), (float)((ghi >> 16) & 255u), (float)(ghi >> 24)} * (1.0f / 255.0f);
                    const f32x4 m0 = {bf_lo(w.x), bf_hi(w.x), bf_lo(w.y), bf_hi(w.y)}, m1 = {bf_lo(w.z), bf_hi(w.z), bf_lo(w.w), bf_hi(w.w)};
                    *(u32x4*)(O + row * 1024 + col) = pk8(acc[ai][bj][m][0] * g0 + m0, acc[ai][bj][m][1] * g1 + m1); } } }
    }
};

struct EpiRes {
    static constexpr bool PERM = false, AFTER_DRAIN = false, I8 = false;
    const float* xin; float* x; unsigned char* ws; size_t xb_off; size_t dry_off;
    __device__ __forceinline__ void operator()(const f32x4 (&acc)[2][2][4][2], const Unit& u, int wr, int wc, int fr, int fq) const {
        const size_t row0 = (size_t)u.pm * BM + wr * 64 + fr; const int col0 = u.pn * BM + 64 * wc + 8 * fq;
        float* xout = dry_off ? (float*)(ws + dry_off) : x; bf16_t* xb = (bf16_t*)(ws + xb_off); float* ss = (float*)(ws + WS_SS);
#pragma unroll
        for (int ai = 0; ai < 2; ++ai)
#pragma unroll
            for (int m = 0; m < 4; ++m) { const size_t row = row0 + ai * HALF + m * 16; float s2 = 0.f;
#pragma unroll
                for (int bj = 0; bj < 2; ++bj) { const size_t off = row * 1024 + col0 + 32 * bj;
                    const f32x4 a = *(const f32x4*)(xin + off) + acc[ai][bj][m][0], b = *(const f32x4*)(xin + off + 4) + acc[ai][bj][m][1];
                    *(f32x4*)(xout + off) = a; *(f32x4*)(xout + off + 4) = b;
                    if (xb_off) { *(u32x4*)(xb + off) = pk8(a, b); s2 += ((a[0] * a[0] + a[1] * a[1]) + (a[2] * a[2] + a[3] * a[3])) + ((b[0] * b[0] + b[1] * b[1]) + (b[2] * b[2] + b[3] * b[3])); } }
                if (xb_off) { s2 += __shfl_xor(s2, 16); s2 += __shfl_xor(s2, 32); if (fq == 0) ss[row * 16 + u.pn * 4 + wc] = s2; } }
    }
};

struct EpiResB {
    static constexpr bool PERM = false, AFTER_DRAIN = false, I8 = false;
    const float* xf; bf16_t* xs;
    __device__ __forceinline__ void operator()(const f32x4 (&acc)[2][2][4][2], const Unit& u, int wr, int wc, int fr, int fq) const {
        const size_t row0 = (size_t)u.pm * BM + wr * 64 + fr; const int col0 = u.pn * BM + 64 * wc + 8 * fq;
        if (xf) {
#pragma unroll
            for (int ai = 0; ai < 2; ++ai)
#pragma unroll
                for (int mh = 0; mh < 2; ++mh) { f32x4 a[2][2], b[2][2];
#pragma unroll
                    for (int m = 0; m < 2; ++m)
#pragma unroll
                        for (int bj = 0; bj < 2; ++bj) { const size_t off = (row0 + ai * HALF + (2 * mh + m) * 16) * 1024 + col0 + 32 * bj; a[m][bj] = *(const f32x4*)(xf + off); b[m][bj] = *(const f32x4*)(xf + off + 4); }
#pragma unroll
                    for (int m = 0; m < 2; ++m)
#pragma unroll
                        for (int bj = 0; bj < 2; ++bj) { const size_t off = (row0 + ai * HALF + (2 * mh + m) * 16) * 1024 + col0 + 32 * bj;
                            *(u32x4*)(xs + off) = pk8(a[m][bj] + acc[ai][bj][2 * mh + m][0], b[m][bj] + acc[ai][bj][2 * mh + m][1]); } }
        } else {
#pragma unroll
            for (int ai = 0; ai < 2; ++ai) { u32x4 w[4][2];
#pragma unroll
                for (int m = 0; m < 4; ++m)
#pragma unroll
                    for (int bj = 0; bj < 2; ++bj) w[m][bj] = *(const u32x4*)(xs + (row0 + ai * HALF + m * 16) * 1024 + col0 + 32 * bj);
#pragma unroll
                for (int m = 0; m < 4; ++m)
#pragma unroll
                    for (int bj = 0; bj < 2; ++bj) { const size_t off = (row0 + ai * HALF + m * 16) * 1024 + col0 + 32 * bj; const u32x4 x = w[m][bj];
                        const f32x4 a = {bf_lo(x.x), bf_hi(x.x), bf_lo(x.y), bf_hi(x.y)}, b = {bf_lo(x.z), bf_hi(x.z), bf_lo(x.w), bf_hi(x.w)};
                        *(u32x4*)(xs + off) = pk8(a + acc[ai][bj][m][0], b + acc[ai][bj][m][1]); } }
        }
    }
};

template <bool I8_> struct EpiSwiglu {
    static constexpr bool PERM = false, AFTER_DRAIN = false, I8 = I8_;
    bf16_t* H; int ldc; const PG8_LAS float* rs; const float* cmax; int nh;
    const PG8_LAS int* texp; int t0;
    __device__ __forceinline__ void operator()(const f32x4 (&acc)[2][2][4][2], const Unit& u, int wr, int wc, int fr, int fq) const {
        const int rl = wr * 64 + fr; const size_t row0 = (size_t)u.pm * BM + rl; const int col0 = u.pn * 128 + 32 * wc + 8 * fq;
        f32x4 c1[2], c3[2];
#pragma unroll
        for (int bj = 0; bj < 2; ++bj) { if constexpr (I8_) { const float* cm = cmax + (texp ? (size_t)texp[t0 + u.pm] * 2 * nh : 0) + col0 + 4 * bj; c1[bj] = *(const f32x4*)cm * (1.0f / 127.0f); c3[bj] = *(const f32x4*)(cm + nh) * (1.0f / 127.0f); } else { c1[bj] = (f32x4){1.f, 1.f, 1.f, 1.f}; c3[bj] = c1[bj]; } }
#pragma unroll
        for (int ai = 0; ai < 2; ++ai)
#pragma unroll
            for (int m = 0; m < 4; ++m) { const float sc = rs[u.idx * 256 + rl + ai * HALF + m * 16]; f32x4 h[2];
#pragma unroll
                for (int bj = 0; bj < 2; ++bj) { const f32x4 a = accf<I8_>(acc[ai][bj][m][0]) * c1[bj] * sc, b = accf<I8_>(acc[ai][bj][m][1]) * c3[bj] * sc;
#pragma unroll
                    for (int j = 0; j < 4; ++j) h[bj][j] = a[j] * sigmoid_f(a[j]) * b[j]; }
                *(u32x4*)(H + (row0 + ai * HALF + m * 16) * ldc + col0) = pk8(h[0], h[1]); }
    }
};

template <class Epi, class Sched, bool ALIGN_EPI = false, bool SP2 = false>
__device__ __forceinline__ void gemm_phase(PG8_LAS unsigned char* lds, const Gemm g, const Sched& S, const Epi& E) {
    int tid_ = threadIdx.x; asm volatile("" : "+v"(tid_));
    const int tid = tid_, wid = __builtin_amdgcn_readfirstlane(tid >> 6), lane = tid & 63, wr = wid >> 2, wc = wid & 3, fr = lane & 15, fq = lane >> 4;
    const int K = g.K, nt = K / BK;
    unsigned voffA[2], voffB[2];
#pragma unroll
    for (int i = 0; i < 2; ++i) { int R, C; stage_rc(tid * 16 + i * 8192, R, C); const int Rb = Epi::PERM ? ((R & ~31) + perm32(R & 31)) : R;
        voffA[i] = (unsigned)(R * K + C) * 2u; voffB[i] = (unsigned)(Rb * K + C) * 2u; }
    const size_t kstep = (size_t)(BK * 2);
    const size_t hstep = (size_t)HALF * K * 2;
    const size_t tstep = 2 * hstep;
    const unsigned ldsw = (unsigned)wid * 1024u;
    const int aoff = lds_byte(wr * 64 + fr, fq * 8), boff = lds_byte(wc * 32 + fr, fq * 8);
#define PG8_SA(b, h) (((b) * 2 + (h)) * HTB)
#define PG8_SB(b, h) ((4 + (b) * 2 + (h)) * HTB)
#define PG8_STAGE(bufoff, gbase, voff) do { _Pragma("unroll") for (int _i = 0; _i < 2; ++_i) \
        __builtin_amdgcn_global_load_lds((const unsigned*)((const char*)(gbase) + (voff)[_i]), (PG8_LAS unsigned*)(lds + (bufoff) + ldsw + _i * 8192), 16, 0, 0); } while (0)
#define PG8_LDA(dst, b, h) do { _Pragma("unroll") for (int m = 0; m < 4; ++m) _Pragma("unroll") for (int k = 0; k < 2; ++k) dst[m][k] = *(const PG8_LAS bf16x8*)(lds + PG8_SA(b, h) + aoff + m * 2048 + k * 1024); } while (0)
#define PG8_LDB(dst, b, h) do { _Pragma("unroll") for (int n = 0; n < 2; ++n) _Pragma("unroll") for (int k = 0; k < 2; ++k) dst[n][k] = *(const PG8_LAS bf16x8*)(lds + PG8_SB(b, h) + boff + n * 2048 + k * 1024); } while (0)
#define PG8_MMA(ai, bj, At, Bt) do { __builtin_amdgcn_s_setprio(1); _Pragma("unroll") for (int m = 0; m < 4; ++m) _Pragma("unroll") for (int n = 0; n < 2; ++n) _Pragma("unroll") for (int k = 0; k < 2; ++k) \
        acc[ai][bj][m][n] = mma16<Epi::I8>(Bt[n][k], At[m][k], acc[ai][bj][m][n]); __builtin_amdgcn_s_setprio(0); } while (0)
#define PG8_WAIT_V(n) asm volatile("s_waitcnt vmcnt(" #n ")" ::: "memory")
#define PG8_WAIT_L(n) asm volatile("s_waitcnt lgkmcnt(" #n ")" ::: "memory")
#define PG8_BAR __builtin_amdgcn_s_barrier()
#define PG8_SCHED __builtin_amdgcn_sched_barrier(0)
    Unit cur, nxt; int ui = 0;
    if (!S.next(0, cur)) return;
    f32x4 acc[2][2][4][2];
#pragma unroll
    for (int a = 0; a < 2; ++a)
#pragma unroll
        for (int b = 0; b < 2; ++b)
#pragma unroll
            for (int m = 0; m < 4; ++m)
#pragma unroll
                for (int n = 0; n < 2; ++n) acc[a][b][m][n] = (f32x4){0.f, 0.f, 0.f, 0.f};
    bf16x8 At[4][2], B0[2][2], B1[2][2];
    const char* cA = S.aptr(g, cur, tstep); const char* cB = S.bptr(g, cur, tstep);
    S.a_ready(cur);
    if constexpr (SP2) {
        PG8_STAGE(PG8_SB(0, 0), cB, voffB); PG8_STAGE(PG8_SB(0, 1), cB + hstep, voffB); PG8_STAGE(PG8_SA(0, 0), cA, voffA); PG8_STAGE(PG8_SA(0, 1), cA + hstep, voffA);
        if (wr == 1) PG8_BAR;
        PG8_WAIT_V(2); PG8_BAR;
        PG8_STAGE(PG8_SB(1, 0), cB + kstep, voffB); PG8_STAGE(PG8_SA(1, 0), cA + kstep, voffA); PG8_STAGE(PG8_SB(1, 1), cB + hstep + kstep, voffB);
        PG8_WAIT_V(6); PG8_BAR;
    } else {
        PG8_STAGE(PG8_SB(0, 0), cB, voffB); PG8_STAGE(PG8_SA(0, 0), cA, voffA); PG8_STAGE(PG8_SB(0, 1), cB + hstep, voffB); PG8_STAGE(PG8_SA(0, 1), cA + hstep, voffA);
        if (wr == 1) PG8_BAR;
        PG8_WAIT_V(4); PG8_BAR;
        PG8_STAGE(PG8_SB(1, 0), cB + kstep, voffB); PG8_STAGE(PG8_SA(1, 0), cA + kstep, voffA); PG8_STAGE(PG8_SB(1, 1), cB + hstep + kstep, voffB);
        PG8_WAIT_V(6); PG8_BAR;
    }
    for (;;) {
        const bool has_next = S.next(ui + 1, nxt);
        const char* nA = has_next ? S.aptr(g, nxt, tstep) : cA; const char* nB = has_next ? S.bptr(g, nxt, tstep) : cB;
        for (int t = 0; t < nt; t += 2) {
            const bool last = (t == nt - 2);
            const char* a1 = cA + (size_t)(t + 1) * kstep;
            const char* a2 = last ? nA : cA + (size_t)(t + 2) * kstep; const char* b2 = last ? nB : cB + (size_t)(t + 2) * kstep;
            const char* a3 = a2 + kstep; const char* b3 = b2 + kstep;
            if (last && has_next) S.a_ready(nxt);
            if constexpr (SP2) {
            PG8_LDB(B0, 0, 0); PG8_LDB(B1, 0, 1); PG8_SCHED; PG8_LDA(At, 0, 0); PG8_STAGE(PG8_SA(1, 1), a1 + hstep, voffA);
            PG8_WAIT_V(8); PG8_WAIT_L(0); PG8_BAR; PG8_MMA(0, 0, At, B0); PG8_MMA(0, 1, At, B1); PG8_BAR; PG8_SCHED;
            PG8_LDA(At, 0, 1); PG8_STAGE(PG8_SB(0, 0), b2, voffB); PG8_STAGE(PG8_SB(0, 1), b2 + hstep, voffB); PG8_STAGE(PG8_SA(0, 0), a2, voffA);
            PG8_WAIT_V(8); PG8_WAIT_L(0); PG8_BAR; PG8_MMA(1, 0, At, B0); PG8_MMA(1, 1, At, B1); PG8_BAR; PG8_SCHED;
            PG8_LDB(B0, 1, 0); PG8_LDB(B1, 1, 1); PG8_SCHED; PG8_LDA(At, 1, 0); PG8_STAGE(PG8_SA(0, 1), a2 + hstep, voffA);
            PG8_WAIT_V(8); PG8_WAIT_L(0); PG8_BAR; PG8_MMA(0, 0, At, B0); PG8_MMA(0, 1, At, B1); PG8_BAR; PG8_SCHED;
            PG8_LDA(At, 1, 1); PG8_STAGE(PG8_SB(1, 0), b3, voffB); PG8_STAGE(PG8_SB(1, 1), b3 + hstep, voffB); PG8_STAGE(PG8_SA(1, 0), a3, voffA);
            PG8_WAIT_V(8); PG8_WAIT_L(0); PG8_BAR; PG8_MMA(1, 0, At, B0); PG8_MMA(1, 1, At, B1); PG8_BAR; PG8_SCHED;
            } else {
            PG8_LDB(B0, 0, 0); PG8_SCHED; PG8_LDA(At, 0, 0); PG8_STAGE(PG8_SA(1, 1), a1 + hstep, voffA);
            PG8_WAIT_L(8); PG8_BAR; PG8_WAIT_L(0); PG8_MMA(0, 0, At, B0); PG8_BAR; PG8_SCHED;
            PG8_LDB(B1, 0, 1); PG8_STAGE(PG8_SB(0, 0), b2, voffB);
            PG8_BAR; PG8_WAIT_L(0); PG8_MMA(0, 1, At, B1); PG8_BAR;
            PG8_LDA(At, 0, 1); PG8_STAGE(PG8_SA(0, 0), a2, voffA);
            PG8_BAR; PG8_WAIT_L(0); PG8_MMA(1, 0, At, B0); PG8_BAR; PG8_SCHED;
            PG8_STAGE(PG8_SB(0, 1), b2 + hstep, voffB);
            PG8_WAIT_V(6); PG8_BAR; PG8_MMA(1, 1, At, B1); PG8_BAR;
            PG8_LDB(B0, 1, 0); PG8_SCHED; PG8_LDA(At, 1, 0); PG8_STAGE(PG8_SA(0, 1), a2 + hstep, voffA);
            PG8_WAIT_L(8); PG8_BAR; PG8_WAIT_L(0); PG8_MMA(0, 0, At, B0); PG8_BAR; PG8_SCHED;
            PG8_LDB(B1, 1, 1); PG8_STAGE(PG8_SB(1, 0), b3, voffB);
            PG8_BAR; PG8_WAIT_L(0); PG8_MMA(0, 1, At, B1); PG8_BAR;
            PG8_LDA(At, 1, 1); PG8_STAGE(PG8_SA(1, 0), a3, voffA);
            PG8_BAR; PG8_WAIT_L(0); PG8_MMA(1, 0, At, B0); PG8_BAR; PG8_SCHED;
            PG8_STAGE(PG8_SB(1, 1), b3 + hstep, voffB);
            PG8_WAIT_V(6); PG8_BAR; PG8_MMA(1, 1, At, B1); PG8_BAR;
            }
        }
        if constexpr (ALIGN_EPI) { if (wr == 0) PG8_BAR; }
        if constexpr (!Epi::AFTER_DRAIN) { E(acc, cur, wr, wc, fr, fq); S.done(cur); }
        if (!has_next) break;
#pragma unroll
        for (int a = 0; a < 2; ++a)
#pragma unroll
            for (int b = 0; b < 2; ++b)
#pragma unroll
                for (int m = 0; m < 4; ++m)
#pragma unroll
                    for (int n = 0; n < 2; ++n) acc[a][b][m][n] = (f32x4){0.f, 0.f, 0.f, 0.f};
        cur = nxt; cA = nA; cB = nB; ++ui;
        if constexpr (ALIGN_EPI) { if (wr == 1) PG8_BAR; }
    }
    PG8_WAIT_V(0);
    if constexpr (!ALIGN_EPI) { if (wr == 0) PG8_BAR; }
    PG8_BAR;
    if constexpr (Epi::AFTER_DRAIN) { E.fused(acc, cur, wr, wc, fr, fq, lds, wid, lane); S.done(cur); }
#undef PG8_SA
#undef PG8_SB
#undef PG8_STAGE
#undef PG8_LDA
#undef PG8_LDB
#undef PG8_MMA
#undef PG8_WAIT_V
#undef PG8_WAIT_L
#undef PG8_BAR
#undef PG8_SCHED
}
}
#define GAS __attribute__((address_space(1)))
#define LAS __attribute__((address_space(3)))
typedef unsigned short bf16_t;
typedef unsigned v4u __attribute__((ext_vector_type(4)));
typedef float f32x4 __attribute__((ext_vector_type(4)));
typedef float f32x2 __attribute__((ext_vector_type(2)));
#define RLX_AGENT __ATOMIC_RELAXED, __HIP_MEMORY_SCOPE_AGENT
__device__ __forceinline__ float wave_sum(float v) {
#pragma unroll
    for (int o = 1; o < 64; o <<= 1) v += __shfl_xor(v, o);
    return v;
}
__device__ __forceinline__ float ld_f32_agent(const float* p) { return __builtin_bit_cast(float, __builtin_amdgcn_readfirstlane(__hip_atomic_load((const unsigned*)p, RLX_AGENT))); }
__device__ __forceinline__ float ld_f32_plain(const float* p) { return *(const GAS float*)p; }
__device__ __forceinline__ int ld_i32_agent(const int* p) { return (int)__hip_atomic_load((const unsigned*)p, RLX_AGENT); }
using pg8::pk_bf16; using pg8::bf_lo; using pg8::bf_hi;

#define XB_TMO      128
#define XB_XCNT(j)  (256  + 64 * (j))
#define XB_XSUB(j)  (1280 + 64 * (j))
#define XB_XGEN(j)  (2304 + 64 * (j))
#define XB_TOP      3328
#define XB_TOPGEN   3392
#define XCD_BAR_WORDS 3456
#define XB_SPIN_CAP (1u << 18)

__device__ __forceinline__ unsigned xb_ld(unsigned* p)              { return __hip_atomic_load(p, __ATOMIC_RELAXED, __HIP_MEMORY_SCOPE_AGENT); }
__device__ __forceinline__ unsigned xb_add(unsigned* p, unsigned v) { return __hip_atomic_fetch_add(p, v, __ATOMIC_RELAXED, __HIP_MEMORY_SCOPE_AGENT); }
__device__ __forceinline__ unsigned xb_xcc_id() { return (unsigned)__builtin_amdgcn_s_getreg((3 << 11) | 20) & 0xFu; }
#define XB_SPIN(cond, bar) do { unsigned _sp = 0; while (cond) { __builtin_amdgcn_s_sleep(1); \
    if ((++_sp & 255u) == 0u) { if (xb_ld(&(bar)[XB_TMO])) break; if (_sp > XB_SPIN_CAP) { atomicAdd(&(bar)[XB_TMO], 1u); break; } } } } while (0)

struct XcdBarrier {
    unsigned* bar; unsigned x;
    volatile LAS unsigned* st;
};

__device__ __forceinline__ XcdBarrier xcd_barrier_post(unsigned* bar, volatile LAS unsigned* st) {
    XcdBarrier b; b.bar = bar; b.x = xb_xcc_id(); b.st = st;
    if (threadIdx.x == 0) (void)xb_add(&bar[XB_XCNT(b.x)], 1u);
    return b;
}
__device__ __forceinline__ void xcd_barrier_complete(unsigned* bar, unsigned x, unsigned& nloc, unsigned& nx) {
    const unsigned G = gridDim.x * gridDim.y * gridDim.z;
    unsigned sum, cnt, mine, sp = 0u;
    for (;;) {
        sum = 0u; cnt = 0u; mine = 0u;
#pragma unroll
        for (unsigned j = 0; j < 16; ++j) { const unsigned c = xb_ld(&bar[XB_XCNT(j)]); sum += c; cnt += (c > 0u) ? 1u : 0u; mine = (j == x) ? c : mine; }
        if (sum == G) break;
        __builtin_amdgcn_s_sleep(1);
        if ((++sp & 255u) == 0u) { if (xb_ld(&bar[XB_TMO])) break; if (sp > XB_SPIN_CAP) { atomicAdd(&bar[XB_TMO], 1u); break; } }
    }
    nloc = mine > 0u ? mine : 1u; nx = cnt > 0u ? cnt : 1u;
}

__device__ __forceinline__ void xcd_barrier(const XcdBarrier& b) {
    asm volatile("s_waitcnt vmcnt(0)" ::: "memory");
    __syncthreads();
    if (threadIdx.x == 0) {
        unsigned* bar = b.bar;
        __builtin_amdgcn_s_waitcnt(0);
        unsigned nloc = b.st[0], nx = b.st[1];
        if (nloc == 0u) { xcd_barrier_complete(bar, b.x, nloc, nx); b.st[0] = nloc; b.st[1] = nx; }
        const unsigned old = xb_add(&bar[XB_XSUB(b.x)], 1u);
        const unsigned gen = old / nloc;
        if (old + 1u == (gen + 1u) * nloc) {
            __builtin_amdgcn_fence(__ATOMIC_RELEASE, "agent");
            asm volatile("s_waitcnt vmcnt(0)" ::: "memory");
            const unsigned og = xb_add(&bar[XB_TOP], 1u);
            const unsigned tg = og / nx;
            if (og + 1u == (tg + 1u) * nx) xb_add(&bar[XB_TOPGEN], 1u);
            else XB_SPIN(xb_ld(&bar[XB_TOPGEN]) == tg, bar);
            __builtin_amdgcn_fence(__ATOMIC_ACQUIRE, "agent");
            xb_add(&bar[XB_XGEN(b.x)], 1u);
            asm volatile("s_waitcnt vmcnt(0)" ::: "memory");
        } else {
            XB_SPIN(xb_ld(&bar[XB_XGEN(b.x)]) == gen, bar);
            __builtin_amdgcn_fence(__ATOMIC_ACQUIRE, "agent");
            asm volatile("s_waitcnt vmcnt(0)" ::: "memory");
        }
    }
    __syncthreads();
}


struct Args { const float* in[31]; float* out; unsigned char* ws; int ph_lo, ph_hi; };

struct TJob { unsigned long long src, dst, gain; int K, N, ld, map, colbase, start, q8, smax, startq; };
constexpr int NJOBS = 41;
__device__ __forceinline__ void make_job(int j, const Args& a, TJob& o) {
    unsigned char* ws = a.ws; const float* src; void* dst; const float* gain = nullptr; o.map = 0; o.colbase = 0; o.q8 = 0; o.smax = 0;
    if (j < 14) { const int l = j / 7, t = j % 7;
        if (t == 0)      { src = a.in[5] + (size_t)l * D * 4096; o.K = D; o.N = 4096; dst = ws + WS_W1T + l * 14 * MiB; gain = a.in[2] + l * D; o.q8 = I8_A; o.smax = SW_G1 + l * 7168; }
        else if (t == 1) { src = a.in[6] + (size_t)l * D * 3072; o.K = D; o.N = 3072; dst = ws + WS_W1T + l * 14 * MiB; gain = a.in[2] + l * D; o.colbase = 4096; o.q8 = I8_A; o.smax = SW_G1 + l * 7168 + 4096; }
        else if (t == 2) { src = a.in[19] + (size_t)l * D * 1024; o.K = D; o.N = 1024; dst = ws + WS_WMEMKV + l * 2 * MiB; gain = a.in[3] + l * D; }
        else if (t == 3) { src = a.in[20] + (size_t)l * 1024 * D; o.K = 1024; o.N = D; dst = ws + WS_WBRDA + l * 2 * MiB; }
        else if (t == 4) { src = a.in[21] + (size_t)l * 512 * D; o.K = 512; o.N = D; dst = ws + WS_WBRPOOL + l * 1 * MiB; }
        else if (t == 5) { src = a.in[22] + (size_t)l * 512 * D; o.K = 512; o.N = D; dst = ws + WS_WBRMEM + l * 1 * MiB; }
        else             { src = a.in[23] + (size_t)l * D * D; o.K = D; o.N = D; dst = ws + WS_WOUT + l * 2 * MiB; }
    } else if (j < 17) { const int t = j - 14;
        if (t < 2) { src = a.in[24 + t]; o.K = D; o.N = FFD; dst = ws + WS_WFF13; gain = a.in[4]; o.map = 1 + t; o.q8 = I8_E; o.smax = SW_FF + t * FFD; }
        else       { src = a.in[26]; o.K = FFD; o.N = D; dst = ws + WS_WFF2; }
    } else { const int e = (j - 17) / 3, t = (j - 17) % 3;
        if (t < 2) { src = a.in[28 + t] + (size_t)e * D * FFE; o.K = D; o.N = FFE; dst = ws + WS_WMOE13 + (size_t)e * 7 * MiB; gain = a.in[4] + D; o.map = 1 + t; o.q8 = USE_I8; o.smax = SW_MOE + e * 2 * FFE + t * FFE; }
        else       { src = a.in[30] + (size_t)e * FFE * D; o.K = FFE; o.N = D; dst = ws + WS_WMOE2 + (size_t)e * 7 * MiB; }
    }
    o.src = (unsigned long long)src; o.dst = (unsigned long long)dst; o.gain = (unsigned long long)gain; o.ld = o.N; o.start = 0; o.startq = 0;
}
__device__ __forceinline__ int bt_row_std(int C) { const int c = C & 255; return (C & ~255) + 128 * ((c >> 5) & 1) + 32 * (c >> 6) + 16 * ((c >> 2) & 1) + 4 * ((c >> 3) & 3) + (c & 3); }
__device__ __forceinline__ int bt_row_swiglu(int h, int which) { const int hl = h & 127; return 256 * (h >> 7) + 128 * ((hl >> 2) & 1) + 32 * (hl >> 5) + 16 * which + 4 * ((hl >> 3) & 3) + (hl & 3); }
struct TileRef { const GAS float* src; GAS bf16_t* dst; const GAS float* gain; int K, ld, map, colbase, k0, n0, q8, smax; };
template <bool QONLY> __device__ __forceinline__ void tile_decode(const LAS TJob* jobs, int& j, int it, TileRef& r) {
    if constexpr (QONLY) { while (it >= jobs[j + 1].startq) ++j; } else { while (it >= jobs[j + 1].start) ++j; }
    const LAS TJob* jb = jobs + j; const int item = it - (QONLY ? jb->startq : jb->start), nblk = jb->N >> 6;
    r.src = (const GAS float*)jb->src; r.dst = (GAS bf16_t*)jb->dst; r.gain = (const GAS float*)jb->gain; r.K = jb->K; r.ld = jb->ld; r.map = jb->map; r.colbase = jb->colbase; r.q8 = jb->q8; r.smax = jb->smax;
    r.k0 = (item / nblk) * 64; r.n0 = (item % nblk) * 64;
}
__device__ __forceinline__ void tile_load(const TileRef& r, int lane, f32x4 (&v)[16]) {
    const GAS float* p = r.src + (size_t)(r.k0 + (lane >> 4)) * r.ld + r.n0 + 4 * (lane & 15);
#pragma unroll
    for (int i = 0; i < 16; ++i) v[i] = __builtin_nontemporal_load((const GAS f32x4*)(p + (size_t)(4 * i) * r.ld));
}
__device__ __forceinline__ void tile_store(const TileRef& r, int lane, const f32x4 (&v)[16], LAS float* scr) {
#pragma unroll
    for (int i = 0; i < 16; ++i) { LAS float* d = scr + (4 * i + (lane >> 4)) * 65 + 4 * (lane & 15); d[0] = v[i][0]; d[1] = v[i][1]; d[2] = v[i][2]; d[3] = v[i][3]; }
    asm volatile("s_waitcnt lgkmcnt(0)" ::: "memory");
    const int kc = lane & 7;
    f32x4 g0 = {1.f, 1.f, 1.f, 1.f}, g1 = g0;
    if (r.gain) { g0 = *(const GAS f32x4*)(r.gain + r.k0 + 8 * kc); g1 = *(const GAS f32x4*)(r.gain + r.k0 + 8 * kc + 4); }
#pragma unroll
    for (int jj = 0; jj < 8; ++jj) { const int n = (lane >> 3) + 8 * jj; const LAS float* s = scr + (8 * kc) * 65 + n;
        v4u o; o.x = pk_bf16(s[0 * 65] * g0[0], s[1 * 65] * g0[1]); o.y = pk_bf16(s[2 * 65] * g0[2], s[3 * 65] * g0[3]); o.z = pk_bf16(s[4 * 65] * g1[0], s[5 * 65] * g1[1]); o.w = pk_bf16(s[6 * 65] * g1[2], s[7 * 65] * g1[3]);
        const int row = (r.map == 0) ? bt_row_std(r.colbase + r.n0 + n) : bt_row_swiglu(r.n0 + n, r.map - 1);
        *(GAS v4u*)(r.dst + (size_t)row * r.K + r.k0 + 8 * kc) = o; }
    asm volatile("s_waitcnt lgkmcnt(0)" ::: "memory");
}
__device__ __forceinline__ void tile_colmax(const TileRef& r, int lane, const f32x4 (&v)[16], float* cmaxbase) {
    float m0 = 0.f, m1 = 0.f, m2 = 0.f, m3 = 0.f;
#pragma unroll
    for (int i = 0; i < 16; ++i) { const float g = r.gain ? r.gain[r.k0 + 4 * i + (lane >> 4)] : 1.f;
        m0 = fmaxf(m0, fabsf(v[i][0] * g)); m1 = fmaxf(m1, fabsf(v[i][1] * g)); m2 = fmaxf(m2, fabsf(v[i][2] * g)); m3 = fmaxf(m3, fabsf(v[i][3] * g)); }
    m0 = fmaxf(m0, __shfl_xor(m0, 16)); m1 = fmaxf(m1, __shfl_xor(m1, 16)); m2 = fmaxf(m2, __shfl_xor(m2, 16)); m3 = fmaxf(m3, __shfl_xor(m3, 16));
    m0 = fmaxf(m0, __shfl_xor(m0, 32)); m1 = fmaxf(m1, __shfl_xor(m1, 32)); m2 = fmaxf(m2, __shfl_xor(m2, 32)); m3 = fmaxf(m3, __shfl_xor(m3, 32));
    if (lane < 16) { unsigned* p = (unsigned*)(cmaxbase + r.smax + r.n0 + 4 * lane);
        atomicMax(p, __float_as_uint(m0)); atomicMax(p + 1, __float_as_uint(m1)); atomicMax(p + 2, __float_as_uint(m2)); atomicMax(p + 3, __float_as_uint(m3)); }
}
__device__ __forceinline__ unsigned pk_i8x4(float a, float b, float c, float d) {
    const int ia = (int)__builtin_rintf(a), ib = (int)__builtin_rintf(b), ic = (int)__builtin_rintf(c), id = (int)__builtin_rintf(d);
    return (unsigned)(ia & 0xff) | ((unsigned)(ib & 0xff) << 8) | ((unsigned)(ic & 0xff) << 16) | ((unsigned)id << 24);
}
__device__ __forceinline__ void tile_store_q8(const TileRef& r, int lane, const f32x4 (&v)[16], LAS float* scr, const float* cmaxbase) {
#pragma unroll
    for (int i = 0; i < 16; ++i) { const float g = r.gain ? r.gain[r.k0 + 4 * i + (lane >> 4)] : 1.f; LAS float* d = scr + (4 * i + (lane >> 4)) * 65 + 4 * (lane & 15); d[0] = v[i][0] * g; d[1] = v[i][1] * g; d[2] = v[i][2] * g; d[3] = v[i][3] * g; }
    asm volatile("s_waitcnt lgkmcnt(0)" ::: "memory");
    const int kc = lane & 3;
#pragma unroll
    for (int jj = 0; jj < 4; ++jj) { const int n = (lane >> 2) + 16 * jj; const LAS float* s = scr + (16 * kc) * 65 + n;
        const float cm = ld_f32_plain(cmaxbase + r.smax + r.n0 + n), inv = cm > 0.f ? 127.0f / cm : 0.f;
        v4u o; o.x = pk_i8x4(s[0 * 65] * inv, s[1 * 65] * inv, s[2 * 65] * inv, s[3 * 65] * inv); o.y = pk_i8x4(s[4 * 65] * inv, s[5 * 65] * inv, s[6 * 65] * inv, s[7 * 65] * inv);
        o.z = pk_i8x4(s[8 * 65] * inv, s[9 * 65] * inv, s[10 * 65] * inv, s[11 * 65] * inv); o.w = pk_i8x4(s[12 * 65] * inv, s[13 * 65] * inv, s[14 * 65] * inv, s[15 * 65] * inv);
        const int row = (r.map == 0) ? bt_row_std(r.colbase + r.n0 + n) : bt_row_swiglu(r.n0 + n, r.map - 1);
        *(GAS v4u*)((GAS unsigned char*)r.dst + (size_t)row * r.K + r.k0 + 16 * kc) = o; }
    asm volatile("s_waitcnt lgkmcnt(0)" ::: "memory");
}
__device__ __forceinline__ void row_to_i8(const float* xrow, unsigned char* qrow, float* sa, int lane) {
    const f32x4* xr = (const f32x4*)xrow + 4 * lane; f32x4 v[4]; float s = 0.f, mx = 0.f;
#pragma unroll
    for (int j = 0; j < 4; ++j) { v[j] = xr[j]; s += (v[j][0] * v[j][0] + v[j][1] * v[j][1]) + (v[j][2] * v[j][2] + v[j][3] * v[j][3]);
        mx = fmaxf(mx, fmaxf(fmaxf(fabsf(v[j][0]), fabsf(v[j][1])), fmaxf(fabsf(v[j][2]), fabsf(v[j][3])))); }
    s = wave_sum(s);
#pragma unroll
    for (int o = 1; o < 64; o <<= 1) mx = fmaxf(mx, __shfl_xor(mx, o));
    const float inv = mx > 0.f ? 127.0f / mx : 0.f;
    v4u w; w.x = pk_i8x4(v[0][0] * inv, v[0][1] * inv, v[0][2] * inv, v[0][3] * inv); w.y = pk_i8x4(v[1][0] * inv, v[1][1] * inv, v[1][2] * inv, v[1][3] * inv);
    w.z = pk_i8x4(v[2][0] * inv, v[2][1] * inv, v[2][2] * inv, v[2][3] * inv); w.w = pk_i8x4(v[3][0] * inv, v[3][1] * inv, v[3][2] * inv, v[3][3] * inv);
    *((v4u*)qrow + lane) = w;
    if (lane == 0) *sa = mx * (1.0f / 127.0f) * __builtin_amdgcn_rsqf(s * (1.0f / 1024.0f) + 1e-6f);
}
__device__ __forceinline__ void ld16_bf16(const bf16_t* p, f32x4 (&v)[4]) {
    const v4u a = *(const v4u*)p, b = *(const v4u*)(p + 8);
    v[0] = (f32x4){bf_lo(a.x), bf_hi(a.x), bf_lo(a.y), bf_hi(a.y)}; v[1] = (f32x4){bf_lo(a.z), bf_hi(a.z), bf_lo(a.w), bf_hi(a.w)};
    v[2] = (f32x4){bf_lo(b.x), bf_hi(b.x), bf_lo(b.y), bf_hi(b.y)}; v[3] = (f32x4){bf_lo(b.z), bf_hi(b.z), bf_lo(b.w), bf_hi(b.w)};
}
__device__ __forceinline__ void rowb_to_i8(const bf16_t* xrow, unsigned char* qrow, float* sa, int lane) {
    f32x4 v[4]; ld16_bf16(xrow + 16 * lane, v); float s = 0.f, mx = 0.f;
#pragma unroll
    for (int j = 0; j < 4; ++j) { s += (v[j][0] * v[j][0] + v[j][1] * v[j][1]) + (v[j][2] * v[j][2] + v[j][3] * v[j][3]);
        mx = fmaxf(mx, fmaxf(fmaxf(fabsf(v[j][0]), fabsf(v[j][1])), fmaxf(fabsf(v[j][2]), fabsf(v[j][3])))); }
    s = wave_sum(s);
#pragma unroll
    for (int o = 1; o < 64; o <<= 1) mx = fmaxf(mx, __shfl_xor(mx, o));
    const float inv = mx > 0.f ? 127.0f / mx : 0.f;
    v4u w; w.x = pk_i8x4(v[0][0] * inv, v[0][1] * inv, v[0][2] * inv, v[0][3] * inv); w.y = pk_i8x4(v[1][0] * inv, v[1][1] * inv, v[1][2] * inv, v[1][3] * inv);
    w.z = pk_i8x4(v[2][0] * inv, v[2][1] * inv, v[2][2] * inv, v[2][3] * inv); w.w = pk_i8x4(v[3][0] * inv, v[3][1] * inv, v[3][2] * inv, v[3][3] * inv);
    *((v4u*)qrow + lane) = w;
    if (lane == 0) *sa = mx * (1.0f / 127.0f) * __builtin_amdgcn_rsqf(s * (1.0f / 1024.0f) + 1e-6f);
}
__device__ __forceinline__ void phase_quant_rows(const bf16_t* x, unsigned char* ws, int lane, int wave) {
    const int gw = blockIdx.x * NWAVES + wave, NGW = gridDim.x * NWAVES;
    for (int m = gw; m < T; m += NGW) rowb_to_i8(x + (size_t)m * D, ws + WS_QX + (size_t)m * D, (float*)(ws + WS_SA) + m, lane);
}
__device__ __forceinline__ void row_to_bf16_ss(const float* xrow, bf16_t* orow, float* ss16, float* fcopy, int lane) {
    const f32x4* xr = (const f32x4*)xrow + lane; f32x4 v[4]; float s = 0.f;
#pragma unroll
    for (int j = 0; j < 4; ++j) { v[j] = xr[64 * j]; s += (v[j][0] * v[j][0] + v[j][1] * v[j][1]) + (v[j][2] * v[j][2] + v[j][3] * v[j][3]); }
    s = wave_sum(s);
    if (fcopy) { f32x4* fc = (f32x4*)fcopy + lane;
#pragma unroll
        for (int j = 0; j < 4; ++j) fc[64 * j] = v[j]; }
    unsigned long long* o8 = (unsigned long long*)orow + lane;
#pragma unroll
    for (int j = 0; j < 4; ++j) o8[64 * j] = (unsigned long long)pk_bf16(v[j][0], v[j][1]) | ((unsigned long long)pk_bf16(v[j][2], v[j][3]) << 32);
    if (lane < 16) ss16[lane] = (lane == 0) ? s : 0.f;
}
__device__ __forceinline__ void build_jobs(const Args& a, LAS TJob* jobs, int tid) {
    if (tid < NJOBS) { TJob jb; make_job(tid, a, jb); LAS TJob* d = jobs + tid; d->src = jb.src; d->dst = jb.dst; d->gain = jb.gain; d->K = jb.K; d->N = jb.N; d->ld = jb.ld; d->map = jb.map; d->colbase = jb.colbase; d->q8 = jb.q8; d->smax = jb.smax; d->start = 0; d->startq = 0; }
    __syncthreads();
    if (tid == 0) { int s = 0, q = 0; for (int j = 0; j < NJOBS; ++j) { jobs[j].start = s; jobs[j].startq = q; if (jobs[j].q8) q += jobs[j].N / 64; else s += (jobs[j].K / 64) * (jobs[j].N / 64); } jobs[NJOBS].start = s; jobs[NJOBS].startq = q; }
    __syncthreads();
}
__device__ __forceinline__ void strip_q8(const LAS TJob* jobs, int& j, int st, LAS unsigned char* lds, int tid, int lane, int wave, float* cmaxbase) {
    while (st >= jobs[j + 1].startq) ++j;
    const LAS TJob* jb = jobs + j;
    TileRef r; r.src = (const GAS float*)jb->src; r.dst = (GAS bf16_t*)jb->dst; r.gain = (const GAS float*)jb->gain; r.K = jb->K; r.ld = jb->ld; r.map = jb->map; r.colbase = jb->colbase; r.q8 = 1; r.smax = jb->smax;
    r.n0 = (st - jb->startq) * 64; r.k0 = 128 * wave;
    LAS float* scr = (LAS float*)(lds + wave * 17408); LAS float* pmax = (LAS float*)(lds + 8 * 17408 + 4096); LAS float* cmf = pmax + 8 * 64;
    f32x4 v0[16], v1[16];
    tile_load(r, lane, v0); r.k0 += 64; tile_load(r, lane, v1); r.k0 -= 64;
    float m0 = 0.f, m1 = 0.f, m2 = 0.f, m3 = 0.f;
#pragma unroll
    for (int i = 0; i < 16; ++i) { const float g0 = r.gain ? r.gain[r.k0 + 4 * i + (lane >> 4)] : 1.f, g1 = r.gain ? r.gain[r.k0 + 64 + 4 * i + (lane >> 4)] : 1.f;
        v0[i] = v0[i] * g0; v1[i] = v1[i] * g1;
        m0 = fmaxf(m0, fmaxf(fabsf(v0[i][0]), fabsf(v1[i][0]))); m1 = fmaxf(m1, fmaxf(fabsf(v0[i][1]), fabsf(v1[i][1]))); m2 = fmaxf(m2, fmaxf(fabsf(v0[i][2]), fabsf(v1[i][2]))); m3 = fmaxf(m3, fmaxf(fabsf(v0[i][3]), fabsf(v1[i][3]))); }
    m0 = fmaxf(m0, __shfl_xor(m0, 16)); m1 = fmaxf(m1, __shfl_xor(m1, 16)); m2 = fmaxf(m2, __shfl_xor(m2, 16)); m3 = fmaxf(m3, __shfl_xor(m3, 16));
    m0 = fmaxf(m0, __shfl_xor(m0, 32)); m1 = fmaxf(m1, __shfl_xor(m1, 32)); m2 = fmaxf(m2, __shfl_xor(m2, 32)); m3 = fmaxf(m3, __shfl_xor(m3, 32));
    __syncthreads();
    if (lane < 16) *(LAS f32x4*)(pmax + wave * 64 + 4 * lane) = (f32x4){m0, m1, m2, m3};
    __syncthreads();
    if (tid < 64) { float m = pmax[tid];
#pragma unroll
        for (int w = 1; w < 8; ++w) m = fmaxf(m, pmax[w * 64 + tid]);
        cmf[tid] = m; cmaxbase[r.smax + r.n0 + tid] = m; }
    __syncthreads();
#pragma unroll
    for (int h = 0; h < 2; ++h) {
#pragma unroll
        for (int i = 0; i < 16; ++i) { LAS float* d = scr + (4 * i + (lane >> 4)) * 65 + 4 * (lane & 15); const f32x4 x = h ? v1[i] : v0[i]; d[0] = x[0]; d[1] = x[1]; d[2] = x[2]; d[3] = x[3]; }
        asm volatile("s_waitcnt lgkmcnt(0)" ::: "memory");
        const int kc = lane & 3;
#pragma unroll
        for (int jj = 0; jj < 4; ++jj) { const int n = (lane >> 2) + 16 * jj; const LAS float* s = scr + (16 * kc) * 65 + n;
            const float cm = cmf[n], inv = cm > 0.f ? 127.0f / cm : 0.f;
            v4u o; o.x = pk_i8x4(s[0 * 65] * inv, s[1 * 65] * inv, s[2 * 65] * inv, s[3 * 65] * inv); o.y = pk_i8x4(s[4 * 65] * inv, s[5 * 65] * inv, s[6 * 65] * inv, s[7 * 65] * inv);
            o.z = pk_i8x4(s[8 * 65] * inv, s[9 * 65] * inv, s[10 * 65] * inv, s[11 * 65] * inv); o.w = pk_i8x4(s[12 * 65] * inv, s[13 * 65] * inv, s[14 * 65] * inv, s[15 * 65] * inv);
            const int row = (r.map == 0) ? bt_row_std(r.colbase + r.n0 + n) : bt_row_swiglu(r.n0 + n, r.map - 1);
            *(GAS v4u*)((GAS unsigned char*)r.dst + (size_t)row * r.K + r.k0 + 64 * h + 16 * kc) = o; }
        asm volatile("s_waitcnt lgkmcnt(0)" ::: "memory");
    }
}
__device__ __forceinline__ void phase_prologue(const Args& a, LAS unsigned char* lds, int tid, int lane, int wave) {
    unsigned char* ws = a.ws;
    LAS TJob* jobs = (LAS TJob*)(lds + 8 * 17408);
    build_jobs(a, jobs, tid);
    const int gw = blockIdx.x * NWAVES + wave, NGW = gridDim.x * NWAVES;
    { const int nstrip = jobs[NJOBS].startq; int js = 0;
      for (int st = blockIdx.x; st < nstrip; st += gridDim.x) strip_q8(jobs, js, st, lds, tid, lane, wave, (float*)(ws + WS_SW));
      __syncthreads(); }
    {
        LAS float* scr = (LAS float*)(lds + wave * 17408);
        const int total = jobs[NJOBS].start; int j = 0;
        if (gw < total) {
            TileRef cur, nxt; f32x4 v[16], vn[16];
            tile_decode<false>(jobs, j, gw, cur); tile_load(cur, lane, v);
#pragma unroll 1
            for (int it = gw; it < total; it += NGW) {
                const bool more = it + NGW < total;
                if (more) { tile_decode<false>(jobs, j, it + NGW, nxt); tile_load(nxt, lane, vn); }
                tile_store(cur, lane, v, scr);
                if (more) { cur = nxt;
#pragma unroll
                    for (int i = 0; i < 16; ++i) v[i] = vn[i]; }
            }
        }
    }
#if I8_A
    for (int m = gw; m < T; m += NGW) row_to_i8(a.in[0] + (size_t)m * D, ws + WS_QX + (size_t)m * D, (float*)(ws + WS_SA) + m, lane);
#else
    for (int m = gw; m < T; m += NGW) row_to_bf16_ss(a.in[0] + (size_t)m * D, (bf16_t*)(ws + WS_XB) + (size_t)m * D, (float*)(ws + WS_SS) + (size_t)m * 16, nullptr, lane);
#endif
    for (int m = gw; m < NBATCH * MEML; m += NGW) row_to_bf16_ss(a.in[1] + (size_t)m * D, (bf16_t*)(ws + WS_MEMBF) + (size_t)m * D, (float*)(ws + WS_SSM) + (size_t)m * 16, nullptr, lane);
    {
        float* prm = (float*)(ws + WS_PARAM); const int gt = blockIdx.x * NTHR + tid, NGT = gridDim.x * NTHR;
        for (int i = gt; i < PB_END; i += NGT) { float v;
            if (i < PB_GQ) v = a.in[7][i]; else if (i < PB_GK) v = a.in[8][i - PB_GQ]; else if (i < PB_GOUT) v = a.in[9][i - PB_GK]; else if (i < PB_POOLS) v = a.in[14][i - PB_GOUT];
            else if (i < PB_MQN) v = a.in[16][i - PB_POOLS]; else if (i < PB_MKN) v = a.in[17][i - PB_MQN]; else if (i < PB_GFFN1) v = a.in[18][i - PB_MKN]; else if (i < PB_WR) v = a.in[4][D + i - PB_GFFN1];
            else if (i < PB_POOLW) v = a.in[27][i - PB_WR]; else v = a.in[15][i - PB_POOLW];
            prm[i] = v; }
        bf16_t* pwt = (bf16_t*)(ws + WS_POOLWT);
        for (int i = gt; i < 2 * 4 * 128 * 128; i += NGT) { const int lg = i >> 14, dout = (i >> 7) & 127, cc = i & 127; pwt[i] = (bf16_t)(pk_bf16(a.in[15][((size_t)lg * 128 + cc) * 128 + dout], 0.f) & 0xffffu); }
    }
    if (blockIdx.x == 0 && wave == 0) {
        float* sc = (float*)(ws + WS_SC);
        for (int l = 0; l < 2; ++l) {
            const float a1 = wave_sum(a.in[10][l * 64 + lane] * a.in[11][l * 64 + lane]), a2 = wave_sum(a.in[12][l * 64 + lane] * a.in[13][l * 64 + lane]);
            const float lam0 = (l == 0) ? 0.2f : (0.8f - 0.6f * 0.7408182206817179f);
            const float lam = __expf(a1) - __expf(a2) + lam0;
            float m0 = fabsf(a.in[8][l * 128 + lane] * a.in[9][l * 128 + lane]), m1 = fabsf(a.in[8][l * 128 + 64 + lane] * a.in[9][l * 128 + 64 + lane]);
            float mm = fmaxf(fabsf(a.in[17][l * 128 + lane] * a.in[18][l * 128 + lane]), fabsf(a.in[17][l * 128 + 64 + lane] * a.in[18][l * 128 + 64 + lane]));
#pragma unroll
            for (int o = 1; o < 64; o <<= 1) { m0 = fmaxf(m0, __shfl_xor(m0, o)); m1 = fmaxf(m1, __shfl_xor(m1, o)); mm = fmaxf(mm, __shfl_xor(mm, o)); }
            if (lane == 0) { sc[l * 8 + 0] = lam; sc[l * 8 + 1] = m0 * 64.f * QSCALE; sc[l * 8 + 2] = m1 * 64.f * QSCALE; sc[l * 8 + 3] = mm * 128.f * MEMSCALE; sc[l * 8 + 4] = 1.0f - lam0; }
        }
    }
}

__device__ __forceinline__ void unpack16(const bf16_t* src, float (&f)[16]) {
    const v4u a = *(const v4u*)src, b = *(const v4u*)(src + 8);
    f[0] = bf_lo(a.x); f[1] = bf_hi(a.x); f[2] = bf_lo(a.y); f[3] = bf_hi(a.y); f[4] = bf_lo(a.z); f[5] = bf_hi(a.z); f[6] = bf_lo(a.w); f[7] = bf_hi(a.w);
    f[8] = bf_lo(b.x); f[9] = bf_hi(b.x); f[10] = bf_lo(b.y); f[11] = bf_hi(b.y); f[12] = bf_lo(b.z); f[13] = bf_hi(b.z); f[14] = bf_lo(b.w); f[15] = bf_hi(b.w);
}
template <bool DIFF>
__device__ __forceinline__ void naive_attn_unit(LAS unsigned char* lds, int tid, const bf16_t* Qg, int ldq, const bf16_t* Kg, int ldk, const bf16_t* Vg, int ldv, bf16_t* Og, int ldo,
                                                int ntiles, int qpos0, const float* qmulA, const float* qmulB, const float* qss, float slope2, float bnd0, float bnd1, float lam, const float* gout, float outmul) {
    constexpr int QW = 4;
    LAS float* Lq = (LAS float*)lds; LAS float* Lk = Lq + 32 * 128; LAS float* Lv = Lk + 64 * 129; LAS float* Lp = Lv + 64 * 128; LAS float* Lrk = Lp + 8 * QW * 2 * 64;
    const int lane = tid & 63, wid = tid >> 6, r = tid >> 3, sg = tid & 7;
    __syncthreads();
    if (tid < 256) { float f[16]; unpack16(Qg + (size_t)r * ldq + sg * 16, f); float mul = 1.f;
      if (!DIFF) { const float s = qss[r * 8] + qss[r * 8 + 1]; mul = __builtin_amdgcn_rsqf(s * (1.f / 128.f) + 1e-6f) * MEMSCALE; }
#pragma unroll
      for (int i = 0; i < 16; ++i) Lq[r * 128 + sg * 16 + i] = DIFF ? f[i] : f[i] * mul * qmulA[sg * 16 + i] * qmulB[sg * 16 + i]; }
    float o0[QW][2], o1[QW][2], l0[QW], l1[QW];
#pragma unroll
    for (int q = 0; q < QW; ++q) { o0[q][0] = o0[q][1] = o1[q][0] = o1[q][1] = 0.f; l0[q] = l1[q] = 0.f; }
#pragma unroll 1
    for (int j = 0; j < ntiles; ++j) {
        __syncthreads();
        { float f[16]; unpack16(Kg + (size_t)(j * 64 + r) * ldk + sg * 16, f);
#pragma unroll
          for (int i = 0; i < 16; ++i) Lk[r * 129 + sg * 16 + i] = f[i];
          unpack16(Vg + (size_t)(j * 64 + r) * ldv + sg * 16, f);
#pragma unroll
          for (int i = 0; i < 16; ++i) Lv[r * 128 + sg * 16 + i] = f[i]; }
        __syncthreads();
        if (!DIFF) { if (tid < 64) { float s = 0.f;
#pragma unroll 4
            for (int d = 0; d < 128; ++d) { const float x = Lk[tid * 129 + d]; s += x * x; } Lrk[tid] = __builtin_amdgcn_rsqf(s * (1.f / 128.f) + 1e-6f); } __syncthreads(); }
        float s0[QW], s1[QW];
#pragma unroll
        for (int q = 0; q < QW; ++q) { s0[q] = 0.f; s1[q] = 0.f; }
#pragma unroll 1
        for (int d4 = 0; d4 < 16; ++d4) {
            const float k0 = Lk[lane * 129 + 4 * d4], k1 = Lk[lane * 129 + 4 * d4 + 1], k2 = Lk[lane * 129 + 4 * d4 + 2], k3 = Lk[lane * 129 + 4 * d4 + 3];
            const float e0 = Lk[lane * 129 + 64 + 4 * d4], e1 = Lk[lane * 129 + 64 + 4 * d4 + 1], e2 = Lk[lane * 129 + 64 + 4 * d4 + 2], e3 = Lk[lane * 129 + 64 + 4 * d4 + 3];
#pragma unroll
            for (int q = 0; q < QW; ++q) { const f32x4 qa = *(const LAS f32x4*)&Lq[(wid * QW + q) * 128 + 4 * d4], qb = *(const LAS f32x4*)&Lq[(wid * QW + q) * 128 + 64 + 4 * d4];
                s0[q] += (qa[0] * k0 + qa[1] * k1) + (qa[2] * k2 + qa[3] * k3); s1[q] += (qb[0] * e0 + qb[1] * e1) + (qb[2] * e2 + qb[3] * e3); }
        }
        const int kpos = j * 64 + lane;
#pragma unroll
        for (int q = 0; q < QW; ++q) { float p0, p1;
            if (DIFF) { const int qpos = qpos0 + wid * QW + q; const float bias = -slope2 * fabsf((float)(qpos - kpos)); p0 = __builtin_amdgcn_exp2f(s0[q] + bias - bnd0); p1 = __builtin_amdgcn_exp2f(s1[q] + bias - bnd1); }
            else { p0 = __builtin_amdgcn_exp2f((s0[q] + s1[q]) * Lrk[lane] - bnd0); p1 = 0.f; }
            l0[q] += p0; l1[q] += p1; Lp[((wid * QW + q) * 2 + 0) * 64 + lane] = p0; Lp[((wid * QW + q) * 2 + 1) * 64 + lane] = p1; }
        asm volatile("s_waitcnt lgkmcnt(0)" ::: "memory");
#pragma unroll 1
        for (int k4 = 0; k4 < 16; ++k4) {
            f32x2 v[4];
#pragma unroll
            for (int i = 0; i < 4; ++i) v[i] = *(const LAS f32x2*)&Lv[(4 * k4 + i) * 128 + 2 * lane];
#pragma unroll
            for (int q = 0; q < QW; ++q) { const f32x4 pa = *(const LAS f32x4*)&Lp[((wid * QW + q) * 2 + 0) * 64 + 4 * k4];
                o0[q][0] += (pa[0] * v[0][0] + pa[1] * v[1][0]) + (pa[2] * v[2][0] + pa[3] * v[3][0]); o0[q][1] += (pa[0] * v[0][1] + pa[1] * v[1][1]) + (pa[2] * v[2][1] + pa[3] * v[3][1]);
                if (DIFF) { const f32x4 pb = *(const LAS f32x4*)&Lp[((wid * QW + q) * 2 + 1) * 64 + 4 * k4];
                    o1[q][0] += (pb[0] * v[0][0] + pb[1] * v[1][0]) + (pb[2] * v[2][0] + pb[3] * v[3][0]); o1[q][1] += (pb[0] * v[0][1] + pb[1] * v[1][1]) + (pb[2] * v[2][1] + pb[3] * v[3][1]); } }
        }
    }
#pragma unroll
    for (int q = 0; q < QW; ++q) { const float L0 = wave_sum(l0[q]); float x = o0[q][0] / L0, y = o0[q][1] / L0;
        if (DIFF) { const float L1 = wave_sum(l1[q]); x -= lam * (o1[q][0] / L1); y -= lam * (o1[q][1] / L1);
            const float ss = wave_sum(x * x + y * y); const float rr = __builtin_amdgcn_rsqf(ss * (1.f / 128.f) + 1e-6f) * outmul; x *= rr * gout[2 * lane]; y *= rr * gout[2 * lane + 1]; }
        *(unsigned*)(Og + (size_t)(wid * QW + q) * ldo + 2 * lane) = pk_bf16(x, y); }
}
__device__ __forceinline__ void naive_pool_unit(LAS unsigned char* lds, int tid, const bf16_t* Pg  , bf16_t* Og  , const float* W  , const float* scale  , int tok0, int g) {
    LAS float* Lp = (LAS float*)lds; LAS float* Ld = Lp + 80 * 128;
    const int w = 2 << g, pos0 = tok0 & (SEQ - 1);
    __syncthreads();
    for (int i = tid; i < 80 * 8; i += NTHR) { const int rr = i >> 3, sg = i & 7; const int tpos = pos0 - 16 + rr;
        float f[16];
        if (tpos >= 0) unpack16(Pg + (size_t)(tok0 - 16 + rr) * 512 + g * 128 + sg * 16, f); else {
#pragma unroll
            for (int k = 0; k < 16; ++k) f[k] = 0.f; }
#pragma unroll
        for (int k = 0; k < 16; ++k) Lp[rr * 128 + sg * 16 + k] = f[k]; }
    __syncthreads();
    for (int i = tid; i < 64 * 128; i += NTHR) { const int t = i >> 7, c = i & 127; const int tpos = pos0 + t; const int lo = (tpos + 1 - w) > 0 ? (tpos + 1 - w) : 0; const int cnt = tpos + 1 - lo;
        float s = 0.f;
#pragma unroll 1
        for (int k = 0; k < cnt; ++k) s += Lp[(16 + t - k) * 128 + c];
        Ld[t * 128 + c] = s / (float)cnt - Lp[(16 + t) * 128 + c]; }
    __syncthreads();
    const int dout = tid & 127, tq = tid >> 7; float acc[16];
#pragma unroll
    for (int i = 0; i < 16; ++i) acc[i] = 0.f;
#pragma unroll 2
    for (int c = 0; c < 128; ++c) { const float wv = W[c * 128 + dout];
#pragma unroll
        for (int i = 0; i < 16; ++i) acc[i] += Ld[(tq * 16 + i) * 128 + c] * wv; }
    const float sc = scale[dout];
#pragma unroll
    for (int i = 0; i < 16; ++i) Og[(size_t)(tok0 + tq * 16 + i) * 512 + g * 128 + dout] = (bf16_t)(pk_bf16(acc[i] * sc, 0.f) & 0xffffu);
}

namespace mix {
typedef short bf16x8 __attribute__((ext_vector_type(8)));
typedef short s16x4 __attribute__((ext_vector_type(4)));
typedef float f32x16 __attribute__((ext_vector_type(16)));
typedef const LAS unsigned char* lptr;
#define SBAR() __builtin_amdgcn_sched_barrier(0)
__device__ __forceinline__ unsigned lds_addr(lptr p) { return (unsigned)(uintptr_t)p; }
__device__ __forceinline__ bf16x8 pack8(const f32x16& p, int b) {
    v4u w; w.x = pk_bf16(p[b], p[b + 1]); w.y = pk_bf16(p[b + 2], p[b + 3]); w.z = pk_bf16(p[b + 4], p[b + 5]); w.w = pk_bf16(p[b + 6], p[b + 7]);
    return __builtin_bit_cast(bf16x8, w);
}
__device__ __forceinline__ void glds16(const void* g, LAS unsigned char* l) { __builtin_amdgcn_global_load_lds((const unsigned*)g, (LAS unsigned*)l, 16, 0, 0); }
#define MFMA32(a, b, c) __builtin_amdgcn_mfma_f32_32x32x16_bf16(a, b, c, 0, 0, 0)

#define VRD(set, db) do { _Pragma("unroll") for (int t_ = 0; t_ < 4; ++t_) { \
        asm volatile("ds_read_b64_tr_b16 %0, %1 offset:%c2" : "=&v"(lo[set][t_]) : "v"(va[db]), "i"(t_ * 4096) : "memory"); \
        asm volatile("ds_read_b64_tr_b16 %0, %1 offset:%c2" : "=&v"(hi[set][t_]) : "v"(va[db]), "i"(t_ * 4096 + 2048) : "memory"); } } while (0)
#define VPK(set, t) (bf16x8){lo[set][t][0], lo[set][t][1], lo[set][t][2], lo[set][t][3], hi[set][t][0], hi[set][t][1], hi[set][t][2], hi[set][t][3]}
__device__ __forceinline__ void pv_tile(f32x16 (&O)[4], const unsigned (&va)[4], const bf16x8 (&pb)[4]) {
    s16x4 lo[2][4], hi[2][4];
    VRD(0, 0);
    VRD(1, 1); asm volatile("s_waitcnt lgkmcnt(8)" ::: "memory"); SBAR();
#pragma unroll
    for (int t = 0; t < 4; ++t) O[0] = MFMA32(VPK(0, t), pb[t], O[0]);
    SBAR(); VRD(0, 2); asm volatile("s_waitcnt lgkmcnt(8)" ::: "memory"); SBAR();
#pragma unroll
    for (int t = 0; t < 4; ++t) O[1] = MFMA32(VPK(1, t), pb[t], O[1]);
    SBAR(); VRD(1, 3); asm volatile("s_waitcnt lgkmcnt(8)" ::: "memory"); SBAR();
#pragma unroll
    for (int t = 0; t < 4; ++t) O[2] = MFMA32(VPK(0, t), pb[t], O[2]);
    SBAR(); asm volatile("s_waitcnt lgkmcnt(0)" ::: "memory"); SBAR();
#pragma unroll
    for (int t = 0; t < 4; ++t) O[3] = MFMA32(VPK(1, t), pb[t], O[3]);
}
__device__ __forceinline__ void kread8_swz(bf16x8 (&kf)[8], const unsigned (&ka)[4]) {
#define KRD(i, a, off) asm volatile("ds_read_b128 %0, %1 offset:%c2" : "=&v"(kf[i]) : "v"(a), "i"(off) : "memory")
    KRD(0, ka[0], 0); KRD(1, ka[0], 8192); KRD(2, ka[1], 0); KRD(3, ka[1], 8192); KRD(4, ka[2], 0); KRD(5, ka[2], 8192); KRD(6, ka[3], 0); KRD(7, ka[3], 8192);
#undef KRD
}
__device__ __forceinline__ void kread8(bf16x8 (&kf)[8], unsigned ka) {
#define KRD(i, off) asm volatile("ds_read_b128 %0, %1 offset:%c2" : "=&v"(kf[i]) : "v"(ka), "i"(off) : "memory")
    KRD(0, 0); KRD(1, 512); KRD(2, 2048); KRD(3, 2560); KRD(4, 4096); KRD(5, 4608); KRD(6, 6144); KRD(7, 6656);
#undef KRD
}

__device__ __forceinline__ void da_bias(f32x16& p0, f32x16& p1, int jt, int cq, float xq, float sl2, float B2) {
    const float x = (float)(64 * jt) - xq;
    const float Be = (jt > cq) ? 1.0e30f : B2;
#pragma unroll
    for (int r = 0; r < 16; ++r) { const float kr = (float)((r & 3) + 8 * (r >> 2)); p0[r] = __builtin_fmaf(-sl2, __builtin_fabsf(x + kr), -Be); p1[r] = __builtin_fmaf(-sl2, __builtin_fabsf(x + (32.f + kr)), -Be); }
}
__device__ __forceinline__ void diffattn_unit(LAS unsigned char* lds, int tid, const bf16_t* Qg, const bf16_t* Kg, const bf16_t* Vg, bf16_t* Og, int b, int h, int u, bool desc, float sl2, float B2, float lam, const float* gout, float outmul) {
    asm volatile("" : "+v"(tid));
    const int lane = tid & 63, wid = __builtin_amdgcn_readfirstlane(tid >> 6), map = wid >> 2, wi = wid & 3, r32 = lane & 31, hi = lane >> 5;
    const int q0 = u * 128 + wi * 32, cq = q0 >> 6, NT = 2 * u + 2;
    const size_t rowb = (size_t)b * SEQ;
    const bf16_t* qrow = Qg + (rowb + q0 + r32) * 1024 + h * 128;
    bf16x8 qf[4];
#pragma unroll
    for (int s = 0; s < 4; ++s) qf[s] = *(const bf16x8*)(qrow + map * 64 + s * 16 + hi * 8);
    unsigned koff[2], voff[2];
#pragma unroll
    for (int i = 0; i < 2; ++i) { const int row = 4 * (2 * wid + i) + (lane >> 4), slot = lane & 15;
        koff[i] = (unsigned)(row * 1024 + ((slot ^ (row & 15)) * 8));
        voff[i] = (unsigned)(row * 1024 + (((slot >> 2) ^ (row & 3)) * 32 + (slot & 3) * 8)); }
    const bf16_t* Kbh = Kg + rowb * 1024 + h * 128; const bf16_t* Vbh = Vg + rowb * 1024 + h * 128;
#define JT(i) (desc ? NT - 1 - (i) : (i))
#define DA_DMA(i) do { const int j_ = JT(i), sl_ = (i) & 3; _Pragma("unroll") for (int i_ = 0; i_ < 2; ++i_) { \
        glds16(Kbh + (size_t)j_ * 65536 + koff[i_], lds + sl_ * 32768 + (2 * wid + i_) * 1024); \
        glds16(Vbh + (size_t)j_ * 65536 + voff[i_], lds + sl_ * 32768 + 16384 + (2 * wid + i_) * 1024); } } while (0)
    f32x16 O[4];
#pragma unroll
    for (int db = 0; db < 4; ++db)
#pragma unroll
        for (int r = 0; r < 16; ++r) O[db][r] = 0.f;
    float lsum = 0.f;
    const float xq = (float)(q0 + r32 - 4 * hi);
    unsigned ka_0, va_0;
    { const unsigned l0 = lds_addr((lptr)lds); const int qp = (lane & 15) >> 2;
      ka_0 = l0 + r32 * 256 + (((map * 8 + hi) ^ (r32 & 15)) << 4);
      va_0 = l0 + 16384 + (4 * hi + qp) * 256 + (qp << 6) + ((lane >> 4) & 1) * 32 + (lane & 3) * 8; }
    __syncthreads();
    asm volatile("" : "+v"(qf[0]), "+v"(qf[1]), "+v"(qf[2]), "+v"(qf[3]));
    DA_DMA(0); DA_DMA(1);
    if (NT > 2) { DA_DMA(2); asm volatile("s_waitcnt vmcnt(4)" ::: "memory"); } else asm volatile("s_waitcnt vmcnt(0)" ::: "memory");
    __builtin_amdgcn_s_barrier();
    f32x16 pA0, pA1, pB0, pB1;
    { da_bias(pA0, pA1, JT(0), cq, xq, sl2, B2);
      unsigned ka[4];
#pragma unroll
      for (int s = 0; s < 4; ++s) ka[s] = ka_0 ^ (s << 5);
      bf16x8 kf[8]; kread8_swz(kf, ka); asm volatile("s_waitcnt lgkmcnt(0)" ::: "memory"); SBAR();
#pragma unroll
      for (int s = 0; s < 4; ++s) { pA0 = MFMA32(kf[2 * s], qf[s], pA0); pA1 = MFMA32(kf[2 * s + 1], qf[s], pA1); }
      asm volatile("s_nop 15\n\ts_nop 15" : "+v"(pA0), "+v"(pA1)); }
    da_bias(pB0, pB1, JT(1), cq, xq, sl2, B2);
#define SM4(P, b_) do { P[b_] = __builtin_amdgcn_exp2f(P[b_]); P[b_ + 1] = __builtin_amdgcn_exp2f(P[b_ + 1]); P[b_ + 2] = __builtin_amdgcn_exp2f(P[b_ + 2]); P[b_ + 3] = __builtin_amdgcn_exp2f(P[b_ + 3]); \
        lsum += (P[b_] + P[b_ + 1]) + (P[b_ + 2] + P[b_ + 3]); } while (0)
#define MFMA_A(acc, a_, b_) asm volatile("v_mfma_f32_32x32x16_bf16 %0, %1, %2, %0" : "+v"(acc) : "v"(a_), "v"(b_))
#define PIN(x_) asm volatile("" : "+v"(x_))
#define FMK(dst, krv) do { float f_; asm volatile("v_fmamk_f32 %0, %1, %c2, %3" : "=v"(f_) : "v"(sl2), "i"(__builtin_bit_cast(int, (float)(krv))), "v"(c0_)); dst = f_; } while (0)
#define FM2(C0, C1, j) do { FMK(C0[j], ((j) & 3) + 8 * ((j) >> 2)); FMK(C1[j], 32 + ((j) & 3) + 8 * ((j) >> 2)); } while (0)
#define DA_STEP(C0, C1, N0, N1, i) do { \
        if ((i) + 3 < NT) DA_DMA((i) + 3); \
        bf16x8 pb[4]; \
        { unsigned ka[4]; _Pragma("unroll") for (int s_ = 0; s_ < 4; ++s_) ka[s_] = (ka_0 + (((i) + 1) & 3) * 32768) ^ (s_ << 5); \
          bf16x8 kf[8]; kread8_swz(kf, ka); asm volatile("s_waitcnt lgkmcnt(0)" ::: "memory"); \
          MFMA_A(N0, kf[0], qf[0]); SM4(C0, 0);  PIN(C0); PIN(lsum); \
          MFMA_A(N1, kf[1], qf[0]); SM4(C0, 4);  PIN(C0); PIN(lsum); \
          MFMA_A(N0, kf[2], qf[1]); SM4(C0, 8);  PIN(C0); PIN(lsum); pb[0] = pack8(C0, 0); PIN(pb[0]); \
          MFMA_A(N1, kf[3], qf[1]); SM4(C0, 12); PIN(C0); PIN(lsum); pb[1] = pack8(C0, 8); PIN(pb[1]); \
          MFMA_A(N0, kf[4], qf[2]); SM4(C1, 0);  PIN(C1); PIN(lsum); \
          MFMA_A(N1, kf[5], qf[2]); SM4(C1, 4);  PIN(C1); PIN(lsum); \
          MFMA_A(N0, kf[6], qf[3]); SM4(C1, 8);  PIN(C1); PIN(lsum); pb[2] = pack8(C1, 0); PIN(pb[2]); \
          MFMA_A(N1, kf[7], qf[3]); SM4(C1, 12); PIN(C1); PIN(lsum); pb[3] = pack8(C1, 8); PIN(pb[3]); } \
        { unsigned va[4]; _Pragma("unroll") for (int d_ = 0; d_ < 4; ++d_) va[d_] = (va_0 + ((i) & 3) * 32768) ^ (d_ << 6); \
          s16x4 lo[2][4], hi[2][4]; \
          const int jt2_ = JT((i) + 2); \
          float c0_ = __builtin_fmaf(sl2s, (float)(64 * jt2_) - xq, (jt2_ > cq) ? -1.0e30f : -B2); PIN(c0_); \
          VRD(0, 0); VRD(1, 1); asm volatile("s_waitcnt lgkmcnt(8)" ::: "memory"); \
          _Pragma("unroll") for (int t_ = 0; t_ < 4; ++t_) { const bf16x8 vf_ = VPK(0, t_); MFMA_A(O[0], vf_, pb[t_]); FM2(C0, C1, t_); } \
          VRD(0, 2); asm volatile("s_waitcnt lgkmcnt(8)" ::: "memory"); \
          _Pragma("unroll") for (int t_ = 0; t_ < 4; ++t_) { const bf16x8 vf_ = VPK(1, t_); MFMA_A(O[1], vf_, pb[t_]); FM2(C0, C1, 4 + t_); } \
          VRD(1, 3); asm volatile("s_waitcnt lgkmcnt(8)" ::: "memory"); \
          _Pragma("unroll") for (int t_ = 0; t_ < 4; ++t_) { const bf16x8 vf_ = VPK(0, t_); MFMA_A(O[2], vf_, pb[t_]); FM2(C0, C1, 8 + t_); } \
          asm volatile("s_waitcnt lgkmcnt(0)" ::: "memory"); \
          _Pragma("unroll") for (int t_ = 0; t_ < 4; ++t_) { const bf16x8 vf_ = VPK(1, t_); MFMA_A(O[3], vf_, pb[t_]); FM2(C0, C1, 12 + t_); } \
          PIN(C0); PIN(C1); \
          if (jt2_ == cq) { da_bias(C0, C1, jt2_, cq, xq, sl2, B2); PIN(C0); PIN(C1); } } \
        if ((i) + 3 < NT) asm volatile("s_waitcnt vmcnt(4) lgkmcnt(0)" ::: "memory"); else asm volatile("s_waitcnt vmcnt(0) lgkmcnt(0)" ::: "memory"); \
        __builtin_amdgcn_s_barrier(); \
    } while (0)
    const float sl2s = __builtin_bit_cast(float, __builtin_amdgcn_readfirstlane(__builtin_bit_cast(int, sl2)));
#pragma unroll 1
    for (int i = 0; i < NT; i += 2) {
        DA_STEP(pA0, pA1, pB0, pB1, i);
        DA_STEP(pB0, pB1, pA0, pA1, i + 1);
    }
#undef DA_STEP
#undef FM2
#undef FMK
#undef MFMA_A
#undef PIN
#undef SM4
    asm volatile("s_nop 15\n\ts_nop 15" : "+v"(O[0]), "+v"(O[1]), "+v"(O[2]), "+v"(O[3]));
#undef DA_DMA
#undef JT
    lsum += __shfl_xor(lsum, 32);
    const float inv = 1.0f / lsum;
    LAS f32x4* xch = (LAS f32x4*)(lds + wi * 16384) + lane;
    if (map == 1) {
        const float f = lam * inv;
#pragma unroll
        for (int db = 0; db < 4; ++db)
#pragma unroll
            for (int g = 0; g < 4; ++g) xch[(db * 4 + g) * 64] = (f32x4){O[db][4 * g] * f, O[db][4 * g + 1] * f, O[db][4 * g + 2] * f, O[db][4 * g + 3] * f};
    }
    __syncthreads();
    if (map == 0) {
        float ss = 0.f;
#pragma unroll
        for (int db = 0; db < 4; ++db)
#pragma unroll
            for (int g = 0; g < 4; ++g) { const f32x4 o1 = xch[(db * 4 + g) * 64];
#pragma unroll
                for (int i = 0; i < 4; ++i) { const float v = O[db][4 * g + i] * inv - o1[i]; O[db][4 * g + i] = v; ss += v * v; } }
        ss += __shfl_xor(ss, 32);
        const float rr = __builtin_amdgcn_rsqf(ss * (1.f / 128.f) + 1e-6f) * outmul;
        bf16_t* orow = Og + (rowb + q0 + r32) * 1024 + h * 128 + 4 * hi;
#pragma unroll
        for (int db = 0; db < 4; ++db)
#pragma unroll
            for (int g = 0; g < 4; ++g) { const f32x4 gv = *(const f32x4*)(gout + 32 * db + 8 * g + 4 * hi);
                const unsigned w0 = pk_bf16(O[db][4 * g] * rr * gv[0], O[db][4 * g + 1] * rr * gv[1]), w1 = pk_bf16(O[db][4 * g + 2] * rr * gv[2], O[db][4 * g + 3] * rr * gv[3]);
                *(unsigned long long*)(orow + 32 * db + 8 * g) = (unsigned long long)w0 | ((unsigned long long)w1 << 32); }
    }
    __syncthreads();
}

__device__ __forceinline__ void memattn_unit(LAS unsigned char* lds, int tid, bf16_t* MQg, bf16_t* Og, const bf16_t* KVg, const float* mqss, const float* qn, const float* kn, int pm, int hd, float Bm) {
    const int lane = tid & 63, wid = __builtin_amdgcn_readfirstlane(tid >> 6), r32 = lane & 31, hi = lane >> 5;
    const int b = pm >> 3; const size_t row = (size_t)pm * 256 + wid * 32 + r32;
    __syncthreads();
#pragma unroll
    for (int i = 0; i < 8; ++i) { const int p = 8 * wid + i, vrow = 4 * p + (lane >> 4), slot = lane & 15;
        glds16(KVg + ((size_t)b * MEML + vrow) * 2048 + 512 + hd * 128 + (((slot >> 2) ^ (vrow & 3)) * 32 + (slot & 3) * 8), lds + 65536 + p * 1024); }
    { const int key = tid >> 1, half = tid & 1; const bf16_t* src = KVg + ((size_t)b * MEML + key) * 2048 + hd * 128 + half * 64;
      v4u raw[8]; float s = 0.f;
#pragma unroll
      for (int c = 0; c < 8; ++c) { raw[c] = *(const v4u*)(src + c * 8);
          const float a0 = bf_lo(raw[c].x), a1 = bf_hi(raw[c].x), a2 = bf_lo(raw[c].y), a3 = bf_hi(raw[c].y), a4 = bf_lo(raw[c].z), a5 = bf_hi(raw[c].z), a6 = bf_lo(raw[c].w), a7 = bf_hi(raw[c].w);
          s += ((a0 * a0 + a1 * a1) + (a2 * a2 + a3 * a3)) + ((a4 * a4 + a5 * a5) + (a6 * a6 + a7 * a7)); }
      s += __shfl_xor(s, 1);
      const float rk = __builtin_amdgcn_rsqf(s * (1.f / 128.f) + 1e-6f) * MEMSCALE;
#pragma unroll
      for (int c = 0; c < 8; ++c) { const int d0 = half * 64 + c * 8; const f32x4 qa = *(const f32x4*)(qn + d0), qb = *(const f32x4*)(qn + d0 + 4), ka = *(const f32x4*)(kn + d0), kb = *(const f32x4*)(kn + d0 + 4);
          v4u w; w.x = pk_bf16(bf_lo(raw[c].x) * rk * qa[0] * ka[0], bf_hi(raw[c].x) * rk * qa[1] * ka[1]); w.y = pk_bf16(bf_lo(raw[c].y) * rk * qa[2] * ka[2], bf_hi(raw[c].y) * rk * qa[3] * ka[3]);
          w.z = pk_bf16(bf_lo(raw[c].z) * rk * qb[0] * kb[0], bf_hi(raw[c].z) * rk * qb[1] * kb[1]); w.w = pk_bf16(bf_lo(raw[c].w) * rk * qb[2] * kb[2], bf_hi(raw[c].w) * rk * qb[3] * kb[3]);
          *(LAS v4u*)(lds + (key >> 6) * 16384 + (half * 8 + c) * 1024 + (key & 63) * 16) = w; } }
    const bf16_t* qrow = MQg + row * 512 + hd * 128;
    bf16x8 qf[8];
#pragma unroll
    for (int s = 0; s < 8; ++s) qf[s] = *(const bf16x8*)(qrow + s * 16 + hi * 8);
    const float rq = __builtin_amdgcn_rsqf((mqss[row * 8 + hd * 2] + mqss[row * 8 + hd * 2 + 1]) * (1.f / 128.f) + 1e-6f);
    f32x16 O[4];
#pragma unroll
    for (int db = 0; db < 4; ++db)
#pragma unroll
        for (int r = 0; r < 16; ++r) O[db][r] = 0.f;
    float lsum = 0.f;
    const lptr kl0 = (lptr)lds + hi * 1024 + r32 * 16;
    unsigned va0[4];
    { const int qp = (lane & 15) >> 2;
#pragma unroll
      for (int db = 0; db < 4; ++db) va0[db] = lds_addr((lptr)lds) + 65536 + (4 * hi + qp) * 256 + ((db ^ qp) * 64) + ((lane >> 4) & 1) * 32 + (lane & 3) * 8; }
    __syncthreads();
#pragma unroll 1
    for (int tl = 0; tl < 4; ++tl) {
        f32x16 p0, p1;
#pragma unroll
        for (int r = 0; r < 16; ++r) { p0[r] = 0.f; p1[r] = 0.f; }
        bf16x8 kf[8], kg[8]; kread8(kf, lds_addr(kl0) + tl * 16384); kread8(kg, lds_addr(kl0) + tl * 16384 + 8192);
        asm volatile("s_waitcnt lgkmcnt(8)" ::: "memory"); SBAR();
#pragma unroll
        for (int s = 0; s < 4; ++s) { p0 = MFMA32(kf[2 * s], qf[s], p0); p1 = MFMA32(kf[2 * s + 1], qf[s], p1); }
        SBAR(); asm volatile("s_waitcnt lgkmcnt(0)" ::: "memory"); SBAR();
#pragma unroll
        for (int s = 0; s < 4; ++s) { p0 = MFMA32(kg[2 * s], qf[4 + s], p0); p1 = MFMA32(kg[2 * s + 1], qf[4 + s], p1); }
#pragma unroll
        for (int r = 0; r < 16; ++r) { p0[r] = __builtin_amdgcn_exp2f(__builtin_fmaf(p0[r], rq, -Bm)); p1[r] = __builtin_amdgcn_exp2f(__builtin_fmaf(p1[r], rq, -Bm)); lsum += p0[r] + p1[r]; }
        bf16x8 pb[4]; pb[0] = pack8(p0, 0); pb[1] = pack8(p0, 8); pb[2] = pack8(p1, 0); pb[3] = pack8(p1, 8);
        unsigned va[4];
#pragma unroll
        for (int db = 0; db < 4; ++db) va[db] = va0[db] + tl * 16384;
        pv_tile(O, va, pb);
    }
    lsum += __shfl_xor(lsum, 32);
    const float inv = 1.0f / lsum;
    bf16_t* orow = Og + row * 512 + hd * 128 + 4 * hi;
#pragma unroll
    for (int db = 0; db < 4; ++db)
#pragma unroll
        for (int g = 0; g < 4; ++g) { const unsigned w0 = pk_bf16(O[db][4 * g] * inv, O[db][4 * g + 1] * inv), w1 = pk_bf16(O[db][4 * g + 2] * inv, O[db][4 * g + 3] * inv);
            *(unsigned long long*)(orow + 32 * db + 8 * g) = (unsigned long long)w0 | ((unsigned long long)w1 << 32); }
}

__device__ __forceinline__ void pool_unit(LAS unsigned char* lds, int tid, const bf16_t* Pg, bf16_t* Og, const bf16_t* Wt, const float* scale, int tok0, int g) {
    const int lane = tid & 63, wid = __builtin_amdgcn_readfirstlane(tid >> 6), r32 = lane & 31, hi = lane >> 5;
    LAS unsigned char* Lp = lds; LAS unsigned char* Ld = lds + 272 * 256;
    const int w = 2 << g, pos0 = tok0 & (SEQ - 1);
    bf16x8 wf[4][8];
#pragma unroll
    for (int db = 0; db < 4; ++db)
#pragma unroll
        for (int s = 0; s < 8; ++s) wf[db][s] = *(const bf16x8*)(Wt + (size_t)(32 * db + r32) * 128 + hi * 8 + s * 16);
    __syncthreads();
    { v4u st[9];
#pragma unroll
      for (int k = 0; k < 9; ++k) { const int i = tid + k * NTHR, ii = i < 272 * 16 ? i : tid, rr = ii >> 4, ch = ii & 15; const bool ok = pos0 - 16 + rr >= 0;
          const v4u v = *(const v4u*)(Pg + (size_t)(tok0 - 16 + (ok ? rr : 16)) * 512 + g * 128 + ch * 8); st[k].x = ok ? v.x : 0u; st[k].y = ok ? v.y : 0u; st[k].z = ok ? v.z : 0u; st[k].w = ok ? v.w : 0u; }
#pragma unroll
      for (int k = 0; k < 9; ++k) { const int i = tid + k * NTHR, rr = i >> 4, ch = i & 15; if (i < 272 * 16) *(LAS v4u*)(Lp + rr * 256 + ch * 16) = st[k]; } }
    __syncthreads();
    { const int ch = tid & 15, t0 = (tid >> 4) * 8;
      float s[8];
#pragma unroll
      for (int i = 0; i < 8; ++i) s[i] = 0.f;
#pragma unroll 1
      for (int k = 1; k < w; ++k) { const v4u v = *(const LAS v4u*)(Lp + (16 + t0 - k) * 256 + ch * 16);
          s[0] += bf_lo(v.x); s[1] += bf_hi(v.x); s[2] += bf_lo(v.y); s[3] += bf_hi(v.y); s[4] += bf_lo(v.z); s[5] += bf_hi(v.z); s[6] += bf_lo(v.w); s[7] += bf_hi(v.w); }
#pragma unroll
      for (int tt = 0; tt < 8; ++tt) { const int t = t0 + tt, tpos = pos0 + t; const int cnt = (tpos + 1 < w) ? (tpos + 1) : w; const float ic = 1.0f / (float)cnt;
          const v4u v = *(const LAS v4u*)(Lp + (16 + t) * 256 + ch * 16), o = *(const LAS v4u*)(Lp + (16 + t - w + 1) * 256 + ch * 16);
          float p[8] = {bf_lo(v.x), bf_hi(v.x), bf_lo(v.y), bf_hi(v.y), bf_lo(v.z), bf_hi(v.z), bf_lo(v.w), bf_hi(v.w)};
          float q[8] = {bf_lo(o.x), bf_hi(o.x), bf_lo(o.y), bf_hi(o.y), bf_lo(o.z), bf_hi(o.z), bf_lo(o.w), bf_hi(o.w)};
          float d[8];
#pragma unroll
          for (int i = 0; i < 8; ++i) { s[i] += p[i]; d[i] = s[i] * ic - p[i]; s[i] -= q[i]; }
          v4u wv; wv.x = pk_bf16(d[0], d[1]); wv.y = pk_bf16(d[2], d[3]); wv.z = pk_bf16(d[4], d[5]); wv.w = pk_bf16(d[6], d[7]);
          *(LAS v4u*)(Ld + t * 256 + ((ch ^ (t & 15)) << 4)) = wv; } }
    __syncthreads();
    const int tok = wid * 32 + r32;
    bf16x8 df[8];
#pragma unroll
    for (int s = 0; s < 8; ++s) df[s] = *(const LAS bf16x8*)(Ld + tok * 256 + (((2 * s + hi) ^ (tok & 15)) << 4));
    bf16_t* orow = Og + (size_t)(tok0 + tok) * 512 + g * 128 + 4 * hi;
#pragma unroll
    for (int db = 0; db < 4; ++db) {
        f32x16 acc;
#pragma unroll
        for (int r = 0; r < 16; ++r) acc[r] = 0.f;
#pragma unroll
        for (int s = 0; s < 8; ++s) acc = MFMA32(wf[db][s], df[s], acc);
#pragma unroll
        for (int gq = 0; gq < 4; ++gq) { const f32x4 sc = *(const f32x4*)(scale + 32 * db + 8 * gq + 4 * hi);
            const unsigned w0 = pk_bf16(acc[4 * gq] * sc[0], acc[4 * gq + 1] * sc[1]), w1 = pk_bf16(acc[4 * gq + 2] * sc[2], acc[4 * gq + 3] * sc[3]);
            *(unsigned long long*)(orow + 32 * db + 8 * gq) = (unsigned long long)w0 | ((unsigned long long)w1 << 32); }
    }
}
#undef MFMA32
#undef VRD
#undef VPK
#undef SBAR
}

#ifndef MIX_NAIVE_DA
#define MIX_NAIVE_DA 0
#endif
#ifndef MIX_NAIVE_MEM
#define MIX_NAIVE_MEM 0
#endif
#ifndef MIX_NAIVE_POOL
#define MIX_NAIVE_POOL 0
#endif
__device__ __forceinline__ void phase_mixers(unsigned char* ws, LAS unsigned char* lds, int l, int tid) {
    const float* prm = (const float*)(ws + WS_PARAM); const float* sc = (const float*)(ws + WS_SC) + l * 8;
    const float lam = ld_f32_agent(sc + 0), bnd0 = ld_f32_agent(sc + 1), bnd1 = ld_f32_agent(sc + 2), bndm = ld_f32_agent(sc + 3), omul = ld_f32_agent(sc + 4);
    const int bx = blockIdx.x, vcu = (gridDim.x == 256) ? ((bx & 7) * 32 + (bx >> 3)) : bx;
    bf16_t* Q = (bf16_t*)(ws + WS_Q); const bf16_t* K = (const bf16_t*)(ws + WS_K); const bf16_t* V = (const bf16_t*)(ws + WS_V);
    bf16_t* MQ = (bf16_t*)(ws + WS_MQ); const bf16_t* KV = (const bf16_t*)(ws + WS_MEMKV) + l * 1024;     const float* mqss = (const float*)(ws + WS_MQSS);
#if MIX_NAIVE_DA
    for (int u = blockIdx.x; u < 4096; u += gridDim.x) { const int hc = 63 - (u >> 6), c = hc >> 1, bh = u & 63, b = bh >> 3, h = bh & 7;
        const size_t rowb = (size_t)b * SEQ; const float slope2 = exp2f(-(float)(h + 1)) * LOG2E;
        naive_attn_unit<true>(lds, tid, Q + (rowb + hc * 32) * 1024 + h * 128, 1024, K + rowb * 1024 + h * 128, 1024, V + rowb * 1024 + h * 128, 1024, (bf16_t*)(ws + WS_XB) + (rowb + hc * 32) * 1024 + h * 128, 1024,
                              c + 1, hc * 32, nullptr, nullptr, nullptr, slope2, bnd0, bnd1, lam, prm + PB_GOUT + l * 128, omul); }
#else
    {
        const float B2 = fmaxf(bnd0, bnd1);
        for (int rep_ = 0; rep_ < REP_DA; ++rep_)
        for (int w = vcu; w < 256; w += gridDim.x) { const int bh = w >> 2, s = w & 3, b = bh >> 3, h = bh & 7; const float sl2 = exp2f(-(float)(h + 1)) * LOG2E;
#pragma unroll 1
            for (int i = 0; i < 4; ++i) { const int u = (i == 0) ? 15 - s : (i == 1) ? 8 + s : (i == 2) ? 7 - s : s;
                mix::diffattn_unit(lds, tid, Q, K, V, (bf16_t*)(ws + WS_XB), b, h, u, (i & 1) != 0, sl2, B2, lam, prm + PB_GOUT + l * 128, omul); } }
    }
#endif
#if MIX_NAIVE_MEM
    for (int u = blockIdx.x; u < 2048; u += gridDim.x) { const int qt = u >> 2, hd = u & 3, b = qt >> 6; const size_t row0 = (size_t)qt * 32;
        naive_attn_unit<false>(lds, tid, MQ + row0 * 512 + hd * 128, 512, KV + (size_t)b * MEML * 2048 + hd * 128, 2048, KV + (size_t)b * MEML * 2048 + 512 + hd * 128, 2048, MQ + row0 * 512 + hd * 128, 512,
                               4, 0, prm + PB_MQN + l * 128, prm + PB_MKN + l * 128, mqss + row0 * 8 + hd * 2, 0.f, bndm, 0.f, 0.f, nullptr, 1.f); }
#else
    for (int rep_ = 0; rep_ < REP_MEM; ++rep_)
    for (int w = vcu; w < 256; w += gridDim.x) mix::memattn_unit(lds, tid, MQ, (rep_ + 1 < REP_MEM) ? (bf16_t*)(ws + WS_OPOOL) : MQ, KV, mqss, prm + PB_MQN + l * 128, prm + PB_MKN + l * 128, w >> 2, w & 3, bndm);
#endif
#if MIX_NAIVE_POOL
    for (int u = blockIdx.x; u < 1024; u += gridDim.x) { const int tt = u >> 2, g = u & 3;
        naive_pool_unit(lds, tid, (const bf16_t*)(ws + WS_P), (bf16_t*)(ws + WS_OPOOL), prm + PB_POOLW + (size_t)(l * 4 + g) * 128 * 128, prm + PB_POOLS + l * 512 + g * 128, tt * 64, g); }
#else
    for (int rep_ = 0; rep_ < REP_POOL; ++rep_)
    for (int w = vcu; w < 256; w += gridDim.x) { const int pm = w >> 2, g = w & 3;
        mix::pool_unit(lds, tid, (const bf16_t*)(ws + WS_P), (bf16_t*)(ws + WS_OPOOL), (const bf16_t*)(ws + WS_POOLWT) + (size_t)(l * 4 + g) * 128 * 128, prm + PB_POOLS + l * 512 + g * 128, pm * 256, g); }
#endif
}

__device__ __forceinline__ void phase_route(unsigned char* ws, const bf16_t* xin, LAS unsigned char* lds, int tid, int lane, int wave) {
    const float* gffn = (const float*)(ws + WS_PARAM) + PB_GFFN1; const float* wr = (const float*)(ws + WS_PARAM) + PB_WR;
    unsigned* cnt = (unsigned*)ws + CW_CNT; int* toke = (int*)(ws + WS_TOKE); int* tokp = (int*)(ws + WS_TOKP); float* tokg = (float*)(ws + WS_TOKG); float* tokr = (float*)(ws + WS_TOKR);
    LAS unsigned* lcnt = (LAS unsigned*)lds; LAS unsigned* lbase = lcnt + 8; LAS int* linfo = (LAS int*)(lds + 64);
    const int per = T / gridDim.x;
    for (int c0 = 0; c0 < per; c0 += 64) {
        __syncthreads();
        if (tid < 8) lcnt[tid] = 0u;
        __syncthreads();
        for (int i = wave; i < 64 && c0 + i < per; i += NWAVES) {
            const int t = blockIdx.x * per + c0 + i;
            f32x4 v[4]; ld16_bf16(xin + (size_t)t * D + 16 * lane, v); float s = 0.f;
#pragma unroll
            for (int j = 0; j < 4; ++j) s += (v[j][0] * v[j][0] + v[j][1] * v[j][1]) + (v[j][2] * v[j][2] + v[j][3] * v[j][3]);
            const float rstd = __builtin_amdgcn_rsqf(wave_sum(s) * (1.f / 1024.f) + 1e-6f);
            float lg[8];
#pragma unroll
            for (int e = 0; e < 8; ++e) lg[e] = 0.f;
#pragma unroll
            for (int j = 0; j < 4; ++j)
#pragma unroll
                for (int k4 = 0; k4 < 4; ++k4) { const int k = 16 * lane + 4 * j + k4; const float xg = v[j][k4] * gffn[k]; const f32x4 w0 = *(const f32x4*)(wr + k * 8), w1 = *(const f32x4*)(wr + k * 8 + 4);
                    lg[0] += xg * w0[0]; lg[1] += xg * w0[1]; lg[2] += xg * w0[2]; lg[3] += xg * w0[3]; lg[4] += xg * w1[0]; lg[5] += xg * w1[1]; lg[6] += xg * w1[2]; lg[7] += xg * w1[3]; }
#pragma unroll
            for (int e = 0; e < 8; ++e) lg[e] = wave_sum(lg[e]) * rstd;
            int i0 = 0; float b0 = lg[0];
#pragma unroll
            for (int e = 1; e < 8; ++e) if (lg[e] > b0) { b0 = lg[e]; i0 = e; }
            int i1 = -1; float b1 = -3.0e38f;
#pragma unroll
            for (int e = 0; e < 8; ++e) if (e != i0 && lg[e] > b1) { b1 = lg[e]; i1 = e; }
            const float g0 = 1.f / (1.f + __expf(b1 - b0)), g1 = 1.f - g0;
            if (lane == 0) { const unsigned p0 = __hip_atomic_fetch_add(lcnt + i0, 1u, __ATOMIC_RELAXED, __HIP_MEMORY_SCOPE_WORKGROUP), p1 = __hip_atomic_fetch_add(lcnt + i1, 1u, __ATOMIC_RELAXED, __HIP_MEMORY_SCOPE_WORKGROUP);
                linfo[i * 4 + 0] = i0; linfo[i * 4 + 1] = i1; linfo[i * 4 + 2] = (int)p0; linfo[i * 4 + 3] = (int)p1;
                toke[2 * t] = i0; toke[2 * t + 1] = i1; tokg[2 * t] = g0; tokg[2 * t + 1] = g1; tokr[t] = rstd; }
        }
        __syncthreads();
        if (tid < 8) lbase[tid] = lcnt[tid] ? atomicAdd(cnt + 64 * tid, lcnt[tid]) : 0u;
        __syncthreads();
        if (tid < 64 && c0 + tid < per) { const int t = blockIdx.x * per + c0 + tid; tokp[2 * t] = (int)lbase[linfo[tid * 4 + 0]] + linfo[tid * 4 + 2]; tokp[2 * t + 1] = (int)lbase[linfo[tid * 4 + 1]] + linfo[tid * 4 + 3]; }
    }
}
__device__ __forceinline__ void build_texp(unsigned char* ws, LAS int* texp, int tid) {
    const unsigned* cnt = (const unsigned*)ws + CW_CNT;
    __syncthreads();
    if (tid == 0) { int tb = 0; for (int e = 0; e < NEXP; ++e) { texp[160 + e] = tb; const int n = (int)__hip_atomic_load(cnt + 64 * e, RLX_AGENT); const int nt = (n + 255) >> 8; for (int i = 0; i < nt; ++i) texp[tb + i] = e; tb += nt; } texp[168] = tb; texp[169] = tb; }
    __syncthreads();
}
__device__ __forceinline__ void phase_gather(unsigned char* ws, const bf16_t* xin, LAS int* texp, int lane, int wave) {
    const int* toke = (const int*)(ws + WS_TOKE); const int* tokp = (const int*)(ws + WS_TOKP); const float* tokr = (const float*)(ws + WS_TOKR);
    unsigned char* xg = ws + WS_XGY; float* xgrs = (float*)(ws + WS_XGRS);
    const int gw = blockIdx.x * NWAVES + wave, NGW = gridDim.x * NWAVES;
    for (int t = gw; t < T; t += NGW) {
        f32x4 v[4]; ld16_bf16(xin + (size_t)t * D + 16 * lane, v); float mx = 0.f;
#pragma unroll
        for (int j = 0; j < 4; ++j) { mx = fmaxf(mx, fmaxf(fmaxf(fabsf(v[j][0]), fabsf(v[j][1])), fmaxf(fabsf(v[j][2]), fabsf(v[j][3])))); }
#pragma unroll
        for (int o = 1; o < 64; o <<= 1) mx = fmaxf(mx, __shfl_xor(mx, o));
        const float inv = mx > 0.f ? 127.0f / mx : 0.f, rs = mx * (1.0f / 127.0f) * tokr[t];
        v4u w; w.x = pk_i8x4(v[0][0] * inv, v[0][1] * inv, v[0][2] * inv, v[0][3] * inv); w.y = pk_i8x4(v[1][0] * inv, v[1][1] * inv, v[1][2] * inv, v[1][3] * inv);
        w.z = pk_i8x4(v[2][0] * inv, v[2][1] * inv, v[2][2] * inv, v[2][3] * inv); w.w = pk_i8x4(v[3][0] * inv, v[3][1] * inv, v[3][2] * inv, v[3][3] * inv);
#pragma unroll
        for (int k = 0; k < 2; ++k) { const int e = toke[2 * t + k], p = tokp[2 * t + k]; const size_t row = (size_t)texp[160 + e] * 256 + p;
            *((v4u*)(xg + row * D) + lane) = w; if (lane == 0) xgrs[row] = rs; }
    }
}
__device__ __forceinline__ void phase_combine(unsigned char* ws, const bf16_t* xs, float* dst, LAS int* texp, int lane, int wave) {
    const int* toke = (const int*)(ws + WS_TOKE); const int* tokp = (const int*)(ws + WS_TOKP); const float* tokg = (const float*)(ws + WS_TOKG);
    const bf16_t* Y = (const bf16_t*)(ws + WS_Y);
    const int gw = blockIdx.x * NWAVES + wave, NGW = gridDim.x * NWAVES;
    for (int t = gw; t < T; t += NGW) {
        const size_t r0 = (size_t)texp[160 + toke[2 * t]] * 256 + tokp[2 * t], r1 = (size_t)texp[160 + toke[2 * t + 1]] * 256 + tokp[2 * t + 1]; const float g0 = tokg[2 * t], g1 = tokg[2 * t + 1];
        f32x4 xv[4]; ld16_bf16(xs + (size_t)t * D + 16 * lane, xv);
        const v4u* y0 = (const v4u*)(Y + r0 * D) + 2 * lane; const v4u* y1 = (const v4u*)(Y + r1 * D) + 2 * lane;
#pragma unroll
        for (int h = 0; h < 2; ++h) { const v4u p = y0[h], q = y1[h]; f32x4 xa = xv[2 * h], xc = xv[2 * h + 1];
            xa[0] += g0 * bf_lo(p.x) + g1 * bf_lo(q.x); xa[1] += g0 * bf_hi(p.x) + g1 * bf_hi(q.x); xa[2] += g0 * bf_lo(p.y) + g1 * bf_lo(q.y); xa[3] += g0 * bf_hi(p.y) + g1 * bf_hi(q.y);
            xc[0] += g0 * bf_lo(p.z) + g1 * bf_lo(q.z); xc[1] += g0 * bf_hi(p.z) + g1 * bf_hi(q.z); xc[2] += g0 * bf_lo(p.w) + g1 * bf_lo(q.w); xc[3] += g0 * bf_hi(p.w) + g1 * bf_hi(q.w);
            f32x4* xw = (f32x4*)(dst + (size_t)t * D) + 4 * lane; xw[2 * h] = xa; xw[2 * h + 1] = xc; }
    }
}

#define GEMM_PHASE(EPI, g, S, E) do { S.prep(); __syncthreads(); pg8::gemm_phase<EPI, pg8::Sched2, true, true>(lds, g, S, E); } while (0)
__global__ void __launch_bounds__(NTHR, 2) fwd_kernel(Args args) {
    extern __shared__ __attribute__((aligned(16))) unsigned char lds_raw[];
    LAS unsigned char* lds = (LAS unsigned char*)lds_raw;
    volatile LAS unsigned* MISC = (volatile LAS unsigned*)(lds + MISC_OFF);
    LAS float* rstab = (LAS float*)(lds + RS_OFF); LAS int* texp = (LAS int*)(lds + TEXP_OFF);
    unsigned char* const ws0 = args.ws; int G = gridDim.x, bx = blockIdx.x;
#define PHASE_BEGIN() size_t z_ = 0; asm volatile("" : "+s"(z_), "+s"(G), "+s"(bx)); unsigned char* ws = args.ws + z_; float* out = args.out + z_; int tid = threadIdx.x; asm volatile("" : "+v"(tid)); const int lane = tid & 63, wave = __builtin_amdgcn_readfirstlane(tid >> 6); (void)lane; (void)wave; (void)out
    if (threadIdx.x < 64) MISC[threadIdx.x] = 0u;
    __syncthreads();
    XcdBarrier bar; bar.bar = (unsigned*)ws0 + CW_BAR; bar.x = 0; bar.st = nullptr;
    const int lo = args.ph_lo, hi = args.ph_hi;
    if (MK_N_LAUNCHES == 1 && hi - lo > 1) bar = xcd_barrier_post((unsigned*)ws0 + CW_BAR, MISC + 8);
#define IN(k) (lo <= (k) && (k) < hi)
#define SEAM(k) do { if (IN(k) && IN((k) + 1)) { size_t zb_ = 0; asm volatile("" : "+s"(zb_)); bar.bar = (unsigned*)args.ws + CW_BAR + zb_; xcd_barrier(bar); } } while (0)

    if (IN(0)) { PHASE_BEGIN(); phase_prologue(args, lds, tid, lane, wave); }
    SEAM(0);
    if (IN(0) && IN(2)) {}
    if (IN(2)) { PHASE_BEGIN();
        pg8::Gemm g{(const bf16_t*)(ws + WS_MEMBF), (const bf16_t*)(ws + WS_WMEMKV), NBATCH * MEML, 2048, D};
        pg8::Sched2 S; S.init2(g.M, g.N, G, bx, rstab); S.rsrc = (const float*)(ws + WS_SSM); S.rmode = 1;
        pg8::EpiStore<true> E{(bf16_t*)(ws + WS_MEMKV), 2048, rstab};
        GEMM_PHASE(pg8::EpiStore<true>, g, S, E);
        __syncthreads();
    }
    SEAM(2);
    for (int l = 0; l < 2; ++l) {
        const int pb = l == 0 ? 3 : 11;
        if (IN(pb)) { for (int rep_ = 0; rep_ < REP_A; ++rep_) { PHASE_BEGIN();
#if I8_A
            pg8::Gemm g{(const bf16_t*)(ws + WS_QX), (const bf16_t*)(ws + WS_W1T + (size_t)l * 14 * MiB), T, NGEMM1, D / 2};
            pg8::Sched2 S; S.init2(T, NGEMM1, G, bx, rstab); S.rsrc = (const float*)(ws + WS_SA); S.rmode = 2; S.wgm = 4;
            pg8::EpiA<true> E{ws, l, rstab};
            GEMM_PHASE(pg8::EpiA<true>, g, S, E); __syncthreads(); }
#else
            pg8::Gemm g{(const bf16_t*)(ws + WS_XB), (const bf16_t*)(ws + WS_W1T + (size_t)l * 14 * MiB), T, NGEMM1, D};
            pg8::Sched2 S; S.init2(T, NGEMM1, G, bx, rstab); S.rsrc = (const float*)(ws + WS_SS); S.rmode = 1; S.wgm = 4;
            pg8::EpiA<false> E{ws, l, rstab};
            GEMM_PHASE(pg8::EpiA<false>, g, S, E); __syncthreads(); }
#endif
        }
        SEAM(pb);
        if (IN(pb + 1)) { PHASE_BEGIN(); phase_mixers(ws, lds, l, tid); }
        SEAM(pb + 1);
        if (IN(pb + 2)) { for (int rep_ = 0; rep_ < REP_C; ++rep_) { PHASE_BEGIN();
            { pg8::Gemm g{(const bf16_t*)(ws + WS_XB), (const bf16_t*)(ws + WS_WBRDA + (size_t)l * 2 * MiB), T, D, 1024}; pg8::Sched2 S; S.init2(T, D, G, bx, rstab);
              pg8::EpiBr0 E{ws}; GEMM_PHASE(pg8::EpiBr0, g, S, E); }
            __syncthreads(); { size_t z2_ = 0; asm volatile("" : "+s"(z2_), "+s"(G), "+s"(bx)); ws = args.ws + z2_; }
            { pg8::Gemm g{(const bf16_t*)(ws + WS_OPOOL), (const bf16_t*)(ws + WS_WBRPOOL + (size_t)l * 1 * MiB), T, D, 512}; pg8::Sched2 S; S.init2(T, D, G, bx, rstab);
              S.chain = 2; S.A2 = (const bf16_t*)(ws + WS_MQ); S.B2 = (const bf16_t*)(ws + WS_WBRMEM + (size_t)l * 1 * MiB);
              pg8::EpiBrC E{ws}; GEMM_PHASE(pg8::EpiBrC, g, S, E); } __syncthreads(); }
        }
        SEAM(pb + 2);
        if (IN(pb + 3)) { PHASE_BEGIN();
            pg8::Gemm g{(const bf16_t*)(ws + WS_Q), (const bf16_t*)(ws + WS_WOUT + (size_t)l * 2 * MiB), T, D, D}; pg8::Sched2 S; S.init2(T, D, G, bx, rstab);
            pg8::EpiResB E{l == 0 ? (const float*)(args.in[0] + z_) : (const float*)nullptr, (bf16_t*)(ws + WS_XS)};
            GEMM_PHASE(pg8::EpiResB, g, S, E); __syncthreads();
        }
        SEAM(pb + 3);
        if (l == 0) {
            if (IN(7) && I8_E) { PHASE_BEGIN(); phase_quant_rows((const bf16_t*)(ws + WS_XS), ws, lane, wave); }
            SEAM(7);
            if (IN(8)) { for (int rep_ = 0; rep_ < REP_E; ++rep_) { PHASE_BEGIN();
#if I8_E
                pg8::Gemm g{(const bf16_t*)(ws + WS_QX), (const bf16_t*)(ws + WS_WFF13), T, 2 * FFD, D / 2}; pg8::Sched2 S; S.init2(T, 2 * FFD, G, bx, rstab); S.rsrc = (const float*)(ws + WS_SA); S.rmode = 2; S.wgm = 4;
                pg8::EpiSwiglu<true> E{(bf16_t*)(ws + WS_HFF), FFD, rstab, (const float*)(ws + WS_SW) + SW_FF, FFD, nullptr, 0};
                GEMM_PHASE(pg8::EpiSwiglu<true>, g, S, E); __syncthreads(); }
#else
                pg8::Gemm g{(const bf16_t*)(ws + WS_X1B), (const bf16_t*)(ws + WS_WFF13), T, 2 * FFD, D}; pg8::Sched2 S; S.init2(T, 2 * FFD, G, bx, rstab); S.rsrc = (const float*)(ws + WS_SS); S.rmode = 1; S.wgm = 4;
                pg8::EpiSwiglu<false> E{(bf16_t*)(ws + WS_HFF), FFD, rstab, nullptr, 0, nullptr, 0};
                GEMM_PHASE(pg8::EpiSwiglu<false>, g, S, E); __syncthreads(); }
#endif
            }
            SEAM(8);
            if (IN(9)) { PHASE_BEGIN();
                pg8::Gemm g{(const bf16_t*)(ws + WS_HFF), (const bf16_t*)(ws + WS_WFF2), T, D, FFD}; pg8::Sched2 S; S.init2(T, D, G, bx, rstab);
                pg8::EpiResB E{nullptr, (bf16_t*)(ws + WS_XS)};
                GEMM_PHASE(pg8::EpiResB, g, S, E); __syncthreads();
            }
            SEAM(9);
            if (IN(10) && I8_A) { PHASE_BEGIN(); phase_quant_rows((const bf16_t*)(ws + WS_XS), ws, lane, wave); }
            SEAM(10);
        }
    }
    if (IN(15)) { PHASE_BEGIN(); phase_route(ws, (const bf16_t*)(ws + WS_XS), lds, tid, lane, wave); }
    SEAM(15);
    if (IN(16)) { PHASE_BEGIN(); build_texp(ws, texp, tid); phase_gather(ws, (const bf16_t*)(ws + WS_XS), texp, lane, wave); }
    SEAM(16);
    for (int k = 0; k < 4; ++k) {
        if (IN(17 + k)) { PHASE_BEGIN();
            build_texp(ws, texp, tid);
            const int ntot = texp[169];
            const int kd = k - 1, ku = k;
            int ntd = 0, ntu = 0;
            if (kd >= 0) { ntd = ntot - MOE_CH * kd; const int cap = (kd == 2) ? MOE_CHL : MOE_CH; ntd = ntd < 0 ? 0 : (ntd > cap ? cap : ntd); }
            if (ku <= 2) { ntu = ntot - MOE_CH * ku; const int cap = (ku == 2) ? MOE_CHL : MOE_CH; ntu = ntu < 0 ? 0 : (ntu > cap ? cap : ntu); }
            const int nX = ntd * 4, nU = ntu * 28;
            const bool mixed = (nX > 0 && nU > 0);
            const int tf = (nU + 7 * nX) / 256, rem = (nU + 7 * nX) - 256 * tf;
            const bool weighted = mixed && tf >= 7 && nX <= 256 && G == 256;
            if (nX > 0) {
                const int t0 = MOE_CH * kd;
                pg8::Gemm g{(const bf16_t*)(ws + WS_HCH + (size_t)(kd & 1) * HCH_BYTES), (const bf16_t*)(ws + WS_WMOE2), ntd * 256, D, FFE};
                pg8::Sched2 S; S.init2(ntd * 256, D, G, bx, rstab); S.texp = texp; S.estride = (size_t)7 * MiB; S.t0 = t0;
                if (weighted) { const int vc = (bx & 7) * 32 + (bx >> 3); S.rng = 1; S.rng_start = vc; S.rng_cnt = (vc < nX) ? 1 : 0; }
                pg8::EpiStore<false> E{(bf16_t*)(ws + WS_Y) + (size_t)t0 * 256 * D, D, rstab};
                for (int rep_ = 0; rep_ < REP_DN; ++rep_) { GEMM_PHASE(pg8::EpiStore<false>, g, S, E); __syncthreads(); }
            }
            if (nU > 0) {
                size_t z3_ = 0; asm volatile("" : "+s"(z3_), "+s"(G), "+s"(bx)); ws = args.ws + z3_;
                const int t0 = MOE_CH * ku;
                pg8::Gemm g{(const bf16_t*)(ws + WS_XGY + (size_t)t0 * 256 * D), (const bf16_t*)(ws + WS_WMOE13), ntu * 256, 2 * FFE, D / 2};
                pg8::Sched2 S; S.init2(ntu * 256, 2 * FFE, G, bx, rstab); S.rsrc = (const float*)(ws + WS_XGRS); S.rmode = 2; S.rrow0 = t0 * 256; S.texp = texp; S.estride = (size_t)7 * MiB; S.t0 = t0;
                if (weighted) { const int vc = (bx & 7) * 32 + (bx >> 3); const int cmin = vc < nX ? vc : nX, over = vc - (256 - rem); S.rng = 1; S.rng_start = vc * tf - 7 * cmin + (over > 0 ? over : 0); S.rng_cnt = tf - (vc < nX ? 7 : 0) + (vc >= 256 - rem ? 1 : 0); }
                pg8::EpiSwiglu<true> E{(bf16_t*)(ws + WS_HCH + (size_t)(ku & 1) * HCH_BYTES), FFE, rstab, (const float*)(ws + WS_SW) + SW_MOE, FFE, texp, t0};
                for (int rep_ = 0; rep_ < REP_UP; ++rep_) { GEMM_PHASE(pg8::EpiSwiglu<true>, g, S, E); __syncthreads(); }
            }
        }
        SEAM(17 + k);
    }
    if (IN(21)) { PHASE_BEGIN(); build_texp(ws, texp, tid); phase_combine(ws, (const bf16_t*)(ws + WS_XS), out, texp, lane, wave); }
#undef IN
#undef SEAM
}

extern "C" void kernel_launch(void* const* d_in, const int* in_sizes, int n_in, void* d_out, int out_size, void* d_ws, size_t ws_size, hipStream_t stream) {
    static int grid = 0;
    if (grid == 0) {
        if (n_in != 31 || out_size != T * D || ws_size < WS_END) { fprintf(stderr, "kernel_launch: unexpected problem (n_in %d, out %d, ws %zu < %zu)\n", n_in, out_size, ws_size, (size_t)WS_END); grid = -1; return; }
        int dev = 0, cus = 0, per_cu = 0;
        if (hipGetDevice(&dev) != hipSuccess || hipDeviceGetAttribute(&cus, hipDeviceAttributeMultiprocessorCount, dev) != hipSuccess) { grid = -1; return; }
        if (hipFuncSetAttribute((const void*)fwd_kernel, hipFuncAttributeMaxDynamicSharedMemorySize, LDS_BYTES) != hipSuccess) { fprintf(stderr, "kernel_launch: hipFuncSetAttribute failed\n"); grid = -1; return; }
        if (hipOccupancyMaxActiveBlocksPerMultiprocessor(&per_cu, (const void*)fwd_kernel, NTHR, LDS_BYTES) != hipSuccess || per_cu < 1) { fprintf(stderr, "kernel_launch: occupancy query says %d\n", per_cu); grid = -1; (void)hipGetLastError(); return; }
        grid = cus;
    }
    if (grid < 0) return;
    if (hipMemsetAsync(d_ws, 0, CTL_ZERO_BYTES, stream) != hipSuccess) return;
    Args a{};
    for (int i = 0; i < 31; ++i) a.in[i] = (const float*)d_in[i];
    a.out = (float*)d_out; a.ws = (unsigned char*)d_ws;
#ifdef PROBE_EXTRA_PROLOGUE
    a.ph_lo = 0; a.ph_hi = 1; hipLaunchKernelGGL(fwd_kernel, dim3(grid), dim3(NTHR), LDS_BYTES, stream, a);
#endif
#ifdef PROBE_EXTRA_PHASE
#ifndef PROBE_EXTRA_REPS
#define PROBE_EXTRA_REPS 1
#endif
    for (int r_ = 0; r_ < PROBE_EXTRA_REPS; ++r_) { a.ph_lo = PROBE_EXTRA_PHASE; a.ph_hi = PROBE_EXTRA_PHASE + 1; hipLaunchKernelGGL(fwd_kernel, dim3(grid), dim3(NTHR), LDS_BYTES, stream, a); }
#endif
    if (MK_N_LAUNCHES == 1) { a.ph_lo = 0; a.ph_hi = NPH; hipLaunchKernelGGL(fwd_kernel, dim3(grid), dim3(NTHR), LDS_BYTES, stream, a); }
    else for (int p = 0; p < NPH; ++p) { a.ph_lo = p; a.ph_hi = p + 1; hipLaunchKernelGGL(fwd_kernel, dim3(grid), dim3(NTHR), LDS_BYTES, stream, a); }
}
```

```cpp
#include <hip/hip_runtime.h>
#include <cstdio>
#include <cstdint>
#define MK_N_LAUNCHES 1
#ifndef USE_I8
#define USE_I8 1
#endif
#ifndef I8_A
#define I8_A 1
#endif
#ifndef I8_E
#define I8_E 1
#endif
#ifndef REP_MEM
#define REP_MEM 1
#endif
#ifndef REP_D
#define REP_D 1
#endif
#ifndef REP_F
#define REP_F 1
#endif
#ifndef REP_Z
#define REP_Z 1
#endif
#ifndef REP_E
#define REP_E 1
#endif
#ifndef REP_DN
#define REP_DN 1
#endif
#ifndef REP_MG
#define REP_MG 1
#endif
#ifndef REP_POOL
#define REP_POOL 1
#endif
#ifndef REP_GA
#define REP_GA 1
#endif
#ifndef REP_PRO
#define REP_PRO 1
#endif
#ifndef REP_A
#define REP_A 1
#endif
#ifndef REP_DA
#define REP_DA 1
#endif
#ifndef REP_C
#define REP_C 1
#endif
#ifndef REP_UP
#define REP_UP 1
#endif

constexpr int NWAVES = 8, NTHR = 512;
constexpr int T = 16384, D = 1024, SEQ = 2048, NBATCH = 8, MEML = 256;
constexpr int NGEMM1 = 7168, FFD = 2816, FFE = 3584, NEXP = 8;
constexpr float LOG2E = 1.4426950408889634f;
constexpr float QSCALE = 0.125f * LOG2E;
constexpr float MEMSCALE = 0.08838834764831845f * LOG2E;
#ifndef MK_N_LAUNCHES
#define MK_N_LAUNCHES 1
#endif
constexpr int NPH = 22;
constexpr int MOE_CH = 45, MOE_CHL = 46;

constexpr size_t MiB = 1u << 20;
constexpr size_t CTL_ZERO_BYTES = 1 * MiB;
constexpr size_t WS_SS = 1 * MiB;
constexpr size_t WS_MQSS = 2 * MiB;
constexpr size_t WS_SSM = 2 * MiB + 512 * 1024;
constexpr size_t WS_TOKE = WS_SSM + 128 * 1024;
constexpr size_t WS_TOKP = WS_TOKE + 128 * 1024;
constexpr size_t WS_TOKG = WS_TOKP + 128 * 1024;
constexpr size_t WS_TOKR = WS_TOKG + 128 * 1024;
constexpr size_t WS_SC = WS_TOKR + 64 * 1024;
constexpr size_t WS_XGRS = WS_SC + 4096;
constexpr size_t WS_PARAM = 3 * MiB + 256 * 1024;
constexpr int PB_BGATE = 0, PB_GQ = 6144, PB_GK = 6400, PB_GOUT = 6656, PB_POOLS = 6912, PB_MQN = 7936, PB_MKN = 8192, PB_GFFN1 = 8448, PB_WR = 9472, PB_POOLW = 17664, PB_END = 17664 + 131072;
constexpr size_t WS_W1T = 4 * MiB;
constexpr size_t WS_WMEMKV = 32 * MiB;
constexpr size_t WS_WBRDA = 36 * MiB;
constexpr size_t WS_WBRPOOL = 40 * MiB;
constexpr size_t WS_WBRMEM = 42 * MiB;
constexpr size_t WS_WOUT = 44 * MiB;
constexpr size_t WS_WFF13 = 48 * MiB;
constexpr size_t WS_WFF2 = 59 * MiB;
constexpr size_t WS_SW = WS_WFF13 + 6 * MiB;
constexpr int SW_G1 = 0, SW_FF = 2 * 7168, SW_MOE = SW_FF + 2 * 2816, SW_END = SW_MOE + 8 * 2 * 3584;
constexpr size_t SW_BYTES = (size_t)SW_END * 4;
constexpr size_t WS_WMOE13 = 65 * MiB;
constexpr size_t WS_XS = WS_WMOE13 + 56 * MiB;
constexpr size_t WS_WMOE2 = 177 * MiB;
constexpr size_t WS_XB = 233 * MiB;
constexpr size_t WS_QX = WS_XB, WS_SA = 1 * MiB;
constexpr size_t WS_MEMKV = 265 * MiB;
constexpr size_t WS_R = 273 * MiB;
constexpr size_t WS_Q = WS_R, WS_K = WS_R + 32 * MiB, WS_V = WS_R + 64 * MiB, WS_P = WS_R + 96 * MiB, WS_MQ = WS_R + 112 * MiB, WS_OPOOL = WS_R + 128 * MiB, WS_G = WS_R + 144 * MiB, WS_MEMBF = WS_R + 240 * MiB, WS_POOLWT = WS_R + 244 * MiB;
constexpr size_t WS_MF = WS_K, WS_X1B = WS_K, WS_HFF = WS_R + 144 * MiB;
constexpr size_t WS_XGY = WS_MEMKV;
constexpr size_t WS_Y = WS_XGY + 34 * MiB;
constexpr size_t WS_HCH = WS_Y + 68 * MiB, HCH_BYTES = (size_t)MOE_CHL * 256 * 7168;
constexpr size_t WS_END = 529 * MiB;
static_assert(WS_XGRS + 34816 * 4 <= WS_PARAM && WS_PARAM + (size_t)PB_END * 4 <= WS_W1T && WS_HCH + 2 * HCH_BYTES <= WS_END && WS_SW + SW_BYTES <= WS_WFF2, "d_ws map");
constexpr int CW_CNT = 64;
constexpr int CW_BAR = 4096;

constexpr int RING_BYTES = 131072;
constexpr int RS_OFF = 131072, RS_UNITS = 16;
constexpr int TEXP_OFF = RS_OFF + RS_UNITS * 1024;
constexpr int LDS_BYTES = 155648;
constexpr int MISC_OFF = LDS_BYTES - 256;

namespace pg8 {
#define PG8_LAS __attribute__((address_space(3)))
typedef unsigned short bf16_t;
typedef short bf16x8 __attribute__((ext_vector_type(8)));
typedef float f32x4 __attribute__((ext_vector_type(4)));
typedef unsigned u32x4 __attribute__((ext_vector_type(4)));
constexpr int BM = 256, BK = 64, HALF = 128, HTB = HALF * BK * 2  , STAGE_BYTES = 8 * HTB, NXCD = 8, WGM = 8;

__host__ __device__ __forceinline__ int lds_byte(int r, int c) { const int st = (r >> 4) * 2 + (c >> 5), rr = r & 15, cc = c & 31, ob = rr * 64 + cc * 2; return st * 1024 + (ob ^ (((ob >> 9) & 1) << 5)); }
__host__ __device__ __forceinline__ void stage_rc(int b, int& R, int& C) { const int st = b / 1024, sb = b % 1024, swz = sb ^ (((sb >> 9) & 1) << 5); R = (st >> 1) * 16 + swz / 64; C = (st & 1) * 32 + (swz % 64) / 2; }
__host__ __device__ __forceinline__ int perm32(int rho) { const int n = rho >> 4, i = rho & 15; return 8 * (i >> 2) + 4 * n + (i & 3); }

struct Unit { int pm, pn, idx; };
struct Gemm { const bf16_t* A; const bf16_t* Bt; int M, N, K; };

struct StaticOrder {
    int nM, nN, nwg, G, c, wgm;
    __host__ __device__ void init(int M, int N, int G_, int c_) { nM = M / BM; nN = N / BM; nwg = nM * nN; G = G_; c = c_; wgm = WGM; }
    __host__ __device__ bool next(int i, Unit& u) const {
        const long L = (long)i * G + c; if (L >= nwg) return false;
        int wgid = (int)L; { const int q = nwg / NXCD, r = nwg % NXCD, xcd = wgid % NXCD, off = wgid / NXCD; wgid = (xcd < r ? xcd * (q + 1) : r * (q + 1) + (xcd - r) * q) + off; }
        const int nig = wgm * nN, gid = wgid / nig, fm = gid * wgm, gsz = (nM - fm) < wgm ? (nM - fm) : wgm;
        u.pm = fm + ((wgid % nig) % gsz); u.pn = (wgid % nig) / gsz; u.idx = i; return true;
    }
    __device__ __forceinline__ const char* bptr(const Gemm& g, const Unit& u, size_t tstep) const { return (const char*)g.Bt + (size_t)u.pn * tstep; }
    __device__ __forceinline__ const char* aptr(const Gemm& g, const Unit& u, size_t tstep) const { return (const char*)g.A + (size_t)u.pm * tstep; }
    __device__ __forceinline__ void a_ready(const Unit&) const {}
    __device__ __forceinline__ void done(const Unit&) const {}
};


typedef float f32x2 __attribute__((ext_vector_type(2)));
typedef __bf16 bf16x2_t __attribute__((ext_vector_type(2)));
__device__ __forceinline__ unsigned pk_bf16(float lo, float hi) { f32x2 v = {lo, hi}; bf16x2_t b = __builtin_convertvector(v, bf16x2_t); return __builtin_bit_cast(unsigned, b); }
__device__ __forceinline__ u32x4 pk8(const f32x4 a, const f32x4 b) { u32x4 w; w.x = pk_bf16(a[0], a[1]); w.y = pk_bf16(a[2], a[3]); w.z = pk_bf16(b[0], b[1]); w.w = pk_bf16(b[2], b[3]); return w; }
__device__ __forceinline__ float bf_lo(unsigned w) { return __builtin_bit_cast(float, w << 16); }
__device__ __forceinline__ float bf_hi(unsigned w) { return __builtin_bit_cast(float, w & 0xffff0000u); }
__device__ __forceinline__ float sigmoid_f(float x) { return __builtin_amdgcn_rcpf(1.0f + __builtin_amdgcn_exp2f(-1.4426950408889634f * x)); }
constexpr float RMS_EPS = 1e-6f;
typedef int i32x4 __attribute__((ext_vector_type(4)));
template <bool I8> __device__ __forceinline__ f32x4 mma16(const bf16x8 a, const bf16x8 b, const f32x4 c) {
    if constexpr (I8) return __builtin_bit_cast(f32x4, __builtin_amdgcn_mfma_i32_16x16x64_i8(__builtin_bit_cast(i32x4, a), __builtin_bit_cast(i32x4, b), __builtin_bit_cast(i32x4, c), 0, 0, 0));
    else return __builtin_amdgcn_mfma_f32_16x16x32_bf16(a, b, c, 0, 0, 0);
}
template <bool I8> __device__ __forceinline__ f32x4 accf(const f32x4 a) {
    if constexpr (I8) { const i32x4 v = __builtin_bit_cast(i32x4, a); return (f32x4){(float)v[0], (float)v[1], (float)v[2], (float)v[3]}; } else return a;
}


struct Sched2 : StaticOrder {
    const float* rsrc; int rmode;
    int rrow0;
    PG8_LAS float* rtab;
    const PG8_LAS int* texp; size_t estride; int t0;
    int rng, rng_start, rng_cnt;
    const bf16_t* A2; const bf16_t* B2; int chain;
    __device__ __forceinline__ void init2(int M, int N, int G_, int c_, PG8_LAS float* tab) { init(M, N, G_, c_); rsrc = nullptr; rmode = 0; rrow0 = 0; rtab = tab; texp = nullptr; estride = 0; t0 = 0; A2 = nullptr; B2 = nullptr; chain = 0; rng = 0; rng_start = 0; rng_cnt = 0; }
    __device__ __forceinline__ bool next(int i, Unit& u) const {
        if (rng != 0) { if (i >= rng_cnt) return false; const int q = rng_start + i; u.pm = q / nN; u.pn = q - u.pm * nN; u.idx = i; return true; }
        if (chain == 0) return StaticOrder::next(i, u); if (i >= chain || !StaticOrder::next(0, u)) return false; u.idx = i; return true; }
    __device__ __forceinline__ const char* aptr(const Gemm& g, const Unit& u, size_t tstep) const { return (const char*)((chain != 0 && u.idx == 1) ? A2 : g.A) + (size_t)u.pm * tstep; }
    __device__ __forceinline__ const char* bptr(const Gemm& g, const Unit& u, size_t tstep) const {
        const char* b = (const char*)((chain != 0 && u.idx == 1) ? B2 : g.Bt) + (size_t)u.pn * tstep;
        if (texp) b += (size_t)texp[t0 + u.pm] * estride;
        return b;
    }
    __device__ __forceinline__ void a_ready(const Unit&) const {}
    __device__ __forceinline__ void prep() const {
        if (rmode == 0) return;
        int tid = threadIdx.x; asm volatile("" : "+v"(tid));
        if (tid < 256) {
            Unit u;
#pragma unroll 1
            for (int i = 0; i < 16 && next(i, u); ++i) {
                const size_t row = (size_t)rrow0 + (size_t)u.pm * 256 + tid; float sc;
                if (rmode == 1) { const f32x4* p = (const f32x4*)(rsrc + row * 16); const f32x4 a = p[0], b = p[1], c = p[2], d = p[3];
                    const float s = ((a[0] + a[1]) + (a[2] + a[3])) + ((b[0] + b[1]) + (b[2] + b[3])) + ((c[0] + c[1]) + (c[2] + c[3])) + ((d[0] + d[1]) + (d[2] + d[3]));
                    sc = __builtin_amdgcn_rsqf(s * (1.0f / 1024.0f) + RMS_EPS); }
                else sc = rsrc[row];
                rtab[i * 256 + tid] = sc;
            }
        }
    }
    __device__ __forceinline__ void done(const Unit&) const {}
};

template <bool RS> struct EpiStore {
    static constexpr bool PERM = false, AFTER_DRAIN = false, I8 = false;
    bf16_t* O; int ldc; const PG8_LAS float* rs;
    __device__ __forceinline__ void operator()(const f32x4 (&acc)[2][2][4][2], const Unit& u, int wr, int wc, int fr, int fq) const {
        const int rl = wr * 64 + fr; const size_t row0 = (size_t)u.pm * BM + rl; const int col0 = u.pn * BM + 64 * wc + 8 * fq;
#pragma unroll
        for (int ai = 0; ai < 2; ++ai)
#pragma unroll
            for (int m = 0; m < 4; ++m) { const float sc = RS ? rs[u.idx * 256 + rl + ai * HALF + m * 16] : 1.f; bf16_t* rowp = O + (row0 + ai * HALF + m * 16) * ldc + col0;
#pragma unroll
                for (int bj = 0; bj < 2; ++bj) *(u32x4*)(rowp + 32 * bj) = pk8(acc[ai][bj][m][0] * sc, acc[ai][bj][m][1] * sc); }
    }
};

template <bool I8_> struct EpiA {
    static constexpr bool PERM = false, AFTER_DRAIN = false, I8 = I8_;
    unsigned char* ws; int l; const PG8_LAS float* rs;
    __device__ __forceinline__ void operator()(const f32x4 (&acc)[2][2][4][2], const Unit& u, int wr, int wc, int fr, int fq) const {
        const int pn = u.pn, rl = wr * 64 + fr; const size_t row0 = (size_t)u.pm * BM + rl; const PG8_LAS float* rsp = rs + u.idx * 256 + rl;
        const float* prm = (const float*)(ws + WS_PARAM);
        f32x4 cw[2][2];
#pragma unroll
        for (int bj = 0; bj < 2; ++bj)
#pragma unroll
            for (int n = 0; n < 2; ++n) { if constexpr (I8_) cw[bj][n] = *(const f32x4*)((const float*)(ws + WS_SW) + SW_G1 + l * 7168 + pn * 256 + 64 * wc + 32 * bj + 8 * fq + 4 * n) * (1.0f / 127.0f); else cw[bj][n] = (f32x4){1.f, 1.f, 1.f, 1.f}; }
#define EA_V(ai, bj, m, n) (accf<I8_>(acc[ai][bj][m][n]) * cw[bj][n])
        if (pn < 8) {
            const bool isq = pn < 4; const float* gg = prm + (isq ? PB_GQ : PB_GK) + l * 128 + (wc & 1) * 64 + 8 * fq; const float mul = isq ? QSCALE : 1.f;
            f32x4 gv[2][2];
#pragma unroll
            for (int bj = 0; bj < 2; ++bj)
#pragma unroll
                for (int n = 0; n < 2; ++n) gv[bj][n] = *(const f32x4*)(gg + 32 * bj + 4 * n);
            bf16_t* base = (bf16_t*)(ws + (isq ? WS_Q : WS_K)) + (pn & 3) * 256 + 64 * wc + 8 * fq;
#pragma unroll
            for (int ai = 0; ai < 2; ++ai)
#pragma unroll
                for (int m = 0; m < 4; ++m) { const float sc = rsp[ai * HALF + m * 16];
                    f32x4 v[2][2]; float ss = 0.f;
#pragma unroll
                    for (int bj = 0; bj < 2; ++bj)
#pragma unroll
                        for (int n = 0; n < 2; ++n) { v[bj][n] = EA_V(ai, bj, m, n) * sc; const f32x4 x = v[bj][n]; ss += (x[0] * x[0] + x[1] * x[1]) + (x[2] * x[2] + x[3] * x[3]); }
                    ss += __shfl_xor(ss, 16); ss += __shfl_xor(ss, 32);
                    const float r = __builtin_amdgcn_rsqf(ss * (1.0f / 64.0f) + RMS_EPS) * mul;
                    bf16_t* rowp = base + (row0 + ai * HALF + m * 16) * 1024;
#pragma unroll
                    for (int bj = 0; bj < 2; ++bj) *(u32x4*)(rowp + 32 * bj) = pk8(v[bj][0] * gv[bj][0] * r, v[bj][1] * gv[bj][1] * r); }
        } else if (pn < 14) {
            bf16_t* base; int ldc;
            if (pn < 12) { base = (bf16_t*)(ws + WS_V) + (pn - 8) * 256; ldc = 1024; } else { base = (bf16_t*)(ws + WS_P) + (pn - 12) * 256; ldc = 512; }
            base += 64 * wc + 8 * fq;
#pragma unroll
            for (int ai = 0; ai < 2; ++ai)
#pragma unroll
                for (int m = 0; m < 4; ++m) { const float sc = rsp[ai * HALF + m * 16]; bf16_t* rowp = base + (row0 + ai * HALF + m * 16) * ldc;
#pragma unroll
                    for (int bj = 0; bj < 2; ++bj) *(u32x4*)(rowp + 32 * bj) = pk8(EA_V(ai, bj, m, 0) * sc, EA_V(ai, bj, m, 1) * sc); }
        } else if (pn < 16) {
            bf16_t* base = (bf16_t*)(ws + WS_MQ) + (pn - 14) * 256 + 64 * wc + 8 * fq; float* mqss = (float*)(ws + WS_MQSS);
#pragma unroll
            for (int ai = 0; ai < 2; ++ai)
#pragma unroll
                for (int m = 0; m < 4; ++m) { const float sc = rsp[ai * HALF + m * 16]; const size_t row = row0 + ai * HALF + m * 16; bf16_t* rowp = base + row * 512; float ss = 0.f;
#pragma unroll
                    for (int bj = 0; bj < 2; ++bj) { const f32x4 a = EA_V(ai, bj, m, 0) * sc, b = EA_V(ai, bj, m, 1) * sc;
                        ss += ((a[0] * a[0] + a[1] * a[1]) + (a[2] * a[2] + a[3] * a[3])) + ((b[0] * b[0] + b[1] * b[1]) + (b[2] * b[2] + b[3] * b[3]));
                        *(u32x4*)(rowp + 32 * bj) = pk8(a, b); }
                    ss += __shfl_xor(ss, 16); ss += __shfl_xor(ss, 32);
                    if (fq == 0) mqss[row * 8 + (pn - 14) * 4 + wc] = ss; }
        } else {
            const int gcol = (pn - 16) * 256 + 64 * wc + 8 * fq; unsigned char* base = (unsigned char*)(ws + WS_G) + gcol; const float* bgate = prm + PB_BGATE + l * 3072 + gcol;
            f32x4 bv[2][2];
#pragma unroll
            for (int bj = 0; bj < 2; ++bj)
#pragma unroll
                for (int n = 0; n < 2; ++n) bv[bj][n] = *(const f32x4*)(bgate + 32 * bj + 4 * n);
#pragma unroll
            for (int ai = 0; ai < 2; ++ai)
#pragma unroll
                for (int m = 0; m < 4; ++m) { const float sc = rsp[ai * HALF + m * 16]; unsigned char* rowp = base + (row0 + ai * HALF + m * 16) * 3072;
#pragma unroll
                    for (int bj = 0; bj < 2; ++bj) { f32x4 a = EA_V(ai, bj, m, 0) * sc + bv[bj][0], b = EA_V(ai, bj, m, 1) * sc + bv[bj][1];
#pragma unroll
                        for (int j = 0; j < 4; ++j) { a[j] = sigmoid_f(a[j]) * 255.0f + 0.5f; b[j] = sigmoid_f(b[j]) * 255.0f + 0.5f; }
                        const unsigned w0 = (unsigned)a[0] | ((unsigned)a[1] << 8) | ((unsigned)a[2] << 16) | ((unsigned)a[3] << 24), w1 = (unsigned)b[0] | ((unsigned)b[1] << 8) | ((unsigned)b[2] << 16) | ((unsigned)b[3] << 24);
                        *(unsigned long long*)(rowp + 32 * bj) = (unsigned long long)w0 | ((unsigned long long)w1 << 32); } }
        }
    }
};
#undef EA_V

struct EpiBr0 {
    static constexpr bool PERM = false, AFTER_DRAIN = false, I8 = false;
    unsigned char* ws;
    __device__ __forceinline__ void operator()(const f32x4 (&acc)[2][2][4][2], const Unit& u, int wr, int wc, int fr, int fq) const {
        const size_t row0 = (size_t)u.pm * BM + wr * 64 + fr; const int col0 = u.pn * BM + 64 * wc + 8 * fq;
        const unsigned char* G = (const unsigned char*)(ws + WS_G); bf16_t* MFb = (bf16_t*)(ws + WS_MF);
#pragma unroll
        for (int ai = 0; ai < 2; ++ai) { unsigned long long gw[4][2];
#pragma unroll
            for (int m = 0; m < 4; ++m)
#pragma unroll
                for (int bj = 0; bj < 2; ++bj) gw[m][bj] = *(const unsigned long long*)(G + (row0 + ai * HALF + m * 16) * 3072 + col0 + 32 * bj);
#pragma unroll
            for (int m = 0; m < 4; ++m) { const size_t row = row0 + ai * HALF + m * 16;
#pragma unroll
                for (int bj = 0; bj < 2; ++bj) { const int col = col0 + 32 * bj;
                    const unsigned glo = (unsigned)gw[m][bj], ghi = (unsigned)(gw[m][bj] >> 32);
                    const f32x4 g0 = (f32x4){(float)(glo & 255u), (float)((glo >> 8) & 255u), (float)((glo >> 16) & 255u), (float)(glo >> 24)} * (1.0f / 255.0f), g1 = (f32x4){(float)(ghi & 255u), (float)((ghi >> 8) & 255u), (float)((ghi >> 16) & 255u), (float)(ghi >> 24)} * (1.0f / 255.0f);
                    *(u32x4*)(MFb + row * 1024 + col) = pk8(acc[ai][bj][m][0] * g0, acc[ai][bj][m][1] * g1); } } }
    }
};
struct EpiBrC {
    static constexpr bool PERM = false, AFTER_DRAIN = false, I8 = false;
    unsigned char* ws;
    __device__ __forceinline__ void operator()(const f32x4 (&acc)[2][2][4][2], const Unit& u, int wr, int wc, int fr, int fq) const {
        const size_t row0 = (size_t)u.pm * BM + wr * 64 + fr; const int col0 = u.pn * BM + 64 * wc + 8 * fq;
        const unsigned char* G = (const unsigned char*)(ws + WS_G) + (1 + u.idx) * 1024; const bf16_t* MFb = (const bf16_t*)(ws + WS_MF); bf16_t* O = (bf16_t*)(ws + (u.idx == 0 ? WS_MF : WS_Q));
#pragma unroll
        for (int ai = 0; ai < 2; ++ai) { unsigned long long gw[4][2]; u32x4 mw[4][2];
#pragma unroll
            for (int m = 0; m < 4; ++m)
#pragma unroll
                for (int bj = 0; bj < 2; ++bj) { const size_t row = row0 + ai * HALF + m * 16; const int col = col0 + 32 * bj;
                    gw[m][bj] = *(const unsigned long long*)(G + row * 3072 + col); mw[m][bj] = *(const u32x4*)(MFb + row * 1024 + col); }
#pragma unroll
            for (int m = 0; m < 4; ++m) { const size_t row = row0 + ai * HALF + m * 16;
#pragma unroll
                for (int bj = 0; bj < 2; ++bj) { const int col = col0 + 32 * bj;
                    const unsigned glo = (unsigned)gw[m][bj], ghi = (unsigned)(gw[m][bj] >> 32); const u32x4 w = mw[m][bj];
                    const f32x4 g0 = (f32x4){(float)(glo & 255u), (float)((glo >> 8) & 255u), (float)((glo >> 16) & 255u), (float)(glo >> 24)} * (1.0f / 255.0f), g1 = (f32x4){(float)(ghi & 255u), (float)((ghi >> 8) & 255u), (float)((ghi >> 16) & 255u), (float)(ghi >> 24)} * (1.0f / 255.0f);
                    const f32x4 m0 = {bf_lo(w.x), bf_hi(w.x), bf_lo(w.y), bf_hi(w.y)}, m1 = {bf_lo(w.z), bf_hi(w.z), bf_lo(w.w), bf_hi(w.w)};
                    *(u32x4*)(O + row * 1024 + col) = pk8(acc[ai][bj][m][0] * g0 + m0, acc[ai][bj][m][1] * g1 + m1); } } }
    }
};

struct EpiRes {
    static constexpr bool PERM = false, AFTER_DRAIN = false, I8 = false;
    const float* xin; float* x; unsigned char* ws; size_t xb_off; size_t dry_off;
    __device__ __forceinline__ void operator()(const f32x4 (&acc)[2][2][4][2], const Unit& u, int wr, int wc, int fr, int fq) const {
        const size_t row0 = (size_t)u.pm * BM + wr * 64 + fr; const int col0 = u.pn * BM + 64 * wc + 8 * fq;
        float* xout = dry_off ? (float*)(ws + dry_off) : x; bf16_t* xb = (bf16_t*)(ws + xb_off); float* ss = (float*)(ws + WS_SS);
#pragma unroll
        for (int ai = 0; ai < 2; ++ai)
#pragma unroll
            for (int m = 0; m < 4; ++m) { const size_t row = row0 + ai * HALF + m * 16; float s2 = 0.f;
#pragma unroll
                for (int bj = 0; bj < 2; ++bj) { const size_t off = row * 1024 + col0 + 32 * bj;
                    const f32x4 a = *(const f32x4*)(xin + off) + acc[ai][bj][m][0], b = *(const f32x4*)(xin + off + 4) + acc[ai][bj][m][1];
                    *(f32x4*)(xout + off) = a; *(f32x4*)(xout + off + 4) = b;
                    if (xb_off) { *(u32x4*)(xb + off) = pk8(a, b); s2 += ((a[0] * a[0] + a[1] * a[1]) + (a[2] * a[2] + a[3] * a[3])) + ((b[0] * b[0] + b[1] * b[1]) + (b[2] * b[2] + b[3] * b[3])); } }
                if (xb_off) { s2 += __shfl_xor(s2, 16); s2 += __shfl_xor(s2, 32); if (fq == 0) ss[row * 16 + u.pn * 4 + wc] = s2; } }
    }
};

struct EpiResB {
    static constexpr bool PERM = false, AFTER_DRAIN = false, I8 = false;
    const float* xf; bf16_t* xs;
    __device__ __forceinline__ void operator()(const f32x4 (&acc)[2][2][4][2], const Unit& u, int wr, int wc, int fr, int fq) const {
        const size_t row0 = (size_t)u.pm * BM + wr * 64 + fr; const int col0 = u.pn * BM + 64 * wc + 8 * fq;
#pragma unroll
        for (int ai = 0; ai < 2; ++ai)
#pragma unroll
            for (int m = 0; m < 4; ++m) { const size_t row = row0 + ai * HALF + m * 16;
#pragma unroll
                for (int bj = 0; bj < 2; ++bj) { const size_t off = row * 1024 + col0 + 32 * bj; f32x4 a, b;
                    if (xf) { a = *(const f32x4*)(xf + off); b = *(const f32x4*)(xf + off + 4); }
                    else { const u32x4 w = *(const u32x4*)(xs + off); a = (f32x4){bf_lo(w.x), bf_hi(w.x), bf_lo(w.y), bf_hi(w.y)}; b = (f32x4){bf_lo(w.z), bf_hi(w.z), bf_lo(w.w), bf_hi(w.w)}; }
                    *(u32x4*)(xs + off) = pk8(a + acc[ai][bj][m][0], b + acc[ai][bj][m][1]); } }
    }
};

template <bool I8_> struct EpiSwiglu {
    static constexpr bool PERM = false, AFTER_DRAIN = false, I8 = I8_;
    bf16_t* H; int ldc; const PG8_LAS float* rs; const float* cmax; int nh;
    const PG8_LAS int* texp; int t0;
    __device__ __forceinline__ void operator()(const f32x4 (&acc)[2][2][4][2], const Unit& u, int wr, int wc, int fr, int fq) const {
        const int rl = wr * 64 + fr; const size_t row0 = (size_t)u.pm * BM + rl; const int col0 = u.pn * 128 + 32 * wc + 8 * fq;
        f32x4 c1[2], c3[2];
#pragma unroll
        for (int bj = 0; bj < 2; ++bj) { if constexpr (I8_) { const float* cm = cmax + (texp ? (size_t)texp[t0 + u.pm] * 2 * nh : 0) + col0 + 4 * bj; c1[bj] = *(const f32x4*)cm * (1.0f / 127.0f); c3[bj] = *(const f32x4*)(cm + nh) * (1.0f / 127.0f); } else { c1[bj] = (f32x4){1.f, 1.f, 1.f, 1.f}; c3[bj] = c1[bj]; } }
#pragma unroll
        for (int ai = 0; ai < 2; ++ai)
#pragma unroll
            for (int m = 0; m < 4; ++m) { const float sc = rs[u.idx * 256 + rl + ai * HALF + m * 16]; f32x4 h[2];
#pragma unroll
                for (int bj = 0; bj < 2; ++bj) { const f32x4 a = accf<I8_>(acc[ai][bj][m][0]) * c1[bj] * sc, b = accf<I8_>(acc[ai][bj][m][1]) * c3[bj] * sc;
#pragma unroll
                    for (int j = 0; j < 4; ++j) h[bj][j] = a[j] * sigmoid_f(a[j]) * b[j]; }
                *(u32x4*)(H + (row0 + ai * HALF + m * 16) * ldc + col0) = pk8(h[0], h[1]); }
    }
};

template <class Epi, class Sched, bool ALIGN_EPI = false, bool SP2 = false>
__device__ __forceinline__ void gemm_phase(PG8_LAS unsigned char* lds, const Gemm g, const Sched& S, const Epi& E) {
    int tid_ = threadIdx.x; asm volatile("" : "+v"(tid_));
    const int tid = tid_, wid = __builtin_amdgcn_readfirstlane(tid >> 6), lane = tid & 63, wr = wid >> 2, wc = wid & 3, fr = lane & 15, fq = lane >> 4;
    const int K = g.K, nt = K / BK;
    unsigned voffA[2], voffB[2];
#pragma unroll
    for (int i = 0; i < 2; ++i) { int R, C; stage_rc(tid * 16 + i * 8192, R, C); const int Rb = Epi::PERM ? ((R & ~31) + perm32(R & 31)) : R;
        voffA[i] = (unsigned)(R * K + C) * 2u; voffB[i] = (unsigned)(Rb * K + C) * 2u; }
    const size_t kstep = (size_t)(BK * 2);
    const size_t hstep = (size_t)HALF * K * 2;
    const size_t tstep = 2 * hstep;
    const unsigned ldsw = (unsigned)wid * 1024u;
    const int aoff = lds_byte(wr * 64 + fr, fq * 8), boff = lds_byte(wc * 32 + fr, fq * 8);
#define PG8_SA(b, h) (((b) * 2 + (h)) * HTB)
#define PG8_SB(b, h) ((4 + (b) * 2 + (h)) * HTB)
#define PG8_STAGE(bufoff, gbase, voff) do { _Pragma("unroll") for (int _i = 0; _i < 2; ++_i) \
        __builtin_amdgcn_global_load_lds((const unsigned*)((const char*)(gbase) + (voff)[_i]), (PG8_LAS unsigned*)(lds + (bufoff) + ldsw + _i * 8192), 16, 0, 0); } while (0)
#define PG8_LDA(dst, b, h) do { _Pragma("unroll") for (int m = 0; m < 4; ++m) _Pragma("unroll") for (int k = 0; k < 2; ++k) dst[m][k] = *(const PG8_LAS bf16x8*)(lds + PG8_SA(b, h) + aoff + m * 2048 + k * 1024); } while (0)
#define PG8_LDB(dst, b, h) do { _Pragma("unroll") for (int n = 0; n < 2; ++n) _Pragma("unroll") for (int k = 0; k < 2; ++k) dst[n][k] = *(const PG8_LAS bf16x8*)(lds + PG8_SB(b, h) + boff + n * 2048 + k * 1024); } while (0)
#define PG8_MMA(ai, bj, At, Bt) do { __builtin_amdgcn_s_setprio(1); _Pragma("unroll") for (int m = 0; m < 4; ++m) _Pragma("unroll") for (int n = 0; n < 2; ++n) _Pragma("unroll") for (int k = 0; k < 2; ++k) \
        acc[ai][bj][m][n] = mma16<Epi::I8>(Bt[n][k], At[m][k], acc[ai][bj][m][n]); __builtin_amdgcn_s_setprio(0); } while (0)
#define PG8_WAIT_V(n) asm volatile("s_waitcnt vmcnt(" #n ")" ::: "memory")
#define PG8_WAIT_L(n) asm volatile("s_waitcnt lgkmcnt(" #n ")" ::: "memory")
#define PG8_BAR __builtin_amdgcn_s_barrier()
#define PG8_SCHED __builtin_amdgcn_sched_barrier(0)
    Unit cur, nxt; int ui = 0;
    if (!S.next(0, cur)) return;
    f32x4 acc[2][2][4][2];
#pragma unroll
    for (int a = 0; a < 2; ++a)
#pragma unroll
        for (int b = 0; b < 2; ++b)
#pragma unroll
            for (int m = 0; m < 4; ++m)
#pragma unroll
                for (int n = 0; n < 2; ++n) acc[a][b][m][n] = (f32x4){0.f, 0.f, 0.f, 0.f};
    bf16x8 At[4][2], B0[2][2], B1[2][2];
    const char* cA = S.aptr(g, cur, tstep); const char* cB = S.bptr(g, cur, tstep);
    S.a_ready(cur);
    if constexpr (SP2) {
        PG8_STAGE(PG8_SB(0, 0), cB, voffB); PG8_STAGE(PG8_SB(0, 1), cB + hstep, voffB); PG8_STAGE(PG8_SA(0, 0), cA, voffA); PG8_STAGE(PG8_SA(0, 1), cA + hstep, voffA);
        if (wr == 1) PG8_BAR;
        PG8_WAIT_V(2); PG8_BAR;
        PG8_STAGE(PG8_SB(1, 0), cB + kstep, voffB); PG8_STAGE(PG8_SA(1, 0), cA + kstep, voffA); PG8_STAGE(PG8_SB(1, 1), cB + hstep + kstep, voffB);
        PG8_WAIT_V(6); PG8_BAR;
    } else {
        PG8_STAGE(PG8_SB(0, 0), cB, voffB); PG8_STAGE(PG8_SA(0, 0), cA, voffA); PG8_STAGE(PG8_SB(0, 1), cB + hstep, voffB); PG8_STAGE(PG8_SA(0, 1), cA + hstep, voffA);
        if (wr == 1) PG8_BAR;
        PG8_WAIT_V(4); PG8_BAR;
        PG8_STAGE(PG8_SB(1, 0), cB + kstep, voffB); PG8_STAGE(PG8_SA(1, 0), cA + kstep, voffA); PG8_STAGE(PG8_SB(1, 1), cB + hstep + kstep, voffB);
        PG8_WAIT_V(6); PG8_BAR;
    }
    for (;;) {
        const bool has_next = S.next(ui + 1, nxt);
        const char* nA = has_next ? S.aptr(g, nxt, tstep) : cA; const char* nB = has_next ? S.bptr(g, nxt, tstep) : cB;
        for (int t = 0; t < nt; t += 2) {
            const bool last = (t == nt - 2);
            const char* a1 = cA + (size_t)(t + 1) * kstep;
            const char* a2 = last ? nA : cA + (size_t)(t + 2) * kstep; const char* b2 = last ? nB : cB + (size_t)(t + 2) * kstep;
            const char* a3 = a2 + kstep; const char* b3 = b2 + kstep;
            if (last && has_next) S.a_ready(nxt);
            if constexpr (SP2) {
            PG8_LDB(B0, 0, 0); PG8_LDB(B1, 0, 1); PG8_SCHED; PG8_LDA(At, 0, 0); PG8_STAGE(PG8_SA(1, 1), a1 + hstep, voffA);
            PG8_WAIT_V(8); PG8_WAIT_L(0); PG8_BAR; PG8_MMA(0, 0, At, B0); PG8_MMA(0, 1, At, B1); PG8_BAR; PG8_SCHED;
            PG8_LDA(At, 0, 1); PG8_STAGE(PG8_SB(0, 0), b2, voffB); PG8_STAGE(PG8_SB(0, 1), b2 + hstep, voffB); PG8_STAGE(PG8_SA(0, 0), a2, voffA);
            PG8_WAIT_V(8); PG8_WAIT_L(0); PG8_BAR; PG8_MMA(1, 0, At, B0); PG8_MMA(1, 1, At, B1); PG8_BAR; PG8_SCHED;
            PG8_LDB(B0, 1, 0); PG8_LDB(B1, 1, 1); PG8_SCHED; PG8_LDA(At, 1, 0); PG8_STAGE(PG8_SA(0, 1), a2 + hstep, voffA);
            PG8_WAIT_V(8); PG8_WAIT_L(0); PG8_BAR; PG8_MMA(0, 0, At, B0); PG8_MMA(0, 1, At, B1); PG8_BAR; PG8_SCHED;
            PG8_LDA(At, 1, 1); PG8_STAGE(PG8_SB(1, 0), b3, voffB); PG8_STAGE(PG8_SB(1, 1), b3 + hstep, voffB); PG8_STAGE(PG8_SA(1, 0), a3, voffA);
            PG8_WAIT_V(8); PG8_WAIT_L(0); PG8_BAR; PG8_MMA(1, 0, At, B0); PG8_MMA(1, 1, At, B1); PG8_BAR; PG8_SCHED;
            } else {
            PG8_LDB(B0, 0, 0); PG8_SCHED; PG8_LDA(At, 0, 0); PG8_STAGE(PG8_SA(1, 1), a1 + hstep, voffA);
            PG8_WAIT_L(8); PG8_BAR; PG8_WAIT_L(0); PG8_MMA(0, 0, At, B0); PG8_BAR; PG8_SCHED;
            PG8_LDB(B1, 0, 1); PG8_STAGE(PG8_SB(0, 0), b2, voffB);
            PG8_BAR; PG8_WAIT_L(0); PG8_MMA(0, 1, At, B1); PG8_BAR;
            PG8_LDA(At, 0, 1); PG8_STAGE(PG8_SA(0, 0), a2, voffA);
            PG8_BAR; PG8_WAIT_L(0); PG8_MMA(1, 0, At, B0); PG8_BAR; PG8_SCHED;
            PG8_STAGE(PG8_SB(0, 1), b2 + hstep, voffB);
            PG8_WAIT_V(6); PG8_BAR; PG8_MMA(1, 1, At, B1); PG8_BAR;
            PG8_LDB(B0, 1, 0); PG8_SCHED; PG8_LDA(At, 1, 0); PG8_STAGE(PG8_SA(0, 1), a2 + hstep, voffA);
            PG8_WAIT_L(8); PG8_BAR; PG8_WAIT_L(0); PG8_MMA(0, 0, At, B0); PG8_BAR; PG8_SCHED;
            PG8_LDB(B1, 1, 1); PG8_STAGE(PG8_SB(1, 0), b3, voffB);
            PG8_BAR; PG8_WAIT_L(0); PG8_MMA(0, 1, At, B1); PG8_BAR;
            PG8_LDA(At, 1, 1); PG8_STAGE(PG8_SA(1, 0), a3, voffA);
            PG8_BAR; PG8_WAIT_L(0); PG8_MMA(1, 0, At, B0); PG8_BAR; PG8_SCHED;
            PG8_STAGE(PG8_SB(1, 1), b3 + hstep, voffB);
            PG8_WAIT_V(6); PG8_BAR; PG8_MMA(1, 1, At, B1); PG8_BAR;
            }
        }
        if constexpr (ALIGN_EPI) { if (wr == 0) PG8_BAR; }
        if constexpr (!Epi::AFTER_DRAIN) { E(acc, cur, wr, wc, fr, fq); S.done(cur); }
        if (!has_next) break;
#pragma unroll
        for (int a = 0; a < 2; ++a)
#pragma unroll
            for (int b = 0; b < 2; ++b)
#pragma unroll
                for (int m = 0; m < 4; ++m)
#pragma unroll
                    for (int n = 0; n < 2; ++n) acc[a][b][m][n] = (f32x4){0.f, 0.f, 0.f, 0.f};
        cur = nxt; cA = nA; cB = nB; ++ui;
        if constexpr (ALIGN_EPI) { if (wr == 1) PG8_BAR; }
    }
    PG8_WAIT_V(0);
    if constexpr (!ALIGN_EPI) { if (wr == 0) PG8_BAR; }
    PG8_BAR;
    if constexpr (Epi::AFTER_DRAIN) { E.fused(acc, cur, wr, wc, fr, fq, lds, wid, lane); S.done(cur); }
#undef PG8_SA
#undef PG8_SB
#undef PG8_STAGE
#undef PG8_LDA
#undef PG8_LDB
#undef PG8_MMA
#undef PG8_WAIT_V
#undef PG8_WAIT_L
#undef PG8_BAR
#undef PG8_SCHED
}
}
#define GAS __attribute__((address_space(1)))
#define LAS __attribute__((address_space(3)))
typedef unsigned short bf16_t;
typedef unsigned v4u __attribute__((ext_vector_type(4)));
typedef float f32x4 __attribute__((ext_vector_type(4)));
typedef float f32x2 __attribute__((ext_vector_type(2)));
#define RLX_AGENT __ATOMIC_RELAXED, __HIP_MEMORY_SCOPE_AGENT
__device__ __forceinline__ float wave_sum(float v) {
#pragma unroll
    for (int o = 1; o < 64; o <<= 1) v += __shfl_xor(v, o);
    return v;
}
__device__ __forceinline__ float ld_f32_agent(const float* p) { return __builtin_bit_cast(float, __builtin_amdgcn_readfirstlane(__hip_atomic_load((const unsigned*)p, RLX_AGENT))); }
__device__ __forceinline__ float ld_f32_plain(const float* p) { return *(const GAS float*)p; }
__device__ __forceinline__ int ld_i32_agent(const int* p) { return (int)__hip_atomic_load((const unsigned*)p, RLX_AGENT); }
using pg8::pk_bf16; using pg8::bf_lo; using pg8::bf_hi;

#define XB_TMO      128
#define XB_XCNT(j)  (256  + 64 * (j))
#define XB_XSUB(j)  (1280 + 64 * (j))
#define XB_XGEN(j)  (2304 + 64 * (j))
#define XB_TOP      3328
#define XB_TOPGEN   3392
#define XCD_BAR_WORDS 3456
#define XB_SPIN_CAP (1u << 18)

__device__ __forceinline__ unsigned xb_ld(unsigned* p)              { return __hip_atomic_load(p, __ATOMIC_RELAXED, __HIP_MEMORY_SCOPE_AGENT); }
__device__ __forceinline__ unsigned xb_add(unsigned* p, unsigned v) { return __hip_atomic_fetch_add(p, v, __ATOMIC_RELAXED, __HIP_MEMORY_SCOPE_AGENT); }
__device__ __forceinline__ unsigned xb_xcc_id() { return (unsigned)__builtin_amdgcn_s_getreg((3 << 11) | 20) & 0xFu; }
#define XB_SPIN(cond, bar) do { unsigned _sp = 0; while (cond) { __builtin_amdgcn_s_sleep(1); \
    if ((++_sp & 255u) == 0u) { if (xb_ld(&(bar)[XB_TMO])) break; if (_sp > XB_SPIN_CAP) { atomicAdd(&(bar)[XB_TMO], 1u); break; } } } } while (0)

struct XcdBarrier {
    unsigned* bar; unsigned x;
    volatile LAS unsigned* st;
};

__device__ __forceinline__ XcdBarrier xcd_barrier_post(unsigned* bar, volatile LAS unsigned* st) {
    XcdBarrier b; b.bar = bar; b.x = xb_xcc_id(); b.st = st;
    if (threadIdx.x == 0) (void)xb_add(&bar[XB_XCNT(b.x)], 1u);
    return b;
}
__device__ __forceinline__ void xcd_barrier_complete(unsigned* bar, unsigned x, unsigned& nloc, unsigned& nx) {
    const unsigned G = gridDim.x * gridDim.y * gridDim.z;
    unsigned sum, cnt, mine, sp = 0u;
    for (;;) {
        sum = 0u; cnt = 0u; mine = 0u;
#pragma unroll
        for (unsigned j = 0; j < 16; ++j) { const unsigned c = xb_ld(&bar[XB_XCNT(j)]); sum += c; cnt += (c > 0u) ? 1u : 0u; mine = (j == x) ? c : mine; }
        if (sum == G) break;
        __builtin_amdgcn_s_sleep(1);
        if ((++sp & 255u) == 0u) { if (xb_ld(&bar[XB_TMO])) break; if (sp > XB_SPIN_CAP) { atomicAdd(&bar[XB_TMO], 1u); break; } }
    }
    nloc = mine > 0u ? mine : 1u; nx = cnt > 0u ? cnt : 1u;
}

__device__ __forceinline__ void xcd_barrier(const XcdBarrier& b) {
    asm volatile("s_waitcnt vmcnt(0)" ::: "memory");
    __syncthreads();
    if (threadIdx.x == 0) {
        unsigned* bar = b.bar;
        __builtin_amdgcn_s_waitcnt(0);
        unsigned nloc = b.st[0], nx = b.st[1];
        if (nloc == 0u) { xcd_barrier_complete(bar, b.x, nloc, nx); b.st[0] = nloc; b.st[1] = nx; }
        const unsigned old = xb_add(&bar[XB_XSUB(b.x)], 1u);
        const unsigned gen = old / nloc;
        if (old + 1u == (gen + 1u) * nloc) {
            __builtin_amdgcn_fence(__ATOMIC_RELEASE, "agent");
            asm volatile("s_waitcnt vmcnt(0)" ::: "memory");
            const unsigned og = xb_add(&bar[XB_TOP], 1u);
            const unsigned tg = og / nx;
            if (og + 1u == (tg + 1u) * nx) xb_add(&bar[XB_TOPGEN], 1u);
            else XB_SPIN(xb_ld(&bar[XB_TOPGEN]) == tg, bar);
            __builtin_amdgcn_fence(__ATOMIC_ACQUIRE, "agent");
            xb_add(&bar[XB_XGEN(b.x)], 1u);
            asm volatile("s_waitcnt vmcnt(0)" ::: "memory");
        } else {
            XB_SPIN(xb_ld(&bar[XB_XGEN(b.x)]) == gen, bar);
            __builtin_amdgcn_fence(__ATOMIC_ACQUIRE, "agent");
            asm volatile("s_waitcnt vmcnt(0)" ::: "memory");
        }
    }
    __syncthreads();
}


struct Args { const float* in[31]; float* out; unsigned char* ws; int ph_lo, ph_hi; };

struct TJob { unsigned long long src, dst, gain; int K, N, ld, map, colbase, start, q8, smax, startq; };
constexpr int NJOBS = 41;
__device__ __forceinline__ void make_job(int j, const Args& a, TJob& o) {
    unsigned char* ws = a.ws; const float* src; void* dst; const float* gain = nullptr; o.map = 0; o.colbase = 0; o.q8 = 0; o.smax = 0;
    if (j < 14) { const int l = j / 7, t = j % 7;
        if (t == 0)      { src = a.in[5] + (size_t)l * D * 4096; o.K = D; o.N = 4096; dst = ws + WS_W1T + l * 14 * MiB; gain = a.in[2] + l * D; o.q8 = I8_A; o.smax = SW_G1 + l * 7168; }
        else if (t == 1) { src = a.in[6] + (size_t)l * D * 3072; o.K = D; o.N = 3072; dst = ws + WS_W1T + l * 14 * MiB; gain = a.in[2] + l * D; o.colbase = 4096; o.q8 = I8_A; o.smax = SW_G1 + l * 7168 + 4096; }
        else if (t == 2) { src = a.in[19] + (size_t)l * D * 1024; o.K = D; o.N = 1024; dst = ws + WS_WMEMKV + l * 2 * MiB; gain = a.in[3] + l * D; }
        else if (t == 3) { src = a.in[20] + (size_t)l * 1024 * D; o.K = 1024; o.N = D; dst = ws + WS_WBRDA + l * 2 * MiB; }
        else if (t == 4) { src = a.in[21] + (size_t)l * 512 * D; o.K = 512; o.N = D; dst = ws + WS_WBRPOOL + l * 1 * MiB; }
        else if (t == 5) { src = a.in[22] + (size_t)l * 512 * D; o.K = 512; o.N = D; dst = ws + WS_WBRMEM + l * 1 * MiB; }
        else             { src = a.in[23] + (size_t)l * D * D; o.K = D; o.N = D; dst = ws + WS_WOUT + l * 2 * MiB; }
    } else if (j < 17) { const int t = j - 14;
        if (t < 2) { src = a.in[24 + t]; o.K = D; o.N = FFD; dst = ws + WS_WFF13; gain = a.in[4]; o.map = 1 + t; o.q8 = I8_E; o.smax = SW_FF + t * FFD; }
        else       { src = a.in[26]; o.K = FFD; o.N = D; dst = ws + WS_WFF2; }
    } else { const int e = (j - 17) / 3, t = (j - 17) % 3;
        if (t < 2) { src = a.in[28 + t] + (size_t)e * D * FFE; o.K = D; o.N = FFE; dst = ws + WS_WMOE13 + (size_t)e * 7 * MiB; gain = a.in[4] + D; o.map = 1 + t; o.q8 = USE_I8; o.smax = SW_MOE + e * 2 * FFE + t * FFE; }
        else       { src = a.in[30] + (size_t)e * FFE * D; o.K = FFE; o.N = D; dst = ws + WS_WMOE2 + (size_t)e * 7 * MiB; }
    }
    o.src = (unsigned long long)src; o.dst = (unsigned long long)dst; o.gain = (unsigned long long)gain; o.ld = o.N; o.start = 0; o.startq = 0;
}
__device__ __forceinline__ int bt_row_std(int C) { const int c = C & 255; return (C & ~255) + 128 * ((c >> 5) & 1) + 32 * (c >> 6) + 16 * ((c >> 2) & 1) + 4 * ((c >> 3) & 3) + (c & 3); }
__device__ __forceinline__ int bt_row_swiglu(int h, int which) { const int hl = h & 127; return 256 * (h >> 7) + 128 * ((hl >> 2) & 1) + 32 * (hl >> 5) + 16 * which + 4 * ((hl >> 3) & 3) + (hl & 3); }
struct TileRef { const GAS float* src; GAS bf16_t* dst; const GAS float* gain; int K, ld, map, colbase, k0, n0, q8, smax; };
template <bool QONLY> __device__ __forceinline__ void tile_decode(const LAS TJob* jobs, int& j, int it, TileRef& r) {
    if constexpr (QONLY) { while (it >= jobs[j + 1].startq) ++j; } else { while (it >= jobs[j + 1].start) ++j; }
    const LAS TJob* jb = jobs + j; const int item = it - (QONLY ? jb->startq : jb->start), nblk = jb->N >> 6;
    r.src = (const GAS float*)jb->src; r.dst = (GAS bf16_t*)jb->dst; r.gain = (const GAS float*)jb->gain; r.K = jb->K; r.ld = jb->ld; r.map = jb->map; r.colbase = jb->colbase; r.q8 = jb->q8; r.smax = jb->smax;
    r.k0 = (item / nblk) * 64; r.n0 = (item % nblk) * 64;
}
__device__ __forceinline__ void tile_load(const TileRef& r, int lane, f32x4 (&v)[16]) {
    const GAS float* p = r.src + (size_t)(r.k0 + (lane >> 4)) * r.ld + r.n0 + 4 * (lane & 15);
#pragma unroll
    for (int i = 0; i < 16; ++i) v[i] = __builtin_nontemporal_load((const GAS f32x4*)(p + (size_t)(4 * i) * r.ld));
}
__device__ __forceinline__ void tile_store(const TileRef& r, int lane, const f32x4 (&v)[16], LAS float* scr) {
#pragma unroll
    for (int i = 0; i < 16; ++i) { LAS float* d = scr + (4 * i + (lane >> 4)) * 65 + 4 * (lane & 15); d[0] = v[i][0]; d[1] = v[i][1]; d[2] = v[i][2]; d[3] = v[i][3]; }
    asm volatile("s_waitcnt lgkmcnt(0)" ::: "memory");
    const int kc = lane & 7;
    f32x4 g0 = {1.f, 1.f, 1.f, 1.f}, g1 = g0;
    if (r.gain) { g0 = *(const GAS f32x4*)(r.gain + r.k0 + 8 * kc); g1 = *(const GAS f32x4*)(r.gain + r.k0 + 8 * kc + 4); }
#pragma unroll
    for (int jj = 0; jj < 8; ++jj) { const int n = (lane >> 3) + 8 * jj; const LAS float* s = scr + (8 * kc) * 65 + n;
        v4u o; o.x = pk_bf16(s[0 * 65] * g0[0], s[1 * 65] * g0[1]); o.y = pk_bf16(s[2 * 65] * g0[2], s[3 * 65] * g0[3]); o.z = pk_bf16(s[4 * 65] * g1[0], s[5 * 65] * g1[1]); o.w = pk_bf16(s[6 * 65] * g1[2], s[7 * 65] * g1[3]);
        const int row = (r.map == 0) ? bt_row_std(r.colbase + r.n0 + n) : bt_row_swiglu(r.n0 + n, r.map - 1);
        *(GAS v4u*)(r.dst + (size_t)row * r.K + r.k0 + 8 * kc) = o; }
    asm volatile("s_waitcnt lgkmcnt(0)" ::: "memory");
}
__device__ __forceinline__ void tile_colmax(const TileRef& r, int lane, const f32x4 (&v)[16], float* cmaxbase) {
    float m0 = 0.f, m1 = 0.f, m2 = 0.f, m3 = 0.f;
#pragma unroll
    for (int i = 0; i < 16; ++i) { const float g = r.gain ? r.gain[r.k0 + 4 * i + (lane >> 4)] : 1.f;
        m0 = fmaxf(m0, fabsf(v[i][0] * g)); m1 = fmaxf(m1, fabsf(v[i][1] * g)); m2 = fmaxf(m2, fabsf(v[i][2] * g)); m3 = fmaxf(m3, fabsf(v[i][3] * g)); }
    m0 = fmaxf(m0, __shfl_xor(m0, 16)); m1 = fmaxf(m1, __shfl_xor(m1, 16)); m2 = fmaxf(m2, __shfl_xor(m2, 16)); m3 = fmaxf(m3, __shfl_xor(m3, 16));
    m0 = fmaxf(m0, __shfl_xor(m0, 32)); m1 = fmaxf(m1, __shfl_xor(m1, 32)); m2 = fmaxf(m2, __shfl_xor(m2, 32)); m3 = fmaxf(m3, __shfl_xor(m3, 32));
    if (lane < 16) { unsigned* p = (unsigned*)(cmaxbase + r.smax + r.n0 + 4 * lane);
        atomicMax(p, __float_as_uint(m0)); atomicMax(p + 1, __float_as_uint(m1)); atomicMax(p + 2, __float_as_uint(m2)); atomicMax(p + 3, __float_as_uint(m3)); }
}
__device__ __forceinline__ unsigned pk_i8x4(float a, float b, float c, float d) {
    const int ia = (int)__builtin_rintf(a), ib = (int)__builtin_rintf(b), ic = (int)__builtin_rintf(c), id = (int)__builtin_rintf(d);
    return (unsigned)(ia & 0xff) | ((unsigned)(ib & 0xff) << 8) | ((unsigned)(ic & 0xff) << 16) | ((unsigned)id << 24);
}
__device__ __forceinline__ void tile_store_q8(const TileRef& r, int lane, const f32x4 (&v)[16], LAS float* scr, const float* cmaxbase) {
#pragma unroll
    for (int i = 0; i < 16; ++i) { const float g = r.gain ? r.gain[r.k0 + 4 * i + (lane >> 4)] : 1.f; LAS float* d = scr + (4 * i + (lane >> 4)) * 65 + 4 * (lane & 15); d[0] = v[i][0] * g; d[1] = v[i][1] * g; d[2] = v[i][2] * g; d[3] = v[i][3] * g; }
    asm volatile("s_waitcnt lgkmcnt(0)" ::: "memory");
    const int kc = lane & 3;
#pragma unroll
    for (int jj = 0; jj < 4; ++jj) { const int n = (lane >> 2) + 16 * jj; const LAS float* s = scr + (16 * kc) * 65 + n;
        const float cm = ld_f32_plain(cmaxbase + r.smax + r.n0 + n), inv = cm > 0.f ? 127.0f / cm : 0.f;
        v4u o; o.x = pk_i8x4(s[0 * 65] * inv, s[1 * 65] * inv, s[2 * 65] * inv, s[3 * 65] * inv); o.y = pk_i8x4(s[4 * 65] * inv, s[5 * 65] * inv, s[6 * 65] * inv, s[7 * 65] * inv);
        o.z = pk_i8x4(s[8 * 65] * inv, s[9 * 65] * inv, s[10 * 65] * inv, s[11 * 65] * inv); o.w = pk_i8x4(s[12 * 65] * inv, s[13 * 65] * inv, s[14 * 65] * inv, s[15 * 65] * inv);
        const int row = (r.map == 0) ? bt_row_std(r.colbase + r.n0 + n) : bt_row_swiglu(r.n0 + n, r.map - 1);
        *(GAS v4u*)((GAS unsigned char*)r.dst + (size_t)row * r.K + r.k0 + 16 * kc) = o; }
    asm volatile("s_waitcnt lgkmcnt(0)" ::: "memory");
}
__device__ __forceinline__ void row_to_i8(const float* xrow, unsigned char* qrow, float* sa, int lane) {
    const f32x4* xr = (const f32x4*)xrow + 4 * lane; f32x4 v[4]; float s = 0.f, mx = 0.f;
#pragma unroll
    for (int j = 0; j < 4; ++j) { v[j] = xr[j]; s += (v[j][0] * v[j][0] + v[j][1] * v[j][1]) + (v[j][2] * v[j][2] + v[j][3] * v[j][3]);
        mx = fmaxf(mx, fmaxf(fmaxf(fabsf(v[j][0]), fabsf(v[j][1])), fmaxf(fabsf(v[j][2]), fabsf(v[j][3])))); }
    s = wave_sum(s);
#pragma unroll
    for (int o = 1; o < 64; o <<= 1) mx = fmaxf(mx, __shfl_xor(mx, o));
    const float inv = mx > 0.f ? 127.0f / mx : 0.f;
    v4u w; w.x = pk_i8x4(v[0][0] * inv, v[0][1] * inv, v[0][2] * inv, v[0][3] * inv); w.y = pk_i8x4(v[1][0] * inv, v[1][1] * inv, v[1][2] * inv, v[1][3] * inv);
    w.z = pk_i8x4(v[2][0] * inv, v[2][1] * inv, v[2][2] * inv, v[2][3] * inv); w.w = pk_i8x4(v[3][0] * inv, v[3][1] * inv, v[3][2] * inv, v[3][3] * inv);
    *((v4u*)qrow + lane) = w;
    if (lane == 0) *sa = mx * (1.0f / 127.0f) * __builtin_amdgcn_rsqf(s * (1.0f / 1024.0f) + 1e-6f);
}
__device__ __forceinline__ void ld16_bf16(const bf16_t* p, f32x4 (&v)[4]) {
    const v4u a = *(const v4u*)p, b = *(const v4u*)(p + 8);
    v[0] = (f32x4){bf_lo(a.x), bf_hi(a.x), bf_lo(a.y), bf_hi(a.y)}; v[1] = (f32x4){bf_lo(a.z), bf_hi(a.z), bf_lo(a.w), bf_hi(a.w)};
    v[2] = (f32x4){bf_lo(b.x), bf_hi(b.x), bf_lo(b.y), bf_hi(b.y)}; v[3] = (f32x4){bf_lo(b.z), bf_hi(b.z), bf_lo(b.w), bf_hi(b.w)};
}
__device__ __forceinline__ void rowb_to_i8(const bf16_t* xrow, unsigned char* qrow, float* sa, int lane) {
    f32x4 v[4]; ld16_bf16(xrow + 16 * lane, v); float s = 0.f, mx = 0.f;
#pragma unroll
    for (int j = 0; j < 4; ++j) { s += (v[j][0] * v[j][0] + v[j][1] * v[j][1]) + (v[j][2] * v[j][2] + v[j][3] * v[j][3]);
        mx = fmaxf(mx, fmaxf(fmaxf(fabsf(v[j][0]), fabsf(v[j][1])), fmaxf(fabsf(v[j][2]), fabsf(v[j][3])))); }
    s = wave_sum(s);
#pragma unroll
    for (int o = 1; o < 64; o <<= 1) mx = fmaxf(mx, __shfl_xor(mx, o));
    const float inv = mx > 0.f ? 127.0f / mx : 0.f;
    v4u w; w.x = pk_i8x4(v[0][0] * inv, v[0][1] * inv, v[0][2] * inv, v[0][3] * inv); w.y = pk_i8x4(v[1][0] * inv, v[1][1] * inv, v[1][2] * inv, v[1][3] * inv);
    w.z = pk_i8x4(v[2][0] * inv, v[2][1] * inv, v[2][2] * inv, v[2][3] * inv); w.w = pk_i8x4(v[3][0] * inv, v[3][1] * inv, v[3][2] * inv, v[3][3] * inv);
    *((v4u*)qrow + lane) = w;
    if (lane == 0) *sa = mx * (1.0f / 127.0f) * __builtin_amdgcn_rsqf(s * (1.0f / 1024.0f) + 1e-6f);
}
__device__ __forceinline__ void phase_quant_rows(const bf16_t* x, unsigned char* ws, int lane, int wave) {
    const int gw = blockIdx.x * NWAVES + wave, NGW = gridDim.x * NWAVES;
    for (int m = gw; m < T; m += NGW) rowb_to_i8(x + (size_t)m * D, ws + WS_QX + (size_t)m * D, (float*)(ws + WS_SA) + m, lane);
}
__device__ __forceinline__ void row_to_bf16_ss(const float* xrow, bf16_t* orow, float* ss16, float* fcopy, int lane) {
    const f32x4* xr = (const f32x4*)xrow + lane; f32x4 v[4]; float s = 0.f;
#pragma unroll
    for (int j = 0; j < 4; ++j) { v[j] = xr[64 * j]; s += (v[j][0] * v[j][0] + v[j][1] * v[j][1]) + (v[j][2] * v[j][2] + v[j][3] * v[j][3]); }
    s = wave_sum(s);
    if (fcopy) { f32x4* fc = (f32x4*)fcopy + lane;
#pragma unroll
        for (int j = 0; j < 4; ++j) fc[64 * j] = v[j]; }
    unsigned long long* o8 = (unsigned long long*)orow + lane;
#pragma unroll
    for (int j = 0; j < 4; ++j) o8[64 * j] = (unsigned long long)pk_bf16(v[j][0], v[j][1]) | ((unsigned long long)pk_bf16(v[j][2], v[j][3]) << 32);
    if (lane < 16) ss16[lane] = (lane == 0) ? s : 0.f;
}
__device__ __forceinline__ void build_jobs(const Args& a, LAS TJob* jobs, int tid) {
    if (tid < NJOBS) { TJob jb; make_job(tid, a, jb); LAS TJob* d = jobs + tid; d->src = jb.src; d->dst = jb.dst; d->gain = jb.gain; d->K = jb.K; d->N = jb.N; d->ld = jb.ld; d->map = jb.map; d->colbase = jb.colbase; d->q8 = jb.q8; d->smax = jb.smax; d->start = 0; d->startq = 0; }
    __syncthreads();
    if (tid == 0) { int s = 0, q = 0; for (int j = 0; j < NJOBS; ++j) { jobs[j].start = s; jobs[j].startq = q; if (jobs[j].q8) q += jobs[j].N / 64; else s += (jobs[j].K / 64) * (jobs[j].N / 64); } jobs[NJOBS].start = s; jobs[NJOBS].startq = q; }
    __syncthreads();
}
__device__ __forceinline__ void strip_q8(const LAS TJob* jobs, int& j, int st, LAS unsigned char* lds, int tid, int lane, int wave, float* cmaxbase) {
    while (st >= jobs[j + 1].startq) ++j;
    const LAS TJob* jb = jobs + j;
    TileRef r; r.src = (const GAS float*)jb->src; r.dst = (GAS bf16_t*)jb->dst; r.gain = (const GAS float*)jb->gain; r.K = jb->K; r.ld = jb->ld; r.map = jb->map; r.colbase = jb->colbase; r.q8 = 1; r.smax = jb->smax;
    r.n0 = (st - jb->startq) * 64; r.k0 = 128 * wave;
    LAS float* scr = (LAS float*)(lds + wave * 17408); LAS float* pmax = (LAS float*)(lds + 8 * 17408 + 4096); LAS float* cmf = pmax + 8 * 64;
    f32x4 v0[16], v1[16];
    tile_load(r, lane, v0); r.k0 += 64; tile_load(r, lane, v1); r.k0 -= 64;
    float m0 = 0.f, m1 = 0.f, m2 = 0.f, m3 = 0.f;
#pragma unroll
    for (int i = 0; i < 16; ++i) { const float g0 = r.gain ? r.gain[r.k0 + 4 * i + (lane >> 4)] : 1.f, g1 = r.gain ? r.gain[r.k0 + 64 + 4 * i + (lane >> 4)] : 1.f;
        v0[i] = v0[i] * g0; v1[i] = v1[i] * g1;
        m0 = fmaxf(m0, fmaxf(fabsf(v0[i][0]), fabsf(v1[i][0]))); m1 = fmaxf(m1, fmaxf(fabsf(v0[i][1]), fabsf(v1[i][1]))); m2 = fmaxf(m2, fmaxf(fabsf(v0[i][2]), fabsf(v1[i][2]))); m3 = fmaxf(m3, fmaxf(fabsf(v0[i][3]), fabsf(v1[i][3]))); }
    m0 = fmaxf(m0, __shfl_xor(m0, 16)); m1 = fmaxf(m1, __shfl_xor(m1, 16)); m2 = fmaxf(m2, __shfl_xor(m2, 16)); m3 = fmaxf(m3, __shfl_xor(m3, 16));
    m0 = fmaxf(m0, __shfl_xor(m0, 32)); m1 = fmaxf(m1, __shfl_xor(m1, 32)); m2 = fmaxf(m2, __shfl_xor(m2, 32)); m3 = fmaxf(m3, __shfl_xor(m3, 32));
    __syncthreads();
    if (lane < 16) *(LAS f32x4*)(pmax + wave * 64 + 4 * lane) = (f32x4){m0, m1, m2, m3};
    __syncthreads();
    if (tid < 64) { float m = pmax[tid];
#pragma unroll
        for (int w = 1; w < 8; ++w) m = fmaxf(m, pmax[w * 64 + tid]);
        cmf[tid] = m; cmaxbase[r.smax + r.n0 + tid] = m; }
    __syncthreads();
#pragma unroll
    for (int h = 0; h < 2; ++h) {
#pragma unroll
        for (int i = 0; i < 16; ++i) { LAS float* d = scr + (4 * i + (lane >> 4)) * 65 + 4 * (lane & 15); const f32x4 x = h ? v1[i] : v0[i]; d[0] = x[0]; d[1] = x[1]; d[2] = x[2]; d[3] = x[3]; }
        asm volatile("s_waitcnt lgkmcnt(0)" ::: "memory");
        const int kc = lane & 3;
#pragma unroll
        for (int jj = 0; jj < 4; ++jj) { const int n = (lane >> 2) + 16 * jj; const LAS float* s = scr + (16 * kc) * 65 + n;
            const float cm = cmf[n], inv = cm > 0.f ? 127.0f / cm : 0.f;
            v4u o; o.x = pk_i8x4(s[0 * 65] * inv, s[1 * 65] * inv, s[2 * 65] * inv, s[3 * 65] * inv); o.y = pk_i8x4(s[4 * 65] * inv, s[5 * 65] * inv, s[6 * 65] * inv, s[7 * 65] * inv);
            o.z = pk_i8x4(s[8 * 65] * inv, s[9 * 65] * inv, s[10 * 65] * inv, s[11 * 65] * inv); o.w = pk_i8x4(s[12 * 65] * inv, s[13 * 65] * inv, s[14 * 65] * inv, s[15 * 65] * inv);
            const int row = (r.map == 0) ? bt_row_std(r.colbase + r.n0 + n) : bt_row_swiglu(r.n0 + n, r.map - 1);
            *(GAS v4u*)((GAS unsigned char*)r.dst + (size_t)row * r.K + r.k0 + 64 * h + 16 * kc) = o; }
        asm volatile("s_waitcnt lgkmcnt(0)" ::: "memory");
    }
}
__device__ __forceinline__ void phase_prologue(const Args& a, LAS unsigned char* lds, int tid, int lane, int wave) {
    unsigned char* ws = a.ws;
    LAS TJob* jobs = (LAS TJob*)(lds + 8 * 17408);
    build_jobs(a, jobs, tid);
    const int gw = blockIdx.x * NWAVES + wave, NGW = gridDim.x * NWAVES;
    { const int nstrip = jobs[NJOBS].startq; int js = 0;
      for (int st = blockIdx.x; st < nstrip; st += gridDim.x) strip_q8(jobs, js, st, lds, tid, lane, wave, (float*)(ws + WS_SW));
      __syncthreads(); }
    {
        LAS float* scr = (LAS float*)(lds + wave * 17408);
        const int total = jobs[NJOBS].start; int j = 0;
        if (gw < total) {
            TileRef cur, nxt; f32x4 v[16], vn[16];
            tile_decode<false>(jobs, j, gw, cur); tile_load(cur, lane, v);
#pragma unroll 1
            for (int it = gw; it < total; it += NGW) {
                const bool more = it + NGW < total;
                if (more) { tile_decode<false>(jobs, j, it + NGW, nxt); tile_load(nxt, lane, vn); }
                tile_store(cur, lane, v, scr);
                if (more) { cur = nxt;
#pragma unroll
                    for (int i = 0; i < 16; ++i) v[i] = vn[i]; }
            }
        }
    }
#if I8_A
    for (int m = gw; m < T; m += NGW) row_to_i8(a.in[0] + (size_t)m * D, ws + WS_QX + (size_t)m * D, (float*)(ws + WS_SA) + m, lane);
#else
    for (int m = gw; m < T; m += NGW) row_to_bf16_ss(a.in[0] + (size_t)m * D, (bf16_t*)(ws + WS_XB) + (size_t)m * D, (float*)(ws + WS_SS) + (size_t)m * 16, nullptr, lane);
#endif
    for (int m = gw; m < NBATCH * MEML; m += NGW) row_to_bf16_ss(a.in[1] + (size_t)m * D, (bf16_t*)(ws + WS_MEMBF) + (size_t)m * D, (float*)(ws + WS_SSM) + (size_t)m * 16, nullptr, lane);
    {
        float* prm = (float*)(ws + WS_PARAM); const int gt = blockIdx.x * NTHR + tid, NGT = gridDim.x * NTHR;
        for (int i = gt; i < PB_END; i += NGT) { float v;
            if (i < PB_GQ) v = a.in[7][i]; else if (i < PB_GK) v = a.in[8][i - PB_GQ]; else if (i < PB_GOUT) v = a.in[9][i - PB_GK]; else if (i < PB_POOLS) v = a.in[14][i - PB_GOUT];
            else if (i < PB_MQN) v = a.in[16][i - PB_POOLS]; else if (i < PB_MKN) v = a.in[17][i - PB_MQN]; else if (i < PB_GFFN1) v = a.in[18][i - PB_MKN]; else if (i < PB_WR) v = a.in[4][D + i - PB_GFFN1];
            else if (i < PB_POOLW) v = a.in[27][i - PB_WR]; else v = a.in[15][i - PB_POOLW];
            prm[i] = v; }
        bf16_t* pwt = (bf16_t*)(ws + WS_POOLWT);
        for (int i = gt; i < 2 * 4 * 128 * 128; i += NGT) { const int lg = i >> 14, dout = (i >> 7) & 127, cc = i & 127; pwt[i] = (bf16_t)(pk_bf16(a.in[15][((size_t)lg * 128 + cc) * 128 + dout], 0.f) & 0xffffu); }
    }
    if (blockIdx.x == 0 && wave == 0) {
        float* sc = (float*)(ws + WS_SC);
        for (int l = 0; l < 2; ++l) {
            const float a1 = wave_sum(a.in[10][l * 64 + lane] * a.in[11][l * 64 + lane]), a2 = wave_sum(a.in[12][l * 64 + lane] * a.in[13][l * 64 + lane]);
            const float lam0 = (l == 0) ? 0.2f : (0.8f - 0.6f * 0.7408182206817179f);
            const float lam = __expf(a1) - __expf(a2) + lam0;
            float m0 = fabsf(a.in[8][l * 128 + lane] * a.in[9][l * 128 + lane]), m1 = fabsf(a.in[8][l * 128 + 64 + lane] * a.in[9][l * 128 + 64 + lane]);
            float mm = fmaxf(fabsf(a.in[17][l * 128 + lane] * a.in[18][l * 128 + lane]), fabsf(a.in[17][l * 128 + 64 + lane] * a.in[18][l * 128 + 64 + lane]));
#pragma unroll
            for (int o = 1; o < 64; o <<= 1) { m0 = fmaxf(m0, __shfl_xor(m0, o)); m1 = fmaxf(m1, __shfl_xor(m1, o)); mm = fmaxf(mm, __shfl_xor(mm, o)); }
            if (lane == 0) { sc[l * 8 + 0] = lam; sc[l * 8 + 1] = m0 * 64.f * QSCALE; sc[l * 8 + 2] = m1 * 64.f * QSCALE; sc[l * 8 + 3] = mm * 128.f * MEMSCALE; sc[l * 8 + 4] = 1.0f - lam0; }
        }
    }
}

__device__ __forceinline__ void unpack16(const bf16_t* src, float (&f)[16]) {
    const v4u a = *(const v4u*)src, b = *(const v4u*)(src + 8);
    f[0] = bf_lo(a.x); f[1] = bf_hi(a.x); f[2] = bf_lo(a.y); f[3] = bf_hi(a.y); f[4] = bf_lo(a.z); f[5] = bf_hi(a.z); f[6] = bf_lo(a.w); f[7] = bf_hi(a.w);
    f[8] = bf_lo(b.x); f[9] = bf_hi(b.x); f[10] = bf_lo(b.y); f[11] = bf_hi(b.y); f[12] = bf_lo(b.z); f[13] = bf_hi(b.z); f[14] = bf_lo(b.w); f[15] = bf_hi(b.w);
}
template <bool DIFF>
__device__ __forceinline__ void naive_attn_unit(LAS unsigned char* lds, int tid, const bf16_t* Qg, int ldq, const bf16_t* Kg, int ldk, const bf16_t* Vg, int ldv, bf16_t* Og, int ldo,
                                                int ntiles, int qpos0, const float* qmulA, const float* qmulB, const float* qss, float slope2, float bnd0, float bnd1, float lam, const float* gout, float outmul) {
    constexpr int QW = 4;
    LAS float* Lq = (LAS float*)lds; LAS float* Lk = Lq + 32 * 128; LAS float* Lv = Lk + 64 * 129; LAS float* Lp = Lv + 64 * 128; LAS float* Lrk = Lp + 8 * QW * 2 * 64;
    const int lane = tid & 63, wid = tid >> 6, r = tid >> 3, sg = tid & 7;
    __syncthreads();
    if (tid < 256) { float f[16]; unpack16(Qg + (size_t)r * ldq + sg * 16, f); float mul = 1.f;
      if (!DIFF) { const float s = qss[r * 8] + qss[r * 8 + 1]; mul = __builtin_amdgcn_rsqf(s * (1.f / 128.f) + 1e-6f) * MEMSCALE; }
#pragma unroll
      for (int i = 0; i < 16; ++i) Lq[r * 128 + sg * 16 + i] = DIFF ? f[i] : f[i] * mul * qmulA[sg * 16 + i] * qmulB[sg * 16 + i]; }
    float o0[QW][2], o1[QW][2], l0[QW], l1[QW];
#pragma unroll
    for (int q = 0; q < QW; ++q) { o0[q][0] = o0[q][1] = o1[q][0] = o1[q][1] = 0.f; l0[q] = l1[q] = 0.f; }
#pragma unroll 1
    for (int j = 0; j < ntiles; ++j) {
        __syncthreads();
        { float f[16]; unpack16(Kg + (size_t)(j * 64 + r) * ldk + sg * 16, f);
#pragma unroll
          for (int i = 0; i < 16; ++i) Lk[r * 129 + sg * 16 + i] = f[i];
          unpack16(Vg + (size_t)(j * 64 + r) * ldv + sg * 16, f);
#pragma unroll
          for (int i = 0; i < 16; ++i) Lv[r * 128 + sg * 16 + i] = f[i]; }
        __syncthreads();
        if (!DIFF) { if (tid < 64) { float s = 0.f;
#pragma unroll 4
            for (int d = 0; d < 128; ++d) { const float x = Lk[tid * 129 + d]; s += x * x; } Lrk[tid] = __builtin_amdgcn_rsqf(s * (1.f / 128.f) + 1e-6f); } __syncthreads(); }
        float s0[QW], s1[QW];
#pragma unroll
        for (int q = 0; q < QW; ++q) { s0[q] = 0.f; s1[q] = 0.f; }
#pragma unroll 1
        for (int d4 = 0; d4 < 16; ++d4) {
            const float k0 = Lk[lane * 129 + 4 * d4], k1 = Lk[lane * 129 + 4 * d4 + 1], k2 = Lk[lane * 129 + 4 * d4 + 2], k3 = Lk[lane * 129 + 4 * d4 + 3];
            const float e0 = Lk[lane * 129 + 64 + 4 * d4], e1 = Lk[lane * 129 + 64 + 4 * d4 + 1], e2 = Lk[lane * 129 + 64 + 4 * d4 + 2], e3 = Lk[lane * 129 + 64 + 4 * d4 + 3];
#pragma unroll
            for (int q = 0; q < QW; ++q) { const f32x4 qa = *(const LAS f32x4*)&Lq[(wid * QW + q) * 128 + 4 * d4], qb = *(const LAS f32x4*)&Lq[(wid * QW + q) * 128 + 64 + 4 * d4];
                s0[q] += (qa[0] * k0 + qa[1] * k1) + (qa[2] * k2 + qa[3] * k3); s1[q] += (qb[0] * e0 + qb[1] * e1) + (qb[2] * e2 + qb[3] * e3); }
        }
        const int kpos = j * 64 + lane;
#pragma unroll
        for (int q = 0; q < QW; ++q) { float p0, p1;
            if (DIFF) { const int qpos = qpos0 + wid * QW + q; const float bias = -slope2 * fabsf((float)(qpos - kpos)); p0 = __builtin_amdgcn_exp2f(s0[q] + bias - bnd0); p1 = __builtin_amdgcn_exp2f(s1[q] + bias - bnd1); }
            else { p0 = __builtin_amdgcn_exp2f((s0[q] + s1[q]) * Lrk[lane] - bnd0); p1 = 0.f; }
            l0[q] += p0; l1[q] += p1; Lp[((wid * QW + q) * 2 + 0) * 64 + lane] = p0; Lp[((wid * QW + q) * 2 + 1) * 64 + lane] = p1; }
        asm volatile("s_waitcnt lgkmcnt(0)" ::: "memory");
#pragma unroll 1
        for (int k4 = 0; k4 < 16; ++k4) {
            f32x2 v[4];
#pragma unroll
            for (int i = 0; i < 4; ++i) v[i] = *(const LAS f32x2*)&Lv[(4 * k4 + i) * 128 + 2 * lane];
#pragma unroll
            for (int q = 0; q < QW; ++q) { const f32x4 pa = *(const LAS f32x4*)&Lp[((wid * QW + q) * 2 + 0) * 64 + 4 * k4];
                o0[q][0] += (pa[0] * v[0][0] + pa[1] * v[1][0]) + (pa[2] * v[2][0] + pa[3] * v[3][0]); o0[q][1] += (pa[0] * v[0][1] + pa[1] * v[1][1]) + (pa[2] * v[2][1] + pa[3] * v[3][1]);
                if (DIFF) { const f32x4 pb = *(const LAS f32x4*)&Lp[((wid * QW + q) * 2 + 1) * 64 + 4 * k4];
                    o1[q][0] += (pb[0] * v[0][0] + pb[1] * v[1][0]) + (pb[2] * v[2][0] + pb[3] * v[3][0]); o1[q][1] += (pb[0] * v[0][1] + pb[1] * v[1][1]) + (pb[2] * v[2][1] + pb[3] * v[3][1]); } }
        }
    }
#pragma unroll
    for (int q = 0; q < QW; ++q) { const float L0 = wave_sum(l0[q]); float x = o0[q][0] / L0, y = o0[q][1] / L0;
        if (DIFF) { const float L1 = wave_sum(l1[q]); x -= lam * (o1[q][0] / L1); y -= lam * (o1[q][1] / L1);
            const float ss = wave_sum(x * x + y * y); const float rr = __builtin_amdgcn_rsqf(ss * (1.f / 128.f) + 1e-6f) * outmul; x *= rr * gout[2 * lane]; y *= rr * gout[2 * lane + 1]; }
        *(unsigned*)(Og + (size_t)(wid * QW + q) * ldo + 2 * lane) = pk_bf16(x, y); }
}
__device__ __forceinline__ void naive_pool_unit(LAS unsigned char* lds, int tid, const bf16_t* Pg  , bf16_t* Og  , const float* W  , const float* scale  , int tok0, int g) {
    LAS float* Lp = (LAS float*)lds; LAS float* Ld = Lp + 80 * 128;
    const int w = 2 << g, pos0 = tok0 & (SEQ - 1);
    __syncthreads();
    for (int i = tid; i < 80 * 8; i += NTHR) { const int rr = i >> 3, sg = i & 7; const int tpos = pos0 - 16 + rr;
        float f[16];
        if (tpos >= 0) unpack16(Pg + (size_t)(tok0 - 16 + rr) * 512 + g * 128 + sg * 16, f); else {
#pragma unroll
            for (int k = 0; k < 16; ++k) f[k] = 0.f; }
#pragma unroll
        for (int k = 0; k < 16; ++k) Lp[rr * 128 + sg * 16 + k] = f[k]; }
    __syncthreads();
    for (int i = tid; i < 64 * 128; i += NTHR) { const int t = i >> 7, c = i & 127; const int tpos = pos0 + t; const int lo = (tpos + 1 - w) > 0 ? (tpos + 1 - w) : 0; const int cnt = tpos + 1 - lo;
        float s = 0.f;
#pragma unroll 1
        for (int k = 0; k < cnt; ++k) s += Lp[(16 + t - k) * 128 + c];
        Ld[t * 128 + c] = s / (float)cnt - Lp[(16 + t) * 128 + c]; }
    __syncthreads();
    const int dout = tid & 127, tq = tid >> 7; float acc[16];
#pragma unroll
    for (int i = 0; i < 16; ++i) acc[i] = 0.f;
#pragma unroll 2
    for (int c = 0; c < 128; ++c) { const float wv = W[c * 128 + dout];
#pragma unroll
        for (int i = 0; i < 16; ++i) acc[i] += Ld[(tq * 16 + i) * 128 + c] * wv; }
    const float sc = scale[dout];
#pragma unroll
    for (int i = 0; i < 16; ++i) Og[(size_t)(tok0 + tq * 16 + i) * 512 + g * 128 + dout] = (bf16_t)(pk_bf16(acc[i] * sc, 0.f) & 0xffffu);
}

namespace mix {
typedef short bf16x8 __attribute__((ext_vector_type(8)));
typedef short s16x4 __attribute__((ext_vector_type(4)));
typedef float f32x16 __attribute__((ext_vector_type(16)));
typedef const LAS unsigned char* lptr;
#define SBAR() __builtin_amdgcn_sched_barrier(0)
__device__ __forceinline__ unsigned lds_addr(lptr p) { return (unsigned)(uintptr_t)p; }
__device__ __forceinline__ bf16x8 pack8(const f32x16& p, int b) {
    v4u w; w.x = pk_bf16(p[b], p[b + 1]); w.y = pk_bf16(p[b + 2], p[b + 3]); w.z = pk_bf16(p[b + 4], p[b + 5]); w.w = pk_bf16(p[b + 6], p[b + 7]);
    return __builtin_bit_cast(bf16x8, w);
}
__device__ __forceinline__ void glds16(const void* g, LAS unsigned char* l) { __builtin_amdgcn_global_load_lds((const unsigned*)g, (LAS unsigned*)l, 16, 0, 0); }
#define MFMA32(a, b, c) __builtin_amdgcn_mfma_f32_32x32x16_bf16(a, b, c, 0, 0, 0)

#define VRD(set, db) do { _Pragma("unroll") for (int t_ = 0; t_ < 4; ++t_) { \
        asm volatile("ds_read_b64_tr_b16 %0, %1 offset:%c2" : "=&v"(lo[set][t_]) : "v"(va[db]), "i"(t_ * 4096) : "memory"); \
        asm volatile("ds_read_b64_tr_b16 %0, %1 offset:%c2" : "=&v"(hi[set][t_]) : "v"(va[db]), "i"(t_ * 4096 + 2048) : "memory"); } } while (0)
#define VPK(set, t) (bf16x8){lo[set][t][0], lo[set][t][1], lo[set][t][2], lo[set][t][3], hi[set][t][0], hi[set][t][1], hi[set][t][2], hi[set][t][3]}
__device__ __forceinline__ void pv_tile(f32x16 (&O)[4], const unsigned (&va)[4], const bf16x8 (&pb)[4]) {
    s16x4 lo[2][4], hi[2][4];
    VRD(0, 0);
    VRD(1, 1); asm volatile("s_waitcnt lgkmcnt(8)" ::: "memory"); SBAR();
#pragma unroll
    for (int t = 0; t < 4; ++t) O[0] = MFMA32(VPK(0, t), pb[t], O[0]);
    SBAR(); VRD(0, 2); asm volatile("s_waitcnt lgkmcnt(8)" ::: "memory"); SBAR();
#pragma unroll
    for (int t = 0; t < 4; ++t) O[1] = MFMA32(VPK(1, t), pb[t], O[1]);
    SBAR(); VRD(1, 3); asm volatile("s_waitcnt lgkmcnt(8)" ::: "memory"); SBAR();
#pragma unroll
    for (int t = 0; t < 4; ++t) O[2] = MFMA32(VPK(0, t), pb[t], O[2]);
    SBAR(); asm volatile("s_waitcnt lgkmcnt(0)" ::: "memory"); SBAR();
#pragma unroll
    for (int t = 0; t < 4; ++t) O[3] = MFMA32(VPK(1, t), pb[t], O[3]);
}
__device__ __forceinline__ void kread8_swz(bf16x8 (&kf)[8], const unsigned (&ka)[4]) {
#define KRD(i, a, off) asm volatile("ds_read_b128 %0, %1 offset:%c2" : "=&v"(kf[i]) : "v"(a), "i"(off) : "memory")
    KRD(0, ka[0], 0); KRD(1, ka[0], 8192); KRD(2, ka[1], 0); KRD(3, ka[1], 8192); KRD(4, ka[2], 0); KRD(5, ka[2], 8192); KRD(6, ka[3], 0); KRD(7, ka[3], 8192);
#undef KRD
}
__device__ __forceinline__ void kread8(bf16x8 (&kf)[8], unsigned ka) {
#define KRD(i, off) asm volatile("ds_read_b128 %0, %1 offset:%c2" : "=&v"(kf[i]) : "v"(ka), "i"(off) : "memory")
    KRD(0, 0); KRD(1, 512); KRD(2, 2048); KRD(3, 2560); KRD(4, 4096); KRD(5, 4608); KRD(6, 6144); KRD(7, 6656);
#undef KRD
}

__device__ __forceinline__ void da_bias(f32x16& p0, f32x16& p1, int jt, int cq, float xq, float sl2, float B2) {
    const float x = (float)(64 * jt) - xq;
    const float Be = (jt > cq) ? 1.0e30f : B2;
#pragma unroll
    for (int r = 0; r < 16; ++r) { const float kr = (float)((r & 3) + 8 * (r >> 2)); p0[r] = __builtin_fmaf(-sl2, __builtin_fabsf(x + kr), -Be); p1[r] = __builtin_fmaf(-sl2, __builtin_fabsf(x + (32.f + kr)), -Be); }
}
__device__ __forceinline__ void diffattn_unit(LAS unsigned char* lds, int tid, const bf16_t* Qg, const bf16_t* Kg, const bf16_t* Vg, bf16_t* Og, int b, int h, int u, bool desc, float sl2, float B2, float lam, const float* gout, float outmul) {
    asm volatile("" : "+v"(tid));
    const int lane = tid & 63, wid = __builtin_amdgcn_readfirstlane(tid >> 6), map = wid >> 2, wi = wid & 3, r32 = lane & 31, hi = lane >> 5;
    const int q0 = u * 128 + wi * 32, cq = q0 >> 6, NT = 2 * u + 2;
    const size_t rowb = (size_t)b * SEQ;
    const bf16_t* qrow = Qg + (rowb + q0 + r32) * 1024 + h * 128;
    bf16x8 qf[4];
#pragma unroll
    for (int s = 0; s < 4; ++s) qf[s] = *(const bf16x8*)(qrow + map * 64 + s * 16 + hi * 8);
    unsigned koff[2], voff[2];
#pragma unroll
    for (int i = 0; i < 2; ++i) { const int row = 4 * (2 * wid + i) + (lane >> 4), slot = lane & 15;
        koff[i] = (unsigned)(row * 1024 + ((slot ^ (row & 15)) * 8));
        voff[i] = (unsigned)(row * 1024 + (((slot >> 2) ^ (row & 3)) * 32 + (slot & 3) * 8)); }
    const bf16_t* Kbh = Kg + rowb * 1024 + h * 128; const bf16_t* Vbh = Vg + rowb * 1024 + h * 128;
#define JT(i) (desc ? NT - 1 - (i) : (i))
#define DA_DMA(i) do { const int j_ = JT(i), sl_ = (i) & 3; _Pragma("unroll") for (int i_ = 0; i_ < 2; ++i_) { \
        glds16(Kbh + (size_t)j_ * 65536 + koff[i_], lds + sl_ * 32768 + (2 * wid + i_) * 1024); \
        glds16(Vbh + (size_t)j_ * 65536 + voff[i_], lds + sl_ * 32768 + 16384 + (2 * wid + i_) * 1024); } } while (0)
    f32x16 O[4];
#pragma unroll
    for (int db = 0; db < 4; ++db)
#pragma unroll
        for (int r = 0; r < 16; ++r) O[db][r] = 0.f;
    float lsum = 0.f;
    const float xq = (float)(q0 + r32 - 4 * hi);
    unsigned ka_0, va_0;
    { const unsigned l0 = lds_addr((lptr)lds); const int qp = (lane & 15) >> 2;
      ka_0 = l0 + r32 * 256 + (((map * 8 + hi) ^ (r32 & 15)) << 4);
      va_0 = l0 + 16384 + (4 * hi + qp) * 256 + (qp << 6) + ((lane >> 4) & 1) * 32 + (lane & 3) * 8; }
    __syncthreads();
    asm volatile("" : "+v"(qf[0]), "+v"(qf[1]), "+v"(qf[2]), "+v"(qf[3]));
    DA_DMA(0); DA_DMA(1);
    if (NT > 2) { DA_DMA(2); asm volatile("s_waitcnt vmcnt(4)" ::: "memory"); } else asm volatile("s_waitcnt vmcnt(0)" ::: "memory");
    __builtin_amdgcn_s_barrier();
    f32x16 pA0, pA1, pB0, pB1;
    { da_bias(pA0, pA1, JT(0), cq, xq, sl2, B2);
      unsigned ka[4];
#pragma unroll
      for (int s = 0; s < 4; ++s) ka[s] = ka_0 ^ (s << 5);
      bf16x8 kf[8]; kread8_swz(kf, ka); asm volatile("s_waitcnt lgkmcnt(0)" ::: "memory"); SBAR();
#pragma unroll
      for (int s = 0; s < 4; ++s) { pA0 = MFMA32(kf[2 * s], qf[s], pA0); pA1 = MFMA32(kf[2 * s + 1], qf[s], pA1); }
      asm volatile("s_nop 15\n\ts_nop 15" : "+v"(pA0), "+v"(pA1)); }
    da_bias(pB0, pB1, JT(1), cq, xq, sl2, B2);
#define SM4(P, b_) do { P[b_] = __builtin_amdgcn_exp2f(P[b_]); P[b_ + 1] = __builtin_amdgcn_exp2f(P[b_ + 1]); P[b_ + 2] = __builtin_amdgcn_exp2f(P[b_ + 2]); P[b_ + 3] = __builtin_amdgcn_exp2f(P[b_ + 3]); \
        lsum += (P[b_] + P[b_ + 1]) + (P[b_ + 2] + P[b_ + 3]); } while (0)
#define MFMA_A(acc, a_, b_) asm volatile("v_mfma_f32_32x32x16_bf16 %0, %1, %2, %0" : "+v"(acc) : "v"(a_), "v"(b_))
#define PIN(x_) asm volatile("" : "+v"(x_))
#define FMK(dst, krv) do { float f_; asm volatile("v_fmamk_f32 %0, %1, %c2, %3" : "=v"(f_) : "v"(sl2), "i"(__builtin_bit_cast(int, (float)(krv))), "v"(c0_)); dst = f_; } while (0)
#define FM2(C0, C1, j) do { FMK(C0[j], ((j) & 3) + 8 * ((j) >> 2)); FMK(C1[j], 32 + ((j) & 3) + 8 * ((j) >> 2)); } while (0)
#define DA_STEP(C0, C1, N0, N1, i) do { \
        if ((i) + 3 < NT) DA_DMA((i) + 3); \
        bf16x8 pb[4]; \
        { unsigned ka[4]; _Pragma("unroll") for (int s_ = 0; s_ < 4; ++s_) ka[s_] = (ka_0 + (((i) + 1) & 3) * 32768) ^ (s_ << 5); \
          bf16x8 kf[8]; kread8_swz(kf, ka); asm volatile("s_waitcnt lgkmcnt(0)" ::: "memory"); \
          MFMA_A(N0, kf[0], qf[0]); SM4(C0, 0);  PIN(C0); PIN(lsum); \
          MFMA_A(N1, kf[1], qf[0]); SM4(C0, 4);  PIN(C0); PIN(lsum); \
          MFMA_A(N0, kf[2], qf[1]); SM4(C0, 8);  PIN(C0); PIN(lsum); pb[0] = pack8(C0, 0); PIN(pb[0]); \
          MFMA_A(N1, kf[3], qf[1]); SM4(C0, 12); PIN(C0); PIN(lsum); pb[1] = pack8(C0, 8); PIN(pb[1]); \
          MFMA_A(N0, kf[4], qf[2]); SM4(C1, 0);  PIN(C1); PIN(lsum); \
          MFMA_A(N1, kf[5], qf[2]); SM4(C1, 4);  PIN(C1); PIN(lsum); \
          MFMA_A(N0, kf[6], qf[3]); SM4(C1, 8);  PIN(C1); PIN(lsum); pb[2] = pack8(C1, 0); PIN(pb[2]); \
          MFMA_A(N1, kf[7], qf[3]); SM4(C1, 12); PIN(C1); PIN(lsum); pb[3] = pack8(C1, 8); PIN(pb[3]); } \
        { unsigned va[4]; _Pragma("unroll") for (int d_ = 0; d_ < 4; ++d_) va[d_] = (va_0 + ((i) & 3) * 32768) ^ (d_ << 6); \
          s16x4 lo[2][4], hi[2][4]; \
          const int jt2_ = JT((i) + 2); \
          float c0_ = __builtin_fmaf(sl2s, (float)(64 * jt2_) - xq, (jt2_ > cq) ? -1.0e30f : -B2); PIN(c0_); \
          VRD(0, 0); VRD(1, 1); asm volatile("s_waitcnt lgkmcnt(8)" ::: "memory"); \
          _Pragma("unroll") for (int t_ = 0; t_ < 4; ++t_) { const bf16x8 vf_ = VPK(0, t_); MFMA_A(O[0], vf_, pb[t_]); FM2(C0, C1, t_); } \
          VRD(0, 2); asm volatile("s_waitcnt lgkmcnt(8)" ::: "memory"); \
          _Pragma("unroll") for (int t_ = 0; t_ < 4; ++t_) { const bf16x8 vf_ = VPK(1, t_); MFMA_A(O[1], vf_, pb[t_]); FM2(C0, C1, 4 + t_); } \
          VRD(1, 3); asm volatile("s_waitcnt lgkmcnt(8)" ::: "memory"); \
          _Pragma("unroll") for (int t_ = 0; t_ < 4; ++t_) { const bf16x8 vf_ = VPK(0, t_); MFMA_A(O[2], vf_, pb[t_]); FM2(C0, C1, 8 + t_); } \
          asm volatile("s_waitcnt lgkmcnt(0)" ::: "memory"); \
          _Pragma("unroll") for (int t_ = 0; t_ < 4; ++t_) { const bf16x8 vf_ = VPK(1, t_); MFMA_A(O[3], vf_, pb[t_]); FM2(C0, C1, 12 + t_); } \
          PIN(C0); PIN(C1); \
          if (jt2_ == cq) { da_bias(C0, C1, jt2_, cq, xq, sl2, B2); PIN(C0); PIN(C1); } } \
        if ((i) + 3 < NT) asm volatile("s_waitcnt vmcnt(4) lgkmcnt(0)" ::: "memory"); else asm volatile("s_waitcnt vmcnt(0) lgkmcnt(0)" ::: "memory"); \
        __builtin_amdgcn_s_barrier(); \
    } while (0)
    const float sl2s = __builtin_bit_cast(float, __builtin_amdgcn_readfirstlane(__builtin_bit_cast(int, sl2)));
#pragma unroll 1
    for (int i = 0; i < NT; i += 2) {
        DA_STEP(pA0, pA1, pB0, pB1, i);
        DA_STEP(pB0, pB1, pA0, pA1, i + 1);
    }
#undef DA_STEP
#undef FM2
#undef FMK
#undef MFMA_A
#undef PIN
#undef SM4
    asm volatile("s_nop 15\n\ts_nop 15" : "+v"(O[0]), "+v"(O[1]), "+v"(O[2]), "+v"(O[3]));
#undef DA_DMA
#undef JT
    lsum += __shfl_xor(lsum, 32);
    const float inv = 1.0f / lsum;
    LAS f32x4* xch = (LAS f32x4*)(lds + wi * 16384) + lane;
    if (map == 1) {
        const float f = lam * inv;
#pragma unroll
        for (int db = 0; db < 4; ++db)
#pragma unroll
            for (int g = 0; g < 4; ++g) xch[(db * 4 + g) * 64] = (f32x4){O[db][4 * g] * f, O[db][4 * g + 1] * f, O[db][4 * g + 2] * f, O[db][4 * g + 3] * f};
    }
    __syncthreads();
    if (map == 0) {
        float ss = 0.f;
#pragma unroll
        for (int db = 0; db < 4; ++db)
#pragma unroll
            for (int g = 0; g < 4; ++g) { const f32x4 o1 = xch[(db * 4 + g) * 64];
#pragma unroll
                for (int i = 0; i < 4; ++i) { const float v = O[db][4 * g + i] * inv - o1[i]; O[db][4 * g + i] = v; ss += v * v; } }
        ss += __shfl_xor(ss, 32);
        const float rr = __builtin_amdgcn_rsqf(ss * (1.f / 128.f) + 1e-6f) * outmul;
        bf16_t* orow = Og + (rowb + q0 + r32) * 1024 + h * 128 + 4 * hi;
#pragma unroll
        for (int db = 0; db < 4; ++db)
#pragma unroll
            for (int g = 0; g < 4; ++g) { const f32x4 gv = *(const f32x4*)(gout + 32 * db + 8 * g + 4 * hi);
                const unsigned w0 = pk_bf16(O[db][4 * g] * rr * gv[0], O[db][4 * g + 1] * rr * gv[1]), w1 = pk_bf16(O[db][4 * g + 2] * rr * gv[2], O[db][4 * g + 3] * rr * gv[3]);
                *(unsigned long long*)(orow + 32 * db + 8 * g) = (unsigned long long)w0 | ((unsigned long long)w1 << 32); }
    }
    __syncthreads();
}

__device__ __forceinline__ void memattn_unit(LAS unsigned char* lds, int tid, bf16_t* MQg, bf16_t* Og, const bf16_t* KVg, const float* mqss, const float* qn, const float* kn, int pm, int hd, float Bm) {
    const int lane = tid & 63, wid = __builtin_amdgcn_readfirstlane(tid >> 6), r32 = lane & 31, hi = lane >> 5;
    const int b = pm >> 3; const size_t row = (size_t)pm * 256 + wid * 32 + r32;
    __syncthreads();
#pragma unroll
    for (int i = 0; i < 8; ++i) { const int p = 8 * wid + i, vrow = 4 * p + (lane >> 4), slot = lane & 15;
        glds16(KVg + ((size_t)b * MEML + vrow) * 2048 + 512 + hd * 128 + (((slot >> 2) ^ (vrow & 3)) * 32 + (slot & 3) * 8), lds + 65536 + p * 1024); }
    { const int key = tid >> 1, half = tid & 1; const bf16_t* src = KVg + ((size_t)b * MEML + key) * 2048 + hd * 128 + half * 64;
      v4u raw[8]; float s = 0.f;
#pragma unroll
      for (int c = 0; c < 8; ++c) { raw[c] = *(const v4u*)(src + c * 8);
          const float a0 = bf_lo(raw[c].x), a1 = bf_hi(raw[c].x), a2 = bf_lo(raw[c].y), a3 = bf_hi(raw[c].y), a4 = bf_lo(raw[c].z), a5 = bf_hi(raw[c].z), a6 = bf_lo(raw[c].w), a7 = bf_hi(raw[c].w);
          s += ((a0 * a0 + a1 * a1) + (a2 * a2 + a3 * a3)) + ((a4 * a4 + a5 * a5) + (a6 * a6 + a7 * a7)); }
      s += __shfl_xor(s, 1);
      const float rk = __builtin_amdgcn_rsqf(s * (1.f / 128.f) + 1e-6f) * MEMSCALE;
#pragma unroll
      for (int c = 0; c < 8; ++c) { const int d0 = half * 64 + c * 8; const f32x4 qa = *(const f32x4*)(qn + d0), qb = *(const f32x4*)(qn + d0 + 4), ka = *(const f32x4*)(kn + d0), kb = *(const f32x4*)(kn + d0 + 4);
          v4u w; w.x = pk_bf16(bf_lo(raw[c].x) * rk * qa[0] * ka[0], bf_hi(raw[c].x) * rk * qa[1] * ka[1]); w.y = pk_bf16(bf_lo(raw[c].y) * rk * qa[2] * ka[2], bf_hi(raw[c].y) * rk * qa[3] * ka[3]);
          w.z = pk_bf16(bf_lo(raw[c].z) * rk * qb[0] * kb[0], bf_hi(raw[c].z) * rk * qb[1] * kb[1]); w.w = pk_bf16(bf_lo(raw[c].w) * rk * qb[2] * kb[2], bf_hi(raw[c].w) * rk * qb[3] * kb[3]);
          *(LAS v4u*)(lds + (key >> 6) * 16384 + (half * 8 + c) * 1024 + (key & 63) * 16) = w; } }
    const bf16_t* qrow = MQg + row * 512 + hd * 128;
    bf16x8 qf[8];
#pragma unroll
    for (int s = 0; s < 8; ++s) qf[s] = *(const bf16x8*)(qrow + s * 16 + hi * 8);
    const float rq = __builtin_amdgcn_rsqf((mqss[row * 8 + hd * 2] + mqss[row * 8 + hd * 2 + 1]) * (1.f / 128.f) + 1e-6f);
    f32x16 O[4];
#pragma unroll
    for (int db = 0; db < 4; ++db)
#pragma unroll
        for (int r = 0; r < 16; ++r) O[db][r] = 0.f;
    float lsum = 0.f;
    const lptr kl0 = (lptr)lds + hi * 1024 + r32 * 16;
    unsigned va0[4];
    { const int qp = (lane & 15) >> 2;
#pragma unroll
      for (int db = 0; db < 4; ++db) va0[db] = lds_addr((lptr)lds) + 65536 + (4 * hi + qp) * 256 + ((db ^ qp) * 64) + ((lane >> 4) & 1) * 32 + (lane & 3) * 8; }
    __syncthreads();
#pragma unroll 1
    for (int tl = 0; tl < 4; ++tl) {
        f32x16 p0, p1;
#pragma unroll
        for (int r = 0; r < 16; ++r) { p0[r] = 0.f; p1[r] = 0.f; }
        bf16x8 kf[8], kg[8]; kread8(kf, lds_addr(kl0) + tl * 16384); kread8(kg, lds_addr(kl0) + tl * 16384 + 8192);
        asm volatile("s_waitcnt lgkmcnt(8)" ::: "memory"); SBAR();
#pragma unroll
        for (int s = 0; s < 4; ++s) { p0 = MFMA32(kf[2 * s], qf[s], p0); p1 = MFMA32(kf[2 * s + 1], qf[s], p1); }
        SBAR(); asm volatile("s_waitcnt lgkmcnt(0)" ::: "memory"); SBAR();
#pragma unroll
        for (int s = 0; s < 4; ++s) { p0 = MFMA32(kg[2 * s], qf[4 + s], p0); p1 = MFMA32(kg[2 * s + 1], qf[4 + s], p1); }
#pragma unroll
        for (int r = 0; r < 16; ++r) { p0[r] = __builtin_amdgcn_exp2f(__builtin_fmaf(p0[r], rq, -Bm)); p1[r] = __builtin_amdgcn_exp2f(__builtin_fmaf(p1[r], rq, -Bm)); lsum += p0[r] + p1[r]; }
        bf16x8 pb[4]; pb[0] = pack8(p0, 0); pb[1] = pack8(p0, 8); pb[2] = pack8(p1, 0); pb[3] = pack8(p1, 8);
        unsigned va[4];
#pragma unroll
        for (int db = 0; db < 4; ++db) va[db] = va0[db] + tl * 16384;
        pv_tile(O, va, pb);
    }
    lsum += __shfl_xor(lsum, 32);
    const float inv = 1.0f / lsum;
    bf16_t* orow = Og + row * 512 + hd * 128 + 4 * hi;
#pragma unroll
    for (int db = 0; db < 4; ++db)
#pragma unroll
        for (int g = 0; g < 4; ++g) { const unsigned w0 = pk_bf16(O[db][4 * g] * inv, O[db][4 * g + 1] * inv), w1 = pk_bf16(O[db][4 * g + 2] * inv, O[db][4 * g + 3] * inv);
            *(unsigned long long*)(orow + 32 * db + 8 * g) = (unsigned long long)w0 | ((unsigned long long)w1 << 32); }
}

__device__ __forceinline__ void pool_unit(LAS unsigned char* lds, int tid, const bf16_t* Pg, bf16_t* Og, const bf16_t* Wt, const float* scale, int tok0, int g) {
    const int lane = tid & 63, wid = __builtin_amdgcn_readfirstlane(tid >> 6), r32 = lane & 31, hi = lane >> 5;
    LAS unsigned char* Lp = lds; LAS unsigned char* Ld = lds + 272 * 256;
    const int w = 2 << g, pos0 = tok0 & (SEQ - 1);
    bf16x8 wf[4][8];
#pragma unroll
    for (int db = 0; db < 4; ++db)
#pragma unroll
        for (int s = 0; s < 8; ++s) wf[db][s] = *(const bf16x8*)(Wt + (size_t)(32 * db + r32) * 128 + hi * 8 + s * 16);
    __syncthreads();
    { v4u st[9];
#pragma unroll
      for (int k = 0; k < 9; ++k) { const int i = tid + k * NTHR, ii = i < 272 * 16 ? i : tid, rr = ii >> 4, ch = ii & 15; const bool ok = pos0 - 16 + rr >= 0;
          const v4u v = *(const v4u*)(Pg + (size_t)(tok0 - 16 + (ok ? rr : 16)) * 512 + g * 128 + ch * 8); st[k].x = ok ? v.x : 0u; st[k].y = ok ? v.y : 0u; st[k].z = ok ? v.z : 0u; st[k].w = ok ? v.w : 0u; }
#pragma unroll
      for (int k = 0; k < 9; ++k) { const int i = tid + k * NTHR, rr = i >> 4, ch = i & 15; if (i < 272 * 16) *(LAS v4u*)(Lp + rr * 256 + ch * 16) = st[k]; } }
    __syncthreads();
    { const int ch = tid & 15, t0 = (tid >> 4) * 8;
      float s[8];
#pragma unroll
      for (int i = 0; i < 8; ++i) s[i] = 0.f;
#pragma unroll 1
      for (int k = 1; k < w; ++k) { const v4u v = *(const LAS v4u*)(Lp + (16 + t0 - k) * 256 + ch * 16);
          s[0] += bf_lo(v.x); s[1] += bf_hi(v.x); s[2] += bf_lo(v.y); s[3] += bf_hi(v.y); s[4] += bf_lo(v.z); s[5] += bf_hi(v.z); s[6] += bf_lo(v.w); s[7] += bf_hi(v.w); }
#pragma unroll
      for (int tt = 0; tt < 8; ++tt) { const int t = t0 + tt, tpos = pos0 + t; const int cnt = (tpos + 1 < w) ? (tpos + 1) : w; const float ic = 1.0f / (float)cnt;
          const v4u v = *(const LAS v4u*)(Lp + (16 + t) * 256 + ch * 16), o = *(const LAS v4u*)(Lp + (16 + t - w + 1) * 256 + ch * 16);
          float p[8] = {bf_lo(v.x), bf_hi(v.x), bf_lo(v.y), bf_hi(v.y), bf_lo(v.z), bf_hi(v.z), bf_lo(v.w), bf_hi(v.w)};
          float q[8] = {bf_lo(o.x), bf_hi(o.x), bf_lo(o.y), bf_hi(o.y), bf_lo(o.z), bf_hi(o.z), bf_lo(o.w), bf_hi(o.w)};
          float d[8];
#pragma unroll
          for (int i = 0; i < 8; ++i) { s[i] += p[i]; d[i] = s[i] * ic - p[i]; s[i] -= q[i]; }
          v4u wv; wv.x = pk_bf16(d[0], d[1]); wv.y = pk_bf16(d[2], d[3]); wv.z = pk_bf16(d[4], d[5]); wv.w = pk_bf16(d[6], d[7]);
          *(LAS v4u*)(Ld + t * 256 + ((ch ^ (t & 15)) << 4)) = wv; } }
    __syncthreads();
    const int tok = wid * 32 + r32;
    bf16x8 df[8];
#pragma unroll
    for (int s = 0; s < 8; ++s) df[s] = *(const LAS bf16x8*)(Ld + tok * 256 + (((2 * s + hi) ^ (tok & 15)) << 4));
    bf16_t* orow = Og + (size_t)(tok0 + tok) * 512 + g * 128 + 4 * hi;
#pragma unroll
    for (int db = 0; db < 4; ++db) {
        f32x16 acc;
#pragma unroll
        for (int r = 0; r < 16; ++r) acc[r] = 0.f;
#pragma unroll
        for (int s = 0; s < 8; ++s) acc = MFMA32(wf[db][s], df[s], acc);
#pragma unroll
        for (int gq = 0; gq < 4; ++gq) { const f32x4 sc = *(const f32x4*)(scale + 32 * db + 8 * gq + 4 * hi);
            const unsigned w0 = pk_bf16(acc[4 * gq] * sc[0], acc[4 * gq + 1] * sc[1]), w1 = pk_bf16(acc[4 * gq + 2] * sc[2], acc[4 * gq + 3] * sc[3]);
            *(unsigned long long*)(orow + 32 * db + 8 * gq) = (unsigned long long)w0 | ((unsigned long long)w1 << 32); }
    }
}
#undef MFMA32
#undef VRD
#undef VPK
#undef SBAR
}

#ifndef MIX_NAIVE_DA
#define MIX_NAIVE_DA 0
#endif
#ifndef MIX_NAIVE_MEM
#define MIX_NAIVE_MEM 0
#endif
#ifndef MIX_NAIVE_POOL
#define MIX_NAIVE_POOL 0
#endif
__device__ __forceinline__ void phase_mixers(unsigned char* ws, LAS unsigned char* lds, int l, int tid) {
    const float* prm = (const float*)(ws + WS_PARAM); const float* sc = (const float*)(ws + WS_SC) + l * 8;
    const float lam = ld_f32_agent(sc + 0), bnd0 = ld_f32_agent(sc + 1), bnd1 = ld_f32_agent(sc + 2), bndm = ld_f32_agent(sc + 3), omul = ld_f32_agent(sc + 4);
    const int bx = blockIdx.x, vcu = (gridDim.x == 256) ? ((bx & 7) * 32 + (bx >> 3)) : bx;
    bf16_t* Q = (bf16_t*)(ws + WS_Q); const bf16_t* K = (const bf16_t*)(ws + WS_K); const bf16_t* V = (const bf16_t*)(ws + WS_V);
    bf16_t* MQ = (bf16_t*)(ws + WS_MQ); const bf16_t* KV = (const bf16_t*)(ws + WS_MEMKV) + l * 1024;     const float* mqss = (const float*)(ws + WS_MQSS);
#if MIX_NAIVE_DA
    for (int u = blockIdx.x; u < 4096; u += gridDim.x) { const int hc = 63 - (u >> 6), c = hc >> 1, bh = u & 63, b = bh >> 3, h = bh & 7;
        const size_t rowb = (size_t)b * SEQ; const float slope2 = exp2f(-(float)(h + 1)) * LOG2E;
        naive_attn_unit<true>(lds, tid, Q + (rowb + hc * 32) * 1024 + h * 128, 1024, K + rowb * 1024 + h * 128, 1024, V + rowb * 1024 + h * 128, 1024, (bf16_t*)(ws + WS_XB) + (rowb + hc * 32) * 1024 + h * 128, 1024,
                              c + 1, hc * 32, nullptr, nullptr, nullptr, slope2, bnd0, bnd1, lam, prm + PB_GOUT + l * 128, omul); }
#else
    {
        const float B2 = fmaxf(bnd0, bnd1);
        for (int rep_ = 0; rep_ < REP_DA; ++rep_)
        for (int w = vcu; w < 256; w += gridDim.x) { const int bh = w >> 2, s = w & 3, b = bh >> 3, h = bh & 7; const float sl2 = exp2f(-(float)(h + 1)) * LOG2E;
#pragma unroll 1
            for (int i = 0; i < 4; ++i) { const int u = (i == 0) ? 15 - s : (i == 1) ? 8 + s : (i == 2) ? 7 - s : s;
                mix::diffattn_unit(lds, tid, Q, K, V, (bf16_t*)(ws + WS_XB), b, h, u, (i & 1) != 0, sl2, B2, lam, prm + PB_GOUT + l * 128, omul); } }
    }
#endif
#if MIX_NAIVE_MEM
    for (int u = blockIdx.x; u < 2048; u += gridDim.x) { const int qt = u >> 2, hd = u & 3, b = qt >> 6; const size_t row0 = (size_t)qt * 32;
        naive_attn_unit<false>(lds, tid, MQ + row0 * 512 + hd * 128, 512, KV + (size_t)b * MEML * 2048 + hd * 128, 2048, KV + (size_t)b * MEML * 2048 + 512 + hd * 128, 2048, MQ + row0 * 512 + hd * 128, 512,
                               4, 0, prm + PB_MQN + l * 128, prm + PB_MKN + l * 128, mqss + row0 * 8 + hd * 2, 0.f, bndm, 0.f, 0.f, nullptr, 1.f); }
#else
    for (int rep_ = 0; rep_ < REP_MEM; ++rep_)
    for (int w = vcu; w < 256; w += gridDim.x) mix::memattn_unit(lds, tid, MQ, (rep_ + 1 < REP_MEM) ? (bf16_t*)(ws + WS_OPOOL) : MQ, KV, mqss, prm + PB_MQN + l * 128, prm + PB_MKN + l * 128, w >> 2, w & 3, bndm);
#endif
#if MIX_NAIVE_POOL
    for (int u = blockIdx.x; u < 1024; u += gridDim.x) { const int tt = u >> 2, g = u & 3;
        naive_pool_unit(lds, tid, (const bf16_t*)(ws + WS_P), (bf16_t*)(ws + WS_OPOOL), prm + PB_POOLW + (size_t)(l * 4 + g) * 128 * 128, prm + PB_POOLS + l * 512 + g * 128, tt * 64, g); }
#else
    for (int rep_ = 0; rep_ < REP_POOL; ++rep_)
    for (int w = vcu; w < 256; w += gridDim.x) { const int pm = w >> 2, g = w & 3;
        mix::pool_unit(lds, tid, (const bf16_t*)(ws + WS_P), (bf16_t*)(ws + WS_OPOOL), (const bf16_t*)(ws + WS_POOLWT) + (size_t)(l * 4 + g) * 128 * 128, prm + PB_POOLS + l * 512 + g * 128, pm * 256, g); }
#endif
}

__device__ __forceinline__ void phase_route(unsigned char* ws, const bf16_t* xin, LAS unsigned char* lds, int tid, int lane, int wave) {
    const float* gffn = (const float*)(ws + WS_PARAM) + PB_GFFN1; const float* wr = (const float*)(ws + WS_PARAM) + PB_WR;
    unsigned* cnt = (unsigned*)ws + CW_CNT; int* toke = (int*)(ws + WS_TOKE); int* tokp = (int*)(ws + WS_TOKP); float* tokg = (float*)(ws + WS_TOKG); float* tokr = (float*)(ws + WS_TOKR);
    LAS unsigned* lcnt = (LAS unsigned*)lds; LAS unsigned* lbase = lcnt + 8; LAS int* linfo = (LAS int*)(lds + 64);
    const int per = T / gridDim.x;
    for (int c0 = 0; c0 < per; c0 += 64) {
        __syncthreads();
        if (tid < 8) lcnt[tid] = 0u;
        __syncthreads();
        for (int i = wave; i < 64 && c0 + i < per; i += NWAVES) {
            const int t = blockIdx.x * per + c0 + i;
            f32x4 v[4]; ld16_bf16(xin + (size_t)t * D + 16 * lane, v); float s = 0.f;
#pragma unroll
            for (int j = 0; j < 4; ++j) s += (v[j][0] * v[j][0] + v[j][1] * v[j][1]) + (v[j][2] * v[j][2] + v[j][3] * v[j][3]);
            const float rstd = __builtin_amdgcn_rsqf(wave_sum(s) * (1.f / 1024.f) + 1e-6f);
            float lg[8];
#pragma unroll
            for (int e = 0; e < 8; ++e) lg[e] = 0.f;
#pragma unroll
            for (int j = 0; j < 4; ++j)
#pragma unroll
                for (int k4 = 0; k4 < 4; ++k4) { const int k = 16 * lane + 4 * j + k4; const float xg = v[j][k4] * gffn[k]; const f32x4 w0 = *(const f32x4*)(wr + k * 8), w1 = *(const f32x4*)(wr + k * 8 + 4);
                    lg[0] += xg * w0[0]; lg[1] += xg * w0[1]; lg[2] += xg * w0[2]; lg[3] += xg * w0[3]; lg[4] += xg * w1[0]; lg[5] += xg * w1[1]; lg[6] += xg * w1[2]; lg[7] += xg * w1[3]; }
#pragma unroll
            for (int e = 0; e < 8; ++e) lg[e] = wave_sum(lg[e]) * rstd;
            int i0 = 0; float b0 = lg[0];
#pragma unroll
            for (int e = 1; e < 8; ++e) if (lg[e] > b0) { b0 = lg[e]; i0 = e; }
            int i1 = -1; float b1 = -3.0e38f;
#pragma unroll
            for (int e = 0; e < 8; ++e) if (e != i0 && lg[e] > b1) { b1 = lg[e]; i1 = e; }
            const float g0 = 1.f / (1.f + __expf(b1 - b0)), g1 = 1.f - g0;
            if (lane == 0) { const unsigned p0 = __hip_atomic_fetch_add(lcnt + i0, 1u, __ATOMIC_RELAXED, __HIP_MEMORY_SCOPE_WORKGROUP), p1 = __hip_atomic_fetch_add(lcnt + i1, 1u, __ATOMIC_RELAXED, __HIP_MEMORY_SCOPE_WORKGROUP);
                linfo[i * 4 + 0] = i0; linfo[i * 4 + 1] = i1; linfo[i * 4 + 2] = (int)p0; linfo[i * 4 + 3] = (int)p1;
                toke[2 * t] = i0; toke[2 * t + 1] = i1; tokg[2 * t] = g0; tokg[2 * t + 1] = g1; tokr[t] = rstd; }
        }
        __syncthreads();
        if (tid < 8) lbase[tid] = lcnt[tid] ? atomicAdd(cnt + 64 * tid, lcnt[tid]) : 0u;
        __syncthreads();
        if (tid < 64 && c0 + tid < per) { const int t = blockIdx.x * per + c0 + tid; tokp[2 * t] = (int)lbase[linfo[tid * 4 + 0]] + linfo[tid * 4 + 2]; tokp[2 * t + 1] = (int)lbase[linfo[tid * 4 + 1]] + linfo[tid * 4 + 3]; }
    }
}
__device__ __forceinline__ void build_texp(unsigned char* ws, LAS int* texp, int tid) {
    const unsigned* cnt = (const unsigned*)ws + CW_CNT;
    __syncthreads();
    if (tid == 0) { int tb = 0; for (int e = 0; e < NEXP; ++e) { texp[160 + e] = tb; const int n = (int)__hip_atomic_load(cnt + 64 * e, RLX_AGENT); const int nt = (n + 255) >> 8; for (int i = 0; i < nt; ++i) texp[tb + i] = e; tb += nt; } texp[168] = tb; texp[169] = tb; }
    __syncthreads();
}
__device__ __forceinline__ void phase_gather(unsigned char* ws, const bf16_t* xin, LAS int* texp, int lane, int wave) {
    const int* toke = (const int*)(ws + WS_TOKE); const int* tokp = (const int*)(ws + WS_TOKP); const float* tokr = (const float*)(ws + WS_TOKR);
    unsigned char* xg = ws + WS_XGY; float* xgrs = (float*)(ws + WS_XGRS);
    const int gw = blockIdx.x * NWAVES + wave, NGW = gridDim.x * NWAVES;
    for (int t = gw; t < T; t += NGW) {
        f32x4 v[4]; ld16_bf16(xin + (size_t)t * D + 16 * lane, v); float mx = 0.f;
#pragma unroll
        for (int j = 0; j < 4; ++j) { mx = fmaxf(mx, fmaxf(fmaxf(fabsf(v[j][0]), fabsf(v[j][1])), fmaxf(fabsf(v[j][2]), fabsf(v[j][3])))); }
#pragma unroll
        for (int o = 1; o < 64; o <<= 1) mx = fmaxf(mx, __shfl_xor(mx, o));
        const float inv = mx > 0.f ? 127.0f / mx : 0.f, rs = mx * (1.0f / 127.0f) * tokr[t];
        v4u w; w.x = pk_i8x4(v[0][0] * inv, v[0][1] * inv, v[0][2] * inv, v[0][3] * inv); w.y = pk_i8x4(v[1][0] * inv, v[1][1] * inv, v[1][2] * inv, v[1][3] * inv);
        w.z = pk_i8x4(v[2][0] * inv, v[2][1] * inv, v[2][2] * inv, v[2][3] * inv); w.w = pk_i8x4(v[3][0] * inv, v[3][1] * inv, v[3][2] * inv, v[3][3] * inv);
#pragma unroll
        for (int k = 0; k < 2; ++k) { const int e = toke[2 * t + k], p = tokp[2 * t + k]; const size_t row = (size_t)texp[160 + e] * 256 + p;
            *((v4u*)(xg + row * D) + lane) = w; if (lane == 0) xgrs[row] = rs; }
    }
}
__device__ __forceinline__ void phase_combine(unsigned char* ws, const bf16_t* xs, float* dst, LAS int* texp, int lane, int wave) {
    const int* toke = (const int*)(ws + WS_TOKE); const int* tokp = (const int*)(ws + WS_TOKP); const float* tokg = (const float*)(ws + WS_TOKG);
    const bf16_t* Y = (const bf16_t*)(ws + WS_Y);
    const int gw = blockIdx.x * NWAVES + wave, NGW = gridDim.x * NWAVES;
    for (int t = gw; t < T; t += NGW) {
        const size_t r0 = (size_t)texp[160 + toke[2 * t]] * 256 + tokp[2 * t], r1 = (size_t)texp[160 + toke[2 * t + 1]] * 256 + tokp[2 * t + 1]; const float g0 = tokg[2 * t], g1 = tokg[2 * t + 1];
        f32x4 xv[4]; ld16_bf16(xs + (size_t)t * D + 16 * lane, xv);
        const v4u* y0 = (const v4u*)(Y + r0 * D) + 2 * lane; const v4u* y1 = (const v4u*)(Y + r1 * D) + 2 * lane;
#pragma unroll
        for (int h = 0; h < 2; ++h) { const v4u p = y0[h], q = y1[h]; f32x4 xa = xv[2 * h], xc = xv[2 * h + 1];
            xa[0] += g0 * bf_lo(p.x) + g1 * bf_lo(q.x); xa[1] += g0 * bf_hi(p.x) + g1 * bf_hi(q.x); xa[2] += g0 * bf_lo(p.y) + g1 * bf_lo(q.y); xa[3] += g0 * bf_hi(p.y) + g1 * bf_hi(q.y);
            xc[0] += g0 * bf_lo(p.z) + g1 * bf_lo(q.z); xc[1] += g0 * bf_hi(p.z) + g1 * bf_hi(q.z); xc[2] += g0 * bf_lo(p.w) + g1 * bf_lo(q.w); xc[3] += g0 * bf_hi(p.w) + g1 * bf_hi(q.w);
            f32x4* xw = (f32x4*)(dst + (size_t)t * D) + 4 * lane; xw[2 * h] = xa; xw[2 * h + 1] = xc; }
    }
}

#define GEMM_PHASE(EPI, g, S, E) do { S.prep(); __syncthreads(); pg8::gemm_phase<EPI, pg8::Sched2, true, true>(lds, g, S, E); } while (0)
__global__ void __launch_bounds__(NTHR, 2) fwd_kernel(Args args) {
    extern __shared__ __attribute__((aligned(16))) unsigned char lds_raw[];
    LAS unsigned char* lds = (LAS unsigned char*)lds_raw;
    volatile LAS unsigned* MISC = (volatile LAS unsigned*)(lds + MISC_OFF);
    LAS float* rstab = (LAS float*)(lds + RS_OFF); LAS int* texp = (LAS int*)(lds + TEXP_OFF);
    unsigned char* const ws0 = args.ws; int G = gridDim.x, bx = blockIdx.x;
#define PHASE_BEGIN() size_t z_ = 0; asm volatile("" : "+s"(z_), "+s"(G), "+s"(bx)); unsigned char* ws = args.ws + z_; float* out = args.out + z_; int tid = threadIdx.x; asm volatile("" : "+v"(tid)); const int lane = tid & 63, wave = __builtin_amdgcn_readfirstlane(tid >> 6); (void)lane; (void)wave; (void)out
    if (threadIdx.x < 64) MISC[threadIdx.x] = 0u;
    __syncthreads();
    XcdBarrier bar; bar.bar = (unsigned*)ws0 + CW_BAR; bar.x = 0; bar.st = nullptr;
    const int lo = args.ph_lo, hi = args.ph_hi;
    if (MK_N_LAUNCHES == 1 && hi - lo > 1) bar = xcd_barrier_post((unsigned*)ws0 + CW_BAR, MISC + 8);
#define IN(k) (lo <= (k) && (k) < hi)
#define SEAM(k) do { if (IN(k) && IN((k) + 1)) { size_t zb_ = 0; asm volatile("" : "+s"(zb_)); bar.bar = (unsigned*)args.ws + CW_BAR + zb_; xcd_barrier(bar); } } while (0)

    if (IN(0)) { PHASE_BEGIN(); phase_prologue(args, lds, tid, lane, wave); }
    SEAM(0);
    if (IN(0) && IN(2)) {}
    if (IN(2)) { PHASE_BEGIN();
        pg8::Gemm g{(const bf16_t*)(ws + WS_MEMBF), (const bf16_t*)(ws + WS_WMEMKV), NBATCH * MEML, 2048, D};
        pg8::Sched2 S; S.init2(g.M, g.N, G, bx, rstab); S.rsrc = (const float*)(ws + WS_SSM); S.rmode = 1;
        pg8::EpiStore<true> E{(bf16_t*)(ws + WS_MEMKV), 2048, rstab};
        GEMM_PHASE(pg8::EpiStore<true>, g, S, E);
        __syncthreads();
    }
    SEAM(2);
    for (int l = 0; l < 2; ++l) {
        const int pb = l == 0 ? 3 : 11;
        if (IN(pb)) { for (int rep_ = 0; rep_ < REP_A; ++rep_) { PHASE_BEGIN();
#if I8_A
            pg8::Gemm g{(const bf16_t*)(ws + WS_QX), (const bf16_t*)(ws + WS_W1T + (size_t)l * 14 * MiB), T, NGEMM1, D / 2};
            pg8::Sched2 S; S.init2(T, NGEMM1, G, bx, rstab); S.rsrc = (const float*)(ws + WS_SA); S.rmode = 2; S.wgm = 4;
            pg8::EpiA<true> E{ws, l, rstab};
            GEMM_PHASE(pg8::EpiA<true>, g, S, E); __syncthreads(); }
#else
            pg8::Gemm g{(const bf16_t*)(ws + WS_XB), (const bf16_t*)(ws + WS_W1T + (size_t)l * 14 * MiB), T, NGEMM1, D};
            pg8::Sched2 S; S.init2(T, NGEMM1, G, bx, rstab); S.rsrc = (const float*)(ws + WS_SS); S.rmode = 1; S.wgm = 4;
            pg8::EpiA<false> E{ws, l, rstab};
            GEMM_PHASE(pg8::EpiA<false>, g, S, E); __syncthreads(); }
#endif
        }
        SEAM(pb);
        if (IN(pb + 1)) { PHASE_BEGIN(); phase_mixers(ws, lds, l, tid); }
        SEAM(pb + 1);
        if (IN(pb + 2)) { for (int rep_ = 0; rep_ < REP_C; ++rep_) { PHASE_BEGIN();
            { pg8::Gemm g{(const bf16_t*)(ws + WS_XB), (const bf16_t*)(ws + WS_WBRDA + (size_t)l * 2 * MiB), T, D, 1024}; pg8::Sched2 S; S.init2(T, D, G, bx, rstab);
              pg8::EpiBr0 E{ws}; GEMM_PHASE(pg8::EpiBr0, g, S, E); }
            __syncthreads(); { size_t z2_ = 0; asm volatile("" : "+s"(z2_), "+s"(G), "+s"(bx)); ws = args.ws + z2_; }
            { pg8::Gemm g{(const bf16_t*)(ws + WS_OPOOL), (const bf16_t*)(ws + WS_WBRPOOL + (size_t)l * 1 * MiB), T, D, 512}; pg8::Sched2 S; S.init2(T, D, G, bx, rstab);
              S.chain = 2; S.A2 = (const bf16_t*)(ws + WS_MQ); S.B2 = (const bf16_t*)(ws + WS_WBRMEM + (size_t)l * 1 * MiB);
              pg8::EpiBrC E{ws}; GEMM_PHASE(pg8::EpiBrC, g, S, E); } __syncthreads(); }
        }
        SEAM(pb + 2);
        if (IN(pb + 3)) { PHASE_BEGIN();
            pg8::Gemm g{(const bf16_t*)(ws + WS_Q), (const bf16_t*)(ws + WS_WOUT + (size_t)l * 2 * MiB), T, D, D}; pg8::Sched2 S; S.init2(T, D, G, bx, rstab);
            pg8::EpiResB E{l == 0 ? (const float*)(args.in[0] + z_) : (const float*)nullptr, (bf16_t*)(ws + WS_XS)};
            GEMM_PHASE(pg8::EpiResB, g, S, E); __syncthreads();
        }
        SEAM(pb + 3);
        if (l == 0) {
            if (IN(7) && I8_E) { PHASE_BEGIN(); phase_quant_rows((const bf16_t*)(ws + WS_XS), ws, lane, wave); }
            SEAM(7);
            if (IN(8)) { for (int rep_ = 0; rep_ < REP_E; ++rep_) { PHASE_BEGIN();
#if I8_E
                pg8::Gemm g{(const bf16_t*)(ws + WS_QX), (const bf16_t*)(ws + WS_WFF13), T, 2 * FFD, D / 2}; pg8::Sched2 S; S.init2(T, 2 * FFD, G, bx, rstab); S.rsrc = (const float*)(ws + WS_SA); S.rmode = 2; S.wgm = 4;
                pg8::EpiSwiglu<true> E{(bf16_t*)(ws + WS_HFF), FFD, rstab, (const float*)(ws + WS_SW) + SW_FF, FFD, nullptr, 0};
                GEMM_PHASE(pg8::EpiSwiglu<true>, g, S, E); __syncthreads(); }
#else
                pg8::Gemm g{(const bf16_t*)(ws + WS_X1B), (const bf16_t*)(ws + WS_WFF13), T, 2 * FFD, D}; pg8::Sched2 S; S.init2(T, 2 * FFD, G, bx, rstab); S.rsrc = (const float*)(ws + WS_SS); S.rmode = 1; S.wgm = 4;
                pg8::EpiSwiglu<false> E{(bf16_t*)(ws + WS_HFF), FFD, rstab, nullptr, 0, nullptr, 0};
                GEMM_PHASE(pg8::EpiSwiglu<false>, g, S, E); __syncthreads(); }
#endif
            }
            SEAM(8);
            if (IN(9)) { PHASE_BEGIN();
                pg8::Gemm g{(const bf16_t*)(ws + WS_HFF), (const bf16_t*)(ws + WS_WFF2), T, D, FFD}; pg8::Sched2 S; S.init2(T, D, G, bx, rstab);
                pg8::EpiResB E{nullptr, (bf16_t*)(ws + WS_XS)};
                GEMM_PHASE(pg8::EpiResB, g, S, E); __syncthreads();
            }
            SEAM(9);
            if (IN(10) && I8_A) { PHASE_BEGIN(); phase_quant_rows((const bf16_t*)(ws + WS_XS), ws, lane, wave); }
            SEAM(10);
        }
    }
    if (IN(15)) { PHASE_BEGIN(); phase_route(ws, (const bf16_t*)(ws + WS_XS), lds, tid, lane, wave); }
    SEAM(15);
    if (IN(16)) { PHASE_BEGIN(); build_texp(ws, texp, tid); phase_gather(ws, (const bf16_t*)(ws + WS_XS), texp, lane, wave); }
    SEAM(16);
    for (int k = 0; k < 4; ++k) {
        if (IN(17 + k)) { PHASE_BEGIN();
            build_texp(ws, texp, tid);
            const int ntot = texp[169];
            const int kd = k - 1, ku = k;
            int ntd = 0, ntu = 0;
            if (kd >= 0) { ntd = ntot - MOE_CH * kd; const int cap = (kd == 2) ? MOE_CHL : MOE_CH; ntd = ntd < 0 ? 0 : (ntd > cap ? cap : ntd); }
            if (ku <= 2) { ntu = ntot - MOE_CH * ku; const int cap = (ku == 2) ? MOE_CHL : MOE_CH; ntu = ntu < 0 ? 0 : (ntu > cap ? cap : ntu); }
            const int nX = ntd * 4, nU = ntu * 28;
            const bool mixed = (nX > 0 && nU > 0);
            const int tf = (nU + 7 * nX) / 256, rem = (nU + 7 * nX) - 256 * tf;
            const bool weighted = mixed && tf >= 7 && nX <= 256 && G == 256;
            if (nX > 0) {
                const int t0 = MOE_CH * kd;
                pg8::Gemm g{(const bf16_t*)(ws + WS_HCH + (size_t)(kd & 1) * HCH_BYTES), (const bf16_t*)(ws + WS_WMOE2), ntd * 256, D, FFE};
                pg8::Sched2 S; S.init2(ntd * 256, D, G, bx, rstab); S.texp = texp; S.estride = (size_t)7 * MiB; S.t0 = t0;
                if (weighted) { const int vc = (bx & 7) * 32 + (bx >> 3); S.rng = 1; S.rng_start = vc; S.rng_cnt = (vc < nX) ? 1 : 0; }
                pg8::EpiStore<false> E{(bf16_t*)(ws + WS_Y) + (size_t)t0 * 256 * D, D, rstab};
                for (int rep_ = 0; rep_ < REP_DN; ++rep_) { GEMM_PHASE(pg8::EpiStore<false>, g, S, E); __syncthreads(); }
            }
            if (nU > 0) {
                size_t z3_ = 0; asm volatile("" : "+s"(z3_), "+s"(G), "+s"(bx)); ws = args.ws + z3_;
                const int t0 = MOE_CH * ku;
                pg8::Gemm g{(const bf16_t*)(ws + WS_XGY + (size_t)t0 * 256 * D), (const bf16_t*)(ws + WS_WMOE13), ntu * 256, 2 * FFE, D / 2};
                pg8::Sched2 S; S.init2(ntu * 256, 2 * FFE, G, bx, rstab); S.rsrc = (const float*)(ws + WS_XGRS); S.rmode = 2; S.rrow0 = t0 * 256; S.texp = texp; S.estride = (size_t)7 * MiB; S.t0 = t0;
                if (weighted) { const int vc = (bx & 7) * 32 + (bx >> 3); const int cmin = vc < nX ? vc : nX, over = vc - (256 - rem); S.rng = 1; S.rng_start = vc * tf - 7 * cmin + (over > 0 ? over : 0); S.rng_cnt = tf - (vc < nX ? 7 : 0) + (vc >= 256 - rem ? 1 : 0); }
                pg8::EpiSwiglu<true> E{(bf16_t*)(ws + WS_HCH + (size_t)(ku & 1) * HCH_BYTES), FFE, rstab, (const float*)(ws + WS_SW) + SW_MOE, FFE, texp, t0};
                for (int rep_ = 0; rep_ < REP_UP; ++rep_) { GEMM_PHASE(pg8::EpiSwiglu<true>, g, S, E); __syncthreads(); }
            }
        }
        SEAM(17 + k);
    }
    if (IN(21)) { PHASE_BEGIN(); build_texp(ws, texp, tid); phase_combine(ws, (const bf16_t*)(ws + WS_XS), out, texp, lane, wave); }
#undef IN
#undef SEAM
}

extern "C" void kernel_launch(void* const* d_in, const int* in_sizes, int n_in, void* d_out, int out_size, void* d_ws, size_t ws_size, hipStream_t stream) {
    static int grid = 0;
    if (grid == 0) {
        if (n_in != 31 || out_size != T * D || ws_size < WS_END) { fprintf(stderr, "kernel_launch: unexpected problem (n_in %d, out %d, ws %zu < %zu)\n", n_in, out_size, ws_size, (size_t)WS_END); grid = -1; return; }
        int dev = 0, cus = 0, per_cu = 0;
        if (hipGetDevice(&dev) != hipSuccess || hipDeviceGetAttribute(&cus, hipDeviceAttributeMultiprocessorCount, dev) != hipSuccess) { grid = -1; return; }
        if (hipFuncSetAttribute((const void*)fwd_kernel, hipFuncAttributeMaxDynamicSharedMemorySize, LDS_BYTES) != hipSuccess) { fprintf(stderr, "kernel_launch: hipFuncSetAttribute failed\n"); grid = -1; return; }
        if (hipOccupancyMaxActiveBlocksPerMultiprocessor(&per_cu, (const void*)fwd_kernel, NTHR, LDS_BYTES) != hipSuccess || per_cu < 1) { fprintf(stderr, "kernel_launch: occupancy query says %d\n", per_cu); grid = -1; (void)hipGetLastError(); return; }
        grid = cus;
    }
    if (grid < 0) return;
    if (hipMemsetAsync(d_ws, 0, CTL_ZERO_BYTES, stream) != hipSuccess) return;
    Args a{};
    for (int i = 0; i < 31; ++i) a.in[i] = (const float*)d_in[i];
    a.out = (float*)d_out; a.ws = (unsigned char*)d_ws;
#ifdef PROBE_EXTRA_PROLOGUE
    a.ph_lo = 0; a.ph_hi = 1; hipLaunchKernelGGL(fwd_kernel, dim3(grid), dim3(NTHR), LDS_BYTES, stream, a);
#endif
#ifdef PROBE_EXTRA_PHASE
#ifndef PROBE_EXTRA_REPS
#define PROBE_EXTRA_REPS 1
#endif
    for (int r_ = 0; r_ < PROBE_EXTRA_REPS; ++r_) { a.ph_lo = PROBE_EXTRA_PHASE; a.ph_hi = PROBE_EXTRA_PHASE + 1; hipLaunchKernelGGL(fwd_kernel, dim3(grid), dim3(NTHR), LDS_BYTES, stream, a); }
#endif
    if (MK_N_LAUNCHES == 1) { a.ph_lo = 0; a.ph_hi = NPH; hipLaunchKernelGGL(fwd_kernel, dim3(grid), dim3(NTHR), LDS_BYTES, stream, a); }
    else for (int p = 0; p < NPH; ++p) { a.ph_lo = p; a.ph_hi = p + 1; hipLaunchKernelGGL(fwd_kernel, dim3(grid), dim3(NTHR), LDS_BYTES, stream, a); }
}
```

```cpp
#include <hip/hip_runtime.h>
#include <cstdio>
#include <cstdint>
#define MK_N_LAUNCHES 1
#ifndef USE_I8
#define USE_I8 1
#endif
#ifndef I8_A
#define I8_A 1
#endif
#ifndef I8_E
#define I8_E 1
#endif
#ifndef REP_MEM
#define REP_MEM 1
#endif
#ifndef REP_D
#define REP_D 1
#endif
#ifndef REP_F
#define REP_F 1
#endif
#ifndef REP_Z
#define REP_Z 1
#endif
#ifndef REP_E
#define REP_E 1
#endif
#ifndef REP_DN
#define REP_DN 1
#endif
#ifndef REP_MG
#define REP_MG 1
#endif
#ifndef REP_POOL
#define REP_POOL 1
#endif
#ifndef REP_GA
#define REP_GA 1
#endif
#ifndef REP_PRO
#define REP_PRO 1
#endif
#ifndef REP_A
#define REP_A 1
#endif
#ifndef REP_DA
#define REP_DA 1
#endif
#ifndef REP_C
#define REP_C 1
#endif
#ifndef REP_UP
#define REP_UP 1
#endif

constexpr int NWAVES = 8, NTHR = 512;
constexpr int T = 16384, D = 1024, SEQ = 2048, NBATCH = 8, MEML = 256;
constexpr int NGEMM1 = 7168, FFD = 2816, FFE = 3584, NEXP = 8;
constexpr float LOG2E = 1.4426950408889634f;
constexpr float QSCALE = 0.125f * LOG2E;
constexpr float MEMSCALE = 0.08838834764831845f * LOG2E;
#ifndef MK_N_LAUNCHES
#define MK_N_LAUNCHES 1
#endif
constexpr int NPH = 22;
constexpr int MOE_CH = 45, MOE_CHL = 46;

constexpr size_t MiB = 1u << 20;
constexpr size_t CTL_ZERO_BYTES = 1 * MiB;
constexpr size_t WS_SS = 1 * MiB;
constexpr size_t WS_MQSS = 2 * MiB;
constexpr size_t WS_SSM = 2 * MiB + 512 * 1024;
constexpr size_t WS_TOKE = WS_SSM + 128 * 1024;
constexpr size_t WS_TOKP = WS_TOKE + 128 * 1024;
constexpr size_t WS_TOKG = WS_TOKP + 128 * 1024;
constexpr size_t WS_TOKR = WS_TOKG + 128 * 1024;
constexpr size_t WS_SC = WS_TOKR + 64 * 1024;
constexpr size_t WS_XGRS = WS_SC + 4096;
constexpr size_t WS_PARAM = 3 * MiB + 256 * 1024;
constexpr int PB_BGATE = 0, PB_GQ = 6144, PB_GK = 6400, PB_GOUT = 6656, PB_POOLS = 6912, PB_MQN = 7936, PB_MKN = 8192, PB_GFFN1 = 8448, PB_WR = 9472, PB_POOLW = 17664, PB_END = 17664 + 131072;
constexpr size_t WS_W1T = 4 * MiB;
constexpr size_t WS_WMEMKV = 32 * MiB;
constexpr size_t WS_WBRDA = 36 * MiB;
constexpr size_t WS_WBRPOOL = 40 * MiB;
constexpr size_t WS_WBRMEM = 42 * MiB;
constexpr size_t WS_WOUT = 44 * MiB;
constexpr size_t WS_WFF13 = 48 * MiB;
constexpr size_t WS_WFF2 = 59 * MiB;
constexpr size_t WS_SW = WS_WFF13 + 6 * MiB;
constexpr int SW_G1 = 0, SW_FF = 2 * 7168, SW_MOE = SW_FF + 2 * 2816, SW_W2 = SW_MOE + 8 * 2 * 3584, SW_END = SW_W2 + 9 * 1024;
constexpr float H8_SCALE = 8.0f;
constexpr int DNW = 3;
constexpr size_t SW_BYTES = (size_t)SW_END * 4;
constexpr size_t WS_WMOE13 = 65 * MiB;
constexpr size_t WS_XS = WS_WMOE13 + 56 * MiB;
constexpr size_t WS_WMOE2 = 177 * MiB;
constexpr size_t WS_XB = 233 * MiB;
constexpr size_t WS_QX = WS_XB, WS_SA = 1 * MiB;
constexpr size_t WS_MEMKV = 265 * MiB;
constexpr size_t WS_R = 273 * MiB;
constexpr size_t WS_Q = WS_R, WS_K = WS_R + 32 * MiB, WS_V = WS_R + 64 * MiB, WS_P = WS_R + 96 * MiB, WS_MQ = WS_R + 112 * MiB, WS_OPOOL = WS_R + 128 * MiB, WS_G = WS_R + 144 * MiB, WS_MEMBF = WS_R + 240 * MiB, WS_POOLWT = WS_R + 244 * MiB;
constexpr size_t WS_MF = WS_K, WS_X1B = WS_K, WS_HFF = WS_R + 144 * MiB;
constexpr size_t WS_XGY = WS_MEMKV;
constexpr size_t WS_Y = WS_XGY + 34 * MiB;
constexpr size_t WS_HCH = WS_Y + 68 * MiB, HCH_BYTES = (size_t)MOE_CHL * 256 * 7168;
constexpr size_t WS_END = 529 * MiB;
static_assert(WS_XGRS + 34816 * 4 <= WS_PARAM && WS_PARAM + (size_t)PB_END * 4 <= WS_W1T && WS_HCH + 2 * HCH_BYTES <= WS_END && WS_SW + SW_BYTES <= WS_WFF2, "d_ws map");
constexpr int CW_CNT = 64;
constexpr int CW_BAR = 4096;

constexpr int RING_BYTES = 131072;
constexpr int RS_OFF = 131072, RS_UNITS = 16;
constexpr int TEXP_OFF = RS_OFF + RS_UNITS * 1024;
constexpr int LDS_BYTES = 155648;
constexpr int MISC_OFF = LDS_BYTES - 256;

namespace pg8 {
#define PG8_LAS __attribute__((address_space(3)))
typedef unsigned short bf16_t;
typedef short bf16x8 __attribute__((ext_vector_type(8)));
typedef float f32x4 __attribute__((ext_vector_type(4)));
typedef unsigned u32x4 __attribute__((ext_vector_type(4)));
constexpr int BM = 256, BK = 64, HALF = 128, HTB = HALF * BK * 2  , STAGE_BYTES = 8 * HTB, NXCD = 8, WGM = 8;

__host__ __device__ __forceinline__ int lds_byte(int r, int c) { const int st = (r >> 4) * 2 + (c >> 5), rr = r & 15, cc = c & 31, ob = rr * 64 + cc * 2; return st * 1024 + (ob ^ (((ob >> 9) & 1) << 5)); }
__host__ __device__ __forceinline__ void stage_rc(int b, int& R, int& C) { const int st = b / 1024, sb = b % 1024, swz = sb ^ (((sb >> 9) & 1) << 5); R = (st >> 1) * 16 + swz / 64; C = (st & 1) * 32 + (swz % 64) / 2; }
__host__ __device__ __forceinline__ int perm32(int rho) { const int n = rho >> 4, i = rho & 15; return 8 * (i >> 2) + 4 * n + (i & 3); }

struct Unit { int pm, pn, idx; };
struct Gemm { const bf16_t* A; const bf16_t* Bt; int M, N, K; };

struct StaticOrder {
    int nM, nN, nwg, G, c, wgm;
    __host__ __device__ void init(int M, int N, int G_, int c_) { nM = M / BM; nN = N / BM; nwg = nM * nN; G = G_; c = c_; wgm = WGM; }
    __host__ __device__ bool next(int i, Unit& u) const {
        const long L = (long)i * G + c; if (L >= nwg) return false;
        int wgid = (int)L; { const int q = nwg / NXCD, r = nwg % NXCD, xcd = wgid % NXCD, off = wgid / NXCD; wgid = (xcd < r ? xcd * (q + 1) : r * (q + 1) + (xcd - r) * q) + off; }
        const int nig = wgm * nN, gid = wgid / nig, fm = gid * wgm, gsz = (nM - fm) < wgm ? (nM - fm) : wgm;
        u.pm = fm + ((wgid % nig) % gsz); u.pn = (wgid % nig) / gsz; u.idx = i; return true;
    }
    __device__ __forceinline__ const char* bptr(const Gemm& g, const Unit& u, size_t tstep) const { return (const char*)g.Bt + (size_t)u.pn * tstep; }
    __device__ __forceinline__ const char* aptr(const Gemm& g, const Unit& u, size_t tstep) const { return (const char*)g.A + (size_t)u.pm * tstep; }
    __device__ __forceinline__ void a_ready(const Unit&) const {}
    __device__ __forceinline__ void done(const Unit&) const {}
};


typedef float f32x2 __attribute__((ext_vector_type(2)));
typedef __bf16 bf16x2_t __attribute__((ext_vector_type(2)));
__device__ __forceinline__ unsigned pk_bf16(float lo, float hi) { f32x2 v = {lo, hi}; bf16x2_t b = __builtin_convertvector(v, bf16x2_t); return __builtin_bit_cast(unsigned, b); }
__device__ __forceinline__ u32x4 pk8(const f32x4 a, const f32x4 b) { u32x4 w; w.x = pk_bf16(a[0], a[1]); w.y = pk_bf16(a[2], a[3]); w.z = pk_bf16(b[0], b[1]); w.w = pk_bf16(b[2], b[3]); return w; }
__device__ __forceinline__ float bf_lo(unsigned w) { return __builtin_bit_cast(float, w << 16); }
__device__ __forceinline__ float bf_hi(unsigned w) { return __builtin_bit_cast(float, w & 0xffff0000u); }
__device__ __forceinline__ float sigmoid_f(float x) { return __builtin_amdgcn_rcpf(1.0f + __builtin_amdgcn_exp2f(-1.4426950408889634f * x)); }
typedef int i32x8 __attribute__((ext_vector_type(8)));
typedef int i32x4 __attribute__((ext_vector_type(4)));
__device__ __forceinline__ f32x4 mma_f8(const i32x8 a, const i32x8 b, f32x4 c) { const int one = 0x7f7f7f7f; asm volatile("v_mfma_scale_f32_16x16x128_f8f6f4 %0, %1, %2, %0, %3, %3 op_sel_hi:[0,0,0]" : "+v"(c) : "v"(a), "v"(b), "v"(one)); return c; }
__device__ __forceinline__ unsigned pk_fp8x4(float a, float b, float c, float d) { int w = __builtin_amdgcn_cvt_pk_fp8_f32(a, b, 0, false); w = __builtin_amdgcn_cvt_pk_fp8_f32(c, d, w, true); return (unsigned)w; }
constexpr float RMS_EPS = 1e-6f;
typedef int i32x4 __attribute__((ext_vector_type(4)));
template <bool I8> __device__ __forceinline__ f32x4 mma16(const bf16x8 a, const bf16x8 b, const f32x4 c) {
    if constexpr (I8) return __builtin_bit_cast(f32x4, __builtin_amdgcn_mfma_i32_16x16x64_i8(__builtin_bit_cast(i32x4, a), __builtin_bit_cast(i32x4, b), __builtin_bit_cast(i32x4, c), 0, 0, 0));
    else return __builtin_amdgcn_mfma_f32_16x16x32_bf16(a, b, c, 0, 0, 0);
}
template <bool I8> __device__ __forceinline__ f32x4 accf(const f32x4 a) {
    if constexpr (I8) { const i32x4 v = __builtin_bit_cast(i32x4, a); return (f32x4){(float)v[0], (float)v[1], (float)v[2], (float)v[3]}; } else return a;
}


struct Sched2 : StaticOrder {
    const float* rsrc; int rmode;
    int rrow0;
    PG8_LAS float* rtab;
    const PG8_LAS int* texp; size_t estride; int t0;
    int rng, rng_start, rng_cnt;
    const bf16_t* A2; const bf16_t* B2; int chain;
    __device__ __forceinline__ void init2(int M, int N, int G_, int c_, PG8_LAS float* tab) { init(M, N, G_, c_); rsrc = nullptr; rmode = 0; rrow0 = 0; rtab = tab; texp = nullptr; estride = 0; t0 = 0; A2 = nullptr; B2 = nullptr; chain = 0; rng = 0; rng_start = 0; rng_cnt = 0; }
    __device__ __forceinline__ bool next(int i, Unit& u) const {
        if (rng != 0) { if (i >= rng_cnt) return false; const int q = rng_start + i; u.pm = q / nN; u.pn = q - u.pm * nN; u.idx = i; return true; }
        if (chain == 0) return StaticOrder::next(i, u); if (i >= chain || !StaticOrder::next(0, u)) return false; u.idx = i; return true; }
    __device__ __forceinline__ const char* aptr(const Gemm& g, const Unit& u, size_t tstep) const { return (const char*)((chain != 0 && u.idx == 1) ? A2 : g.A) + (size_t)u.pm * tstep; }
    __device__ __forceinline__ const char* bptr(const Gemm& g, const Unit& u, size_t tstep) const {
        const char* b = (const char*)((chain != 0 && u.idx == 1) ? B2 : g.Bt) + (size_t)u.pn * tstep;
        if (texp) b += (size_t)texp[t0 + u.pm] * estride;
        return b;
    }
    __device__ __forceinline__ void a_ready(const Unit&) const {}
    __device__ __forceinline__ void prep() const {
        if (rmode == 0) return;
        int tid = threadIdx.x; asm volatile("" : "+v"(tid));
        if (tid < 256) {
            Unit u;
#pragma unroll 1
            for (int i = 0; i < 16 && next(i, u); ++i) {
                const size_t row = (size_t)rrow0 + (size_t)u.pm * 256 + tid; float sc;
                if (rmode == 1) { const f32x4* p = (const f32x4*)(rsrc + row * 16); const f32x4 a = p[0], b = p[1], c = p[2], d = p[3];
                    const float s = ((a[0] + a[1]) + (a[2] + a[3])) + ((b[0] + b[1]) + (b[2] + b[3])) + ((c[0] + c[1]) + (c[2] + c[3])) + ((d[0] + d[1]) + (d[2] + d[3]));
                    sc = __builtin_amdgcn_rsqf(s * (1.0f / 1024.0f) + RMS_EPS); }
                else sc = rsrc[row];
                rtab[i * 256 + tid] = sc;
            }
        }
    }
    __device__ __forceinline__ void done(const Unit&) const {}
};

template <bool RS> struct EpiStore {
    static constexpr bool PERM = false, AFTER_DRAIN = false, I8 = false, F8 = false;
    bf16_t* O; int ldc; const PG8_LAS float* rs;
    __device__ __forceinline__ void operator()(const f32x4 (&acc)[2][2][4][2], const Unit& u, int wr, int wc, int fr, int fq) const {
        const int rl = wr * 64 + fr; const size_t row0 = (size_t)u.pm * BM + rl; const int col0 = u.pn * BM + 64 * wc + 8 * fq;
#pragma unroll
        for (int ai = 0; ai < 2; ++ai)
#pragma unroll
            for (int m = 0; m < 4; ++m) { const float sc = RS ? rs[u.idx * 256 + rl + ai * HALF + m * 16] : 1.f; bf16_t* rowp = O + (row0 + ai * HALF + m * 16) * ldc + col0;
#pragma unroll
                for (int bj = 0; bj < 2; ++bj) *(u32x4*)(rowp + 32 * bj) = pk8(acc[ai][bj][m][0] * sc, acc[ai][bj][m][1] * sc); }
    }
};

template <bool I8_> struct EpiA {
    static constexpr bool PERM = false, AFTER_DRAIN = false, I8 = I8_, F8 = false;
    unsigned char* ws; int l; const PG8_LAS float* rs;
    __device__ __forceinline__ void operator()(const f32x4 (&acc)[2][2][4][2], const Unit& u, int wr, int wc, int fr, int fq) const {
        const int pn = u.pn, rl = wr * 64 + fr; const size_t row0 = (size_t)u.pm * BM + rl; const PG8_LAS float* rsp = rs + u.idx * 256 + rl;
        const float* prm = (const float*)(ws + WS_PARAM);
        f32x4 cw[2][2];
#pragma unroll
        for (int bj = 0; bj < 2; ++bj)
#pragma unroll
            for (int n = 0; n < 2; ++n) { if constexpr (I8_) cw[bj][n] = *(const f32x4*)((const float*)(ws + WS_SW) + SW_G1 + l * 7168 + pn * 256 + 64 * wc + 32 * bj + 8 * fq + 4 * n) * (1.0f / 127.0f); else cw[bj][n] = (f32x4){1.f, 1.f, 1.f, 1.f}; }
#define EA_V(ai, bj, m, n) (accf<I8_>(acc[ai][bj][m][n]) * cw[bj][n])
        if (pn < 8) {
            const bool isq = pn < 4; const float* gg = prm + (isq ? PB_GQ : PB_GK) + l * 128 + (wc & 1) * 64 + 8 * fq; const float mul = isq ? QSCALE : 1.f;
            f32x4 gv[2][2];
#pragma unroll
            for (int bj = 0; bj < 2; ++bj)
#pragma unroll
                for (int n = 0; n < 2; ++n) gv[bj][n] = *(const f32x4*)(gg + 32 * bj + 4 * n);
            bf16_t* base = (bf16_t*)(ws + (isq ? WS_Q : WS_K)) + (pn & 3) * 256 + 64 * wc + 8 * fq;
#pragma unroll
            for (int ai = 0; ai < 2; ++ai)
#pragma unroll
                for (int m = 0; m < 4; ++m) { const float sc = rsp[ai * HALF + m * 16];
                    f32x4 v[2][2]; float ss = 0.f;
#pragma unroll
                    for (int bj = 0; bj < 2; ++bj)
#pragma unroll
                        for (int n = 0; n < 2; ++n) { v[bj][n] = EA_V(ai, bj, m, n) * sc; const f32x4 x = v[bj][n]; ss += (x[0] * x[0] + x[1] * x[1]) + (x[2] * x[2] + x[3] * x[3]); }
                    ss += __shfl_xor(ss, 16); ss += __shfl_xor(ss, 32);
                    const float r = __builtin_amdgcn_rsqf(ss * (1.0f / 64.0f) + RMS_EPS) * mul;
                    bf16_t* rowp = base + (row0 + ai * HALF + m * 16) * 1024;
#pragma unroll
                    for (int bj = 0; bj < 2; ++bj) *(u32x4*)(rowp + 32 * bj) = pk8(v[bj][0] * gv[bj][0] * r, v[bj][1] * gv[bj][1] * r); }
        } else if (pn < 14) {
            bf16_t* base; int ldc;
            if (pn < 12) { base = (bf16_t*)(ws + WS_V) + (pn - 8) * 256; ldc = 1024; } else { base = (bf16_t*)(ws + WS_P) + (pn - 12) * 256; ldc = 512; }
            base += 64 * wc + 8 * fq;
#pragma unroll
            for (int ai = 0; ai < 2; ++ai)
#pragma unroll
                for (int m = 0; m < 4; ++m) { const float sc = rsp[ai * HALF + m * 16]; bf16_t* rowp = base + (row0 + ai * HALF + m * 16) * ldc;
#pragma unroll
                    for (int bj = 0; bj < 2; ++bj) *(u32x4*)(rowp + 32 * bj) = pk8(EA_V(ai, bj, m, 0) * sc, EA_V(ai, bj, m, 1) * sc); }
        } else if (pn < 16) {
            bf16_t* base = (bf16_t*)(ws + WS_MQ) + (pn - 14) * 256 + 64 * wc + 8 * fq; float* mqss = (float*)(ws + WS_MQSS);
#pragma unroll
            for (int ai = 0; ai < 2; ++ai)
#pragma unroll
                for (int m = 0; m < 4; ++m) { const float sc = rsp[ai * HALF + m * 16]; const size_t row = row0 + ai * HALF + m * 16; bf16_t* rowp = base + row * 512; float ss = 0.f;
#pragma unroll
                    for (int bj = 0; bj < 2; ++bj) { const f32x4 a = EA_V(ai, bj, m, 0) * sc, b = EA_V(ai, bj, m, 1) * sc;
                        ss += ((a[0] * a[0] + a[1] * a[1]) + (a[2] * a[2] + a[3] * a[3])) + ((b[0] * b[0] + b[1] * b[1]) + (b[2] * b[2] + b[3] * b[3]));
                        *(u32x4*)(rowp + 32 * bj) = pk8(a, b); }
                    ss += __shfl_xor(ss, 16); ss += __shfl_xor(ss, 32);
                    if (fq == 0) mqss[row * 8 + (pn - 14) * 4 + wc] = ss; }
        } else {
            const int gcol = (pn - 16) * 256 + 64 * wc + 8 * fq; unsigned char* base = (unsigned char*)(ws + WS_G) + gcol; const float* bgate = prm + PB_BGATE + l * 3072 + gcol;
            f32x4 bv[2][2];
#pragma unroll
            for (int bj = 0; bj < 2; ++bj)
#pragma unroll
                for (int n = 0; n < 2; ++n) bv[bj][n] = *(const f32x4*)(bgate + 32 * bj + 4 * n);
#pragma unroll
            for (int ai = 0; ai < 2; ++ai)
#pragma unroll
                for (int m = 0; m < 4; ++m) { const float sc = rsp[ai * HALF + m * 16]; unsigned char* rowp = base + (row0 + ai * HALF + m * 16) * 3072;
#pragma unroll
                    for (int bj = 0; bj < 2; ++bj) { f32x4 a = EA_V(ai, bj, m, 0) * sc + bv[bj][0], b = EA_V(ai, bj, m, 1) * sc + bv[bj][1];
#pragma unroll
                        for (int j = 0; j < 4; ++j) { a[j] = sigmoid_f(a[j]) * 255.0f + 0.5f; b[j] = sigmoid_f(b[j]) * 255.0f + 0.5f; }
                        const unsigned w0 = (unsigned)a[0] | ((unsigned)a[1] << 8) | ((unsigned)a[2] << 16) | ((unsigned)a[3] << 24), w1 = (unsigned)b[0] | ((unsigned)b[1] << 8) | ((unsigned)b[2] << 16) | ((unsigned)b[3] << 24);
                        *(unsigned long long*)(rowp + 32 * bj) = (unsigned long long)w0 | ((unsigned long long)w1 << 32); } }
        }
    }
};
#undef EA_V

struct EpiBr0 {
    static constexpr bool PERM = false, AFTER_DRAIN = false, I8 = false, F8 = false;
    unsigned char* ws;
    __device__ __forceinline__ void operator()(const f32x4 (&acc)[2][2][4][2], const Unit& u, int wr, int wc, int fr, int fq) const {
        const size_t row0 = (size_t)u.pm * BM + wr * 64 + fr; const int col0 = u.pn * BM + 64 * wc + 8 * fq;
        const unsigned char* G = (const unsigned char*)(ws + WS_G); bf16_t* MFb = (bf16_t*)(ws + WS_MF);
#pragma unroll
        for (int ai = 0; ai < 2; ++ai) { unsigned long long gw[4][2];
#pragma unroll
            for (int m = 0; m < 4; ++m)
#pragma unroll
                for (int bj = 0; bj < 2; ++bj) gw[m][bj] = *(const unsigned long long*)(G + (row0 + ai * HALF + m * 16) * 3072 + col0 + 32 * bj);
#pragma unroll
            for (int m = 0; m < 4; ++m) { const size_t row = row0 + ai * HALF + m * 16;
#pragma unroll
                for (int bj = 0; bj < 2; ++bj) { const int col = col0 + 32 * bj;
                    const unsigned glo = (unsigned)gw[m][bj], ghi = (unsigned)(gw[m][bj] >> 32);
                    const f32x4 g0 = (f32x4){(float)(glo & 255u), (float)((glo >> 8) & 255u), (float)((glo >> 16) & 255u), (float)(glo >> 24)} * (1.0f / 255.0f), g1 = (f32x4){(float)(ghi & 255u), (float)((ghi >> 8) & 255u), (float)((ghi >> 16) & 255u), (float)(ghi >> 24)} * (1.0f / 255.0f);
                    *(u32x4*)(MFb + row * 1024 + col) = pk8(acc[ai][bj][m][0] * g0, acc[ai][bj][m][1] * g1); } } }
    }
};
struct EpiBrC {
    static constexpr bool PERM = false, AFTER_DRAIN = false, I8 = false, F8 = false;
    unsigned char* ws;
    __device__ __forceinline__ void operator()(const f32x4 (&acc)[2][2][4][2], const Unit& u, int wr, int wc, int fr, int fq) const {
        const size_t row0 = (size_t)u.pm * BM + wr * 64 + fr; const int col0 = u.pn * BM + 64 * wc + 8 * fq;
        const unsigned char* G = (const unsigned char*)(ws + WS_G) + (1 + u.idx) * 1024; const bf16_t* MFb = (const bf16_t*)(ws + WS_MF); bf16_t* O = (bf16_t*)(ws + (u.idx == 0 ? WS_MF : WS_Q));
#pragma unroll
        for (int ai = 0; ai < 2; ++ai) { unsigned long long gw[4][2]; u32x4 mw[4][2];
#pragma unroll
            for (int m = 0; m < 4; ++m)
#pragma unroll
                for (int bj = 0; bj < 2; ++bj) { const size_t row = row0 + ai * HALF + m * 16; const int col = col0 + 32 * bj;
                    gw[m][bj] = *(const unsigned long long*)(G + row * 3072 + col); mw[m][bj] = *(const u32x4*)(MFb + row * 1024 + col); }
#pragma unroll
            for (int m = 0; m < 4; ++m) { const size_t row = row0 + ai * HALF + m * 16;
#pragma unroll
                for (int bj = 0; bj < 2; ++bj) { const int col = col0 + 32 * bj;
                    const unsigned glo = (unsigned)gw[m][bj], ghi = (unsigned)(gw[m][bj] >> 32); const u32x4 w = mw[m][bj];
                    const f32x4 g0 = (f32x4){(float)(glo & 255u), (float)((glo >> 8) & 255u), (float)((glo >> 16) & 255u), (float)(glo >> 24)} * (1.0f / 255.0f), g1 = (f32x4){(float)(ghi & 255u), (float)((ghi >> 8) & 255u), (float)((ghi >> 16) & 255u), (float)(ghi >> 24)} * (1.0f / 255.0f);
                    const f32x4 m0 = {bf_lo(w.x), bf_hi(w.x), bf_lo(w.y), bf_hi(w.y)}, m1 = {bf_lo(w.z), bf_hi(w.z), bf_lo(w.w), bf_hi(w.w)};
                    *(u32x4*)(O + row * 1024 + col) = pk8(acc[ai][bj][m][0] * g0 + m0, acc[ai][bj][m][1] * g1 + m1); } } }
    }
};

struct EpiRes {
    static constexpr bool PERM = false, AFTER_DRAIN = false, I8 = false, F8 = false;
    const float* xin; float* x; unsigned char* ws; size_t xb_off; size_t dry_off;
    __device__ __forceinline__ void operator()(const f32x4 (&acc)[2][2][4][2], const Unit& u, int wr, int wc, int fr, int fq) const {
        const size_t row0 = (size_t)u.pm * BM + wr * 64 + fr; const int col0 = u.pn * BM + 64 * wc + 8 * fq;
        float* xout = dry_off ? (float*)(ws + dry_off) : x; bf16_t* xb = (bf16_t*)(ws + xb_off); float* ss = (float*)(ws + WS_SS);
#pragma unroll
        for (int ai = 0; ai < 2; ++ai)
#pragma unroll
            for (int m = 0; m < 4; ++m) { const size_t row = row0 + ai * HALF + m * 16; float s2 = 0.f;
#pragma unroll
                for (int bj = 0; bj < 2; ++bj) { const size_t off = row * 1024 + col0 + 32 * bj;
                    const f32x4 a = *(const f32x4*)(xin + off) + acc[ai][bj][m][0], b = *(const f32x4*)(xin + off + 4) + acc[ai][bj][m][1];
                    *(f32x4*)(xout + off) = a; *(f32x4*)(xout + off + 4) = b;
                    if (xb_off) { *(u32x4*)(xb + off) = pk8(a, b); s2 += ((a[0] * a[0] + a[1] * a[1]) + (a[2] * a[2] + a[3] * a[3])) + ((b[0] * b[0] + b[1] * b[1]) + (b[2] * b[2] + b[3] * b[3])); } }
                if (xb_off) { s2 += __shfl_xor(s2, 16); s2 += __shfl_xor(s2, 32); if (fq == 0) ss[row * 16 + u.pn * 4 + wc] = s2; } }
    }
};

struct EpiResB {
    static constexpr bool PERM = false, AFTER_DRAIN = false, I8 = false, F8 = false;
    const float* xf; bf16_t* xs;
    __device__ __forceinline__ void operator()(const f32x4 (&acc)[2][2][4][2], const Unit& u, int wr, int wc, int fr, int fq) const {
        const size_t row0 = (size_t)u.pm * BM + wr * 64 + fr; const int col0 = u.pn * BM + 64 * wc + 8 * fq;
#pragma unroll
        for (int ai = 0; ai < 2; ++ai)
#pragma unroll
            for (int m = 0; m < 4; ++m) { const size_t row = row0 + ai * HALF + m * 16;
#pragma unroll
                for (int bj = 0; bj < 2; ++bj) { const size_t off = row * 1024 + col0 + 32 * bj; f32x4 a, b;
                    if (xf) { a = *(const f32x4*)(xf + off); b = *(const f32x4*)(xf + off + 4); }
                    else { const u32x4 w = *(const u32x4*)(xs + off); a = (f32x4){bf_lo(w.x), bf_hi(w.x), bf_lo(w.y), bf_hi(w.y)}; b = (f32x4){bf_lo(w.z), bf_hi(w.z), bf_lo(w.w), bf_hi(w.w)}; }
                    *(u32x4*)(xs + off) = pk8(a + acc[ai][bj][m][0], b + acc[ai][bj][m][1]); } }
    }
};

template <bool I8_, bool OUT8 = false> struct EpiSwiglu {
    static constexpr bool PERM = false, AFTER_DRAIN = false, I8 = I8_, F8 = false;
    bf16_t* H; int ldc; const PG8_LAS float* rs; const float* cmax; int nh;
    const PG8_LAS int* texp; int t0;
    __device__ __forceinline__ void operator()(const f32x4 (&acc)[2][2][4][2], const Unit& u, int wr, int wc, int fr, int fq) const {
        const int rl = wr * 64 + fr; const size_t row0 = (size_t)u.pm * BM + rl; const int col0 = u.pn * 128 + 32 * wc + 8 * fq;
        f32x4 c1[2], c3[2];
#pragma unroll
        for (int bj = 0; bj < 2; ++bj) { if constexpr (I8_) { const float* cm = cmax + (texp ? (size_t)texp[t0 + u.pm] * 2 * nh : 0) + col0 + 4 * bj; c1[bj] = *(const f32x4*)cm * (1.0f / 127.0f); c3[bj] = *(const f32x4*)(cm + nh) * (OUT8 ? H8_SCALE / 127.0f : 1.0f / 127.0f); } else { c1[bj] = (f32x4){1.f, 1.f, 1.f, 1.f}; c3[bj] = c1[bj]; } }
#pragma unroll
        for (int ai = 0; ai < 2; ++ai)
#pragma unroll
            for (int m = 0; m < 4; ++m) { const float sc = rs[u.idx * 256 + rl + ai * HALF + m * 16]; f32x4 h[2];
#pragma unroll
                for (int bj = 0; bj < 2; ++bj) { const f32x4 a = accf<I8_>(acc[ai][bj][m][0]) * c1[bj] * sc, b = accf<I8_>(acc[ai][bj][m][1]) * c3[bj] * sc;
#pragma unroll
                    for (int j = 0; j < 4; ++j) h[bj][j] = a[j] * sigmoid_f(a[j]) * b[j]; }
                if constexpr (OUT8) {
#pragma unroll
                    for (int bj = 0; bj < 2; ++bj)
#pragma unroll
                        for (int j = 0; j < 4; ++j) h[bj][j] = __builtin_fminf(__builtin_fmaxf(h[bj][j], -448.0f), 448.0f);
                    const unsigned w0 = pk_fp8x4(h[0][0], h[0][1], h[0][2], h[0][3]), w1 = pk_fp8x4(h[1][0], h[1][1], h[1][2], h[1][3]);
                    *(unsigned long long*)((unsigned char*)H + (row0 + ai * HALF + m * 16) * ldc + col0) = (unsigned long long)w0 | ((unsigned long long)w1 << 32);
                } else *(u32x4*)(H + (row0 + ai * HALF + m * 16) * ldc + col0) = pk8(h[0], h[1]); }
    }
};

struct EpiStoreF8 {
    static constexpr bool PERM = false, AFTER_DRAIN = false, I8 = false, F8 = true;
    bf16_t* O; int ldc; const float* cs; const PG8_LAS int* texp; int t0;
    __device__ __forceinline__ void operator()(const f32x4 (&acc)[2][2][4][2], const Unit& u, int wr, int wc, int fr, int fq) const {
        const int rl = wr * 64 + fr; const size_t row0 = (size_t)u.pm * BM + rl; const int col0 = u.pn * BM + 64 * wc + 8 * fq;
        const float* c = cs + (texp ? (size_t)texp[t0 + u.pm] * 1024 : 0) + col0; f32x4 cw[2][2];
#pragma unroll
        for (int bj = 0; bj < 2; ++bj)
#pragma unroll
            for (int n = 0; n < 2; ++n) cw[bj][n] = *(const f32x4*)(c + 32 * bj + 4 * n);
#pragma unroll
        for (int ai = 0; ai < 2; ++ai)
#pragma unroll
            for (int m = 0; m < 4; ++m) { bf16_t* rowp = O + (row0 + ai * HALF + m * 16) * ldc + col0;
#pragma unroll
                for (int bj = 0; bj < 2; ++bj) *(u32x4*)(rowp + 32 * bj) = pk8(acc[ai][bj][m][0] * cw[bj][0], acc[ai][bj][m][1] * cw[bj][1]); }
    }
};
struct EpiResB8 {
    static constexpr bool PERM = false, AFTER_DRAIN = false, I8 = false, F8 = true;
    bf16_t* xs; const float* cs;
    __device__ __forceinline__ void operator()(const f32x4 (&acc)[2][2][4][2], const Unit& u, int wr, int wc, int fr, int fq) const {
        const size_t row0 = (size_t)u.pm * BM + wr * 64 + fr; const int col0 = u.pn * BM + 64 * wc + 8 * fq; f32x4 cw[2][2];
#pragma unroll
        for (int bj = 0; bj < 2; ++bj)
#pragma unroll
            for (int n = 0; n < 2; ++n) cw[bj][n] = *(const f32x4*)(cs + col0 + 32 * bj + 4 * n);
#pragma unroll
        for (int ai = 0; ai < 2; ++ai)
#pragma unroll
            for (int m = 0; m < 4; ++m) { const size_t row = row0 + ai * HALF + m * 16;
#pragma unroll
                for (int bj = 0; bj < 2; ++bj) { const size_t off = row * 1024 + col0 + 32 * bj; const u32x4 w = *(const u32x4*)(xs + off);
                    const f32x4 a = {bf_lo(w.x), bf_hi(w.x), bf_lo(w.y), bf_hi(w.y)}, b = {bf_lo(w.z), bf_hi(w.z), bf_lo(w.w), bf_hi(w.w)};
                    *(u32x4*)(xs + off) = pk8(a + acc[ai][bj][m][0] * cw[bj][0], b + acc[ai][bj][m][1] * cw[bj][1]); } }
    }
};
template <class Epi, class Sched, bool ALIGN_EPI = false, bool SP2 = false>
__device__ __forceinline__ void gemm_phase(PG8_LAS unsigned char* lds, const Gemm g, const Sched& S, const Epi& E) {
    int tid_ = threadIdx.x; asm volatile("" : "+v"(tid_));
    const int tid = tid_, wid = __builtin_amdgcn_readfirstlane(tid >> 6), lane = tid & 63, wr = wid >> 2, wc = wid & 3, fr = lane & 15, fq = lane >> 4;
    const int K = g.K, nt = K / BK;
    unsigned voffA[2], voffB[2];
#pragma unroll
    for (int i = 0; i < 2; ++i) { int R, C; stage_rc(tid * 16 + i * 8192, R, C); const int Rb = Epi::PERM ? ((R & ~31) + perm32(R & 31)) : R;
        voffA[i] = (unsigned)(R * K + C) * 2u; voffB[i] = (unsigned)(Rb * K + C) * 2u; }
    const size_t kstep = (size_t)(BK * 2);
    const size_t hstep = (size_t)HALF * K * 2;
    const size_t tstep = 2 * hstep;
    const unsigned ldsw = (unsigned)wid * 1024u;
    const int aoff = lds_byte(wr * 64 + fr, fq * 8), boff = lds_byte(wc * 32 + fr, fq * 8);
#define PG8_SA(b, h) (((b) * 2 + (h)) * HTB)
#define PG8_SB(b, h) ((4 + (b) * 2 + (h)) * HTB)
#define PG8_STAGE(bufoff, gbase, voff) do { _Pragma("unroll") for (int _i = 0; _i < 2; ++_i) \
        __builtin_amdgcn_global_load_lds((const unsigned*)((const char*)(gbase) + (voff)[_i]), (PG8_LAS unsigned*)(lds + (bufoff) + ldsw + _i * 8192), 16, 0, 0); } while (0)
#define PG8_LDA(dst, b, h) do { if constexpr (Epi::F8) { _Pragma("unroll") for (int m = 0; m < 4; ++m) { const i32x4 lo_ = *(const PG8_LAS i32x4*)(lds + PG8_SA(b, h) + aoff + m * 2048), hi_ = *(const PG8_LAS i32x4*)(lds + PG8_SA(b, h) + aoff + m * 2048 + 1024); dst##8[m] = __builtin_shufflevector(lo_, hi_, 0, 1, 2, 3, 4, 5, 6, 7); } } \
        else { _Pragma("unroll") for (int m = 0; m < 4; ++m) _Pragma("unroll") for (int k = 0; k < 2; ++k) dst[m][k] = *(const PG8_LAS bf16x8*)(lds + PG8_SA(b, h) + aoff + m * 2048 + k * 1024); } } while (0)
#define PG8_LDB(dst, b, h) do { if constexpr (Epi::F8) { _Pragma("unroll") for (int n = 0; n < 2; ++n) { const i32x4 lo_ = *(const PG8_LAS i32x4*)(lds + PG8_SB(b, h) + boff + n * 2048), hi_ = *(const PG8_LAS i32x4*)(lds + PG8_SB(b, h) + boff + n * 2048 + 1024); dst##8[n] = __builtin_shufflevector(lo_, hi_, 0, 1, 2, 3, 4, 5, 6, 7); } } \
        else { _Pragma("unroll") for (int n = 0; n < 2; ++n) _Pragma("unroll") for (int k = 0; k < 2; ++k) dst[n][k] = *(const PG8_LAS bf16x8*)(lds + PG8_SB(b, h) + boff + n * 2048 + k * 1024); } } while (0)
#define PG8_MMA(ai, bj, At, Bt) do { __builtin_amdgcn_s_setprio(1); if constexpr (Epi::F8) { _Pragma("unroll") for (int m = 0; m < 4; ++m) _Pragma("unroll") for (int n = 0; n < 2; ++n) acc[ai][bj][m][n] = mma_f8(Bt##8[n], At##8[m], acc[ai][bj][m][n]); } \
        else { _Pragma("unroll") for (int m = 0; m < 4; ++m) _Pragma("unroll") for (int n = 0; n < 2; ++n) _Pragma("unroll") for (int k = 0; k < 2; ++k) acc[ai][bj][m][n] = mma16<Epi::I8>(Bt[n][k], At[m][k], acc[ai][bj][m][n]); } __builtin_amdgcn_s_setprio(0); } while (0)
#define PG8_WAIT_V(n) asm volatile("s_waitcnt vmcnt(" #n ")" ::: "memory")
#define PG8_WAIT_L(n) asm volatile("s_waitcnt lgkmcnt(" #n ")" ::: "memory")
#define PG8_BAR __builtin_amdgcn_s_barrier()
#define PG8_SCHED __builtin_amdgcn_sched_barrier(0)
    Unit cur, nxt; int ui = 0;
    if (!S.next(0, cur)) return;
    f32x4 acc[2][2][4][2];
#pragma unroll
    for (int a = 0; a < 2; ++a)
#pragma unroll
        for (int b = 0; b < 2; ++b)
#pragma unroll
            for (int m = 0; m < 4; ++m)
#pragma unroll
                for (int n = 0; n < 2; ++n) acc[a][b][m][n] = (f32x4){0.f, 0.f, 0.f, 0.f};
    bf16x8 At[4][2], B0[2][2], B1[2][2];
    i32x8 At8[4], B08[2], B18[2];
    const char* cA = S.aptr(g, cur, tstep); const char* cB = S.bptr(g, cur, tstep);
    S.a_ready(cur);
    if constexpr (SP2) {
        PG8_STAGE(PG8_SB(0, 0), cB, voffB); PG8_STAGE(PG8_SB(0, 1), cB + hstep, voffB); PG8_STAGE(PG8_SA(0, 0), cA, voffA); PG8_STAGE(PG8_SA(0, 1), cA + hstep, voffA);
        if (wr == 1) PG8_BAR;
        PG8_WAIT_V(2); PG8_BAR;
        PG8_STAGE(PG8_SB(1, 0), cB + kstep, voffB); PG8_STAGE(PG8_SA(1, 0), cA + kstep, voffA); PG8_STAGE(PG8_SB(1, 1), cB + hstep + kstep, voffB);
        PG8_WAIT_V(6); PG8_BAR;
    } else {
        PG8_STAGE(PG8_SB(0, 0), cB, voffB); PG8_STAGE(PG8_SA(0, 0), cA, voffA); PG8_STAGE(PG8_SB(0, 1), cB + hstep, voffB); PG8_STAGE(PG8_SA(0, 1), cA + hstep, voffA);
        if (wr == 1) PG8_BAR;
        PG8_WAIT_V(4); PG8_BAR;
        PG8_STAGE(PG8_SB(1, 0), cB + kstep, voffB); PG8_STAGE(PG8_SA(1, 0), cA + kstep, voffA); PG8_STAGE(PG8_SB(1, 1), cB + hstep + kstep, voffB);
        PG8_WAIT_V(6); PG8_BAR;
    }
    for (;;) {
        const bool has_next = S.next(ui + 1, nxt);
        const char* nA = has_next ? S.aptr(g, nxt, tstep) : cA; const char* nB = has_next ? S.bptr(g, nxt, tstep) : cB;
        for (int t = 0; t < nt; t += 2) {
            const bool last = (t == nt - 2);
            const char* a1 = cA + (size_t)(t + 1) * kstep;
            const char* a2 = last ? nA : cA + (size_t)(t + 2) * kstep; const char* b2 = last ? nB : cB + (size_t)(t + 2) * kstep;
            const char* a3 = a2 + kstep; const char* b3 = b2 + kstep;
            if (last && has_next) S.a_ready(nxt);
            if constexpr (SP2) {
            PG8_LDB(B0, 0, 0); PG8_LDB(B1, 0, 1); PG8_SCHED; PG8_LDA(At, 0, 0); PG8_STAGE(PG8_SA(1, 1), a1 + hstep, voffA);
            PG8_WAIT_V(8); PG8_WAIT_L(0); PG8_BAR; PG8_MMA(0, 0, At, B0); PG8_MMA(0, 1, At, B1); PG8_BAR; PG8_SCHED;
            PG8_LDA(At, 0, 1); PG8_STAGE(PG8_SB(0, 0), b2, voffB); PG8_STAGE(PG8_SB(0, 1), b2 + hstep, voffB); PG8_STAGE(PG8_SA(0, 0), a2, voffA);
            PG8_WAIT_V(8); PG8_WAIT_L(0); PG8_BAR; PG8_MMA(1, 0, At, B0); PG8_MMA(1, 1, At, B1); PG8_BAR; PG8_SCHED;
            PG8_LDB(B0, 1, 0); PG8_LDB(B1, 1, 1); PG8_SCHED; PG8_LDA(At, 1, 0); PG8_STAGE(PG8_SA(0, 1), a2 + hstep, voffA);
            PG8_WAIT_V(8); PG8_WAIT_L(0); PG8_BAR; PG8_MMA(0, 0, At, B0); PG8_MMA(0, 1, At, B1); PG8_BAR; PG8_SCHED;
            PG8_LDA(At, 1, 1); PG8_STAGE(PG8_SB(1, 0), b3, voffB); PG8_STAGE(PG8_SB(1, 1), b3 + hstep, voffB); PG8_STAGE(PG8_SA(1, 0), a3, voffA);
            PG8_WAIT_V(8); PG8_WAIT_L(0); PG8_BAR; PG8_MMA(1, 0, At, B0); PG8_MMA(1, 1, At, B1); PG8_BAR; PG8_SCHED;
            } else {
            PG8_LDB(B0, 0, 0); PG8_SCHED; PG8_LDA(At, 0, 0); PG8_STAGE(PG8_SA(1, 1), a1 + hstep, voffA);
            PG8_WAIT_L(8); PG8_BAR; PG8_WAIT_L(0); PG8_MMA(0, 0, At, B0); PG8_BAR; PG8_SCHED;
            PG8_LDB(B1, 0, 1); PG8_STAGE(PG8_SB(0, 0), b2, voffB);
            PG8_BAR; PG8_WAIT_L(0); PG8_MMA(0, 1, At, B1); PG8_BAR;
            PG8_LDA(At, 0, 1); PG8_STAGE(PG8_SA(0, 0), a2, voffA);
            PG8_BAR; PG8_WAIT_L(0); PG8_MMA(1, 0, At, B0); PG8_BAR; PG8_SCHED;
            PG8_STAGE(PG8_SB(0, 1), b2 + hstep, voffB);
            PG8_WAIT_V(6); PG8_BAR; PG8_MMA(1, 1, At, B1); PG8_BAR;
            PG8_LDB(B0, 1, 0); PG8_SCHED; PG8_LDA(At, 1, 0); PG8_STAGE(PG8_SA(0, 1), a2 + hstep, voffA);
            PG8_WAIT_L(8); PG8_BAR; PG8_WAIT_L(0); PG8_MMA(0, 0, At, B0); PG8_BAR; PG8_SCHED;
            PG8_LDB(B1, 1, 1); PG8_STAGE(PG8_SB(1, 0), b3, voffB);
            PG8_BAR; PG8_WAIT_L(0); PG8_MMA(0, 1, At, B1); PG8_BAR;
            PG8_LDA(At, 1, 1); PG8_STAGE(PG8_SA(1, 0), a3, voffA);
            PG8_BAR; PG8_WAIT_L(0); PG8_MMA(1, 0, At, B0); PG8_BAR; PG8_SCHED;
            PG8_STAGE(PG8_SB(1, 1), b3 + hstep, voffB);
            PG8_WAIT_V(6); PG8_BAR; PG8_MMA(1, 1, At, B1); PG8_BAR;
            }
        }
        if constexpr (ALIGN_EPI) { if (wr == 0) PG8_BAR; }
        if constexpr (!Epi::AFTER_DRAIN) { E(acc, cur, wr, wc, fr, fq); S.done(cur); }
        if (!has_next) break;
#pragma unroll
        for (int a = 0; a < 2; ++a)
#pragma unroll
            for (int b = 0; b < 2; ++b)
#pragma unroll
                for (int m = 0; m < 4; ++m)
#pragma unroll
                    for (int n = 0; n < 2; ++n) acc[a][b][m][n] = (f32x4){0.f, 0.f, 0.f, 0.f};
        cur = nxt; cA = nA; cB = nB; ++ui;
        if constexpr (ALIGN_EPI) { if (wr == 1) PG8_BAR; }
    }
    PG8_WAIT_V(0);
    if constexpr (!ALIGN_EPI) { if (wr == 0) PG8_BAR; }
    PG8_BAR;
    if constexpr (Epi::AFTER_DRAIN) { E.fused(acc, cur, wr, wc, fr, fq, lds, wid, lane); S.done(cur); }
#undef PG8_SA
#undef PG8_SB
#undef PG8_STAGE
#undef PG8_LDA
#undef PG8_LDB
#undef PG8_MMA
#undef PG8_WAIT_V
#undef PG8_WAIT_L
#undef PG8_BAR
#undef PG8_SCHED
}
}
#define GAS __attribute__((address_space(1)))
#define LAS __attribute__((address_space(3)))
typedef unsigned short bf16_t;
typedef unsigned v4u __attribute__((ext_vector_type(4)));
typedef float f32x4 __attribute__((ext_vector_type(4)));
typedef float f32x2 __attribute__((ext_vector_type(2)));
#define RLX_AGENT __ATOMIC_RELAXED, __HIP_MEMORY_SCOPE_AGENT
__device__ __forceinline__ float wave_sum(float v) {
#pragma unroll
    for (int o = 1; o < 64; o <<= 1) v += __shfl_xor(v, o);
    return v;
}
__device__ __forceinline__ float ld_f32_agent(const float* p) { return __builtin_bit_cast(float, __builtin_amdgcn_readfirstlane(__hip_atomic_load((const unsigned*)p, RLX_AGENT))); }
__device__ __forceinline__ float ld_f32_plain(const float* p) { return *(const GAS float*)p; }
__device__ __forceinline__ int ld_i32_agent(const int* p) { return (int)__hip_atomic_load((const unsigned*)p, RLX_AGENT); }
using pg8::pk_bf16; using pg8::bf_lo; using pg8::bf_hi;

#define XB_TMO      128
#define XB_XCNT(j)  (256  + 64 * (j))
#define XB_XSUB(j)  (1280 + 64 * (j))
#define XB_XGEN(j)  (2304 + 64 * (j))
#define XB_TOP      3328
#define XB_TOPGEN   3392
#define XCD_BAR_WORDS 3456
#define XB_SPIN_CAP (1u << 18)

__device__ __forceinline__ unsigned xb_ld(unsigned* p)              { return __hip_atomic_load(p, __ATOMIC_RELAXED, __HIP_MEMORY_SCOPE_AGENT); }
__device__ __forceinline__ unsigned xb_add(unsigned* p, unsigned v) { return __hip_atomic_fetch_add(p, v, __ATOMIC_RELAXED, __HIP_MEMORY_SCOPE_AGENT); }
__device__ __forceinline__ unsigned xb_xcc_id() { return (unsigned)__builtin_amdgcn_s_getreg((3 << 11) | 20) & 0xFu; }
#define XB_SPIN(cond, bar) do { unsigned _sp = 0; while (cond) { __builtin_amdgcn_s_sleep(1); \
    if ((++_sp & 255u) == 0u) { if (xb_ld(&(bar)[XB_TMO])) break; if (_sp > XB_SPIN_CAP) { atomicAdd(&(bar)[XB_TMO], 1u); break; } } } } while (0)

struct XcdBarrier {
    unsigned* bar; unsigned x;
    volatile LAS unsigned* st;
};

__device__ __forceinline__ XcdBarrier xcd_barrier_post(unsigned* bar, volatile LAS unsigned* st) {
    XcdBarrier b; b.bar = bar; b.x = xb_xcc_id(); b.st = st;
    if (threadIdx.x == 0) (void)xb_add(&bar[XB_XCNT(b.x)], 1u);
    return b;
}
__device__ __forceinline__ void xcd_barrier_complete(unsigned* bar, unsigned x, unsigned& nloc, unsigned& nx) {
    const unsigned G = gridDim.x * gridDim.y * gridDim.z;
    unsigned sum, cnt, mine, sp = 0u;
    for (;;) {
        sum = 0u; cnt = 0u; mine = 0u;
#pragma unroll
        for (unsigned j = 0; j < 16; ++j) { const unsigned c = xb_ld(&bar[XB_XCNT(j)]); sum += c; cnt += (c > 0u) ? 1u : 0u; mine = (j == x) ? c : mine; }
        if (sum == G) break;
        __builtin_amdgcn_s_sleep(1);
        if ((++sp & 255u) == 0u) { if (xb_ld(&bar[XB_TMO])) break; if (sp > XB_SPIN_CAP) { atomicAdd(&bar[XB_TMO], 1u); break; } }
    }
    nloc = mine > 0u ? mine : 1u; nx = cnt > 0u ? cnt : 1u;
}

__device__ __forceinline__ void xcd_barrier(const XcdBarrier& b) {
    asm volatile("s_waitcnt vmcnt(0)" ::: "memory");
    __syncthreads();
    if (threadIdx.x == 0) {
        unsigned* bar = b.bar;
        __builtin_amdgcn_s_waitcnt(0);
        unsigned nloc = b.st[0], nx = b.st[1];
        if (nloc == 0u) { xcd_barrier_complete(bar, b.x, nloc, nx); b.st[0] = nloc; b.st[1] = nx; }
        const unsigned old = xb_add(&bar[XB_XSUB(b.x)], 1u);
        const unsigned gen = old / nloc;
        if (old + 1u == (gen + 1u) * nloc) {
            __builtin_amdgcn_fence(__ATOMIC_RELEASE, "agent");
            asm volatile("s_waitcnt vmcnt(0)" ::: "memory");
            const unsigned og = xb_add(&bar[XB_TOP], 1u);
            const unsigned tg = og / nx;
            if (og + 1u == (tg + 1u) * nx) xb_add(&bar[XB_TOPGEN], 1u);
            else XB_SPIN(xb_ld(&bar[XB_TOPGEN]) == tg, bar);
            __builtin_amdgcn_fence(__ATOMIC_ACQUIRE, "agent");
            xb_add(&bar[XB_XGEN(b.x)], 1u);
            asm volatile("s_waitcnt vmcnt(0)" ::: "memory");
        } else {
            XB_SPIN(xb_ld(&bar[XB_XGEN(b.x)]) == gen, bar);
            __builtin_amdgcn_fence(__ATOMIC_ACQUIRE, "agent");
            asm volatile("s_waitcnt vmcnt(0)" ::: "memory");
        }
    }
    __syncthreads();
}


struct Args { const float* in[31]; float* out; unsigned char* ws; int ph_lo, ph_hi; };

struct TJob { unsigned long long src, dst, gain; int K, N, ld, map, colbase, start, q8, smax, startq, f8, startf; };
constexpr int NJOBS = 41;
__device__ __forceinline__ void make_job(int j, const Args& a, TJob& o) {
    unsigned char* ws = a.ws; const float* src; void* dst; const float* gain = nullptr; o.map = 0; o.colbase = 0; o.q8 = 0; o.smax = 0; o.f8 = 0;
    if (j < 14) { const int l = j / 7, t = j % 7;
        if (t == 0)      { src = a.in[5] + (size_t)l * D * 4096; o.K = D; o.N = 4096; dst = ws + WS_W1T + l * 14 * MiB; gain = a.in[2] + l * D; o.q8 = I8_A; o.smax = SW_G1 + l * 7168; }
        else if (t == 1) { src = a.in[6] + (size_t)l * D * 3072; o.K = D; o.N = 3072; dst = ws + WS_W1T + l * 14 * MiB; gain = a.in[2] + l * D; o.colbase = 4096; o.q8 = I8_A; o.smax = SW_G1 + l * 7168 + 4096; }
        else if (t == 2) { src = a.in[19] + (size_t)l * D * 1024; o.K = D; o.N = 1024; dst = ws + WS_WMEMKV + l * 2 * MiB; gain = a.in[3] + l * D; }
        else if (t == 3) { src = a.in[20] + (size_t)l * 1024 * D; o.K = 1024; o.N = D; dst = ws + WS_WBRDA + l * 2 * MiB; }
        else if (t == 4) { src = a.in[21] + (size_t)l * 512 * D; o.K = 512; o.N = D; dst = ws + WS_WBRPOOL + l * 1 * MiB; }
        else if (t == 5) { src = a.in[22] + (size_t)l * 512 * D; o.K = 512; o.N = D; dst = ws + WS_WBRMEM + l * 1 * MiB; }
        else             { src = a.in[23] + (size_t)l * D * D; o.K = D; o.N = D; dst = ws + WS_WOUT + l * 2 * MiB; }
    } else if (j < 17) { const int t = j - 14;
        if (t < 2) { src = a.in[24 + t]; o.K = D; o.N = FFD; dst = ws + WS_WFF13; gain = a.in[4]; o.map = 1 + t; o.q8 = I8_E; o.smax = SW_FF + t * FFD; }
        else       { src = a.in[26]; o.K = FFD; o.N = D; dst = ws + WS_WFF2; o.f8 = 1; o.smax = SW_W2 + 8 * 1024; }
    } else { const int e = (j - 17) / 3, t = (j - 17) % 3;
        if (t < 2) { src = a.in[28 + t] + (size_t)e * D * FFE; o.K = D; o.N = FFE; dst = ws + WS_WMOE13 + (size_t)e * 7 * MiB; gain = a.in[4] + D; o.map = 1 + t; o.q8 = USE_I8; o.smax = SW_MOE + e * 2 * FFE + t * FFE; }
        else       { src = a.in[30] + (size_t)e * FFE * D; o.K = FFE; o.N = D; dst = ws + WS_WMOE2 + (size_t)e * 7 * MiB; o.f8 = 1; o.smax = SW_W2 + e * 1024; }
    }
    o.src = (unsigned long long)src; o.dst = (unsigned long long)dst; o.gain = (unsigned long long)gain; o.ld = o.N; o.start = 0; o.startq = 0; o.startf = 0;
}
__device__ __forceinline__ int bt_row_std(int C) { const int c = C & 255; return (C & ~255) + 128 * ((c >> 5) & 1) + 32 * (c >> 6) + 16 * ((c >> 2) & 1) + 4 * ((c >> 3) & 3) + (c & 3); }
__device__ __forceinline__ int bt_row_swiglu(int h, int which) { const int hl = h & 127; return 256 * (h >> 7) + 128 * ((hl >> 2) & 1) + 32 * (hl >> 5) + 16 * which + 4 * ((hl >> 3) & 3) + (hl & 3); }
struct TileRef { const GAS float* src; GAS bf16_t* dst; const GAS float* gain; int K, ld, map, colbase, k0, n0, q8, smax; };
template <bool QONLY> __device__ __forceinline__ void tile_decode(const LAS TJob* jobs, int& j, int it, TileRef& r) {
    if constexpr (QONLY) { while (it >= jobs[j + 1].startq) ++j; } else { while (it >= jobs[j + 1].start) ++j; }
    const LAS TJob* jb = jobs + j; const int item = it - (QONLY ? jb->startq : jb->start), nblk = jb->N >> 6;
    r.src = (const GAS float*)jb->src; r.dst = (GAS bf16_t*)jb->dst; r.gain = (const GAS float*)jb->gain; r.K = jb->K; r.ld = jb->ld; r.map = jb->map; r.colbase = jb->colbase; r.q8 = jb->q8; r.smax = jb->smax;
    r.k0 = (item / nblk) * 64; r.n0 = (item % nblk) * 64;
}
__device__ __forceinline__ void tile_load(const TileRef& r, int lane, f32x4 (&v)[16]) {
    const GAS float* p = r.src + (size_t)(r.k0 + (lane >> 4)) * r.ld + r.n0 + 4 * (lane & 15);
#pragma unroll
    for (int i = 0; i < 16; ++i) v[i] = __builtin_nontemporal_load((const GAS f32x4*)(p + (size_t)(4 * i) * r.ld));
}
__device__ __forceinline__ void tile_store(const TileRef& r, int lane, const f32x4 (&v)[16], LAS float* scr) {
#pragma unroll
    for (int i = 0; i < 16; ++i) { LAS float* d = scr + (4 * i + (lane >> 4)) * 65 + 4 * (lane & 15); d[0] = v[i][0]; d[1] = v[i][1]; d[2] = v[i][2]; d[3] = v[i][3]; }
    asm volatile("s_waitcnt lgkmcnt(0)" ::: "memory");
    const int kc = lane & 7;
    f32x4 g0 = {1.f, 1.f, 1.f, 1.f}, g1 = g0;
    if (r.gain) { g0 = *(const GAS f32x4*)(r.gain + r.k0 + 8 * kc); g1 = *(const GAS f32x4*)(r.gain + r.k0 + 8 * kc + 4); }
#pragma unroll
    for (int jj = 0; jj < 8; ++jj) { const int n = (lane >> 3) + 8 * jj; const LAS float* s = scr + (8 * kc) * 65 + n;
        v4u o; o.x = pk_bf16(s[0 * 65] * g0[0], s[1 * 65] * g0[1]); o.y = pk_bf16(s[2 * 65] * g0[2], s[3 * 65] * g0[3]); o.z = pk_bf16(s[4 * 65] * g1[0], s[5 * 65] * g1[1]); o.w = pk_bf16(s[6 * 65] * g1[2], s[7 * 65] * g1[3]);
        const int row = (r.map == 0) ? bt_row_std(r.colbase + r.n0 + n) : bt_row_swiglu(r.n0 + n, r.map - 1);
        *(GAS v4u*)(r.dst + (size_t)row * r.K + r.k0 + 8 * kc) = o; }
    asm volatile("s_waitcnt lgkmcnt(0)" ::: "memory");
}
__device__ __forceinline__ void tile_colmax(const TileRef& r, int lane, const f32x4 (&v)[16], float* cmaxbase) {
    float m0 = 0.f, m1 = 0.f, m2 = 0.f, m3 = 0.f;
#pragma unroll
    for (int i = 0; i < 16; ++i) { const float g = r.gain ? r.gain[r.k0 + 4 * i + (lane >> 4)] : 1.f;
        m0 = fmaxf(m0, fabsf(v[i][0] * g)); m1 = fmaxf(m1, fabsf(v[i][1] * g)); m2 = fmaxf(m2, fabsf(v[i][2] * g)); m3 = fmaxf(m3, fabsf(v[i][3] * g)); }
    m0 = fmaxf(m0, __shfl_xor(m0, 16)); m1 = fmaxf(m1, __shfl_xor(m1, 16)); m2 = fmaxf(m2, __shfl_xor(m2, 16)); m3 = fmaxf(m3, __shfl_xor(m3, 16));
    m0 = fmaxf(m0, __shfl_xor(m0, 32)); m1 = fmaxf(m1, __shfl_xor(m1, 32)); m2 = fmaxf(m2, __shfl_xor(m2, 32)); m3 = fmaxf(m3, __shfl_xor(m3, 32));
    if (lane < 16) { unsigned* p = (unsigned*)(cmaxbase + r.smax + r.n0 + 4 * lane);
        atomicMax(p, __float_as_uint(m0)); atomicMax(p + 1, __float_as_uint(m1)); atomicMax(p + 2, __float_as_uint(m2)); atomicMax(p + 3, __float_as_uint(m3)); }
}
__device__ __forceinline__ unsigned pk_i8x4(float a, float b, float c, float d) {
    const int ia = (int)__builtin_rintf(a), ib = (int)__builtin_rintf(b), ic = (int)__builtin_rintf(c), id = (int)__builtin_rintf(d);
    return (unsigned)(ia & 0xff) | ((unsigned)(ib & 0xff) << 8) | ((unsigned)(ic & 0xff) << 16) | ((unsigned)id << 24);
}
__device__ __forceinline__ void tile_store_q8(const TileRef& r, int lane, const f32x4 (&v)[16], LAS float* scr, const float* cmaxbase) {
#pragma unroll
    for (int i = 0; i < 16; ++i) { const float g = r.gain ? r.gain[r.k0 + 4 * i + (lane >> 4)] : 1.f; LAS float* d = scr + (4 * i + (lane >> 4)) * 65 + 4 * (lane & 15); d[0] = v[i][0] * g; d[1] = v[i][1] * g; d[2] = v[i][2] * g; d[3] = v[i][3] * g; }
    asm volatile("s_waitcnt lgkmcnt(0)" ::: "memory");
    const int kc = lane & 3;
#pragma unroll
    for (int jj = 0; jj < 4; ++jj) { const int n = (lane >> 2) + 16 * jj; const LAS float* s = scr + (16 * kc) * 65 + n;
        const float cm = ld_f32_plain(cmaxbase + r.smax + r.n0 + n), inv = cm > 0.f ? 127.0f / cm : 0.f;
        v4u o; o.x = pk_i8x4(s[0 * 65] * inv, s[1 * 65] * inv, s[2 * 65] * inv, s[3 * 65] * inv); o.y = pk_i8x4(s[4 * 65] * inv, s[5 * 65] * inv, s[6 * 65] * inv, s[7 * 65] * inv);
        o.z = pk_i8x4(s[8 * 65] * inv, s[9 * 65] * inv, s[10 * 65] * inv, s[11 * 65] * inv); o.w = pk_i8x4(s[12 * 65] * inv, s[13 * 65] * inv, s[14 * 65] * inv, s[15 * 65] * inv);
        const int row = (r.map == 0) ? bt_row_std(r.colbase + r.n0 + n) : bt_row_swiglu(r.n0 + n, r.map - 1);
        *(GAS v4u*)((GAS unsigned char*)r.dst + (size_t)row * r.K + r.k0 + 16 * kc) = o; }
    asm volatile("s_waitcnt lgkmcnt(0)" ::: "memory");
}
__device__ __forceinline__ void row_to_i8(const float* xrow, unsigned char* qrow, float* sa, int lane) {
    const f32x4* xr = (const f32x4*)xrow + 4 * lane; f32x4 v[4]; float s = 0.f, mx = 0.f;
#pragma unroll
    for (int j = 0; j < 4; ++j) { v[j] = xr[j]; s += (v[j][0] * v[j][0] + v[j][1] * v[j][1]) + (v[j][2] * v[j][2] + v[j][3] * v[j][3]);
        mx = fmaxf(mx, fmaxf(fmaxf(fabsf(v[j][0]), fabsf(v[j][1])), fmaxf(fabsf(v[j][2]), fabsf(v[j][3])))); }
    s = wave_sum(s);
#pragma unroll
    for (int o = 1; o < 64; o <<= 1) mx = fmaxf(mx, __shfl_xor(mx, o));
    const float inv = mx > 0.f ? 127.0f / mx : 0.f;
    v4u w; w.x = pk_i8x4(v[0][0] * inv, v[0][1] * inv, v[0][2] * inv, v[0][3] * inv); w.y = pk_i8x4(v[1][0] * inv, v[1][1] * inv, v[1][2] * inv, v[1][3] * inv);
    w.z = pk_i8x4(v[2][0] * inv, v[2][1] * inv, v[2][2] * inv, v[2][3] * inv); w.w = pk_i8x4(v[3][0] * inv, v[3][1] * inv, v[3][2] * inv, v[3][3] * inv);
    *((v4u*)qrow + lane) = w;
    if (lane == 0) *sa = mx * (1.0f / 127.0f) * __builtin_amdgcn_rsqf(s * (1.0f / 1024.0f) + 1e-6f);
}
__device__ __forceinline__ void ld16_bf16(const bf16_t* p, f32x4 (&v)[4]) {
    const v4u a = *(const v4u*)p, b = *(const v4u*)(p + 8);
    v[0] = (f32x4){bf_lo(a.x), bf_hi(a.x), bf_lo(a.y), bf_hi(a.y)}; v[1] = (f32x4){bf_lo(a.z), bf_hi(a.z), bf_lo(a.w), bf_hi(a.w)};
    v[2] = (f32x4){bf_lo(b.x), bf_hi(b.x), bf_lo(b.y), bf_hi(b.y)}; v[3] = (f32x4){bf_lo(b.z), bf_hi(b.z), bf_lo(b.w), bf_hi(b.w)};
}
__device__ __forceinline__ void rowb_to_i8(const bf16_t* xrow, unsigned char* qrow, float* sa, int lane) {
    f32x4 v[4]; ld16_bf16(xrow + 16 * lane, v); float s = 0.f, mx = 0.f;
#pragma unroll
    for (int j = 0; j < 4; ++j) { s += (v[j][0] * v[j][0] + v[j][1] * v[j][1]) + (v[j][2] * v[j][2] + v[j][3] * v[j][3]);
        mx = fmaxf(mx, fmaxf(fmaxf(fabsf(v[j][0]), fabsf(v[j][1])), fmaxf(fabsf(v[j][2]), fabsf(v[j][3])))); }
    s = wave_sum(s);
#pragma unroll
    for (int o = 1; o < 64; o <<= 1) mx = fmaxf(mx, __shfl_xor(mx, o));
    const float inv = mx > 0.f ? 127.0f / mx : 0.f;
    v4u w; w.x = pk_i8x4(v[0][0] * inv, v[0][1] * inv, v[0][2] * inv, v[0][3] * inv); w.y = pk_i8x4(v[1][0] * inv, v[1][1] * inv, v[1][2] * inv, v[1][3] * inv);
    w.z = pk_i8x4(v[2][0] * inv, v[2][1] * inv, v[2][2] * inv, v[2][3] * inv); w.w = pk_i8x4(v[3][0] * inv, v[3][1] * inv, v[3][2] * inv, v[3][3] * inv);
    *((v4u*)qrow + lane) = w;
    if (lane == 0) *sa = mx * (1.0f / 127.0f) * __builtin_amdgcn_rsqf(s * (1.0f / 1024.0f) + 1e-6f);
}
__device__ __forceinline__ void phase_quant_rows(const bf16_t* x, unsigned char* ws, int lane, int wave) {
    const int gw = blockIdx.x * NWAVES + wave, NGW = gridDim.x * NWAVES;
    for (int m = gw; m < T; m += NGW) rowb_to_i8(x + (size_t)m * D, ws + WS_QX + (size_t)m * D, (float*)(ws + WS_SA) + m, lane);
}
__device__ __forceinline__ void row_to_bf16_ss(const float* xrow, bf16_t* orow, float* ss16, float* fcopy, int lane) {
    const f32x4* xr = (const f32x4*)xrow + lane; f32x4 v[4]; float s = 0.f;
#pragma unroll
    for (int j = 0; j < 4; ++j) { v[j] = xr[64 * j]; s += (v[j][0] * v[j][0] + v[j][1] * v[j][1]) + (v[j][2] * v[j][2] + v[j][3] * v[j][3]); }
    s = wave_sum(s);
    if (fcopy) { f32x4* fc = (f32x4*)fcopy + lane;
#pragma unroll
        for (int j = 0; j < 4; ++j) fc[64 * j] = v[j]; }
    unsigned long long* o8 = (unsigned long long*)orow + lane;
#pragma unroll
    for (int j = 0; j < 4; ++j) o8[64 * j] = (unsigned long long)pk_bf16(v[j][0], v[j][1]) | ((unsigned long long)pk_bf16(v[j][2], v[j][3]) << 32);
    if (lane < 16) ss16[lane] = (lane == 0) ? s : 0.f;
}
__device__ __forceinline__ void build_jobs(const Args& a, LAS TJob* jobs, int tid) {
    if (tid < NJOBS) { TJob jb; make_job(tid, a, jb); LAS TJob* d = jobs + tid; d->src = jb.src; d->dst = jb.dst; d->gain = jb.gain; d->K = jb.K; d->N = jb.N; d->ld = jb.ld; d->map = jb.map; d->colbase = jb.colbase; d->q8 = jb.q8; d->smax = jb.smax; d->start = 0; d->startq = 0; d->f8 = jb.f8; d->startf = 0; }
    __syncthreads();
    if (tid == 0) { int s = 0, q = 0, f = 0; for (int j = 0; j < NJOBS; ++j) { jobs[j].start = s; jobs[j].startq = q; jobs[j].startf = f; if (jobs[j].q8) q += jobs[j].N / 64; else if (jobs[j].f8) f += jobs[j].N / 16; else s += (jobs[j].K / 64) * (jobs[j].N / 64); }
        jobs[NJOBS].start = s; jobs[NJOBS].startq = q; jobs[NJOBS].startf = f; }
    __syncthreads();
}
__device__ __forceinline__ void strip_q8(const LAS TJob* jobs, int& j, int st, LAS unsigned char* lds, int tid, int lane, int wave, float* cmaxbase) {
    while (st >= jobs[j + 1].startq) ++j;
    const LAS TJob* jb = jobs + j;
    TileRef r; r.src = (const GAS float*)jb->src; r.dst = (GAS bf16_t*)jb->dst; r.gain = (const GAS float*)jb->gain; r.K = jb->K; r.ld = jb->ld; r.map = jb->map; r.colbase = jb->colbase; r.q8 = 1; r.smax = jb->smax;
    r.n0 = (st - jb->startq) * 64; r.k0 = 128 * wave;
    LAS float* scr = (LAS float*)(lds + wave * 17408); LAS float* pmax = (LAS float*)(lds + 8 * 17408 + 4096); LAS float* cmf = pmax + 8 * 64;
    f32x4 v0[16], v1[16];
    tile_load(r, lane, v0); r.k0 += 64; tile_load(r, lane, v1); r.k0 -= 64;
    float m0 = 0.f, m1 = 0.f, m2 = 0.f, m3 = 0.f;
#pragma unroll
    for (int i = 0; i < 16; ++i) { const float g0 = r.gain ? r.gain[r.k0 + 4 * i + (lane >> 4)] : 1.f, g1 = r.gain ? r.gain[r.k0 + 64 + 4 * i + (lane >> 4)] : 1.f;
        v0[i] = v0[i] * g0; v1[i] = v1[i] * g1;
        m0 = fmaxf(m0, fmaxf(fabsf(v0[i][0]), fabsf(v1[i][0]))); m1 = fmaxf(m1, fmaxf(fabsf(v0[i][1]), fabsf(v1[i][1]))); m2 = fmaxf(m2, fmaxf(fabsf(v0[i][2]), fabsf(v1[i][2]))); m3 = fmaxf(m3, fmaxf(fabsf(v0[i][3]), fabsf(v1[i][3]))); }
    m0 = fmaxf(m0, __shfl_xor(m0, 16)); m1 = fmaxf(m1, __shfl_xor(m1, 16)); m2 = fmaxf(m2, __shfl_xor(m2, 16)); m3 = fmaxf(m3, __shfl_xor(m3, 16));
    m0 = fmaxf(m0, __shfl_xor(m0, 32)); m1 = fmaxf(m1, __shfl_xor(m1, 32)); m2 = fmaxf(m2, __shfl_xor(m2, 32)); m3 = fmaxf(m3, __shfl_xor(m3, 32));
    __syncthreads();
    if (lane < 16) *(LAS f32x4*)(pmax + wave * 64 + 4 * lane) = (f32x4){m0, m1, m2, m3};
    __syncthreads();
    if (tid < 64) { float m = pmax[tid];
#pragma unroll
        for (int w = 1; w < 8; ++w) m = fmaxf(m, pmax[w * 64 + tid]);
        cmf[tid] = m; cmaxbase[r.smax + r.n0 + tid] = m; }
    __syncthreads();
#pragma unroll
    for (int h = 0; h < 2; ++h) {
#pragma unroll
        for (int i = 0; i < 16; ++i) { LAS float* d = scr + (4 * i + (lane >> 4)) * 65 + 4 * (lane & 15); const f32x4 x = h ? v1[i] : v0[i]; d[0] = x[0]; d[1] = x[1]; d[2] = x[2]; d[3] = x[3]; }
        asm volatile("s_waitcnt lgkmcnt(0)" ::: "memory");
        const int kc = lane & 3;
#pragma unroll
        for (int jj = 0; jj < 4; ++jj) { const int n = (lane >> 2) + 16 * jj; const LAS float* s = scr + (16 * kc) * 65 + n;
            const float cm = cmf[n], inv = cm > 0.f ? 127.0f / cm : 0.f;
            v4u o; o.x = pk_i8x4(s[0 * 65] * inv, s[1 * 65] * inv, s[2 * 65] * inv, s[3 * 65] * inv); o.y = pk_i8x4(s[4 * 65] * inv, s[5 * 65] * inv, s[6 * 65] * inv, s[7 * 65] * inv);
            o.z = pk_i8x4(s[8 * 65] * inv, s[9 * 65] * inv, s[10 * 65] * inv, s[11 * 65] * inv); o.w = pk_i8x4(s[12 * 65] * inv, s[13 * 65] * inv, s[14 * 65] * inv, s[15 * 65] * inv);
            const int row = (r.map == 0) ? bt_row_std(r.colbase + r.n0 + n) : bt_row_swiglu(r.n0 + n, r.map - 1);
            *(GAS v4u*)((GAS unsigned char*)r.dst + (size_t)row * r.K + r.k0 + 64 * h + 16 * kc) = o; }
        asm volatile("s_waitcnt lgkmcnt(0)" ::: "memory");
    }
}
__device__ __forceinline__ void strip_f8(const LAS TJob* jobs, int& j, int st, LAS unsigned char* lds, int tid, int lane, int wave, float* cmaxbase) {
    while (st >= jobs[j + 1].startf) ++j;
    const LAS TJob* jb = jobs + j;
    const GAS float* src = (const GAS float*)jb->src; GAS unsigned char* dst = (GAS unsigned char*)jb->dst; const int K = jb->K, n0 = (st - jb->startf) * 16, smax = jb->smax, nq = K >> 2;
    const int c4 = tid & 3, q0 = tid >> 2;
    constexpr int RS8 = 3584 + 16;
    LAS float* pmax = (LAS float*)(lds + 8 * 17408 + 4096); LAS float* cmf = pmax + 8 * 16;
    f32x4 v[7][4];
#pragma unroll
    for (int i = 0; i < 7; ++i) { const int q = q0 + 128 * i; const GAS float* p = src + (size_t)(4 * q) * 1024 + n0 + 4 * c4;
#pragma unroll
        for (int kk = 0; kk < 4; ++kk) v[i][kk] = (q < nq) ? __builtin_nontemporal_load((const GAS f32x4*)(p + kk * 1024)) : (f32x4){0.f, 0.f, 0.f, 0.f}; }
    float m0 = 0.f, m1 = 0.f, m2 = 0.f, m3 = 0.f;
#pragma unroll
    for (int i = 0; i < 7; ++i)
#pragma unroll
        for (int kk = 0; kk < 4; ++kk) { m0 = fmaxf(m0, fabsf(v[i][kk][0])); m1 = fmaxf(m1, fabsf(v[i][kk][1])); m2 = fmaxf(m2, fabsf(v[i][kk][2])); m3 = fmaxf(m3, fabsf(v[i][kk][3])); }
#pragma unroll
    for (int o = 4; o < 64; o <<= 1) { m0 = fmaxf(m0, __shfl_xor(m0, o)); m1 = fmaxf(m1, __shfl_xor(m1, o)); m2 = fmaxf(m2, __shfl_xor(m2, o)); m3 = fmaxf(m3, __shfl_xor(m3, o)); }
    __syncthreads();
    if (lane < 4) *(LAS f32x4*)(pmax + wave * 16 + 4 * lane) = (f32x4){m0, m1, m2, m3};
    __syncthreads();
    if (tid < 16) { float m = pmax[tid];
#pragma unroll
        for (int w = 1; w < 8; ++w) m = fmaxf(m, pmax[w * 16 + tid]);
        cmf[tid] = m; cmaxbase[smax + n0 + tid] = m * (1.0f / (256.0f * H8_SCALE)); }
    __syncthreads();
    { const f32x4 cm = *(const LAS f32x4*)(cmf + 4 * c4); f32x4 inv;
#pragma unroll
      for (int jj = 0; jj < 4; ++jj) inv[jj] = cm[jj] > 0.f ? 256.0f / cm[jj] : 0.f;
#pragma unroll
      for (int i = 0; i < 7; ++i) { const int q = q0 + 128 * i;
          if (q < nq) {
#pragma unroll
              for (int jj = 0; jj < 4; ++jj) *(LAS unsigned*)(lds + (4 * c4 + jj) * RS8 + 4 * q) = pg8::pk_fp8x4(v[i][0][jj] * inv[jj], v[i][1][jj] * inv[jj], v[i][2][jj] * inv[jj], v[i][3][jj] * inv[jj]); } } }
    __syncthreads();
    { const int row = tid >> 5, t32 = tid & 31; GAS unsigned char* drow = dst + (size_t)bt_row_std(n0 + row) * K;
#pragma unroll
      for (int it = 0; it < 7; ++it) { const int ch = t32 + 32 * it; if (ch * 16 < K) *(GAS v4u*)(drow + ch * 16) = *(const LAS v4u*)(lds + row * RS8 + ch * 16); } }
}
__device__ __forceinline__ void phase_prologue(const Args& a, LAS unsigned char* lds, int tid, int lane, int wave) {
    unsigned char* ws = a.ws;
    LAS TJob* jobs = (LAS TJob*)(lds + 8 * 17408);
    build_jobs(a, jobs, tid);
    const int gw = blockIdx.x * NWAVES + wave, NGW = gridDim.x * NWAVES;
    { const int nstrip = jobs[NJOBS].startq; int js = 0;
      for (int st = blockIdx.x; st < nstrip; st += gridDim.x) strip_q8(jobs, js, st, lds, tid, lane, wave, (float*)(ws + WS_SW));
      __syncthreads(); }
    { const int nstrip = jobs[NJOBS].startf; int js = 0;
      const int first = (int)(((unsigned)blockIdx.x + gridDim.x - (unsigned)(jobs[NJOBS].startq % (int)gridDim.x)) % gridDim.x);
      for (int st = first; st < nstrip; st += gridDim.x) strip_f8(jobs, js, st, lds, tid, lane, wave, (float*)(ws + WS_SW));
      __syncthreads(); }
    {
        LAS float* scr = (LAS float*)(lds + wave * 17408);
        const int total = jobs[NJOBS].start; int j = 0;
        if (gw < total) {
            TileRef cur, nxt; f32x4 v[16], vn[16];
            tile_decode<false>(jobs, j, gw, cur); tile_load(cur, lane, v);
#pragma unroll 1
            for (int it = gw; it < total; it += NGW) {
                const bool more = it + NGW < total;
                if (more) { tile_decode<false>(jobs, j, it + NGW, nxt); tile_load(nxt, lane, vn); }
                tile_store(cur, lane, v, scr);
                if (more) { cur = nxt;
#pragma unroll
                    for (int i = 0; i < 16; ++i) v[i] = vn[i]; }
            }
        }
    }
#if I8_A
    for (int m = gw; m < T; m += NGW) row_to_i8(a.in[0] + (size_t)m * D, ws + WS_QX + (size_t)m * D, (float*)(ws + WS_SA) + m, lane);
#else
    for (int m = gw; m < T; m += NGW) row_to_bf16_ss(a.in[0] + (size_t)m * D, (bf16_t*)(ws + WS_XB) + (size_t)m * D, (float*)(ws + WS_SS) + (size_t)m * 16, nullptr, lane);
#endif
    for (int m = gw; m < NBATCH * MEML; m += NGW) row_to_bf16_ss(a.in[1] + (size_t)m * D, (bf16_t*)(ws + WS_MEMBF) + (size_t)m * D, (float*)(ws + WS_SSM) + (size_t)m * 16, nullptr, lane);
    {
        float* prm = (float*)(ws + WS_PARAM); const int gt = blockIdx.x * NTHR + tid, NGT = gridDim.x * NTHR;
        for (int i = gt; i < PB_END; i += NGT) { float v;
            if (i < PB_GQ) v = a.in[7][i]; else if (i < PB_GK) v = a.in[8][i - PB_GQ]; else if (i < PB_GOUT) v = a.in[9][i - PB_GK]; else if (i < PB_POOLS) v = a.in[14][i - PB_GOUT];
            else if (i < PB_MQN) v = a.in[16][i - PB_POOLS]; else if (i < PB_MKN) v = a.in[17][i - PB_MQN]; else if (i < PB_GFFN1) v = a.in[18][i - PB_MKN]; else if (i < PB_WR) v = a.in[4][D + i - PB_GFFN1];
            else if (i < PB_POOLW) v = a.in[27][i - PB_WR]; else v = a.in[15][i - PB_POOLW];
            prm[i] = v; }
        bf16_t* pwt = (bf16_t*)(ws + WS_POOLWT);
        for (int i = gt; i < 2 * 4 * 128 * 128; i += NGT) { const int lg = i >> 14, dout = (i >> 7) & 127, cc = i & 127; pwt[i] = (bf16_t)(pk_bf16(a.in[15][((size_t)lg * 128 + cc) * 128 + dout], 0.f) & 0xffffu); }
    }
    if (blockIdx.x == 0 && wave == 0) {
        float* sc = (float*)(ws + WS_SC);
        for (int l = 0; l < 2; ++l) {
            const float a1 = wave_sum(a.in[10][l * 64 + lane] * a.in[11][l * 64 + lane]), a2 = wave_sum(a.in[12][l * 64 + lane] * a.in[13][l * 64 + lane]);
            const float lam0 = (l == 0) ? 0.2f : (0.8f - 0.6f * 0.7408182206817179f);
            const float lam = __expf(a1) - __expf(a2) + lam0;
            float m0 = fabsf(a.in[8][l * 128 + lane] * a.in[9][l * 128 + lane]), m1 = fabsf(a.in[8][l * 128 + 64 + lane] * a.in[9][l * 128 + 64 + lane]);
            float mm = fmaxf(fabsf(a.in[17][l * 128 + lane] * a.in[18][l * 128 + lane]), fabsf(a.in[17][l * 128 + 64 + lane] * a.in[18][l * 128 + 64 + lane]));
#pragma unroll
            for (int o = 1; o < 64; o <<= 1) { m0 = fmaxf(m0, __shfl_xor(m0, o)); m1 = fmaxf(m1, __shfl_xor(m1, o)); mm = fmaxf(mm, __shfl_xor(mm, o)); }
            if (lane == 0) { sc[l * 8 + 0] = lam; sc[l * 8 + 1] = m0 * 64.f * QSCALE; sc[l * 8 + 2] = m1 * 64.f * QSCALE; sc[l * 8 + 3] = mm * 128.f * MEMSCALE; sc[l * 8 + 4] = 1.0f - lam0; }
        }
    }
}

__device__ __forceinline__ void unpack16(const bf16_t* src, float (&f)[16]) {
    const v4u a = *(const v4u*)src, b = *(const v4u*)(src + 8);
    f[0] = bf_lo(a.x); f[1] = bf_hi(a.x); f[2] = bf_lo(a.y); f[3] = bf_hi(a.y); f[4] = bf_lo(a.z); f[5] = bf_hi(a.z); f[6] = bf_lo(a.w); f[7] = bf_hi(a.w);
    f[8] = bf_lo(b.x); f[9] = bf_hi(b.x); f[10] = bf_lo(b.y); f[11] = bf_hi(b.y); f[12] = bf_lo(b.z); f[13] = bf_hi(b.z); f[14] = bf_lo(b.w); f[15] = bf_hi(b.w);
}
template <bool DIFF>
__device__ __forceinline__ void naive_attn_unit(LAS unsigned char* lds, int tid, const bf16_t* Qg, int ldq, const bf16_t* Kg, int ldk, const bf16_t* Vg, int ldv, bf16_t* Og, int ldo,
                                                int ntiles, int qpos0, const float* qmulA, const float* qmulB, const float* qss, float slope2, float bnd0, float bnd1, float lam, const float* gout, float outmul) {
    constexpr int QW = 4;
    LAS float* Lq = (LAS float*)lds; LAS float* Lk = Lq + 32 * 128; LAS float* Lv = Lk + 64 * 129; LAS float* Lp = Lv + 64 * 128; LAS float* Lrk = Lp + 8 * QW * 2 * 64;
    const int lane = tid & 63, wid = tid >> 6, r = tid >> 3, sg = tid & 7;
    __syncthreads();
    if (tid < 256) { float f[16]; unpack16(Qg + (size_t)r * ldq + sg * 16, f); float mul = 1.f;
      if (!DIFF) { const float s = qss[r * 8] + qss[r * 8 + 1]; mul = __builtin_amdgcn_rsqf(s * (1.f / 128.f) + 1e-6f) * MEMSCALE; }
#pragma unroll
      for (int i = 0; i < 16; ++i) Lq[r * 128 + sg * 16 + i] = DIFF ? f[i] : f[i] * mul * qmulA[sg * 16 + i] * qmulB[sg * 16 + i]; }
    float o0[QW][2], o1[QW][2], l0[QW], l1[QW];
#pragma unroll
    for (int q = 0; q < QW; ++q) { o0[q][0] = o0[q][1] = o1[q][0] = o1[q][1] = 0.f; l0[q] = l1[q] = 0.f; }
#pragma unroll 1
    for (int j = 0; j < ntiles; ++j) {
        __syncthreads();
        { float f[16]; unpack16(Kg + (size_t)(j * 64 + r) * ldk + sg * 16, f);
#pragma unroll
          for (int i = 0; i < 16; ++i) Lk[r * 129 + sg * 16 + i] = f[i];
          unpack16(Vg + (size_t)(j * 64 + r) * ldv + sg * 16, f);
#pragma unroll
          for (int i = 0; i < 16; ++i) Lv[r * 128 + sg * 16 + i] = f[i]; }
        __syncthreads();
        if (!DIFF) { if (tid < 64) { float s = 0.f;
#pragma unroll 4
            for (int d = 0; d < 128; ++d) { const float x = Lk[tid * 129 + d]; s += x * x; } Lrk[tid] = __builtin_amdgcn_rsqf(s * (1.f / 128.f) + 1e-6f); } __syncthreads(); }
        float s0[QW], s1[QW];
#pragma unroll
        for (int q = 0; q < QW; ++q) { s0[q] = 0.f; s1[q] = 0.f; }
#pragma unroll 1
        for (int d4 = 0; d4 < 16; ++d4) {
            const float k0 = Lk[lane * 129 + 4 * d4], k1 = Lk[lane * 129 + 4 * d4 + 1], k2 = Lk[lane * 129 + 4 * d4 + 2], k3 = Lk[lane * 129 + 4 * d4 + 3];
            const float e0 = Lk[lane * 129 + 64 + 4 * d4], e1 = Lk[lane * 129 + 64 + 4 * d4 + 1], e2 = Lk[lane * 129 + 64 + 4 * d4 + 2], e3 = Lk[lane * 129 + 64 + 4 * d4 + 3];
#pragma unroll
            for (int q = 0; q < QW; ++q) { const f32x4 qa = *(const LAS f32x4*)&Lq[(wid * QW + q) * 128 + 4 * d4], qb = *(const LAS f32x4*)&Lq[(wid * QW + q) * 128 + 64 + 4 * d4];
                s0[q] += (qa[0] * k0 + qa[1] * k1) + (qa[2] * k2 + qa[3] * k3); s1[q] += (qb[0] * e0 + qb[1] * e1) + (qb[2] * e2 + qb[3] * e3); }
        }
        const int kpos = j * 64 + lane;
#pragma unroll
        for (int q = 0; q < QW; ++q) { float p0, p1;
            if (DIFF) { const int qpos = qpos0 + wid * QW + q; const float bias = -slope2 * fabsf((float)(qpos - kpos)); p0 = __builtin_amdgcn_exp2f(s0[q] + bias - bnd0); p1 = __builtin_amdgcn_exp2f(s1[q] + bias - bnd1); }
            else { p0 = __builtin_amdgcn_exp2f((s0[q] + s1[q]) * Lrk[lane] - bnd0); p1 = 0.f; }
            l0[q] += p0; l1[q] += p1; Lp[((wid * QW + q) * 2 + 0) * 64 + lane] = p0; Lp[((wid * QW + q) * 2 + 1) * 64 + lane] = p1; }
        asm volatile("s_waitcnt lgkmcnt(0)" ::: "memory");
#pragma unroll 1
        for (int k4 = 0; k4 < 16; ++k4) {
            f32x2 v[4];
#pragma unroll
            for (int i = 0; i < 4; ++i) v[i] = *(const LAS f32x2*)&Lv[(4 * k4 + i) * 128 + 2 * lane];
#pragma unroll
            for (int q = 0; q < QW; ++q) { const f32x4 pa = *(const LAS f32x4*)&Lp[((wid * QW + q) * 2 + 0) * 64 + 4 * k4];
                o0[q][0] += (pa[0] * v[0][0] + pa[1] * v[1][0]) + (pa[2] * v[2][0] + pa[3] * v[3][0]); o0[q][1] += (pa[0] * v[0][1] + pa[1] * v[1][1]) + (pa[2] * v[2][1] + pa[3] * v[3][1]);
                if (DIFF) { const f32x4 pb = *(const LAS f32x4*)&Lp[((wid * QW + q) * 2 + 1) * 64 + 4 * k4];
                    o1[q][0] += (pb[0] * v[0][0] + pb[1] * v[1][0]) + (pb[2] * v[2][0] + pb[3] * v[3][0]); o1[q][1] += (pb[0] * v[0][1] + pb[1] * v[1][1]) + (pb[2] * v[2][1] + pb[3] * v[3][1]); } }
        }
    }
#pragma unroll
    for (int q = 0; q < QW; ++q) { const float L0 = wave_sum(l0[q]); float x = o0[q][0] / L0, y = o0[q][1] / L0;
        if (DIFF) { const float L1 = wave_sum(l1[q]); x -= lam * (o1[q][0] / L1); y -= lam * (o1[q][1] / L1);
            const float ss = wave_sum(x * x + y * y); const float rr = __builtin_amdgcn_rsqf(ss * (1.f / 128.f) + 1e-6f) * outmul; x *= rr * gout[2 * lane]; y *= rr * gout[2 * lane + 1]; }
        *(unsigned*)(Og + (size_t)(wid * QW + q) * ldo + 2 * lane) = pk_bf16(x, y); }
}
__device__ __forceinline__ void naive_pool_unit(LAS unsigned char* lds, int tid, const bf16_t* Pg  , bf16_t* Og  , const float* W  , const float* scale  , int tok0, int g) {
    LAS float* Lp = (LAS float*)lds; LAS float* Ld = Lp + 80 * 128;
    const int w = 2 << g, pos0 = tok0 & (SEQ - 1);
    __syncthreads();
    for (int i = tid; i < 80 * 8; i += NTHR) { const int rr = i >> 3, sg = i & 7; const int tpos = pos0 - 16 + rr;
        float f[16];
        if (tpos >= 0) unpack16(Pg + (size_t)(tok0 - 16 + rr) * 512 + g * 128 + sg * 16, f); else {
#pragma unroll
            for (int k = 0; k < 16; ++k) f[k] = 0.f; }
#pragma unroll
        for (int k = 0; k < 16; ++k) Lp[rr * 128 + sg * 16 + k] = f[k]; }
    __syncthreads();
    for (int i = tid; i < 64 * 128; i += NTHR) { const int t = i >> 7, c = i & 127; const int tpos = pos0 + t; const int lo = (tpos + 1 - w) > 0 ? (tpos + 1 - w) : 0; const int cnt = tpos + 1 - lo;
        float s = 0.f;
#pragma unroll 1
        for (int k = 0; k < cnt; ++k) s += Lp[(16 + t - k) * 128 + c];
        Ld[t * 128 + c] = s / (float)cnt - Lp[(16 + t) * 128 + c]; }
    __syncthreads();
    const int dout = tid & 127, tq = tid >> 7; float acc[16];
#pragma unroll
    for (int i = 0; i < 16; ++i) acc[i] = 0.f;
#pragma unroll 2
    for (int c = 0; c < 128; ++c) { const float wv = W[c * 128 + dout];
#pragma unroll
        for (int i = 0; i < 16; ++i) acc[i] += Ld[(tq * 16 + i) * 128 + c] * wv; }
    const float sc = scale[dout];
#pragma unroll
    for (int i = 0; i < 16; ++i) Og[(size_t)(tok0 + tq * 16 + i) * 512 + g * 128 + dout] = (bf16_t)(pk_bf16(acc[i] * sc, 0.f) & 0xffffu);
}

namespace mix {
typedef short bf16x8 __attribute__((ext_vector_type(8)));
typedef short s16x4 __attribute__((ext_vector_type(4)));
typedef float f32x16 __attribute__((ext_vector_type(16)));
typedef const LAS unsigned char* lptr;
#define SBAR() __builtin_amdgcn_sched_barrier(0)
__device__ __forceinline__ unsigned lds_addr(lptr p) { return (unsigned)(uintptr_t)p; }
__device__ __forceinline__ bf16x8 pack8(const f32x16& p, int b) {
    v4u w; w.x = pk_bf16(p[b], p[b + 1]); w.y = pk_bf16(p[b + 2], p[b + 3]); w.z = pk_bf16(p[b + 4], p[b + 5]); w.w = pk_bf16(p[b + 6], p[b + 7]);
    return __builtin_bit_cast(bf16x8, w);
}
__device__ __forceinline__ void glds16(const void* g, LAS unsigned char* l) { __builtin_amdgcn_global_load_lds((const unsigned*)g, (LAS unsigned*)l, 16, 0, 0); }
#define MFMA32(a, b, c) __builtin_amdgcn_mfma_f32_32x32x16_bf16(a, b, c, 0, 0, 0)

#define VRD(set, db) do { _Pragma("unroll") for (int t_ = 0; t_ < 4; ++t_) { \
        asm volatile("ds_read_b64_tr_b16 %0, %1 offset:%c2" : "=&v"(lo[set][t_]) : "v"(va[db]), "i"(t_ * 4096) : "memory"); \
        asm volatile("ds_read_b64_tr_b16 %0, %1 offset:%c2" : "=&v"(hi[set][t_]) : "v"(va[db]), "i"(t_ * 4096 + 2048) : "memory"); } } while (0)
#define VPK(set, t) (bf16x8){lo[set][t][0], lo[set][t][1], lo[set][t][2], lo[set][t][3], hi[set][t][0], hi[set][t][1], hi[set][t][2], hi[set][t][3]}
__device__ __forceinline__ void pv_tile(f32x16 (&O)[4], const unsigned (&va)[4], const bf16x8 (&pb)[4]) {
    s16x4 lo[2][4], hi[2][4];
    VRD(0, 0);
    VRD(1, 1); asm volatile("s_waitcnt lgkmcnt(8)" ::: "memory"); SBAR();
#pragma unroll
    for (int t = 0; t < 4; ++t) O[0] = MFMA32(VPK(0, t), pb[t], O[0]);
    SBAR(); VRD(0, 2); asm volatile("s_waitcnt lgkmcnt(8)" ::: "memory"); SBAR();
#pragma unroll
    for (int t = 0; t < 4; ++t) O[1] = MFMA32(VPK(1, t), pb[t], O[1]);
    SBAR(); VRD(1, 3); asm volatile("s_waitcnt lgkmcnt(8)" ::: "memory"); SBAR();
#pragma unroll
    for (int t = 0; t < 4; ++t) O[2] = MFMA32(VPK(0, t), pb[t], O[2]);
    SBAR(); asm volatile("s_waitcnt lgkmcnt(0)" ::: "memory"); SBAR();
#pragma unroll
    for (int t = 0; t < 4; ++t) O[3] = MFMA32(VPK(1, t), pb[t], O[3]);
}
__device__ __forceinline__ void kread8_swz(bf16x8 (&kf)[8], const unsigned (&ka)[4]) {
#define KRD(i, a, off) asm volatile("ds_read_b128 %0, %1 offset:%c2" : "=&v"(kf[i]) : "v"(a), "i"(off) : "memory")
    KRD(0, ka[0], 0); KRD(1, ka[0], 8192); KRD(2, ka[1], 0); KRD(3, ka[1], 8192); KRD(4, ka[2], 0); KRD(5, ka[2], 8192); KRD(6, ka[3], 0); KRD(7, ka[3], 8192);
#undef KRD
}
__device__ __forceinline__ void kread8(bf16x8 (&kf)[8], unsigned ka) {
#define KRD(i, off) asm volatile("ds_read_b128 %0, %1 offset:%c2" : "=&v"(kf[i]) : "v"(ka), "i"(off) : "memory")
    KRD(0, 0); KRD(1, 512); KRD(2, 2048); KRD(3, 2560); KRD(4, 4096); KRD(5, 4608); KRD(6, 6144); KRD(7, 6656);
#undef KRD
}

__device__ __forceinline__ void da_bias(f32x16& p0, f32x16& p1, int jt, int cq, float xq, float sl2, float B2) {
    const float x = (float)(64 * jt) - xq;
    const float Be = (jt > cq) ? 1.0e30f : B2;
#pragma unroll
    for (int r = 0; r < 16; ++r) { const float kr = (float)((r & 3) + 8 * (r >> 2)); p0[r] = __builtin_fmaf(-sl2, __builtin_fabsf(x + kr), -Be); p1[r] = __builtin_fmaf(-sl2, __builtin_fabsf(x + (32.f + kr)), -Be); }
}
__device__ __forceinline__ void diffattn_unit(LAS unsigned char* lds, int tid, const bf16_t* Qg, const bf16_t* Kg, const bf16_t* Vg, bf16_t* Og, int b, int h, int u, bool desc, float sl2, float B2, float lam, const float* gout, float outmul) {
    asm volatile("" : "+v"(tid));
    const int lane = tid & 63, wid = __builtin_amdgcn_readfirstlane(tid >> 6), map = wid >> 2, wi = wid & 3, r32 = lane & 31, hi = lane >> 5;
    const int q0 = u * 128 + wi * 32, cq = q0 >> 6, NT = 2 * u + 2;
    const size_t rowb = (size_t)b * SEQ;
    const bf16_t* qrow = Qg + (rowb + q0 + r32) * 1024 + h * 128;
    bf16x8 qf[4];
#pragma unroll
    for (int s = 0; s < 4; ++s) qf[s] = *(const bf16x8*)(qrow + map * 64 + s * 16 + hi * 8);
    unsigned koff0, voff0;
    { const int row = 8 * wid + (lane >> 4), slot = lane & 15;
      koff0 = (unsigned)(row * 1024 + ((slot ^ (row & 15)) * 8));
      voff0 = (unsigned)(row * 1024 + (((slot >> 2) ^ (row & 3)) * 32 + (slot & 3) * 8)); }
    const bf16_t* Kbh = Kg + rowb * 1024 + h * 128; const bf16_t* Vbh = Vg + rowb * 1024 + h * 128;
#define JT(i) (desc ? NT - 1 - (i) : (i))
#define DA_DMA(i) do { const int j_ = JT(i), sl_ = (i) & 3; _Pragma("unroll") for (int i_ = 0; i_ < 2; ++i_) { \
        glds16(Kbh + (size_t)j_ * 65536 + (i_ ? (koff0 ^ 32u) + 4096u : koff0), lds + sl_ * 32768 + (2 * wid + i_) * 1024); \
        glds16(Vbh + (size_t)j_ * 65536 + (i_ ? voff0 + 4096u : voff0), lds + sl_ * 32768 + 16384 + (2 * wid + i_) * 1024); } } while (0)
    f32x16 O[4];
#pragma unroll
    for (int db = 0; db < 4; ++db)
#pragma unroll
        for (int r = 0; r < 16; ++r) O[db][r] = 0.f;
    float lsum = 0.f;
    const float xq = (float)(q0 + r32 - 4 * hi);
    unsigned ka_0, va_0;
    { const unsigned l0 = lds_addr((lptr)lds); const int qp = (lane & 15) >> 2;
      ka_0 = l0 + r32 * 256 + (((map * 8 + hi) ^ (r32 & 15)) << 4);
      va_0 = l0 + 16384 + (4 * hi + qp) * 256 + (qp << 6) + ((lane >> 4) & 1) * 32 + (lane & 3) * 8; }
    __syncthreads();
    asm volatile("" : "+v"(qf[0]), "+v"(qf[1]), "+v"(qf[2]), "+v"(qf[3]));
    DA_DMA(0); DA_DMA(1);
    if (NT > 2) { DA_DMA(2); asm volatile("s_waitcnt vmcnt(4)" ::: "memory"); } else asm volatile("s_waitcnt vmcnt(0)" ::: "memory");
    __builtin_amdgcn_s_barrier();
    f32x16 pA0, pA1, pB0, pB1;
    { da_bias(pA0, pA1, JT(0), cq, xq, sl2, B2);
      unsigned ka[4];
#pragma unroll
      for (int s = 0; s < 4; ++s) ka[s] = ka_0 ^ (s << 5);
      bf16x8 kf[8]; kread8_swz(kf, ka); asm volatile("s_waitcnt lgkmcnt(0)" ::: "memory"); SBAR();
#pragma unroll
      for (int s = 0; s < 4; ++s) { pA0 = MFMA32(kf[2 * s], qf[s], pA0); pA1 = MFMA32(kf[2 * s + 1], qf[s], pA1); }
      asm volatile("s_nop 15\n\ts_nop 15" : "+v"(pA0), "+v"(pA1)); }
    da_bias(pB0, pB1, JT(1), cq, xq, sl2, B2);
#define SM4(P, b_) do { P[b_] = __builtin_amdgcn_exp2f(P[b_]); P[b_ + 1] = __builtin_amdgcn_exp2f(P[b_ + 1]); P[b_ + 2] = __builtin_amdgcn_exp2f(P[b_ + 2]); P[b_ + 3] = __builtin_amdgcn_exp2f(P[b_ + 3]); \
        lsum += (P[b_] + P[b_ + 1]) + (P[b_ + 2] + P[b_ + 3]); } while (0)
#define MFMA_A(acc, a_, b_) asm volatile("v_mfma_f32_32x32x16_bf16 %0, %1, %2, %0" : "+v"(acc) : "v"(a_), "v"(b_))
#define PIN(x_) asm volatile("" : "+v"(x_))
#define FMK(dst, krv) do { float f_; asm volatile("v_fmamk_f32 %0, %1, %c2, %3" : "=v"(f_) : "v"(sl2), "i"(__builtin_bit_cast(int, (float)(krv))), "v"(c0_)); dst = f_; } while (0)
#define FM2(C0, C1, j) do { FMK(C0[j], ((j) & 3) + 8 * ((j) >> 2)); FMK(C1[j], 32 + ((j) & 3) + 8 * ((j) >> 2)); } while (0)
#define DA_STEP(C0, C1, N0, N1, i) do { \
        if ((i) + 3 < NT) DA_DMA((i) + 3); \
        bf16x8 pb[4]; \
        { unsigned ka[4]; _Pragma("unroll") for (int s_ = 0; s_ < 4; ++s_) ka[s_] = (ka_0 + (((i) + 1) & 3) * 32768) ^ (s_ << 5); \
          bf16x8 kf[8]; kread8_swz(kf, ka); asm volatile("s_waitcnt lgkmcnt(0)" ::: "memory"); \
          MFMA_A(N0, kf[0], qf[0]); SM4(C0, 0);  PIN(C0); PIN(lsum); \
          MFMA_A(N1, kf[1], qf[0]); SM4(C0, 4);  PIN(C0); PIN(lsum); \
          MFMA_A(N0, kf[2], qf[1]); SM4(C0, 8);  PIN(C0); PIN(lsum); pb[0] = pack8(C0, 0); PIN(pb[0]); \
          MFMA_A(N1, kf[3], qf[1]); SM4(C0, 12); PIN(C0); PIN(lsum); pb[1] = pack8(C0, 8); PIN(pb[1]); \
          MFMA_A(N0, kf[4], qf[2]); SM4(C1, 0);  PIN(C1); PIN(lsum); \
          MFMA_A(N1, kf[5], qf[2]); SM4(C1, 4);  PIN(C1); PIN(lsum); \
          MFMA_A(N0, kf[6], qf[3]); SM4(C1, 8);  PIN(C1); PIN(lsum); pb[2] = pack8(C1, 0); PIN(pb[2]); \
          MFMA_A(N1, kf[7], qf[3]); SM4(C1, 12); PIN(C1); PIN(lsum); pb[3] = pack8(C1, 8); PIN(pb[3]); } \
        { unsigned va[4]; _Pragma("unroll") for (int d_ = 0; d_ < 4; ++d_) va[d_] = (va_0 + ((i) & 3) * 32768) ^ (d_ << 6); \
          s16x4 lo[2][4], hi[2][4]; \
          const int jt2_ = JT((i) + 2); \
          float c0_ = __builtin_fmaf(sl2s, (float)(64 * jt2_) - xq, (jt2_ > cq) ? -1.0e30f : -B2); PIN(c0_); \
          VRD(0, 0); VRD(1, 1); asm volatile("s_waitcnt lgkmcnt(8)" ::: "memory"); \
          _Pragma("unroll") for (int t_ = 0; t_ < 4; ++t_) { const bf16x8 vf_ = VPK(0, t_); MFMA_A(O[0], vf_, pb[t_]); FM2(C0, C1, t_); } \
          VRD(0, 2); asm volatile("s_waitcnt lgkmcnt(8)" ::: "memory"); \
          _Pragma("unroll") for (int t_ = 0; t_ < 4; ++t_) { const bf16x8 vf_ = VPK(1, t_); MFMA_A(O[1], vf_, pb[t_]); FM2(C0, C1, 4 + t_); } \
          VRD(1, 3); asm volatile("s_waitcnt lgkmcnt(8)" ::: "memory"); \
          _Pragma("unroll") for (int t_ = 0; t_ < 4; ++t_) { const bf16x8 vf_ = VPK(0, t_); MFMA_A(O[2], vf_, pb[t_]); FM2(C0, C1, 8 + t_); } \
          asm volatile("s_waitcnt lgkmcnt(0)" ::: "memory"); \
          _Pragma("unroll") for (int t_ = 0; t_ < 4; ++t_) { const bf16x8 vf_ = VPK(1, t_); MFMA_A(O[3], vf_, pb[t_]); FM2(C0, C1, 12 + t_); } \
          PIN(C0); PIN(C1); \
          if (jt2_ == cq) { da_bias(C0, C1, jt2_, cq, xq, sl2, B2); PIN(C0); PIN(C1); } } \
        if ((i) + 3 < NT) asm volatile("s_waitcnt vmcnt(4) lgkmcnt(0)" ::: "memory"); else asm volatile("s_waitcnt vmcnt(0) lgkmcnt(0)" ::: "memory"); \
        __builtin_amdgcn_s_barrier(); \
    } while (0)
    const float sl2s = __builtin_bit_cast(float, __builtin_amdgcn_readfirstlane(__builtin_bit_cast(int, sl2)));
#pragma unroll 1
    for (int i = 0; i < NT; i += 2) {
        DA_STEP(pA0, pA1, pB0, pB1, i);
        DA_STEP(pB0, pB1, pA0, pA1, i + 1);
    }
#undef DA_STEP
#undef FM2
#undef FMK
#undef MFMA_A
#undef PIN
#undef SM4
    asm volatile("s_nop 15\n\ts_nop 15" : "+v"(O[0]), "+v"(O[1]), "+v"(O[2]), "+v"(O[3]));
#undef DA_DMA
#undef JT
    lsum += __shfl_xor(lsum, 32);
    const float inv = 1.0f / lsum;
    LAS f32x4* xch = (LAS f32x4*)(lds + wi * 16384) + lane;
    if (map == 1) {
        const float f = lam * inv;
#pragma unroll
        for (int db = 0; db < 4; ++db)
#pragma unroll
            for (int g = 0; g < 4; ++g) xch[(db * 4 + g) * 64] = (f32x4){O[db][4 * g] * f, O[db][4 * g + 1] * f, O[db][4 * g + 2] * f, O[db][4 * g + 3] * f};
    }
    __syncthreads();
    if (map == 0) {
        float ss = 0.f;
#pragma unroll
        for (int db = 0; db < 4; ++db)
#pragma unroll
            for (int g = 0; g < 4; ++g) { const f32x4 o1 = xch[(db * 4 + g) * 64];
#pragma unroll
                for (int i = 0; i < 4; ++i) { const float v = O[db][4 * g + i] * inv - o1[i]; O[db][4 * g + i] = v; ss += v * v; } }
        ss += __shfl_xor(ss, 32);
        const float rr = __builtin_amdgcn_rsqf(ss * (1.f / 128.f) + 1e-6f) * outmul;
        bf16_t* orow = Og + (rowb + q0 + r32) * 1024 + h * 128 + 4 * hi;
#pragma unroll
        for (int db = 0; db < 4; ++db)
#pragma unroll
            for (int g = 0; g < 4; ++g) { const f32x4 gv = *(const f32x4*)(gout + 32 * db + 8 * g + 4 * hi);
                const unsigned w0 = pk_bf16(O[db][4 * g] * rr * gv[0], O[db][4 * g + 1] * rr * gv[1]), w1 = pk_bf16(O[db][4 * g + 2] * rr * gv[2], O[db][4 * g + 3] * rr * gv[3]);
                *(unsigned long long*)(orow + 32 * db + 8 * g) = (unsigned long long)w0 | ((unsigned long long)w1 << 32); }
    }
    __syncthreads();
}

__device__ __forceinline__ void memattn_unit(LAS unsigned char* lds, int tid, bf16_t* MQg, bf16_t* Og, const bf16_t* KVg, const float* mqss, const float* qn, const float* kn, int pm, int hd, float Bm) {
    const int lane = tid & 63, wid = __builtin_amdgcn_readfirstlane(tid >> 6), r32 = lane & 31, hi = lane >> 5;
    const int b = pm >> 3; const size_t row = (size_t)pm * 256 + wid * 32 + r32;
    __syncthreads();
#pragma unroll
    for (int i = 0; i < 8; ++i) { const int p = 8 * wid + i, vrow = 4 * p + (lane >> 4), slot = lane & 15;
        glds16(KVg + ((size_t)b * MEML + vrow) * 2048 + 512 + hd * 128 + (((slot >> 2) ^ (vrow & 3)) * 32 + (slot & 3) * 8), lds + 65536 + p * 1024); }
    { const int key = tid >> 1, half = tid & 1; const bf16_t* src = KVg + ((size_t)b * MEML + key) * 2048 + hd * 128 + half * 64;
      v4u raw[8]; float s = 0.f;
#pragma unroll
      for (int c = 0; c < 8; ++c) { raw[c] = *(const v4u*)(src + c * 8);
          const float a0 = bf_lo(raw[c].x), a1 = bf_hi(raw[c].x), a2 = bf_lo(raw[c].y), a3 = bf_hi(raw[c].y), a4 = bf_lo(raw[c].z), a5 = bf_hi(raw[c].z), a6 = bf_lo(raw[c].w), a7 = bf_hi(raw[c].w);
          s += ((a0 * a0 + a1 * a1) + (a2 * a2 + a3 * a3)) + ((a4 * a4 + a5 * a5) + (a6 * a6 + a7 * a7)); }
      s += __shfl_xor(s, 1);
      const float rk = __builtin_amdgcn_rsqf(s * (1.f / 128.f) + 1e-6f) * MEMSCALE;
#pragma unroll
      for (int c = 0; c < 8; ++c) { const int d0 = half * 64 + c * 8; const f32x4 qa = *(const f32x4*)(qn + d0), qb = *(const f32x4*)(qn + d0 + 4), ka = *(const f32x4*)(kn + d0), kb = *(const f32x4*)(kn + d0 + 4);
          v4u w; w.x = pk_bf16(bf_lo(raw[c].x) * rk * qa[0] * ka[0], bf_hi(raw[c].x) * rk * qa[1] * ka[1]); w.y = pk_bf16(bf_lo(raw[c].y) * rk * qa[2] * ka[2], bf_hi(raw[c].y) * rk * qa[3] * ka[3]);
          w.z = pk_bf16(bf_lo(raw[c].z) * rk * qb[0] * kb[0], bf_hi(raw[c].z) * rk * qb[1] * kb[1]); w.w = pk_bf16(bf_lo(raw[c].w) * rk * qb[2] * kb[2], bf_hi(raw[c].w) * rk * qb[3] * kb[3]);
          *(LAS v4u*)(lds + (key >> 6) * 16384 + (half * 8 + c) * 1024 + (key & 63) * 16) = w; } }
    const bf16_t* qrow = MQg + row * 512 + hd * 128;
    bf16x8 qf[8];
#pragma unroll
    for (int s = 0; s < 8; ++s) qf[s] = *(const bf16x8*)(qrow + s * 16 + hi * 8);
    const float rq = __builtin_amdgcn_rsqf((mqss[row * 8 + hd * 2] + mqss[row * 8 + hd * 2 + 1]) * (1.f / 128.f) + 1e-6f);
    f32x16 O[4];
#pragma unroll
    for (int db = 0; db < 4; ++db)
#pragma unroll
        for (int r = 0; r < 16; ++r) O[db][r] = 0.f;
    float lsum = 0.f;
    const lptr kl0 = (lptr)lds + hi * 1024 + r32 * 16;
    unsigned va0[4];
    { const int qp = (lane & 15) >> 2;
#pragma unroll
      for (int db = 0; db < 4; ++db) va0[db] = lds_addr((lptr)lds) + 65536 + (4 * hi + qp) * 256 + ((db ^ qp) * 64) + ((lane >> 4) & 1) * 32 + (lane & 3) * 8; }
    __syncthreads();
#pragma unroll 1
    for (int tl = 0; tl < 4; ++tl) {
        f32x16 p0, p1;
#pragma unroll
        for (int r = 0; r < 16; ++r) { p0[r] = 0.f; p1[r] = 0.f; }
        bf16x8 kf[8], kg[8]; kread8(kf, lds_addr(kl0) + tl * 16384); kread8(kg, lds_addr(kl0) + tl * 16384 + 8192);
        asm volatile("s_waitcnt lgkmcnt(8)" ::: "memory"); SBAR();
#pragma unroll
        for (int s = 0; s < 4; ++s) { p0 = MFMA32(kf[2 * s], qf[s], p0); p1 = MFMA32(kf[2 * s + 1], qf[s], p1); }
        SBAR(); asm volatile("s_waitcnt lgkmcnt(0)" ::: "memory"); SBAR();
#pragma unroll
        for (int s = 0; s < 4; ++s) { p0 = MFMA32(kg[2 * s], qf[4 + s], p0); p1 = MFMA32(kg[2 * s + 1], qf[4 + s], p1); }
#pragma unroll
        for (int r = 0; r < 16; ++r) { p0[r] = __builtin_amdgcn_exp2f(__builtin_fmaf(p0[r], rq, -Bm)); p1[r] = __builtin_amdgcn_exp2f(__builtin_fmaf(p1[r], rq, -Bm)); lsum += p0[r] + p1[r]; }
        bf16x8 pb[4]; pb[0] = pack8(p0, 0); pb[1] = pack8(p0, 8); pb[2] = pack8(p1, 0); pb[3] = pack8(p1, 8);
        unsigned va[4];
#pragma unroll
        for (int db = 0; db < 4; ++db) va[db] = va0[db] + tl * 16384;
        pv_tile(O, va, pb);
    }
    lsum += __shfl_xor(lsum, 32);
    const float inv = 1.0f / lsum;
    bf16_t* orow = Og + row * 512 + hd * 128 + 4 * hi;
#pragma unroll
    for (int db = 0; db < 4; ++db)
#pragma unroll
        for (int g = 0; g < 4; ++g) { const unsigned w0 = pk_bf16(O[db][4 * g] * inv, O[db][4 * g + 1] * inv), w1 = pk_bf16(O[db][4 * g + 2] * inv, O[db][4 * g + 3] * inv);
            *(unsigned long long*)(orow + 32 * db + 8 * g) = (unsigned long long)w0 | ((unsigned long long)w1 << 32); }
}

__device__ __forceinline__ void pool_unit(LAS unsigned char* lds, int tid, const bf16_t* Pg, bf16_t* Og, const bf16_t* Wt, const float* scale, int tok0, int g) {
    const int lane = tid & 63, wid = __builtin_amdgcn_readfirstlane(tid >> 6), r32 = lane & 31, hi = lane >> 5;
    LAS unsigned char* Lp = lds; LAS unsigned char* Ld = lds + 272 * 256;
    const int w = 2 << g, pos0 = tok0 & (SEQ - 1);
    __syncthreads();
    { v4u st[9];
#pragma unroll
      for (int k = 0; k < 9; ++k) { const int i = tid + k * NTHR, ii = i < 272 * 16 ? i : tid, rr = ii >> 4, ch = ii & 15; const bool ok = pos0 - 16 + rr >= 0;
          const v4u v = *(const v4u*)(Pg + (size_t)(tok0 - 16 + (ok ? rr : 16)) * 512 + g * 128 + ch * 8); st[k].x = ok ? v.x : 0u; st[k].y = ok ? v.y : 0u; st[k].z = ok ? v.z : 0u; st[k].w = ok ? v.w : 0u; }
#pragma unroll
      for (int k = 0; k < 9; ++k) { const int i = tid + k * NTHR, rr = i >> 4, ch = i & 15; if (i < 272 * 16) *(LAS v4u*)(Lp + rr * 256 + ch * 16) = st[k]; } }
    bf16x8 wf[4][8];
#pragma unroll
    for (int db = 0; db < 4; ++db)
#pragma unroll
        for (int s = 0; s < 8; ++s) wf[db][s] = *(const bf16x8*)(Wt + (size_t)(32 * db + r32) * 128 + hi * 8 + s * 16);
    __syncthreads();
    { const int ch = tid & 15, t0 = (tid >> 4) * 8;
      float s[8];
#pragma unroll
      for (int i = 0; i < 8; ++i) s[i] = 0.f;
#pragma unroll 1
      for (int k = 1; k < w; ++k) { const v4u v = *(const LAS v4u*)(Lp + (16 + t0 - k) * 256 + ch * 16);
          s[0] += bf_lo(v.x); s[1] += bf_hi(v.x); s[2] += bf_lo(v.y); s[3] += bf_hi(v.y); s[4] += bf_lo(v.z); s[5] += bf_hi(v.z); s[6] += bf_lo(v.w); s[7] += bf_hi(v.w); }
#pragma unroll
      for (int tt = 0; tt < 8; ++tt) { const int t = t0 + tt, tpos = pos0 + t; const int cnt = (tpos + 1 < w) ? (tpos + 1) : w; const float ic = 1.0f / (float)cnt;
          const v4u v = *(const LAS v4u*)(Lp + (16 + t) * 256 + ch * 16), o = *(const LAS v4u*)(Lp + (16 + t - w + 1) * 256 + ch * 16);
          float p[8] = {bf_lo(v.x), bf_hi(v.x), bf_lo(v.y), bf_hi(v.y), bf_lo(v.z), bf_hi(v.z), bf_lo(v.w), bf_hi(v.w)};
          float q[8] = {bf_lo(o.x), bf_hi(o.x), bf_lo(o.y), bf_hi(o.y), bf_lo(o.z), bf_hi(o.z), bf_lo(o.w), bf_hi(o.w)};
          float d[8];
#pragma unroll
          for (int i = 0; i < 8; ++i) { s[i] += p[i]; d[i] = s[i] * ic - p[i]; s[i] -= q[i]; }
          v4u wv; wv.x = pk_bf16(d[0], d[1]); wv.y = pk_bf16(d[2], d[3]); wv.z = pk_bf16(d[4], d[5]); wv.w = pk_bf16(d[6], d[7]);
          *(LAS v4u*)(Ld + t * 256 + ((ch ^ (t & 15)) << 4)) = wv; } }
    __syncthreads();
    const int tok = wid * 32 + r32;
    bf16x8 df[8];
#pragma unroll
    for (int s = 0; s < 8; ++s) df[s] = *(const LAS bf16x8*)(Ld + tok * 256 + (((2 * s + hi) ^ (tok & 15)) << 4));
    bf16_t* orow = Og + (size_t)(tok0 + tok) * 512 + g * 128 + 4 * hi;
#pragma unroll
    for (int db = 0; db < 4; ++db) {
        f32x16 acc;
#pragma unroll
        for (int r = 0; r < 16; ++r) acc[r] = 0.f;
#pragma unroll
        for (int s = 0; s < 8; ++s) acc = MFMA32(wf[db][s], df[s], acc);
#pragma unroll
        for (int gq = 0; gq < 4; ++gq) { const f32x4 sc = *(const f32x4*)(scale + 32 * db + 8 * gq + 4 * hi);
            const unsigned w0 = pk_bf16(acc[4 * gq] * sc[0], acc[4 * gq + 1] * sc[1]), w1 = pk_bf16(acc[4 * gq + 2] * sc[2], acc[4 * gq + 3] * sc[3]);
            *(unsigned long long*)(orow + 32 * db + 8 * gq) = (unsigned long long)w0 | ((unsigned long long)w1 << 32); }
    }
}
#undef MFMA32
#undef VRD
#undef VPK
#undef SBAR
}

#ifndef MIX_NAIVE_DA
#define MIX_NAIVE_DA 0
#endif
#ifndef MIX_NAIVE_MEM
#define MIX_NAIVE_MEM 0
#endif
#ifndef MIX_NAIVE_POOL
#define MIX_NAIVE_POOL 0
#endif
__device__ __forceinline__ void phase_mixers(unsigned char* ws, LAS unsigned char* lds, int l, int tid) {
    const float* prm = (const float*)(ws + WS_PARAM); const float* sc = (const float*)(ws + WS_SC) + l * 8;
    const float lam = ld_f32_agent(sc + 0), bnd0 = ld_f32_agent(sc + 1), bnd1 = ld_f32_agent(sc + 2), bndm = ld_f32_agent(sc + 3), omul = ld_f32_agent(sc + 4);
    const int bx = blockIdx.x, vcu = (gridDim.x == 256) ? ((bx & 7) * 32 + (bx >> 3)) : bx;
    bf16_t* Q = (bf16_t*)(ws + WS_Q); const bf16_t* K = (const bf16_t*)(ws + WS_K); const bf16_t* V = (const bf16_t*)(ws + WS_V);
    bf16_t* MQ = (bf16_t*)(ws + WS_MQ); const bf16_t* KV = (const bf16_t*)(ws + WS_MEMKV) + l * 1024;     const float* mqss = (const float*)(ws + WS_MQSS);
#if MIX_NAIVE_DA
    for (int u = blockIdx.x; u < 4096; u += gridDim.x) { const int hc = 63 - (u >> 6), c = hc >> 1, bh = u & 63, b = bh >> 3, h = bh & 7;
        const size_t rowb = (size_t)b * SEQ; const float slope2 = exp2f(-(float)(h + 1)) * LOG2E;
        naive_attn_unit<true>(lds, tid, Q + (rowb + hc * 32) * 1024 + h * 128, 1024, K + rowb * 1024 + h * 128, 1024, V + rowb * 1024 + h * 128, 1024, (bf16_t*)(ws + WS_XB) + (rowb + hc * 32) * 1024 + h * 128, 1024,
                              c + 1, hc * 32, nullptr, nullptr, nullptr, slope2, bnd0, bnd1, lam, prm + PB_GOUT + l * 128, omul); }
#else
    {
        const float B2 = fmaxf(bnd0, bnd1);
        for (int rep_ = 0; rep_ < REP_DA; ++rep_)
        for (int w = vcu; w < 256; w += gridDim.x) { const int bh = w >> 2, s = w & 3, b = bh >> 3, h = bh & 7; const float sl2 = exp2f(-(float)(h + 1)) * LOG2E;
#pragma unroll 1
            for (int i = 0; i < 4; ++i) { const int u = (i == 0) ? 15 - s : (i == 1) ? 8 + s : (i == 2) ? 7 - s : s;
                mix::diffattn_unit(lds, tid, Q, K, V, (bf16_t*)(ws + WS_XB), b, h, u, (i & 1) != 0, sl2, B2, lam, prm + PB_GOUT + l * 128, omul); } }
    }
#endif
#if MIX_NAIVE_MEM
    for (int u = blockIdx.x; u < 2048; u += gridDim.x) { const int qt = u >> 2, hd = u & 3, b = qt >> 6; const size_t row0 = (size_t)qt * 32;
        naive_attn_unit<false>(lds, tid, MQ + row0 * 512 + hd * 128, 512, KV + (size_t)b * MEML * 2048 + hd * 128, 2048, KV + (size_t)b * MEML * 2048 + 512 + hd * 128, 2048, MQ + row0 * 512 + hd * 128, 512,
                               4, 0, prm + PB_MQN + l * 128, prm + PB_MKN + l * 128, mqss + row0 * 8 + hd * 2, 0.f, bndm, 0.f, 0.f, nullptr, 1.f); }
#else
    for (int rep_ = 0; rep_ < REP_MEM; ++rep_)
    for (int w = vcu; w < 256; w += gridDim.x) mix::memattn_unit(lds, tid, MQ, (rep_ + 1 < REP_MEM) ? (bf16_t*)(ws + WS_OPOOL) : MQ, KV, mqss, prm + PB_MQN + l * 128, prm + PB_MKN + l * 128, w >> 2, w & 3, bndm);
#endif
#if MIX_NAIVE_POOL
    for (int u = blockIdx.x; u < 1024; u += gridDim.x) { const int tt = u >> 2, g = u & 3;
        naive_pool_unit(lds, tid, (const bf16_t*)(ws + WS_P), (bf16_t*)(ws + WS_OPOOL), prm + PB_POOLW + (size_t)(l * 4 + g) * 128 * 128, prm + PB_POOLS + l * 512 + g * 128, tt * 64, g); }
#else
    for (int rep_ = 0; rep_ < REP_POOL; ++rep_)
    for (int w = vcu; w < 256; w += gridDim.x) { const int pm = w >> 2, g = w & 3;
        mix::pool_unit(lds, tid, (const bf16_t*)(ws + WS_P), (bf16_t*)(ws + WS_OPOOL), (const bf16_t*)(ws + WS_POOLWT) + (size_t)(l * 4 + g) * 128 * 128, prm + PB_POOLS + l * 512 + g * 128, pm * 256, g); }
#endif
}

__device__ __forceinline__ void phase_route(unsigned char* ws, const bf16_t* xin, LAS unsigned char* lds, int tid, int lane, int wave) {
    const float* gffn = (const float*)(ws + WS_PARAM) + PB_GFFN1; const float* wr = (const float*)(ws + WS_PARAM) + PB_WR;
    unsigned* cnt = (unsigned*)ws + CW_CNT; int* toke = (int*)(ws + WS_TOKE); int* tokp = (int*)(ws + WS_TOKP); float* tokg = (float*)(ws + WS_TOKG); float* tokr = (float*)(ws + WS_TOKR);
    LAS unsigned* lcnt = (LAS unsigned*)lds; LAS unsigned* lbase = lcnt + 8; LAS int* linfo = (LAS int*)(lds + 64);
    const int per = T / gridDim.x;
    for (int c0 = 0; c0 < per; c0 += 64) {
        __syncthreads();
        if (tid < 8) lcnt[tid] = 0u;
        __syncthreads();
        for (int i = wave; i < 64 && c0 + i < per; i += NWAVES) {
            const int t = blockIdx.x * per + c0 + i;
            f32x4 v[4]; ld16_bf16(xin + (size_t)t * D + 16 * lane, v); float s = 0.f;
#pragma unroll
            for (int j = 0; j < 4; ++j) s += (v[j][0] * v[j][0] + v[j][1] * v[j][1]) + (v[j][2] * v[j][2] + v[j][3] * v[j][3]);
            const float rstd = __builtin_amdgcn_rsqf(wave_sum(s) * (1.f / 1024.f) + 1e-6f);
            float lg[8];
#pragma unroll
            for (int e = 0; e < 8; ++e) lg[e] = 0.f;
#pragma unroll
            for (int j = 0; j < 4; ++j)
#pragma unroll
                for (int k4 = 0; k4 < 4; ++k4) { const int k = 16 * lane + 4 * j + k4; const float xg = v[j][k4] * gffn[k]; const f32x4 w0 = *(const f32x4*)(wr + k * 8), w1 = *(const f32x4*)(wr + k * 8 + 4);
                    lg[0] += xg * w0[0]; lg[1] += xg * w0[1]; lg[2] += xg * w0[2]; lg[3] += xg * w0[3]; lg[4] += xg * w1[0]; lg[5] += xg * w1[1]; lg[6] += xg * w1[2]; lg[7] += xg * w1[3]; }
#pragma unroll
            for (int e = 0; e < 8; ++e) lg[e] = wave_sum(lg[e]) * rstd;
            int i0 = 0; float b0 = lg[0];
#pragma unroll
            for (int e = 1; e < 8; ++e) if (lg[e] > b0) { b0 = lg[e]; i0 = e; }
            int i1 = -1; float b1 = -3.0e38f;
#pragma unroll
            for (int e = 0; e < 8; ++e) if (e != i0 && lg[e] > b1) { b1 = lg[e]; i1 = e; }
            const float g0 = 1.f / (1.f + __expf(b1 - b0)), g1 = 1.f - g0;
            if (lane == 0) { const unsigned p0 = __hip_atomic_fetch_add(lcnt + i0, 1u, __ATOMIC_RELAXED, __HIP_MEMORY_SCOPE_WORKGROUP), p1 = __hip_atomic_fetch_add(lcnt + i1, 1u, __ATOMIC_RELAXED, __HIP_MEMORY_SCOPE_WORKGROUP);
                linfo[i * 4 + 0] = i0; linfo[i * 4 + 1] = i1; linfo[i * 4 + 2] = (int)p0; linfo[i * 4 + 3] = (int)p1;
                toke[2 * t] = i0; toke[2 * t + 1] = i1; tokg[2 * t] = g0; tokg[2 * t + 1] = g1; tokr[t] = rstd; }
        }
        __syncthreads();
        if (tid < 8) lbase[tid] = lcnt[tid] ? atomicAdd(cnt + 64 * tid, lcnt[tid]) : 0u;
        __syncthreads();
        if (tid < 64 && c0 + tid < per) { const int t = blockIdx.x * per + c0 + tid; tokp[2 * t] = (int)lbase[linfo[tid * 4 + 0]] + linfo[tid * 4 + 2]; tokp[2 * t + 1] = (int)lbase[linfo[tid * 4 + 1]] + linfo[tid * 4 + 3]; }
    }
}
__device__ __forceinline__ void build_texp(unsigned char* ws, LAS int* texp, int tid) {
    const unsigned* cnt = (const unsigned*)ws + CW_CNT;
    __syncthreads();
    if (tid == 0) { int tb = 0; for (int e = 0; e < NEXP; ++e) { texp[160 + e] = tb; const int n = (int)__hip_atomic_load(cnt + 64 * e, RLX_AGENT); const int nt = (n + 255) >> 8; for (int i = 0; i < nt; ++i) texp[tb + i] = e; tb += nt; } texp[168] = tb; texp[169] = tb; }
    __syncthreads();
}
__device__ __forceinline__ void phase_gather(unsigned char* ws, const bf16_t* xin, LAS int* texp, int lane, int wave) {
    const int* toke = (const int*)(ws + WS_TOKE); const int* tokp = (const int*)(ws + WS_TOKP); const float* tokr = (const float*)(ws + WS_TOKR);
    unsigned char* xg = ws + WS_XGY; float* xgrs = (float*)(ws + WS_XGRS);
    const int gw = blockIdx.x * NWAVES + wave, NGW = gridDim.x * NWAVES;
    for (int t = gw; t < T; t += NGW) {
        f32x4 v[4]; ld16_bf16(xin + (size_t)t * D + 16 * lane, v); float mx = 0.f;
#pragma unroll
        for (int j = 0; j < 4; ++j) { mx = fmaxf(mx, fmaxf(fmaxf(fabsf(v[j][0]), fabsf(v[j][1])), fmaxf(fabsf(v[j][2]), fabsf(v[j][3])))); }
#pragma unroll
        for (int o = 1; o < 64; o <<= 1) mx = fmaxf(mx, __shfl_xor(mx, o));
        const float inv = mx > 0.f ? 127.0f / mx : 0.f, rs = mx * (1.0f / 127.0f) * tokr[t];
        v4u w; w.x = pk_i8x4(v[0][0] * inv, v[0][1] * inv, v[0][2] * inv, v[0][3] * inv); w.y = pk_i8x4(v[1][0] * inv, v[1][1] * inv, v[1][2] * inv, v[1][3] * inv);
        w.z = pk_i8x4(v[2][0] * inv, v[2][1] * inv, v[2][2] * inv, v[2][3] * inv); w.w = pk_i8x4(v[3][0] * inv, v[3][1] * inv, v[3][2] * inv, v[3][3] * inv);
#pragma unroll
        for (int k = 0; k < 2; ++k) { const int e = toke[2 * t + k], p = tokp[2 * t + k]; const size_t row = (size_t)texp[160 + e] * 256 + p;
            *((v4u*)(xg + row * D) + lane) = w; if (lane == 0) xgrs[row] = rs; }
    }
}
__device__ __forceinline__ void phase_combine(unsigned char* ws, const bf16_t* xs, float* dst, LAS int* texp, int lane, int wave) {
    const int* toke = (const int*)(ws + WS_TOKE); const int* tokp = (const int*)(ws + WS_TOKP); const float* tokg = (const float*)(ws + WS_TOKG);
    const bf16_t* Y = (const bf16_t*)(ws + WS_Y);
    const int gw = blockIdx.x * NWAVES + wave, NGW = gridDim.x * NWAVES;
    for (int t = gw; t < T; t += NGW) {
        const size_t r0 = (size_t)texp[160 + toke[2 * t]] * 256 + tokp[2 * t], r1 = (size_t)texp[160 + toke[2 * t + 1]] * 256 + tokp[2 * t + 1]; const float g0 = tokg[2 * t], g1 = tokg[2 * t + 1];
        f32x4 xv[4]; ld16_bf16(xs + (size_t)t * D + 16 * lane, xv);
        const v4u* y0 = (const v4u*)(Y + r0 * D) + 2 * lane; const v4u* y1 = (const v4u*)(Y + r1 * D) + 2 * lane;
#pragma unroll
        for (int h = 0; h < 2; ++h) { const v4u p = y0[h], q = y1[h]; f32x4 xa = xv[2 * h], xc = xv[2 * h + 1];
            xa[0] += g0 * bf_lo(p.x) + g1 * bf_lo(q.x); xa[1] += g0 * bf_hi(p.x) + g1 * bf_hi(q.x); xa[2] += g0 * bf_lo(p.y) + g1 * bf_lo(q.y); xa[3] += g0 * bf_hi(p.y) + g1 * bf_hi(q.y);
            xc[0] += g0 * bf_lo(p.z) + g1 * bf_lo(q.z); xc[1] += g0 * bf_hi(p.z) + g1 * bf_hi(q.z); xc[2] += g0 * bf_lo(p.w) + g1 * bf_lo(q.w); xc[3] += g0 * bf_hi(p.w) + g1 * bf_hi(q.w);
            f32x4* xw = (f32x4*)(dst + (size_t)t * D) + 4 * lane; xw[2 * h] = xa; xw[2 * h + 1] = xc; }
    }
}

typedef pg8::EpiSwiglu<true, true> EpiSwigluF8;
#define GEMM_PHASE(EPI, g, S, E) do { S.prep(); __syncthreads(); pg8::gemm_phase<EPI, pg8::Sched2, true, true>(lds, g, S, E); } while (0)
__global__ void __launch_bounds__(NTHR, 2) fwd_kernel(Args args) {
    extern __shared__ __attribute__((aligned(16))) unsigned char lds_raw[];
    LAS unsigned char* lds = (LAS unsigned char*)lds_raw;
    volatile LAS unsigned* MISC = (volatile LAS unsigned*)(lds + MISC_OFF);
    LAS float* rstab = (LAS float*)(lds + RS_OFF); LAS int* texp = (LAS int*)(lds + TEXP_OFF);
    unsigned char* const ws0 = args.ws; int G = gridDim.x, bx = blockIdx.x;
#define PHASE_BEGIN() size_t z_ = 0; asm volatile("" : "+s"(z_), "+s"(G), "+s"(bx)); unsigned char* ws = args.ws + z_; float* out = args.out + z_; int tid = threadIdx.x; asm volatile("" : "+v"(tid)); const int lane = tid & 63, wave = __builtin_amdgcn_readfirstlane(tid >> 6); (void)lane; (void)wave; (void)out
    if (threadIdx.x < 64) MISC[threadIdx.x] = 0u;
    __syncthreads();
    XcdBarrier bar; bar.bar = (unsigned*)ws0 + CW_BAR; bar.x = 0; bar.st = nullptr;
    const int lo = args.ph_lo, hi = args.ph_hi;
    if (MK_N_LAUNCHES == 1 && hi - lo > 1) bar = xcd_barrier_post((unsigned*)ws0 + CW_BAR, MISC + 8);
#define IN(k) (lo <= (k) && (k) < hi)
#define SEAM(k) do { if (IN(k) && IN((k) + 1)) { size_t zb_ = 0; asm volatile("" : "+s"(zb_)); bar.bar = (unsigned*)args.ws + CW_BAR + zb_; xcd_barrier(bar); } } while (0)

    if (IN(0)) { PHASE_BEGIN(); phase_prologue(args, lds, tid, lane, wave); }
    SEAM(0);
    if (IN(0) && IN(2)) {}
    if (IN(2)) { PHASE_BEGIN();
        pg8::Gemm g{(const bf16_t*)(ws + WS_MEMBF), (const bf16_t*)(ws + WS_WMEMKV), NBATCH * MEML, 2048, D};
        pg8::Sched2 S; S.init2(g.M, g.N, G, bx, rstab); S.rsrc = (const float*)(ws + WS_SSM); S.rmode = 1;
        pg8::EpiStore<true> E{(bf16_t*)(ws + WS_MEMKV), 2048, rstab};
        GEMM_PHASE(pg8::EpiStore<true>, g, S, E);
        __syncthreads();
    }
    SEAM(2);
    for (int l = 0; l < 2; ++l) {
        const int pb = l == 0 ? 3 : 11;
        if (IN(pb)) { for (int rep_ = 0; rep_ < REP_A; ++rep_) { PHASE_BEGIN();
#if I8_A
            pg8::Gemm g{(const bf16_t*)(ws + WS_QX), (const bf16_t*)(ws + WS_W1T + (size_t)l * 14 * MiB), T, NGEMM1, D / 2};
            pg8::Sched2 S; S.init2(T, NGEMM1, G, bx, rstab); S.rsrc = (const float*)(ws + WS_SA); S.rmode = 2; S.wgm = 4;
            pg8::EpiA<true> E{ws, l, rstab};
            GEMM_PHASE(pg8::EpiA<true>, g, S, E); __syncthreads(); }
#else
            pg8::Gemm g{(const bf16_t*)(ws + WS_XB), (const bf16_t*)(ws + WS_W1T + (size_t)l * 14 * MiB), T, NGEMM1, D};
            pg8::Sched2 S; S.init2(T, NGEMM1, G, bx, rstab); S.rsrc = (const float*)(ws + WS_SS); S.rmode = 1; S.wgm = 4;
            pg8::EpiA<false> E{ws, l, rstab};
            GEMM_PHASE(pg8::EpiA<false>, g, S, E); __syncthreads(); }
#endif
        }
        SEAM(pb);
        if (IN(pb + 1)) { PHASE_BEGIN(); phase_mixers(ws, lds, l, tid); }
        SEAM(pb + 1);
        if (IN(pb + 2)) { for (int rep_ = 0; rep_ < REP_C; ++rep_) { PHASE_BEGIN();
            { pg8::Gemm g{(const bf16_t*)(ws + WS_XB), (const bf16_t*)(ws + WS_WBRDA + (size_t)l * 2 * MiB), T, D, 1024}; pg8::Sched2 S; S.init2(T, D, G, bx, rstab);
              pg8::EpiBr0 E{ws}; GEMM_PHASE(pg8::EpiBr0, g, S, E); }
            __syncthreads(); { size_t z2_ = 0; asm volatile("" : "+s"(z2_), "+s"(G), "+s"(bx)); ws = args.ws + z2_; }
            { pg8::Gemm g{(const bf16_t*)(ws + WS_OPOOL), (const bf16_t*)(ws + WS_WBRPOOL + (size_t)l * 1 * MiB), T, D, 512}; pg8::Sched2 S; S.init2(T, D, G, bx, rstab);
              S.chain = 2; S.A2 = (const bf16_t*)(ws + WS_MQ); S.B2 = (const bf16_t*)(ws + WS_WBRMEM + (size_t)l * 1 * MiB);
              pg8::EpiBrC E{ws}; GEMM_PHASE(pg8::EpiBrC, g, S, E); } __syncthreads(); }
        }
        SEAM(pb + 2);
        if (IN(pb + 3)) { PHASE_BEGIN();
            pg8::Gemm g{(const bf16_t*)(ws + WS_Q), (const bf16_t*)(ws + WS_WOUT + (size_t)l * 2 * MiB), T, D, D}; pg8::Sched2 S; S.init2(T, D, G, bx, rstab);
            pg8::EpiResB E{l == 0 ? (const float*)(args.in[0] + z_) : (const float*)nullptr, (bf16_t*)(ws + WS_XS)};
            GEMM_PHASE(pg8::EpiResB, g, S, E); __syncthreads();
        }
        SEAM(pb + 3);
        if (l == 0) {
            if (IN(7) && I8_E) { PHASE_BEGIN(); phase_quant_rows((const bf16_t*)(ws + WS_XS), ws, lane, wave); }
            SEAM(7);
            if (IN(8)) { for (int rep_ = 0; rep_ < REP_E; ++rep_) { PHASE_BEGIN();
#if I8_E
                pg8::Gemm g{(const bf16_t*)(ws + WS_QX), (const bf16_t*)(ws + WS_WFF13), T, 2 * FFD, D / 2}; pg8::Sched2 S; S.init2(T, 2 * FFD, G, bx, rstab); S.rsrc = (const float*)(ws + WS_SA); S.rmode = 2; S.wgm = 4;
                EpiSwigluF8 E{(bf16_t*)(ws + WS_HFF), FFD, rstab, (const float*)(ws + WS_SW) + SW_FF, FFD, nullptr, 0};
                GEMM_PHASE(EpiSwigluF8, g, S, E); __syncthreads(); }
#else
                pg8::Gemm g{(const bf16_t*)(ws + WS_X1B), (const bf16_t*)(ws + WS_WFF13), T, 2 * FFD, D}; pg8::Sched2 S; S.init2(T, 2 * FFD, G, bx, rstab); S.rsrc = (const float*)(ws + WS_SS); S.rmode = 1; S.wgm = 4;
                pg8::EpiSwiglu<false> E{(bf16_t*)(ws + WS_HFF), FFD, rstab, nullptr, 0, nullptr, 0};
                GEMM_PHASE(pg8::EpiSwiglu<false>, g, S, E); __syncthreads(); }
#endif
            }
            SEAM(8);
            if (IN(9)) { PHASE_BEGIN();
                pg8::Gemm g{(const bf16_t*)(ws + WS_HFF), (const bf16_t*)(ws + WS_WFF2), T, D, FFD / 2}; pg8::Sched2 S; S.init2(T, D, G, bx, rstab);
                pg8::EpiResB8 E{(bf16_t*)(ws + WS_XS), (const float*)(ws + WS_SW) + SW_W2 + 8 * 1024};
                GEMM_PHASE(pg8::EpiResB8, g, S, E); __syncthreads();
            }
            SEAM(9);
            if (IN(10) && I8_A) { PHASE_BEGIN(); phase_quant_rows((const bf16_t*)(ws + WS_XS), ws, lane, wave); }
            SEAM(10);
        }
    }
    if (IN(15)) { PHASE_BEGIN(); phase_route(ws, (const bf16_t*)(ws + WS_XS), lds, tid, lane, wave); }
    SEAM(15);
    if (IN(16)) { PHASE_BEGIN(); build_texp(ws, texp, tid); phase_gather(ws, (const bf16_t*)(ws + WS_XS), texp, lane, wave); }
    SEAM(16);
    for (int k = 0; k < 4; ++k) {
        if (IN(17 + k)) { PHASE_BEGIN();
            build_texp(ws, texp, tid);
            const int ntot = texp[169];
            const int kd = k - 1, ku = k;
            int ntd = 0, ntu = 0;
            if (kd >= 0) { ntd = ntot - MOE_CH * kd; const int cap = (kd == 2) ? MOE_CHL : MOE_CH; ntd = ntd < 0 ? 0 : (ntd > cap ? cap : ntd); }
            if (ku <= 2) { ntu = ntot - MOE_CH * ku; const int cap = (ku == 2) ? MOE_CHL : MOE_CH; ntu = ntu < 0 ? 0 : (ntu > cap ? cap : ntu); }
            const int nX = ntd * 4, nU = ntu * 28;
            const bool mixed = (nX > 0 && nU > 0);
            const int tf = (nU + DNW * nX) / 256, rem = (nU + DNW * nX) - 256 * tf;
            const bool weighted = mixed && tf >= DNW && nX <= 256 && G == 256;
            if (nX > 0) {
                const int t0 = MOE_CH * kd;
                pg8::Gemm g{(const bf16_t*)(ws + WS_HCH + (size_t)(kd & 1) * HCH_BYTES), (const bf16_t*)(ws + WS_WMOE2), ntd * 256, D, FFE / 2};
                pg8::Sched2 S; S.init2(ntd * 256, D, G, bx, rstab); S.texp = texp; S.estride = (size_t)7 * MiB; S.t0 = t0;
                if (weighted) { const int vc = (bx & 7) * 32 + (bx >> 3); S.rng = 1; S.rng_start = vc; S.rng_cnt = (vc < nX) ? 1 : 0; }
                pg8::EpiStoreF8 E{(bf16_t*)(ws + WS_Y) + (size_t)t0 * 256 * D, D, (const float*)(ws + WS_SW) + SW_W2, texp, t0};
                for (int rep_ = 0; rep_ < REP_DN; ++rep_) { GEMM_PHASE(pg8::EpiStoreF8, g, S, E); __syncthreads(); }
            }
            if (nU > 0) {
                size_t z3_ = 0; asm volatile("" : "+s"(z3_), "+s"(G), "+s"(bx)); ws = args.ws + z3_;
                const int t0 = MOE_CH * ku;
                pg8::Gemm g{(const bf16_t*)(ws + WS_XGY + (size_t)t0 * 256 * D), (const bf16_t*)(ws + WS_WMOE13), ntu * 256, 2 * FFE, D / 2};
                pg8::Sched2 S; S.init2(ntu * 256, 2 * FFE, G, bx, rstab); S.rsrc = (const float*)(ws + WS_XGRS); S.rmode = 2; S.rrow0 = t0 * 256; S.texp = texp; S.estride = (size_t)7 * MiB; S.t0 = t0;
                if (weighted) { const int vc = (bx & 7) * 32 + (bx >> 3); const int cmin = vc < nX ? vc : nX, over = vc - (256 - rem); S.rng = 1; S.rng_start = vc * tf - DNW * cmin + (over > 0 ? over : 0); S.rng_cnt = tf - (vc < nX ? DNW : 0) + (vc >= 256 - rem ? 1 : 0); }
                EpiSwigluF8 E{(bf16_t*)(ws + WS_HCH + (size_t)(ku & 1) * HCH_BYTES), FFE, rstab, (const float*)(ws + WS_SW) + SW_MOE, FFE, texp, t0};
                for (int rep_ = 0; rep_ < REP_UP; ++rep_) { GEMM_PHASE(EpiSwigluF8, g, S, E); __syncthreads(); }
            }
        }
        SEAM(17 + k);
    }
    if (IN(21)) { PHASE_BEGIN(); build_texp(ws, texp, tid); phase_combine(ws, (const bf16_t*)(ws + WS_XS), out, texp, lane, wave); }
#undef IN
#undef SEAM
}

extern "C" void kernel_launch(void* const* d_in, const int* in_sizes, int n_in, void* d_out, int out_size, void* d_ws, size_t ws_size, hipStream_t stream) {
    static int grid = 0;
    if (grid == 0) {
        if (n_in != 31 || out_size != T * D || ws_size < WS_END) { fprintf(stderr, "kernel_launch: unexpected problem (n_in %d, out %d, ws %zu < %zu)\n", n_in, out_size, ws_size, (size_t)WS_END); grid = -1; return; }
        int dev = 0, cus = 0, per_cu = 0;
        if (hipGetDevice(&dev) != hipSuccess || hipDeviceGetAttribute(&cus, hipDeviceAttributeMultiprocessorCount, dev) != hipSuccess) { grid = -1; return; }
        if (hipFuncSetAttribute((const void*)fwd_kernel, hipFuncAttributeMaxDynamicSharedMemorySize, LDS_BYTES) != hipSuccess) { fprintf(stderr, "kernel_launch: hipFuncSetAttribute failed\n"); grid = -1; return; }
        if (hipOccupancyMaxActiveBlocksPerMultiprocessor(&per_cu, (const void*)fwd_kernel, NTHR, LDS_BYTES) != hipSuccess || per_cu < 1) { fprintf(stderr, "kernel_launch: occupancy query says %d\n", per_cu); grid = -1; (void)hipGetLastError(); return; }
        grid = cus;
    }
    if (grid < 0) return;
    if (hipMemsetAsync(d_ws, 0, CTL_ZERO_BYTES, stream) != hipSuccess) return;
    Args a{};
    for (int i = 0; i < 31; ++i) a.in[i] = (const float*)d_in[i];
    a.out = (float*)d_out; a.ws = (unsigned char*)d_ws;
#ifdef PROBE_EXTRA_PROLOGUE
    a.ph_lo = 0; a.ph_hi = 1; hipLaunchKernelGGL(fwd_kernel, dim3(grid), dim3(NTHR), LDS_BYTES, stream, a);
#endif
#ifdef PROBE_EXTRA_PHASE
#ifndef PROBE_EXTRA_REPS
#define PROBE_EXTRA_REPS 1
#endif
    for (int r_ = 0; r_ < PROBE_EXTRA_REPS; ++r_) { a.ph_lo = PROBE_EXTRA_PHASE; a.ph_hi = PROBE_EXTRA_PHASE + 1; hipLaunchKernelGGL(fwd_kernel, dim3(grid), dim3(NTHR), LDS_BYTES, stream, a); }
#endif
    if (MK_N_LAUNCHES == 1) { a.ph_lo = 0; a.ph_hi = NPH; hipLaunchKernelGGL(fwd_kernel, dim3(grid), dim3(NTHR), LDS_BYTES, stream, a); }
    else for (int p = 0; p < NPH; ++p) { a.ph_lo = p; a.ph_hi = p + 1; hipLaunchKernelGGL(fwd_kernel, dim3(grid), dim3(NTHR), LDS_BYTES, stream, a); }
}
```

```cpp
#include <hip/hip_runtime.h>
#include <cstdio>
#include <cstdint>
#define MK_N_LAUNCHES 1
#ifndef USE_I8
#define USE_I8 1
#endif
#ifndef I8_A
#define I8_A 1
#endif
#ifndef I8_E
#define I8_E 1
#endif
#ifndef REP_MEM
#define REP_MEM 1
#endif
#ifndef REP_D
#define REP_D 1
#endif
#ifndef REP_F
#define REP_F 1
#endif
#ifndef REP_Z
#define REP_Z 1
#endif
#ifndef REP_E
#define REP_E 1
#endif
#ifndef REP_DN
#define REP_DN 1
#endif
#ifndef REP_MG
#define REP_MG 1
#endif
#ifndef REP_POOL
#define REP_POOL 1
#endif
#ifndef REP_GA
#define REP_GA 1
#endif
#ifndef REP_PRO
#define REP_PRO 1
#endif
#ifndef REP_A
#define REP_A 1
#endif
#ifndef REP_DA
#define REP_DA 1
#endif
#ifndef REP_C
#define REP_C 1
#endif
#ifndef REP_UP
#define REP_UP 1
#endif

constexpr int NWAVES = 8, NTHR = 512;
constexpr int T = 16384, D = 1024, SEQ = 2048, NBATCH = 8, MEML = 256;
constexpr int NGEMM1 = 7168, FFD = 2816, FFE = 3584, NEXP = 8;
constexpr float LOG2E = 1.4426950408889634f;
constexpr float QSCALE = 0.125f * LOG2E;
constexpr float MEMSCALE = 0.08838834764831845f * LOG2E;
#ifndef MK_N_LAUNCHES
#define MK_N_LAUNCHES 1
#endif
constexpr int NPH = 22;
constexpr int MOE_CH = 45, MOE_CHL = 46;

constexpr size_t MiB = 1u << 20;
constexpr size_t CTL_ZERO_BYTES = 1 * MiB;
constexpr size_t WS_SS = 1 * MiB;
constexpr size_t WS_MQSS = 2 * MiB;
constexpr size_t WS_SSM = 2 * MiB + 512 * 1024;
constexpr size_t WS_TOKE = WS_SSM + 128 * 1024;
constexpr size_t WS_TOKP = WS_TOKE + 128 * 1024;
constexpr size_t WS_TOKG = WS_TOKP + 128 * 1024;
constexpr size_t WS_TOKR = WS_TOKG + 128 * 1024;
constexpr size_t WS_SC = WS_TOKR + 64 * 1024;
constexpr size_t WS_XGRS = WS_SC + 4096;
constexpr size_t WS_PARAM = 3 * MiB + 256 * 1024;
constexpr int PB_BGATE = 0, PB_GQ = 6144, PB_GK = 6400, PB_GOUT = 6656, PB_POOLS = 6912, PB_MQN = 7936, PB_MKN = 8192, PB_GFFN1 = 8448, PB_WR = 9472, PB_POOLW = 17664, PB_END = 17664 + 131072;
constexpr size_t WS_W1T = 4 * MiB;
constexpr size_t WS_WMEMKV = 32 * MiB;
constexpr size_t WS_WBRDA = 36 * MiB;
constexpr size_t WS_WBRPOOL = 40 * MiB;
constexpr size_t WS_WBRMEM = 42 * MiB;
constexpr size_t WS_WOUT = 44 * MiB;
constexpr size_t WS_WFF13 = 48 * MiB;
constexpr size_t WS_WFF2 = 59 * MiB;
constexpr size_t WS_SW = WS_WFF13 + 6 * MiB;
constexpr int SW_G1 = 0, SW_FF = 2 * 7168, SW_MOE = SW_FF + 2 * 2816, SW_W2 = SW_MOE + 8 * 2 * 3584, SW_END = SW_W2 + 9 * 1024;
constexpr float H8_SCALE = 8.0f;
constexpr int DNW = 2;
constexpr size_t SW_BYTES = (size_t)SW_END * 4;
constexpr size_t WS_WMOE13 = 65 * MiB;
constexpr size_t WS_XS = WS_WMOE13 + 56 * MiB;
constexpr size_t WS_WMOE2 = 177 * MiB;
constexpr size_t WS_XB = 233 * MiB;
constexpr size_t WS_QX = WS_XB, WS_SA = 1 * MiB;
constexpr size_t WS_MEMKV = 265 * MiB;
constexpr size_t WS_R = 273 * MiB;
constexpr size_t WS_Q = WS_R, WS_K = WS_R + 32 * MiB, WS_V = WS_R + 64 * MiB, WS_P = WS_R + 96 * MiB, WS_MQ = WS_R + 112 * MiB, WS_OPOOL = WS_R + 128 * MiB, WS_G = WS_R + 144 * MiB, WS_MEMBF = WS_R + 240 * MiB, WS_POOLWT = WS_R + 244 * MiB;
constexpr size_t WS_MF = WS_K, WS_X1B = WS_K, WS_HFF = WS_R + 144 * MiB;
constexpr size_t WS_XGY = WS_MEMKV;
constexpr size_t WS_Y = WS_XGY + 34 * MiB;
constexpr size_t WS_HCH = WS_Y + 68 * MiB, HCH_BYTES = (size_t)MOE_CHL * 256 * 7168;
constexpr size_t WS_END = 529 * MiB;
static_assert(WS_XGRS + 34816 * 4 <= WS_PARAM && WS_PARAM + (size_t)PB_END * 4 <= WS_W1T && WS_HCH + 2 * HCH_BYTES <= WS_END && WS_SW + SW_BYTES <= WS_WFF2, "d_ws map");
constexpr int CW_CNT = 64;
constexpr int CW_BAR = 4096;

constexpr int RING_BYTES = 131072;
constexpr int RS_OFF = 131072, RS_UNITS = 16;
constexpr int TEXP_OFF = RS_OFF + RS_UNITS * 1024;
constexpr int LDS_BYTES = 155648;
constexpr int MISC_OFF = LDS_BYTES - 256;

namespace pg8 {
#define PG8_LAS __attribute__((address_space(3)))
typedef unsigned short bf16_t;
typedef short bf16x8 __attribute__((ext_vector_type(8)));
typedef float f32x4 __attribute__((ext_vector_type(4)));
typedef unsigned u32x4 __attribute__((ext_vector_type(4)));
constexpr int BM = 256, BK = 64, HALF = 128, HTB = HALF * BK * 2  , STAGE_BYTES = 8 * HTB, NXCD = 8, WGM = 8;

__host__ __device__ __forceinline__ int lds_byte(int r, int c) { const int st = (r >> 4) * 2 + (c >> 5), rr = r & 15, cc = c & 31, ob = rr * 64 + cc * 2; return st * 1024 + (ob ^ (((ob >> 9) & 1) << 5)); }
__host__ __device__ __forceinline__ void stage_rc(int b, int& R, int& C) { const int st = b / 1024, sb = b % 1024, swz = sb ^ (((sb >> 9) & 1) << 5); R = (st >> 1) * 16 + swz / 64; C = (st & 1) * 32 + (swz % 64) / 2; }
__host__ __device__ __forceinline__ int perm32(int rho) { const int n = rho >> 4, i = rho & 15; return 8 * (i >> 2) + 4 * n + (i & 3); }

struct Unit { int pm, pn, idx; };
struct Gemm { const bf16_t* A; const bf16_t* Bt; int M, N, K; };

struct StaticOrder {
    int nM, nN, nwg, G, c, wgm;
    __host__ __device__ void init(int M, int N, int G_, int c_) { nM = M / BM; nN = N / BM; nwg = nM * nN; G = G_; c = c_; wgm = WGM; }
    __host__ __device__ bool next(int i, Unit& u) const {
        const long L = (long)i * G + c; if (L >= nwg) return false;
        int wgid = (int)L; { const int q = nwg / NXCD, r = nwg % NXCD, xcd = wgid % NXCD, off = wgid / NXCD; wgid = (xcd < r ? xcd * (q + 1) : r * (q + 1) + (xcd - r) * q) + off; }
        const int nig = wgm * nN, gid = wgid / nig, fm = gid * wgm, gsz = (nM - fm) < wgm ? (nM - fm) : wgm;
        u.pm = fm + ((wgid % nig) % gsz); u.pn = (wgid % nig) / gsz; u.idx = i; return true;
    }
    __device__ __forceinline__ const char* bptr(const Gemm& g, const Unit& u, size_t tstep) const { return (const char*)g.Bt + (size_t)u.pn * tstep; }
    __device__ __forceinline__ const char* aptr(const Gemm& g, const Unit& u, size_t tstep) const { return (const char*)g.A + (size_t)u.pm * tstep; }
    __device__ __forceinline__ void a_ready(const Unit&) const {}
    __device__ __forceinline__ void done(const Unit&) const {}
};


typedef float f32x2 __attribute__((ext_vector_type(2)));
typedef __bf16 bf16x2_t __attribute__((ext_vector_type(2)));
__device__ __forceinline__ unsigned pk_bf16(float lo, float hi) { f32x2 v = {lo, hi}; bf16x2_t b = __builtin_convertvector(v, bf16x2_t); return __builtin_bit_cast(unsigned, b); }
__device__ __forceinline__ u32x4 pk8(const f32x4 a, const f32x4 b) { u32x4 w; w.x = pk_bf16(a[0], a[1]); w.y = pk_bf16(a[2], a[3]); w.z = pk_bf16(b[0], b[1]); w.w = pk_bf16(b[2], b[3]); return w; }
__device__ __forceinline__ float bf_lo(unsigned w) { return __builtin_bit_cast(float, w << 16); }
__device__ __forceinline__ float bf_hi(unsigned w) { return __builtin_bit_cast(float, w & 0xffff0000u); }
__device__ __forceinline__ float sigmoid_f(float x) { return __builtin_amdgcn_rcpf(1.0f + __builtin_amdgcn_exp2f(-1.4426950408889634f * x)); }
typedef int i32x8 __attribute__((ext_vector_type(8)));
typedef int i32x4 __attribute__((ext_vector_type(4)));
__device__ __forceinline__ f32x4 mma_f8(const i32x8 a, const i32x8 b, f32x4 c) { const int one = 0x7f7f7f7f; asm volatile("v_mfma_scale_f32_16x16x128_f8f6f4 %0, %1, %2, %0, %3, %3 op_sel_hi:[0,0,0]" : "+v"(c) : "v"(a), "v"(b), "v"(one)); return c; }
__device__ __forceinline__ unsigned pk_fp8x4(float a, float b, float c, float d) { int w = __builtin_amdgcn_cvt_pk_fp8_f32(a, b, 0, false); w = __builtin_amdgcn_cvt_pk_fp8_f32(c, d, w, true); return (unsigned)w; }
constexpr float RMS_EPS = 1e-6f;
typedef int i32x4 __attribute__((ext_vector_type(4)));
template <bool I8> __device__ __forceinline__ f32x4 mma16(const bf16x8 a, const bf16x8 b, const f32x4 c) {
    if constexpr (I8) return __builtin_bit_cast(f32x4, __builtin_amdgcn_mfma_i32_16x16x64_i8(__builtin_bit_cast(i32x4, a), __builtin_bit_cast(i32x4, b), __builtin_bit_cast(i32x4, c), 0, 0, 0));
    else return __builtin_amdgcn_mfma_f32_16x16x32_bf16(a, b, c, 0, 0, 0);
}
template <bool I8> __device__ __forceinline__ f32x4 accf(const f32x4 a) {
    if constexpr (I8) { const i32x4 v = __builtin_bit_cast(i32x4, a); return (f32x4){(float)v[0], (float)v[1], (float)v[2], (float)v[3]}; } else return a;
}


struct Sched2 : StaticOrder {
    const float* rsrc; int rmode;
    int rrow0;
    PG8_LAS float* rtab;
    const PG8_LAS int* texp; size_t estride; int t0;
    int rng, rng_start, rng_cnt;
    const bf16_t* A2; const bf16_t* B2; int chain;
    __device__ __forceinline__ void init2(int M, int N, int G_, int c_, PG8_LAS float* tab) { init(M, N, G_, c_); rsrc = nullptr; rmode = 0; rrow0 = 0; rtab = tab; texp = nullptr; estride = 0; t0 = 0; A2 = nullptr; B2 = nullptr; chain = 0; rng = 0; rng_start = 0; rng_cnt = 0; }
    __device__ __forceinline__ bool next(int i, Unit& u) const {
        if (rng != 0) { if (i >= rng_cnt) return false; const int q = rng_start + i; u.pm = q / nN; u.pn = q - u.pm * nN; u.idx = i; return true; }
        if (chain == 0) return StaticOrder::next(i, u); if (i >= chain || !StaticOrder::next(0, u)) return false; u.idx = i; return true; }
    __device__ __forceinline__ const char* aptr(const Gemm& g, const Unit& u, size_t tstep) const { return (const char*)((chain != 0 && u.idx == 1) ? A2 : g.A) + (size_t)u.pm * tstep; }
    __device__ __forceinline__ const char* bptr(const Gemm& g, const Unit& u, size_t tstep) const {
        const char* b = (const char*)((chain != 0 && u.idx == 1) ? B2 : g.Bt) + (size_t)u.pn * tstep;
        if (texp) b += (size_t)texp[t0 + u.pm] * estride;
        return b;
    }
    __device__ __forceinline__ void a_ready(const Unit&) const {}
    __device__ __forceinline__ void prep() const {
        if (rmode == 0) return;
        int tid = threadIdx.x; asm volatile("" : "+v"(tid));
        if (tid < 256) {
            Unit u;
#pragma unroll 1
            for (int i = 0; i < 16 && next(i, u); ++i) {
                const size_t row = (size_t)rrow0 + (size_t)u.pm * 256 + tid; float sc;
                if (rmode == 1) { const f32x4* p = (const f32x4*)(rsrc + row * 16); const f32x4 a = p[0], b = p[1], c = p[2], d = p[3];
                    const float s = ((a[0] + a[1]) + (a[2] + a[3])) + ((b[0] + b[1]) + (b[2] + b[3])) + ((c[0] + c[1]) + (c[2] + c[3])) + ((d[0] + d[1]) + (d[2] + d[3]));
                    sc = __builtin_amdgcn_rsqf(s * (1.0f / 1024.0f) + RMS_EPS); }
                else sc = rsrc[row];
                rtab[i * 256 + tid] = sc;
            }
        }
    }
    __device__ __forceinline__ void done(const Unit&) const {}
};

template <bool RS> struct EpiStore {
    static constexpr bool PERM = false, AFTER_DRAIN = false, I8 = false, F8 = false;
    bf16_t* O; int ldc; const PG8_LAS float* rs;
    __device__ __forceinline__ void operator()(const f32x4 (&acc)[2][2][4][2], const Unit& u, int wr, int wc, int fr, int fq) const {
        const int rl = wr * 64 + fr; const size_t row0 = (size_t)u.pm * BM + rl; const int col0 = u.pn * BM + 64 * wc + 8 * fq;
#pragma unroll
        for (int ai = 0; ai < 2; ++ai)
#pragma unroll
            for (int m = 0; m < 4; ++m) { const float sc = RS ? rs[u.idx * 256 + rl + ai * HALF + m * 16] : 1.f; bf16_t* rowp = O + (row0 + ai * HALF + m * 16) * ldc + col0;
#pragma unroll
                for (int bj = 0; bj < 2; ++bj) *(u32x4*)(rowp + 32 * bj) = pk8(acc[ai][bj][m][0] * sc, acc[ai][bj][m][1] * sc); }
    }
};

template <bool I8_> struct EpiA {
    static constexpr bool PERM = false, AFTER_DRAIN = false, I8 = I8_, F8 = false;
    unsigned char* ws; int l; const PG8_LAS float* rs;
    __device__ __forceinline__ void operator()(const f32x4 (&acc)[2][2][4][2], const Unit& u, int wr, int wc, int fr, int fq) const {
        const int pn = u.pn, rl = wr * 64 + fr; const size_t row0 = (size_t)u.pm * BM + rl; const PG8_LAS float* rsp = rs + u.idx * 256 + rl;
        const float* prm = (const float*)(ws + WS_PARAM);
        f32x4 cw[2][2];
#pragma unroll
        for (int bj = 0; bj < 2; ++bj)
#pragma unroll
            for (int n = 0; n < 2; ++n) { if constexpr (I8_) cw[bj][n] = *(const f32x4*)((const float*)(ws + WS_SW) + SW_G1 + l * 7168 + pn * 256 + 64 * wc + 32 * bj + 8 * fq + 4 * n) * (1.0f / 127.0f); else cw[bj][n] = (f32x4){1.f, 1.f, 1.f, 1.f}; }
#define EA_V(ai, bj, m, n) (accf<I8_>(acc[ai][bj][m][n]) * cw[bj][n])
        if (pn < 8) {
            const bool isq = pn < 4; const float* gg = prm + (isq ? PB_GQ : PB_GK) + l * 128 + (wc & 1) * 64 + 8 * fq; const float mul = isq ? QSCALE : 1.f;
            f32x4 gv[2][2];
#pragma unroll
            for (int bj = 0; bj < 2; ++bj)
#pragma unroll
                for (int n = 0; n < 2; ++n) gv[bj][n] = *(const f32x4*)(gg + 32 * bj + 4 * n);
            bf16_t* base = (bf16_t*)(ws + (isq ? WS_Q : WS_K)) + (pn & 3) * 256 + 64 * wc + 8 * fq;
#pragma unroll
            for (int ai = 0; ai < 2; ++ai)
#pragma unroll
                for (int m = 0; m < 4; ++m) { const float sc = rsp[ai * HALF + m * 16];
                    f32x4 v[2][2]; float ss = 0.f;
#pragma unroll
                    for (int bj = 0; bj < 2; ++bj)
#pragma unroll
                        for (int n = 0; n < 2; ++n) { v[bj][n] = EA_V(ai, bj, m, n) * sc; const f32x4 x = v[bj][n]; ss += (x[0] * x[0] + x[1] * x[1]) + (x[2] * x[2] + x[3] * x[3]); }
                    ss += __shfl_xor(ss, 16); ss += __shfl_xor(ss, 32);
                    const float r = __builtin_amdgcn_rsqf(ss * (1.0f / 64.0f) + RMS_EPS) * mul;
                    bf16_t* rowp = base + (row0 + ai * HALF + m * 16) * 1024;
#pragma unroll
                    for (int bj = 0; bj < 2; ++bj) *(u32x4*)(rowp + 32 * bj) = pk8(v[bj][0] * gv[bj][0] * r, v[bj][1] * gv[bj][1] * r); }
        } else if (pn < 14) {
            bf16_t* base; int ldc;
            if (pn < 12) { base = (bf16_t*)(ws + WS_V) + (pn - 8) * 256; ldc = 1024; } else { base = (bf16_t*)(ws + WS_P) + (pn - 12) * 256; ldc = 512; }
            base += 64 * wc + 8 * fq;
#pragma unroll
            for (int ai = 0; ai < 2; ++ai)
#pragma unroll
                for (int m = 0; m < 4; ++m) { const float sc = rsp[ai * HALF + m * 16]; bf16_t* rowp = base + (row0 + ai * HALF + m * 16) * ldc;
#pragma unroll
                    for (int bj = 0; bj < 2; ++bj) *(u32x4*)(rowp + 32 * bj) = pk8(EA_V(ai, bj, m, 0) * sc, EA_V(ai, bj, m, 1) * sc); }
        } else if (pn < 16) {
            bf16_t* base = (bf16_t*)(ws + WS_MQ) + (pn - 14) * 256 + 64 * wc + 8 * fq; float* mqss = (float*)(ws + WS_MQSS);
#pragma unroll
            for (int ai = 0; ai < 2; ++ai)
#pragma unroll
                for (int m = 0; m < 4; ++m) { const float sc = rsp[ai * HALF + m * 16]; const size_t row = row0 + ai * HALF + m * 16; bf16_t* rowp = base + row * 512; float ss = 0.f;
#pragma unroll
                    for (int bj = 0; bj < 2; ++bj) { const f32x4 a = EA_V(ai, bj, m, 0) * sc, b = EA_V(ai, bj, m, 1) * sc;
                        ss += ((a[0] * a[0] + a[1] * a[1]) + (a[2] * a[2] + a[3] * a[3])) + ((b[0] * b[0] + b[1] * b[1]) + (b[2] * b[2] + b[3] * b[3]));
                        *(u32x4*)(rowp + 32 * bj) = pk8(a, b); }
                    ss += __shfl_xor(ss, 16); ss += __shfl_xor(ss, 32);
                    if (fq == 0) mqss[row * 8 + (pn - 14) * 4 + wc] = ss; }
        } else {
            const int gcol = (pn - 16) * 256 + 64 * wc + 8 * fq; unsigned char* base = (unsigned char*)(ws + WS_G) + gcol; const float* bgate = prm + PB_BGATE + l * 3072 + gcol;
            f32x4 bv[2][2];
#pragma unroll
            for (int bj = 0; bj < 2; ++bj)
#pragma unroll
                for (int n = 0; n < 2; ++n) bv[bj][n] = *(const f32x4*)(bgate + 32 * bj + 4 * n);
#pragma unroll
            for (int ai = 0; ai < 2; ++ai)
#pragma unroll
                for (int m = 0; m < 4; ++m) { const float sc = rsp[ai * HALF + m * 16]; unsigned char* rowp = base + (row0 + ai * HALF + m * 16) * 3072;
#pragma unroll
                    for (int bj = 0; bj < 2; ++bj) { f32x4 a = EA_V(ai, bj, m, 0) * sc + bv[bj][0], b = EA_V(ai, bj, m, 1) * sc + bv[bj][1];
#pragma unroll
                        for (int j = 0; j < 4; ++j) { a[j] = sigmoid_f(a[j]) * 255.0f + 0.5f; b[j] = sigmoid_f(b[j]) * 255.0f + 0.5f; }
                        const unsigned w0 = (unsigned)a[0] | ((unsigned)a[1] << 8) | ((unsigned)a[2] << 16) | ((unsigned)a[3] << 24), w1 = (unsigned)b[0] | ((unsigned)b[1] << 8) | ((unsigned)b[2] << 16) | ((unsigned)b[3] << 24);
                        *(unsigned long long*)(rowp + 32 * bj) = (unsigned long long)w0 | ((unsigned long long)w1 << 32); } }
        }
    }
};
#undef EA_V

struct EpiBr0 {
    static constexpr bool PERM = false, AFTER_DRAIN = false, I8 = false, F8 = false;
    unsigned char* ws;
    __device__ __forceinline__ void operator()(const f32x4 (&acc)[2][2][4][2], const Unit& u, int wr, int wc, int fr, int fq) const {
        const size_t row0 = (size_t)u.pm * BM + wr * 64 + fr; const int col0 = u.pn * BM + 64 * wc + 8 * fq;
        const unsigned char* G = (const unsigned char*)(ws + WS_G); bf16_t* MFb = (bf16_t*)(ws + WS_MF);
#pragma unroll
        for (int ai = 0; ai < 2; ++ai) { unsigned long long gw[4][2];
#pragma unroll
            for (int m = 0; m < 4; ++m)
#pragma unroll
                for (int bj = 0; bj < 2; ++bj) gw[m][bj] = *(const unsigned long long*)(G + (row0 + ai * HALF + m * 16) * 3072 + col0 + 32 * bj);
#pragma unroll
            for (int m = 0; m < 4; ++m) { const size_t row = row0 + ai * HALF + m * 16;
#pragma unroll
                for (int bj = 0; bj < 2; ++bj) { const int col = col0 + 32 * bj;
                    const unsigned glo = (unsigned)gw[m][bj], ghi = (unsigned)(gw[m][bj] >> 32);
                    const f32x4 g0 = (f32x4){(float)(glo & 255u), (float)((glo >> 8) & 255u), (float)((glo >> 16) & 255u), (float)(glo >> 24)} * (1.0f / 255.0f), g1 = (f32x4){(float)(ghi & 255u), (float)((ghi >> 8) & 255u), (float)((ghi >> 16) & 255u), (float)(ghi >> 24)} * (1.0f / 255.0f);
                    *(u32x4*)(MFb + row * 1024 + col) = pk8(acc[ai][bj][m][0] * g0, acc[ai][bj][m][1] * g1); } } }
    }
};
struct EpiBrC {
    static constexpr bool PERM = false, AFTER_DRAIN = false, I8 = false, F8 = false;
    unsigned char* ws;
    __device__ __forceinline__ void operator()(const f32x4 (&acc)[2][2][4][2], const Unit& u, int wr, int wc, int fr, int fq) const {
        const size_t row0 = (size_t)u.pm * BM + wr * 64 + fr; const int col0 = u.pn * BM + 64 * wc + 8 * fq;
        const unsigned char* G = (const unsigned char*)(ws + WS_G) + (1 + u.idx) * 1024; const bf16_t* MFb = (const bf16_t*)(ws + WS_MF); bf16_t* O = (bf16_t*)(ws + (u.idx == 0 ? WS_MF : WS_Q));
#pragma unroll
        for (int ai = 0; ai < 2; ++ai) { unsigned long long gw[4][2]; u32x4 mw[4][2];
#pragma unroll
            for (int m = 0; m < 4; ++m)
#pragma unroll
                for (int bj = 0; bj < 2; ++bj) { const size_t row = row0 + ai * HALF + m * 16; const int col = col0 + 32 * bj;
                    gw[m][bj] = *(const unsigned long long*)(G + row * 3072 + col); mw[m][bj] = *(const u32x4*)(MFb + row * 1024 + col); }
#pragma unroll
            for (int m = 0; m < 4; ++m) { const size_t row = row0 + ai * HALF + m * 16;
#pragma unroll
                for (int bj = 0; bj < 2; ++bj) { const int col = col0 + 32 * bj;
                    const unsigned glo = (unsigned)gw[m][bj], ghi = (unsigned)(gw[m][bj] >> 32); const u32x4 w = mw[m][bj];
                    const f32x4 g0 = (f32x4){(float)(glo & 255u), (float)((glo >> 8) & 255u), (float)((glo >> 16) & 255u), (float)(glo >> 24)} * (1.0f / 255.0f), g1 = (f32x4){(float)(ghi & 255u), (float)((ghi >> 8) & 255u), (float)((ghi >> 16) & 255u), (float)(ghi >> 24)} * (1.0f / 255.0f);
                    const f32x4 m0 = {bf_lo(w.x), bf_hi(w.x), bf_lo(w.y), bf_hi(w.y)}, m1 = {bf_lo(w.z), bf_hi(w.z), bf_lo(w.w), bf_hi(w.w)};
                    *(u32x4*)(O + row * 1024 + col) = pk8(acc[ai][bj][m][0] * g0 + m0, acc[ai][bj][m][1] * g1 + m1); } } }
    }
};

struct EpiRes {
    static constexpr bool PERM = false, AFTER_DRAIN = false, I8 = false, F8 = false;
    const float* xin; float* x; unsigned char* ws; size_t xb_off; size_t dry_off;
    __device__ __forceinline__ void operator()(const f32x4 (&acc)[2][2][4][2], const Unit& u, int wr, int wc, int fr, int fq) const {
        const size_t row0 = (size_t)u.pm * BM + wr * 64 + fr; const int col0 = u.pn * BM + 64 * wc + 8 * fq;
        float* xout = dry_off ? (float*)(ws + dry_off) : x; bf16_t* xb = (bf16_t*)(ws + xb_off); float* ss = (float*)(ws + WS_SS);
#pragma unroll
        for (int ai = 0; ai < 2; ++ai)
#pragma unroll
            for (int m = 0; m < 4; ++m) { const size_t row = row0 + ai * HALF + m * 16; float s2 = 0.f;
#pragma unroll
                for (int bj = 0; bj < 2; ++bj) { const size_t off = row * 1024 + col0 + 32 * bj;
                    const f32x4 a = *(const f32x4*)(xin + off) + acc[ai][bj][m][0], b = *(const f32x4*)(xin + off + 4) + acc[ai][bj][m][1];
                    *(f32x4*)(xout + off) = a; *(f32x4*)(xout + off + 4) = b;
                    if (xb_off) { *(u32x4*)(xb + off) = pk8(a, b); s2 += ((a[0] * a[0] + a[1] * a[1]) + (a[2] * a[2] + a[3] * a[3])) + ((b[0] * b[0] + b[1] * b[1]) + (b[2] * b[2] + b[3] * b[3])); } }
                if (xb_off) { s2 += __shfl_xor(s2, 16); s2 += __shfl_xor(s2, 32); if (fq == 0) ss[row * 16 + u.pn * 4 + wc] = s2; } }
    }
};

struct EpiResB {
    static constexpr bool PERM = false, AFTER_DRAIN = false, I8 = false, F8 = false;
    const float* xf; bf16_t* xs;
    __device__ __forceinline__ void operator()(const f32x4 (&acc)[2][2][4][2], const Unit& u, int wr, int wc, int fr, int fq) const {
        const size_t row0 = (size_t)u.pm * BM + wr * 64 + fr; const int col0 = u.pn * BM + 64 * wc + 8 * fq;
#pragma unroll
        for (int ai = 0; ai < 2; ++ai)
#pragma unroll
            for (int m = 0; m < 4; ++m) { const size_t row = row0 + ai * HALF + m * 16;
#pragma unroll
                for (int bj = 0; bj < 2; ++bj) { const size_t off = row * 1024 + col0 + 32 * bj; f32x4 a, b;
                    if (xf) { a = *(const f32x4*)(xf + off); b = *(const f32x4*)(xf + off + 4); }
                    else { const u32x4 w = *(const u32x4*)(xs + off); a = (f32x4){bf_lo(w.x), bf_hi(w.x), bf_lo(w.y), bf_hi(w.y)}; b = (f32x4){bf_lo(w.z), bf_hi(w.z), bf_lo(w.w), bf_hi(w.w)}; }
                    *(u32x4*)(xs + off) = pk8(a + acc[ai][bj][m][0], b + acc[ai][bj][m][1]); } }
    }
};

template <bool I8_, bool OUT8 = false> struct EpiSwiglu {
    static constexpr bool PERM = false, AFTER_DRAIN = false, I8 = I8_, F8 = false;
    bf16_t* H; int ldc; const PG8_LAS float* rs; const float* cmax; int nh;
    const PG8_LAS int* texp; int t0;
    __device__ __forceinline__ void operator()(const f32x4 (&acc)[2][2][4][2], const Unit& u, int wr, int wc, int fr, int fq) const {
        const int rl = wr * 64 + fr; const size_t row0 = (size_t)u.pm * BM + rl; const int col0 = u.pn * 128 + 32 * wc + 8 * fq;
        f32x4 c1[2], c3[2];
#pragma unroll
        for (int bj = 0; bj < 2; ++bj) { if constexpr (I8_) { const float* cm = cmax + (texp ? (size_t)texp[t0 + u.pm] * 2 * nh : 0) + col0 + 4 * bj; c1[bj] = *(const f32x4*)cm * (1.0f / 127.0f); c3[bj] = *(const f32x4*)(cm + nh) * (OUT8 ? H8_SCALE / 127.0f : 1.0f / 127.0f); } else { c1[bj] = (f32x4){1.f, 1.f, 1.f, 1.f}; c3[bj] = c1[bj]; } }
#pragma unroll
        for (int ai = 0; ai < 2; ++ai)
#pragma unroll
            for (int m = 0; m < 4; ++m) { const float sc = rs[u.idx * 256 + rl + ai * HALF + m * 16]; f32x4 h[2];
#pragma unroll
                for (int bj = 0; bj < 2; ++bj) { const f32x4 a = accf<I8_>(acc[ai][bj][m][0]) * c1[bj] * sc, b = accf<I8_>(acc[ai][bj][m][1]) * c3[bj] * sc;
#pragma unroll
                    for (int j = 0; j < 4; ++j) h[bj][j] = a[j] * sigmoid_f(a[j]) * b[j]; }
                if constexpr (OUT8) {
#pragma unroll
                    for (int bj = 0; bj < 2; ++bj)
#pragma unroll
                        for (int j = 0; j < 4; ++j) h[bj][j] = __builtin_fminf(__builtin_fmaxf(h[bj][j], -448.0f), 448.0f);
                    const unsigned w0 = pk_fp8x4(h[0][0], h[0][1], h[0][2], h[0][3]), w1 = pk_fp8x4(h[1][0], h[1][1], h[1][2], h[1][3]);
                    *(unsigned long long*)((unsigned char*)H + (row0 + ai * HALF + m * 16) * ldc + col0) = (unsigned long long)w0 | ((unsigned long long)w1 << 32);
                } else *(u32x4*)(H + (row0 + ai * HALF + m * 16) * ldc + col0) = pk8(h[0], h[1]); }
    }
};

struct EpiStoreF8 {
    static constexpr bool PERM = false, AFTER_DRAIN = false, I8 = false, F8 = true;
    bf16_t* O; int ldc; const float* cs; const PG8_LAS int* texp; int t0;
    __device__ __forceinline__ void operator()(const f32x4 (&acc)[2][2][4][2], const Unit& u, int wr, int wc, int fr, int fq) const {
        const int rl = wr * 64 + fr; const size_t row0 = (size_t)u.pm * BM + rl; const int col0 = u.pn * BM + 64 * wc + 8 * fq;
        const float* c = cs + (texp ? (size_t)texp[t0 + u.pm] * 1024 : 0) + col0; f32x4 cw[2][2];
#pragma unroll
        for (int bj = 0; bj < 2; ++bj)
#pragma unroll
            for (int n = 0; n < 2; ++n) cw[bj][n] = *(const f32x4*)(c + 32 * bj + 4 * n);
#pragma unroll
        for (int ai = 0; ai < 2; ++ai)
#pragma unroll
            for (int m = 0; m < 4; ++m) { bf16_t* rowp = O + (row0 + ai * HALF + m * 16) * ldc + col0;
#pragma unroll
                for (int bj = 0; bj < 2; ++bj) *(u32x4*)(rowp + 32 * bj) = pk8(acc[ai][bj][m][0] * cw[bj][0], acc[ai][bj][m][1] * cw[bj][1]); }
    }
};
struct EpiResB8 {
    static constexpr bool PERM = false, AFTER_DRAIN = false, I8 = false, F8 = true;
    bf16_t* xs; const float* cs;
    __device__ __forceinline__ void operator()(const f32x4 (&acc)[2][2][4][2], const Unit& u, int wr, int wc, int fr, int fq) const {
        const size_t row0 = (size_t)u.pm * BM + wr * 64 + fr; const int col0 = u.pn * BM + 64 * wc + 8 * fq; f32x4 cw[2][2];
#pragma unroll
        for (int bj = 0; bj < 2; ++bj)
#pragma unroll
            for (int n = 0; n < 2; ++n) cw[bj][n] = *(const f32x4*)(cs + col0 + 32 * bj + 4 * n);
#pragma unroll
        for (int ai = 0; ai < 2; ++ai)
#pragma unroll
            for (int m = 0; m < 4; ++m) { const size_t row = row0 + ai * HALF + m * 16;
#pragma unroll
                for (int bj = 0; bj < 2; ++bj) { const size_t off = row * 1024 + col0 + 32 * bj; const u32x4 w = *(const u32x4*)(xs + off);
                    const f32x4 a = {bf_lo(w.x), bf_hi(w.x), bf_lo(w.y), bf_hi(w.y)}, b = {bf_lo(w.z), bf_hi(w.z), bf_lo(w.w), bf_hi(w.w)};
                    *(u32x4*)(xs + off) = pk8(a + acc[ai][bj][m][0] * cw[bj][0], b + acc[ai][bj][m][1] * cw[bj][1]); } }
    }
};
template <class Epi, class Sched, bool ALIGN_EPI = false, bool SP2 = false>
__device__ __forceinline__ void gemm_phase(PG8_LAS unsigned char* lds, const Gemm g, const Sched& S, const Epi& E) {
    int tid_ = threadIdx.x; asm volatile("" : "+v"(tid_));
    const int tid = tid_, wid = __builtin_amdgcn_readfirstlane(tid >> 6), lane = tid & 63, wr = wid >> 2, wc = wid & 3, fr = lane & 15, fq = lane >> 4;
    const int K = g.K, nt = K / BK;
    unsigned voffA[2], voffB[2];
#pragma unroll
    for (int i = 0; i < 2; ++i) { int R, C; stage_rc(tid * 16 + i * 8192, R, C); const int Rb = Epi::PERM ? ((R & ~31) + perm32(R & 31)) : R;
        voffA[i] = (unsigned)(R * K + C) * 2u; voffB[i] = (unsigned)(Rb * K + C) * 2u; }
    const size_t kstep = (size_t)(BK * 2);
    const size_t hstep = (size_t)HALF * K * 2;
    const size_t tstep = 2 * hstep;
    const unsigned ldsw = (unsigned)wid * 1024u;
    const int aoff = lds_byte(wr * 64 + fr, fq * 8), boff = lds_byte(wc * 32 + fr, fq * 8);
#define PG8_SA(b, h) (((b) * 2 + (h)) * HTB)
#define PG8_SB(b, h) ((4 + (b) * 2 + (h)) * HTB)
#define PG8_STAGE(bufoff, gbase, voff) do { _Pragma("unroll") for (int _i = 0; _i < 2; ++_i) \
        __builtin_amdgcn_global_load_lds((const unsigned*)((const char*)(gbase) + (voff)[_i]), (PG8_LAS unsigned*)(lds + (bufoff) + ldsw + _i * 8192), 16, 0, 0); } while (0)
#define PG8_LDA(dst, b, h) do { if constexpr (Epi::F8) { _Pragma("unroll") for (int m = 0; m < 4; ++m) { const i32x4 lo_ = *(const PG8_LAS i32x4*)(lds + PG8_SA(b, h) + aoff + m * 2048), hi_ = *(const PG8_LAS i32x4*)(lds + PG8_SA(b, h) + aoff + m * 2048 + 1024); dst##8[m] = __builtin_shufflevector(lo_, hi_, 0, 1, 2, 3, 4, 5, 6, 7); } } \
        else { _Pragma("unroll") for (int m = 0; m < 4; ++m) _Pragma("unroll") for (int k = 0; k < 2; ++k) dst[m][k] = *(const PG8_LAS bf16x8*)(lds + PG8_SA(b, h) + aoff + m * 2048 + k * 1024); } } while (0)
#define PG8_LDB(dst, b, h) do { if constexpr (Epi::F8) { _Pragma("unroll") for (int n = 0; n < 2; ++n) { const i32x4 lo_ = *(const PG8_LAS i32x4*)(lds + PG8_SB(b, h) + boff + n * 2048), hi_ = *(const PG8_LAS i32x4*)(lds + PG8_SB(b, h) + boff + n * 2048 + 1024); dst##8[n] = __builtin_shufflevector(lo_, hi_, 0, 1, 2, 3, 4, 5, 6, 7); } } \
        else { _Pragma("unroll") for (int n = 0; n < 2; ++n) _Pragma("unroll") for (int k = 0; k < 2; ++k) dst[n][k] = *(const PG8_LAS bf16x8*)(lds + PG8_SB(b, h) + boff + n * 2048 + k * 1024); } } while (0)
#define PG8_MMA(ai, bj, At, Bt) do { __builtin_amdgcn_s_setprio(1); if constexpr (Epi::F8) { _Pragma("unroll") for (int m = 0; m < 4; ++m) _Pragma("unroll") for (int n = 0; n < 2; ++n) acc[ai][bj][m][n] = mma_f8(Bt##8[n], At##8[m], acc[ai][bj][m][n]); } \
        else { _Pragma("unroll") for (int m = 0; m < 4; ++m) _Pragma("unroll") for (int n = 0; n < 2; ++n) _Pragma("unroll") for (int k = 0; k < 2; ++k) acc[ai][bj][m][n] = mma16<Epi::I8>(Bt[n][k], At[m][k], acc[ai][bj][m][n]); } __builtin_amdgcn_s_setprio(0); } while (0)
#define PG8_WAIT_V(n) asm volatile("s_waitcnt vmcnt(" #n ")" ::: "memory")
#define PG8_WAIT_L(n) asm volatile("s_waitcnt lgkmcnt(" #n ")" ::: "memory")
#define PG8_BAR __builtin_amdgcn_s_barrier()
#define PG8_SCHED __builtin_amdgcn_sched_barrier(0)
    Unit cur, nxt; int ui = 0;
    if (!S.next(0, cur)) return;
    f32x4 acc[2][2][4][2];
#pragma unroll
    for (int a = 0; a < 2; ++a)
#pragma unroll
        for (int b = 0; b < 2; ++b)
#pragma unroll
            for (int m = 0; m < 4; ++m)
#pragma unroll
                for (int n = 0; n < 2; ++n) acc[a][b][m][n] = (f32x4){0.f, 0.f, 0.f, 0.f};
    bf16x8 At[4][2], B0[2][2], B1[2][2];
    i32x8 At8[4], B08[2], B18[2];
    const char* cA = S.aptr(g, cur, tstep); const char* cB = S.bptr(g, cur, tstep);
    S.a_ready(cur);
    if constexpr (SP2) {
        PG8_STAGE(PG8_SB(0, 0), cB, voffB); PG8_STAGE(PG8_SB(0, 1), cB + hstep, voffB); PG8_STAGE(PG8_SA(0, 0), cA, voffA); PG8_STAGE(PG8_SA(0, 1), cA + hstep, voffA);
        if (wr == 1) PG8_BAR;
        PG8_WAIT_V(2); PG8_BAR;
        PG8_STAGE(PG8_SB(1, 0), cB + kstep, voffB); PG8_STAGE(PG8_SA(1, 0), cA + kstep, voffA); PG8_STAGE(PG8_SB(1, 1), cB + hstep + kstep, voffB);
        PG8_WAIT_V(6); PG8_BAR;
    } else {
        PG8_STAGE(PG8_SB(0, 0), cB, voffB); PG8_STAGE(PG8_SA(0, 0), cA, voffA); PG8_STAGE(PG8_SB(0, 1), cB + hstep, voffB); PG8_STAGE(PG8_SA(0, 1), cA + hstep, voffA);
        if (wr == 1) PG8_BAR;
        PG8_WAIT_V(4); PG8_BAR;
        PG8_STAGE(PG8_SB(1, 0), cB + kstep, voffB); PG8_STAGE(PG8_SA(1, 0), cA + kstep, voffA); PG8_STAGE(PG8_SB(1, 1), cB + hstep + kstep, voffB);
        PG8_WAIT_V(6); PG8_BAR;
    }
    for (;;) {
        const bool has_next = S.next(ui + 1, nxt);
        const char* nA = has_next ? S.aptr(g, nxt, tstep) : cA; const char* nB = has_next ? S.bptr(g, nxt, tstep) : cB;
        for (int t = 0; t < nt; t += 2) {
            const bool last = (t == nt - 2);
            const char* a1 = cA + (size_t)(t + 1) * kstep;
            const char* a2 = last ? nA : cA + (size_t)(t + 2) * kstep; const char* b2 = last ? nB : cB + (size_t)(t + 2) * kstep;
            const char* a3 = a2 + kstep; const char* b3 = b2 + kstep;
            if (last && has_next) S.a_ready(nxt);
            if constexpr (SP2) {
            PG8_LDB(B0, 0, 0); PG8_LDB(B1, 0, 1); PG8_SCHED; PG8_LDA(At, 0, 0); PG8_STAGE(PG8_SA(1, 1), a1 + hstep, voffA);
            PG8_WAIT_V(8); PG8_WAIT_L(0); PG8_BAR; PG8_MMA(0, 0, At, B0); PG8_MMA(0, 1, At, B1); PG8_BAR; PG8_SCHED;
            PG8_LDA(At, 0, 1); PG8_STAGE(PG8_SB(0, 0), b2, voffB); PG8_STAGE(PG8_SB(0, 1), b2 + hstep, voffB); PG8_STAGE(PG8_SA(0, 0), a2, voffA);
            PG8_WAIT_V(8); PG8_WAIT_L(0); PG8_BAR; PG8_MMA(1, 0, At, B0); PG8_MMA(1, 1, At, B1); PG8_BAR; PG8_SCHED;
            PG8_LDB(B0, 1, 0); PG8_LDB(B1, 1, 1); PG8_SCHED; PG8_LDA(At, 1, 0); PG8_STAGE(PG8_SA(0, 1), a2 + hstep, voffA);
            PG8_WAIT_V(8); PG8_WAIT_L(0); PG8_BAR; PG8_MMA(0, 0, At, B0); PG8_MMA(0, 1, At, B1); PG8_BAR; PG8_SCHED;
            PG8_LDA(At, 1, 1); PG8_STAGE(PG8_SB(1, 0), b3, voffB); PG8_STAGE(PG8_SB(1, 1), b3 + hstep, voffB); PG8_STAGE(PG8_SA(1, 0), a3, voffA);
            PG8_WAIT_V(8); PG8_WAIT_L(0); PG8_BAR; PG8_MMA(1, 0, At, B0); PG8_MMA(1, 1, At, B1); PG8_BAR; PG8_SCHED;
            } else {
            PG8_LDB(B0, 0, 0); PG8_SCHED; PG8_LDA(At, 0, 0); PG8_STAGE(PG8_SA(1, 1), a1 + hstep, voffA);
            PG8_WAIT_L(8); PG8_BAR; PG8_WAIT_L(0); PG8_MMA(0, 0, At, B0); PG8_BAR; PG8_SCHED;
            PG8_LDB(B1, 0, 1); PG8_STAGE(PG8_SB(0, 0), b2, voffB);
            PG8_BAR; PG8_WAIT_L(0); PG8_MMA(0, 1, At, B1); PG8_BAR;
            PG8_LDA(At, 0, 1); PG8_STAGE(PG8_SA(0, 0), a2, voffA);
            PG8_BAR; PG8_WAIT_L(0); PG8_MMA(1, 0, At, B0); PG8_BAR; PG8_SCHED;
            PG8_STAGE(PG8_SB(0, 1), b2 + hstep, voffB);
            PG8_WAIT_V(6); PG8_BAR; PG8_MMA(1, 1, At, B1); PG8_BAR;
            PG8_LDB(B0, 1, 0); PG8_SCHED; PG8_LDA(At, 1, 0); PG8_STAGE(PG8_SA(0, 1), a2 + hstep, voffA);
            PG8_WAIT_L(8); PG8_BAR; PG8_WAIT_L(0); PG8_MMA(0, 0, At, B0); PG8_BAR; PG8_SCHED;
            PG8_LDB(B1, 1, 1); PG8_STAGE(PG8_SB(1, 0), b3, voffB);
            PG8_BAR; PG8_WAIT_L(0); PG8_MMA(0, 1, At, B1); PG8_BAR;
            PG8_LDA(At, 1, 1); PG8_STAGE(PG8_SA(1, 0), a3, voffA);
            PG8_BAR; PG8_WAIT_L(0); PG8_MMA(1, 0, At, B0); PG8_BAR; PG8_SCHED;
            PG8_STAGE(PG8_SB(1, 1), b3 + hstep, voffB);
            PG8_WAIT_V(6); PG8_BAR; PG8_MMA(1, 1, At, B1); PG8_BAR;
            }
        }
        if constexpr (ALIGN_EPI) { if (wr == 0) PG8_BAR; }
        if constexpr (!Epi::AFTER_DRAIN) { E(acc, cur, wr, wc, fr, fq); S.done(cur); }
        if (!has_next) break;
#pragma unroll
        for (int a = 0; a < 2; ++a)
#pragma unroll
            for (int b = 0; b < 2; ++b)
#pragma unroll
                for (int m = 0; m < 4; ++m)
#pragma unroll
                    for (int n = 0; n < 2; ++n) acc[a][b][m][n] = (f32x4){0.f, 0.f, 0.f, 0.f};
        cur = nxt; cA = nA; cB = nB; ++ui;
        if constexpr (ALIGN_EPI) { if (wr == 1) PG8_BAR; }
    }
    PG8_WAIT_V(0);
    if constexpr (!ALIGN_EPI) { if (wr == 0) PG8_BAR; }
    PG8_BAR;
    if constexpr (Epi::AFTER_DRAIN) { E.fused(acc, cur, wr, wc, fr, fq, lds, wid, lane); S.done(cur); }
#undef PG8_SA
#undef PG8_SB
#undef PG8_STAGE
#undef PG8_LDA
#undef PG8_LDB
#undef PG8_MMA
#undef PG8_WAIT_V
#undef PG8_WAIT_L
#undef PG8_BAR
#undef PG8_SCHED
}
}
#define GAS __attribute__((address_space(1)))
#define LAS __attribute__((address_space(3)))
typedef unsigned short bf16_t;
typedef unsigned v4u __attribute__((ext_vector_type(4)));
typedef float f32x4 __attribute__((ext_vector_type(4)));
typedef float f32x2 __attribute__((ext_vector_type(2)));
#define RLX_AGENT __ATOMIC_RELAXED, __HIP_MEMORY_SCOPE_AGENT
__device__ __forceinline__ float wave_sum(float v) {
#pragma unroll
    for (int o = 1; o < 64; o <<= 1) v += __shfl_xor(v, o);
    return v;
}
__device__ __forceinline__ float ld_f32_agent(const float* p) { return __builtin_bit_cast(float, __builtin_amdgcn_readfirstlane(__hip_atomic_load((const unsigned*)p, RLX_AGENT))); }
__device__ __forceinline__ float ld_f32_plain(const float* p) { return *(const GAS float*)p; }
__device__ __forceinline__ int ld_i32_agent(const int* p) { return (int)__hip_atomic_load((const unsigned*)p, RLX_AGENT); }
using pg8::pk_bf16; using pg8::bf_lo; using pg8::bf_hi;

#define XB_TMO      128
#define XB_XCNT(j)  (256  + 64 * (j))
#define XB_XSUB(j)  (1280 + 64 * (j))
#define XB_XGEN(j)  (2304 + 64 * (j))
#define XB_TOP      3328
#define XB_TOPGEN   3392
#define XCD_BAR_WORDS 3456
#define XB_SPIN_CAP (1u << 18)

__device__ __forceinline__ unsigned xb_ld(unsigned* p)              { return __hip_atomic_load(p, __ATOMIC_RELAXED, __HIP_MEMORY_SCOPE_AGENT); }
__device__ __forceinline__ unsigned xb_add(unsigned* p, unsigned v) { return __hip_atomic_fetch_add(p, v, __ATOMIC_RELAXED, __HIP_MEMORY_SCOPE_AGENT); }
__device__ __forceinline__ unsigned xb_xcc_id() { return (unsigned)__builtin_amdgcn_s_getreg((3 << 11) | 20) & 0xFu; }
#define XB_SPIN(cond, bar) do { unsigned _sp = 0; while (cond) { __builtin_amdgcn_s_sleep(1); \
    if ((++_sp & 255u) == 0u) { if (xb_ld(&(bar)[XB_TMO])) break; if (_sp > XB_SPIN_CAP) { atomicAdd(&(bar)[XB_TMO], 1u); break; } } } } while (0)

struct XcdBarrier {
    unsigned* bar; unsigned x;
    volatile LAS unsigned* st;
};

__device__ __forceinline__ XcdBarrier xcd_barrier_post(unsigned* bar, volatile LAS unsigned* st) {
    XcdBarrier b; b.bar = bar; b.x = xb_xcc_id(); b.st = st;
    if (threadIdx.x == 0) (void)xb_add(&bar[XB_XCNT(b.x)], 1u);
    return b;
}
__device__ __forceinline__ void xcd_barrier_complete(unsigned* bar, unsigned x, unsigned& nloc, unsigned& nx) {
    const unsigned G = gridDim.x * gridDim.y * gridDim.z;
    unsigned sum, cnt, mine, sp = 0u;
    for (;;) {
        sum = 0u; cnt = 0u; mine = 0u;
#pragma unroll
        for (unsigned j = 0; j < 16; ++j) { const unsigned c = xb_ld(&bar[XB_XCNT(j)]); sum += c; cnt += (c > 0u) ? 1u : 0u; mine = (j == x) ? c : mine; }
        if (sum == G) break;
        __builtin_amdgcn_s_sleep(1);
        if ((++sp & 255u) == 0u) { if (xb_ld(&bar[XB_TMO])) break; if (sp > XB_SPIN_CAP) { atomicAdd(&bar[XB_TMO], 1u); break; } }
    }
    nloc = mine > 0u ? mine : 1u; nx = cnt > 0u ? cnt : 1u;
}

__device__ __forceinline__ void xcd_barrier(const XcdBarrier& b) {
    asm volatile("s_waitcnt vmcnt(0)" ::: "memory");
    __syncthreads();
    if (threadIdx.x == 0) {
        unsigned* bar = b.bar;
        __builtin_amdgcn_s_waitcnt(0);
        unsigned nloc = b.st[0], nx = b.st[1];
        if (nloc == 0u) { xcd_barrier_complete(bar, b.x, nloc, nx); b.st[0] = nloc; b.st[1] = nx; }
        const unsigned old = xb_add(&bar[XB_XSUB(b.x)], 1u);
        const unsigned gen = old / nloc;
        if (old + 1u == (gen + 1u) * nloc) {
            __builtin_amdgcn_fence(__ATOMIC_RELEASE, "agent");
            asm volatile("s_waitcnt vmcnt(0)" ::: "memory");
            const unsigned og = xb_add(&bar[XB_TOP], 1u);
            const unsigned tg = og / nx;
            if (og + 1u == (tg + 1u) * nx) xb_add(&bar[XB_TOPGEN], 1u);
            else XB_SPIN(xb_ld(&bar[XB_TOPGEN]) == tg, bar);
            __builtin_amdgcn_fence(__ATOMIC_ACQUIRE, "agent");
            xb_add(&bar[XB_XGEN(b.x)], 1u);
            asm volatile("s_waitcnt vmcnt(0)" ::: "memory");
        } else {
            XB_SPIN(xb_ld(&bar[XB_XGEN(b.x)]) == gen, bar);
            __builtin_amdgcn_fence(__ATOMIC_ACQUIRE, "agent");
            asm volatile("s_waitcnt vmcnt(0)" ::: "memory");
        }
    }
    __syncthreads();
}


struct Args { const float* in[31]; float* out; unsigned char* ws; int ph_lo, ph_hi; };

struct TJob { unsigned long long src, dst, gain; int K, N, ld, map, colbase, start, q8, smax, startq, f8, startf; };
constexpr int NJOBS = 41;
__device__ __forceinline__ void make_job(int j, const Args& a, TJob& o) {
    unsigned char* ws = a.ws; const float* src; void* dst; const float* gain = nullptr; o.map = 0; o.colbase = 0; o.q8 = 0; o.smax = 0; o.f8 = 0;
    if (j < 14) { const int l = j / 7, t = j % 7;
        if (t == 0)      { src = a.in[5] + (size_t)l * D * 4096; o.K = D; o.N = 4096; dst = ws + WS_W1T + l * 14 * MiB; gain = a.in[2] + l * D; o.q8 = I8_A; o.smax = SW_G1 + l * 7168; }
        else if (t == 1) { src = a.in[6] + (size_t)l * D * 3072; o.K = D; o.N = 3072; dst = ws + WS_W1T + l * 14 * MiB; gain = a.in[2] + l * D; o.colbase = 4096; o.q8 = I8_A; o.smax = SW_G1 + l * 7168 + 4096; }
        else if (t == 2) { src = a.in[19] + (size_t)l * D * 1024; o.K = D; o.N = 1024; dst = ws + WS_WMEMKV + l * 2 * MiB; gain = a.in[3] + l * D; }
        else if (t == 3) { src = a.in[20] + (size_t)l * 1024 * D; o.K = 1024; o.N = D; dst = ws + WS_WBRDA + l * 2 * MiB; }
        else if (t == 4) { src = a.in[21] + (size_t)l * 512 * D; o.K = 512; o.N = D; dst = ws + WS_WBRPOOL + l * 1 * MiB; }
        else if (t == 5) { src = a.in[22] + (size_t)l * 512 * D; o.K = 512; o.N = D; dst = ws + WS_WBRMEM + l * 1 * MiB; }
        else             { src = a.in[23] + (size_t)l * D * D; o.K = D; o.N = D; dst = ws + WS_WOUT + l * 2 * MiB; }
    } else if (j < 17) { const int t = j - 14;
        if (t < 2) { src = a.in[24 + t]; o.K = D; o.N = FFD; dst = ws + WS_WFF13; gain = a.in[4]; o.map = 1 + t; o.q8 = I8_E; o.smax = SW_FF + t * FFD; }
        else       { src = a.in[26]; o.K = FFD; o.N = D; dst = ws + WS_WFF2; o.f8 = 1; o.smax = SW_W2 + 8 * 1024; }
    } else { const int e = (j - 17) / 3, t = (j - 17) % 3;
        if (t < 2) { src = a.in[28 + t] + (size_t)e * D * FFE; o.K = D; o.N = FFE; dst = ws + WS_WMOE13 + (size_t)e * 7 * MiB; gain = a.in[4] + D; o.map = 1 + t; o.q8 = USE_I8; o.smax = SW_MOE + e * 2 * FFE + t * FFE; }
        else       { src = a.in[30] + (size_t)e * FFE * D; o.K = FFE; o.N = D; dst = ws + WS_WMOE2 + (size_t)e * 7 * MiB; o.f8 = 1; o.smax = SW_W2 + e * 1024; }
    }
    o.src = (unsigned long long)src; o.dst = (unsigned long long)dst; o.gain = (unsigned long long)gain; o.ld = o.N; o.start = 0; o.startq = 0; o.startf = 0;
}
__device__ __forceinline__ int bt_row_std(int C) { const int c = C & 255; return (C & ~255) + 128 * ((c >> 5) & 1) + 32 * (c >> 6) + 16 * ((c >> 2) & 1) + 4 * ((c >> 3) & 3) + (c & 3); }
__device__ __forceinline__ int bt_row_swiglu(int h, int which) { const int hl = h & 127; return 256 * (h >> 7) + 128 * ((hl >> 2) & 1) + 32 * (hl >> 5) + 16 * which + 4 * ((hl >> 3) & 3) + (hl & 3); }
struct TileRef { const GAS float* src; GAS bf16_t* dst; const GAS float* gain; int K, ld, map, colbase, k0, n0, q8, smax; };
template <bool QONLY> __device__ __forceinline__ void tile_decode(const LAS TJob* jobs, int& j, int it, TileRef& r) {
    if constexpr (QONLY) { while (it >= jobs[j + 1].startq) ++j; } else { while (it >= jobs[j + 1].start) ++j; }
    const LAS TJob* jb = jobs + j; const int item = it - (QONLY ? jb->startq : jb->start), nblk = jb->N >> 6;
    r.src = (const GAS float*)jb->src; r.dst = (GAS bf16_t*)jb->dst; r.gain = (const GAS float*)jb->gain; r.K = jb->K; r.ld = jb->ld; r.map = jb->map; r.colbase = jb->colbase; r.q8 = jb->q8; r.smax = jb->smax;
    r.k0 = (item / nblk) * 64; r.n0 = (item % nblk) * 64;
}
__device__ __forceinline__ void tile_load(const TileRef& r, int lane, f32x4 (&v)[16]) {
    const GAS float* p = r.src + (size_t)(r.k0 + (lane >> 4)) * r.ld + r.n0 + 4 * (lane & 15);
#pragma unroll
    for (int i = 0; i < 16; ++i) v[i] = __builtin_nontemporal_load((const GAS f32x4*)(p + (size_t)(4 * i) * r.ld));
}
__device__ __forceinline__ void tile_store(const TileRef& r, int lane, const f32x4 (&v)[16], LAS float* scr) {
#pragma unroll
    for (int i = 0; i < 16; ++i) { LAS float* d = scr + (4 * i + (lane >> 4)) * 65 + 4 * (lane & 15); d[0] = v[i][0]; d[1] = v[i][1]; d[2] = v[i][2]; d[3] = v[i][3]; }
    asm volatile("s_waitcnt lgkmcnt(0)" ::: "memory");
    const int kc = lane & 7;
    f32x4 g0 = {1.f, 1.f, 1.f, 1.f}, g1 = g0;
    if (r.gain) { g0 = *(const GAS f32x4*)(r.gain + r.k0 + 8 * kc); g1 = *(const GAS f32x4*)(r.gain + r.k0 + 8 * kc + 4); }
#pragma unroll
    for (int jj = 0; jj < 8; ++jj) { const int n = (lane >> 3) + 8 * jj; const LAS float* s = scr + (8 * kc) * 65 + n;
        v4u o; o.x = pk_bf16(s[0 * 65] * g0[0], s[1 * 65] * g0[1]); o.y = pk_bf16(s[2 * 65] * g0[2], s[3 * 65] * g0[3]); o.z = pk_bf16(s[4 * 65] * g1[0], s[5 * 65] * g1[1]); o.w = pk_bf16(s[6 * 65] * g1[2], s[7 * 65] * g1[3]);
        const int row = (r.map == 0) ? bt_row_std(r.colbase + r.n0 + n) : bt_row_swiglu(r.n0 + n, r.map - 1);
        *(GAS v4u*)(r.dst + (size_t)row * r.K + r.k0 + 8 * kc) = o; }
    asm volatile("s_waitcnt lgkmcnt(0)" ::: "memory");
}
__device__ __forceinline__ void tile_colmax(const TileRef& r, int lane, const f32x4 (&v)[16], float* cmaxbase) {
    float m0 = 0.f, m1 = 0.f, m2 = 0.f, m3 = 0.f;
#pragma unroll
    for (int i = 0; i < 16; ++i) { const float g = r.gain ? r.gain[r.k0 + 4 * i + (lane >> 4)] : 1.f;
        m0 = fmaxf(m0, fabsf(v[i][0] * g)); m1 = fmaxf(m1, fabsf(v[i][1] * g)); m2 = fmaxf(m2, fabsf(v[i][2] * g)); m3 = fmaxf(m3, fabsf(v[i][3] * g)); }
    m0 = fmaxf(m0, __shfl_xor(m0, 16)); m1 = fmaxf(m1, __shfl_xor(m1, 16)); m2 = fmaxf(m2, __shfl_xor(m2, 16)); m3 = fmaxf(m3, __shfl_xor(m3, 16));
    m0 = fmaxf(m0, __shfl_xor(m0, 32)); m1 = fmaxf(m1, __shfl_xor(m1, 32)); m2 = fmaxf(m2, __shfl_xor(m2, 32)); m3 = fmaxf(m3, __shfl_xor(m3, 32));
    if (lane < 16) { unsigned* p = (unsigned*)(cmaxbase + r.smax + r.n0 + 4 * lane);
        atomicMax(p, __float_as_uint(m0)); atomicMax(p + 1, __float_as_uint(m1)); atomicMax(p + 2, __float_as_uint(m2)); atomicMax(p + 3, __float_as_uint(m3)); }
}
__device__ __forceinline__ unsigned pk_i8x4(float a, float b, float c, float d) {
    const int ia = (int)__builtin_rintf(a), ib = (int)__builtin_rintf(b), ic = (int)__builtin_rintf(c), id = (int)__builtin_rintf(d);
    return (unsigned)(ia & 0xff) | ((unsigned)(ib & 0xff) << 8) | ((unsigned)(ic & 0xff) << 16) | ((unsigned)id << 24);
}
__device__ __forceinline__ void tile_store_q8(const TileRef& r, int lane, const f32x4 (&v)[16], LAS float* scr, const float* cmaxbase) {
#pragma unroll
    for (int i = 0; i < 16; ++i) { const float g = r.gain ? r.gain[r.k0 + 4 * i + (lane >> 4)] : 1.f; LAS float* d = scr + (4 * i + (lane >> 4)) * 65 + 4 * (lane & 15); d[0] = v[i][0] * g; d[1] = v[i][1] * g; d[2] = v[i][2] * g; d[3] = v[i][3] * g; }
    asm volatile("s_waitcnt lgkmcnt(0)" ::: "memory");
    const int kc = lane & 3;
#pragma unroll
    for (int jj = 0; jj < 4; ++jj) { const int n = (lane >> 2) + 16 * jj; const LAS float* s = scr + (16 * kc) * 65 + n;
        const float cm = ld_f32_plain(cmaxbase + r.smax + r.n0 + n), inv = cm > 0.f ? 127.0f / cm : 0.f;
        v4u o; o.x = pk_i8x4(s[0 * 65] * inv, s[1 * 65] * inv, s[2 * 65] * inv, s[3 * 65] * inv); o.y = pk_i8x4(s[4 * 65] * inv, s[5 * 65] * inv, s[6 * 65] * inv, s[7 * 65] * inv);
        o.z = pk_i8x4(s[8 * 65] * inv, s[9 * 65] * inv, s[10 * 65] * inv, s[11 * 65] * inv); o.w = pk_i8x4(s[12 * 65] * inv, s[13 * 65] * inv, s[14 * 65] * inv, s[15 * 65] * inv);
        const int row = (r.map == 0) ? bt_row_std(r.colbase + r.n0 + n) : bt_row_swiglu(r.n0 + n, r.map - 1);
        *(GAS v4u*)((GAS unsigned char*)r.dst + (size_t)row * r.K + r.k0 + 16 * kc) = o; }
    asm volatile("s_waitcnt lgkmcnt(0)" ::: "memory");
}
__device__ __forceinline__ void row_to_i8(const float* xrow, unsigned char* qrow, float* sa, int lane) {
    const f32x4* xr = (const f32x4*)xrow + 4 * lane; f32x4 v[4]; float s = 0.f, mx = 0.f;
#pragma unroll
    for (int j = 0; j < 4; ++j) { v[j] = xr[j]; s += (v[j][0] * v[j][0] + v[j][1] * v[j][1]) + (v[j][2] * v[j][2] + v[j][3] * v[j][3]);
        mx = fmaxf(mx, fmaxf(fmaxf(fabsf(v[j][0]), fabsf(v[j][1])), fmaxf(fabsf(v[j][2]), fabsf(v[j][3])))); }
    s = wave_sum(s);
#pragma unroll
    for (int o = 1; o < 64; o <<= 1) mx = fmaxf(mx, __shfl_xor(mx, o));
    const float inv = mx > 0.f ? 127.0f / mx : 0.f;
    v4u w; w.x = pk_i8x4(v[0][0] * inv, v[0][1] * inv, v[0][2] * inv, v[0][3] * inv); w.y = pk_i8x4(v[1][0] * inv, v[1][1] * inv, v[1][2] * inv, v[1][3] * inv);
    w.z = pk_i8x4(v[2][0] * inv, v[2][1] * inv, v[2][2] * inv, v[2][3] * inv); w.w = pk_i8x4(v[3][0] * inv, v[3][1] * inv, v[3][2] * inv, v[3][3] * inv);
    *((v4u*)qrow + lane) = w;
    if (lane == 0) *sa = mx * (1.0f / 127.0f) * __builtin_amdgcn_rsqf(s * (1.0f / 1024.0f) + 1e-6f);
}
__device__ __forceinline__ void ld16_bf16(const bf16_t* p, f32x4 (&v)[4]) {
    const v4u a = *(const v4u*)p, b = *(const v4u*)(p + 8);
    v[0] = (f32x4){bf_lo(a.x), bf_hi(a.x), bf_lo(a.y), bf_hi(a.y)}; v[1] = (f32x4){bf_lo(a.z), bf_hi(a.z), bf_lo(a.w), bf_hi(a.w)};
    v[2] = (f32x4){bf_lo(b.x), bf_hi(b.x), bf_lo(b.y), bf_hi(b.y)}; v[3] = (f32x4){bf_lo(b.z), bf_hi(b.z), bf_lo(b.w), bf_hi(b.w)};
}
__device__ __forceinline__ void rowb_to_i8(const bf16_t* xrow, unsigned char* qrow, float* sa, int lane) {
    f32x4 v[4]; ld16_bf16(xrow + 16 * lane, v); float s = 0.f, mx = 0.f;
#pragma unroll
    for (int j = 0; j < 4; ++j) { s += (v[j][0] * v[j][0] + v[j][1] * v[j][1]) + (v[j][2] * v[j][2] + v[j][3] * v[j][3]);
        mx = fmaxf(mx, fmaxf(fmaxf(fabsf(v[j][0]), fabsf(v[j][1])), fmaxf(fabsf(v[j][2]), fabsf(v[j][3])))); }
    s = wave_sum(s);
#pragma unroll
    for (int o = 1; o < 64; o <<= 1) mx = fmaxf(mx, __shfl_xor(mx, o));
    const float inv = mx > 0.f ? 127.0f / mx : 0.f;
    v4u w; w.x = pk_i8x4(v[0][0] * inv, v[0][1] * inv, v[0][2] * inv, v[0][3] * inv); w.y = pk_i8x4(v[1][0] * inv, v[1][1] * inv, v[1][2] * inv, v[1][3] * inv);
    w.z = pk_i8x4(v[2][0] * inv, v[2][1] * inv, v[2][2] * inv, v[2][3] * inv); w.w = pk_i8x4(v[3][0] * inv, v[3][1] * inv, v[3][2] * inv, v[3][3] * inv);
    *((v4u*)qrow + lane) = w;
    if (lane == 0) *sa = mx * (1.0f / 127.0f) * __builtin_amdgcn_rsqf(s * (1.0f / 1024.0f) + 1e-6f);
}
__device__ __forceinline__ void phase_quant_rows(const bf16_t* x, unsigned char* ws, int lane, int wave) {
    const int gw = blockIdx.x * NWAVES + wave, NGW = gridDim.x * NWAVES;
    for (int m = gw; m < T; m += NGW) rowb_to_i8(x + (size_t)m * D, ws + WS_QX + (size_t)m * D, (float*)(ws + WS_SA) + m, lane);
}
__device__ __forceinline__ void row_to_bf16_ss(const float* xrow, bf16_t* orow, float* ss16, float* fcopy, int lane) {
    const f32x4* xr = (const f32x4*)xrow + lane; f32x4 v[4]; float s = 0.f;
#pragma unroll
    for (int j = 0; j < 4; ++j) { v[j] = xr[64 * j]; s += (v[j][0] * v[j][0] + v[j][1] * v[j][1]) + (v[j][2] * v[j][2] + v[j][3] * v[j][3]); }
    s = wave_sum(s);
    if (fcopy) { f32x4* fc = (f32x4*)fcopy + lane;
#pragma unroll
        for (int j = 0; j < 4; ++j) fc[64 * j] = v[j]; }
    unsigned long long* o8 = (unsigned long long*)orow + lane;
#pragma unroll
    for (int j = 0; j < 4; ++j) o8[64 * j] = (unsigned long long)pk_bf16(v[j][0], v[j][1]) | ((unsigned long long)pk_bf16(v[j][2], v[j][3]) << 32);
    if (lane < 16) ss16[lane] = (lane == 0) ? s : 0.f;
}
__device__ __forceinline__ void build_jobs(const Args& a, LAS TJob* jobs, int tid) {
    if (tid < NJOBS) { TJob jb; make_job(tid, a, jb); LAS TJob* d = jobs + tid; d->src = jb.src; d->dst = jb.dst; d->gain = jb.gain; d->K = jb.K; d->N = jb.N; d->ld = jb.ld; d->map = jb.map; d->colbase = jb.colbase; d->q8 = jb.q8; d->smax = jb.smax; d->start = 0; d->startq = 0; d->f8 = jb.f8; d->startf = 0; }
    __syncthreads();
    if (tid == 0) { int s = 0, q = 0, f = 0; for (int j = 0; j < NJOBS; ++j) { jobs[j].start = s; jobs[j].startq = q; jobs[j].startf = f; if (jobs[j].q8) q += jobs[j].N / 64; else if (jobs[j].f8) f += jobs[j].N / 16; else s += (jobs[j].K / 64) * (jobs[j].N / 64); }
        jobs[NJOBS].start = s; jobs[NJOBS].startq = q; jobs[NJOBS].startf = f; }
    __syncthreads();
}
__device__ __forceinline__ void strip_q8(const LAS TJob* jobs, int& j, int st, LAS unsigned char* lds, int tid, int lane, int wave, float* cmaxbase) {
    while (st >= jobs[j + 1].startq) ++j;
    const LAS TJob* jb = jobs + j;
    TileRef r; r.src = (const GAS float*)jb->src; r.dst = (GAS bf16_t*)jb->dst; r.gain = (const GAS float*)jb->gain; r.K = jb->K; r.ld = jb->ld; r.map = jb->map; r.colbase = jb->colbase; r.q8 = 1; r.smax = jb->smax;
    r.n0 = (st - jb->startq) * 64; r.k0 = 128 * wave;
    LAS float* scr = (LAS float*)(lds + wave * 17408); LAS float* pmax = (LAS float*)(lds + 8 * 17408 + 4096); LAS float* cmf = pmax + 8 * 64;
    f32x4 v0[16], v1[16];
    tile_load(r, lane, v0); r.k0 += 64; tile_load(r, lane, v1); r.k0 -= 64;
    float m0 = 0.f, m1 = 0.f, m2 = 0.f, m3 = 0.f;
#pragma unroll
    for (int i = 0; i < 16; ++i) { const float g0 = r.gain ? r.gain[r.k0 + 4 * i + (lane >> 4)] : 1.f, g1 = r.gain ? r.gain[r.k0 + 64 + 4 * i + (lane >> 4)] : 1.f;
        v0[i] = v0[i] * g0; v1[i] = v1[i] * g1;
        m0 = fmaxf(m0, fmaxf(fabsf(v0[i][0]), fabsf(v1[i][0]))); m1 = fmaxf(m1, fmaxf(fabsf(v0[i][1]), fabsf(v1[i][1]))); m2 = fmaxf(m2, fmaxf(fabsf(v0[i][2]), fabsf(v1[i][2]))); m3 = fmaxf(m3, fmaxf(fabsf(v0[i][3]), fabsf(v1[i][3]))); }
    m0 = fmaxf(m0, __shfl_xor(m0, 16)); m1 = fmaxf(m1, __shfl_xor(m1, 16)); m2 = fmaxf(m2, __shfl_xor(m2, 16)); m3 = fmaxf(m3, __shfl_xor(m3, 16));
    m0 = fmaxf(m0, __shfl_xor(m0, 32)); m1 = fmaxf(m1, __shfl_xor(m1, 32)); m2 = fmaxf(m2, __shfl_xor(m2, 32)); m3 = fmaxf(m3, __shfl_xor(m3, 32));
    __syncthreads();
    if (lane < 16) *(LAS f32x4*)(pmax + wave * 64 + 4 * lane) = (f32x4){m0, m1, m2, m3};
    __syncthreads();
    if (tid < 64) { float m = pmax[tid];
#pragma unroll
        for (int w = 1; w < 8; ++w) m = fmaxf(m, pmax[w * 64 + tid]);
        cmf[tid] = m; cmaxbase[r.smax + r.n0 + tid] = m; }
    __syncthreads();
#pragma unroll
    for (int h = 0; h < 2; ++h) {
#pragma unroll
        for (int i = 0; i < 16; ++i) { LAS float* d = scr + (4 * i + (lane >> 4)) * 65 + 4 * (lane & 15); const f32x4 x = h ? v1[i] : v0[i]; d[0] = x[0]; d[1] = x[1]; d[2] = x[2]; d[3] = x[3]; }
        asm volatile("s_waitcnt lgkmcnt(0)" ::: "memory");
        const int kc = lane & 3;
#pragma unroll
        for (int jj = 0; jj < 4; ++jj) { const int n = (lane >> 2) + 16 * jj; const LAS float* s = scr + (16 * kc) * 65 + n;
            const float cm = cmf[n], inv = cm > 0.f ? 127.0f / cm : 0.f;
            v4u o; o.x = pk_i8x4(s[0 * 65] * inv, s[1 * 65] * inv, s[2 * 65] * inv, s[3 * 65] * inv); o.y = pk_i8x4(s[4 * 65] * inv, s[5 * 65] * inv, s[6 * 65] * inv, s[7 * 65] * inv);
            o.z = pk_i8x4(s[8 * 65] * inv, s[9 * 65] * inv, s[10 * 65] * inv, s[11 * 65] * inv); o.w = pk_i8x4(s[12 * 65] * inv, s[13 * 65] * inv, s[14 * 65] * inv, s[15 * 65] * inv);
            const int row = (r.map == 0) ? bt_row_std(r.colbase + r.n0 + n) : bt_row_swiglu(r.n0 + n, r.map - 1);
            *(GAS v4u*)((GAS unsigned char*)r.dst + (size_t)row * r.K + r.k0 + 64 * h + 16 * kc) = o; }
        asm volatile("s_waitcnt lgkmcnt(0)" ::: "memory");
    }
}
__device__ __forceinline__ void strip_f8(const LAS TJob* jobs, int& j, int st, LAS unsigned char* lds, int tid, int lane, int wave, float* cmaxbase) {
    while (st >= jobs[j + 1].startf) ++j;
    const LAS TJob* jb = jobs + j;
    const GAS float* src = (const GAS float*)jb->src; GAS unsigned char* dst = (GAS unsigned char*)jb->dst; const int K = jb->K, n0 = (st - jb->startf) * 16, smax = jb->smax, nq = K >> 2;
    const int c4 = tid & 3, q0 = tid >> 2;
    constexpr int RS8 = 3584 + 16;
    LAS float* pmax = (LAS float*)(lds + 8 * 17408 + 4096); LAS float* cmf = pmax + 8 * 16;
    f32x4 v[7][4];
#pragma unroll
    for (int i = 0; i < 7; ++i) { const int q = q0 + 128 * i; const GAS float* p = src + (size_t)(4 * q) * 1024 + n0 + 4 * c4;
#pragma unroll
        for (int kk = 0; kk < 4; ++kk) v[i][kk] = (q < nq) ? __builtin_nontemporal_load((const GAS f32x4*)(p + kk * 1024)) : (f32x4){0.f, 0.f, 0.f, 0.f}; }
    float m0 = 0.f, m1 = 0.f, m2 = 0.f, m3 = 0.f;
#pragma unroll
    for (int i = 0; i < 7; ++i)
#pragma unroll
        for (int kk = 0; kk < 4; ++kk) { m0 = fmaxf(m0, fabsf(v[i][kk][0])); m1 = fmaxf(m1, fabsf(v[i][kk][1])); m2 = fmaxf(m2, fabsf(v[i][kk][2])); m3 = fmaxf(m3, fabsf(v[i][kk][3])); }
#pragma unroll
    for (int o = 4; o < 64; o <<= 1) { m0 = fmaxf(m0, __shfl_xor(m0, o)); m1 = fmaxf(m1, __shfl_xor(m1, o)); m2 = fmaxf(m2, __shfl_xor(m2, o)); m3 = fmaxf(m3, __shfl_xor(m3, o)); }
    __syncthreads();
    if (lane < 4) *(LAS f32x4*)(pmax + wave * 16 + 4 * lane) = (f32x4){m0, m1, m2, m3};
    __syncthreads();
    if (tid < 16) { float m = pmax[tid];
#pragma unroll
        for (int w = 1; w < 8; ++w) m = fmaxf(m, pmax[w * 16 + tid]);
        cmf[tid] = m; cmaxbase[smax + n0 + tid] = m * (1.0f / (256.0f * H8_SCALE)); }
    __syncthreads();
    { const f32x4 cm = *(const LAS f32x4*)(cmf + 4 * c4); f32x4 inv;
#pragma unroll
      for (int jj = 0; jj < 4; ++jj) inv[jj] = cm[jj] > 0.f ? 256.0f / cm[jj] : 0.f;
#pragma unroll
      for (int i = 0; i < 7; ++i) { const int q = q0 + 128 * i;
          if (q < nq) {
#pragma unroll
              for (int jj = 0; jj < 4; ++jj) *(LAS unsigned*)(lds + (4 * c4 + jj) * RS8 + 4 * q) = pg8::pk_fp8x4(v[i][0][jj] * inv[jj], v[i][1][jj] * inv[jj], v[i][2][jj] * inv[jj], v[i][3][jj] * inv[jj]); } } }
    __syncthreads();
    { const int row = tid >> 5, t32 = tid & 31; GAS unsigned char* drow = dst + (size_t)bt_row_std(n0 + row) * K;
#pragma unroll
      for (int it = 0; it < 7; ++it) { const int ch = t32 + 32 * it; if (ch * 16 < K) *(GAS v4u*)(drow + ch * 16) = *(const LAS v4u*)(lds + row * RS8 + ch * 16); } }
}
__device__ __forceinline__ void phase_prologue(const Args& a, LAS unsigned char* lds, int tid, int lane, int wave) {
    unsigned char* ws = a.ws;
    LAS TJob* jobs = (LAS TJob*)(lds + 8 * 17408);
    build_jobs(a, jobs, tid);
    const int gw = blockIdx.x * NWAVES + wave, NGW = gridDim.x * NWAVES;
    { const int nstrip = jobs[NJOBS].startq; int js = 0;
      for (int st = blockIdx.x; st < nstrip; st += gridDim.x) strip_q8(jobs, js, st, lds, tid, lane, wave, (float*)(ws + WS_SW));
      __syncthreads(); }
    { const int nstrip = jobs[NJOBS].startf; int js = 0;
      const int first = (int)(((unsigned)blockIdx.x + gridDim.x - (unsigned)(jobs[NJOBS].startq % (int)gridDim.x)) % gridDim.x);
      for (int st = first; st < nstrip; st += gridDim.x) strip_f8(jobs, js, st, lds, tid, lane, wave, (float*)(ws + WS_SW));
      __syncthreads(); }
    {
        LAS float* scr = (LAS float*)(lds + wave * 17408);
        const int total = jobs[NJOBS].start; int j = 0;
        if (gw < total) {
            TileRef cur, nxt; f32x4 v[16], vn[16];
            tile_decode<false>(jobs, j, gw, cur); tile_load(cur, lane, v);
#pragma unroll 1
            for (int it = gw; it < total; it += NGW) {
                const bool more = it + NGW < total;
                if (more) { tile_decode<false>(jobs, j, it + NGW, nxt); tile_load(nxt, lane, vn); }
                tile_store(cur, lane, v, scr);
                if (more) { cur = nxt;
#pragma unroll
                    for (int i = 0; i < 16; ++i) v[i] = vn[i]; }
            }
        }
    }
#if I8_A
    for (int m = gw; m < T; m += NGW) row_to_i8(a.in[0] + (size_t)m * D, ws + WS_QX + (size_t)m * D, (float*)(ws + WS_SA) + m, lane);
#else
    for (int m = gw; m < T; m += NGW) row_to_bf16_ss(a.in[0] + (size_t)m * D, (bf16_t*)(ws + WS_XB) + (size_t)m * D, (float*)(ws + WS_SS) + (size_t)m * 16, nullptr, lane);
#endif
    for (int m = gw; m < NBATCH * MEML; m += NGW) row_to_bf16_ss(a.in[1] + (size_t)m * D, (bf16_t*)(ws + WS_MEMBF) + (size_t)m * D, (float*)(ws + WS_SSM) + (size_t)m * 16, nullptr, lane);
    {
        float* prm = (float*)(ws + WS_PARAM); const int gt = blockIdx.x * NTHR + tid, NGT = gridDim.x * NTHR;
        for (int i = gt; i < PB_END; i += NGT) { float v;
            if (i < PB_GQ) v = a.in[7][i]; else if (i < PB_GK) v = a.in[8][i - PB_GQ]; else if (i < PB_GOUT) v = a.in[9][i - PB_GK]; else if (i < PB_POOLS) v = a.in[14][i - PB_GOUT];
            else if (i < PB_MQN) v = a.in[16][i - PB_POOLS]; else if (i < PB_MKN) v = a.in[17][i - PB_MQN]; else if (i < PB_GFFN1) v = a.in[18][i - PB_MKN]; else if (i < PB_WR) v = a.in[4][D + i - PB_GFFN1];
            else if (i < PB_POOLW) v = a.in[27][i - PB_WR]; else v = a.in[15][i - PB_POOLW];
            prm[i] = v; }
        bf16_t* pwt = (bf16_t*)(ws + WS_POOLWT);
        for (int i = gt; i < 2 * 4 * 128 * 128; i += NGT) { const int lg = i >> 14, dout = (i >> 7) & 127, cc = i & 127; pwt[i] = (bf16_t)(pk_bf16(a.in[15][((size_t)lg * 128 + cc) * 128 + dout], 0.f) & 0xffffu); }
    }
    if (blockIdx.x == 0 && wave == 0) {
        float* sc = (float*)(ws + WS_SC);
        for (int l = 0; l < 2; ++l) {
            const float a1 = wave_sum(a.in[10][l * 64 + lane] * a.in[11][l * 64 + lane]), a2 = wave_sum(a.in[12][l * 64 + lane] * a.in[13][l * 64 + lane]);
            const float lam0 = (l == 0) ? 0.2f : (0.8f - 0.6f * 0.7408182206817179f);
            const float lam = __expf(a1) - __expf(a2) + lam0;
            float m0 = fabsf(a.in[8][l * 128 + lane] * a.in[9][l * 128 + lane]), m1 = fabsf(a.in[8][l * 128 + 64 + lane] * a.in[9][l * 128 + 64 + lane]);
            float mm = fmaxf(fabsf(a.in[17][l * 128 + lane] * a.in[18][l * 128 + lane]), fabsf(a.in[17][l * 128 + 64 + lane] * a.in[18][l * 128 + 64 + lane]));
#pragma unroll
            for (int o = 1; o < 64; o <<= 1) { m0 = fmaxf(m0, __shfl_xor(m0, o)); m1 = fmaxf(m1, __shfl_xor(m1, o)); mm = fmaxf(mm, __shfl_xor(mm, o)); }
            if (lane == 0) { sc[l * 8 + 0] = lam; sc[l * 8 + 1] = m0 * 64.f * QSCALE; sc[l * 8 + 2] = m1 * 64.f * QSCALE; sc[l * 8 + 3] = mm * 128.f * MEMSCALE; sc[l * 8 + 4] = 1.0f - lam0; }
        }
    }
}

__device__ __forceinline__ void unpack16(const bf16_t* src, float (&f)[16]) {
    const v4u a = *(const v4u*)src, b = *(const v4u*)(src + 8);
    f[0] = bf_lo(a.x); f[1] = bf_hi(a.x); f[2] = bf_lo(a.y); f[3] = bf_hi(a.y); f[4] = bf_lo(a.z); f[5] = bf_hi(a.z); f[6] = bf_lo(a.w); f[7] = bf_hi(a.w);
    f[8] = bf_lo(b.x); f[9] = bf_hi(b.x); f[10] = bf_lo(b.y); f[11] = bf_hi(b.y); f[12] = bf_lo(b.z); f[13] = bf_hi(b.z); f[14] = bf_lo(b.w); f[15] = bf_hi(b.w);
}
template <bool DIFF>
__device__ __forceinline__ void naive_attn_unit(LAS unsigned char* lds, int tid, const bf16_t* Qg, int ldq, const bf16_t* Kg, int ldk, const bf16_t* Vg, int ldv, bf16_t* Og, int ldo,
                                                int ntiles, int qpos0, const float* qmulA, const float* qmulB, const float* qss, float slope2, float bnd0, float bnd1, float lam, const float* gout, float outmul) {
    constexpr int QW = 4;
    LAS float* Lq = (LAS float*)lds; LAS float* Lk = Lq + 32 * 128; LAS float* Lv = Lk + 64 * 129; LAS float* Lp = Lv + 64 * 128; LAS float* Lrk = Lp + 8 * QW * 2 * 64;
    const int lane = tid & 63, wid = tid >> 6, r = tid >> 3, sg = tid & 7;
    __syncthreads();
    if (tid < 256) { float f[16]; unpack16(Qg + (size_t)r * ldq + sg * 16, f); float mul = 1.f;
      if (!DIFF) { const float s = qss[r * 8] + qss[r * 8 + 1]; mul = __builtin_amdgcn_rsqf(s * (1.f / 128.f) + 1e-6f) * MEMSCALE; }
#pragma unroll
      for (int i = 0; i < 16; ++i) Lq[r * 128 + sg * 16 + i] = DIFF ? f[i] : f[i] * mul * qmulA[sg * 16 + i] * qmulB[sg * 16 + i]; }
    float o0[QW][2], o1[QW][2], l0[QW], l1[QW];
#pragma unroll
    for (int q = 0; q < QW; ++q) { o0[q][0] = o0[q][1] = o1[q][0] = o1[q][1] = 0.f; l0[q] = l1[q] = 0.f; }
#pragma unroll 1
    for (int j = 0; j < ntiles; ++j) {
        __syncthreads();
        { float f[16]; unpack16(Kg + (size_t)(j * 64 + r) * ldk + sg * 16, f);
#pragma unroll
          for (int i = 0; i < 16; ++i) Lk[r * 129 + sg * 16 + i] = f[i];
          unpack16(Vg + (size_t)(j * 64 + r) * ldv + sg * 16, f);
#pragma unroll
          for (int i = 0; i < 16; ++i) Lv[r * 128 + sg * 16 + i] = f[i]; }
        __syncthreads();
        if (!DIFF) { if (tid < 64) { float s = 0.f;
#pragma unroll 4
            for (int d = 0; d < 128; ++d) { const float x = Lk[tid * 129 + d]; s += x * x; } Lrk[tid] = __builtin_amdgcn_rsqf(s * (1.f / 128.f) + 1e-6f); } __syncthreads(); }
        float s0[QW], s1[QW];
#pragma unroll
        for (int q = 0; q < QW; ++q) { s0[q] = 0.f; s1[q] = 0.f; }
#pragma unroll 1
        for (int d4 = 0; d4 < 16; ++d4) {
            const float k0 = Lk[lane * 129 + 4 * d4], k1 = Lk[lane * 129 + 4 * d4 + 1], k2 = Lk[lane * 129 + 4 * d4 + 2], k3 = Lk[lane * 129 + 4 * d4 + 3];
            const float e0 = Lk[lane * 129 + 64 + 4 * d4], e1 = Lk[lane * 129 + 64 + 4 * d4 + 1], e2 = Lk[lane * 129 + 64 + 4 * d4 + 2], e3 = Lk[lane * 129 + 64 + 4 * d4 + 3];
#pragma unroll
            for (int q = 0; q < QW; ++q) { const f32x4 qa = *(const LAS f32x4*)&Lq[(wid * QW + q) * 128 + 4 * d4], qb = *(const LAS f32x4*)&Lq[(wid * QW + q) * 128 + 64 + 4 * d4];
                s0[q] += (qa[0] * k0 + qa[1] * k1) + (qa[2] * k2 + qa[3] * k3); s1[q] += (qb[0] * e0 + qb[1] * e1) + (qb[2] * e2 + qb[3] * e3); }
        }
        const int kpos = j * 64 + lane;
#pragma unroll
        for (int q = 0; q < QW; ++q) { float p0, p1;
            if (DIFF) { const int qpos = qpos0 + wid * QW + q; const float bias = -slope2 * fabsf((float)(qpos - kpos)); p0 = __builtin_amdgcn_exp2f(s0[q] + bias - bnd0); p1 = __builtin_amdgcn_exp2f(s1[q] + bias - bnd1); }
            else { p0 = __builtin_amdgcn_exp2f((s0[q] + s1[q]) * Lrk[lane] - bnd0); p1 = 0.f; }
            l0[q] += p0; l1[q] += p1; Lp[((wid * QW + q) * 2 + 0) * 64 + lane] = p0; Lp[((wid * QW + q) * 2 + 1) * 64 + lane] = p1; }
        asm volatile("s_waitcnt lgkmcnt(0)" ::: "memory");
#pragma unroll 1
        for (int k4 = 0; k4 < 16; ++k4) {
            f32x2 v[4];
#pragma unroll
            for (int i = 0; i < 4; ++i) v[i] = *(const LAS f32x2*)&Lv[(4 * k4 + i) * 128 + 2 * lane];
#pragma unroll
            for (int q = 0; q < QW; ++q) { const f32x4 pa = *(const LAS f32x4*)&Lp[((wid * QW + q) * 2 + 0) * 64 + 4 * k4];
                o0[q][0] += (pa[0] * v[0][0] + pa[1] * v[1][0]) + (pa[2] * v[2][0] + pa[3] * v[3][0]); o0[q][1] += (pa[0] * v[0][1] + pa[1] * v[1][1]) + (pa[2] * v[2][1] + pa[3] * v[3][1]);
                if (DIFF) { const f32x4 pb = *(const LAS f32x4*)&Lp[((wid * QW + q) * 2 + 1) * 64 + 4 * k4];
                    o1[q][0] += (pb[0] * v[0][0] + pb[1] * v[1][0]) + (pb[2] * v[2][0] + pb[3] * v[3][0]); o1[q][1] += (pb[0] * v[0][1] + pb[1] * v[1][1]) + (pb[2] * v[2][1] + pb[3] * v[3][1]); } }
        }
    }
#pragma unroll
    for (int q = 0; q < QW; ++q) { const float L0 = wave_sum(l0[q]); float x = o0[q][0] / L0, y = o0[q][1] / L0;
        if (DIFF) { const float L1 = wave_sum(l1[q]); x -= lam * (o1[q][0] / L1); y -= lam * (o1[q][1] / L1);
            const float ss = wave_sum(x * x + y * y); const float rr = __builtin_amdgcn_rsqf(ss * (1.f / 128.f) + 1e-6f) * outmul; x *= rr * gout[2 * lane]; y *= rr * gout[2 * lane + 1]; }
        *(unsigned*)(Og + (size_t)(wid * QW + q) * ldo + 2 * lane) = pk_bf16(x, y); }
}
__device__ __forceinline__ void naive_pool_unit(LAS unsigned char* lds, int tid, const bf16_t* Pg  , bf16_t* Og  , const float* W  , const float* scale  , int tok0, int g) {
    LAS float* Lp = (LAS float*)lds; LAS float* Ld = Lp + 80 * 128;
    const int w = 2 << g, pos0 = tok0 & (SEQ - 1);
    __syncthreads();
    for (int i = tid; i < 80 * 8; i += NTHR) { const int rr = i >> 3, sg = i & 7; const int tpos = pos0 - 16 + rr;
        float f[16];
        if (tpos >= 0) unpack16(Pg + (size_t)(tok0 - 16 + rr) * 512 + g * 128 + sg * 16, f); else {
#pragma unroll
            for (int k = 0; k < 16; ++k) f[k] = 0.f; }
#pragma unroll
        for (int k = 0; k < 16; ++k) Lp[rr * 128 + sg * 16 + k] = f[k]; }
    __syncthreads();
    for (int i = tid; i < 64 * 128; i += NTHR) { const int t = i >> 7, c = i & 127; const int tpos = pos0 + t; const int lo = (tpos + 1 - w) > 0 ? (tpos + 1 - w) : 0; const int cnt = tpos + 1 - lo;
        float s = 0.f;
#pragma unroll 1
        for (int k = 0; k < cnt; ++k) s += Lp[(16 + t - k) * 128 + c];
        Ld[t * 128 + c] = s / (float)cnt - Lp[(16 + t) * 128 + c]; }
    __syncthreads();
    const int dout = tid & 127, tq = tid >> 7; float acc[16];
#pragma unroll
    for (int i = 0; i < 16; ++i) acc[i] = 0.f;
#pragma unroll 2
    for (int c = 0; c < 128; ++c) { const float wv = W[c * 128 + dout];
#pragma unroll
        for (int i = 0; i < 16; ++i) acc[i] += Ld[(tq * 16 + i) * 128 + c] * wv; }
    const float sc = scale[dout];
#pragma unroll
    for (int i = 0; i < 16; ++i) Og[(size_t)(tok0 + tq * 16 + i) * 512 + g * 128 + dout] = (bf16_t)(pk_bf16(acc[i] * sc, 0.f) & 0xffffu);
}

namespace mix {
typedef short bf16x8 __attribute__((ext_vector_type(8)));
typedef short s16x4 __attribute__((ext_vector_type(4)));
typedef float f32x16 __attribute__((ext_vector_type(16)));
typedef const LAS unsigned char* lptr;
#define SBAR() __builtin_amdgcn_sched_barrier(0)
__device__ __forceinline__ unsigned lds_addr(lptr p) { return (unsigned)(uintptr_t)p; }
__device__ __forceinline__ bf16x8 pack8(const f32x16& p, int b) {
    v4u w; w.x = pk_bf16(p[b], p[b + 1]); w.y = pk_bf16(p[b + 2], p[b + 3]); w.z = pk_bf16(p[b + 4], p[b + 5]); w.w = pk_bf16(p[b + 6], p[b + 7]);
    return __builtin_bit_cast(bf16x8, w);
}
__device__ __forceinline__ void glds16(const void* g, LAS unsigned char* l) { __builtin_amdgcn_global_load_lds((const unsigned*)g, (LAS unsigned*)l, 16, 0, 0); }
#define MFMA32(a, b, c) __builtin_amdgcn_mfma_f32_32x32x16_bf16(a, b, c, 0, 0, 0)

#define VRD(set, db) do { _Pragma("unroll") for (int t_ = 0; t_ < 4; ++t_) { \
        asm volatile("ds_read_b64_tr_b16 %0, %1 offset:%c2" : "=&v"(lo[set][t_]) : "v"(va[db]), "i"(t_ * 4096) : "memory"); \
        asm volatile("ds_read_b64_tr_b16 %0, %1 offset:%c2" : "=&v"(hi[set][t_]) : "v"(va[db]), "i"(t_ * 4096 + 2048) : "memory"); } } while (0)
#define VPK(set, t) (bf16x8){lo[set][t][0], lo[set][t][1], lo[set][t][2], lo[set][t][3], hi[set][t][0], hi[set][t][1], hi[set][t][2], hi[set][t][3]}
__device__ __forceinline__ void pv_tile(f32x16 (&O)[4], const unsigned (&va)[4], const bf16x8 (&pb)[4]) {
    s16x4 lo[2][4], hi[2][4];
    VRD(0, 0);
    VRD(1, 1); asm volatile("s_waitcnt lgkmcnt(8)" ::: "memory"); SBAR();
#pragma unroll
    for (int t = 0; t < 4; ++t) O[0] = MFMA32(VPK(0, t), pb[t], O[0]);
    SBAR(); VRD(0, 2); asm volatile("s_waitcnt lgkmcnt(8)" ::: "memory"); SBAR();
#pragma unroll
    for (int t = 0; t < 4; ++t) O[1] = MFMA32(VPK(1, t), pb[t], O[1]);
    SBAR(); VRD(1, 3); asm volatile("s_waitcnt lgkmcnt(8)" ::: "memory"); SBAR();
#pragma unroll
    for (int t = 0; t < 4; ++t) O[2] = MFMA32(VPK(0, t), pb[t], O[2]);
    SBAR(); asm volatile("s_waitcnt lgkmcnt(0)" ::: "memory"); SBAR();
#pragma unroll
    for (int t = 0; t < 4; ++t) O[3] = MFMA32(VPK(1, t), pb[t], O[3]);
}
__device__ __forceinline__ void kread8_swz(bf16x8 (&kf)[8], const unsigned (&ka)[4]) {
#define KRD(i, a, off) asm volatile("ds_read_b128 %0, %1 offset:%c2" : "=&v"(kf[i]) : "v"(a), "i"(off) : "memory")
    KRD(0, ka[0], 0); KRD(1, ka[0], 8192); KRD(2, ka[1], 0); KRD(3, ka[1], 8192); KRD(4, ka[2], 0); KRD(5, ka[2], 8192); KRD(6, ka[3], 0); KRD(7, ka[3], 8192);
#undef KRD
}
__device__ __forceinline__ void kread8(bf16x8 (&kf)[8], unsigned ka) {
#define KRD(i, off) asm volatile("ds_read_b128 %0, %1 offset:%c2" : "=&v"(kf[i]) : "v"(ka), "i"(off) : "memory")
    KRD(0, 0); KRD(1, 512); KRD(2, 2048); KRD(3, 2560); KRD(4, 4096); KRD(5, 4608); KRD(6, 6144); KRD(7, 6656);
#undef KRD
}

__device__ __forceinline__ void da_bias(f32x16& p0, f32x16& p1, int jt, int cq, float xq, float sl2, float B2) {
    const float x = (float)(64 * jt) - xq;
    const float Be = (jt > cq) ? 1.0e30f : B2;
#pragma unroll
    for (int r = 0; r < 16; ++r) { const float kr = (float)((r & 3) + 8 * (r >> 2)); p0[r] = __builtin_fmaf(-sl2, __builtin_fabsf(x + kr), -Be); p1[r] = __builtin_fmaf(-sl2, __builtin_fabsf(x + (32.f + kr)), -Be); }
}
__device__ __forceinline__ void diffattn_unit(LAS unsigned char* lds, int tid, const bf16_t* Qg, const bf16_t* Kg, const bf16_t* Vg, bf16_t* Og, int b, int h, int u, bool desc, float sl2, float B2, float lam, const float* gout, float outmul) {
    asm volatile("" : "+v"(tid));
    const int lane = tid & 63, wid = __builtin_amdgcn_readfirstlane(tid >> 6), map = wid >> 2, wi = wid & 3, r32 = lane & 31, hi = lane >> 5;
    const int q0 = u * 128 + wi * 32, cq = q0 >> 6, NT = 2 * u + 2;
    const size_t rowb = (size_t)b * SEQ;
    const bf16_t* qrow = Qg + (rowb + q0 + r32) * 1024 + h * 128;
    bf16x8 qf[4];
#pragma unroll
    for (int s = 0; s < 4; ++s) qf[s] = *(const bf16x8*)(qrow + map * 64 + s * 16 + hi * 8);
    unsigned koff0, voff0;
    { const int row = 8 * wid + (lane >> 4), slot = lane & 15;
      koff0 = (unsigned)(row * 1024 + ((slot ^ (row & 15)) * 8));
      voff0 = (unsigned)(row * 1024 + (((slot >> 2) ^ (row & 3)) * 32 + (slot & 3) * 8)); }
    const bf16_t* Kbh = Kg + rowb * 1024 + h * 128; const bf16_t* Vbh = Vg + rowb * 1024 + h * 128;
#define JT(i) (desc ? NT - 1 - (i) : (i))
#define DA_DMA(i) do { const int j_ = JT(i), sl_ = (i) & 3; _Pragma("unroll") for (int i_ = 0; i_ < 2; ++i_) { \
        glds16(Kbh + (size_t)j_ * 65536 + (i_ ? (koff0 ^ 32u) + 4096u : koff0), lds + sl_ * 32768 + (2 * wid + i_) * 1024); \
        glds16(Vbh + (size_t)j_ * 65536 + (i_ ? voff0 + 4096u : voff0), lds + sl_ * 32768 + 16384 + (2 * wid + i_) * 1024); } } while (0)
    f32x16 O[4];
#pragma unroll
    for (int db = 0; db < 4; ++db)
#pragma unroll
        for (int r = 0; r < 16; ++r) O[db][r] = 0.f;
    float lsum = 0.f;
    const float xq = (float)(q0 + r32 - 4 * hi);
    unsigned ka_0, va_0;
    { const unsigned l0 = lds_addr((lptr)lds); const int qp = (lane & 15) >> 2;
      ka_0 = l0 + r32 * 256 + (((map * 8 + hi) ^ (r32 & 15)) << 4);
      va_0 = l0 + 16384 + (4 * hi + qp) * 256 + (qp << 6) + ((lane >> 4) & 1) * 32 + (lane & 3) * 8; }
    __syncthreads();
    asm volatile("" : "+v"(qf[0]), "+v"(qf[1]), "+v"(qf[2]), "+v"(qf[3]));
    DA_DMA(0); DA_DMA(1);
    if (NT > 2) { DA_DMA(2); asm volatile("s_waitcnt vmcnt(4)" ::: "memory"); } else asm volatile("s_waitcnt vmcnt(0)" ::: "memory");
    __builtin_amdgcn_s_barrier();
    f32x16 pA0, pA1, pB0, pB1;
    { da_bias(pA0, pA1, JT(0), cq, xq, sl2, B2);
      unsigned ka[4];
#pragma unroll
      for (int s = 0; s < 4; ++s) ka[s] = ka_0 ^ (s << 5);
      bf16x8 kf[8]; kread8_swz(kf, ka); asm volatile("s_waitcnt lgkmcnt(0)" ::: "memory"); SBAR();
#pragma unroll
      for (int s = 0; s < 4; ++s) { pA0 = MFMA32(kf[2 * s], qf[s], pA0); pA1 = MFMA32(kf[2 * s + 1], qf[s], pA1); }
      asm volatile("s_nop 15\n\ts_nop 15" : "+v"(pA0), "+v"(pA1)); }
    da_bias(pB0, pB1, JT(1), cq, xq, sl2, B2);
#define SM4(P, b_) do { P[b_] = __builtin_amdgcn_exp2f(P[b_]); P[b_ + 1] = __builtin_amdgcn_exp2f(P[b_ + 1]); P[b_ + 2] = __builtin_amdgcn_exp2f(P[b_ + 2]); P[b_ + 3] = __builtin_amdgcn_exp2f(P[b_ + 3]); \
        lsum += (P[b_] + P[b_ + 1]) + (P[b_ + 2] + P[b_ + 3]); } while (0)
#define MFMA_A(acc, a_, b_) asm volatile("v_mfma_f32_32x32x16_bf16 %0, %1, %2, %0" : "+v"(acc) : "v"(a_), "v"(b_))
#define PIN(x_) asm volatile("" : "+v"(x_))
#define FMK(dst, krv) do { float f_; asm volatile("v_fmamk_f32 %0, %1, %c2, %3" : "=v"(f_) : "v"(sl2), "i"(__builtin_bit_cast(int, (float)(krv))), "v"(c0_)); dst = f_; } while (0)
#define FM2(C0, C1, j) do { FMK(C0[j], ((j) & 3) + 8 * ((j) >> 2)); FMK(C1[j], 32 + ((j) & 3) + 8 * ((j) >> 2)); } while (0)
#define DA_STEP(C0, C1, N0, N1, i) do { \
        if ((i) + 3 < NT) DA_DMA((i) + 3); \
        bf16x8 pb[4]; \
        { unsigned ka[4]; _Pragma("unroll") for (int s_ = 0; s_ < 4; ++s_) ka[s_] = (ka_0 + (((i) + 1) & 3) * 32768) ^ (s_ << 5); \
          bf16x8 kf[8]; kread8_swz(kf, ka); asm volatile("s_waitcnt lgkmcnt(0)" ::: "memory"); \
          MFMA_A(N0, kf[0], qf[0]); SM4(C0, 0);  PIN(C0); PIN(lsum); \
          MFMA_A(N1, kf[1], qf[0]); SM4(C0, 4);  PIN(C0); PIN(lsum); \
          MFMA_A(N0, kf[2], qf[1]); SM4(C0, 8);  PIN(C0); PIN(lsum); pb[0] = pack8(C0, 0); PIN(pb[0]); \
          MFMA_A(N1, kf[3], qf[1]); SM4(C0, 12); PIN(C0); PIN(lsum); pb[1] = pack8(C0, 8); PIN(pb[1]); \
          MFMA_A(N0, kf[4], qf[2]); SM4(C1, 0);  PIN(C1); PIN(lsum); \
          MFMA_A(N1, kf[5], qf[2]); SM4(C1, 4);  PIN(C1); PIN(lsum); \
          MFMA_A(N0, kf[6], qf[3]); SM4(C1, 8);  PIN(C1); PIN(lsum); pb[2] = pack8(C1, 0); PIN(pb[2]); \
          MFMA_A(N1, kf[7], qf[3]); SM4(C1, 12); PIN(C1); PIN(lsum); pb[3] = pack8(C1, 8); PIN(pb[3]); } \
        { unsigned va[4]; _Pragma("unroll") for (int d_ = 0; d_ < 4; ++d_) va[d_] = (va_0 + ((i) & 3) * 32768) ^ (d_ << 6); \
          s16x4 lo[2][4], hi[2][4]; \
          const int jt2_ = JT((i) + 2); \
          float c0_ = __builtin_fmaf(sl2s, (float)(64 * jt2_) - xq, (jt2_ > cq) ? -1.0e30f : -B2); PIN(c0_); \
          VRD(0, 0); VRD(1, 1); asm volatile("s_waitcnt lgkmcnt(8)" ::: "memory"); \
          _Pragma("unroll") for (int t_ = 0; t_ < 4; ++t_) { const bf16x8 vf_ = VPK(0, t_); MFMA_A(O[0], vf_, pb[t_]); FM2(C0, C1, t_); } \
          VRD(0, 2); asm volatile("s_waitcnt lgkmcnt(8)" ::: "memory"); \
          _Pragma("unroll") for (int t_ = 0; t_ < 4; ++t_) { const bf16x8 vf_ = VPK(1, t_); MFMA_A(O[1], vf_, pb[t_]); FM2(C0, C1, 4 + t_); } \
          VRD(1, 3); asm volatile("s_waitcnt lgkmcnt(8)" ::: "memory"); \
          _Pragma("unroll") for (int t_ = 0; t_ < 4; ++t_) { const bf16x8 vf_ = VPK(0, t_); MFMA_A(O[2], vf_, pb[t_]); FM2(C0, C1, 8 + t_); } \
          asm volatile("s_waitcnt lgkmcnt(0)" ::: "memory"); \
          _Pragma("unroll") for (int t_ = 0; t_ < 4; ++t_) { const bf16x8 vf_ = VPK(1, t_); MFMA_A(O[3], vf_, pb[t_]); FM2(C0, C1, 12 + t_); } \
          PIN(C0); PIN(C1); \
          if (jt2_ == cq) { da_bias(C0, C1, jt2_, cq, xq, sl2, B2); PIN(C0); PIN(C1); } } \
        if ((i) + 3 < NT) asm volatile("s_waitcnt vmcnt(4) lgkmcnt(0)" ::: "memory"); else asm volatile("s_waitcnt vmcnt(0) lgkmcnt(0)" ::: "memory"); \
        __builtin_amdgcn_s_barrier(); \
    } while (0)
    const float sl2s = __builtin_bit_cast(float, __builtin_amdgcn_readfirstlane(__builtin_bit_cast(int, sl2)));
#pragma unroll 1
    for (int i = 0; i < NT; i += 2) {
        DA_STEP(pA0, pA1, pB0, pB1, i);
        DA_STEP(pB0, pB1, pA0, pA1, i + 1);
    }
#undef DA_STEP
#undef FM2
#undef FMK
#undef MFMA_A
#undef PIN
#undef SM4
    asm volatile("s_nop 15\n\ts_nop 15" : "+v"(O[0]), "+v"(O[1]), "+v"(O[2]), "+v"(O[3]));
#undef DA_DMA
#undef JT
    lsum += __shfl_xor(lsum, 32);
    const float inv = 1.0f / lsum;
    LAS f32x4* xch = (LAS f32x4*)(lds + wi * 16384) + lane;
    if (map == 1) {
        const float f = lam * inv;
#pragma unroll
        for (int db = 0; db < 4; ++db)
#pragma unroll
            for (int g = 0; g < 4; ++g) xch[(db * 4 + g) * 64] = (f32x4){O[db][4 * g] * f, O[db][4 * g + 1] * f, O[db][4 * g + 2] * f, O[db][4 * g + 3] * f};
    }
    __syncthreads();
    if (map == 0) {
        float ss = 0.f;
#pragma unroll
        for (int db = 0; db < 4; ++db)
#pragma unroll
            for (int g = 0; g < 4; ++g) { const f32x4 o1 = xch[(db * 4 + g) * 64];
#pragma unroll
                for (int i = 0; i < 4; ++i) { const float v = O[db][4 * g + i] * inv - o1[i]; O[db][4 * g + i] = v; ss += v * v; } }
        ss += __shfl_xor(ss, 32);
        const float rr = __builtin_amdgcn_rsqf(ss * (1.f / 128.f) + 1e-6f) * outmul;
        bf16_t* orow = Og + (rowb + q0 + r32) * 1024 + h * 128 + 4 * hi;
#pragma unroll
        for (int db = 0; db < 4; ++db)
#pragma unroll
            for (int g = 0; g < 4; ++g) { const f32x4 gv = *(const f32x4*)(gout + 32 * db + 8 * g + 4 * hi);
                const unsigned w0 = pk_bf16(O[db][4 * g] * rr * gv[0], O[db][4 * g + 1] * rr * gv[1]), w1 = pk_bf16(O[db][4 * g + 2] * rr * gv[2], O[db][4 * g + 3] * rr * gv[3]);
                *(unsigned long long*)(orow + 32 * db + 8 * g) = (unsigned long long)w0 | ((unsigned long long)w1 << 32); }
    }
    __syncthreads();
}

__device__ __forceinline__ void memattn_unit(LAS unsigned char* lds, int tid, bf16_t* MQg, bf16_t* Og, const bf16_t* KVg, const float* mqss, const float* qn, const float* kn, int pm, int hd, float Bm) {
    const int lane = tid & 63, wid = __builtin_amdgcn_readfirstlane(tid >> 6), r32 = lane & 31, hi = lane >> 5;
    const int b = pm >> 3; const size_t row = (size_t)pm * 256 + wid * 32 + r32;
    __syncthreads();
#pragma unroll
    for (int i = 0; i < 8; ++i) { const int p = 8 * wid + i, vrow = 4 * p + (lane >> 4), slot = lane & 15;
        glds16(KVg + ((size_t)b * MEML + vrow) * 2048 + 512 + hd * 128 + (((slot >> 2) ^ (vrow & 3)) * 32 + (slot & 3) * 8), lds + 65536 + p * 1024); }
    { const int key = tid >> 1, half = tid & 1; const bf16_t* src = KVg + ((size_t)b * MEML + key) * 2048 + hd * 128 + half * 64;
      v4u raw[8]; float s = 0.f;
#pragma unroll
      for (int c = 0; c < 8; ++c) { raw[c] = *(const v4u*)(src + c * 8);
          const float a0 = bf_lo(raw[c].x), a1 = bf_hi(raw[c].x), a2 = bf_lo(raw[c].y), a3 = bf_hi(raw[c].y), a4 = bf_lo(raw[c].z), a5 = bf_hi(raw[c].z), a6 = bf_lo(raw[c].w), a7 = bf_hi(raw[c].w);
          s += ((a0 * a0 + a1 * a1) + (a2 * a2 + a3 * a3)) + ((a4 * a4 + a5 * a5) + (a6 * a6 + a7 * a7)); }
      s += __shfl_xor(s, 1);
      const float rk = __builtin_amdgcn_rsqf(s * (1.f / 128.f) + 1e-6f) * MEMSCALE;
#pragma unroll
      for (int c = 0; c < 8; ++c) { const int d0 = half * 64 + c * 8; const f32x4 qa = *(const f32x4*)(qn + d0), qb = *(const f32x4*)(qn + d0 + 4), ka = *(const f32x4*)(kn + d0), kb = *(const f32x4*)(kn + d0 + 4);
          v4u w; w.x = pk_bf16(bf_lo(raw[c].x) * rk * qa[0] * ka[0], bf_hi(raw[c].x) * rk * qa[1] * ka[1]); w.y = pk_bf16(bf_lo(raw[c].y) * rk * qa[2] * ka[2], bf_hi(raw[c].y) * rk * qa[3] * ka[3]);
          w.z = pk_bf16(bf_lo(raw[c].z) * rk * qb[0] * kb[0], bf_hi(raw[c].z) * rk * qb[1] * kb[1]); w.w = pk_bf16(bf_lo(raw[c].w) * rk * qb[2] * kb[2], bf_hi(raw[c].w) * rk * qb[3] * kb[3]);
          *(LAS v4u*)(lds + (key >> 6) * 16384 + (half * 8 + c) * 1024 + (key & 63) * 16) = w; } }
    const bf16_t* qrow = MQg + row * 512 + hd * 128;
    bf16x8 qf[8];
#pragma unroll
    for (int s = 0; s < 8; ++s) qf[s] = *(const bf16x8*)(qrow + s * 16 + hi * 8);
    const float rq = __builtin_amdgcn_rsqf((mqss[row * 8 + hd * 2] + mqss[row * 8 + hd * 2 + 1]) * (1.f / 128.f) + 1e-6f);
    f32x16 O[4];
#pragma unroll
    for (int db = 0; db < 4; ++db)
#pragma unroll
        for (int r = 0; r < 16; ++r) O[db][r] = 0.f;
    float lsum = 0.f;
    const lptr kl0 = (lptr)lds + hi * 1024 + r32 * 16;
    unsigned va0[4];
    { const int qp = (lane & 15) >> 2;
#pragma unroll
      for (int db = 0; db < 4; ++db) va0[db] = lds_addr((lptr)lds) + 65536 + (4 * hi + qp) * 256 + ((db ^ qp) * 64) + ((lane >> 4) & 1) * 32 + (lane & 3) * 8; }
    __syncthreads();
#pragma unroll 1
    for (int tl = 0; tl < 4; ++tl) {
        f32x16 p0, p1;
#pragma unroll
        for (int r = 0; r < 16; ++r) { p0[r] = 0.f; p1[r] = 0.f; }
        bf16x8 kf[8], kg[8]; kread8(kf, lds_addr(kl0) + tl * 16384); kread8(kg, lds_addr(kl0) + tl * 16384 + 8192);
        asm volatile("s_waitcnt lgkmcnt(8)" ::: "memory"); SBAR();
#pragma unroll
        for (int s = 0; s < 4; ++s) { p0 = MFMA32(kf[2 * s], qf[s], p0); p1 = MFMA32(kf[2 * s + 1], qf[s], p1); }
        SBAR(); asm volatile("s_waitcnt lgkmcnt(0)" ::: "memory"); SBAR();
#pragma unroll
        for (int s = 0; s < 4; ++s) { p0 = MFMA32(kg[2 * s], qf[4 + s], p0); p1 = MFMA32(kg[2 * s + 1], qf[4 + s], p1); }
#pragma unroll
        for (int r = 0; r < 16; ++r) { p0[r] = __builtin_amdgcn_exp2f(__builtin_fmaf(p0[r], rq, -Bm)); p1[r] = __builtin_amdgcn_exp2f(__builtin_fmaf(p1[r], rq, -Bm)); lsum += p0[r] + p1[r]; }
        bf16x8 pb[4]; pb[0] = pack8(p0, 0); pb[1] = pack8(p0, 8); pb[2] = pack8(p1, 0); pb[3] = pack8(p1, 8);
        unsigned va[4];
#pragma unroll
        for (int db = 0; db < 4; ++db) va[db] = va0[db] + tl * 16384;
        pv_tile(O, va, pb);
    }
    lsum += __shfl_xor(lsum, 32);
    const float inv = 1.0f / lsum;
    bf16_t* orow = Og + row * 512 + hd * 128 + 4 * hi;
#pragma unroll
    for (int db = 0; db < 4; ++db)
#pragma unroll
        for (int g = 0; g < 4; ++g) { const unsigned w0 = pk_bf16(O[db][4 * g] * inv, O[db][4 * g + 1] * inv), w1 = pk_bf16(O[db][4 * g + 2] * inv, O[db][4 * g + 3] * inv);
            *(unsigned long long*)(orow + 32 * db + 8 * g) = (unsigned long long)w0 | ((unsigned long long)w1 << 32); }
}

__device__ __forceinline__ void pool_unit(LAS unsigned char* lds, int tid, const bf16_t* Pg, bf16_t* Og, const bf16_t* Wt, const float* scale, int tok0, int g) {
    const int lane = tid & 63, wid = __builtin_amdgcn_readfirstlane(tid >> 6), r32 = lane & 31, hi = lane >> 5;
    LAS unsigned char* Lp = lds; LAS unsigned char* Ld = lds + 272 * 256;
    const int w = 2 << g, pos0 = tok0 & (SEQ - 1);
    __syncthreads();
    { v4u st[9];
#pragma unroll
      for (int k = 0; k < 9; ++k) { const int i = tid + k * NTHR, ii = i < 272 * 16 ? i : tid, rr = ii >> 4, ch = ii & 15; const bool ok = pos0 - 16 + rr >= 0;
          const v4u v = *(const v4u*)(Pg + (size_t)(tok0 - 16 + (ok ? rr : 16)) * 512 + g * 128 + ch * 8); st[k].x = ok ? v.x : 0u; st[k].y = ok ? v.y : 0u; st[k].z = ok ? v.z : 0u; st[k].w = ok ? v.w : 0u; }
#pragma unroll
      for (int k = 0; k < 9; ++k) { const int i = tid + k * NTHR, rr = i >> 4, ch = i & 15; if (i < 272 * 16) *(LAS v4u*)(Lp + rr * 256 + ch * 16) = st[k]; } }
    bf16x8 wf[4][8];
#pragma unroll
    for (int db = 0; db < 4; ++db)
#pragma unroll
        for (int s = 0; s < 8; ++s) wf[db][s] = *(const bf16x8*)(Wt + (size_t)(32 * db + r32) * 128 + hi * 8 + s * 16);
    __syncthreads();
    { const int ch = tid & 15, t0 = (tid >> 4) * 8;
      float s[8];
#pragma unroll
      for (int i = 0; i < 8; ++i) s[i] = 0.f;
#pragma unroll 1
      for (int k = 1; k < w; ++k) { const v4u v = *(const LAS v4u*)(Lp + (16 + t0 - k) * 256 + ch * 16);
          s[0] += bf_lo(v.x); s[1] += bf_hi(v.x); s[2] += bf_lo(v.y); s[3] += bf_hi(v.y); s[4] += bf_lo(v.z); s[5] += bf_hi(v.z); s[6] += bf_lo(v.w); s[7] += bf_hi(v.w); }
#pragma unroll
      for (int tt = 0; tt < 8; ++tt) { const int t = t0 + tt, tpos = pos0 + t; const int cnt = (tpos + 1 < w) ? (tpos + 1) : w; const float ic = 1.0f / (float)cnt;
          const v4u v = *(const LAS v4u*)(Lp + (16 + t) * 256 + ch * 16), o = *(const LAS v4u*)(Lp + (16 + t - w + 1) * 256 + ch * 16);
          float p[8] = {bf_lo(v.x), bf_hi(v.x), bf_lo(v.y), bf_hi(v.y), bf_lo(v.z), bf_hi(v.z), bf_lo(v.w), bf_hi(v.w)};
          float q[8] = {bf_lo(o.x), bf_hi(o.x), bf_lo(o.y), bf_hi(o.y), bf_lo(o.z), bf_hi(o.z), bf_lo(o.w), bf_hi(o.w)};
          float d[8];
#pragma unroll
          for (int i = 0; i < 8; ++i) { s[i] += p[i]; d[i] = s[i] * ic - p[i]; s[i] -= q[i]; }
          v4u wv; wv.x = pk_bf16(d[0], d[1]); wv.y = pk_bf16(d[2], d[3]); wv.z = pk_bf16(d[4], d[5]); wv.w = pk_bf16(d[6], d[7]);
          *(LAS v4u*)(Ld + t * 256 + ((ch ^ (t & 15)) << 4)) = wv; } }
    __syncthreads();
    const int tok = wid * 32 + r32;
    bf16x8 df[8];
#pragma unroll
    for (int s = 0; s < 8; ++s) df[s] = *(const LAS bf16x8*)(Ld + tok * 256 + (((2 * s + hi) ^ (tok & 15)) << 4));
    bf16_t* orow = Og + (size_t)(tok0 + tok) * 512 + g * 128 + 4 * hi;
#pragma unroll
    for (int db = 0; db < 4; ++db) {
        f32x16 acc;
#pragma unroll
        for (int r = 0; r < 16; ++r) acc[r] = 0.f;
#pragma unroll
        for (int s = 0; s < 8; ++s) acc = MFMA32(wf[db][s], df[s], acc);
#pragma unroll
        for (int gq = 0; gq < 4; ++gq) { const f32x4 sc = *(const f32x4*)(scale + 32 * db + 8 * gq + 4 * hi);
            const unsigned w0 = pk_bf16(acc[4 * gq] * sc[0], acc[4 * gq + 1] * sc[1]), w1 = pk_bf16(acc[4 * gq + 2] * sc[2], acc[4 * gq + 3] * sc[3]);
            *(unsigned long long*)(orow + 32 * db + 8 * gq) = (unsigned long long)w0 | ((unsigned long long)w1 << 32); }
    }
}
#undef MFMA32
#undef VRD
#undef VPK
#undef SBAR
}

#ifndef MIX_NAIVE_DA
#define MIX_NAIVE_DA 0
#endif
#ifndef MIX_NAIVE_MEM
#define MIX_NAIVE_MEM 0
#endif
#ifndef MIX_NAIVE_POOL
#define MIX_NAIVE_POOL 0
#endif
__device__ __forceinline__ void phase_mixers(unsigned char* ws, LAS unsigned char* lds, int l, int tid) {
    const float* prm = (const float*)(ws + WS_PARAM); const float* sc = (const float*)(ws + WS_SC) + l * 8;
    const float lam = ld_f32_agent(sc + 0), bnd0 = ld_f32_agent(sc + 1), bnd1 = ld_f32_agent(sc + 2), bndm = ld_f32_agent(sc + 3), omul = ld_f32_agent(sc + 4);
    const int bx = blockIdx.x, vcu = (gridDim.x == 256) ? ((bx & 7) * 32 + (bx >> 3)) : bx;
    bf16_t* Q = (bf16_t*)(ws + WS_Q); const bf16_t* K = (const bf16_t*)(ws + WS_K); const bf16_t* V = (const bf16_t*)(ws + WS_V);
    bf16_t* MQ = (bf16_t*)(ws + WS_MQ); const bf16_t* KV = (const bf16_t*)(ws + WS_MEMKV) + l * 1024;     const float* mqss = (const float*)(ws + WS_MQSS);
#if MIX_NAIVE_DA
    for (int u = blockIdx.x; u < 4096; u += gridDim.x) { const int hc = 63 - (u >> 6), c = hc >> 1, bh = u & 63, b = bh >> 3, h = bh & 7;
        const size_t rowb = (size_t)b * SEQ; const float slope2 = exp2f(-(float)(h + 1)) * LOG2E;
        naive_attn_unit<true>(lds, tid, Q + (rowb + hc * 32) * 1024 + h * 128, 1024, K + rowb * 1024 + h * 128, 1024, V + rowb * 1024 + h * 128, 1024, (bf16_t*)(ws + WS_XB) + (rowb + hc * 32) * 1024 + h * 128, 1024,
                              c + 1, hc * 32, nullptr, nullptr, nullptr, slope2, bnd0, bnd1, lam, prm + PB_GOUT + l * 128, omul); }
#else
    {
        const float B2 = fmaxf(bnd0, bnd1);
        for (int rep_ = 0; rep_ < REP_DA; ++rep_)
        for (int w = vcu; w < 256; w += gridDim.x) { const int bh = w >> 2, s = w & 3, b = bh >> 3, h = bh & 7; const float sl2 = exp2f(-(float)(h + 1)) * LOG2E;
#pragma unroll 1
            for (int i = 0; i < 4; ++i) { const int u = (i == 0) ? 15 - s : (i == 1) ? 8 + s : (i == 2) ? 7 - s : s;
                mix::diffattn_unit(lds, tid, Q, K, V, (bf16_t*)(ws + WS_XB), b, h, u, (i & 1) != 0, sl2, B2, lam, prm + PB_GOUT + l * 128, omul); } }
    }
#endif
#if MIX_NAIVE_MEM
    for (int u = blockIdx.x; u < 2048; u += gridDim.x) { const int qt = u >> 2, hd = u & 3, b = qt >> 6; const size_t row0 = (size_t)qt * 32;
        naive_attn_unit<false>(lds, tid, MQ + row0 * 512 + hd * 128, 512, KV + (size_t)b * MEML * 2048 + hd * 128, 2048, KV + (size_t)b * MEML * 2048 + 512 + hd * 128, 2048, MQ + row0 * 512 + hd * 128, 512,
                               4, 0, prm + PB_MQN + l * 128, prm + PB_MKN + l * 128, mqss + row0 * 8 + hd * 2, 0.f, bndm, 0.f, 0.f, nullptr, 1.f); }
#else
    for (int rep_ = 0; rep_ < REP_MEM; ++rep_)
    for (int w = vcu; w < 256; w += gridDim.x) mix::memattn_unit(lds, tid, MQ, (rep_ + 1 < REP_MEM) ? (bf16_t*)(ws + WS_OPOOL) : MQ, KV, mqss, prm + PB_MQN + l * 128, prm + PB_MKN + l * 128, w >> 2, w & 3, bndm);
#endif
#if MIX_NAIVE_POOL
    for (int u = blockIdx.x; u < 1024; u += gridDim.x) { const int tt = u >> 2, g = u & 3;
        naive_pool_unit(lds, tid, (const bf16_t*)(ws + WS_P), (bf16_t*)(ws + WS_OPOOL), prm + PB_POOLW + (size_t)(l * 4 + g) * 128 * 128, prm + PB_POOLS + l * 512 + g * 128, tt * 64, g); }
#else
    for (int rep_ = 0; rep_ < REP_POOL; ++rep_)
    for (int w = vcu; w < 256; w += gridDim.x) { const int pm = w >> 2, g = w & 3;
        mix::pool_unit(lds, tid, (const bf16_t*)(ws + WS_P), (bf16_t*)(ws + WS_OPOOL), (const bf16_t*)(ws + WS_POOLWT) + (size_t)(l * 4 + g) * 128 * 128, prm + PB_POOLS + l * 512 + g * 128, pm * 256, g); }
#endif
}

__device__ __forceinline__ void phase_route(unsigned char* ws, const bf16_t* xin, LAS unsigned char* lds, int tid, int lane, int wave) {
    const float* gffn = (const float*)(ws + WS_PARAM) + PB_GFFN1; const float* wr = (const float*)(ws + WS_PARAM) + PB_WR;
    unsigned* cnt = (unsigned*)ws + CW_CNT; int* toke = (int*)(ws + WS_TOKE); int* tokp = (int*)(ws + WS_TOKP); float* tokg = (float*)(ws + WS_TOKG); float* tokr = (float*)(ws + WS_TOKR);
    LAS unsigned* lcnt = (LAS unsigned*)lds; LAS unsigned* lbase = lcnt + 8; LAS int* linfo = (LAS int*)(lds + 64);
    const int per = T / gridDim.x;
    for (int c0 = 0; c0 < per; c0 += 64) {
        __syncthreads();
        if (tid < 8) lcnt[tid] = 0u;
        __syncthreads();
        for (int i = wave; i < 64 && c0 + i < per; i += NWAVES) {
            const int t = blockIdx.x * per + c0 + i;
            f32x4 v[4]; ld16_bf16(xin + (size_t)t * D + 16 * lane, v); float s = 0.f;
#pragma unroll
            for (int j = 0; j < 4; ++j) s += (v[j][0] * v[j][0] + v[j][1] * v[j][1]) + (v[j][2] * v[j][2] + v[j][3] * v[j][3]);
            const float rstd = __builtin_amdgcn_rsqf(wave_sum(s) * (1.f / 1024.f) + 1e-6f);
            float lg[8];
#pragma unroll
            for (int e = 0; e < 8; ++e) lg[e] = 0.f;
#pragma unroll
            for (int j = 0; j < 4; ++j)
#pragma unroll
                for (int k4 = 0; k4 < 4; ++k4) { const int k = 16 * lane + 4 * j + k4; const float xg = v[j][k4] * gffn[k]; const f32x4 w0 = *(const f32x4*)(wr + k * 8), w1 = *(const f32x4*)(wr + k * 8 + 4);
                    lg[0] += xg * w0[0]; lg[1] += xg * w0[1]; lg[2] += xg * w0[2]; lg[3] += xg * w0[3]; lg[4] += xg * w1[0]; lg[5] += xg * w1[1]; lg[6] += xg * w1[2]; lg[7] += xg * w1[3]; }
#pragma unroll
            for (int e = 0; e < 8; ++e) lg[e] = wave_sum(lg[e]) * rstd;
            int i0 = 0; float b0 = lg[0];
#pragma unroll
            for (int e = 1; e < 8; ++e) if (lg[e] > b0) { b0 = lg[e]; i0 = e; }
            int i1 = -1; float b1 = -3.0e38f;
#pragma unroll
            for (int e = 0; e < 8; ++e) if (e != i0 && lg[e] > b1) { b1 = lg[e]; i1 = e; }
            const float g0 = 1.f / (1.f + __expf(b1 - b0)), g1 = 1.f - g0;
            if (lane == 0) { const unsigned p0 = __hip_atomic_fetch_add(lcnt + i0, 1u, __ATOMIC_RELAXED, __HIP_MEMORY_SCOPE_WORKGROUP), p1 = __hip_atomic_fetch_add(lcnt + i1, 1u, __ATOMIC_RELAXED, __HIP_MEMORY_SCOPE_WORKGROUP);
                linfo[i * 4 + 0] = i0; linfo[i * 4 + 1] = i1; linfo[i * 4 + 2] = (int)p0; linfo[i * 4 + 3] = (int)p1;
                toke[2 * t] = i0; toke[2 * t + 1] = i1; tokg[2 * t] = g0; tokg[2 * t + 1] = g1; tokr[t] = rstd; }
        }
        __syncthreads();
        if (tid < 8) lbase[tid] = lcnt[tid] ? atomicAdd(cnt + 64 * tid, lcnt[tid]) : 0u;
        __syncthreads();
        if (tid < 64 && c0 + tid < per) { const int t = blockIdx.x * per + c0 + tid; tokp[2 * t] = (int)lbase[linfo[tid * 4 + 0]] + linfo[tid * 4 + 2]; tokp[2 * t + 1] = (int)lbase[linfo[tid * 4 + 1]] + linfo[tid * 4 + 3]; }
    }
}
__device__ __forceinline__ void build_texp(unsigned char* ws, LAS int* texp, int tid) {
    const unsigned* cnt = (const unsigned*)ws + CW_CNT;
    __syncthreads();
    if (tid == 0) { int tb = 0; for (int e = 0; e < NEXP; ++e) { texp[160 + e] = tb; const int n = (int)__hip_atomic_load(cnt + 64 * e, RLX_AGENT); const int nt = (n + 255) >> 8; for (int i = 0; i < nt; ++i) texp[tb + i] = e; tb += nt; } texp[168] = tb; texp[169] = tb; }
    __syncthreads();
}
__device__ __forceinline__ void phase_gather(unsigned char* ws, const bf16_t* xin, LAS int* texp, int lane, int wave) {
    const int* toke = (const int*)(ws + WS_TOKE); const int* tokp = (const int*)(ws + WS_TOKP); const float* tokr = (const float*)(ws + WS_TOKR);
    unsigned char* xg = ws + WS_XGY; float* xgrs = (float*)(ws + WS_XGRS);
    const int gw = blockIdx.x * NWAVES + wave, NGW = gridDim.x * NWAVES;
    for (int t = gw; t < T; t += NGW) {
        f32x4 v[4]; ld16_bf16(xin + (size_t)t * D + 16 * lane, v); float mx = 0.f;
#pragma unroll
        for (int j = 0; j < 4; ++j) { mx = fmaxf(mx, fmaxf(fmaxf(fabsf(v[j][0]), fabsf(v[j][1])), fmaxf(fabsf(v[j][2]), fabsf(v[j][3])))); }
#pragma unroll
        for (int o = 1; o < 64; o <<= 1) mx = fmaxf(mx, __shfl_xor(mx, o));
        const float inv = mx > 0.f ? 127.0f / mx : 0.f, rs = mx * (1.0f / 127.0f) * tokr[t];
        v4u w; w.x = pk_i8x4(v[0][0] * inv, v[0][1] * inv, v[0][2] * inv, v[0][3] * inv); w.y = pk_i8x4(v[1][0] * inv, v[1][1] * inv, v[1][2] * inv, v[1][3] * inv);
        w.z = pk_i8x4(v[2][0] * inv, v[2][1] * inv, v[2][2] * inv, v[2][3] * inv); w.w = pk_i8x4(v[3][0] * inv, v[3][1] * inv, v[3][2] * inv, v[3][3] * inv);
#pragma unroll
        for (int k = 0; k < 2; ++k) { const int e = toke[2 * t + k], p = tokp[2 * t + k]; const size_t row = (size_t)texp[160 + e] * 256 + p;
            *((v4u*)(xg + row * D) + lane) = w; if (lane == 0) xgrs[row] = rs; }
    }
}
__device__ __forceinline__ void phase_combine(unsigned char* ws, const bf16_t* xs, float* dst, LAS int* texp, int lane, int wave) {
    const int* toke = (const int*)(ws + WS_TOKE); const int* tokp = (const int*)(ws + WS_TOKP); const float* tokg = (const float*)(ws + WS_TOKG);
    const bf16_t* Y = (const bf16_t*)(ws + WS_Y);
    const int gw = blockIdx.x * NWAVES + wave, NGW = gridDim.x * NWAVES;
    for (int t = gw; t < T; t += NGW) {
        const size_t r0 = (size_t)texp[160 + toke[2 * t]] * 256 + tokp[2 * t], r1 = (size_t)texp[160 + toke[2 * t + 1]] * 256 + tokp[2 * t + 1]; const float g0 = tokg[2 * t], g1 = tokg[2 * t + 1];
        f32x4 xv[4]; ld16_bf16(xs + (size_t)t * D + 16 * lane, xv);
        const v4u* y0 = (const v4u*)(Y + r0 * D) + 2 * lane; const v4u* y1 = (const v4u*)(Y + r1 * D) + 2 * lane;
#pragma unroll
        for (int h = 0; h < 2; ++h) { const v4u p = y0[h], q = y1[h]; f32x4 xa = xv[2 * h], xc = xv[2 * h + 1];
            xa[0] += g0 * bf_lo(p.x) + g1 * bf_lo(q.x); xa[1] += g0 * bf_hi(p.x) + g1 * bf_hi(q.x); xa[2] += g0 * bf_lo(p.y) + g1 * bf_lo(q.y); xa[3] += g0 * bf_hi(p.y) + g1 * bf_hi(q.y);
            xc[0] += g0 * bf_lo(p.z) + g1 * bf_lo(q.z); xc[1] += g0 * bf_hi(p.z) + g1 * bf_hi(q.z); xc[2] += g0 * bf_lo(p.w) + g1 * bf_lo(q.w); xc[3] += g0 * bf_hi(p.w) + g1 * bf_hi(q.w);
            f32x4* xw = (f32x4*)(dst + (size_t)t * D) + 4 * lane; xw[2 * h] = xa; xw[2 * h + 1] = xc; }
    }
}

typedef pg8::EpiSwiglu<true, true> EpiSwigluF8;
#define GEMM_PHASE(EPI, g, S, E) do { S.prep(); __syncthreads(); pg8::gemm_phase<EPI, pg8::Sched2, true, true>(lds, g, S, E); } while (0)
__global__ void __launch_bounds__(NTHR, 2) fwd_kernel(Args args) {
    extern __shared__ __attribute__((aligned(16))) unsigned char lds_raw[];
    LAS unsigned char* lds = (LAS unsigned char*)lds_raw;
    volatile LAS unsigned* MISC = (volatile LAS unsigned*)(lds + MISC_OFF);
    LAS float* rstab = (LAS float*)(lds + RS_OFF); LAS int* texp = (LAS int*)(lds + TEXP_OFF);
    unsigned char* const ws0 = args.ws; int G = gridDim.x, bx = blockIdx.x;
#define PHASE_BEGIN() size_t z_ = 0; asm volatile("" : "+s"(z_), "+s"(G), "+s"(bx)); unsigned char* ws = args.ws + z_; float* out = args.out + z_; int tid = threadIdx.x; asm volatile("" : "+v"(tid)); const int lane = tid & 63, wave = __builtin_amdgcn_readfirstlane(tid >> 6); (void)lane; (void)wave; (void)out
    if (threadIdx.x < 64) MISC[threadIdx.x] = 0u;
    __syncthreads();
    XcdBarrier bar; bar.bar = (unsigned*)ws0 + CW_BAR; bar.x = 0; bar.st = nullptr;
    const int lo = args.ph_lo, hi = args.ph_hi;
    if (MK_N_LAUNCHES == 1 && hi - lo > 1) bar = xcd_barrier_post((unsigned*)ws0 + CW_BAR, MISC + 8);
#define IN(k) (lo <= (k) && (k) < hi)
#define SEAM(k) do { if (IN(k) && IN((k) + 1)) { size_t zb_ = 0; asm volatile("" : "+s"(zb_)); bar.bar = (unsigned*)args.ws + CW_BAR + zb_; xcd_barrier(bar); } } while (0)

    if (IN(0)) { PHASE_BEGIN(); phase_prologue(args, lds, tid, lane, wave); }
    SEAM(0);
    if (IN(0) && IN(2)) {}
    if (IN(2)) { PHASE_BEGIN();
        pg8::Gemm g{(const bf16_t*)(ws + WS_MEMBF), (const bf16_t*)(ws + WS_WMEMKV), NBATCH * MEML, 2048, D};
        pg8::Sched2 S; S.init2(g.M, g.N, G, bx, rstab); S.rsrc = (const float*)(ws + WS_SSM); S.rmode = 1;
        pg8::EpiStore<true> E{(bf16_t*)(ws + WS_MEMKV), 2048, rstab};
        GEMM_PHASE(pg8::EpiStore<true>, g, S, E);
        __syncthreads();
    }
    SEAM(2);
    for (int l = 0; l < 2; ++l) {
        const int pb = l == 0 ? 3 : 11;
        if (IN(pb)) { for (int rep_ = 0; rep_ < REP_A; ++rep_) { PHASE_BEGIN();
#if I8_A
            pg8::Gemm g{(const bf16_t*)(ws + WS_QX), (const bf16_t*)(ws + WS_W1T + (size_t)l * 14 * MiB), T, NGEMM1, D / 2};
            pg8::Sched2 S; S.init2(T, NGEMM1, G, bx, rstab); S.rsrc = (const float*)(ws + WS_SA); S.rmode = 2; S.wgm = 4;
            pg8::EpiA<true> E{ws, l, rstab};
            GEMM_PHASE(pg8::EpiA<true>, g, S, E); __syncthreads(); }
#else
            pg8::Gemm g{(const bf16_t*)(ws + WS_XB), (const bf16_t*)(ws + WS_W1T + (size_t)l * 14 * MiB), T, NGEMM1, D};
            pg8::Sched2 S; S.init2(T, NGEMM1, G, bx, rstab); S.rsrc = (const float*)(ws + WS_SS); S.rmode = 1; S.wgm = 4;
            pg8::EpiA<false> E{ws, l, rstab};
            GEMM_PHASE(pg8::EpiA<false>, g, S, E); __syncthreads(); }
#endif
        }
        SEAM(pb);
        if (IN(pb + 1)) { PHASE_BEGIN(); phase_mixers(ws, lds, l, tid); }
        SEAM(pb + 1);
        if (IN(pb + 2)) { for (int rep_ = 0; rep_ < REP_C; ++rep_) { PHASE_BEGIN();
            { pg8::Gemm g{(const bf16_t*)(ws + WS_XB), (const bf16_t*)(ws + WS_WBRDA + (size_t)l * 2 * MiB), T, D, 1024}; pg8::Sched2 S; S.init2(T, D, G, bx, rstab);
              pg8::EpiBr0 E{ws}; GEMM_PHASE(pg8::EpiBr0, g, S, E); }
            __syncthreads(); { size_t z2_ = 0; asm volatile("" : "+s"(z2_), "+s"(G), "+s"(bx)); ws = args.ws + z2_; }
            { pg8::Gemm g{(const bf16_t*)(ws + WS_OPOOL), (const bf16_t*)(ws + WS_WBRPOOL + (size_t)l * 1 * MiB), T, D, 512}; pg8::Sched2 S; S.init2(T, D, G, bx, rstab);
              S.chain = 2; S.A2 = (const bf16_t*)(ws + WS_MQ); S.B2 = (const bf16_t*)(ws + WS_WBRMEM + (size_t)l * 1 * MiB);
              pg8::EpiBrC E{ws}; GEMM_PHASE(pg8::EpiBrC, g, S, E); } __syncthreads(); }
        }
        SEAM(pb + 2);
        if (IN(pb + 3)) { PHASE_BEGIN();
            pg8::Gemm g{(const bf16_t*)(ws + WS_Q), (const bf16_t*)(ws + WS_WOUT + (size_t)l * 2 * MiB), T, D, D}; pg8::Sched2 S; S.init2(T, D, G, bx, rstab);
            pg8::EpiResB E{l == 0 ? (const float*)(args.in[0] + z_) : (const float*)nullptr, (bf16_t*)(ws + WS_XS)};
            GEMM_PHASE(pg8::EpiResB, g, S, E); __syncthreads();
        }
        SEAM(pb + 3);
        if (l == 0) {
            if (IN(7) && I8_E) { PHASE_BEGIN(); phase_quant_rows((const bf16_t*)(ws + WS_XS), ws, lane, wave); }
            SEAM(7);
            if (IN(8)) { for (int rep_ = 0; rep_ < REP_E; ++rep_) { PHASE_BEGIN();
#if I8_E
                pg8::Gemm g{(const bf16_t*)(ws + WS_QX), (const bf16_t*)(ws + WS_WFF13), T, 2 * FFD, D / 2}; pg8::Sched2 S; S.init2(T, 2 * FFD, G, bx, rstab); S.rsrc = (const float*)(ws + WS_SA); S.rmode = 2; S.wgm = 4;
                EpiSwigluF8 E{(bf16_t*)(ws + WS_HFF), FFD, rstab, (const float*)(ws + WS_SW) + SW_FF, FFD, nullptr, 0};
                GEMM_PHASE(EpiSwigluF8, g, S, E); __syncthreads(); }
#else
                pg8::Gemm g{(const bf16_t*)(ws + WS_X1B), (const bf16_t*)(ws + WS_WFF13), T, 2 * FFD, D}; pg8::Sched2 S; S.init2(T, 2 * FFD, G, bx, rstab); S.rsrc = (const float*)(ws + WS_SS); S.rmode = 1; S.wgm = 4;
                pg8::EpiSwiglu<false> E{(bf16_t*)(ws + WS_HFF), FFD, rstab, nullptr, 0, nullptr, 0};
                GEMM_PHASE(pg8::EpiSwiglu<false>, g, S, E); __syncthreads(); }
#endif
            }
            SEAM(8);
            if (IN(9)) { PHASE_BEGIN();
                pg8::Gemm g{(const bf16_t*)(ws + WS_HFF), (const bf16_t*)(ws + WS_WFF2), T, D, FFD / 2}; pg8::Sched2 S; S.init2(T, D, G, bx, rstab);
                pg8::EpiResB8 E{(bf16_t*)(ws + WS_XS), (const float*)(ws + WS_SW) + SW_W2 + 8 * 1024};
                GEMM_PHASE(pg8::EpiResB8, g, S, E); __syncthreads();
            }
            SEAM(9);
            if (IN(10) && I8_A) { PHASE_BEGIN(); phase_quant_rows((const bf16_t*)(ws + WS_XS), ws, lane, wave); }
            SEAM(10);
        }
    }
    if (IN(15)) { PHASE_BEGIN(); phase_route(ws, (const bf16_t*)(ws + WS_XS), lds, tid, lane, wave); }
    SEAM(15);
    if (IN(16)) { PHASE_BEGIN(); build_texp(ws, texp, tid); phase_gather(ws, (const bf16_t*)(ws + WS_XS), texp, lane, wave); }
    SEAM(16);
    for (int k = 0; k < 4; ++k) {
        if (IN(17 + k)) { PHASE_BEGIN();
            build_texp(ws, texp, tid);
            const int ntot = texp[169];
            const int kd = k - 1, ku = k;
            int ntd = 0, ntu = 0;
            if (kd >= 0) { ntd = ntot - MOE_CH * kd; const int cap = (kd == 2) ? MOE_CHL : MOE_CH; ntd = ntd < 0 ? 0 : (ntd > cap ? cap : ntd); }
            if (ku <= 2) { ntu = ntot - MOE_CH * ku; const int cap = (ku == 2) ? MOE_CHL : MOE_CH; ntu = ntu < 0 ? 0 : (ntu > cap ? cap : ntu); }
            const int nX = ntd * 4, nU = ntu * 28;
            const bool mixed = (nX > 0 && nU > 0);
            const int tf = (nU + DNW * nX) / 256, rem = (nU + DNW * nX) - 256 * tf;
            const bool weighted = mixed && tf >= DNW && nX <= 256 && G == 256;
            if (nX > 0) {
                const int t0 = MOE_CH * kd;
                pg8::Gemm g{(const bf16_t*)(ws + WS_HCH + (size_t)(kd & 1) * HCH_BYTES), (const bf16_t*)(ws + WS_WMOE2), ntd * 256, D, FFE / 2};
                pg8::Sched2 S; S.init2(ntd * 256, D, G, bx, rstab); S.texp = texp; S.estride = (size_t)7 * MiB; S.t0 = t0;
                if (weighted) { const int vc = (bx & 7) * 32 + (bx >> 3); S.rng = 1; S.rng_start = vc; S.rng_cnt = (vc < nX) ? 1 : 0; }
                pg8::EpiStoreF8 E{(bf16_t*)(ws + WS_Y) + (size_t)t0 * 256 * D, D, (const float*)(ws + WS_SW) + SW_W2, texp, t0};
                for (int rep_ = 0; rep_ < REP_DN; ++rep_) { GEMM_PHASE(pg8::EpiStoreF8, g, S, E); __syncthreads(); }
            }
            if (nU > 0) {
                size_t z3_ = 0; asm volatile("" : "+s"(z3_), "+s"(G), "+s"(bx)); ws = args.ws + z3_;
                const int t0 = MOE_CH * ku;
                pg8::Gemm g{(const bf16_t*)(ws + WS_XGY + (size_t)t0 * 256 * D), (const bf16_t*)(ws + WS_WMOE13), ntu * 256, 2 * FFE, D / 2};
                pg8::Sched2 S; S.init2(ntu * 256, 2 * FFE, G, bx, rstab); S.rsrc = (const float*)(ws + WS_XGRS); S.rmode = 2; S.rrow0 = t0 * 256; S.texp = texp; S.estride = (size_t)7 * MiB; S.t0 = t0;
                if (weighted) { const int vc = (bx & 7) * 32 + (bx >> 3); const int cmin = vc < nX ? vc : nX, over = vc - (256 - rem); S.rng = 1; S.rng_start = vc * tf - DNW * cmin + (over > 0 ? over : 0); S.rng_cnt = tf - (vc < nX ? DNW : 0) + (vc >= 256 - rem ? 1 : 0); }
                EpiSwigluF8 E{(bf16_t*)(ws + WS_HCH + (size_t)(ku & 1) * HCH_BYTES), FFE, rstab, (const float*)(ws + WS_SW) + SW_MOE, FFE, texp, t0};
                for (int rep_ = 0; rep_ < REP_UP; ++rep_) { GEMM_PHASE(EpiSwigluF8, g, S, E); __syncthreads(); }
            }
        }
        SEAM(17 + k);
    }
    if (IN(21)) { PHASE_BEGIN(); build_texp(ws, texp, tid); phase_combine(ws, (const bf16_t*)(ws + WS_XS), out, texp, lane, wave); }
#undef IN
#undef SEAM
}

extern "C" void kernel_launch(void* const* d_in, const int* in_sizes, int n_in, void* d_out, int out_size, void* d_ws, size_t ws_size, hipStream_t stream) {
    static int grid = 0;
    if (grid == 0) {
        if (n_in != 31 || out_size != T * D || ws_size < WS_END) { fprintf(stderr, "kernel_launch: unexpected problem (n_in %d, out %d, ws %zu < %zu)\n", n_in, out_size, ws_size, (size_t)WS_END); grid = -1; return; }
        int dev = 0, cus = 0, per_cu = 0;
        if (hipGetDevice(&dev) != hipSuccess || hipDeviceGetAttribute(&cus, hipDeviceAttributeMultiprocessorCount, dev) != hipSuccess) { grid = -1; return; }
        if (hipFuncSetAttribute((const void*)fwd_kernel, hipFuncAttributeMaxDynamicSharedMemorySize, LDS_BYTES) != hipSuccess) { fprintf(stderr, "kernel_launch: hipFuncSetAttribute failed\n"); grid = -1; return; }
        if (hipOccupancyMaxActiveBlocksPerMultiprocessor(&per_cu, (const void*)fwd_kernel, NTHR, LDS_BYTES) != hipSuccess || per_cu < 1) { fprintf(stderr, "kernel_launch: occupancy query says %d\n", per_cu); grid = -1; (void)hipGetLastError(); return; }
        grid = cus;
    }
    if (grid < 0) return;
    if (hipMemsetAsync(d_ws, 0, CTL_ZERO_BYTES, stream) != hipSuccess) return;
    Args a{};
    for (int i = 0; i < 31; ++i) a.in[i] = (const float*)d_in[i];
    a.out = (float*)d_out; a.ws = (unsigned char*)d_ws;
#ifdef PROBE_EXTRA_PROLOGUE
    a.ph_lo = 0; a.ph_hi = 1; hipLaunchKernelGGL(fwd_kernel, dim3(grid), dim3(NTHR), LDS_BYTES, stream, a);
#endif
#ifdef PROBE_EXTRA_PHASE
#ifndef PROBE_EXTRA_REPS
#define PROBE_EXTRA_REPS 1
#endif
    for (int r_ = 0; r_ < PROBE_EXTRA_REPS; ++r_) { a.ph_lo = PROBE_EXTRA_PHASE; a.ph_hi = PROBE_EXTRA_PHASE + 1; hipLaunchKernelGGL(fwd_kernel, dim3(grid), dim3(NTHR), LDS_BYTES, stream, a); }
#endif
    if (MK_N_LAUNCHES == 1) { a.ph_lo = 0; a.ph_hi = NPH; hipLaunchKernelGGL(fwd_kernel, dim3(grid), dim3(NTHR), LDS_BYTES, stream, a); }
    else for (int p = 0; p < NPH; ++p) { a.ph_lo = p; a.ph_hi = p + 1; hipLaunchKernelGGL(fwd_kernel, dim3(grid), dim3(NTHR), LDS_BYTES, stream, a); }
}
```

```cpp
#include <hip/hip_runtime.h>
#include <cstdio>
#include <cstdint>
#define MK_N_LAUNCHES 1
#ifndef USE_I8
#define USE_I8 1
#endif
#ifndef I8_A
#define I8_A 1
#endif
#ifndef I8_E
#define I8_E 1
#endif
#ifndef REP_MEM
#define REP_MEM 1
#endif
#ifndef REP_D
#define REP_D 1
#endif
#ifndef REP_F
#define REP_F 1
#endif
#ifndef REP_Z
#define REP_Z 1
#endif
#ifndef REP_E
#define REP_E 1
#endif
#ifndef REP_DN
#define REP_DN 1
#endif
#ifndef REP_MG
#define REP_MG 1
#endif
#ifndef REP_POOL
#define REP_POOL 1
#endif
#ifndef REP_GA
#define REP_GA 1
#endif
#ifndef REP_PRO
#define REP_PRO 1
#endif
#ifndef REP_A
#define REP_A 1
#endif
#ifndef REP_DA
#define REP_DA 1
#endif
#ifndef REP_C
#define REP_C 1
#endif
#ifndef REP_UP
#define REP_UP 1
#endif

constexpr int NWAVES = 8, NTHR = 512;
constexpr int T = 16384, D = 1024, SEQ = 2048, NBATCH = 8, MEML = 256;
constexpr int NGEMM1 = 7168, FFD = 2816, FFE = 3584, NEXP = 8;
constexpr float LOG2E = 1.4426950408889634f;
constexpr float QSCALE = 0.125f * LOG2E;
constexpr float MEMSCALE = 0.08838834764831845f * LOG2E;
#ifndef MK_N_LAUNCHES
#define MK_N_LAUNCHES 1
#endif
constexpr int NPH = 22;
constexpr int MOE_CH = 45, MOE_CHL = 46;

constexpr size_t MiB = 1u << 20;
constexpr size_t CTL_ZERO_BYTES = 1 * MiB;
constexpr size_t WS_SS = 1 * MiB;
constexpr size_t WS_MQSS = 2 * MiB;
constexpr size_t WS_SSM = 2 * MiB + 512 * 1024;
constexpr size_t WS_TOKE = WS_SSM + 128 * 1024;
constexpr size_t WS_TOKP = WS_TOKE + 128 * 1024;
constexpr size_t WS_TOKG = WS_TOKP + 128 * 1024;
constexpr size_t WS_TOKR = WS_TOKG + 128 * 1024;
constexpr size_t WS_SC = WS_TOKR + 64 * 1024;
constexpr size_t WS_XGRS = WS_SC + 4096;
constexpr size_t WS_PARAM = 3 * MiB + 256 * 1024;
constexpr int PB_BGATE = 0, PB_GQ = 6144, PB_GK = 6400, PB_GOUT = 6656, PB_POOLS = 6912, PB_MQN = 7936, PB_MKN = 8192, PB_GFFN1 = 8448, PB_WR = 9472, PB_POOLW = 17664, PB_END = 17664 + 131072;
constexpr size_t WS_W1T = 4 * MiB;
constexpr size_t WS_WMEMKV = 32 * MiB;
constexpr size_t WS_WBRDA = 36 * MiB;
constexpr size_t WS_WBRPOOL = 40 * MiB;
constexpr size_t WS_WBRMEM = 42 * MiB;
constexpr size_t WS_WOUT = 44 * MiB;
constexpr size_t WS_WFF13 = 48 * MiB;
constexpr size_t WS_WFF2 = 59 * MiB;
constexpr size_t WS_SW = WS_WFF13 + 6 * MiB;
constexpr int SW_G1 = 0, SW_FF = 2 * 7168, SW_MOE = SW_FF + 2 * 2816, SW_W2 = SW_MOE + 8 * 2 * 3584, SW_END = SW_W2 + 9 * 1024;
constexpr float H8_SCALE = 8.0f;
constexpr int DNW = 2;
constexpr size_t SW_BYTES = (size_t)SW_END * 4;
constexpr size_t WS_WMOE13 = 65 * MiB;
constexpr size_t WS_XS = WS_WMOE13 + 56 * MiB;
constexpr size_t WS_WMOE2 = 177 * MiB;
constexpr size_t WS_XB = 233 * MiB;
constexpr size_t WS_QX = WS_XB, WS_SA = 1 * MiB;
constexpr size_t WS_MEMKV = 265 * MiB;
constexpr size_t WS_R = 273 * MiB;
constexpr size_t WS_Q = WS_R, WS_K = WS_R + 32 * MiB, WS_V = WS_R + 64 * MiB, WS_P = WS_R + 96 * MiB, WS_MQ = WS_R + 112 * MiB, WS_OPOOL = WS_R + 128 * MiB, WS_G = WS_R + 144 * MiB, WS_MEMBF = WS_R + 240 * MiB, WS_POOLWT = WS_R + 244 * MiB;
constexpr size_t WS_MF = WS_K, WS_X1B = WS_K, WS_HFF = WS_R + 144 * MiB;
constexpr size_t WS_XGY = WS_MEMKV;
constexpr size_t WS_Y = WS_XGY + 34 * MiB;
constexpr size_t WS_HCH = WS_Y + 68 * MiB, HCH_BYTES = (size_t)MOE_CHL * 256 * 7168;
constexpr size_t WS_END = 529 * MiB;
static_assert(WS_XGRS + 34816 * 4 <= WS_PARAM && WS_PARAM + (size_t)PB_END * 4 <= WS_W1T && WS_HCH + 2 * HCH_BYTES <= WS_END && WS_SW + SW_BYTES <= WS_WFF2, "d_ws map");
constexpr int CW_CNT = 64;
constexpr int CW_BAR = 4096;

constexpr int RING_BYTES = 131072;
constexpr int RS_OFF = 131072, RS_UNITS = 16;
constexpr int TEXP_OFF = RS_OFF + RS_UNITS * 1024;
constexpr int LDS_BYTES = 155648;
constexpr int MISC_OFF = LDS_BYTES - 256;

namespace pg8 {
#define PG8_LAS __attribute__((address_space(3)))
typedef unsigned short bf16_t;
typedef short bf16x8 __attribute__((ext_vector_type(8)));
typedef float f32x4 __attribute__((ext_vector_type(4)));
typedef unsigned u32x4 __attribute__((ext_vector_type(4)));
constexpr int BM = 256, BK = 64, HALF = 128, HTB = HALF * BK * 2  , STAGE_BYTES = 8 * HTB, NXCD = 8, WGM = 8;

__host__ __device__ __forceinline__ int lds_byte(int r, int c) { const int st = (r >> 4) * 2 + (c >> 5), rr = r & 15, cc = c & 31, ob = rr * 64 + cc * 2; return st * 1024 + (ob ^ (((ob >> 9) & 1) << 5)); }
__host__ __device__ __forceinline__ void stage_rc(int b, int& R, int& C) { const int st = b / 1024, sb = b % 1024, swz = sb ^ (((sb >> 9) & 1) << 5); R = (st >> 1) * 16 + swz / 64; C = (st & 1) * 32 + (swz % 64) / 2; }
__host__ __device__ __forceinline__ int perm32(int rho) { const int n = rho >> 4, i = rho & 15; return 8 * (i >> 2) + 4 * n + (i & 3); }

struct Unit { int pm, pn, idx; };
struct Gemm { const bf16_t* A; const bf16_t* Bt; int M, N, K; };

struct StaticOrder {
    int nM, nN, nwg, G, c, wgm;
    __host__ __device__ void init(int M, int N, int G_, int c_) { nM = M / BM; nN = N / BM; nwg = nM * nN; G = G_; c = c_; wgm = WGM; }
    __host__ __device__ bool next(int i, Unit& u) const {
        const long L = (long)i * G + c; if (L >= nwg) return false;
        int wgid = (int)L; { const int q = nwg / NXCD, r = nwg % NXCD, xcd = wgid % NXCD, off = wgid / NXCD; wgid = (xcd < r ? xcd * (q + 1) : r * (q + 1) + (xcd - r) * q) + off; }
        const int nig = wgm * nN, gid = wgid / nig, fm = gid * wgm, gsz = (nM - fm) < wgm ? (nM - fm) : wgm;
        u.pm = fm + ((wgid % nig) % gsz); u.pn = (wgid % nig) / gsz; u.idx = i; return true;
    }
    __device__ __forceinline__ const char* bptr(const Gemm& g, const Unit& u, size_t tstep) const { return (const char*)g.Bt + (size_t)u.pn * tstep; }
    __device__ __forceinline__ const char* aptr(const Gemm& g, const Unit& u, size_t tstep) const { return (const char*)g.A + (size_t)u.pm * tstep; }
    __device__ __forceinline__ void a_ready(const Unit&) const {}
    __device__ __forceinline__ void done(const Unit&) const {}
};


typedef float f32x2 __attribute__((ext_vector_type(2)));
typedef __bf16 bf16x2_t __attribute__((ext_vector_type(2)));
__device__ __forceinline__ unsigned pk_bf16(float lo, float hi) { f32x2 v = {lo, hi}; bf16x2_t b = __builtin_convertvector(v, bf16x2_t); return __builtin_bit_cast(unsigned, b); }
__device__ __forceinline__ u32x4 pk8(const f32x4 a, const f32x4 b) { u32x4 w; w.x = pk_bf16(a[0], a[1]); w.y = pk_bf16(a[2], a[3]); w.z = pk_bf16(b[0], b[1]); w.w = pk_bf16(b[2], b[3]); return w; }
__device__ __forceinline__ float bf_lo(unsigned w) { return __builtin_bit_cast(float, w << 16); }
__device__ __forceinline__ float bf_hi(unsigned w) { return __builtin_bit_cast(float, w & 0xffff0000u); }
__device__ __forceinline__ float sigmoid_f(float x) { return __builtin_amdgcn_rcpf(1.0f + __builtin_amdgcn_exp2f(-1.4426950408889634f * x)); }
typedef int i32x8 __attribute__((ext_vector_type(8)));
typedef int i32x4 __attribute__((ext_vector_type(4)));
__device__ __forceinline__ f32x4 mma_f8(const i32x8 a, const i32x8 b, f32x4 c) { const int one = 0x7f7f7f7f; asm volatile("v_mfma_scale_f32_16x16x128_f8f6f4 %0, %1, %2, %0, %3, %3 op_sel_hi:[0,0,0]" : "+v"(c) : "v"(a), "v"(b), "v"(one)); return c; }
__device__ __forceinline__ unsigned pk_fp8x4(float a, float b, float c, float d) { int w = __builtin_amdgcn_cvt_pk_fp8_f32(a, b, 0, false); w = __builtin_amdgcn_cvt_pk_fp8_f32(c, d, w, true); return (unsigned)w; }
constexpr float RMS_EPS = 1e-6f;
typedef int i32x4 __attribute__((ext_vector_type(4)));
template <bool I8> __device__ __forceinline__ f32x4 mma16(const bf16x8 a, const bf16x8 b, const f32x4 c) {
    if constexpr (I8) return __builtin_bit_cast(f32x4, __builtin_amdgcn_mfma_i32_16x16x64_i8(__builtin_bit_cast(i32x4, a), __builtin_bit_cast(i32x4, b), __builtin_bit_cast(i32x4, c), 0, 0, 0));
    else return __builtin_amdgcn_mfma_f32_16x16x32_bf16(a, b, c, 0, 0, 0);
}
template <bool I8> __device__ __forceinline__ f32x4 accf(const f32x4 a) {
    if constexpr (I8) { const i32x4 v = __builtin_bit_cast(i32x4, a); return (f32x4){(float)v[0], (float)v[1], (float)v[2], (float)v[3]}; } else return a;
}


struct Sched2 : StaticOrder {
    const float* rsrc; int rmode;
    int rrow0;
    PG8_LAS float* rtab;
    const PG8_LAS int* texp; size_t estride; int t0;
    int rng, rng_start, rng_cnt;
    const bf16_t* A2; const bf16_t* B2; int chain;
    __device__ __forceinline__ void init2(int M, int N, int G_, int c_, PG8_LAS float* tab) { init(M, N, G_, c_); rsrc = nullptr; rmode = 0; rrow0 = 0; rtab = tab; texp = nullptr; estride = 0; t0 = 0; A2 = nullptr; B2 = nullptr; chain = 0; rng = 0; rng_start = 0; rng_cnt = 0; }
    __device__ __forceinline__ bool next(int i, Unit& u) const {
        if (rng != 0) { if (i >= rng_cnt) return false; const int q = rng_start + i; u.pm = q / nN; u.pn = q - u.pm * nN; u.idx = i; return true; }
        if (chain == 0) return StaticOrder::next(i, u); if (i >= chain || !StaticOrder::next(0, u)) return false; u.idx = i; return true; }
    __device__ __forceinline__ const char* aptr(const Gemm& g, const Unit& u, size_t tstep) const { return (const char*)((chain != 0 && u.idx == 1) ? A2 : g.A) + (size_t)u.pm * tstep; }
    __device__ __forceinline__ const char* bptr(const Gemm& g, const Unit& u, size_t tstep) const {
        const char* b = (const char*)((chain != 0 && u.idx == 1) ? B2 : g.Bt) + (size_t)u.pn * tstep;
        if (texp) b += (size_t)texp[t0 + u.pm] * estride;
        return b;
    }
    __device__ __forceinline__ void a_ready(const Unit&) const {}
    __device__ __forceinline__ void prep() const {
        if (rmode == 0) return;
        int tid = threadIdx.x; asm volatile("" : "+v"(tid));
        if (tid < 256) {
            Unit u;
#pragma unroll 1
            for (int i = 0; i < 16 && next(i, u); ++i) {
                const size_t row = (size_t)rrow0 + (size_t)u.pm * 256 + tid; float sc;
                if (rmode == 1) { const f32x4* p = (const f32x4*)(rsrc + row * 16); const f32x4 a = p[0], b = p[1], c = p[2], d = p[3];
                    const float s = ((a[0] + a[1]) + (a[2] + a[3])) + ((b[0] + b[1]) + (b[2] + b[3])) + ((c[0] + c[1]) + (c[2] + c[3])) + ((d[0] + d[1]) + (d[2] + d[3]));
                    sc = __builtin_amdgcn_rsqf(s * (1.0f / 1024.0f) + RMS_EPS); }
                else sc = rsrc[row];
                rtab[i * 256 + tid] = sc;
            }
        }
    }
    __device__ __forceinline__ void done(const Unit&) const {}
};

template <bool RS> struct EpiStore {
    static constexpr bool PERM = false, AFTER_DRAIN = false, I8 = false, F8 = false;
    bf16_t* O; int ldc; const PG8_LAS float* rs;
    __device__ __forceinline__ void operator()(const f32x4 (&acc)[2][2][4][2], const Unit& u, int wr, int wc, int fr, int fq) const {
        const int rl = wr * 64 + fr; const size_t row0 = (size_t)u.pm * BM + rl; const int col0 = u.pn * BM + 64 * wc + 8 * fq;
#pragma unroll
        for (int ai = 0; ai < 2; ++ai)
#pragma unroll
            for (int m = 0; m < 4; ++m) { const float sc = RS ? rs[u.idx * 256 + rl + ai * HALF + m * 16] : 1.f; bf16_t* rowp = O + (row0 + ai * HALF + m * 16) * ldc + col0;
#pragma unroll
                for (int bj = 0; bj < 2; ++bj) *(u32x4*)(rowp + 32 * bj) = pk8(acc[ai][bj][m][0] * sc, acc[ai][bj][m][1] * sc); }
    }
};

template <bool I8_> struct EpiA {
    static constexpr bool PERM = false, AFTER_DRAIN = false, I8 = I8_, F8 = false;
    unsigned char* ws; int l; const PG8_LAS float* rs;
    __device__ __forceinline__ void operator()(const f32x4 (&acc)[2][2][4][2], const Unit& u, int wr, int wc, int fr, int fq) const {
        const int pn = u.pn, rl = wr * 64 + fr; const size_t row0 = (size_t)u.pm * BM + rl; const PG8_LAS float* rsp = rs + u.idx * 256 + rl;
        const float* prm = (const float*)(ws + WS_PARAM);
        f32x4 cw[2][2];
#pragma unroll
        for (int bj = 0; bj < 2; ++bj)
#pragma unroll
            for (int n = 0; n < 2; ++n) { if constexpr (I8_) cw[bj][n] = *(const f32x4*)((const float*)(ws + WS_SW) + SW_G1 + l * 7168 + pn * 256 + 64 * wc + 32 * bj + 8 * fq + 4 * n) * (1.0f / 127.0f); else cw[bj][n] = (f32x4){1.f, 1.f, 1.f, 1.f}; }
#define EA_V(ai, bj, m, n) (accf<I8_>(acc[ai][bj][m][n]) * cw[bj][n])
        if (pn < 8) {
            const bool isq = pn < 4; const float* gg = prm + (isq ? PB_GQ : PB_GK) + l * 128 + (wc & 1) * 64 + 8 * fq; const float mul = isq ? QSCALE : 1.f;
            f32x4 gv[2][2];
#pragma unroll
            for (int bj = 0; bj < 2; ++bj)
#pragma unroll
                for (int n = 0; n < 2; ++n) gv[bj][n] = *(const f32x4*)(gg + 32 * bj + 4 * n);
            bf16_t* base = (bf16_t*)(ws + (isq ? WS_Q : WS_K)) + (pn & 3) * 256 + 64 * wc + 8 * fq;
#pragma unroll
            for (int ai = 0; ai < 2; ++ai)
#pragma unroll
                for (int m = 0; m < 4; ++m) { const float sc = rsp[ai * HALF + m * 16];
                    f32x4 v[2][2]; float ss = 0.f;
#pragma unroll
                    for (int bj = 0; bj < 2; ++bj)
#pragma unroll
                        for (int n = 0; n < 2; ++n) { v[bj][n] = EA_V(ai, bj, m, n) * sc; const f32x4 x = v[bj][n]; ss += (x[0] * x[0] + x[1] * x[1]) + (x[2] * x[2] + x[3] * x[3]); }
                    ss += __shfl_xor(ss, 16); ss += __shfl_xor(ss, 32);
                    const float r = __builtin_amdgcn_rsqf(ss * (1.0f / 64.0f) + RMS_EPS) * mul;
                    bf16_t* rowp = base + (row0 + ai * HALF + m * 16) * 1024;
#pragma unroll
                    for (int bj = 0; bj < 2; ++bj) *(u32x4*)(rowp + 32 * bj) = pk8(v[bj][0] * gv[bj][0] * r, v[bj][1] * gv[bj][1] * r); }
        } else if (pn < 14) {
            bf16_t* base; int ldc;
            if (pn < 12) { base = (bf16_t*)(ws + WS_V) + (pn - 8) * 256; ldc = 1024; } else { base = (bf16_t*)(ws + WS_P) + (pn - 12) * 256; ldc = 512; }
            base += 64 * wc + 8 * fq;
#pragma unroll
            for (int ai = 0; ai < 2; ++ai)
#pragma unroll
                for (int m = 0; m < 4; ++m) { const float sc = rsp[ai * HALF + m * 16]; bf16_t* rowp = base + (row0 + ai * HALF + m * 16) * ldc;
#pragma unroll
                    for (int bj = 0; bj < 2; ++bj) *(u32x4*)(rowp + 32 * bj) = pk8(EA_V(ai, bj, m, 0) * sc, EA_V(ai, bj, m, 1) * sc); }
        } else if (pn < 16) {
            bf16_t* base = (bf16_t*)(ws + WS_MQ) + (pn - 14) * 256 + 64 * wc + 8 * fq; float* mqss = (float*)(ws + WS_MQSS);
#pragma unroll
            for (int ai = 0; ai < 2; ++ai)
#pragma unroll
                for (int m = 0; m < 4; ++m) { const float sc = rsp[ai * HALF + m * 16]; const size_t row = row0 + ai * HALF + m * 16; bf16_t* rowp = base + row * 512; float ss = 0.f;
#pragma unroll
                    for (int bj = 0; bj < 2; ++bj) { const f32x4 a = EA_V(ai, bj, m, 0) * sc, b = EA_V(ai, bj, m, 1) * sc;
                        ss += ((a[0] * a[0] + a[1] * a[1]) + (a[2] * a[2] + a[3] * a[3])) + ((b[0] * b[0] + b[1] * b[1]) + (b[2] * b[2] + b[3] * b[3]));
                        *(u32x4*)(rowp + 32 * bj) = pk8(a, b); }
                    ss += __shfl_xor(ss, 16); ss += __shfl_xor(ss, 32);
                    if (fq == 0) mqss[row * 8 + (pn - 14) * 4 + wc] = ss; }
        } else {
            const int gcol = (pn - 16) * 256 + 64 * wc + 8 * fq; unsigned char* base = (unsigned char*)(ws + WS_G) + gcol; const float* bgate = prm + PB_BGATE + l * 3072 + gcol;
            f32x4 bv[2][2];
#pragma unroll
            for (int bj = 0; bj < 2; ++bj)
#pragma unroll
                for (int n = 0; n < 2; ++n) bv[bj][n] = *(const f32x4*)(bgate + 32 * bj + 4 * n);
#pragma unroll
            for (int ai = 0; ai < 2; ++ai)
#pragma unroll
                for (int m = 0; m < 4; ++m) { const float sc = rsp[ai * HALF + m * 16]; unsigned char* rowp = base + (row0 + ai * HALF + m * 16) * 3072;
#pragma unroll
                    for (int bj = 0; bj < 2; ++bj) { f32x4 a = EA_V(ai, bj, m, 0) * sc + bv[bj][0], b = EA_V(ai, bj, m, 1) * sc + bv[bj][1];
#pragma unroll
                        for (int j = 0; j < 4; ++j) { a[j] = sigmoid_f(a[j]) * 255.0f + 0.5f; b[j] = sigmoid_f(b[j]) * 255.0f + 0.5f; }
                        const unsigned w0 = (unsigned)a[0] | ((unsigned)a[1] << 8) | ((unsigned)a[2] << 16) | ((unsigned)a[3] << 24), w1 = (unsigned)b[0] | ((unsigned)b[1] << 8) | ((unsigned)b[2] << 16) | ((unsigned)b[3] << 24);
                        *(unsigned long long*)(rowp + 32 * bj) = (unsigned long long)w0 | ((unsigned long long)w1 << 32); } }
        }
    }
};
#undef EA_V

struct EpiBr0 {
    static constexpr bool PERM = false, AFTER_DRAIN = false, I8 = false, F8 = false;
    unsigned char* ws;
    __device__ __forceinline__ void operator()(const f32x4 (&acc)[2][2][4][2], const Unit& u, int wr, int wc, int fr, int fq) const {
        const size_t row0 = (size_t)u.pm * BM + wr * 64 + fr; const int col0 = u.pn * BM + 64 * wc + 8 * fq;
        const unsigned char* G = (const unsigned char*)(ws + WS_G); bf16_t* MFb = (bf16_t*)(ws + WS_MF);
#pragma unroll
        for (int ai = 0; ai < 2; ++ai) { unsigned long long gw[4][2];
#pragma unroll
            for (int m = 0; m < 4; ++m)
#pragma unroll
                for (int bj = 0; bj < 2; ++bj) gw[m][bj] = *(const unsigned long long*)(G + (row0 + ai * HALF + m * 16) * 3072 + col0 + 32 * bj);
#pragma unroll
            for (int m = 0; m < 4; ++m) { const size_t row = row0 + ai * HALF + m * 16;
#pragma unroll
                for (int bj = 0; bj < 2; ++bj) { const int col = col0 + 32 * bj;
                    const unsigned glo = (unsigned)gw[m][bj], ghi = (unsigned)(gw[m][bj] >> 32);
                    const f32x4 g0 = (f32x4){(float)(glo & 255u), (float)((glo >> 8) & 255u), (float)((glo >> 16) & 255u), (float)(glo >> 24)} * (1.0f / 255.0f), g1 = (f32x4){(float)(ghi & 255u), (float)((ghi >> 8) & 255u), (float)((ghi >> 16) & 255u), (float)(ghi >> 24)} * (1.0f / 255.0f);
                    *(u32x4*)(MFb + row * 1024 + col) = pk8(acc[ai][bj][m][0] * g0, acc[ai][bj][m][1] * g1); } } }
    }
};
struct EpiBrC {
    static constexpr bool PERM = false, AFTER_DRAIN = false, I8 = false, F8 = false;
    unsigned char* ws;
    __device__ __forceinline__ void operator()(const f32x4 (&acc)[2][2][4][2], const Unit& u, int wr, int wc, int fr, int fq) const {
        const size_t row0 = (size_t)u.pm * BM + wr * 64 + fr; const int col0 = u.pn * BM + 64 * wc + 8 * fq;
        const unsigned char* G = (const unsigned char*)(ws + WS_G) + (1 + u.idx) * 1024; const bf16_t* MFb = (const bf16_t*)(ws + WS_MF); bf16_t* O = (bf16_t*)(ws + (u.idx == 0 ? WS_MF : WS_Q));
#pragma unroll
        for (int ai = 0; ai < 2; ++ai) { unsigned long long gw[4][2]; u32x4 mw[4][2];
#pragma unroll
            for (int m = 0; m < 4; ++m)
#pragma unroll
                for (int bj = 0; bj < 2; ++bj) { const size_t row = row0 + ai * HALF + m * 16; const int col = col0 + 32 * bj;
                    gw[m][bj] = *(const unsigned long long*)(G + row * 3072 + col); mw[m][bj] = *(const u32x4*)(MFb + row * 1024 + col); }
#pragma unroll
            for (int m = 0; m < 4; ++m) { const size_t row = row0 + ai * HALF + m * 16;
#pragma unroll
                for (int bj = 0; bj < 2; ++bj) { const int col = col0 + 32 * bj;
                    const unsigned glo = (unsigned)gw[m][bj], ghi = (unsigned)(gw[m][bj] >> 32); const u32x4 w = mw[m][bj];
                    const f32x4 g0 = (f32x4){(float)(glo & 255u), (float)((glo >> 8) & 255u), (float)((glo >> 16) & 255u), (float)(glo >> 24)} * (1.0f / 255.0f), g1 = (f32x4){(float)(ghi & 255u), (float)((ghi >> 8) & 255u), (float)((ghi >> 16) & 255u), (float)(ghi >> 24)} * (1.0f / 255.0f);
                    const f32x4 m0 = {bf_lo(w.x), bf_hi(w.x), bf_lo(w.y), bf_hi(w.y)}, m1 = {bf_lo(w.z), bf_hi(w.z), bf_lo(w.w), bf_hi(w.w)};
                    *(u32x4*)(O + row * 1024 + col) = pk8(acc[ai][bj][m][0] * g0 + m0, acc[ai][bj][m][1] * g1 + m1); } } }
    }
};

struct EpiRes {
    static constexpr bool PERM = false, AFTER_DRAIN = false, I8 = false, F8 = false;
    const float* xin; float* x; unsigned char* ws; size_t xb_off; size_t dry_off;
    __device__ __forceinline__ void operator()(const f32x4 (&acc)[2][2][4][2], const Unit& u, int wr, int wc, int fr, int fq) const {
        const size_t row0 = (size_t)u.pm * BM + wr * 64 + fr; const int col0 = u.pn * BM + 64 * wc + 8 * fq;
        float* xout = dry_off ? (float*)(ws + dry_off) : x; bf16_t* xb = (bf16_t*)(ws + xb_off); float* ss = (float*)(ws + WS_SS);
#pragma unroll
        for (int ai = 0; ai < 2; ++ai)
#pragma unroll
            for (int m = 0; m < 4; ++m) { const size_t row = row0 + ai * HALF + m * 16; float s2 = 0.f;
#pragma unroll
                for (int bj = 0; bj < 2; ++bj) { const size_t off = row * 1024 + col0 + 32 * bj;
                    const f32x4 a = *(const f32x4*)(xin + off) + acc[ai][bj][m][0], b = *(const f32x4*)(xin + off + 4) + acc[ai][bj][m][1];
                    *(f32x4*)(xout + off) = a; *(f32x4*)(xout + off + 4) = b;
                    if (xb_off) { *(u32x4*)(xb + off) = pk8(a, b); s2 += ((a[0] * a[0] + a[1] * a[1]) + (a[2] * a[2] + a[3] * a[3])) + ((b[0] * b[0] + b[1] * b[1]) + (b[2] * b[2] + b[3] * b[3])); } }
                if (xb_off) { s2 += __shfl_xor(s2, 16); s2 += __shfl_xor(s2, 32); if (fq == 0) ss[row * 16 + u.pn * 4 + wc] = s2; } }
    }
};

struct EpiResB {
    static constexpr bool PERM = false, AFTER_DRAIN = false, I8 = false, F8 = false;
    const float* xf; bf16_t* xs;
    __device__ __forceinline__ void operator()(const f32x4 (&acc)[2][2][4][2], const Unit& u, int wr, int wc, int fr, int fq) const {
        const size_t row0 = (size_t)u.pm * BM + wr * 64 + fr; const int col0 = u.pn * BM + 64 * wc + 8 * fq;
#pragma unroll
        for (int ai = 0; ai < 2; ++ai)
#pragma unroll
            for (int m = 0; m < 4; ++m) { const size_t row = row0 + ai * HALF + m * 16;
#pragma unroll
                for (int bj = 0; bj < 2; ++bj) { const size_t off = row * 1024 + col0 + 32 * bj; f32x4 a, b;
                    if (xf) { a = *(const f32x4*)(xf + off); b = *(const f32x4*)(xf + off + 4); }
                    else { const u32x4 w = *(const u32x4*)(xs + off); a = (f32x4){bf_lo(w.x), bf_hi(w.x), bf_lo(w.y), bf_hi(w.y)}; b = (f32x4){bf_lo(w.z), bf_hi(w.z), bf_lo(w.w), bf_hi(w.w)}; }
                    *(u32x4*)(xs + off) = pk8(a + acc[ai][bj][m][0], b + acc[ai][bj][m][1]); } }
    }
};

template <bool I8_, bool OUT8 = false> struct EpiSwiglu {
    static constexpr bool PERM = false, AFTER_DRAIN = false, I8 = I8_, F8 = false;
    bf16_t* H; int ldc; const PG8_LAS float* rs; const float* cmax; int nh;
    const PG8_LAS int* texp; int t0;
    __device__ __forceinline__ void operator()(const f32x4 (&acc)[2][2][4][2], const Unit& u, int wr, int wc, int fr, int fq) const {
        const int rl = wr * 64 + fr; const size_t row0 = (size_t)u.pm * BM + rl; const int col0 = u.pn * 128 + 32 * wc + 8 * fq;
        f32x4 c1[2], c3[2];
#pragma unroll
        for (int bj = 0; bj < 2; ++bj) { if constexpr (I8_) { const float* cm = cmax + (texp ? (size_t)texp[t0 + u.pm] * 2 * nh : 0) + col0 + 4 * bj; c1[bj] = *(const f32x4*)cm * (1.0f / 127.0f); c3[bj] = *(const f32x4*)(cm + nh) * (OUT8 ? H8_SCALE / 127.0f : 1.0f / 127.0f); } else { c1[bj] = (f32x4){1.f, 1.f, 1.f, 1.f}; c3[bj] = c1[bj]; } }
#pragma unroll
        for (int ai = 0; ai < 2; ++ai)
#pragma unroll
            for (int m = 0; m < 4; ++m) { const float sc = rs[u.idx * 256 + rl + ai * HALF + m * 16]; f32x4 h[2];
#pragma unroll
                for (int bj = 0; bj < 2; ++bj) { const f32x4 a = accf<I8_>(acc[ai][bj][m][0]) * c1[bj] * sc, b = accf<I8_>(acc[ai][bj][m][1]) * c3[bj] * sc;
#pragma unroll
                    for (int j = 0; j < 4; ++j) h[bj][j] = a[j] * sigmoid_f(a[j]) * b[j]; }
                if constexpr (OUT8) {
#pragma unroll
                    for (int bj = 0; bj < 2; ++bj)
#pragma unroll
                        for (int j = 0; j < 4; ++j) h[bj][j] = __builtin_fminf(__builtin_fmaxf(h[bj][j], -448.0f), 448.0f);
                    const unsigned w0 = pk_fp8x4(h[0][0], h[0][1], h[0][2], h[0][3]), w1 = pk_fp8x4(h[1][0], h[1][1], h[1][2], h[1][3]);
                    *(unsigned long long*)((unsigned char*)H + (row0 + ai * HALF + m * 16) * ldc + col0) = (unsigned long long)w0 | ((unsigned long long)w1 << 32);
                } else *(u32x4*)(H + (row0 + ai * HALF + m * 16) * ldc + col0) = pk8(h[0], h[1]); }
    }
};

struct EpiStoreF8 {
    static constexpr bool PERM = false, AFTER_DRAIN = false, I8 = false, F8 = true;
    bf16_t* O; int ldc; const float* cs; const PG8_LAS int* texp; int t0;
    __device__ __forceinline__ void operator()(const f32x4 (&acc)[2][2][4][2], const Unit& u, int wr, int wc, int fr, int fq) const {
        const int rl = wr * 64 + fr; const size_t row0 = (size_t)u.pm * BM + rl; const int col0 = u.pn * BM + 64 * wc + 8 * fq;
        const float* c = cs + (texp ? (size_t)texp[t0 + u.pm] * 1024 : 0) + col0; f32x4 cw[2][2];
#pragma unroll
        for (int bj = 0; bj < 2; ++bj)
#pragma unroll
            for (int n = 0; n < 2; ++n) cw[bj][n] = *(const f32x4*)(c + 32 * bj + 4 * n);
#pragma unroll
        for (int ai = 0; ai < 2; ++ai)
#pragma unroll
            for (int m = 0; m < 4; ++m) { bf16_t* rowp = O + (row0 + ai * HALF + m * 16) * ldc + col0;
#pragma unroll
                for (int bj = 0; bj < 2; ++bj) *(u32x4*)(rowp + 32 * bj) = pk8(acc[ai][bj][m][0] * cw[bj][0], acc[ai][bj][m][1] * cw[bj][1]); }
    }
};
struct EpiResB8 {
    static constexpr bool PERM = false, AFTER_DRAIN = false, I8 = false, F8 = true;
    bf16_t* xs; const float* cs;
    __device__ __forceinline__ void operator()(const f32x4 (&acc)[2][2][4][2], const Unit& u, int wr, int wc, int fr, int fq) const {
        const size_t row0 = (size_t)u.pm * BM + wr * 64 + fr; const int col0 = u.pn * BM + 64 * wc + 8 * fq; f32x4 cw[2][2];
#pragma unroll
        for (int bj = 0; bj < 2; ++bj)
#pragma unroll
            for (int n = 0; n < 2; ++n) cw[bj][n] = *(const f32x4*)(cs + col0 + 32 * bj + 4 * n);
#pragma unroll
        for (int ai = 0; ai < 2; ++ai)
#pragma unroll
            for (int m = 0; m < 4; ++m) { const size_t row = row0 + ai * HALF + m * 16;
#pragma unroll
                for (int bj = 0; bj < 2; ++bj) { const size_t off = row * 1024 + col0 + 32 * bj; const u32x4 w = *(const u32x4*)(xs + off);
                    const f32x4 a = {bf_lo(w.x), bf_hi(w.x), bf_lo(w.y), bf_hi(w.y)}, b = {bf_lo(w.z), bf_hi(w.z), bf_lo(w.w), bf_hi(w.w)};
                    *(u32x4*)(xs + off) = pk8(a + acc[ai][bj][m][0] * cw[bj][0], b + acc[ai][bj][m][1] * cw[bj][1]); } }
    }
};
template <class Epi, class Sched, bool ALIGN_EPI = false, bool SP2 = false>
__device__ __forceinline__ void gemm_phase(PG8_LAS unsigned char* lds, const Gemm g, const Sched& S, const Epi& E) {
    int tid_ = threadIdx.x; asm volatile("" : "+v"(tid_));
    const int tid = tid_, wid = __builtin_amdgcn_readfirstlane(tid >> 6), lane = tid & 63, wr = wid >> 2, wc = wid & 3, fr = lane & 15, fq = lane >> 4;
    const int K = g.K, nt = K / BK;
    unsigned voffA[2], voffB[2];
#pragma unroll
    for (int i = 0; i < 2; ++i) { int R, C; stage_rc(tid * 16 + i * 8192, R, C); const int Rb = Epi::PERM ? ((R & ~31) + perm32(R & 31)) : R;
        voffA[i] = (unsigned)(R * K + C) * 2u; voffB[i] = (unsigned)(Rb * K + C) * 2u; }
    const size_t kstep = (size_t)(BK * 2);
    const size_t hstep = (size_t)HALF * K * 2;
    const size_t tstep = 2 * hstep;
    const unsigned ldsw = (unsigned)wid * 1024u;
    const int aoff = lds_byte(wr * 64 + fr, fq * 8), boff = lds_byte(wc * 32 + fr, fq * 8);
#define PG8_SA(b, h) (((b) * 2 + (h)) * HTB)
#define PG8_SB(b, h) ((4 + (b) * 2 + (h)) * HTB)
#define PG8_STAGE(bufoff, gbase, voff) do { _Pragma("unroll") for (int _i = 0; _i < 2; ++_i) \
        __builtin_amdgcn_global_load_lds((const unsigned*)((const char*)(gbase) + (voff)[_i]), (PG8_LAS unsigned*)(lds + (bufoff) + ldsw + _i * 8192), 16, 0, 0); } while (0)
#define PG8_LDA(dst, b, h) do { if constexpr (Epi::F8) { _Pragma("unroll") for (int m = 0; m < 4; ++m) { const i32x4 lo_ = *(const PG8_LAS i32x4*)(lds + PG8_SA(b, h) + aoff + m * 2048), hi_ = *(const PG8_LAS i32x4*)(lds + PG8_SA(b, h) + aoff + m * 2048 + 1024); dst##8[m] = __builtin_shufflevector(lo_, hi_, 0, 1, 2, 3, 4, 5, 6, 7); } } \
        else { _Pragma("unroll") for (int m = 0; m < 4; ++m) _Pragma("unroll") for (int k = 0; k < 2; ++k) dst[m][k] = *(const PG8_LAS bf16x8*)(lds + PG8_SA(b, h) + aoff + m * 2048 + k * 1024); } } while (0)
#define PG8_LDB(dst, b, h) do { if constexpr (Epi::F8) { _Pragma("unroll") for (int n = 0; n < 2; ++n) { const i32x4 lo_ = *(const PG8_LAS i32x4*)(lds + PG8_SB(b, h) + boff + n * 2048), hi_ = *(const PG8_LAS i32x4*)(lds + PG8_SB(b, h) + boff + n * 2048 + 1024); dst##8[n] = __builtin_shufflevector(lo_, hi_, 0, 1, 2, 3, 4, 5, 6, 7); } } \
        else { _Pragma("unroll") for (int n = 0; n < 2; ++n) _Pragma("unroll") for (int k = 0; k < 2; ++k) dst[n][k] = *(const PG8_LAS bf16x8*)(lds + PG8_SB(b, h) + boff + n * 2048 + k * 1024); } } while (0)
#define PG8_MMA(ai, bj, At, Bt) do { __builtin_amdgcn_s_setprio(1); if constexpr (Epi::F8) { _Pragma("unroll") for (int m = 0; m < 4; ++m) _Pragma("unroll") for (int n = 0; n < 2; ++n) acc[ai][bj][m][n] = mma_f8(Bt##8[n], At##8[m], acc[ai][bj][m][n]); } \
        else { _Pragma("unroll") for (int m = 0; m < 4; ++m) _Pragma("unroll") for (int n = 0; n < 2; ++n) _Pragma("unroll") for (int k = 0; k < 2; ++k) acc[ai][bj][m][n] = mma16<Epi::I8>(Bt[n][k], At[m][k], acc[ai][bj][m][n]); } __builtin_amdgcn_s_setprio(0); } while (0)
#define PG8_WAIT_V(n) asm volatile("s_waitcnt vmcnt(" #n ")" ::: "memory")
#define PG8_WAIT_L(n) asm volatile("s_waitcnt lgkmcnt(" #n ")" ::: "memory")
#define PG8_BAR __builtin_amdgcn_s_barrier()
#define PG8_SCHED __builtin_amdgcn_sched_barrier(0)
    Unit cur, nxt; int ui = 0;
    if (!S.next(0, cur)) return;
    f32x4 acc[2][2][4][2];
#pragma unroll
    for (int a = 0; a < 2; ++a)
#pragma unroll
        for (int b = 0; b < 2; ++b)
#pragma unroll
            for (int m = 0; m < 4; ++m)
#pragma unroll
                for (int n = 0; n < 2; ++n) acc[a][b][m][n] = (f32x4){0.f, 0.f, 0.f, 0.f};
    bf16x8 At[4][2], B0[2][2], B1[2][2];
    i32x8 At8[4], B08[2], B18[2];
    const char* cA = S.aptr(g, cur, tstep); const char* cB = S.bptr(g, cur, tstep);
    S.a_ready(cur);
    if constexpr (SP2) {
        PG8_STAGE(PG8_SB(0, 0), cB, voffB); PG8_STAGE(PG8_SB(0, 1), cB + hstep, voffB); PG8_STAGE(PG8_SA(0, 0), cA, voffA); PG8_STAGE(PG8_SA(0, 1), cA + hstep, voffA);
        if (wr == 1) PG8_BAR;
        PG8_WAIT_V(2); PG8_BAR;
        PG8_STAGE(PG8_SB(1, 0), cB + kstep, voffB); PG8_STAGE(PG8_SA(1, 0), cA + kstep, voffA); PG8_STAGE(PG8_SB(1, 1), cB + hstep + kstep, voffB);
        PG8_WAIT_V(6); PG8_BAR;
    } else {
        PG8_STAGE(PG8_SB(0, 0), cB, voffB); PG8_STAGE(PG8_SA(0, 0), cA, voffA); PG8_STAGE(PG8_SB(0, 1), cB + hstep, voffB); PG8_STAGE(PG8_SA(0, 1), cA + hstep, voffA);
        if (wr == 1) PG8_BAR;
        PG8_WAIT_V(4); PG8_BAR;
        PG8_STAGE(PG8_SB(1, 0), cB + kstep, voffB); PG8_STAGE(PG8_SA(1, 0), cA + kstep, voffA); PG8_STAGE(PG8_SB(1, 1), cB + hstep + kstep, voffB);
        PG8_WAIT_V(6); PG8_BAR;
    }
    for (;;) {
        const bool has_next = S.next(ui + 1, nxt);
        const char* nA = has_next ? S.aptr(g, nxt, tstep) : cA; const char* nB = has_next ? S.bptr(g, nxt, tstep) : cB;
        for (int t = 0; t < nt; t += 2) {
            const bool last = (t == nt - 2);
            const char* a1 = cA + (size_t)(t + 1) * kstep;
            const char* a2 = last ? nA : cA + (size_t)(t + 2) * kstep; const char* b2 = last ? nB : cB + (size_t)(t + 2) * kstep;
            const char* a3 = a2 + kstep; const char* b3 = b2 + kstep;
            if (last && has_next) S.a_ready(nxt);
            if constexpr (SP2) {
            PG8_LDB(B0, 0, 0); PG8_LDB(B1, 0, 1); PG8_SCHED; PG8_LDA(At, 0, 0); PG8_STAGE(PG8_SA(1, 1), a1 + hstep, voffA);
            PG8_WAIT_V(8); PG8_WAIT_L(0); PG8_BAR; PG8_MMA(0, 0, At, B0); PG8_MMA(0, 1, At, B1); PG8_BAR; PG8_SCHED;
            PG8_LDA(At, 0, 1); PG8_STAGE(PG8_SB(0, 0), b2, voffB); PG8_STAGE(PG8_SB(0, 1), b2 + hstep, voffB); PG8_STAGE(PG8_SA(0, 0), a2, voffA);
            PG8_WAIT_V(8); PG8_WAIT_L(0); PG8_BAR; PG8_MMA(1, 0, At, B0); PG8_MMA(1, 1, At, B1); PG8_BAR; PG8_SCHED;
            PG8_LDB(B0, 1, 0); PG8_LDB(B1, 1, 1); PG8_SCHED; PG8_LDA(At, 1, 0); PG8_STAGE(PG8_SA(0, 1), a2 + hstep, voffA);
            PG8_WAIT_V(8); PG8_WAIT_L(0); PG8_BAR; PG8_MMA(0, 0, At, B0); PG8_MMA(0, 1, At, B1); PG8_BAR; PG8_SCHED;
            PG8_LDA(At, 1, 1); PG8_STAGE(PG8_SB(1, 0), b3, voffB); PG8_STAGE(PG8_SB(1, 1), b3 + hstep, voffB); PG8_STAGE(PG8_SA(1, 0), a3, voffA);
            PG8_WAIT_V(8); PG8_WAIT_L(0); PG8_BAR; PG8_MMA(1, 0, At, B0); PG8_MMA(1, 1, At, B1); PG8_BAR; PG8_SCHED;
            } else {
            PG8_LDB(B0, 0, 0); PG8_SCHED; PG8_LDA(At, 0, 0); PG8_STAGE(PG8_SA(1, 1), a1 + hstep, voffA);
            PG8_WAIT_L(8); PG8_BAR; PG8_WAIT_L(0); PG8_MMA(0, 0, At, B0); PG8_BAR; PG8_SCHED;
            PG8_LDB(B1, 0, 1); PG8_STAGE(PG8_SB(0, 0), b2, voffB);
            PG8_BAR; PG8_WAIT_L(0); PG8_MMA(0, 1, At, B1); PG8_BAR;
            PG8_LDA(At, 0, 1); PG8_STAGE(PG8_SA(0, 0), a2, voffA);
            PG8_BAR; PG8_WAIT_L(0); PG8_MMA(1, 0, At, B0); PG8_BAR; PG8_SCHED;
            PG8_STAGE(PG8_SB(0, 1), b2 + hstep, voffB);
            PG8_WAIT_V(6); PG8_BAR; PG8_MMA(1, 1, At, B1); PG8_BAR;
            PG8_LDB(B0, 1, 0); PG8_SCHED; PG8_LDA(At, 1, 0); PG8_STAGE(PG8_SA(0, 1), a2 + hstep, voffA);
            PG8_WAIT_L(8); PG8_BAR; PG8_WAIT_L(0); PG8_MMA(0, 0, At, B0); PG8_BAR; PG8_SCHED;
            PG8_LDB(B1, 1, 1); PG8_STAGE(PG8_SB(1, 0), b3, voffB);
            PG8_BAR; PG8_WAIT_L(0); PG8_MMA(0, 1, At, B1); PG8_BAR;
            PG8_LDA(At, 1, 1); PG8_STAGE(PG8_SA(1, 0), a3, voffA);
            PG8_BAR; PG8_WAIT_L(0); PG8_MMA(1, 0, At, B0); PG8_BAR; PG8_SCHED;
            PG8_STAGE(PG8_SB(1, 1), b3 + hstep, voffB);
            PG8_WAIT_V(6); PG8_BAR; PG8_MMA(1, 1, At, B1); PG8_BAR;
            }
        }
        if constexpr (ALIGN_EPI) { if (wr == 0) PG8_BAR; }
        if constexpr (!Epi::AFTER_DRAIN) { E(acc, cur, wr, wc, fr, fq); S.done(cur); }
        if (!has_next) break;
#pragma unroll
        for (int a = 0; a < 2; ++a)
#pragma unroll
            for (int b = 0; b < 2; ++b)
#pragma unroll
                for (int m = 0; m < 4; ++m)
#pragma unroll
                    for (int n = 0; n < 2; ++n) acc[a][b][m][n] = (f32x4){0.f, 0.f, 0.f, 0.f};
        cur = nxt; cA = nA; cB = nB; ++ui;
        if constexpr (ALIGN_EPI) { if (wr == 1) PG8_BAR; }
    }
    PG8_WAIT_V(0);
    if constexpr (!ALIGN_EPI) { if (wr == 0) PG8_BAR; }
    PG8_BAR;
    if constexpr (Epi::AFTER_DRAIN) { E.fused(acc, cur, wr, wc, fr, fq, lds, wid, lane); S.done(cur); }
#undef PG8_SA
#undef PG8_SB
#undef PG8_STAGE
#undef PG8_LDA
#undef PG8_LDB
#undef PG8_MMA
#undef PG8_WAIT_V
#undef PG8_WAIT_L
#undef PG8_BAR
#undef PG8_SCHED
}
}
#define GAS __attribute__((address_space(1)))
#define LAS __attribute__((address_space(3)))
typedef unsigned short bf16_t;
typedef unsigned v4u __attribute__((ext_vector_type(4)));
typedef float f32x4 __attribute__((ext_vector_type(4)));
typedef float f32x2 __attribute__((ext_vector_type(2)));
#define RLX_AGENT __ATOMIC_RELAXED, __HIP_MEMORY_SCOPE_AGENT
__device__ __forceinline__ float wave_sum(float v) {
#pragma unroll
    for (int o = 1; o < 64; o <<= 1) v += __shfl_xor(v, o);
    return v;
}
__device__ __forceinline__ float ld_f32_agent(const float* p) { return __builtin_bit_cast(float, __builtin_amdgcn_readfirstlane(__hip_atomic_load((const unsigned*)p, RLX_AGENT))); }
__device__ __forceinline__ float ld_f32_plain(const float* p) { return *(const GAS float*)p; }
__device__ __forceinline__ int ld_i32_agent(const int* p) { return (int)__hip_atomic_load((const unsigned*)p, RLX_AGENT); }
using pg8::pk_bf16; using pg8::bf_lo; using pg8::bf_hi;

#define XB_TMO      128
#define XB_XCNT(j)  (256  + 64 * (j))
#define XB_XSUB(j)  (1280 + 64 * (j))
#define XB_XGEN(j)  (2304 + 64 * (j))
#define XB_TOP      3328
#define XB_TOPGEN   3392
#define XCD_BAR_WORDS 3456
#define XB_SPIN_CAP (1u << 18)

__device__ __forceinline__ unsigned xb_ld(unsigned* p)              { return __hip_atomic_load(p, __ATOMIC_RELAXED, __HIP_MEMORY_SCOPE_AGENT); }
__device__ __forceinline__ unsigned xb_add(unsigned* p, unsigned v) { return __hip_atomic_fetch_add(p, v, __ATOMIC_RELAXED, __HIP_MEMORY_SCOPE_AGENT); }
__device__ __forceinline__ unsigned xb_xcc_id() { return (unsigned)__builtin_amdgcn_s_getreg((3 << 11) | 20) & 0xFu; }
#define XB_SPIN(cond, bar) do { unsigned _sp = 0; while (cond) { __builtin_amdgcn_s_sleep(1); \
    if ((++_sp & 255u) == 0u) { if (xb_ld(&(bar)[XB_TMO])) break; if (_sp > XB_SPIN_CAP) { atomicAdd(&(bar)[XB_TMO], 1u); break; } } } } while (0)

struct XcdBarrier {
    unsigned* bar; unsigned x;
    volatile LAS unsigned* st;
};

__device__ __forceinline__ XcdBarrier xcd_barrier_post(unsigned* bar, volatile LAS unsigned* st) {
    XcdBarrier b; b.bar = bar; b.x = xb_xcc_id(); b.st = st;
    if (threadIdx.x == 0) (void)xb_add(&bar[XB_XCNT(b.x)], 1u);
    return b;
}
__device__ __forceinline__ void xcd_barrier_complete(unsigned* bar, unsigned x, unsigned& nloc, unsigned& nx) {
    const unsigned G = gridDim.x * gridDim.y * gridDim.z;
    unsigned sum, cnt, mine, sp = 0u;
    for (;;) {
        sum = 0u; cnt = 0u; mine = 0u;
#pragma unroll
        for (unsigned j = 0; j < 16; ++j) { const unsigned c = xb_ld(&bar[XB_XCNT(j)]); sum += c; cnt += (c > 0u) ? 1u : 0u; mine = (j == x) ? c : mine; }
        if (sum == G) break;
        __builtin_amdgcn_s_sleep(1);
        if ((++sp & 255u) == 0u) { if (xb_ld(&bar[XB_TMO])) break; if (sp > XB_SPIN_CAP) { atomicAdd(&bar[XB_TMO], 1u); break; } }
    }
    nloc = mine > 0u ? mine : 1u; nx = cnt > 0u ? cnt : 1u;
}

__device__ __forceinline__ void xcd_barrier(const XcdBarrier& b) {
    asm volatile("s_waitcnt vmcnt(0)" ::: "memory");
    __syncthreads();
    if (threadIdx.x == 0) {
        unsigned* bar = b.bar;
        __builtin_amdgcn_s_waitcnt(0);
        unsigned nloc = b.st[0], nx = b.st[1];
        if (nloc == 0u) { xcd_barrier_complete(bar, b.x, nloc, nx); b.st[0] = nloc; b.st[1] = nx; }
        const unsigned old = xb_add(&bar[XB_XSUB(b.x)], 1u);
        const unsigned gen = old / nloc;
        if (old + 1u == (gen + 1u) * nloc) {
            __builtin_amdgcn_fence(__ATOMIC_RELEASE, "agent");
            asm volatile("s_waitcnt vmcnt(0)" ::: "memory");
            const unsigned og = xb_add(&bar[XB_TOP], 1u);
            const unsigned tg = og / nx;
            if (og + 1u == (tg + 1u) * nx) xb_add(&bar[XB_TOPGEN], 1u);
            else XB_SPIN(xb_ld(&bar[XB_TOPGEN]) == tg, bar);
            __builtin_amdgcn_fence(__ATOMIC_ACQUIRE, "agent");
            xb_add(&bar[XB_XGEN(b.x)], 1u);
            asm volatile("s_waitcnt vmcnt(0)" ::: "memory");
        } else {
            XB_SPIN(xb_ld(&bar[XB_XGEN(b.x)]) == gen, bar);
            __builtin_amdgcn_fence(__ATOMIC_ACQUIRE, "agent");
            asm volatile("s_waitcnt vmcnt(0)" ::: "memory");
        }
    }
    __syncthreads();
}


struct Args { const float* in[31]; float* out; unsigned char* ws; int ph_lo, ph_hi; };

struct TJob { unsigned long long src, dst, gain; int K, N, ld, map, colbase, start, q8, smax, startq, f8, startf; };
constexpr int NJOBS = 41;
__device__ __forceinline__ void make_job(int j, const Args& a, TJob& o) {
    unsigned char* ws = a.ws; const float* src; void* dst; const float* gain = nullptr; o.map = 0; o.colbase = 0; o.q8 = 0; o.smax = 0; o.f8 = 0;
    if (j < 14) { const int l = j / 7, t = j % 7;
        if (t == 0)      { src = a.in[5] + (size_t)l * D * 4096; o.K = D; o.N = 4096; dst = ws + WS_W1T + l * 14 * MiB; gain = a.in[2] + l * D; o.q8 = I8_A; o.smax = SW_G1 + l * 7168; }
        else if (t == 1) { src = a.in[6] + (size_t)l * D * 3072; o.K = D; o.N = 3072; dst = ws + WS_W1T + l * 14 * MiB; gain = a.in[2] + l * D; o.colbase = 4096; o.q8 = I8_A; o.smax = SW_G1 + l * 7168 + 4096; }
        else if (t == 2) { src = a.in[19] + (size_t)l * D * 1024; o.K = D; o.N = 1024; dst = ws + WS_WMEMKV + l * 2 * MiB; gain = a.in[3] + l * D; }
        else if (t == 3) { src = a.in[20] + (size_t)l * 1024 * D; o.K = 1024; o.N = D; dst = ws + WS_WBRDA + l * 2 * MiB; }
        else if (t == 4) { src = a.in[21] + (size_t)l * 512 * D; o.K = 512; o.N = D; dst = ws + WS_WBRPOOL + l * 1 * MiB; }
        else if (t == 5) { src = a.in[22] + (size_t)l * 512 * D; o.K = 512; o.N = D; dst = ws + WS_WBRMEM + l * 1 * MiB; }
        else             { src = a.in[23] + (size_t)l * D * D; o.K = D; o.N = D; dst = ws + WS_WOUT + l * 2 * MiB; }
    } else if (j < 17) { const int t = j - 14;
        if (t < 2) { src = a.in[24 + t]; o.K = D; o.N = FFD; dst = ws + WS_WFF13; gain = a.in[4]; o.map = 1 + t; o.q8 = I8_E; o.smax = SW_FF + t * FFD; }
        else       { src = a.in[26]; o.K = FFD; o.N = D; dst = ws + WS_WFF2; o.f8 = 1; o.smax = SW_W2 + 8 * 1024; }
    } else { const int e = (j - 17) / 3, t = (j - 17) % 3;
        if (t < 2) { src = a.in[28 + t] + (size_t)e * D * FFE; o.K = D; o.N = FFE; dst = ws + WS_WMOE13 + (size_t)e * 7 * MiB; gain = a.in[4] + D; o.map = 1 + t; o.q8 = USE_I8; o.smax = SW_MOE + e * 2 * FFE + t * FFE; }
        else       { src = a.in[30] + (size_t)e * FFE * D; o.K = FFE; o.N = D; dst = ws + WS_WMOE2 + (size_t)e * 7 * MiB; o.f8 = 1; o.smax = SW_W2 + e * 1024; }
    }
    o.src = (unsigned long long)src; o.dst = (unsigned long long)dst; o.gain = (unsigned long long)gain; o.ld = o.N; o.start = 0; o.startq = 0; o.startf = 0;
}
__device__ __forceinline__ int bt_row_std(int C) { const int c = C & 255; return (C & ~255) + 128 * ((c >> 5) & 1) + 32 * (c >> 6) + 16 * ((c >> 2) & 1) + 4 * ((c >> 3) & 3) + (c & 3); }
__device__ __forceinline__ int bt_row_swiglu(int h, int which) { const int hl = h & 127; return 256 * (h >> 7) + 128 * ((hl >> 2) & 1) + 32 * (hl >> 5) + 16 * which + 4 * ((hl >> 3) & 3) + (hl & 3); }
struct TileRef { const GAS float* src; GAS bf16_t* dst; const GAS float* gain; int K, ld, map, colbase, k0, n0, q8, smax; };
template <bool QONLY> __device__ __forceinline__ void tile_decode(const LAS TJob* jobs, int& j, int it, TileRef& r) {
    if constexpr (QONLY) { while (it >= jobs[j + 1].startq) ++j; } else { while (it >= jobs[j + 1].start) ++j; }
    const LAS TJob* jb = jobs + j; const int item = it - (QONLY ? jb->startq : jb->start), nblk = jb->N >> 6;
    r.src = (const GAS float*)jb->src; r.dst = (GAS bf16_t*)jb->dst; r.gain = (const GAS float*)jb->gain; r.K = jb->K; r.ld = jb->ld; r.map = jb->map; r.colbase = jb->colbase; r.q8 = jb->q8; r.smax = jb->smax;
    r.k0 = (item / nblk) * 64; r.n0 = (item % nblk) * 64;
}
__device__ __forceinline__ void tile_load(const TileRef& r, int lane, f32x4 (&v)[16]) {
    const GAS float* p = r.src + (size_t)(r.k0 + (lane >> 4)) * r.ld + r.n0 + 4 * (lane & 15);
#pragma unroll
    for (int i = 0; i < 16; ++i) v[i] = __builtin_nontemporal_load((const GAS f32x4*)(p + (size_t)(4 * i) * r.ld));
}
__device__ __forceinline__ void tile_store(const TileRef& r, int lane, const f32x4 (&v)[16], LAS float* scr) {
#pragma unroll
    for (int i = 0; i < 16; ++i) { LAS float* d = scr + (4 * i + (lane >> 4)) * 65 + 4 * (lane & 15); d[0] = v[i][0]; d[1] = v[i][1]; d[2] = v[i][2]; d[3] = v[i][3]; }
    asm volatile("s_waitcnt lgkmcnt(0)" ::: "memory");
    const int kc = lane & 7;
    f32x4 g0 = {1.f, 1.f, 1.f, 1.f}, g1 = g0;
    if (r.gain) { g0 = *(const GAS f32x4*)(r.gain + r.k0 + 8 * kc); g1 = *(const GAS f32x4*)(r.gain + r.k0 + 8 * kc + 4); }
#pragma unroll
    for (int jj = 0; jj < 8; ++jj) { const int n = (lane >> 3) + 8 * jj; const LAS float* s = scr + (8 * kc) * 65 + n;
        v4u o; o.x = pk_bf16(s[0 * 65] * g0[0], s[1 * 65] * g0[1]); o.y = pk_bf16(s[2 * 65] * g0[2], s[3 * 65] * g0[3]); o.z = pk_bf16(s[4 * 65] * g1[0], s[5 * 65] * g1[1]); o.w = pk_bf16(s[6 * 65] * g1[2], s[7 * 65] * g1[3]);
        const int row = (r.map == 0) ? bt_row_std(r.colbase + r.n0 + n) : bt_row_swiglu(r.n0 + n, r.map - 1);
        *(GAS v4u*)(r.dst + (size_t)row * r.K + r.k0 + 8 * kc) = o; }
    asm volatile("s_waitcnt lgkmcnt(0)" ::: "memory");
}
__device__ __forceinline__ void tile_colmax(const TileRef& r, int lane, const f32x4 (&v)[16], float* cmaxbase) {
    float m0 = 0.f, m1 = 0.f, m2 = 0.f, m3 = 0.f;
#pragma unroll
    for (int i = 0; i < 16; ++i) { const float g = r.gain ? r.gain[r.k0 + 4 * i + (lane >> 4)] : 1.f;
        m0 = fmaxf(m0, fabsf(v[i][0] * g)); m1 = fmaxf(m1, fabsf(v[i][1] * g)); m2 = fmaxf(m2, fabsf(v[i][2] * g)); m3 = fmaxf(m3, fabsf(v[i][3] * g)); }
    m0 = fmaxf(m0, __shfl_xor(m0, 16)); m1 = fmaxf(m1, __shfl_xor(m1, 16)); m2 = fmaxf(m2, __shfl_xor(m2, 16)); m3 = fmaxf(m3, __shfl_xor(m3, 16));
    m0 = fmaxf(m0, __shfl_xor(m0, 32)); m1 = fmaxf(m1, __shfl_xor(m1, 32)); m2 = fmaxf(m2, __shfl_xor(m2, 32)); m3 = fmaxf(m3, __shfl_xor(m3, 32));
    if (lane < 16) { unsigned* p = (unsigned*)(cmaxbase + r.smax + r.n0 + 4 * lane);
        atomicMax(p, __float_as_uint(m0)); atomicMax(p + 1, __float_as_uint(m1)); atomicMax(p + 2, __float_as_uint(m2)); atomicMax(p + 3, __float_as_uint(m3)); }
}
__device__ __forceinline__ unsigned pk_i8x4(float a, float b, float c, float d) {
    const int ia = (int)__builtin_rintf(a), ib = (int)__builtin_rintf(b), ic = (int)__builtin_rintf(c), id = (int)__builtin_rintf(d);
    return (unsigned)(ia & 0xff) | ((unsigned)(ib & 0xff) << 8) | ((unsigned)(ic & 0xff) << 16) | ((unsigned)id << 24);
}
__device__ __forceinline__ void tile_store_q8(const TileRef& r, int lane, const f32x4 (&v)[16], LAS float* scr, const float* cmaxbase) {
#pragma unroll
    for (int i = 0; i < 16; ++i) { const float g = r.gain ? r.gain[r.k0 + 4 * i + (lane >> 4)] : 1.f; LAS float* d = scr + (4 * i + (lane >> 4)) * 65 + 4 * (lane & 15); d[0] = v[i][0] * g; d[1] = v[i][1] * g; d[2] = v[i][2] * g; d[3] = v[i][3] * g; }
    asm volatile("s_waitcnt lgkmcnt(0)" ::: "memory");
    const int kc = lane & 3;
#pragma unroll
    for (int jj = 0; jj < 4; ++jj) { const int n = (lane >> 2) + 16 * jj; const LAS float* s = scr + (16 * kc) * 65 + n;
        const float cm = ld_f32_plain(cmaxbase + r.smax + r.n0 + n), inv = cm > 0.f ? 127.0f / cm : 0.f;
        v4u o; o.x = pk_i8x4(s[0 * 65] * inv, s[1 * 65] * inv, s[2 * 65] * inv, s[3 * 65] * inv); o.y = pk_i8x4(s[4 * 65] * inv, s[5 * 65] * inv, s[6 * 65] * inv, s[7 * 65] * inv);
        o.z = pk_i8x4(s[8 * 65] * inv, s[9 * 65] * inv, s[10 * 65] * inv, s[11 * 65] * inv); o.w = pk_i8x4(s[12 * 65] * inv, s[13 * 65] * inv, s[14 * 65] * inv, s[15 * 65] * inv);
        const int row = (r.map == 0) ? bt_row_std(r.colbase + r.n0 + n) : bt_row_swiglu(r.n0 + n, r.map - 1);
        *(GAS v4u*)((GAS unsigned char*)r.dst + (size_t)row * r.K + r.k0 + 16 * kc) = o; }
    asm volatile("s_waitcnt lgkmcnt(0)" ::: "memory");
}
__device__ __forceinline__ void row_to_i8(const float* xrow, unsigned char* qrow, float* sa, int lane) {
    const f32x4* xr = (const f32x4*)xrow + 4 * lane; f32x4 v[4]; float s = 0.f, mx = 0.f;
#pragma unroll
    for (int j = 0; j < 4; ++j) { v[j] = xr[j]; s += (v[j][0] * v[j][0] + v[j][1] * v[j][1]) + (v[j][2] * v[j][2] + v[j][3] * v[j][3]);
        mx = fmaxf(mx, fmaxf(fmaxf(fabsf(v[j][0]), fabsf(v[j][1])), fmaxf(fabsf(v[j][2]), fabsf(v[j][3])))); }
    s = wave_sum(s);
#pragma unroll
    for (int o = 1; o < 64; o <<= 1) mx = fmaxf(mx, __shfl_xor(mx, o));
    const float inv = mx > 0.f ? 127.0f / mx : 0.f;
    v4u w; w.x = pk_i8x4(v[0][0] * inv, v[0][1] * inv, v[0][2] * inv, v[0][3] * inv); w.y = pk_i8x4(v[1][0] * inv, v[1][1] * inv, v[1][2] * inv, v[1][3] * inv);
    w.z = pk_i8x4(v[2][0] * inv, v[2][1] * inv, v[2][2] * inv, v[2][3] * inv); w.w = pk_i8x4(v[3][0] * inv, v[3][1] * inv, v[3][2] * inv, v[3][3] * inv);
    *((v4u*)qrow + lane) = w;
    if (lane == 0) *sa = mx * (1.0f / 127.0f) * __builtin_amdgcn_rsqf(s * (1.0f / 1024.0f) + 1e-6f);
}
__device__ __forceinline__ void ld16_bf16(const bf16_t* p, f32x4 (&v)[4]) {
    const v4u a = *(const v4u*)p, b = *(const v4u*)(p + 8);
    v[0] = (f32x4){bf_lo(a.x), bf_hi(a.x), bf_lo(a.y), bf_hi(a.y)}; v[1] = (f32x4){bf_lo(a.z), bf_hi(a.z), bf_lo(a.w), bf_hi(a.w)};
    v[2] = (f32x4){bf_lo(b.x), bf_hi(b.x), bf_lo(b.y), bf_hi(b.y)}; v[3] = (f32x4){bf_lo(b.z), bf_hi(b.z), bf_lo(b.w), bf_hi(b.w)};
}
__device__ __forceinline__ void rowb_to_i8(const bf16_t* xrow, unsigned char* qrow, float* sa, int lane) {
    f32x4 v[4]; ld16_bf16(xrow + 16 * lane, v); float s = 0.f, mx = 0.f;
#pragma unroll
    for (int j = 0; j < 4; ++j) { s += (v[j][0] * v[j][0] + v[j][1] * v[j][1]) + (v[j][2] * v[j][2] + v[j][3] * v[j][3]);
        mx = fmaxf(mx, fmaxf(fmaxf(fabsf(v[j][0]), fabsf(v[j][1])), fmaxf(fabsf(v[j][2]), fabsf(v[j][3])))); }
    s = wave_sum(s);
#pragma unroll
    for (int o = 1; o < 64; o <<= 1) mx = fmaxf(mx, __shfl_xor(mx, o));
    const float inv = mx > 0.f ? 127.0f / mx : 0.f;
    v4u w; w.x = pk_i8x4(v[0][0] * inv, v[0][1] * inv, v[0][2] * inv, v[0][3] * inv); w.y = pk_i8x4(v[1][0] * inv, v[1][1] * inv, v[1][2] * inv, v[1][3] * inv);
    w.z = pk_i8x4(v[2][0] * inv, v[2][1] * inv, v[2][2] * inv, v[2][3] * inv); w.w = pk_i8x4(v[3][0] * inv, v[3][1] * inv, v[3][2] * inv, v[3][3] * inv);
    *((v4u*)qrow + lane) = w;
    if (lane == 0) *sa = mx * (1.0f / 127.0f) * __builtin_amdgcn_rsqf(s * (1.0f / 1024.0f) + 1e-6f);
}
__device__ __forceinline__ void phase_quant_rows(const bf16_t* x, unsigned char* ws, int lane, int wave) {
    const int gw = blockIdx.x * NWAVES + wave, NGW = gridDim.x * NWAVES;
    for (int m = gw; m < T; m += NGW) rowb_to_i8(x + (size_t)m * D, ws + WS_QX + (size_t)m * D, (float*)(ws + WS_SA) + m, lane);
}
__device__ __forceinline__ void row_to_bf16_ss(const float* xrow, bf16_t* orow, float* ss16, float* fcopy, int lane) {
    const f32x4* xr = (const f32x4*)xrow + lane; f32x4 v[4]; float s = 0.f;
#pragma unroll
    for (int j = 0; j < 4; ++j) { v[j] = xr[64 * j]; s += (v[j][0] * v[j][0] + v[j][1] * v[j][1]) + (v[j][2] * v[j][2] + v[j][3] * v[j][3]); }
    s = wave_sum(s);
    if (fcopy) { f32x4* fc = (f32x4*)fcopy + lane;
#pragma unroll
        for (int j = 0; j < 4; ++j) fc[64 * j] = v[j]; }
    unsigned long long* o8 = (unsigned long long*)orow + lane;
#pragma unroll
    for (int j = 0; j < 4; ++j) o8[64 * j] = (unsigned long long)pk_bf16(v[j][0], v[j][1]) | ((unsigned long long)pk_bf16(v[j][2], v[j][3]) << 32);
    if (lane < 16) ss16[lane] = (lane == 0) ? s : 0.f;
}
__device__ __forceinline__ void build_jobs(const Args& a, LAS TJob* jobs, int tid) {
    if (tid < NJOBS) { TJob jb; make_job(tid, a, jb); LAS TJob* d = jobs + tid; d->src = jb.src; d->dst = jb.dst; d->gain = jb.gain; d->K = jb.K; d->N = jb.N; d->ld = jb.ld; d->map = jb.map; d->colbase = jb.colbase; d->q8 = jb.q8; d->smax = jb.smax; d->start = 0; d->startq = 0; d->f8 = jb.f8; d->startf = 0; }
    __syncthreads();
    if (tid == 0) { int s = 0, q = 0, f = 0; for (int j = 0; j < NJOBS; ++j) { jobs[j].start = s; jobs[j].startq = q; jobs[j].startf = f; if (jobs[j].q8) q += jobs[j].N / 64; else if (jobs[j].f8) f += jobs[j].N / 16; else s += (jobs[j].K / 64) * (jobs[j].N / 64); }
        jobs[NJOBS].start = s; jobs[NJOBS].startq = q; jobs[NJOBS].startf = f; }
    __syncthreads();
}
__device__ __forceinline__ void strip_q8(const LAS TJob* jobs, int& j, int st, LAS unsigned char* lds, int tid, int lane, int wave, float* cmaxbase) {
    while (st >= jobs[j + 1].startq) ++j;
    const LAS TJob* jb = jobs + j;
    TileRef r; r.src = (const GAS float*)jb->src; r.dst = (GAS bf16_t*)jb->dst; r.gain = (const GAS float*)jb->gain; r.K = jb->K; r.ld = jb->ld; r.map = jb->map; r.colbase = jb->colbase; r.q8 = 1; r.smax = jb->smax;
    r.n0 = (st - jb->startq) * 64; r.k0 = 128 * wave;
    LAS float* scr = (LAS float*)(lds + wave * 17408); LAS float* pmax = (LAS float*)(lds + 8 * 17408 + 4096); LAS float* cmf = pmax + 8 * 64;
    f32x4 v0[16], v1[16];
    tile_load(r, lane, v0); r.k0 += 64; tile_load(r, lane, v1); r.k0 -= 64;
    float m0 = 0.f, m1 = 0.f, m2 = 0.f, m3 = 0.f;
#pragma unroll
    for (int i = 0; i < 16; ++i) { const float g0 = r.gain ? r.gain[r.k0 + 4 * i + (lane >> 4)] : 1.f, g1 = r.gain ? r.gain[r.k0 + 64 + 4 * i + (lane >> 4)] : 1.f;
        v0[i] = v0[i] * g0; v1[i] = v1[i] * g1;
        m0 = fmaxf(m0, fmaxf(fabsf(v0[i][0]), fabsf(v1[i][0]))); m1 = fmaxf(m1, fmaxf(fabsf(v0[i][1]), fabsf(v1[i][1]))); m2 = fmaxf(m2, fmaxf(fabsf(v0[i][2]), fabsf(v1[i][2]))); m3 = fmaxf(m3, fmaxf(fabsf(v0[i][3]), fabsf(v1[i][3]))); }
    m0 = fmaxf(m0, __shfl_xor(m0, 16)); m1 = fmaxf(m1, __shfl_xor(m1, 16)); m2 = fmaxf(m2, __shfl_xor(m2, 16)); m3 = fmaxf(m3, __shfl_xor(m3, 16));
    m0 = fmaxf(m0, __shfl_xor(m0, 32)); m1 = fmaxf(m1, __shfl_xor(m1, 32)); m2 = fmaxf(m2, __shfl_xor(m2, 32)); m3 = fmaxf(m3, __shfl_xor(m3, 32));
    __syncthreads();
    if (lane < 16) *(LAS f32x4*)(pmax + wave * 64 + 4 * lane) = (f32x4){m0, m1, m2, m3};
    __syncthreads();
    if (tid < 64) { float m = pmax[tid];
#pragma unroll
        for (int w = 1; w < 8; ++w) m = fmaxf(m, pmax[w * 64 + tid]);
        cmf[tid] = m; cmaxbase[r.smax + r.n0 + tid] = m; }
    __syncthreads();
#pragma unroll
    for (int h = 0; h < 2; ++h) {
#pragma unroll
        for (int i = 0; i < 16; ++i) { LAS float* d = scr + (4 * i + (lane >> 4)) * 65 + 4 * (lane & 15); const f32x4 x = h ? v1[i] : v0[i]; d[0] = x[0]; d[1] = x[1]; d[2] = x[2]; d[3] = x[3]; }
        asm volatile("s_waitcnt lgkmcnt(0)" ::: "memory");
        const int kc = lane & 3;
#pragma unroll
        for (int jj = 0; jj < 4; ++jj) { const int n = (lane >> 2) + 16 * jj; const LAS float* s = scr + (16 * kc) * 65 + n;
            const float cm = cmf[n], inv = cm > 0.f ? 127.0f / cm : 0.f;
            v4u o; o.x = pk_i8x4(s[0 * 65] * inv, s[1 * 65] * inv, s[2 * 65] * inv, s[3 * 65] * inv); o.y = pk_i8x4(s[4 * 65] * inv, s[5 * 65] * inv, s[6 * 65] * inv, s[7 * 65] * inv);
            o.z = pk_i8x4(s[8 * 65] * inv, s[9 * 65] * inv, s[10 * 65] * inv, s[11 * 65] * inv); o.w = pk_i8x4(s[12 * 65] * inv, s[13 * 65] * inv, s[14 * 65] * inv, s[15 * 65] * inv);
            const int row = (r.map == 0) ? bt_row_std(r.colbase + r.n0 + n) : bt_row_swiglu(r.n0 + n, r.map - 1);
            *(GAS v4u*)((GAS unsigned char*)r.dst + (size_t)row * r.K + r.k0 + 64 * h + 16 * kc) = o; }
        asm volatile("s_waitcnt lgkmcnt(0)" ::: "memory");
    }
}
__device__ __forceinline__ void strip_f8(const LAS TJob* jobs, int& j, int st, LAS unsigned char* lds, int tid, int lane, int wave, float* cmaxbase) {
    while (st >= jobs[j + 1].startf) ++j;
    const LAS TJob* jb = jobs + j;
    const GAS float* src = (const GAS float*)jb->src; GAS unsigned char* dst = (GAS unsigned char*)jb->dst; const int K = jb->K, n0 = (st - jb->startf) * 16, smax = jb->smax, nq = K >> 2;
    const int c4 = tid & 3, q0 = tid >> 2;
    constexpr int RS8 = 3584 + 16;
    LAS float* pmax = (LAS float*)(lds + 8 * 17408 + 4096); LAS float* cmf = pmax + 8 * 16;
    f32x4 v[7][4];
#pragma unroll
    for (int i = 0; i < 7; ++i) { const int q = q0 + 128 * i; const GAS float* p = src + (size_t)(4 * q) * 1024 + n0 + 4 * c4;
#pragma unroll
        for (int kk = 0; kk < 4; ++kk) v[i][kk] = (q < nq) ? __builtin_nontemporal_load((const GAS f32x4*)(p + kk * 1024)) : (f32x4){0.f, 0.f, 0.f, 0.f}; }
    float m0 = 0.f, m1 = 0.f, m2 = 0.f, m3 = 0.f;
#pragma unroll
    for (int i = 0; i < 7; ++i)
#pragma unroll
        for (int kk = 0; kk < 4; ++kk) { m0 = fmaxf(m0, fabsf(v[i][kk][0])); m1 = fmaxf(m1, fabsf(v[i][kk][1])); m2 = fmaxf(m2, fabsf(v[i][kk][2])); m3 = fmaxf(m3, fabsf(v[i][kk][3])); }
#pragma unroll
    for (int o = 4; o < 64; o <<= 1) { m0 = fmaxf(m0, __shfl_xor(m0, o)); m1 = fmaxf(m1, __shfl_xor(m1, o)); m2 = fmaxf(m2, __shfl_xor(m2, o)); m3 = fmaxf(m3, __shfl_xor(m3, o)); }
    __syncthreads();
    if (lane < 4) *(LAS f32x4*)(pmax + wave * 16 + 4 * lane) = (f32x4){m0, m1, m2, m3};
    __syncthreads();
    if (tid < 16) { float m = pmax[tid];
#pragma unroll
        for (int w = 1; w < 8; ++w) m = fmaxf(m, pmax[w * 16 + tid]);
        cmf[tid] = m; cmaxbase[smax + n0 + tid] = m * (1.0f / (256.0f * H8_SCALE)); }
    __syncthreads();
    { const f32x4 cm = *(const LAS f32x4*)(cmf + 4 * c4); f32x4 inv;
#pragma unroll
      for (int jj = 0; jj < 4; ++jj) inv[jj] = cm[jj] > 0.f ? 256.0f / cm[jj] : 0.f;
#pragma unroll
      for (int i = 0; i < 7; ++i) { const int q = q0 + 128 * i;
          if (q < nq) {
#pragma unroll
              for (int jj = 0; jj < 4; ++jj) *(LAS unsigned*)(lds + (4 * c4 + jj) * RS8 + 4 * q) = pg8::pk_fp8x4(v[i][0][jj] * inv[jj], v[i][1][jj] * inv[jj], v[i][2][jj] * inv[jj], v[i][3][jj] * inv[jj]); } } }
    __syncthreads();
    { const int row = tid >> 5, t32 = tid & 31; GAS unsigned char* drow = dst + (size_t)bt_row_std(n0 + row) * K;
#pragma unroll
      for (int it = 0; it < 7; ++it) { const int ch = t32 + 32 * it; if (ch * 16 < K) *(GAS v4u*)(drow + ch * 16) = *(const LAS v4u*)(lds + row * RS8 + ch * 16); } }
}
__device__ __forceinline__ void phase_prologue(const Args& a, LAS unsigned char* lds, int tid, int lane, int wave) {
    unsigned char* ws = a.ws;
    LAS TJob* jobs = (LAS TJob*)(lds + 8 * 17408);
    build_jobs(a, jobs, tid);
    const int gw = blockIdx.x * NWAVES + wave, NGW = gridDim.x * NWAVES;
    { const int nstrip = jobs[NJOBS].startq; int js = 0;
      for (int st = blockIdx.x; st < nstrip; st += gridDim.x) strip_q8(jobs, js, st, lds, tid, lane, wave, (float*)(ws + WS_SW));
      __syncthreads(); }
    { const int nstrip = jobs[NJOBS].startf; int js = 0;
      const int first = (int)(((unsigned)blockIdx.x + gridDim.x - (unsigned)(jobs[NJOBS].startq % (int)gridDim.x)) % gridDim.x);
      for (int st = first; st < nstrip; st += gridDim.x) strip_f8(jobs, js, st, lds, tid, lane, wave, (float*)(ws + WS_SW));
      __syncthreads(); }
    {
        LAS float* scr = (LAS float*)(lds + wave * 17408);
        const int total = jobs[NJOBS].start; int j = 0;
        if (gw < total) {
            TileRef cur, nxt; f32x4 v[16], vn[16];
            tile_decode<false>(jobs, j, gw, cur); tile_load(cur, lane, v);
#pragma unroll 1
            for (int it = gw; it < total; it += NGW) {
                const bool more = it + NGW < total;
                if (more) { tile_decode<false>(jobs, j, it + NGW, nxt); tile_load(nxt, lane, vn); }
                tile_store(cur, lane, v, scr);
                if (more) { cur = nxt;
#pragma unroll
                    for (int i = 0; i < 16; ++i) v[i] = vn[i]; }
            }
        }
    }
#if I8_A
    for (int m = gw; m < T; m += NGW) row_to_i8(a.in[0] + (size_t)m * D, ws + WS_QX + (size_t)m * D, (float*)(ws + WS_SA) + m, lane);
#else
    for (int m = gw; m < T; m += NGW) row_to_bf16_ss(a.in[0] + (size_t)m * D, (bf16_t*)(ws + WS_XB) + (size_t)m * D, (float*)(ws + WS_SS) + (size_t)m * 16, nullptr, lane);
#endif
    for (int m = gw; m < NBATCH * MEML; m += NGW) row_to_bf16_ss(a.in[1] + (size_t)m * D, (bf16_t*)(ws + WS_MEMBF) + (size_t)m * D, (float*)(ws + WS_SSM) + (size_t)m * 16, nullptr, lane);
    {
        float* prm = (float*)(ws + WS_PARAM); const int gt = blockIdx.x * NTHR + tid, NGT = gridDim.x * NTHR;
        for (int i = gt; i < PB_END; i += NGT) { float v;
            if (i < PB_GQ) v = a.in[7][i]; else if (i < PB_GK) v = a.in[8][i - PB_GQ]; else if (i < PB_GOUT) v = a.in[9][i - PB_GK]; else if (i < PB_POOLS) v = a.in[14][i - PB_GOUT];
            else if (i < PB_MQN) v = a.in[16][i - PB_POOLS]; else if (i < PB_MKN) v = a.in[17][i - PB_MQN]; else if (i < PB_GFFN1) v = a.in[18][i - PB_MKN]; else if (i < PB_WR) v = a.in[4][D + i - PB_GFFN1];
            else if (i < PB_POOLW) v = a.in[27][i - PB_WR]; else v = a.in[15][i - PB_POOLW];
            prm[i] = v; }
        bf16_t* pwt = (bf16_t*)(ws + WS_POOLWT);
        for (int i = gt; i < 2 * 4 * 128 * 128; i += NGT) { const int lg = i >> 14, dout = (i >> 7) & 127, cc = i & 127; pwt[i] = (bf16_t)(pk_bf16(a.in[15][((size_t)lg * 128 + cc) * 128 + dout], 0.f) & 0xffffu); }
    }
    if (blockIdx.x == 0 && wave == 0) {
        float* sc = (float*)(ws + WS_SC);
        for (int l = 0; l < 2; ++l) {
            const float a1 = wave_sum(a.in[10][l * 64 + lane] * a.in[11][l * 64 + lane]), a2 = wave_sum(a.in[12][l * 64 + lane] * a.in[13][l * 64 + lane]);
            const float lam0 = (l == 0) ? 0.2f : (0.8f - 0.6f * 0.7408182206817179f);
            const float lam = __expf(a1) - __expf(a2) + lam0;
            float m0 = fabsf(a.in[8][l * 128 + lane] * a.in[9][l * 128 + lane]), m1 = fabsf(a.in[8][l * 128 + 64 + lane] * a.in[9][l * 128 + 64 + lane]);
            float mm = fmaxf(fabsf(a.in[17][l * 128 + lane] * a.in[18][l * 128 + lane]), fabsf(a.in[17][l * 128 + 64 + lane] * a.in[18][l * 128 + 64 + lane]));
#pragma unroll
            for (int o = 1; o < 64; o <<= 1) { m0 = fmaxf(m0, __shfl_xor(m0, o)); m1 = fmaxf(m1, __shfl_xor(m1, o)); mm = fmaxf(mm, __shfl_xor(mm, o)); }
            if (lane == 0) { sc[l * 8 + 0] = lam; sc[l * 8 + 1] = m0 * 64.f * QSCALE; sc[l * 8 + 2] = m1 * 64.f * QSCALE; sc[l * 8 + 3] = mm * 128.f * MEMSCALE; sc[l * 8 + 4] = 1.0f - lam0; }
        }
    }
}

__device__ __forceinline__ void unpack16(const bf16_t* src, float (&f)[16]) {
    const v4u a = *(const v4u*)src, b = *(const v4u*)(src + 8);
    f[0] = bf_lo(a.x); f[1] = bf_hi(a.x); f[2] = bf_lo(a.y); f[3] = bf_hi(a.y); f[4] = bf_lo(a.z); f[5] = bf_hi(a.z); f[6] = bf_lo(a.w); f[7] = bf_hi(a.w);
    f[8] = bf_lo(b.x); f[9] = bf_hi(b.x); f[10] = bf_lo(b.y); f[11] = bf_hi(b.y); f[12] = bf_lo(b.z); f[13] = bf_hi(b.z); f[14] = bf_lo(b.w); f[15] = bf_hi(b.w);
}
template <bool DIFF>
__device__ __forceinline__ void naive_attn_unit(LAS unsigned char* lds, int tid, const bf16_t* Qg, int ldq, const bf16_t* Kg, int ldk, const bf16_t* Vg, int ldv, bf16_t* Og, int ldo,
                                                int ntiles, int qpos0, const float* qmulA, const float* qmulB, const float* qss, float slope2, float bnd0, float bnd1, float lam, const float* gout, float outmul) {
    constexpr int QW = 4;
    LAS float* Lq = (LAS float*)lds; LAS float* Lk = Lq + 32 * 128; LAS float* Lv = Lk + 64 * 129; LAS float* Lp = Lv + 64 * 128; LAS float* Lrk = Lp + 8 * QW * 2 * 64;
    const int lane = tid & 63, wid = tid >> 6, r = tid >> 3, sg = tid & 7;
    __syncthreads();
    if (tid < 256) { float f[16]; unpack16(Qg + (size_t)r * ldq + sg * 16, f); float mul = 1.f;
      if (!DIFF) { const float s = qss[r * 8] + qss[r * 8 + 1]; mul = __builtin_amdgcn_rsqf(s * (1.f / 128.f) + 1e-6f) * MEMSCALE; }
#pragma unroll
      for (int i = 0; i < 16; ++i) Lq[r * 128 + sg * 16 + i] = DIFF ? f[i] : f[i] * mul * qmulA[sg * 16 + i] * qmulB[sg * 16 + i]; }
    float o0[QW][2], o1[QW][2], l0[QW], l1[QW];
#pragma unroll
    for (int q = 0; q < QW; ++q) { o0[q][0] = o0[q][1] = o1[q][0] = o1[q][1] = 0.f; l0[q] = l1[q] = 0.f; }
#pragma unroll 1
    for (int j = 0; j < ntiles; ++j) {
        __syncthreads();
        { float f[16]; unpack16(Kg + (size_t)(j * 64 + r) * ldk + sg * 16, f);
#pragma unroll
          for (int i = 0; i < 16; ++i) Lk[r * 129 + sg * 16 + i] = f[i];
          unpack16(Vg + (size_t)(j * 64 + r) * ldv + sg * 16, f);
#pragma unroll
          for (int i = 0; i < 16; ++i) Lv[r * 128 + sg * 16 + i] = f[i]; }
        __syncthreads();
        if (!DIFF) { if (tid < 64) { float s = 0.f;
#pragma unroll 4
            for (int d = 0; d < 128; ++d) { const float x = Lk[tid * 129 + d]; s += x * x; } Lrk[tid] = __builtin_amdgcn_rsqf(s * (1.f / 128.f) + 1e-6f); } __syncthreads(); }
        float s0[QW], s1[QW];
#pragma unroll
        for (int q = 0; q < QW; ++q) { s0[q] = 0.f; s1[q] = 0.f; }
#pragma unroll 1
        for (int d4 = 0; d4 < 16; ++d4) {
            const float k0 = Lk[lane * 129 + 4 * d4], k1 = Lk[lane * 129 + 4 * d4 + 1], k2 = Lk[lane * 129 + 4 * d4 + 2], k3 = Lk[lane * 129 + 4 * d4 + 3];
            const float e0 = Lk[lane * 129 + 64 + 4 * d4], e1 = Lk[lane * 129 + 64 + 4 * d4 + 1], e2 = Lk[lane * 129 + 64 + 4 * d4 + 2], e3 = Lk[lane * 129 + 64 + 4 * d4 + 3];
#pragma unroll
            for (int q = 0; q < QW; ++q) { const f32x4 qa = *(const LAS f32x4*)&Lq[(wid * QW + q) * 128 + 4 * d4], qb = *(const LAS f32x4*)&Lq[(wid * QW + q) * 128 + 64 + 4 * d4];
                s0[q] += (qa[0] * k0 + qa[1] * k1) + (qa[2] * k2 + qa[3] * k3); s1[q] += (qb[0] * e0 + qb[1] * e1) + (qb[2] * e2 + qb[3] * e3); }
        }
        const int kpos = j * 64 + lane;
#pragma unroll
        for (int q = 0; q < QW; ++q) { float p0, p1;
            if (DIFF) { const int qpos = qpos0 + wid * QW + q; const float bias = -slope2 * fabsf((float)(qpos - kpos)); p0 = __builtin_amdgcn_exp2f(s0[q] + bias - bnd0); p1 = __builtin_amdgcn_exp2f(s1[q] + bias - bnd1); }
            else { p0 = __builtin_amdgcn_exp2f((s0[q] + s1[q]) * Lrk[lane] - bnd0); p1 = 0.f; }
            l0[q] += p0; l1[q] += p1; Lp[((wid * QW + q) * 2 + 0) * 64 + lane] = p0; Lp[((wid * QW + q) * 2 + 1) * 64 + lane] = p1; }
        asm volatile("s_waitcnt lgkmcnt(0)" ::: "memory");
#pragma unroll 1
        for (int k4 = 0; k4 < 16; ++k4) {
            f32x2 v[4];
#pragma unroll
            for (int i = 0; i < 4; ++i) v[i] = *(const LAS f32x2*)&Lv[(4 * k4 + i) * 128 + 2 * lane];
#pragma unroll
            for (int q = 0; q < QW; ++q) { const f32x4 pa = *(const LAS f32x4*)&Lp[((wid * QW + q) * 2 + 0) * 64 + 4 * k4];
                o0[q][0] += (pa[0] * v[0][0] + pa[1] * v[1][0]) + (pa[2] * v[2][0] + pa[3] * v[3][0]); o0[q][1] += (pa[0] * v[0][1] + pa[1] * v[1][1]) + (pa[2] * v[2][1] + pa[3] * v[3][1]);
                if (DIFF) { const f32x4 pb = *(const LAS f32x4*)&Lp[((wid * QW + q) * 2 + 1) * 64 + 4 * k4];
                    o1[q][0] += (pb[0] * v[0][0] + pb[1] * v[1][0]) + (pb[2] * v[2][0] + pb[3] * v[3][0]); o1[q][1] += (pb[0] * v[0][1] + pb[1] * v[1][1]) + (pb[2] * v[2][1] + pb[3] * v[3][1]); } }
        }
    }
#pragma unroll
    for (int q = 0; q < QW; ++q) { const float L0 = wave_sum(l0[q]); float x = o0[q][0] / L0, y = o0[q][1] / L0;
        if (DIFF) { const float L1 = wave_sum(l1[q]); x -= lam * (o1[q][0] / L1); y -= lam * (o1[q][1] / L1);
            const float ss = wave_sum(x * x + y * y); const float rr = __builtin_amdgcn_rsqf(ss * (1.f / 128.f) + 1e-6f) * outmul; x *= rr * gout[2 * lane]; y *= rr * gout[2 * lane + 1]; }
        *(unsigned*)(Og + (size_t)(wid * QW + q) * ldo + 2 * lane) = pk_bf16(x, y); }
}
__device__ __forceinline__ void naive_pool_unit(LAS unsigned char* lds, int tid, const bf16_t* Pg  , bf16_t* Og  , const float* W  , const float* scale  , int tok0, int g) {
    LAS float* Lp = (LAS float*)lds; LAS float* Ld = Lp + 80 * 128;
    const int w = 2 << g, pos0 = tok0 & (SEQ - 1);
    __syncthreads();
    for (int i = tid; i < 80 * 8; i += NTHR) { const int rr = i >> 3, sg = i & 7; const int tpos = pos0 - 16 + rr;
        float f[16];
        if (tpos >= 0) unpack16(Pg + (size_t)(tok0 - 16 + rr) * 512 + g * 128 + sg * 16, f); else {
#pragma unroll
            for (int k = 0; k < 16; ++k) f[k] = 0.f; }
#pragma unroll
        for (int k = 0; k < 16; ++k) Lp[rr * 128 + sg * 16 + k] = f[k]; }
    __syncthreads();
    for (int i = tid; i < 64 * 128; i += NTHR) { const int t = i >> 7, c = i & 127; const int tpos = pos0 + t; const int lo = (tpos + 1 - w) > 0 ? (tpos + 1 - w) : 0; const int cnt = tpos + 1 - lo;
        float s = 0.f;
#pragma unroll 1
        for (int k = 0; k < cnt; ++k) s += Lp[(16 + t - k) * 128 + c];
        Ld[t * 128 + c] = s / (float)cnt - Lp[(16 + t) * 128 + c]; }
    __syncthreads();
    const int dout = tid & 127, tq = tid >> 7; float acc[16];
#pragma unroll
    for (int i = 0; i < 16; ++i) acc[i] = 0.f;
#pragma unroll 2
    for (int c = 0; c < 128; ++c) { const float wv = W[c * 128 + dout];
#pragma unroll
        for (int i = 0; i < 16; ++i) acc[i] += Ld[(tq * 16 + i) * 128 + c] * wv; }
    const float sc = scale[dout];
#pragma unroll
    for (int i = 0; i < 16; ++i) Og[(size_t)(tok0 + tq * 16 + i) * 512 + g * 128 + dout] = (bf16_t)(pk_bf16(acc[i] * sc, 0.f) & 0xffffu);
}

namespace mix {
typedef short bf16x8 __attribute__((ext_vector_type(8)));
typedef short s16x4 __attribute__((ext_vector_type(4)));
typedef float f32x16 __attribute__((ext_vector_type(16)));
typedef const LAS unsigned char* lptr;
#define SBAR() __builtin_amdgcn_sched_barrier(0)
__device__ __forceinline__ unsigned lds_addr(lptr p) { return (unsigned)(uintptr_t)p; }
__device__ __forceinline__ bf16x8 pack8(const f32x16& p, int b) {
    v4u w; w.x = pk_bf16(p[b], p[b + 1]); w.y = pk_bf16(p[b + 2], p[b + 3]); w.z = pk_bf16(p[b + 4], p[b + 5]); w.w = pk_bf16(p[b + 6], p[b + 7]);
    return __builtin_bit_cast(bf16x8, w);
}
__device__ __forceinline__ void glds16(const void* g, LAS unsigned char* l) { __builtin_amdgcn_global_load_lds((const unsigned*)g, (LAS unsigned*)l, 16, 0, 0); }
#define MFMA32(a, b, c) __builtin_amdgcn_mfma_f32_32x32x16_bf16(a, b, c, 0, 0, 0)

#define VRD(set, db) do { _Pragma("unroll") for (int t_ = 0; t_ < 4; ++t_) { \
        asm volatile("ds_read_b64_tr_b16 %0, %1 offset:%c2" : "=&v"(lo[set][t_]) : "v"(va[db]), "i"(t_ * 4096) : "memory"); \
        asm volatile("ds_read_b64_tr_b16 %0, %1 offset:%c2" : "=&v"(hi[set][t_]) : "v"(va[db]), "i"(t_ * 4096 + 2048) : "memory"); } } while (0)
#define VPK(set, t) (bf16x8){lo[set][t][0], lo[set][t][1], lo[set][t][2], lo[set][t][3], hi[set][t][0], hi[set][t][1], hi[set][t][2], hi[set][t][3]}
__device__ __forceinline__ void pv_tile(f32x16 (&O)[4], const unsigned (&va)[4], const bf16x8 (&pb)[4]) {
    s16x4 lo[2][4], hi[2][4];
    VRD(0, 0);
    VRD(1, 1); asm volatile("s_waitcnt lgkmcnt(8)" ::: "memory"); SBAR();
#pragma unroll
    for (int t = 0; t < 4; ++t) O[0] = MFMA32(VPK(0, t), pb[t], O[0]);
    SBAR(); VRD(0, 2); asm volatile("s_waitcnt lgkmcnt(8)" ::: "memory"); SBAR();
#pragma unroll
    for (int t = 0; t < 4; ++t) O[1] = MFMA32(VPK(1, t), pb[t], O[1]);
    SBAR(); VRD(1, 3); asm volatile("s_waitcnt lgkmcnt(8)" ::: "memory"); SBAR();
#pragma unroll
    for (int t = 0; t < 4; ++t) O[2] = MFMA32(VPK(0, t), pb[t], O[2]);
    SBAR(); asm volatile("s_waitcnt lgkmcnt(0)" ::: "memory"); SBAR();
#pragma unroll
    for (int t = 0; t < 4; ++t) O[3] = MFMA32(VPK(1, t), pb[t], O[3]);
}
__device__ __forceinline__ void kread8_swz(bf16x8 (&kf)[8], const unsigned (&ka)[4]) {
#define KRD(i, a, off) asm volatile("ds_read_b128 %0, %1 offset:%c2" : "=&v"(kf[i]) : "v"(a), "i"(off) : "memory")
    KRD(0, ka[0], 0); KRD(1, ka[0], 8192); KRD(2, ka[1], 0); KRD(3, ka[1], 8192); KRD(4, ka[2], 0); KRD(5, ka[2], 8192); KRD(6, ka[3], 0); KRD(7, ka[3], 8192);
#undef KRD
}
__device__ __forceinline__ void kread8(bf16x8 (&kf)[8], unsigned ka) {
#define KRD(i, off) asm volatile("ds_read_b128 %0, %1 offset:%c2" : "=&v"(kf[i]) : "v"(ka), "i"(off) : "memory")
    KRD(0, 0); KRD(1, 512); KRD(2, 2048); KRD(3, 2560); KRD(4, 4096); KRD(5, 4608); KRD(6, 6144); KRD(7, 6656);
#undef KRD
}

__device__ __forceinline__ void da_bias(f32x16& p0, f32x16& p1, int jt, int cq, float xq, float sl2, float B2) {
    const float x = (float)(64 * jt) - xq;
    const float Be = (jt > cq) ? 1.0e30f : B2;
#pragma unroll
    for (int r = 0; r < 16; ++r) { const float kr = (float)((r & 3) + 8 * (r >> 2)); p0[r] = __builtin_fmaf(-sl2, __builtin_fabsf(x + kr), -Be); p1[r] = __builtin_fmaf(-sl2, __builtin_fabsf(x + (32.f + kr)), -Be); }
}
__device__ __forceinline__ void diffattn_unit(LAS unsigned char* lds, int tid, const bf16_t* Qg, const bf16_t* Kg, const bf16_t* Vg, bf16_t* Og, int b, int h, int u, bool desc, float sl2, float B2, float lam, const float* gout, float outmul) {
    asm volatile("" : "+v"(tid));
    const int lane = tid & 63, wid = __builtin_amdgcn_readfirstlane(tid >> 6), map = wid >> 2, wi = wid & 3, r32 = lane & 31, hi = lane >> 5;
    const int q0 = u * 128 + wi * 32, cq = q0 >> 6, NT = 2 * u + 2;
    const size_t rowb = (size_t)b * SEQ;
    const bf16_t* qrow = Qg + (rowb + q0 + r32) * 1024 + h * 128;
    bf16x8 qf[4];
#pragma unroll
    for (int s = 0; s < 4; ++s) qf[s] = *(const bf16x8*)(qrow + map * 64 + s * 16 + hi * 8);
    unsigned koff0, voff0;
    { const int row = 8 * wid + (lane >> 4), slot = lane & 15;
      koff0 = (unsigned)(row * 1024 + ((slot ^ (row & 15)) * 8));
      voff0 = (unsigned)(row * 1024 + (((slot >> 2) ^ (row & 3)) * 32 + (slot & 3) * 8)); }
    const bf16_t* Kbh = Kg + rowb * 1024 + h * 128; const bf16_t* Vbh = Vg + rowb * 1024 + h * 128;
#define JT(i) (desc ? NT - 1 - (i) : (i))
#define DA_DMA(i) do { const int j_ = JT(i), sl_ = (i) & 3; _Pragma("unroll") for (int i_ = 0; i_ < 2; ++i_) { \
        glds16(Kbh + (size_t)j_ * 65536 + (i_ ? (koff0 ^ 32u) + 4096u : koff0), lds + sl_ * 32768 + (2 * wid + i_) * 1024); \
        glds16(Vbh + (size_t)j_ * 65536 + (i_ ? voff0 + 4096u : voff0), lds + sl_ * 32768 + 16384 + (2 * wid + i_) * 1024); } } while (0)
    f32x16 O[4];
#pragma unroll
    for (int db = 0; db < 4; ++db)
#pragma unroll
        for (int r = 0; r < 16; ++r) O[db][r] = 0.f;
    float lsum = 0.f;
    const float xq = (float)(q0 + r32 - 4 * hi);
    unsigned ka_0, va_0;
    { const unsigned l0 = lds_addr((lptr)lds); const int qp = (lane & 15) >> 2;
      ka_0 = l0 + r32 * 256 + (((map * 8 + hi) ^ (r32 & 15)) << 4);
      va_0 = l0 + 16384 + (4 * hi + qp) * 256 + (qp << 6) + ((lane >> 4) & 1) * 32 + (lane & 3) * 8; }
    __syncthreads();
    asm volatile("" : "+v"(qf[0]), "+v"(qf[1]), "+v"(qf[2]), "+v"(qf[3]));
    DA_DMA(0); DA_DMA(1);
    if (NT > 2) { DA_DMA(2); asm volatile("s_waitcnt vmcnt(4)" ::: "memory"); } else asm volatile("s_waitcnt vmcnt(0)" ::: "memory");
    __builtin_amdgcn_s_barrier();
    f32x16 pA0, pA1, pB0, pB1;
    { da_bias(pA0, pA1, JT(0), cq, xq, sl2, B2);
      unsigned ka[4];
#pragma unroll
      for (int s = 0; s < 4; ++s) ka[s] = ka_0 ^ (s << 5);
      bf16x8 kf[8]; kread8_swz(kf, ka); asm volatile("s_waitcnt lgkmcnt(0)" ::: "memory"); SBAR();
#pragma unroll
      for (int s = 0; s < 4; ++s) { pA0 = MFMA32(kf[2 * s], qf[s], pA0); pA1 = MFMA32(kf[2 * s + 1], qf[s], pA1); }
      asm volatile("s_nop 15\n\ts_nop 15" : "+v"(pA0), "+v"(pA1)); }
    da_bias(pB0, pB1, JT(1), cq, xq, sl2, B2);
#define SM4(P, b_) do { P[b_] = __builtin_amdgcn_exp2f(P[b_]); P[b_ + 1] = __builtin_amdgcn_exp2f(P[b_ + 1]); P[b_ + 2] = __builtin_amdgcn_exp2f(P[b_ + 2]); P[b_ + 3] = __builtin_amdgcn_exp2f(P[b_ + 3]); \
        lsum += (P[b_] + P[b_ + 1]) + (P[b_ + 2] + P[b_ + 3]); } while (0)
#define MFMA_A(acc, a_, b_) asm volatile("v_mfma_f32_32x32x16_bf16 %0, %1, %2, %0" : "+v"(acc) : "v"(a_), "v"(b_))
#define PIN(x_) asm volatile("" : "+v"(x_))
#define FMK(dst, krv) do { float f_; asm volatile("v_fmamk_f32 %0, %1, %c2, %3" : "=v"(f_) : "v"(sl2), "i"(__builtin_bit_cast(int, (float)(krv))), "v"(c0_)); dst = f_; } while (0)
#define FM2(C0, C1, j) do { FMK(C0[j], ((j) & 3) + 8 * ((j) >> 2)); FMK(C1[j], 32 + ((j) & 3) + 8 * ((j) >> 2)); } while (0)
#define DA_STEP(C0, C1, N0, N1, i) do { \
        if ((i) + 3 < NT) DA_DMA((i) + 3); \
        bf16x8 pb[4]; \
        { unsigned ka[4]; _Pragma("unroll") for (int s_ = 0; s_ < 4; ++s_) ka[s_] = (ka_0 + (((i) + 1) & 3) * 32768) ^ (s_ << 5); \
          bf16x8 kf[8]; kread8_swz(kf, ka); asm volatile("s_waitcnt lgkmcnt(0)" ::: "memory"); \
          MFMA_A(N0, kf[0], qf[0]); SM4(C0, 0);  PIN(C0); PIN(lsum); \
          MFMA_A(N1, kf[1], qf[0]); SM4(C0, 4);  PIN(C0); PIN(lsum); \
          MFMA_A(N0, kf[2], qf[1]); SM4(C0, 8);  PIN(C0); PIN(lsum); pb[0] = pack8(C0, 0); PIN(pb[0]); \
          MFMA_A(N1, kf[3], qf[1]); SM4(C0, 12); PIN(C0); PIN(lsum); pb[1] = pack8(C0, 8); PIN(pb[1]); \
          MFMA_A(N0, kf[4], qf[2]); SM4(C1, 0);  PIN(C1); PIN(lsum); \
          MFMA_A(N1, kf[5], qf[2]); SM4(C1, 4);  PIN(C1); PIN(lsum); \
          MFMA_A(N0, kf[6], qf[3]); SM4(C1, 8);  PIN(C1); PIN(lsum); pb[2] = pack8(C1, 0); PIN(pb[2]); \
          MFMA_A(N1, kf[7], qf[3]); SM4(C1, 12); PIN(C1); PIN(lsum); pb[3] = pack8(C1, 8); PIN(pb[3]); } \
        { unsigned va[4]; _Pragma("unroll") for (int d_ = 0; d_ < 4; ++d_) va[d_] = (va_0 + ((i) & 3) * 32768) ^ (d_ << 6); \
          s16x4 lo[2][4], hi[2][4]; \
          const int jt2_ = JT((i) + 2); \
          float c0_ = __builtin_fmaf(sl2s, (float)(64 * jt2_) - xq, (jt2_ > cq) ? -1.0e30f : -B2); PIN(c0_); \
          VRD(0, 0); VRD(1, 1); asm volatile("s_waitcnt lgkmcnt(8)" ::: "memory"); \
          _Pragma("unroll") for (int t_ = 0; t_ < 4; ++t_) { const bf16x8 vf_ = VPK(0, t_); MFMA_A(O[0], vf_, pb[t_]); FM2(C0, C1, t_); } \
          VRD(0, 2); asm volatile("s_waitcnt lgkmcnt(8)" ::: "memory"); \
          _Pragma("unroll") for (int t_ = 0; t_ < 4; ++t_) { const bf16x8 vf_ = VPK(1, t_); MFMA_A(O[1], vf_, pb[t_]); FM2(C0, C1, 4 + t_); } \
          VRD(1, 3); asm volatile("s_waitcnt lgkmcnt(8)" ::: "memory"); \
          _Pragma("unroll") for (int t_ = 0; t_ < 4; ++t_) { const bf16x8 vf_ = VPK(0, t_); MFMA_A(O[2], vf_, pb[t_]); FM2(C0, C1, 8 + t_); } \
          asm volatile("s_waitcnt lgkmcnt(0)" ::: "memory"); \
          _Pragma("unroll") for (int t_ = 0; t_ < 4; ++t_) { const bf16x8 vf_ = VPK(1, t_); MFMA_A(O[3], vf_, pb[t_]); FM2(C0, C1, 12 + t_); } \
          PIN(C0); PIN(C1); \
          if (jt2_ == cq) { da_bias(C0, C1, jt2_, cq, xq, sl2, B2); PIN(C0); PIN(C1); } } \
        if ((i) + 3 < NT) asm volatile("s_waitcnt vmcnt(4) lgkmcnt(0)" ::: "memory"); else asm volatile("s_waitcnt vmcnt(0) lgkmcnt(0)" ::: "memory"); \
        __builtin_amdgcn_s_barrier(); \
    } while (0)
    const float sl2s = __builtin_bit_cast(float, __builtin_amdgcn_readfirstlane(__builtin_bit_cast(int, sl2)));
#pragma unroll 1
    for (int i = 0; i < NT; i += 2) {
        DA_STEP(pA0, pA1, pB0, pB1, i);
        DA_STEP(pB0, pB1, pA0, pA1, i + 1);
    }
#undef DA_STEP
#undef FM2
#undef FMK
#undef MFMA_A
#undef PIN
#undef SM4
    asm volatile("s_nop 15\n\ts_nop 15" : "+v"(O[0]), "+v"(O[1]), "+v"(O[2]), "+v"(O[3]));
#undef DA_DMA
#undef JT
    lsum += __shfl_xor(lsum, 32);
    const float inv = 1.0f / lsum;
    LAS f32x4* xch = (LAS f32x4*)(lds + wi * 16384) + lane;
    if (map == 1) {
        const float f = lam * inv;
#pragma unroll
        for (int db = 0; db < 4; ++db)
#pragma unroll
            for (int g = 0; g < 4; ++g) xch[(db * 4 + g) * 64] = (f32x4){O[db][4 * g] * f, O[db][4 * g + 1] * f, O[db][4 * g + 2] * f, O[db][4 * g + 3] * f};
    }
    __syncthreads();
    if (map == 0) {
        float ss = 0.f;
#pragma unroll
        for (int db = 0; db < 4; ++db)
#pragma unroll
            for (int g = 0; g < 4; ++g) { const f32x4 o1 = xch[(db * 4 + g) * 64];
#pragma unroll
                for (int i = 0; i < 4; ++i) { const float v = O[db][4 * g + i] * inv - o1[i]; O[db][4 * g + i] = v; ss += v * v; } }
        ss += __shfl_xor(ss, 32);
        const float rr = __builtin_amdgcn_rsqf(ss * (1.f / 128.f) + 1e-6f) * outmul;
        bf16_t* orow = Og + (rowb + q0 + r32) * 1024 + h * 128 + 4 * hi;
#pragma unroll
        for (int db = 0; db < 4; ++db)
#pragma unroll
            for (int g = 0; g < 4; ++g) { const f32x4 gv = *(const f32x4*)(gout + 32 * db + 8 * g + 4 * hi);
                const unsigned w0 = pk_bf16(O[db][4 * g] * rr * gv[0], O[db][4 * g + 1] * rr * gv[1]), w1 = pk_bf16(O[db][4 * g + 2] * rr * gv[2], O[db][4 * g + 3] * rr * gv[3]);
                *(unsigned long long*)(orow + 32 * db + 8 * g) = (unsigned long long)w0 | ((unsigned long long)w1 << 32); }
    }
    __syncthreads();
}

__device__ __forceinline__ void memattn_unit(LAS unsigned char* lds, int tid, bf16_t* MQg, bf16_t* Og, const bf16_t* KVg, const float* mqss, const float* qn, const float* kn, int pm, int hd, float Bm) {
    const int lane = tid & 63, wid = __builtin_amdgcn_readfirstlane(tid >> 6), r32 = lane & 31, hi = lane >> 5;
    const int b = pm >> 3; const size_t row = (size_t)pm * 256 + wid * 32 + r32;
    __syncthreads();
#pragma unroll
    for (int i = 0; i < 8; ++i) { const int p = 8 * wid + i, vrow = 4 * p + (lane >> 4), slot = lane & 15;
        glds16(KVg + ((size_t)b * MEML + vrow) * 2048 + 512 + hd * 128 + (((slot >> 2) ^ (vrow & 3)) * 32 + (slot & 3) * 8), lds + 65536 + p * 1024); }
    { const int key = tid >> 1, half = tid & 1; const bf16_t* src = KVg + ((size_t)b * MEML + key) * 2048 + hd * 128 + half * 64;
      v4u raw[8]; float s = 0.f;
#pragma unroll
      for (int c = 0; c < 8; ++c) { raw[c] = *(const v4u*)(src + c * 8);
          const float a0 = bf_lo(raw[c].x), a1 = bf_hi(raw[c].x), a2 = bf_lo(raw[c].y), a3 = bf_hi(raw[c].y), a4 = bf_lo(raw[c].z), a5 = bf_hi(raw[c].z), a6 = bf_lo(raw[c].w), a7 = bf_hi(raw[c].w);
          s += ((a0 * a0 + a1 * a1) + (a2 * a2 + a3 * a3)) + ((a4 * a4 + a5 * a5) + (a6 * a6 + a7 * a7)); }
      s += __shfl_xor(s, 1);
      const float rk = __builtin_amdgcn_rsqf(s * (1.f / 128.f) + 1e-6f) * MEMSCALE;
#pragma unroll
      for (int c = 0; c < 8; ++c) { const int d0 = half * 64 + c * 8; const f32x4 qa = *(const f32x4*)(qn + d0), qb = *(const f32x4*)(qn + d0 + 4), ka = *(const f32x4*)(kn + d0), kb = *(const f32x4*)(kn + d0 + 4);
          v4u w; w.x = pk_bf16(bf_lo(raw[c].x) * rk * qa[0] * ka[0], bf_hi(raw[c].x) * rk * qa[1] * ka[1]); w.y = pk_bf16(bf_lo(raw[c].y) * rk * qa[2] * ka[2], bf_hi(raw[c].y) * rk * qa[3] * ka[3]);
          w.z = pk_bf16(bf_lo(raw[c].z) * rk * qb[0] * kb[0], bf_hi(raw[c].z) * rk * qb[1] * kb[1]); w.w = pk_bf16(bf_lo(raw[c].w) * rk * qb[2] * kb[2], bf_hi(raw[c].w) * rk * qb[3] * kb[3]);
          *(LAS v4u*)(lds + (key >> 6) * 16384 + (half * 8 + c) * 1024 + (key & 63) * 16) = w; } }
    const bf16_t* qrow = MQg + row * 512 + hd * 128;
    bf16x8 qf[8];
#pragma unroll
    for (int s = 0; s < 8; ++s) qf[s] = *(const bf16x8*)(qrow + s * 16 + hi * 8);
    const float rq = __builtin_amdgcn_rsqf((mqss[row * 8 + hd * 2] + mqss[row * 8 + hd * 2 + 1]) * (1.f / 128.f) + 1e-6f);
    f32x16 O[4];
#pragma unroll
    for (int db = 0; db < 4; ++db)
#pragma unroll
        for (int r = 0; r < 16; ++r) O[db][r] = 0.f;
    float lsum = 0.f;
    const lptr kl0 = (lptr)lds + hi * 1024 + r32 * 16;
    unsigned va0[4];
    { const int qp = (lane & 15) >> 2;
#pragma unroll
      for (int db = 0; db < 4; ++db) va0[db] = lds_addr((lptr)lds) + 65536 + (4 * hi + qp) * 256 + ((db ^ qp) * 64) + ((lane >> 4) & 1) * 32 + (lane & 3) * 8; }
    __syncthreads();
#pragma unroll 1
    for (int tl = 0; tl < 4; ++tl) {
        f32x16 p0, p1;
#pragma unroll
        for (int r = 0; r < 16; ++r) { p0[r] = 0.f; p1[r] = 0.f; }
        bf16x8 kf[8], kg[8]; kread8(kf, lds_addr(kl0) + tl * 16384); kread8(kg, lds_addr(kl0) + tl * 16384 + 8192);
        asm volatile("s_waitcnt lgkmcnt(8)" ::: "memory"); SBAR();
#pragma unroll
        for (int s = 0; s < 4; ++s) { p0 = MFMA32(kf[2 * s], qf[s], p0); p1 = MFMA32(kf[2 * s + 1], qf[s], p1); }
        SBAR(); asm volatile("s_waitcnt lgkmcnt(0)" ::: "memory"); SBAR();
#pragma unroll
        for (int s = 0; s < 4; ++s) { p0 = MFMA32(kg[2 * s], qf[4 + s], p0); p1 = MFMA32(kg[2 * s + 1], qf[4 + s], p1); }
#pragma unroll
        for (int r = 0; r < 16; ++r) { p0[r] = __builtin_amdgcn_exp2f(__builtin_fmaf(p0[r], rq, -Bm)); p1[r] = __builtin_amdgcn_exp2f(__builtin_fmaf(p1[r], rq, -Bm)); lsum += p0[r] + p1[r]; }
        bf16x8 pb[4]; pb[0] = pack8(p0, 0); pb[1] = pack8(p0, 8); pb[2] = pack8(p1, 0); pb[3] = pack8(p1, 8);
        unsigned va[4];
#pragma unroll
        for (int db = 0; db < 4; ++db) va[db] = va0[db] + tl * 16384;
        pv_tile(O, va, pb);
    }
    lsum += __shfl_xor(lsum, 32);
    const float inv = 1.0f / lsum;
    bf16_t* orow = Og + row * 512 + hd * 128 + 4 * hi;
#pragma unroll
    for (int db = 0; db < 4; ++db)
#pragma unroll
        for (int g = 0; g < 4; ++g) { const unsigned w0 = pk_bf16(O[db][4 * g] * inv, O[db][4 * g + 1] * inv), w1 = pk_bf16(O[db][4 * g + 2] * inv, O[db][4 * g + 3] * inv);
            *(unsigned long long*)(orow + 32 * db + 8 * g) = (unsigned long long)w0 | ((unsigned long long)w1 << 32); }
}

__device__ __forceinline__ void pool_unit(LAS unsigned char* lds, int tid, const bf16_t* Pg, bf16_t* Og, const bf16_t* Wt, const float* scale, int tok0, int g) {
    const int lane = tid & 63, wid = __builtin_amdgcn_readfirstlane(tid >> 6), r32 = lane & 31, hi = lane >> 5;
    LAS unsigned char* Lp = lds; LAS unsigned char* Ld = lds + 272 * 256;
    const int w = 2 << g, pos0 = tok0 & (SEQ - 1);
    __syncthreads();
    { v4u st[9];
#pragma unroll
      for (int k = 0; k < 9; ++k) { const int i = tid + k * NTHR, ii = i < 272 * 16 ? i : tid, rr = ii >> 4, ch = ii & 15; const bool ok = pos0 - 16 + rr >= 0;
          const v4u v = *(const v4u*)(Pg + (size_t)(tok0 - 16 + (ok ? rr : 16)) * 512 + g * 128 + ch * 8); st[k].x = ok ? v.x : 0u; st[k].y = ok ? v.y : 0u; st[k].z = ok ? v.z : 0u; st[k].w = ok ? v.w : 0u; }
#pragma unroll
      for (int k = 0; k < 9; ++k) { const int i = tid + k * NTHR, rr = i >> 4, ch = i & 15; if (i < 272 * 16) *(LAS v4u*)(Lp + rr * 256 + ch * 16) = st[k]; } }
    bf16x8 wf[4][8];
#pragma unroll
    for (int db = 0; db < 4; ++db)
#pragma unroll
        for (int s = 0; s < 8; ++s) wf[db][s] = *(const bf16x8*)(Wt + (size_t)(32 * db + r32) * 128 + hi * 8 + s * 16);
    __syncthreads();
    { const int ch = tid & 15, t0 = (tid >> 4) * 8;
      float s[8];
#pragma unroll
      for (int i = 0; i < 8; ++i) s[i] = 0.f;
#pragma unroll 1
      for (int k = 1; k < w; ++k) { const v4u v = *(const LAS v4u*)(Lp + (16 + t0 - k) * 256 + ch * 16);
          s[0] += bf_lo(v.x); s[1] += bf_hi(v.x); s[2] += bf_lo(v.y); s[3] += bf_hi(v.y); s[4] += bf_lo(v.z); s[5] += bf_hi(v.z); s[6] += bf_lo(v.w); s[7] += bf_hi(v.w); }
#pragma unroll
      for (int tt = 0; tt < 8; ++tt) { const int t = t0 + tt, tpos = pos0 + t; const int cnt = (tpos + 1 < w) ? (tpos + 1) : w; const float ic = 1.0f / (float)cnt;
          const v4u v = *(const LAS v4u*)(Lp + (16 + t) * 256 + ch * 16), o = *(const LAS v4u*)(Lp + (16 + t - w + 1) * 256 + ch * 16);
          float p[8] = {bf_lo(v.x), bf_hi(v.x), bf_lo(v.y), bf_hi(v.y), bf_lo(v.z), bf_hi(v.z), bf_lo(v.w), bf_hi(v.w)};
          float q[8] = {bf_lo(o.x), bf_hi(o.x), bf_lo(o.y), bf_hi(o.y), bf_lo(o.z), bf_hi(o.z), bf_lo(o.w), bf_hi(o.w)};
          float d[8];
#pragma unroll
          for (int i = 0; i < 8; ++i) { s[i] += p[i]; d[i] = s[i] * ic - p[i]; s[i] -= q[i]; }
          v4u wv; wv.x = pk_bf16(d[0], d[1]); wv.y = pk_bf16(d[2], d[3]); wv.z = pk_bf16(d[4], d[5]); wv.w = pk_bf16(d[6], d[7]);
          *(LAS v4u*)(Ld + t * 256 + ((ch ^ (t & 15)) << 4)) = wv; } }
    __syncthreads();
    const int tok = wid * 32 + r32;
    bf16x8 df[8];
#pragma unroll
    for (int s = 0; s < 8; ++s) df[s] = *(const LAS bf16x8*)(Ld + tok * 256 + (((2 * s + hi) ^ (tok & 15)) << 4));
    bf16_t* orow = Og + (size_t)(tok0 + tok) * 512 + g * 128 + 4 * hi;
#pragma unroll
    for (int db = 0; db < 4; ++db) {
        f32x16 acc;
#pragma unroll
        for (int r = 0; r < 16; ++r) acc[r] = 0.f;
#pragma unroll
        for (int s = 0; s < 8; ++s) acc = MFMA32(wf[db][s], df[s], acc);
#pragma unroll
        for (int gq = 0; gq < 4; ++gq) { const f32x4 sc = *(const f32x4*)(scale + 32 * db + 8 * gq + 4 * hi);
            const unsigned w0 = pk_bf16(acc[4 * gq] * sc[0], acc[4 * gq + 1] * sc[1]), w1 = pk_bf16(acc[4 * gq + 2] * sc[2], acc[4 * gq + 3] * sc[3]);
            *(unsigned long long*)(orow + 32 * db + 8 * gq) = (unsigned long long)w0 | ((unsigned long long)w1 << 32); }
    }
}
#undef MFMA32
#undef VRD
#undef VPK
#undef SBAR
}

#ifndef MIX_NAIVE_DA
#define MIX_NAIVE_DA 0
#endif
#ifndef MIX_NAIVE_MEM
#define MIX_NAIVE_MEM 0
#endif
#ifndef MIX_NAIVE_POOL
#define MIX_NAIVE_POOL 0
#endif
__device__ __forceinline__ void phase_mixers(unsigned char* ws, LAS unsigned char* lds, int l, int tid) {
    const float* prm = (const float*)(ws + WS_PARAM); const float* sc = (const float*)(ws + WS_SC) + l * 8;
    const float lam = ld_f32_agent(sc + 0), bnd0 = ld_f32_agent(sc + 1), bnd1 = ld_f32_agent(sc + 2), bndm = ld_f32_agent(sc + 3), omul = ld_f32_agent(sc + 4);
    const int bx = blockIdx.x, vcu = (gridDim.x == 256) ? ((bx & 7) * 32 + (bx >> 3)) : bx;
    bf16_t* Q = (bf16_t*)(ws + WS_Q); const bf16_t* K = (const bf16_t*)(ws + WS_K); const bf16_t* V = (const bf16_t*)(ws + WS_V);
    bf16_t* MQ = (bf16_t*)(ws + WS_MQ); const bf16_t* KV = (const bf16_t*)(ws + WS_MEMKV) + l * 1024;     const float* mqss = (const float*)(ws + WS_MQSS);
#if MIX_NAIVE_DA
    for (int u = blockIdx.x; u < 4096; u += gridDim.x) { const int hc = 63 - (u >> 6), c = hc >> 1, bh = u & 63, b = bh >> 3, h = bh & 7;
        const size_t rowb = (size_t)b * SEQ; const float slope2 = exp2f(-(float)(h + 1)) * LOG2E;
        naive_attn_unit<true>(lds, tid, Q + (rowb + hc * 32) * 1024 + h * 128, 1024, K + rowb * 1024 + h * 128, 1024, V + rowb * 1024 + h * 128, 1024, (bf16_t*)(ws + WS_XB) + (rowb + hc * 32) * 1024 + h * 128, 1024,
                              c + 1, hc * 32, nullptr, nullptr, nullptr, slope2, bnd0, bnd1, lam, prm + PB_GOUT + l * 128, omul); }
#else
    {
        const float B2 = fmaxf(bnd0, bnd1);
        for (int rep_ = 0; rep_ < REP_DA; ++rep_)
        for (int w = vcu; w < 256; w += gridDim.x) { const int bh = w >> 2, s = w & 3, b = bh >> 3, h = bh & 7; const float sl2 = exp2f(-(float)(h + 1)) * LOG2E;
#pragma unroll 1
            for (int i = 0; i < 4; ++i) { const int u = (i == 0) ? 15 - s : (i == 1) ? 8 + s : (i == 2) ? 7 - s : s;
                mix::diffattn_unit(lds, tid, Q, K, V, (bf16_t*)(ws + WS_XB), b, h, u, (i & 1) != 0, sl2, B2, lam, prm + PB_GOUT + l * 128, omul); } }
    }
#endif
#if MIX_NAIVE_MEM
    for (int u = blockIdx.x; u < 2048; u += gridDim.x) { const int qt = u >> 2, hd = u & 3, b = qt >> 6; const size_t row0 = (size_t)qt * 32;
        naive_attn_unit<false>(lds, tid, MQ + row0 * 512 + hd * 128, 512, KV + (size_t)b * MEML * 2048 + hd * 128, 2048, KV + (size_t)b * MEML * 2048 + 512 + hd * 128, 2048, MQ + row0 * 512 + hd * 128, 512,
                               4, 0, prm + PB_MQN + l * 128, prm + PB_MKN + l * 128, mqss + row0 * 8 + hd * 2, 0.f, bndm, 0.f, 0.f, nullptr, 1.f); }
#else
    for (int rep_ = 0; rep_ < REP_MEM; ++rep_)
    for (int w = vcu; w < 256; w += gridDim.x) mix::memattn_unit(lds, tid, MQ, (rep_ + 1 < REP_MEM) ? (bf16_t*)(ws + WS_OPOOL) : MQ, KV, mqss, prm + PB_MQN + l * 128, prm + PB_MKN + l * 128, w >> 2, w & 3, bndm);
#endif
#if MIX_NAIVE_POOL
    for (int u = blockIdx.x; u < 1024; u += gridDim.x) { const int tt = u >> 2, g = u & 3;
        naive_pool_unit(lds, tid, (const bf16_t*)(ws + WS_P), (bf16_t*)(ws + WS_OPOOL), prm + PB_POOLW + (size_t)(l * 4 + g) * 128 * 128, prm + PB_POOLS + l * 512 + g * 128, tt * 64, g); }
#else
    for (int rep_ = 0; rep_ < REP_POOL; ++rep_)
    for (int w = vcu; w < 256; w += gridDim.x) { const int pm = w >> 2, g = w & 3;
        mix::pool_unit(lds, tid, (const bf16_t*)(ws + WS_P), (bf16_t*)(ws + WS_OPOOL), (const bf16_t*)(ws + WS_POOLWT) + (size_t)(l * 4 + g) * 128 * 128, prm + PB_POOLS + l * 512 + g * 128, pm * 256, g); }
#endif
}

__device__ __forceinline__ void phase_route(unsigned char* ws, const bf16_t* xin, LAS unsigned char* lds, int tid, int lane, int wave) {
    const float* gffn = (const float*)(ws + WS_PARAM) + PB_GFFN1; const float* wr = (const float*)(ws + WS_PARAM) + PB_WR;
    unsigned* cnt = (unsigned*)ws + CW_CNT; int* toke = (int*)(ws + WS_TOKE); int* tokp = (int*)(ws + WS_TOKP); float* tokg = (float*)(ws + WS_TOKG); float* tokr = (float*)(ws + WS_TOKR);
    LAS unsigned* lcnt = (LAS unsigned*)lds; LAS unsigned* lbase = lcnt + 8; LAS int* linfo = (LAS int*)(lds + 64);
    const int per = T / gridDim.x;
    f32x4 wg0[16], wg1[16];
#pragma unroll
    for (int kk = 0; kk < 16; ++kk) { const int k = 16 * lane + kk; const float g = gffn[k]; wg0[kk] = *(const f32x4*)(wr + k * 8) * g; wg1[kk] = *(const f32x4*)(wr + k * 8 + 4) * g; }
    for (int c0 = 0; c0 < per; c0 += 64) {
        __syncthreads();
        if (tid < 8) lcnt[tid] = 0u;
        __syncthreads();
        v4u raw[8][2];
#pragma unroll
        for (int q = 0; q < 8; ++q) { const int i = wave + q * NWAVES; const int t = blockIdx.x * per + ((c0 + i < per) ? c0 + i : 0); const bf16_t* p = xin + (size_t)t * D + 16 * lane; raw[q][0] = *(const v4u*)p; raw[q][1] = *(const v4u*)(p + 8); }
#pragma unroll
        for (int q = 0; q < 8; ++q) { const int i = wave + q * NWAVES; if (c0 + i >= per) break;
            const int t = blockIdx.x * per + c0 + i;
            f32x4 v[4]; { const v4u a_ = raw[q][0], b_ = raw[q][1];
              v[0] = (f32x4){bf_lo(a_.x), bf_hi(a_.x), bf_lo(a_.y), bf_hi(a_.y)}; v[1] = (f32x4){bf_lo(a_.z), bf_hi(a_.z), bf_lo(a_.w), bf_hi(a_.w)};
              v[2] = (f32x4){bf_lo(b_.x), bf_hi(b_.x), bf_lo(b_.y), bf_hi(b_.y)}; v[3] = (f32x4){bf_lo(b_.z), bf_hi(b_.z), bf_lo(b_.w), bf_hi(b_.w)}; }
            float s = 0.f;
#pragma unroll
            for (int j = 0; j < 4; ++j) s += (v[j][0] * v[j][0] + v[j][1] * v[j][1]) + (v[j][2] * v[j][2] + v[j][3] * v[j][3]);
            const float rstd = __builtin_amdgcn_rsqf(wave_sum(s) * (1.f / 1024.f) + 1e-6f);
            float lg[8];
#pragma unroll
            for (int e = 0; e < 8; ++e) lg[e] = 0.f;
#pragma unroll
            for (int j = 0; j < 4; ++j)
#pragma unroll
                for (int k4 = 0; k4 < 4; ++k4) { const float xv = v[j][k4]; const f32x4 w0 = wg0[4 * j + k4], w1 = wg1[4 * j + k4];
                    lg[0] += xv * w0[0]; lg[1] += xv * w0[1]; lg[2] += xv * w0[2]; lg[3] += xv * w0[3]; lg[4] += xv * w1[0]; lg[5] += xv * w1[1]; lg[6] += xv * w1[2]; lg[7] += xv * w1[3]; }
#pragma unroll
            for (int e = 0; e < 8; ++e) lg[e] = wave_sum(lg[e]) * rstd;
            int i0 = 0; float b0 = lg[0];
#pragma unroll
            for (int e = 1; e < 8; ++e) if (lg[e] > b0) { b0 = lg[e]; i0 = e; }
            int i1 = -1; float b1 = -3.0e38f;
#pragma unroll
            for (int e = 0; e < 8; ++e) if (e != i0 && lg[e] > b1) { b1 = lg[e]; i1 = e; }
            const float g0 = 1.f / (1.f + __expf(b1 - b0)), g1 = 1.f - g0;
            if (lane == 0) { const unsigned p0 = __hip_atomic_fetch_add(lcnt + i0, 1u, __ATOMIC_RELAXED, __HIP_MEMORY_SCOPE_WORKGROUP), p1 = __hip_atomic_fetch_add(lcnt + i1, 1u, __ATOMIC_RELAXED, __HIP_MEMORY_SCOPE_WORKGROUP);
                linfo[i * 4 + 0] = i0; linfo[i * 4 + 1] = i1; linfo[i * 4 + 2] = (int)p0; linfo[i * 4 + 3] = (int)p1;
                toke[2 * t] = i0; toke[2 * t + 1] = i1; tokg[2 * t] = g0; tokg[2 * t + 1] = g1; tokr[t] = rstd; }
        }
        __syncthreads();
        if (tid < 8) lbase[tid] = lcnt[tid] ? atomicAdd(cnt + 64 * tid, lcnt[tid]) : 0u;
        __syncthreads();
        if (tid < 64 && c0 + tid < per) { const int t = blockIdx.x * per + c0 + tid; tokp[2 * t] = (int)lbase[linfo[tid * 4 + 0]] + linfo[tid * 4 + 2]; tokp[2 * t + 1] = (int)lbase[linfo[tid * 4 + 1]] + linfo[tid * 4 + 3]; }
    }
}
__device__ __forceinline__ void build_texp(unsigned char* ws, LAS int* texp, int tid) {
    const unsigned* cnt = (const unsigned*)ws + CW_CNT;
    __syncthreads();
    if (tid == 0) { int tb = 0; for (int e = 0; e < NEXP; ++e) { texp[160 + e] = tb; const int n = (int)__hip_atomic_load(cnt + 64 * e, RLX_AGENT); const int nt = (n + 255) >> 8; for (int i = 0; i < nt; ++i) texp[tb + i] = e; tb += nt; } texp[168] = tb; texp[169] = tb; }
    __syncthreads();
}
__device__ __forceinline__ void phase_gather(unsigned char* ws, const bf16_t* xin, LAS int* texp, int lane, int wave) {
    const int* toke = (const int*)(ws + WS_TOKE); const int* tokp = (const int*)(ws + WS_TOKP); const float* tokr = (const float*)(ws + WS_TOKR);
    unsigned char* xg = ws + WS_XGY; float* xgrs = (float*)(ws + WS_XGRS);
    const int gw = blockIdx.x * NWAVES + wave, NGW = gridDim.x * NWAVES;
    for (int t = gw; t < T; t += NGW) {
        f32x4 v[4]; ld16_bf16(xin + (size_t)t * D + 16 * lane, v); float mx = 0.f;
#pragma unroll
        for (int j = 0; j < 4; ++j) { mx = fmaxf(mx, fmaxf(fmaxf(fabsf(v[j][0]), fabsf(v[j][1])), fmaxf(fabsf(v[j][2]), fabsf(v[j][3])))); }
#pragma unroll
        for (int o = 1; o < 64; o <<= 1) mx = fmaxf(mx, __shfl_xor(mx, o));
        const float inv = mx > 0.f ? 127.0f / mx : 0.f, rs = mx * (1.0f / 127.0f) * tokr[t];
        v4u w; w.x = pk_i8x4(v[0][0] * inv, v[0][1] * inv, v[0][2] * inv, v[0][3] * inv); w.y = pk_i8x4(v[1][0] * inv, v[1][1] * inv, v[1][2] * inv, v[1][3] * inv);
        w.z = pk_i8x4(v[2][0] * inv, v[2][1] * inv, v[2][2] * inv, v[2][3] * inv); w.w = pk_i8x4(v[3][0] * inv, v[3][1] * inv, v[3][2] * inv, v[3][3] * inv);
#pragma unroll
        for (int k = 0; k < 2; ++k) { const int e = toke[2 * t + k], p = tokp[2 * t + k]; const size_t row = (size_t)texp[160 + e] * 256 + p;
            *((v4u*)(xg + row * D) + lane) = w; if (lane == 0) xgrs[row] = rs; }
    }
}
__device__ __forceinline__ void phase_combine(unsigned char* ws, const bf16_t* xs, float* dst, LAS int* texp, int lane, int wave) {
    const int* toke = (const int*)(ws + WS_TOKE); const int* tokp = (const int*)(ws + WS_TOKP); const float* tokg = (const float*)(ws + WS_TOKG);
    const bf16_t* Y = (const bf16_t*)(ws + WS_Y);
    const int gw = blockIdx.x * NWAVES + wave, NGW = gridDim.x * NWAVES;
    for (int t = gw; t < T; t += NGW) {
        const size_t r0 = (size_t)texp[160 + toke[2 * t]] * 256 + tokp[2 * t], r1 = (size_t)texp[160 + toke[2 * t + 1]] * 256 + tokp[2 * t + 1]; const float g0 = tokg[2 * t], g1 = tokg[2 * t + 1];
        f32x4 xv[4]; ld16_bf16(xs + (size_t)t * D + 16 * lane, xv);
        const v4u* y0 = (const v4u*)(Y + r0 * D) + 2 * lane; const v4u* y1 = (const v4u*)(Y + r1 * D) + 2 * lane;
#pragma unroll
        for (int h = 0; h < 2; ++h) { const v4u p = y0[h], q = y1[h]; f32x4 xa = xv[2 * h], xc = xv[2 * h + 1];
            xa[0] += g0 * bf_lo(p.x) + g1 * bf_lo(q.x); xa[1] += g0 * bf_hi(p.x) + g1 * bf_hi(q.x); xa[2] += g0 * bf_lo(p.y) + g1 * bf_lo(q.y); xa[3] += g0 * bf_hi(p.y) + g1 * bf_hi(q.y);
            xc[0] += g0 * bf_lo(p.z) + g1 * bf_lo(q.z); xc[1] += g0 * bf_hi(p.z) + g1 * bf_hi(q.z); xc[2] += g0 * bf_lo(p.w) + g1 * bf_lo(q.w); xc[3] += g0 * bf_hi(p.w) + g1 * bf_hi(q.w);
            f32x4* xw = (f32x4*)(dst + (size_t)t * D) + 4 * lane; xw[2 * h] = xa; xw[2 * h + 1] = xc; }
    }
}

typedef pg8::EpiSwiglu<true, true> EpiSwigluF8;
#define GEMM_PHASE(EPI, g, S, E) do { S.prep(); __syncthreads(); pg8::gemm_phase<EPI, pg8::Sched2, true, true>(lds, g, S, E); } while (0)
__global__ void __launch_bounds__(NTHR, 2) fwd_kernel(Args args) {
    extern __shared__ __attribute__((aligned(16))) unsigned char lds_raw[];
    LAS unsigned char* lds = (LAS unsigned char*)lds_raw;
    volatile LAS unsigned* MISC = (volatile LAS unsigned*)(lds + MISC_OFF);
    LAS float* rstab = (LAS float*)(lds + RS_OFF); LAS int* texp = (LAS int*)(lds + TEXP_OFF);
    unsigned char* const ws0 = args.ws; int G = gridDim.x, bx = blockIdx.x;
#define PHASE_BEGIN() size_t z_ = 0; asm volatile("" : "+s"(z_), "+s"(G), "+s"(bx)); unsigned char* ws = args.ws + z_; float* out = args.out + z_; int tid = threadIdx.x; asm volatile("" : "+v"(tid)); const int lane = tid & 63, wave = __builtin_amdgcn_readfirstlane(tid >> 6); (void)lane; (void)wave; (void)out
    if (threadIdx.x < 64) MISC[threadIdx.x] = 0u;
    __syncthreads();
    XcdBarrier bar; bar.bar = (unsigned*)ws0 + CW_BAR; bar.x = 0; bar.st = nullptr;
    const int lo = args.ph_lo, hi = args.ph_hi;
    if (MK_N_LAUNCHES == 1 && hi - lo > 1) bar = xcd_barrier_post((unsigned*)ws0 + CW_BAR, MISC + 8);
#define IN(k) (lo <= (k) && (k) < hi)
#define SEAM(k) do { if (IN(k) && IN((k) + 1)) { size_t zb_ = 0; asm volatile("" : "+s"(zb_)); bar.bar = (unsigned*)args.ws + CW_BAR + zb_; xcd_barrier(bar); } } while (0)

    if (IN(0)) { PHASE_BEGIN(); phase_prologue(args, lds, tid, lane, wave); }
    SEAM(0);
    if (IN(0) && IN(2)) {}
    if (IN(2)) { PHASE_BEGIN();
        pg8::Gemm g{(const bf16_t*)(ws + WS_MEMBF), (const bf16_t*)(ws + WS_WMEMKV), NBATCH * MEML, 2048, D};
        pg8::Sched2 S; S.init2(g.M, g.N, G, bx, rstab); S.rsrc = (const float*)(ws + WS_SSM); S.rmode = 1;
        pg8::EpiStore<true> E{(bf16_t*)(ws + WS_MEMKV), 2048, rstab};
        GEMM_PHASE(pg8::EpiStore<true>, g, S, E);
        __syncthreads();
    }
    SEAM(2);
    for (int l = 0; l < 2; ++l) {
        const int pb = l == 0 ? 3 : 11;
        if (IN(pb)) { for (int rep_ = 0; rep_ < REP_A; ++rep_) { PHASE_BEGIN();
#if I8_A
            pg8::Gemm g{(const bf16_t*)(ws + WS_QX), (const bf16_t*)(ws + WS_W1T + (size_t)l * 14 * MiB), T, NGEMM1, D / 2};
            pg8::Sched2 S; S.init2(T, NGEMM1, G, bx, rstab); S.rsrc = (const float*)(ws + WS_SA); S.rmode = 2; S.wgm = 4;
            pg8::EpiA<true> E{ws, l, rstab};
            GEMM_PHASE(pg8::EpiA<true>, g, S, E); __syncthreads(); }
#else
            pg8::Gemm g{(const bf16_t*)(ws + WS_XB), (const bf16_t*)(ws + WS_W1T + (size_t)l * 14 * MiB), T, NGEMM1, D};
            pg8::Sched2 S; S.init2(T, NGEMM1, G, bx, rstab); S.rsrc = (const float*)(ws + WS_SS); S.rmode = 1; S.wgm = 4;
            pg8::EpiA<false> E{ws, l, rstab};
            GEMM_PHASE(pg8::EpiA<false>, g, S, E); __syncthreads(); }
#endif
        }
        SEAM(pb);
        if (IN(pb + 1)) { PHASE_BEGIN(); phase_mixers(ws, lds, l, tid); }
        SEAM(pb + 1);
        if (IN(pb + 2)) { for (int rep_ = 0; rep_ < REP_C; ++rep_) { PHASE_BEGIN();
            { pg8::Gemm g{(const bf16_t*)(ws + WS_XB), (const bf16_t*)(ws + WS_WBRDA + (size_t)l * 2 * MiB), T, D, 1024}; pg8::Sched2 S; S.init2(T, D, G, bx, rstab);
              pg8::EpiBr0 E{ws}; GEMM_PHASE(pg8::EpiBr0, g, S, E); }
            __syncthreads(); { size_t z2_ = 0; asm volatile("" : "+s"(z2_), "+s"(G), "+s"(bx)); ws = args.ws + z2_; }
            { pg8::Gemm g{(const bf16_t*)(ws + WS_OPOOL), (const bf16_t*)(ws + WS_WBRPOOL + (size_t)l * 1 * MiB), T, D, 512}; pg8::Sched2 S; S.init2(T, D, G, bx, rstab);
              S.chain = 2; S.A2 = (const bf16_t*)(ws + WS_MQ); S.B2 = (const bf16_t*)(ws + WS_WBRMEM + (size_t)l * 1 * MiB);
              pg8::EpiBrC E{ws}; GEMM_PHASE(pg8::EpiBrC, g, S, E); } __syncthreads(); }
        }
        SEAM(pb + 2);
        if (IN(pb + 3)) { PHASE_BEGIN();
            pg8::Gemm g{(const bf16_t*)(ws + WS_Q), (const bf16_t*)(ws + WS_WOUT + (size_t)l * 2 * MiB), T, D, D}; pg8::Sched2 S; S.init2(T, D, G, bx, rstab);
            pg8::EpiResB E{l == 0 ? (const float*)(args.in[0] + z_) : (const float*)nullptr, (bf16_t*)(ws + WS_XS)};
            GEMM_PHASE(pg8::EpiResB, g, S, E); __syncthreads();
        }
        SEAM(pb + 3);
        if (l == 0) {
            if (IN(7) && I8_E) { PHASE_BEGIN(); phase_quant_rows((const bf16_t*)(ws + WS_XS), ws, lane, wave); }
            SEAM(7);
            if (IN(8)) { for (int rep_ = 0; rep_ < REP_E; ++rep_) { PHASE_BEGIN();
#if I8_E
                pg8::Gemm g{(const bf16_t*)(ws + WS_QX), (const bf16_t*)(ws + WS_WFF13), T, 2 * FFD, D / 2}; pg8::Sched2 S; S.init2(T, 2 * FFD, G, bx, rstab); S.rsrc = (const float*)(ws + WS_SA); S.rmode = 2; S.wgm = 4;
                EpiSwigluF8 E{(bf16_t*)(ws + WS_HFF), FFD, rstab, (const float*)(ws + WS_SW) + SW_FF, FFD, nullptr, 0};
                GEMM_PHASE(EpiSwigluF8, g, S, E); __syncthreads(); }
#else
                pg8::Gemm g{(const bf16_t*)(ws + WS_X1B), (const bf16_t*)(ws + WS_WFF13), T, 2 * FFD, D}; pg8::Sched2 S; S.init2(T, 2 * FFD, G, bx, rstab); S.rsrc = (const float*)(ws + WS_SS); S.rmode = 1; S.wgm = 4;
                pg8::EpiSwiglu<false> E{(bf16_t*)(ws + WS_HFF), FFD, rstab, nullptr, 0, nullptr, 0};
                GEMM_PHASE(pg8::EpiSwiglu<false>, g, S, E); __syncthreads(); }
#endif
            }
            SEAM(8);
            if (IN(9)) { PHASE_BEGIN();
                pg8::Gemm g{(const bf16_t*)(ws + WS_HFF), (const bf16_t*)(ws + WS_WFF2), T, D, FFD / 2}; pg8::Sched2 S; S.init2(T, D, G, bx, rstab);
                pg8::EpiResB8 E{(bf16_t*)(ws + WS_XS), (const float*)(ws + WS_SW) + SW_W2 + 8 * 1024};
                GEMM_PHASE(pg8::EpiResB8, g, S, E); __syncthreads();
            }
            SEAM(9);
            if (IN(10) && I8_A) { PHASE_BEGIN(); phase_quant_rows((const bf16_t*)(ws + WS_XS), ws, lane, wave); }
            SEAM(10);
        }
    }
    if (IN(15)) { PHASE_BEGIN(); phase_route(ws, (const bf16_t*)(ws + WS_XS), lds, tid, lane, wave); }
    SEAM(15);
    if (IN(16)) { PHASE_BEGIN(); build_texp(ws, texp, tid); phase_gather(ws, (const bf16_t*)(ws + WS_XS), texp, lane, wave); }
    SEAM(16);
    for (int k = 0; k < 4; ++k) {
        if (IN(17 + k)) { PHASE_BEGIN();
            build_texp(ws, texp, tid);
            const int ntot = texp[169];
            const int kd = k - 1, ku = k;
            int ntd = 0, ntu = 0;
            if (kd >= 0) { ntd = ntot - MOE_CH * kd; const int cap = (kd == 2) ? MOE_CHL : MOE_CH; ntd = ntd < 0 ? 0 : (ntd > cap ? cap : ntd); }
            if (ku <= 2) { ntu = ntot - MOE_CH * ku; const int cap = (ku == 2) ? MOE_CHL : MOE_CH; ntu = ntu < 0 ? 0 : (ntu > cap ? cap : ntu); }
            const int nX = ntd * 4, nU = ntu * 28;
            const bool mixed = (nX > 0 && nU > 0);
            const int tf = (nU + DNW * nX) / 256, rem = (nU + DNW * nX) - 256 * tf;
            const bool weighted = mixed && tf >= DNW && nX <= 256 && G == 256;
            if (nX > 0) {
                const int t0 = MOE_CH * kd;
                pg8::Gemm g{(const bf16_t*)(ws + WS_HCH + (size_t)(kd & 1) * HCH_BYTES), (const bf16_t*)(ws + WS_WMOE2), ntd * 256, D, FFE / 2};
                pg8::Sched2 S; S.init2(ntd * 256, D, G, bx, rstab); S.texp = texp; S.estride = (size_t)7 * MiB; S.t0 = t0;
                if (weighted) { const int vc = (bx & 7) * 32 + (bx >> 3); S.rng = 1; S.rng_start = vc; S.rng_cnt = (vc < nX) ? 1 : 0; }
                pg8::EpiStoreF8 E{(bf16_t*)(ws + WS_Y) + (size_t)t0 * 256 * D, D, (const float*)(ws + WS_SW) + SW_W2, texp, t0};
                for (int rep_ = 0; rep_ < REP_DN; ++rep_) { GEMM_PHASE(pg8::EpiStoreF8, g, S, E); __syncthreads(); }
            }
            if (nU > 0) {
                size_t z3_ = 0; asm volatile("" : "+s"(z3_), "+s"(G), "+s"(bx)); ws = args.ws + z3_;
                const int t0 = MOE_CH * ku;
                pg8::Gemm g{(const bf16_t*)(ws + WS_XGY + (size_t)t0 * 256 * D), (const bf16_t*)(ws + WS_WMOE13), ntu * 256, 2 * FFE, D / 2};
                pg8::Sched2 S; S.init2(ntu * 256, 2 * FFE, G, bx, rstab); S.rsrc = (const float*)(ws + WS_XGRS); S.rmode = 2; S.rrow0 = t0 * 256; S.texp = texp; S.estride = (size_t)7 * MiB; S.t0 = t0;
                if (weighted) { const int vc = (bx & 7) * 32 + (bx >> 3); const int cmin = vc < nX ? vc : nX, over = vc - (256 - rem); S.rng = 1; S.rng_start = vc * tf - DNW * cmin + (over > 0 ? over : 0); S.rng_cnt = tf - (vc < nX ? DNW : 0) + (vc >= 256 - rem ? 1 : 0); }
                EpiSwigluF8 E{(bf16_t*)(ws + WS_HCH + (size_t)(ku & 1) * HCH_BYTES), FFE, rstab, (const float*)(ws + WS_SW) + SW_MOE, FFE, texp, t0};
                for (int rep_ = 0; rep_ < REP_UP; ++rep_) { GEMM_PHASE(EpiSwigluF8, g, S, E); __syncthreads(); }
            }
        }
        SEAM(17 + k);
    }
    if (IN(21)) { PHASE_BEGIN(); build_texp(ws, texp, tid); phase_combine(ws, (const bf16_t*)(ws + WS_XS), out, texp, lane, wave); }
#undef IN
#undef SEAM
}

extern "C" void kernel_launch(void* const* d_in, const int* in_sizes, int n_in, void* d_out, int out_size, void* d_ws, size_t ws_size, hipStream_t stream) {
    static int grid = 0;
    if (grid == 0) {
        if (n_in != 31 || out_size != T * D || ws_size < WS_END) { fprintf(stderr, "kernel_launch: unexpected problem (n_in %d, out %d, ws %zu < %zu)\n", n_in, out_size, ws_size, (size_t)WS_END); grid = -1; return; }
        int dev = 0, cus = 0, per_cu = 0;
        if (hipGetDevice(&dev) != hipSuccess || hipDeviceGetAttribute(&cus, hipDeviceAttributeMultiprocessorCount, dev) != hipSuccess) { grid = -1; return; }
        if (hipFuncSetAttribute((const void*)fwd_kernel, hipFuncAttributeMaxDynamicSharedMemorySize, LDS_BYTES) != hipSuccess) { fprintf(stderr, "kernel_launch: hipFuncSetAttribute failed\n"); grid = -1; return; }
        if (hipOccupancyMaxActiveBlocksPerMultiprocessor(&per_cu, (const void*)fwd_kernel, NTHR, LDS_BYTES) != hipSuccess || per_cu < 1) { fprintf(stderr, "kernel_launch: occupancy query says %d\n", per_cu); grid = -1; (void)hipGetLastError(); return; }
        grid = cus;
    }
    if (grid < 0) return;
    if (hipMemsetAsync(d_ws, 0, CTL_ZERO_BYTES, stream) != hipSuccess) return;
    Args a{};
    for (int i = 0; i < 31; ++i) a.in[i] = (const float*)d_in[i];
    a.out = (float*)d_out; a.ws = (unsigned char*)d_ws;
#ifndef PROBE_EXTRA_REPS
#define PROBE_EXTRA_REPS 1
#endif
#ifdef PROBE_EXTRA_PROLOGUE
    a.ph_lo = 0; a.ph_hi = 1; hipLaunchKernelGGL(fwd_kernel, dim3(grid), dim3(NTHR), LDS_BYTES, stream, a);
#endif
#ifdef PROBE_EXTRA_PHASE
    for (int r_ = 0; r_ < PROBE_EXTRA_REPS; ++r_) { a.ph_lo = PROBE_EXTRA_PHASE; a.ph_hi = PROBE_EXTRA_PHASE + 1; hipLaunchKernelGGL(fwd_kernel, dim3(grid), dim3(NTHR), LDS_BYTES, stream, a); }
#endif
    if (MK_N_LAUNCHES == 1) { a.ph_lo = 0; a.ph_hi = NPH; hipLaunchKernelGGL(fwd_kernel, dim3(grid), dim3(NTHR), LDS_BYTES, stream, a); }
    else for (int p = 0; p < NPH; ++p) { a.ph_lo = p; a.ph_hi = p + 1; hipLaunchKernelGGL(fwd_kernel, dim3(grid), dim3(NTHR), LDS_BYTES, stream, a); }
#ifdef PROBE_POST_PHASE
    for (int r_ = 0; r_ < PROBE_EXTRA_REPS; ++r_) { a.ph_lo = PROBE_POST_PHASE; a.ph_hi = PROBE_POST_PHASE + 1; hipLaunchKernelGGL(fwd_kernel, dim3(grid), dim3(NTHR), LDS_BYTES, stream, a); }
#endif
}
```

```cpp
#include <hip/hip_runtime.h>
#include <cstdio>
#include <cstdint>
#define MK_N_LAUNCHES 1
#ifndef USE_I8
#define USE_I8 1
#endif
#ifndef I8_A
#define I8_A 1
#endif
#ifndef I8_E
#define I8_E 1
#endif
#ifndef REP_MEM
#define REP_MEM 1
#endif
#ifndef REP_D
#define REP_D 1
#endif
#ifndef REP_F
#define REP_F 1
#endif
#ifndef REP_Z
#define REP_Z 1
#endif
#ifndef REP_E
#define REP_E 1
#endif
#ifndef REP_DN
#define REP_DN 1
#endif
#ifndef REP_MG
#define REP_MG 1
#endif
#ifndef REP_POOL
#define REP_POOL 1
#endif
#ifndef REP_GA
#define REP_GA 1
#endif
#ifndef REP_PRO
#define REP_PRO 1
#endif
#ifndef REP_A
#define REP_A 1
#endif
#ifndef REP_DA
#define REP_DA 1
#endif
#ifndef REP_C
#define REP_C 1
#endif
#ifndef REP_UP
#define REP_UP 1
#endif

constexpr int NWAVES = 8, NTHR = 512;
constexpr int T = 16384, D = 1024, SEQ = 2048, NBATCH = 8, MEML = 256;
constexpr int NGEMM1 = 7168, FFD = 2816, FFE = 3584, NEXP = 8;
constexpr float LOG2E = 1.4426950408889634f;
constexpr float QSCALE = 0.125f * LOG2E;
constexpr float MEMSCALE = 0.08838834764831845f * LOG2E;
#ifndef MK_N_LAUNCHES
#define MK_N_LAUNCHES 1
#endif
constexpr int NPH = 22;
constexpr int MOE_CH = 45, MOE_CHL = 46;

constexpr size_t MiB = 1u << 20;
constexpr size_t CTL_ZERO_BYTES = 1 * MiB;
constexpr size_t WS_SS = 1 * MiB;
constexpr size_t WS_MQSS = 2 * MiB;
constexpr size_t WS_SSM = 2 * MiB + 512 * 1024;
constexpr size_t WS_TOKE = WS_SSM + 128 * 1024;
constexpr size_t WS_TOKP = WS_TOKE + 128 * 1024;
constexpr size_t WS_TOKG = WS_TOKP + 128 * 1024;
constexpr size_t WS_TOKR = WS_TOKG + 128 * 1024;
constexpr size_t WS_SC = WS_TOKR + 64 * 1024;
constexpr size_t WS_XGRS = WS_SC + 4096;
constexpr size_t WS_PARAM = 3 * MiB + 256 * 1024;
constexpr int PB_BGATE = 0, PB_GQ = 6144, PB_GK = 6400, PB_GOUT = 6656, PB_POOLS = 6912, PB_MQN = 7936, PB_MKN = 8192, PB_GFFN1 = 8448, PB_WR = 9472, PB_POOLW = 17664, PB_END = 17664 + 131072;
constexpr size_t WS_W1T = 4 * MiB;
constexpr size_t WS_WMEMKV = 32 * MiB;
constexpr size_t WS_WBRDA = 36 * MiB;
constexpr size_t WS_WBRPOOL = 40 * MiB;
constexpr size_t WS_WBRMEM = 42 * MiB;
constexpr size_t WS_WOUT = 44 * MiB;
constexpr size_t WS_WFF13 = 48 * MiB;
constexpr size_t WS_WFF2 = 59 * MiB;
constexpr size_t WS_SW = WS_WFF13 + 6 * MiB;
constexpr int SW_G1 = 0, SW_FF = 2 * 7168, SW_MOE = SW_FF + 2 * 2816, SW_W2 = SW_MOE + 8 * 2 * 3584, SW_END = SW_W2 + 9 * 1024;
constexpr float H8_SCALE = 8.0f;
#ifndef DA_LOOP_ALIGN
#define DA_LOOP_ALIGN ".p2align 6"
#endif
constexpr int DNW = 2;
constexpr size_t SW_BYTES = (size_t)SW_END * 4;
constexpr size_t WS_WMOE13 = 65 * MiB;
constexpr size_t WS_XS = WS_WMOE13 + 56 * MiB;
constexpr size_t WS_WMOE2 = 177 * MiB;
constexpr size_t WS_XB = 233 * MiB;
constexpr size_t WS_QX = WS_XB, WS_SA = 1 * MiB;
constexpr size_t WS_MEMKV = 265 * MiB;
constexpr size_t WS_R = 273 * MiB;
constexpr size_t WS_Q = WS_R, WS_K = WS_R + 32 * MiB, WS_V = WS_R + 64 * MiB, WS_P = WS_R + 96 * MiB, WS_MQ = WS_R + 112 * MiB, WS_OPOOL = WS_R + 128 * MiB, WS_G = WS_R + 144 * MiB, WS_MEMBF = WS_R + 240 * MiB, WS_POOLWT = WS_R + 244 * MiB;
constexpr size_t WS_MF = WS_K, WS_X1B = WS_K, WS_HFF = WS_R + 144 * MiB;
constexpr size_t WS_XGY = WS_MEMKV;
constexpr size_t WS_Y = WS_XGY + 34 * MiB;
constexpr size_t WS_HCH = WS_Y + 68 * MiB, HCH_BYTES = (size_t)MOE_CHL * 256 * 7168;
constexpr size_t WS_END = 529 * MiB;
static_assert(WS_XGRS + 34816 * 4 <= WS_PARAM && WS_PARAM + (size_t)PB_END * 4 <= WS_W1T && WS_HCH + 2 * HCH_BYTES <= WS_END && WS_SW + SW_BYTES <= WS_WFF2, "d_ws map");
constexpr int CW_CNT = 64;
constexpr int CW_WCNT = 1024;
constexpr int CW_BAR = 4096;

constexpr int RING_BYTES = 131072;
constexpr int RS_OFF = 131072, RS_UNITS = 16;
constexpr int TEXP_OFF = RS_OFF + RS_UNITS * 1024;
constexpr int LDS_BYTES = 155648;
constexpr int MISC_OFF = LDS_BYTES - 256;

namespace pg8 {
#define PG8_LAS __attribute__((address_space(3)))
typedef unsigned short bf16_t;
typedef short bf16x8 __attribute__((ext_vector_type(8)));
typedef float f32x4 __attribute__((ext_vector_type(4)));
typedef unsigned u32x4 __attribute__((ext_vector_type(4)));
constexpr int BM = 256, BK = 64, HALF = 128, HTB = HALF * BK * 2  , STAGE_BYTES = 8 * HTB, NXCD = 8, WGM = 8;

__host__ __device__ __forceinline__ int lds_byte(int r, int c) { const int st = (r >> 4) * 2 + (c >> 5), rr = r & 15, cc = c & 31, ob = rr * 64 + cc * 2; return st * 1024 + (ob ^ (((ob >> 9) & 1) << 5)); }
__host__ __device__ __forceinline__ void stage_rc(int b, int& R, int& C) { const int st = b / 1024, sb = b % 1024, swz = sb ^ (((sb >> 9) & 1) << 5); R = (st >> 1) * 16 + swz / 64; C = (st & 1) * 32 + (swz % 64) / 2; }
__host__ __device__ __forceinline__ int perm32(int rho) { const int n = rho >> 4, i = rho & 15; return 8 * (i >> 2) + 4 * n + (i & 3); }

struct Unit { int pm, pn, idx; };
struct Gemm { const bf16_t* A; const bf16_t* Bt; int M, N, K; };

struct StaticOrder {
    int nM, nN, nwg, G, c, wgm;
    __host__ __device__ void init(int M, int N, int G_, int c_) { nM = M / BM; nN = N / BM; nwg = nM * nN; G = G_; c = c_; wgm = WGM; }
    __host__ __device__ bool next(int i, Unit& u) const {
        const long L = (long)i * G + c; if (L >= nwg) return false;
        int wgid = (int)L; { const int q = nwg / NXCD, r = nwg % NXCD, xcd = wgid % NXCD, off = wgid / NXCD; wgid = (xcd < r ? xcd * (q + 1) : r * (q + 1) + (xcd - r) * q) + off; }
        const int nig = wgm * nN, gid = wgid / nig, fm = gid * wgm, gsz = (nM - fm) < wgm ? (nM - fm) : wgm;
        u.pm = fm + ((wgid % nig) % gsz); u.pn = (wgid % nig) / gsz; u.idx = i; return true;
    }
    __device__ __forceinline__ const char* bptr(const Gemm& g, const Unit& u, size_t tstep) const { return (const char*)g.Bt + (size_t)u.pn * tstep; }
    __device__ __forceinline__ const char* aptr(const Gemm& g, const Unit& u, size_t tstep) const { return (const char*)g.A + (size_t)u.pm * tstep; }
    __device__ __forceinline__ void a_ready(const Unit&) const {}
    __device__ __forceinline__ void done(const Unit&) const {}
};


typedef float f32x2 __attribute__((ext_vector_type(2)));
typedef __bf16 bf16x2_t __attribute__((ext_vector_type(2)));
__device__ __forceinline__ unsigned pk_bf16(float lo, float hi) { f32x2 v = {lo, hi}; bf16x2_t b = __builtin_convertvector(v, bf16x2_t); return __builtin_bit_cast(unsigned, b); }
__device__ __forceinline__ u32x4 pk8(const f32x4 a, const f32x4 b) { u32x4 w; w.x = pk_bf16(a[0], a[1]); w.y = pk_bf16(a[2], a[3]); w.z = pk_bf16(b[0], b[1]); w.w = pk_bf16(b[2], b[3]); return w; }
__device__ __forceinline__ float bf_lo(unsigned w) { return __builtin_bit_cast(float, w << 16); }
__device__ __forceinline__ float bf_hi(unsigned w) { return __builtin_bit_cast(float, w & 0xffff0000u); }
__device__ __forceinline__ float sigmoid_f(float x) { return __builtin_amdgcn_rcpf(1.0f + __builtin_amdgcn_exp2f(-1.4426950408889634f * x)); }
typedef int i32x8 __attribute__((ext_vector_type(8)));
typedef int i32x4 __attribute__((ext_vector_type(4)));
__device__ __forceinline__ f32x4 mma_f8(const i32x8 a, const i32x8 b, f32x4 c) { const int one = 0x7f7f7f7f; asm volatile("v_mfma_scale_f32_16x16x128_f8f6f4 %0, %1, %2, %0, %3, %3 op_sel_hi:[0,0,0]" : "+v"(c) : "v"(a), "v"(b), "v"(one)); return c; }
__device__ __forceinline__ unsigned pk_fp8x4(float a, float b, float c, float d) { int w = __builtin_amdgcn_cvt_pk_fp8_f32(a, b, 0, false); w = __builtin_amdgcn_cvt_pk_fp8_f32(c, d, w, true); return (unsigned)w; }
constexpr float RMS_EPS = 1e-6f;
typedef int i32x4 __attribute__((ext_vector_type(4)));
template <bool I8> __device__ __forceinline__ f32x4 mma16(const bf16x8 a, const bf16x8 b, const f32x4 c) {
    if constexpr (I8) return __builtin_bit_cast(f32x4, __builtin_amdgcn_mfma_i32_16x16x64_i8(__builtin_bit_cast(i32x4, a), __builtin_bit_cast(i32x4, b), __builtin_bit_cast(i32x4, c), 0, 0, 0));
    else return __builtin_amdgcn_mfma_f32_16x16x32_bf16(a, b, c, 0, 0, 0);
}
template <bool I8> __device__ __forceinline__ f32x4 accf(const f32x4 a) {
    if constexpr (I8) { const i32x4 v = __builtin_bit_cast(i32x4, a); return (f32x4){(float)v[0], (float)v[1], (float)v[2], (float)v[3]}; } else return a;
}


struct Sched2 : StaticOrder {
    const float* rsrc; int rmode;
    int rrow0;
    PG8_LAS float* rtab;
    const PG8_LAS int* texp; size_t estride; int t0;
    int rng, rng_start, rng_cnt;
    const bf16_t* A2; const bf16_t* B2; int chain;
    __device__ __forceinline__ void init2(int M, int N, int G_, int c_, PG8_LAS float* tab) { init(M, N, G_, c_); rsrc = nullptr; rmode = 0; rrow0 = 0; rtab = tab; texp = nullptr; estride = 0; t0 = 0; A2 = nullptr; B2 = nullptr; chain = 0; rng = 0; rng_start = 0; rng_cnt = 0; }
    __device__ __forceinline__ bool next(int i, Unit& u) const {
        if (rng != 0) { if (i >= rng_cnt) return false; const int q = rng_start + i; u.pm = q / nN; u.pn = q - u.pm * nN; u.idx = i; return true; }
        if (chain == 0) return StaticOrder::next(i, u); if (i >= chain || !StaticOrder::next(0, u)) return false; u.idx = i; return true; }
    __device__ __forceinline__ const char* aptr(const Gemm& g, const Unit& u, size_t tstep) const { return (const char*)((chain != 0 && u.idx == 1) ? A2 : g.A) + (size_t)u.pm * tstep; }
    __device__ __forceinline__ const char* bptr(const Gemm& g, const Unit& u, size_t tstep) const {
        const char* b = (const char*)((chain != 0 && u.idx == 1) ? B2 : g.Bt) + (size_t)u.pn * tstep;
        if (texp) b += (size_t)texp[t0 + u.pm] * estride;
        return b;
    }
    __device__ __forceinline__ void a_ready(const Unit&) const {}
    __device__ __forceinline__ void prep() const {
        if (rmode == 0) return;
        int tid = threadIdx.x; asm volatile("" : "+v"(tid));
        if (tid < 256) {
            Unit u;
#pragma unroll 1
            for (int i = 0; i < 16 && next(i, u); ++i) {
                const size_t row = (size_t)rrow0 + (size_t)u.pm * 256 + tid; float sc;
                if (rmode == 1) { const f32x4* p = (const f32x4*)(rsrc + row * 16); const f32x4 a = p[0], b = p[1], c = p[2], d = p[3];
                    const float s = ((a[0] + a[1]) + (a[2] + a[3])) + ((b[0] + b[1]) + (b[2] + b[3])) + ((c[0] + c[1]) + (c[2] + c[3])) + ((d[0] + d[1]) + (d[2] + d[3]));
                    sc = __builtin_amdgcn_rsqf(s * (1.0f / 1024.0f) + RMS_EPS); }
                else sc = rsrc[row];
                rtab[i * 256 + tid] = sc;
            }
        }
    }
    __device__ __forceinline__ void done(const Unit&) const {}
};

template <bool RS> struct EpiStore {
    static constexpr bool PERM = false, AFTER_DRAIN = false, I8 = false, F8 = false;
    bf16_t* O; int ldc; const PG8_LAS float* rs;
    __device__ __forceinline__ void operator()(const f32x4 (&acc)[2][2][4][2], const Unit& u, int wr, int wc, int fr, int fq) const {
        const int rl = wr * 64 + fr; const size_t row0 = (size_t)u.pm * BM + rl; const int col0 = u.pn * BM + 64 * wc + 8 * fq;
#pragma unroll
        for (int ai = 0; ai < 2; ++ai)
#pragma unroll
            for (int m = 0; m < 4; ++m) { const float sc = RS ? rs[u.idx * 256 + rl + ai * HALF + m * 16] : 1.f; bf16_t* rowp = O + (row0 + ai * HALF + m * 16) * ldc + col0;
#pragma unroll
                for (int bj = 0; bj < 2; ++bj) *(u32x4*)(rowp + 32 * bj) = pk8(acc[ai][bj][m][0] * sc, acc[ai][bj][m][1] * sc); }
    }
};

template <bool I8_> struct EpiA {
    static constexpr bool PERM = false, AFTER_DRAIN = false, I8 = I8_, F8 = false;
    unsigned char* ws; int l; const PG8_LAS float* rs;
    __device__ __forceinline__ void operator()(const f32x4 (&acc)[2][2][4][2], const Unit& u, int wr, int wc, int fr, int fq) const {
        const int pn = u.pn, rl = wr * 64 + fr; const size_t row0 = (size_t)u.pm * BM + rl; const PG8_LAS float* rsp = rs + u.idx * 256 + rl;
        const float* prm = (const float*)(ws + WS_PARAM);
        f32x4 cw[2][2];
#pragma unroll
        for (int bj = 0; bj < 2; ++bj)
#pragma unroll
            for (int n = 0; n < 2; ++n) { if constexpr (I8_) cw[bj][n] = *(const f32x4*)((const float*)(ws + WS_SW) + SW_G1 + l * 7168 + pn * 256 + 64 * wc + 32 * bj + 8 * fq + 4 * n) * (1.0f / 127.0f); else cw[bj][n] = (f32x4){1.f, 1.f, 1.f, 1.f}; }
#define EA_V(ai, bj, m, n) (accf<I8_>(acc[ai][bj][m][n]) * cw[bj][n])
        if (pn < 8) {
            const bool isq = pn < 4; const float* gg = prm + (isq ? PB_GQ : PB_GK) + l * 128 + (wc & 1) * 64 + 8 * fq; const float mul = isq ? QSCALE : 1.f;
            f32x4 gv[2][2];
#pragma unroll
            for (int bj = 0; bj < 2; ++bj)
#pragma unroll
                for (int n = 0; n < 2; ++n) gv[bj][n] = *(const f32x4*)(gg + 32 * bj + 4 * n);
            bf16_t* base = (bf16_t*)(ws + (isq ? WS_Q : WS_K)) + (pn & 3) * 256 + 64 * wc + 8 * fq;
#pragma unroll
            for (int ai = 0; ai < 2; ++ai)
#pragma unroll
                for (int m = 0; m < 4; ++m) { const float sc = rsp[ai * HALF + m * 16];
                    f32x4 v[2][2]; float ss = 0.f;
#pragma unroll
                    for (int bj = 0; bj < 2; ++bj)
#pragma unroll
                        for (int n = 0; n < 2; ++n) { v[bj][n] = EA_V(ai, bj, m, n) * sc; const f32x4 x = v[bj][n]; ss += (x[0] * x[0] + x[1] * x[1]) + (x[2] * x[2] + x[3] * x[3]); }
                    ss += __shfl_xor(ss, 16); ss += __shfl_xor(ss, 32);
                    const float r = __builtin_amdgcn_rsqf(ss * (1.0f / 64.0f) + RMS_EPS) * mul;
                    bf16_t* rowp = base + (row0 + ai * HALF + m * 16) * 1024;
#pragma unroll
                    for (int bj = 0; bj < 2; ++bj) *(u32x4*)(rowp + 32 * bj) = pk8(v[bj][0] * gv[bj][0] * r, v[bj][1] * gv[bj][1] * r); }
        } else if (pn < 14) {
            bf16_t* base; int ldc;
            if (pn < 12) { base = (bf16_t*)(ws + WS_V) + (pn - 8) * 256; ldc = 1024; } else { base = (bf16_t*)(ws + WS_P) + (pn - 12) * 256; ldc = 512; }
            base += 64 * wc + 8 * fq;
#pragma unroll
            for (int ai = 0; ai < 2; ++ai)
#pragma unroll
                for (int m = 0; m < 4; ++m) { const float sc = rsp[ai * HALF + m * 16]; bf16_t* rowp = base + (row0 + ai * HALF + m * 16) * ldc;
#pragma unroll
                    for (int bj = 0; bj < 2; ++bj) *(u32x4*)(rowp + 32 * bj) = pk8(EA_V(ai, bj, m, 0) * sc, EA_V(ai, bj, m, 1) * sc); }
        } else if (pn < 16) {
            bf16_t* base = (bf16_t*)(ws + WS_MQ) + (pn - 14) * 256 + 64 * wc + 8 * fq; float* mqss = (float*)(ws + WS_MQSS);
#pragma unroll
            for (int ai = 0; ai < 2; ++ai)
#pragma unroll
                for (int m = 0; m < 4; ++m) { const float sc = rsp[ai * HALF + m * 16]; const size_t row = row0 + ai * HALF + m * 16; bf16_t* rowp = base + row * 512; float ss = 0.f;
#pragma unroll
                    for (int bj = 0; bj < 2; ++bj) { const f32x4 a = EA_V(ai, bj, m, 0) * sc, b = EA_V(ai, bj, m, 1) * sc;
                        ss += ((a[0] * a[0] + a[1] * a[1]) + (a[2] * a[2] + a[3] * a[3])) + ((b[0] * b[0] + b[1] * b[1]) + (b[2] * b[2] + b[3] * b[3]));
                        *(u32x4*)(rowp + 32 * bj) = pk8(a, b); }
                    ss += __shfl_xor(ss, 16); ss += __shfl_xor(ss, 32);
                    if (fq == 0) mqss[row * 8 + (pn - 14) * 4 + wc] = ss; }
        } else {
            const int gcol = (pn - 16) * 256 + 64 * wc + 8 * fq; unsigned char* base = (unsigned char*)(ws + WS_G) + gcol; const float* bgate = prm + PB_BGATE + l * 3072 + gcol;
            f32x4 bv[2][2];
#pragma unroll
            for (int bj = 0; bj < 2; ++bj)
#pragma unroll
                for (int n = 0; n < 2; ++n) bv[bj][n] = *(const f32x4*)(bgate + 32 * bj + 4 * n);
#pragma unroll
            for (int ai = 0; ai < 2; ++ai)
#pragma unroll
                for (int m = 0; m < 4; ++m) { const float sc = rsp[ai * HALF + m * 16]; unsigned char* rowp = base + (row0 + ai * HALF + m * 16) * 3072;
#pragma unroll
                    for (int bj = 0; bj < 2; ++bj) { f32x4 a = EA_V(ai, bj, m, 0) * sc + bv[bj][0], b = EA_V(ai, bj, m, 1) * sc + bv[bj][1];
#pragma unroll
                        for (int j = 0; j < 4; ++j) { a[j] = sigmoid_f(a[j]) * 255.0f + 0.5f; b[j] = sigmoid_f(b[j]) * 255.0f + 0.5f; }
                        const unsigned w0 = (unsigned)a[0] | ((unsigned)a[1] << 8) | ((unsigned)a[2] << 16) | ((unsigned)a[3] << 24), w1 = (unsigned)b[0] | ((unsigned)b[1] << 8) | ((unsigned)b[2] << 16) | ((unsigned)b[3] << 24);
                        *(unsigned long long*)(rowp + 32 * bj) = (unsigned long long)w0 | ((unsigned long long)w1 << 32); } }
        }
    }
};
#undef EA_V

struct EpiBr0 {
    static constexpr bool PERM = false, AFTER_DRAIN = false, I8 = false, F8 = false;
    unsigned char* ws;
    __device__ __forceinline__ void operator()(const f32x4 (&acc)[2][2][4][2], const Unit& u, int wr, int wc, int fr, int fq) const {
        const size_t row0 = (size_t)u.pm * BM + wr * 64 + fr; const int col0 = u.pn * BM + 64 * wc + 8 * fq;
        const unsigned char* G = (const unsigned char*)(ws + WS_G); bf16_t* MFb = (bf16_t*)(ws + WS_MF);
#pragma unroll
        for (int ai = 0; ai < 2; ++ai) { unsigned long long gw[4][2];
#pragma unroll
            for (int m = 0; m < 4; ++m)
#pragma unroll
                for (int bj = 0; bj < 2; ++bj) gw[m][bj] = *(const unsigned long long*)(G + (row0 + ai * HALF + m * 16) * 3072 + col0 + 32 * bj);
#pragma unroll
            for (int m = 0; m < 4; ++m) { const size_t row = row0 + ai * HALF + m * 16;
#pragma unroll
                for (int bj = 0; bj < 2; ++bj) { const int col = col0 + 32 * bj;
                    const unsigned glo = (unsigned)gw[m][bj], ghi = (unsigned)(gw[m][bj] >> 32);
                    const f32x4 g0 = (f32x4){(float)(glo & 255u), (float)((glo >> 8) & 255u), (float)((glo >> 16) & 255u), (float)(glo >> 24)} * (1.0f / 255.0f), g1 = (f32x4){(float)(ghi & 255u), (float)((ghi >> 8) & 255u), (float)((ghi >> 16) & 255u), (float)(ghi >> 24)} * (1.0f / 255.0f);
                    *(u32x4*)(MFb + row * 1024 + col) = pk8(acc[ai][bj][m][0] * g0, acc[ai][bj][m][1] * g1); } } }
    }
};
struct EpiBrC {
    static constexpr bool PERM = false, AFTER_DRAIN = false, I8 = false, F8 = false;
    unsigned char* ws;
    __device__ __forceinline__ void operator()(const f32x4 (&acc)[2][2][4][2], const Unit& u, int wr, int wc, int fr, int fq) const {
        const size_t row0 = (size_t)u.pm * BM + wr * 64 + fr; const int col0 = u.pn * BM + 64 * wc + 8 * fq;
        const unsigned char* G = (const unsigned char*)(ws + WS_G) + (1 + u.idx) * 1024; const bf16_t* MFb = (const bf16_t*)(ws + WS_MF); bf16_t* O = (bf16_t*)(ws + (u.idx == 0 ? WS_MF : WS_Q));
#pragma unroll
        for (int ai = 0; ai < 2; ++ai) { unsigned long long gw[4][2]; u32x4 mw[4][2];
#pragma unroll
            for (int m = 0; m < 4; ++m)
#pragma unroll
                for (int bj = 0; bj < 2; ++bj) { const size_t row = row0 + ai * HALF + m * 16; const int col = col0 + 32 * bj;
                    gw[m][bj] = *(const unsigned long long*)(G + row * 3072 + col); mw[m][bj] = *(const u32x4*)(MFb + row * 1024 + col); }
#pragma unroll
            for (int m = 0; m < 4; ++m) { const size_t row = row0 + ai * HALF + m * 16;
#pragma unroll
                for (int bj = 0; bj < 2; ++bj) { const int col = col0 + 32 * bj;
                    const unsigned glo = (unsigned)gw[m][bj], ghi = (unsigned)(gw[m][bj] >> 32); const u32x4 w = mw[m][bj];
                    const f32x4 g0 = (f32x4){(float)(glo & 255u), (float)((glo >> 8) & 255u), (float)((glo >> 16) & 255u), (float)(glo >> 24)} * (1.0f / 255.0f), g1 = (f32x4){(float)(ghi & 255u), (float)((ghi >> 8) & 255u), (float)((ghi >> 16) & 255u), (float)(ghi >> 24)} * (1.0f / 255.0f);
                    const f32x4 m0 = {bf_lo(w.x), bf_hi(w.x), bf_lo(w.y), bf_hi(w.y)}, m1 = {bf_lo(w.z), bf_hi(w.z), bf_lo(w.w), bf_hi(w.w)};
                    *(u32x4*)(O + row * 1024 + col) = pk8(acc[ai][bj][m][0] * g0 + m0, acc[ai][bj][m][1] * g1 + m1); } } }
    }
};

struct EpiRes {
    static constexpr bool PERM = false, AFTER_DRAIN = false, I8 = false, F8 = false;
    const float* xin; float* x; unsigned char* ws; size_t xb_off; size_t dry_off;
    __device__ __forceinline__ void operator()(const f32x4 (&acc)[2][2][4][2], const Unit& u, int wr, int wc, int fr, int fq) const {
        const size_t row0 = (size_t)u.pm * BM + wr * 64 + fr; const int col0 = u.pn * BM + 64 * wc + 8 * fq;
        float* xout = dry_off ? (float*)(ws + dry_off) : x; bf16_t* xb = (bf16_t*)(ws + xb_off); float* ss = (float*)(ws + WS_SS);
#pragma unroll
        for (int ai = 0; ai < 2; ++ai)
#pragma unroll
            for (int m = 0; m < 4; ++m) { const size_t row = row0 + ai * HALF + m * 16; float s2 = 0.f;
#pragma unroll
                for (int bj = 0; bj < 2; ++bj) { const size_t off = row * 1024 + col0 + 32 * bj;
                    const f32x4 a = *(const f32x4*)(xin + off) + acc[ai][bj][m][0], b = *(const f32x4*)(xin + off + 4) + acc[ai][bj][m][1];
                    *(f32x4*)(xout + off) = a; *(f32x4*)(xout + off + 4) = b;
                    if (xb_off) { *(u32x4*)(xb + off) = pk8(a, b); s2 += ((a[0] * a[0] + a[1] * a[1]) + (a[2] * a[2] + a[3] * a[3])) + ((b[0] * b[0] + b[1] * b[1]) + (b[2] * b[2] + b[3] * b[3])); } }
                if (xb_off) { s2 += __shfl_xor(s2, 16); s2 += __shfl_xor(s2, 32); if (fq == 0) ss[row * 16 + u.pn * 4 + wc] = s2; } }
    }
};

struct EpiResB {
    static constexpr bool PERM = false, AFTER_DRAIN = false, I8 = false, F8 = false;
    const float* xf; bf16_t* xs;
    __device__ __forceinline__ void operator()(const f32x4 (&acc)[2][2][4][2], const Unit& u, int wr, int wc, int fr, int fq) const {
        const size_t row0 = (size_t)u.pm * BM + wr * 64 + fr; const int col0 = u.pn * BM + 64 * wc + 8 * fq;
#pragma unroll
        for (int ai = 0; ai < 2; ++ai)
#pragma unroll
            for (int m = 0; m < 4; ++m) { const size_t row = row0 + ai * HALF + m * 16;
#pragma unroll
                for (int bj = 0; bj < 2; ++bj) { const size_t off = row * 1024 + col0 + 32 * bj; f32x4 a, b;
                    if (xf) { a = *(const f32x4*)(xf + off); b = *(const f32x4*)(xf + off + 4); }
                    else { const u32x4 w = *(const u32x4*)(xs + off); a = (f32x4){bf_lo(w.x), bf_hi(w.x), bf_lo(w.y), bf_hi(w.y)}; b = (f32x4){bf_lo(w.z), bf_hi(w.z), bf_lo(w.w), bf_hi(w.w)}; }
                    *(u32x4*)(xs + off) = pk8(a + acc[ai][bj][m][0], b + acc[ai][bj][m][1]); } }
    }
};

template <bool I8_, bool OUT8 = false> struct EpiSwiglu {
    static constexpr bool PERM = false, AFTER_DRAIN = false, I8 = I8_, F8 = false;
    bf16_t* H; int ldc; const PG8_LAS float* rs; const float* cmax; int nh;
    const PG8_LAS int* texp; int t0;
    __device__ __forceinline__ void operator()(const f32x4 (&acc)[2][2][4][2], const Unit& u, int wr, int wc, int fr, int fq) const {
        const int rl = wr * 64 + fr; const size_t row0 = (size_t)u.pm * BM + rl; const int col0 = u.pn * 128 + 32 * wc + 8 * fq;
        f32x4 c1[2], c3[2];
#pragma unroll
        for (int bj = 0; bj < 2; ++bj) { if constexpr (I8_) { const float* cm = cmax + (texp ? (size_t)texp[t0 + u.pm] * 2 * nh : 0) + col0 + 4 * bj; c1[bj] = *(const f32x4*)cm * (1.0f / 127.0f); c3[bj] = *(const f32x4*)(cm + nh) * (OUT8 ? H8_SCALE / 127.0f : 1.0f / 127.0f); } else { c1[bj] = (f32x4){1.f, 1.f, 1.f, 1.f}; c3[bj] = c1[bj]; } }
#pragma unroll
        for (int ai = 0; ai < 2; ++ai)
#pragma unroll
            for (int m = 0; m < 4; ++m) { const float sc = rs[u.idx * 256 + rl + ai * HALF + m * 16]; f32x4 h[2];
#pragma unroll
                for (int bj = 0; bj < 2; ++bj) { const f32x4 a = accf<I8_>(acc[ai][bj][m][0]) * c1[bj] * sc, b = accf<I8_>(acc[ai][bj][m][1]) * c3[bj] * sc;
#pragma unroll
                    for (int j = 0; j < 4; ++j) h[bj][j] = a[j] * sigmoid_f(a[j]) * b[j]; }
                if constexpr (OUT8) {
#pragma unroll
                    for (int bj = 0; bj < 2; ++bj)
#pragma unroll
                        for (int j = 0; j < 4; ++j) h[bj][j] = __builtin_fminf(__builtin_fmaxf(h[bj][j], -448.0f), 448.0f);
                    const unsigned w0 = pk_fp8x4(h[0][0], h[0][1], h[0][2], h[0][3]), w1 = pk_fp8x4(h[1][0], h[1][1], h[1][2], h[1][3]);
                    *(unsigned long long*)((unsigned char*)H + (row0 + ai * HALF + m * 16) * ldc + col0) = (unsigned long long)w0 | ((unsigned long long)w1 << 32);
                } else *(u32x4*)(H + (row0 + ai * HALF + m * 16) * ldc + col0) = pk8(h[0], h[1]); }
    }
};

struct EpiStoreF8 {
    static constexpr bool PERM = false, AFTER_DRAIN = false, I8 = false, F8 = true;
    bf16_t* O; int ldc; const float* cs; const PG8_LAS int* texp; int t0;
    __device__ __forceinline__ void operator()(const f32x4 (&acc)[2][2][4][2], const Unit& u, int wr, int wc, int fr, int fq) const {
        const int rl = wr * 64 + fr; const size_t row0 = (size_t)u.pm * BM + rl; const int col0 = u.pn * BM + 64 * wc + 8 * fq;
        const float* c = cs + (texp ? (size_t)texp[t0 + u.pm] * 1024 : 0) + col0; f32x4 cw[2][2];
#pragma unroll
        for (int bj = 0; bj < 2; ++bj)
#pragma unroll
            for (int n = 0; n < 2; ++n) cw[bj][n] = *(const f32x4*)(c + 32 * bj + 4 * n);
#pragma unroll
        for (int ai = 0; ai < 2; ++ai)
#pragma unroll
            for (int m = 0; m < 4; ++m) { bf16_t* rowp = O + (row0 + ai * HALF + m * 16) * ldc + col0;
#pragma unroll
                for (int bj = 0; bj < 2; ++bj) *(u32x4*)(rowp + 32 * bj) = pk8(acc[ai][bj][m][0] * cw[bj][0], acc[ai][bj][m][1] * cw[bj][1]); }
    }
};
struct EpiResB8 {
    static constexpr bool PERM = false, AFTER_DRAIN = false, I8 = false, F8 = true;
    bf16_t* xs; const float* cs;
    __device__ __forceinline__ void operator()(const f32x4 (&acc)[2][2][4][2], const Unit& u, int wr, int wc, int fr, int fq) const {
        const size_t row0 = (size_t)u.pm * BM + wr * 64 + fr; const int col0 = u.pn * BM + 64 * wc + 8 * fq; f32x4 cw[2][2];
#pragma unroll
        for (int bj = 0; bj < 2; ++bj)
#pragma unroll
            for (int n = 0; n < 2; ++n) cw[bj][n] = *(const f32x4*)(cs + col0 + 32 * bj + 4 * n);
#pragma unroll
        for (int ai = 0; ai < 2; ++ai)
#pragma unroll
            for (int m = 0; m < 4; ++m) { const size_t row = row0 + ai * HALF + m * 16;
#pragma unroll
                for (int bj = 0; bj < 2; ++bj) { const size_t off = row * 1024 + col0 + 32 * bj; const u32x4 w = *(const u32x4*)(xs + off);
                    const f32x4 a = {bf_lo(w.x), bf_hi(w.x), bf_lo(w.y), bf_hi(w.y)}, b = {bf_lo(w.z), bf_hi(w.z), bf_lo(w.w), bf_hi(w.w)};
                    *(u32x4*)(xs + off) = pk8(a + acc[ai][bj][m][0] * cw[bj][0], b + acc[ai][bj][m][1] * cw[bj][1]); } }
    }
};
template <class Epi, class Sched, bool ALIGN_EPI = false, bool SP2 = false>
__device__ __forceinline__ void gemm_phase(PG8_LAS unsigned char* lds, const Gemm g, const Sched& S, const Epi& E) {
    int tid_ = threadIdx.x; asm volatile("" : "+v"(tid_));
    const int tid = tid_, wid = __builtin_amdgcn_readfirstlane(tid >> 6), lane = tid & 63, wr = wid >> 2, wc = wid & 3, fr = lane & 15, fq = lane >> 4;
    const int K = g.K, nt = K / BK;
    unsigned voffA[2], voffB[2];
#pragma unroll
    for (int i = 0; i < 2; ++i) { int R, C; stage_rc(tid * 16 + i * 8192, R, C); const int Rb = Epi::PERM ? ((R & ~31) + perm32(R & 31)) : R;
        voffA[i] = (unsigned)(R * K + C) * 2u; voffB[i] = (unsigned)(Rb * K + C) * 2u; }
    const size_t kstep = (size_t)(BK * 2);
    const size_t hstep = (size_t)HALF * K * 2;
    const size_t tstep = 2 * hstep;
    const unsigned ldsw = (unsigned)wid * 1024u;
    const int aoff = lds_byte(wr * 64 + fr, fq * 8), boff = lds_byte(wc * 32 + fr, fq * 8);
#define PG8_SA(b, h) (((b) * 2 + (h)) * HTB)
#define PG8_SB(b, h) ((4 + (b) * 2 + (h)) * HTB)
#define PG8_STAGE(bufoff, gbase, voff) do { _Pragma("unroll") for (int _i = 0; _i < 2; ++_i) \
        __builtin_amdgcn_global_load_lds((const unsigned*)((const char*)(gbase) + (voff)[_i]), (PG8_LAS unsigned*)(lds + (bufoff) + ldsw + _i * 8192), 16, 0, 0); } while (0)
#define PG8_LDA(dst, b, h) do { if constexpr (Epi::F8) { _Pragma("unroll") for (int m = 0; m < 4; ++m) { const i32x4 lo_ = *(const PG8_LAS i32x4*)(lds + PG8_SA(b, h) + aoff + m * 2048), hi_ = *(const PG8_LAS i32x4*)(lds + PG8_SA(b, h) + aoff + m * 2048 + 1024); dst##8[m] = __builtin_shufflevector(lo_, hi_, 0, 1, 2, 3, 4, 5, 6, 7); } } \
        else { _Pragma("unroll") for (int m = 0; m < 4; ++m) _Pragma("unroll") for (int k = 0; k < 2; ++k) dst[m][k] = *(const PG8_LAS bf16x8*)(lds + PG8_SA(b, h) + aoff + m * 2048 + k * 1024); } } while (0)
#define PG8_LDB(dst, b, h) do { if constexpr (Epi::F8) { _Pragma("unroll") for (int n = 0; n < 2; ++n) { const i32x4 lo_ = *(const PG8_LAS i32x4*)(lds + PG8_SB(b, h) + boff + n * 2048), hi_ = *(const PG8_LAS i32x4*)(lds + PG8_SB(b, h) + boff + n * 2048 + 1024); dst##8[n] = __builtin_shufflevector(lo_, hi_, 0, 1, 2, 3, 4, 5, 6, 7); } } \
        else { _Pragma("unroll") for (int n = 0; n < 2; ++n) _Pragma("unroll") for (int k = 0; k < 2; ++k) dst[n][k] = *(const PG8_LAS bf16x8*)(lds + PG8_SB(b, h) + boff + n * 2048 + k * 1024); } } while (0)
#define PG8_MMA(ai, bj, At, Bt) do { __builtin_amdgcn_s_setprio(1); if constexpr (Epi::F8) { _Pragma("unroll") for (int m = 0; m < 4; ++m) _Pragma("unroll") for (int n = 0; n < 2; ++n) acc[ai][bj][m][n] = mma_f8(Bt##8[n], At##8[m], acc[ai][bj][m][n]); } \
        else { _Pragma("unroll") for (int m = 0; m < 4; ++m) _Pragma("unroll") for (int n = 0; n < 2; ++n) _Pragma("unroll") for (int k = 0; k < 2; ++k) acc[ai][bj][m][n] = mma16<Epi::I8>(Bt[n][k], At[m][k], acc[ai][bj][m][n]); } __builtin_amdgcn_s_setprio(0); } while (0)
#define PG8_WAIT_V(n) asm volatile("s_waitcnt vmcnt(" #n ")" ::: "memory")
#define PG8_WAIT_L(n) asm volatile("s_waitcnt lgkmcnt(" #n ")" ::: "memory")
#define PG8_BAR __builtin_amdgcn_s_barrier()
#define PG8_SCHED __builtin_amdgcn_sched_barrier(0)
    Unit cur, nxt; int ui = 0;
    if (!S.next(0, cur)) return;
    f32x4 acc[2][2][4][2];
#pragma unroll
    for (int a = 0; a < 2; ++a)
#pragma unroll
        for (int b = 0; b < 2; ++b)
#pragma unroll
            for (int m = 0; m < 4; ++m)
#pragma unroll
                for (int n = 0; n < 2; ++n) acc[a][b][m][n] = (f32x4){0.f, 0.f, 0.f, 0.f};
    bf16x8 At[4][2], B0[2][2], B1[2][2];
    i32x8 At8[4], B08[2], B18[2];
    const char* cA = S.aptr(g, cur, tstep); const char* cB = S.bptr(g, cur, tstep);
    S.a_ready(cur);
    if constexpr (SP2) {
        PG8_STAGE(PG8_SB(0, 0), cB, voffB); PG8_STAGE(PG8_SB(0, 1), cB + hstep, voffB); PG8_STAGE(PG8_SA(0, 0), cA, voffA); PG8_STAGE(PG8_SA(0, 1), cA + hstep, voffA);
        if (wr == 1) PG8_BAR;
        PG8_WAIT_V(2); PG8_BAR;
        PG8_STAGE(PG8_SB(1, 0), cB + kstep, voffB); PG8_STAGE(PG8_SA(1, 0), cA + kstep, voffA); PG8_STAGE(PG8_SB(1, 1), cB + hstep + kstep, voffB);
        PG8_WAIT_V(6); PG8_BAR;
    } else {
        PG8_STAGE(PG8_SB(0, 0), cB, voffB); PG8_STAGE(PG8_SA(0, 0), cA, voffA); PG8_STAGE(PG8_SB(0, 1), cB + hstep, voffB); PG8_STAGE(PG8_SA(0, 1), cA + hstep, voffA);
        if (wr == 1) PG8_BAR;
        PG8_WAIT_V(4); PG8_BAR;
        PG8_STAGE(PG8_SB(1, 0), cB + kstep, voffB); PG8_STAGE(PG8_SA(1, 0), cA + kstep, voffA); PG8_STAGE(PG8_SB(1, 1), cB + hstep + kstep, voffB);
        PG8_WAIT_V(6); PG8_BAR;
    }
    for (;;) {
        const bool has_next = S.next(ui + 1, nxt);
        const char* nA = has_next ? S.aptr(g, nxt, tstep) : cA; const char* nB = has_next ? S.bptr(g, nxt, tstep) : cB;
        for (int t = 0; t < nt; t += 2) {
            const bool last = (t == nt - 2);
            const char* a1 = cA + (size_t)(t + 1) * kstep;
            const char* a2 = last ? nA : cA + (size_t)(t + 2) * kstep; const char* b2 = last ? nB : cB + (size_t)(t + 2) * kstep;
            const char* a3 = a2 + kstep; const char* b3 = b2 + kstep;
            if (last && has_next) S.a_ready(nxt);
            if constexpr (SP2) {
            PG8_LDB(B0, 0, 0); PG8_LDB(B1, 0, 1); PG8_SCHED; PG8_LDA(At, 0, 0); PG8_STAGE(PG8_SA(1, 1), a1 + hstep, voffA);
            PG8_WAIT_V(8); PG8_WAIT_L(0); PG8_BAR; PG8_MMA(0, 0, At, B0); PG8_MMA(0, 1, At, B1); PG8_BAR; PG8_SCHED;
            PG8_LDA(At, 0, 1); PG8_STAGE(PG8_SB(0, 0), b2, voffB); PG8_STAGE(PG8_SB(0, 1), b2 + hstep, voffB); PG8_STAGE(PG8_SA(0, 0), a2, voffA);
            PG8_WAIT_V(8); PG8_WAIT_L(0); PG8_BAR; PG8_MMA(1, 0, At, B0); PG8_MMA(1, 1, At, B1); PG8_BAR; PG8_SCHED;
            PG8_LDB(B0, 1, 0); PG8_LDB(B1, 1, 1); PG8_SCHED; PG8_LDA(At, 1, 0); PG8_STAGE(PG8_SA(0, 1), a2 + hstep, voffA);
            PG8_WAIT_V(8); PG8_WAIT_L(0); PG8_BAR; PG8_MMA(0, 0, At, B0); PG8_MMA(0, 1, At, B1); PG8_BAR; PG8_SCHED;
            PG8_LDA(At, 1, 1); PG8_STAGE(PG8_SB(1, 0), b3, voffB); PG8_STAGE(PG8_SB(1, 1), b3 + hstep, voffB); PG8_STAGE(PG8_SA(1, 0), a3, voffA);
            PG8_WAIT_V(8); PG8_WAIT_L(0); PG8_BAR; PG8_MMA(1, 0, At, B0); PG8_MMA(1, 1, At, B1); PG8_BAR; PG8_SCHED;
            } else {
            PG8_LDB(B0, 0, 0); PG8_SCHED; PG8_LDA(At, 0, 0); PG8_STAGE(PG8_SA(1, 1), a1 + hstep, voffA);
            PG8_WAIT_L(8); PG8_BAR; PG8_WAIT_L(0); PG8_MMA(0, 0, At, B0); PG8_BAR; PG8_SCHED;
            PG8_LDB(B1, 0, 1); PG8_STAGE(PG8_SB(0, 0), b2, voffB);
            PG8_BAR; PG8_WAIT_L(0); PG8_MMA(0, 1, At, B1); PG8_BAR;
            PG8_LDA(At, 0, 1); PG8_STAGE(PG8_SA(0, 0), a2, voffA);
            PG8_BAR; PG8_WAIT_L(0); PG8_MMA(1, 0, At, B0); PG8_BAR; PG8_SCHED;
            PG8_STAGE(PG8_SB(0, 1), b2 + hstep, voffB);
            PG8_WAIT_V(6); PG8_BAR; PG8_MMA(1, 1, At, B1); PG8_BAR;
            PG8_LDB(B0, 1, 0); PG8_SCHED; PG8_LDA(At, 1, 0); PG8_STAGE(PG8_SA(0, 1), a2 + hstep, voffA);
            PG8_WAIT_L(8); PG8_BAR; PG8_WAIT_L(0); PG8_MMA(0, 0, At, B0); PG8_BAR; PG8_SCHED;
            PG8_LDB(B1, 1, 1); PG8_STAGE(PG8_SB(1, 0), b3, voffB);
            PG8_BAR; PG8_WAIT_L(0); PG8_MMA(0, 1, At, B1); PG8_BAR;
            PG8_LDA(At, 1, 1); PG8_STAGE(PG8_SA(1, 0), a3, voffA);
            PG8_BAR; PG8_WAIT_L(0); PG8_MMA(1, 0, At, B0); PG8_BAR; PG8_SCHED;
            PG8_STAGE(PG8_SB(1, 1), b3 + hstep, voffB);
            PG8_WAIT_V(6); PG8_BAR; PG8_MMA(1, 1, At, B1); PG8_BAR;
            }
        }
        if constexpr (ALIGN_EPI) { if (wr == 0) PG8_BAR; }
        if constexpr (!Epi::AFTER_DRAIN) { E(acc, cur, wr, wc, fr, fq); S.done(cur); }
        if (!has_next) break;
#pragma unroll
        for (int a = 0; a < 2; ++a)
#pragma unroll
            for (int b = 0; b < 2; ++b)
#pragma unroll
                for (int m = 0; m < 4; ++m)
#pragma unroll
                    for (int n = 0; n < 2; ++n) acc[a][b][m][n] = (f32x4){0.f, 0.f, 0.f, 0.f};
        cur = nxt; cA = nA; cB = nB; ++ui;
        if constexpr (ALIGN_EPI) { if (wr == 1) PG8_BAR; }
    }
    PG8_WAIT_V(0);
    if constexpr (!ALIGN_EPI) { if (wr == 0) PG8_BAR; }
    PG8_BAR;
    if constexpr (Epi::AFTER_DRAIN) { E.fused(acc, cur, wr, wc, fr, fq, lds, wid, lane); S.done(cur); }
#undef PG8_SA
#undef PG8_SB
#undef PG8_STAGE
#undef PG8_LDA
#undef PG8_LDB
#undef PG8_MMA
#undef PG8_WAIT_V
#undef PG8_WAIT_L
#undef PG8_BAR
#undef PG8_SCHED
}
}
#define GAS __attribute__((address_space(1)))
#define LAS __attribute__((address_space(3)))
typedef unsigned short bf16_t;
typedef unsigned v4u __attribute__((ext_vector_type(4)));
typedef float f32x4 __attribute__((ext_vector_type(4)));
typedef float f32x2 __attribute__((ext_vector_type(2)));
#define RLX_AGENT __ATOMIC_RELAXED, __HIP_MEMORY_SCOPE_AGENT
__device__ __forceinline__ float wave_sum(float v) {
#pragma unroll
    for (int o = 1; o < 64; o <<= 1) v += __shfl_xor(v, o);
    return v;
}
__device__ __forceinline__ float ld_f32_agent(const float* p) { return __builtin_bit_cast(float, __builtin_amdgcn_readfirstlane(__hip_atomic_load((const unsigned*)p, RLX_AGENT))); }
__device__ __forceinline__ float ld_f32_plain(const float* p) { return *(const GAS float*)p; }
__device__ __forceinline__ int ld_i32_agent(const int* p) { return (int)__hip_atomic_load((const unsigned*)p, RLX_AGENT); }
using pg8::pk_bf16; using pg8::bf_lo; using pg8::bf_hi;

#define XB_TMO      128
#define XB_XCNT(j)  (256  + 64 * (j))
#define XB_XSUB(j)  (1280 + 64 * (j))
#define XB_XGEN(j)  (2304 + 64 * (j))
#define XB_TOP      3328
#define XB_TOPGEN   3392
#define XCD_BAR_WORDS 3456
#define XB_SPIN_CAP (1u << 18)

__device__ __forceinline__ unsigned xb_ld(unsigned* p)              { return __hip_atomic_load(p, __ATOMIC_RELAXED, __HIP_MEMORY_SCOPE_AGENT); }
__device__ __forceinline__ unsigned xb_add(unsigned* p, unsigned v) { return __hip_atomic_fetch_add(p, v, __ATOMIC_RELAXED, __HIP_MEMORY_SCOPE_AGENT); }
__device__ __forceinline__ unsigned xb_xcc_id() { return (unsigned)__builtin_amdgcn_s_getreg((3 << 11) | 20) & 0xFu; }
#define XB_SPIN(cond, bar) do { unsigned _sp = 0; while (cond) { __builtin_amdgcn_s_sleep(1); \
    if ((++_sp & 255u) == 0u) { if (xb_ld(&(bar)[XB_TMO])) break; if (_sp > XB_SPIN_CAP) { atomicAdd(&(bar)[XB_TMO], 1u); break; } } } } while (0)

struct XcdBarrier {
    unsigned* bar; unsigned x;
    volatile LAS unsigned* st;
};

__device__ __forceinline__ XcdBarrier xcd_barrier_post(unsigned* bar, volatile LAS unsigned* st) {
    XcdBarrier b; b.bar = bar; b.x = xb_xcc_id(); b.st = st;
    if (threadIdx.x == 0) (void)xb_add(&bar[XB_XCNT(b.x)], 1u);
    return b;
}
__device__ __forceinline__ void xcd_barrier_complete(unsigned* bar, unsigned x, unsigned& nloc, unsigned& nx) {
    const unsigned G = gridDim.x * gridDim.y * gridDim.z;
    unsigned sum, cnt, mine, sp = 0u;
    for (;;) {
        sum = 0u; cnt = 0u; mine = 0u;
#pragma unroll
        for (unsigned j = 0; j < 16; ++j) { const unsigned c = xb_ld(&bar[XB_XCNT(j)]); sum += c; cnt += (c > 0u) ? 1u : 0u; mine = (j == x) ? c : mine; }
        if (sum == G) break;
        __builtin_amdgcn_s_sleep(1);
        if ((++sp & 255u) == 0u) { if (xb_ld(&bar[XB_TMO])) break; if (sp > XB_SPIN_CAP) { atomicAdd(&bar[XB_TMO], 1u); break; } }
    }
    nloc = mine > 0u ? mine : 1u; nx = cnt > 0u ? cnt : 1u;
}

__device__ __forceinline__ void xcd_barrier(const XcdBarrier& b) {
    asm volatile("s_waitcnt vmcnt(0)" ::: "memory");
    __syncthreads();
    if (threadIdx.x == 0) {
        unsigned* bar = b.bar;
        __builtin_amdgcn_s_waitcnt(0);
        unsigned nloc = b.st[0], nx = b.st[1];
        if (nloc == 0u) { xcd_barrier_complete(bar, b.x, nloc, nx); b.st[0] = nloc; b.st[1] = nx; }
        const unsigned old = xb_add(&bar[XB_XSUB(b.x)], 1u);
        const unsigned gen = old / nloc;
        if (old + 1u == (gen + 1u) * nloc) {
            __builtin_amdgcn_fence(__ATOMIC_RELEASE, "agent");
            asm volatile("s_waitcnt vmcnt(0)" ::: "memory");
            const unsigned og = xb_add(&bar[XB_TOP], 1u);
            const unsigned tg = og / nx;
            if (og + 1u == (tg + 1u) * nx) xb_add(&bar[XB_TOPGEN], 1u);
            else XB_SPIN(xb_ld(&bar[XB_TOPGEN]) == tg, bar);
            __builtin_amdgcn_fence(__ATOMIC_ACQUIRE, "agent");
            xb_add(&bar[XB_XGEN(b.x)], 1u);
            asm volatile("s_waitcnt vmcnt(0)" ::: "memory");
        } else {
            XB_SPIN(xb_ld(&bar[XB_XGEN(b.x)]) == gen, bar);
            __builtin_amdgcn_fence(__ATOMIC_ACQUIRE, "agent");
            asm volatile("s_waitcnt vmcnt(0)" ::: "memory");
        }
    }
    __syncthreads();
}


struct Args { const float* in[31]; float* out; unsigned char* ws; int ph_lo, ph_hi; };

struct TJob { unsigned long long src, dst, gain; int K, N, ld, map, colbase, start, q8, smax, startq, f8, startf; };
constexpr int NJOBS = 41;
__device__ __forceinline__ void make_job(int j, const Args& a, TJob& o) {
    unsigned char* ws = a.ws; const float* src; void* dst; const float* gain = nullptr; o.map = 0; o.colbase = 0; o.q8 = 0; o.smax = 0; o.f8 = 0;
    if (j < 14) { const int l = j / 7, t = j % 7;
        if (t == 0)      { src = a.in[5] + (size_t)l * D * 4096; o.K = D; o.N = 4096; dst = ws + WS_W1T + l * 14 * MiB; gain = a.in[2] + l * D; o.q8 = I8_A; o.smax = SW_G1 + l * 7168; }
        else if (t == 1) { src = a.in[6] + (size_t)l * D * 3072; o.K = D; o.N = 3072; dst = ws + WS_W1T + l * 14 * MiB; gain = a.in[2] + l * D; o.colbase = 4096; o.q8 = I8_A; o.smax = SW_G1 + l * 7168 + 4096; }
        else if (t == 2) { src = a.in[19] + (size_t)l * D * 1024; o.K = D; o.N = 1024; dst = ws + WS_WMEMKV + l * 2 * MiB; gain = a.in[3] + l * D; }
        else if (t == 3) { src = a.in[20] + (size_t)l * 1024 * D; o.K = 1024; o.N = D; dst = ws + WS_WBRDA + l * 2 * MiB; }
        else if (t == 4) { src = a.in[21] + (size_t)l * 512 * D; o.K = 512; o.N = D; dst = ws + WS_WBRPOOL + l * 1 * MiB; }
        else if (t == 5) { src = a.in[22] + (size_t)l * 512 * D; o.K = 512; o.N = D; dst = ws + WS_WBRMEM + l * 1 * MiB; }
        else             { src = a.in[23] + (size_t)l * D * D; o.K = D; o.N = D; dst = ws + WS_WOUT + l * 2 * MiB; }
    } else if (j < 17) { const int t = j - 14;
        if (t < 2) { src = a.in[24 + t]; o.K = D; o.N = FFD; dst = ws + WS_WFF13; gain = a.in[4]; o.map = 1 + t; o.q8 = I8_E; o.smax = SW_FF + t * FFD; }
        else       { src = a.in[26]; o.K = FFD; o.N = D; dst = ws + WS_WFF2; o.f8 = 1; o.smax = SW_W2 + 8 * 1024; }
    } else { const int e = (j - 17) / 3, t = (j - 17) % 3;
        if (t < 2) { src = a.in[28 + t] + (size_t)e * D * FFE; o.K = D; o.N = FFE; dst = ws + WS_WMOE13 + (size_t)e * 7 * MiB; gain = a.in[4] + D; o.map = 1 + t; o.q8 = USE_I8; o.smax = SW_MOE + e * 2 * FFE + t * FFE; }
        else       { src = a.in[30] + (size_t)e * FFE * D; o.K = FFE; o.N = D; dst = ws + WS_WMOE2 + (size_t)e * 7 * MiB; o.f8 = 1; o.smax = SW_W2 + e * 1024; }
    }
    o.src = (unsigned long long)src; o.dst = (unsigned long long)dst; o.gain = (unsigned long long)gain; o.ld = o.N; o.start = 0; o.startq = 0; o.startf = 0;
}
__device__ __forceinline__ int bt_row_std(int C) { const int c = C & 255; return (C & ~255) + 128 * ((c >> 5) & 1) + 32 * (c >> 6) + 16 * ((c >> 2) & 1) + 4 * ((c >> 3) & 3) + (c & 3); }
__device__ __forceinline__ int bt_row_swiglu(int h, int which) { const int hl = h & 127; return 256 * (h >> 7) + 128 * ((hl >> 2) & 1) + 32 * (hl >> 5) + 16 * which + 4 * ((hl >> 3) & 3) + (hl & 3); }
struct TileRef { const GAS float* src; GAS bf16_t* dst; const GAS float* gain; int K, ld, map, colbase, k0, n0, q8, smax; };
template <bool QONLY> __device__ __forceinline__ void tile_decode(const LAS TJob* jobs, int& j, int it, TileRef& r) {
    if constexpr (QONLY) { while (it >= jobs[j + 1].startq) ++j; } else { while (it >= jobs[j + 1].start) ++j; }
    const LAS TJob* jb = jobs + j; const int item = it - (QONLY ? jb->startq : jb->start), nblk = jb->N >> 6;
    r.src = (const GAS float*)jb->src; r.dst = (GAS bf16_t*)jb->dst; r.gain = (const GAS float*)jb->gain; r.K = jb->K; r.ld = jb->ld; r.map = jb->map; r.colbase = jb->colbase; r.q8 = jb->q8; r.smax = jb->smax;
    r.k0 = (item / nblk) * 64; r.n0 = (item % nblk) * 64;
}
__device__ __forceinline__ void tile_load(const TileRef& r, int lane, f32x4 (&v)[16]) {
    const GAS float* p = r.src + (size_t)(r.k0 + (lane >> 4)) * r.ld + r.n0 + 4 * (lane & 15);
#pragma unroll
    for (int i = 0; i < 16; ++i) v[i] = __builtin_nontemporal_load((const GAS f32x4*)(p + (size_t)(4 * i) * r.ld));
}
__device__ __forceinline__ void tile_store(const TileRef& r, int lane, const f32x4 (&v)[16], LAS float* scr) {
#pragma unroll
    for (int i = 0; i < 16; ++i) { LAS float* d = scr + (4 * i + (lane >> 4)) * 65 + 4 * (lane & 15); d[0] = v[i][0]; d[1] = v[i][1]; d[2] = v[i][2]; d[3] = v[i][3]; }
    asm volatile("s_waitcnt lgkmcnt(0)" ::: "memory");
    const int kc = lane & 7;
    f32x4 g0 = {1.f, 1.f, 1.f, 1.f}, g1 = g0;
    if (r.gain) { g0 = *(const GAS f32x4*)(r.gain + r.k0 + 8 * kc); g1 = *(const GAS f32x4*)(r.gain + r.k0 + 8 * kc + 4); }
#pragma unroll
    for (int jj = 0; jj < 8; ++jj) { const int n = (lane >> 3) + 8 * jj; const LAS float* s = scr + (8 * kc) * 65 + n;
        v4u o; o.x = pk_bf16(s[0 * 65] * g0[0], s[1 * 65] * g0[1]); o.y = pk_bf16(s[2 * 65] * g0[2], s[3 * 65] * g0[3]); o.z = pk_bf16(s[4 * 65] * g1[0], s[5 * 65] * g1[1]); o.w = pk_bf16(s[6 * 65] * g1[2], s[7 * 65] * g1[3]);
        const int row = (r.map == 0) ? bt_row_std(r.colbase + r.n0 + n) : bt_row_swiglu(r.n0 + n, r.map - 1);
        *(GAS v4u*)(r.dst + (size_t)row * r.K + r.k0 + 8 * kc) = o; }
    asm volatile("s_waitcnt lgkmcnt(0)" ::: "memory");
}
__device__ __forceinline__ void tile_colmax(const TileRef& r, int lane, const f32x4 (&v)[16], float* cmaxbase) {
    float m0 = 0.f, m1 = 0.f, m2 = 0.f, m3 = 0.f;
#pragma unroll
    for (int i = 0; i < 16; ++i) { const float g = r.gain ? r.gain[r.k0 + 4 * i + (lane >> 4)] : 1.f;
        m0 = fmaxf(m0, fabsf(v[i][0] * g)); m1 = fmaxf(m1, fabsf(v[i][1] * g)); m2 = fmaxf(m2, fabsf(v[i][2] * g)); m3 = fmaxf(m3, fabsf(v[i][3] * g)); }
    m0 = fmaxf(m0, __shfl_xor(m0, 16)); m1 = fmaxf(m1, __shfl_xor(m1, 16)); m2 = fmaxf(m2, __shfl_xor(m2, 16)); m3 = fmaxf(m3, __shfl_xor(m3, 16));
    m0 = fmaxf(m0, __shfl_xor(m0, 32)); m1 = fmaxf(m1, __shfl_xor(m1, 32)); m2 = fmaxf(m2, __shfl_xor(m2, 32)); m3 = fmaxf(m3, __shfl_xor(m3, 32));
    if (lane < 16) { unsigned* p = (unsigned*)(cmaxbase + r.smax + r.n0 + 4 * lane);
        atomicMax(p, __float_as_uint(m0)); atomicMax(p + 1, __float_as_uint(m1)); atomicMax(p + 2, __float_as_uint(m2)); atomicMax(p + 3, __float_as_uint(m3)); }
}
__device__ __forceinline__ unsigned pk_i8x4(float a, float b, float c, float d) {
    const int ia = (int)__builtin_rintf(a), ib = (int)__builtin_rintf(b), ic = (int)__builtin_rintf(c), id = (int)__builtin_rintf(d);
    return (unsigned)(ia & 0xff) | ((unsigned)(ib & 0xff) << 8) | ((unsigned)(ic & 0xff) << 16) | ((unsigned)id << 24);
}
__device__ __forceinline__ void tile_store_q8(const TileRef& r, int lane, const f32x4 (&v)[16], LAS float* scr, const float* cmaxbase) {
#pragma unroll
    for (int i = 0; i < 16; ++i) { const float g = r.gain ? r.gain[r.k0 + 4 * i + (lane >> 4)] : 1.f; LAS float* d = scr + (4 * i + (lane >> 4)) * 65 + 4 * (lane & 15); d[0] = v[i][0] * g; d[1] = v[i][1] * g; d[2] = v[i][2] * g; d[3] = v[i][3] * g; }
    asm volatile("s_waitcnt lgkmcnt(0)" ::: "memory");
    const int kc = lane & 3;
#pragma unroll
    for (int jj = 0; jj < 4; ++jj) { const int n = (lane >> 2) + 16 * jj; const LAS float* s = scr + (16 * kc) * 65 + n;
        const float cm = ld_f32_plain(cmaxbase + r.smax + r.n0 + n), inv = cm > 0.f ? 127.0f / cm : 0.f;
        v4u o; o.x = pk_i8x4(s[0 * 65] * inv, s[1 * 65] * inv, s[2 * 65] * inv, s[3 * 65] * inv); o.y = pk_i8x4(s[4 * 65] * inv, s[5 * 65] * inv, s[6 * 65] * inv, s[7 * 65] * inv);
        o.z = pk_i8x4(s[8 * 65] * inv, s[9 * 65] * inv, s[10 * 65] * inv, s[11 * 65] * inv); o.w = pk_i8x4(s[12 * 65] * inv, s[13 * 65] * inv, s[14 * 65] * inv, s[15 * 65] * inv);
        const int row = (r.map == 0) ? bt_row_std(r.colbase + r.n0 + n) : bt_row_swiglu(r.n0 + n, r.map - 1);
        *(GAS v4u*)((GAS unsigned char*)r.dst + (size_t)row * r.K + r.k0 + 16 * kc) = o; }
    asm volatile("s_waitcnt lgkmcnt(0)" ::: "memory");
}
__device__ __forceinline__ void row_to_i8(const float* xrow, unsigned char* qrow, float* sa, int lane) {
    const f32x4* xr = (const f32x4*)xrow + 4 * lane; f32x4 v[4]; float s = 0.f, mx = 0.f;
#pragma unroll
    for (int j = 0; j < 4; ++j) { v[j] = xr[j]; s += (v[j][0] * v[j][0] + v[j][1] * v[j][1]) + (v[j][2] * v[j][2] + v[j][3] * v[j][3]);
        mx = fmaxf(mx, fmaxf(fmaxf(fabsf(v[j][0]), fabsf(v[j][1])), fmaxf(fabsf(v[j][2]), fabsf(v[j][3])))); }
    s = wave_sum(s);
#pragma unroll
    for (int o = 1; o < 64; o <<= 1) mx = fmaxf(mx, __shfl_xor(mx, o));
    const float inv = mx > 0.f ? 127.0f / mx : 0.f;
    v4u w; w.x = pk_i8x4(v[0][0] * inv, v[0][1] * inv, v[0][2] * inv, v[0][3] * inv); w.y = pk_i8x4(v[1][0] * inv, v[1][1] * inv, v[1][2] * inv, v[1][3] * inv);
    w.z = pk_i8x4(v[2][0] * inv, v[2][1] * inv, v[2][2] * inv, v[2][3] * inv); w.w = pk_i8x4(v[3][0] * inv, v[3][1] * inv, v[3][2] * inv, v[3][3] * inv);
    *((v4u*)qrow + lane) = w;
    if (lane == 0) *sa = mx * (1.0f / 127.0f) * __builtin_amdgcn_rsqf(s * (1.0f / 1024.0f) + 1e-6f);
}
__device__ __forceinline__ void ld16_bf16(const bf16_t* p, f32x4 (&v)[4]) {
    const v4u a = *(const v4u*)p, b = *(const v4u*)(p + 8);
    v[0] = (f32x4){bf_lo(a.x), bf_hi(a.x), bf_lo(a.y), bf_hi(a.y)}; v[1] = (f32x4){bf_lo(a.z), bf_hi(a.z), bf_lo(a.w), bf_hi(a.w)};
    v[2] = (f32x4){bf_lo(b.x), bf_hi(b.x), bf_lo(b.y), bf_hi(b.y)}; v[3] = (f32x4){bf_lo(b.z), bf_hi(b.z), bf_lo(b.w), bf_hi(b.w)};
}
__device__ __forceinline__ void rowb_to_i8(const bf16_t* xrow, unsigned char* qrow, float* sa, int lane) {
    f32x4 v[4]; ld16_bf16(xrow + 16 * lane, v); float s = 0.f, mx = 0.f;
#pragma unroll
    for (int j = 0; j < 4; ++j) { s += (v[j][0] * v[j][0] + v[j][1] * v[j][1]) + (v[j][2] * v[j][2] + v[j][3] * v[j][3]);
        mx = fmaxf(mx, fmaxf(fmaxf(fabsf(v[j][0]), fabsf(v[j][1])), fmaxf(fabsf(v[j][2]), fabsf(v[j][3])))); }
    s = wave_sum(s);
#pragma unroll
    for (int o = 1; o < 64; o <<= 1) mx = fmaxf(mx, __shfl_xor(mx, o));
    const float inv = mx > 0.f ? 127.0f / mx : 0.f;
    v4u w; w.x = pk_i8x4(v[0][0] * inv, v[0][1] * inv, v[0][2] * inv, v[0][3] * inv); w.y = pk_i8x4(v[1][0] * inv, v[1][1] * inv, v[1][2] * inv, v[1][3] * inv);
    w.z = pk_i8x4(v[2][0] * inv, v[2][1] * inv, v[2][2] * inv, v[2][3] * inv); w.w = pk_i8x4(v[3][0] * inv, v[3][1] * inv, v[3][2] * inv, v[3][3] * inv);
    *((v4u*)qrow + lane) = w;
    if (lane == 0) *sa = mx * (1.0f / 127.0f) * __builtin_amdgcn_rsqf(s * (1.0f / 1024.0f) + 1e-6f);
}
__device__ __forceinline__ void phase_quant_rows(const bf16_t* x, unsigned char* ws, int lane, int wave) {
    const int gw = blockIdx.x * NWAVES + wave, NGW = gridDim.x * NWAVES;
    for (int m = gw; m < T; m += NGW) rowb_to_i8(x + (size_t)m * D, ws + WS_QX + (size_t)m * D, (float*)(ws + WS_SA) + m, lane);
}
__device__ __forceinline__ void row_to_bf16_ss(const float* xrow, bf16_t* orow, float* ss16, float* fcopy, int lane) {
    const f32x4* xr = (const f32x4*)xrow + lane; f32x4 v[4]; float s = 0.f;
#pragma unroll
    for (int j = 0; j < 4; ++j) { v[j] = xr[64 * j]; s += (v[j][0] * v[j][0] + v[j][1] * v[j][1]) + (v[j][2] * v[j][2] + v[j][3] * v[j][3]); }
    s = wave_sum(s);
    if (fcopy) { f32x4* fc = (f32x4*)fcopy + lane;
#pragma unroll
        for (int j = 0; j < 4; ++j) fc[64 * j] = v[j]; }
    unsigned long long* o8 = (unsigned long long*)orow + lane;
#pragma unroll
    for (int j = 0; j < 4; ++j) o8[64 * j] = (unsigned long long)pk_bf16(v[j][0], v[j][1]) | ((unsigned long long)pk_bf16(v[j][2], v[j][3]) << 32);
    if (lane < 16) ss16[lane] = (lane == 0) ? s : 0.f;
}
__device__ __forceinline__ void build_jobs(const Args& a, LAS TJob* jobs, int tid) {
    if (tid < NJOBS) { TJob jb; make_job(tid, a, jb); LAS TJob* d = jobs + tid; d->src = jb.src; d->dst = jb.dst; d->gain = jb.gain; d->K = jb.K; d->N = jb.N; d->ld = jb.ld; d->map = jb.map; d->colbase = jb.colbase; d->q8 = jb.q8; d->smax = jb.smax; d->start = 0; d->startq = 0; d->f8 = jb.f8; d->startf = 0; }
    __syncthreads();
    if (tid == 0) { int s = 0, q = 0, f = 0; for (int j = 0; j < NJOBS; ++j) { jobs[j].start = s; jobs[j].startq = q; jobs[j].startf = f; if (jobs[j].q8) q += jobs[j].N / 64; else if (jobs[j].f8) f += jobs[j].N / 16; else s += (jobs[j].K / 64) * (jobs[j].N / 64); }
        jobs[NJOBS].start = s; jobs[NJOBS].startq = q; jobs[NJOBS].startf = f; }
    __syncthreads();
}
__device__ __forceinline__ void strip_q8(const LAS TJob* jobs, int& j, int st, LAS unsigned char* lds, int tid, int lane, int wave, float* cmaxbase) {
    while (st >= jobs[j + 1].startq) ++j;
    const LAS TJob* jb = jobs + j;
    TileRef r; r.src = (const GAS float*)jb->src; r.dst = (GAS bf16_t*)jb->dst; r.gain = (const GAS float*)jb->gain; r.K = jb->K; r.ld = jb->ld; r.map = jb->map; r.colbase = jb->colbase; r.q8 = 1; r.smax = jb->smax;
    r.n0 = (st - jb->startq) * 64; r.k0 = 128 * wave;
    LAS float* scr = (LAS float*)(lds + wave * 17408); LAS float* pmax = (LAS float*)(lds + 8 * 17408 + 4096); LAS float* cmf = pmax + 8 * 64;
    f32x4 v0[16], v1[16];
    tile_load(r, lane, v0); r.k0 += 64; tile_load(r, lane, v1); r.k0 -= 64;
    float m0 = 0.f, m1 = 0.f, m2 = 0.f, m3 = 0.f;
#pragma unroll
    for (int i = 0; i < 16; ++i) { const float g0 = r.gain ? r.gain[r.k0 + 4 * i + (lane >> 4)] : 1.f, g1 = r.gain ? r.gain[r.k0 + 64 + 4 * i + (lane >> 4)] : 1.f;
        v0[i] = v0[i] * g0; v1[i] = v1[i] * g1;
        m0 = fmaxf(m0, fmaxf(fabsf(v0[i][0]), fabsf(v1[i][0]))); m1 = fmaxf(m1, fmaxf(fabsf(v0[i][1]), fabsf(v1[i][1]))); m2 = fmaxf(m2, fmaxf(fabsf(v0[i][2]), fabsf(v1[i][2]))); m3 = fmaxf(m3, fmaxf(fabsf(v0[i][3]), fabsf(v1[i][3]))); }
    m0 = fmaxf(m0, __shfl_xor(m0, 16)); m1 = fmaxf(m1, __shfl_xor(m1, 16)); m2 = fmaxf(m2, __shfl_xor(m2, 16)); m3 = fmaxf(m3, __shfl_xor(m3, 16));
    m0 = fmaxf(m0, __shfl_xor(m0, 32)); m1 = fmaxf(m1, __shfl_xor(m1, 32)); m2 = fmaxf(m2, __shfl_xor(m2, 32)); m3 = fmaxf(m3, __shfl_xor(m3, 32));
    __syncthreads();
    if (lane < 16) *(LAS f32x4*)(pmax + wave * 64 + 4 * lane) = (f32x4){m0, m1, m2, m3};
    __syncthreads();
    if (tid < 64) { float m = pmax[tid];
#pragma unroll
        for (int w = 1; w < 8; ++w) m = fmaxf(m, pmax[w * 64 + tid]);
        cmf[tid] = m; cmaxbase[r.smax + r.n0 + tid] = m; }
    __syncthreads();
#pragma unroll
    for (int h = 0; h < 2; ++h) {
#pragma unroll
        for (int i = 0; i < 16; ++i) { LAS float* d = scr + (4 * i + (lane >> 4)) * 65 + 4 * (lane & 15); const f32x4 x = h ? v1[i] : v0[i]; d[0] = x[0]; d[1] = x[1]; d[2] = x[2]; d[3] = x[3]; }
        asm volatile("s_waitcnt lgkmcnt(0)" ::: "memory");
        const int kc = lane & 3;
#pragma unroll
        for (int jj = 0; jj < 4; ++jj) { const int n = (lane >> 2) + 16 * jj; const LAS float* s = scr + (16 * kc) * 65 + n;
            const float cm = cmf[n], inv = cm > 0.f ? 127.0f / cm : 0.f;
            v4u o; o.x = pk_i8x4(s[0 * 65] * inv, s[1 * 65] * inv, s[2 * 65] * inv, s[3 * 65] * inv); o.y = pk_i8x4(s[4 * 65] * inv, s[5 * 65] * inv, s[6 * 65] * inv, s[7 * 65] * inv);
            o.z = pk_i8x4(s[8 * 65] * inv, s[9 * 65] * inv, s[10 * 65] * inv, s[11 * 65] * inv); o.w = pk_i8x4(s[12 * 65] * inv, s[13 * 65] * inv, s[14 * 65] * inv, s[15 * 65] * inv);
            const int row = (r.map == 0) ? bt_row_std(r.colbase + r.n0 + n) : bt_row_swiglu(r.n0 + n, r.map - 1);
            *(GAS v4u*)((GAS unsigned char*)r.dst + (size_t)row * r.K + r.k0 + 64 * h + 16 * kc) = o; }
        asm volatile("s_waitcnt lgkmcnt(0)" ::: "memory");
    }
}
__device__ __forceinline__ void strip_f8(const LAS TJob* jobs, int& j, int st, LAS unsigned char* lds, int tid, int lane, int wave, float* cmaxbase) {
    while (st >= jobs[j + 1].startf) ++j;
    const LAS TJob* jb = jobs + j;
    const GAS float* src = (const GAS float*)jb->src; GAS unsigned char* dst = (GAS unsigned char*)jb->dst; const int K = jb->K, n0 = (st - jb->startf) * 16, smax = jb->smax, nq = K >> 2;
    const int c4 = tid & 3, q0 = tid >> 2;
    constexpr int RS8 = 3584 + 16;
    LAS float* pmax = (LAS float*)(lds + 8 * 17408 + 4096); LAS float* cmf = pmax + 8 * 16;
    f32x4 v[7][4];
#pragma unroll
    for (int i = 0; i < 7; ++i) { const int q = q0 + 128 * i; const GAS float* p = src + (size_t)(4 * q) * 1024 + n0 + 4 * c4;
#pragma unroll
        for (int kk = 0; kk < 4; ++kk) v[i][kk] = (q < nq) ? __builtin_nontemporal_load((const GAS f32x4*)(p + kk * 1024)) : (f32x4){0.f, 0.f, 0.f, 0.f}; }
    float m0 = 0.f, m1 = 0.f, m2 = 0.f, m3 = 0.f;
#pragma unroll
    for (int i = 0; i < 7; ++i)
#pragma unroll
        for (int kk = 0; kk < 4; ++kk) { m0 = fmaxf(m0, fabsf(v[i][kk][0])); m1 = fmaxf(m1, fabsf(v[i][kk][1])); m2 = fmaxf(m2, fabsf(v[i][kk][2])); m3 = fmaxf(m3, fabsf(v[i][kk][3])); }
#pragma unroll
    for (int o = 4; o < 64; o <<= 1) { m0 = fmaxf(m0, __shfl_xor(m0, o)); m1 = fmaxf(m1, __shfl_xor(m1, o)); m2 = fmaxf(m2, __shfl_xor(m2, o)); m3 = fmaxf(m3, __shfl_xor(m3, o)); }
    __syncthreads();
    if (lane < 4) *(LAS f32x4*)(pmax + wave * 16 + 4 * lane) = (f32x4){m0, m1, m2, m3};
    __syncthreads();
    if (tid < 16) { float m = pmax[tid];
#pragma unroll
        for (int w = 1; w < 8; ++w) m = fmaxf(m, pmax[w * 16 + tid]);
        cmf[tid] = m; cmaxbase[smax + n0 + tid] = m * (1.0f / (256.0f * H8_SCALE)); }
    __syncthreads();
    { const f32x4 cm = *(const LAS f32x4*)(cmf + 4 * c4); f32x4 inv;
#pragma unroll
      for (int jj = 0; jj < 4; ++jj) inv[jj] = cm[jj] > 0.f ? 256.0f / cm[jj] : 0.f;
#pragma unroll
      for (int i = 0; i < 7; ++i) { const int q = q0 + 128 * i;
          if (q < nq) {
#pragma unroll
              for (int jj = 0; jj < 4; ++jj) *(LAS unsigned*)(lds + (4 * c4 + jj) * RS8 + 4 * q) = pg8::pk_fp8x4(v[i][0][jj] * inv[jj], v[i][1][jj] * inv[jj], v[i][2][jj] * inv[jj], v[i][3][jj] * inv[jj]); } } }
    __syncthreads();
    { const int row = tid >> 5, t32 = tid & 31; GAS unsigned char* drow = dst + (size_t)bt_row_std(n0 + row) * K;
#pragma unroll
      for (int it = 0; it < 7; ++it) { const int ch = t32 + 32 * it; if (ch * 16 < K) *(GAS v4u*)(drow + ch * 16) = *(const LAS v4u*)(lds + row * RS8 + ch * 16); } }
}
__device__ __forceinline__ void phase_prologue(const Args& a, LAS unsigned char* lds, int tid, int lane, int wave) {
    unsigned char* ws = a.ws;
    LAS TJob* jobs = (LAS TJob*)(lds + 8 * 17408);
    build_jobs(a, jobs, tid);
    const int gw = blockIdx.x * NWAVES + wave, NGW = gridDim.x * NWAVES;
    { const int nstrip = jobs[NJOBS].startq; int js = 0;
      for (int st = blockIdx.x; st < nstrip; st += gridDim.x) strip_q8(jobs, js, st, lds, tid, lane, wave, (float*)(ws + WS_SW));
      __syncthreads(); }
    { const int nstrip = jobs[NJOBS].startf; int js = 0;
      const int first = (int)(((unsigned)blockIdx.x + gridDim.x - (unsigned)(jobs[NJOBS].startq % (int)gridDim.x)) % gridDim.x);
      for (int st = first; st < nstrip; st += gridDim.x) strip_f8(jobs, js, st, lds, tid, lane, wave, (float*)(ws + WS_SW));
      __syncthreads(); }
    {
        LAS float* scr = (LAS float*)(lds + wave * 17408);
        const int total = jobs[NJOBS].start; int j = 0;
        if (gw < total) {
            TileRef cur, nxt; f32x4 v[16], vn[16];
            tile_decode<false>(jobs, j, gw, cur); tile_load(cur, lane, v);
#pragma unroll 1
            for (int it = gw; it < total; it += NGW) {
                const bool more = it + NGW < total;
                if (more) { tile_decode<false>(jobs, j, it + NGW, nxt); tile_load(nxt, lane, vn); }
                tile_store(cur, lane, v, scr);
                if (more) { cur = nxt;
#pragma unroll
                    for (int i = 0; i < 16; ++i) v[i] = vn[i]; }
            }
        }
    }
#if I8_A
    for (int m = gw; m < T; m += NGW) row_to_i8(a.in[0] + (size_t)m * D, ws + WS_QX + (size_t)m * D, (float*)(ws + WS_SA) + m, lane);
#else
    for (int m = gw; m < T; m += NGW) row_to_bf16_ss(a.in[0] + (size_t)m * D, (bf16_t*)(ws + WS_XB) + (size_t)m * D, (float*)(ws + WS_SS) + (size_t)m * 16, nullptr, lane);
#endif
    for (int m = gw; m < NBATCH * MEML; m += NGW) row_to_bf16_ss(a.in[1] + (size_t)m * D, (bf16_t*)(ws + WS_MEMBF) + (size_t)m * D, (float*)(ws + WS_SSM) + (size_t)m * 16, nullptr, lane);
    {
        float* prm = (float*)(ws + WS_PARAM); const int gt = blockIdx.x * NTHR + tid, NGT = gridDim.x * NTHR;
        for (int i = gt; i < PB_END; i += NGT) { float v;
            if (i < PB_GQ) v = a.in[7][i]; else if (i < PB_GK) v = a.in[8][i - PB_GQ]; else if (i < PB_GOUT) v = a.in[9][i - PB_GK]; else if (i < PB_POOLS) v = a.in[14][i - PB_GOUT];
            else if (i < PB_MQN) v = a.in[16][i - PB_POOLS]; else if (i < PB_MKN) v = a.in[17][i - PB_MQN]; else if (i < PB_GFFN1) v = a.in[18][i - PB_MKN]; else if (i < PB_WR) v = a.in[4][D + i - PB_GFFN1];
            else if (i < PB_POOLW) v = a.in[27][i - PB_WR]; else v = a.in[15][i - PB_POOLW];
            prm[i] = v; }
        bf16_t* pwt = (bf16_t*)(ws + WS_POOLWT);
        for (int i = gt; i < 2 * 4 * 128 * 128; i += NGT) { const int lg = i >> 14, dout = (i >> 7) & 127, cc = i & 127; pwt[i] = (bf16_t)(pk_bf16(a.in[15][((size_t)lg * 128 + cc) * 128 + dout], 0.f) & 0xffffu); }
    }
    if (blockIdx.x == 0 && wave == 0) {
        float* sc = (float*)(ws + WS_SC);
        for (int l = 0; l < 2; ++l) {
            const float a1 = wave_sum(a.in[10][l * 64 + lane] * a.in[11][l * 64 + lane]), a2 = wave_sum(a.in[12][l * 64 + lane] * a.in[13][l * 64 + lane]);
            const float lam0 = (l == 0) ? 0.2f : (0.8f - 0.6f * 0.7408182206817179f);
            const float lam = __expf(a1) - __expf(a2) + lam0;
            float m0 = fabsf(a.in[8][l * 128 + lane] * a.in[9][l * 128 + lane]), m1 = fabsf(a.in[8][l * 128 + 64 + lane] * a.in[9][l * 128 + 64 + lane]);
            float mm = fmaxf(fabsf(a.in[17][l * 128 + lane] * a.in[18][l * 128 + lane]), fabsf(a.in[17][l * 128 + 64 + lane] * a.in[18][l * 128 + 64 + lane]));
#pragma unroll
            for (int o = 1; o < 64; o <<= 1) { m0 = fmaxf(m0, __shfl_xor(m0, o)); m1 = fmaxf(m1, __shfl_xor(m1, o)); mm = fmaxf(mm, __shfl_xor(mm, o)); }
            if (lane == 0) { sc[l * 8 + 0] = lam; sc[l * 8 + 1] = m0 * 64.f * QSCALE; sc[l * 8 + 2] = m1 * 64.f * QSCALE; sc[l * 8 + 3] = mm * 128.f * MEMSCALE; sc[l * 8 + 4] = 1.0f - lam0; }
        }
    }
}

__device__ __forceinline__ void unpack16(const bf16_t* src, float (&f)[16]) {
    const v4u a = *(const v4u*)src, b = *(const v4u*)(src + 8);
    f[0] = bf_lo(a.x); f[1] = bf_hi(a.x); f[2] = bf_lo(a.y); f[3] = bf_hi(a.y); f[4] = bf_lo(a.z); f[5] = bf_hi(a.z); f[6] = bf_lo(a.w); f[7] = bf_hi(a.w);
    f[8] = bf_lo(b.x); f[9] = bf_hi(b.x); f[10] = bf_lo(b.y); f[11] = bf_hi(b.y); f[12] = bf_lo(b.z); f[13] = bf_hi(b.z); f[14] = bf_lo(b.w); f[15] = bf_hi(b.w);
}
template <bool DIFF>
__device__ __forceinline__ void naive_attn_unit(LAS unsigned char* lds, int tid, const bf16_t* Qg, int ldq, const bf16_t* Kg, int ldk, const bf16_t* Vg, int ldv, bf16_t* Og, int ldo,
                                                int ntiles, int qpos0, const float* qmulA, const float* qmulB, const float* qss, float slope2, float bnd0, float bnd1, float lam, const float* gout, float outmul) {
    constexpr int QW = 4;
    LAS float* Lq = (LAS float*)lds; LAS float* Lk = Lq + 32 * 128; LAS float* Lv = Lk + 64 * 129; LAS float* Lp = Lv + 64 * 128; LAS float* Lrk = Lp + 8 * QW * 2 * 64;
    const int lane = tid & 63, wid = tid >> 6, r = tid >> 3, sg = tid & 7;
    __syncthreads();
    if (tid < 256) { float f[16]; unpack16(Qg + (size_t)r * ldq + sg * 16, f); float mul = 1.f;
      if (!DIFF) { const float s = qss[r * 8] + qss[r * 8 + 1]; mul = __builtin_amdgcn_rsqf(s * (1.f / 128.f) + 1e-6f) * MEMSCALE; }
#pragma unroll
      for (int i = 0; i < 16; ++i) Lq[r * 128 + sg * 16 + i] = DIFF ? f[i] : f[i] * mul * qmulA[sg * 16 + i] * qmulB[sg * 16 + i]; }
    float o0[QW][2], o1[QW][2], l0[QW], l1[QW];
#pragma unroll
    for (int q = 0; q < QW; ++q) { o0[q][0] = o0[q][1] = o1[q][0] = o1[q][1] = 0.f; l0[q] = l1[q] = 0.f; }
#pragma unroll 1
    for (int j = 0; j < ntiles; ++j) {
        __syncthreads();
        { float f[16]; unpack16(Kg + (size_t)(j * 64 + r) * ldk + sg * 16, f);
#pragma unroll
          for (int i = 0; i < 16; ++i) Lk[r * 129 + sg * 16 + i] = f[i];
          unpack16(Vg + (size_t)(j * 64 + r) * ldv + sg * 16, f);
#pragma unroll
          for (int i = 0; i < 16; ++i) Lv[r * 128 + sg * 16 + i] = f[i]; }
        __syncthreads();
        if (!DIFF) { if (tid < 64) { float s = 0.f;
#pragma unroll 4
            for (int d = 0; d < 128; ++d) { const float x = Lk[tid * 129 + d]; s += x * x; } Lrk[tid] = __builtin_amdgcn_rsqf(s * (1.f / 128.f) + 1e-6f); } __syncthreads(); }
        float s0[QW], s1[QW];
#pragma unroll
        for (int q = 0; q < QW; ++q) { s0[q] = 0.f; s1[q] = 0.f; }
#pragma unroll 1
        for (int d4 = 0; d4 < 16; ++d4) {
            const float k0 = Lk[lane * 129 + 4 * d4], k1 = Lk[lane * 129 + 4 * d4 + 1], k2 = Lk[lane * 129 + 4 * d4 + 2], k3 = Lk[lane * 129 + 4 * d4 + 3];
            const float e0 = Lk[lane * 129 + 64 + 4 * d4], e1 = Lk[lane * 129 + 64 + 4 * d4 + 1], e2 = Lk[lane * 129 + 64 + 4 * d4 + 2], e3 = Lk[lane * 129 + 64 + 4 * d4 + 3];
#pragma unroll
            for (int q = 0; q < QW; ++q) { const f32x4 qa = *(const LAS f32x4*)&Lq[(wid * QW + q) * 128 + 4 * d4], qb = *(const LAS f32x4*)&Lq[(wid * QW + q) * 128 + 64 + 4 * d4];
                s0[q] += (qa[0] * k0 + qa[1] * k1) + (qa[2] * k2 + qa[3] * k3); s1[q] += (qb[0] * e0 + qb[1] * e1) + (qb[2] * e2 + qb[3] * e3); }
        }
        const int kpos = j * 64 + lane;
#pragma unroll
        for (int q = 0; q < QW; ++q) { float p0, p1;
            if (DIFF) { const int qpos = qpos0 + wid * QW + q; const float bias = -slope2 * fabsf((float)(qpos - kpos)); p0 = __builtin_amdgcn_exp2f(s0[q] + bias - bnd0); p1 = __builtin_amdgcn_exp2f(s1[q] + bias - bnd1); }
            else { p0 = __builtin_amdgcn_exp2f((s0[q] + s1[q]) * Lrk[lane] - bnd0); p1 = 0.f; }
            l0[q] += p0; l1[q] += p1; Lp[((wid * QW + q) * 2 + 0) * 64 + lane] = p0; Lp[((wid * QW + q) * 2 + 1) * 64 + lane] = p1; }
        asm volatile("s_waitcnt lgkmcnt(0)" ::: "memory");
#pragma unroll 1
        for (int k4 = 0; k4 < 16; ++k4) {
            f32x2 v[4];
#pragma unroll
            for (int i = 0; i < 4; ++i) v[i] = *(const LAS f32x2*)&Lv[(4 * k4 + i) * 128 + 2 * lane];
#pragma unroll
            for (int q = 0; q < QW; ++q) { const f32x4 pa = *(const LAS f32x4*)&Lp[((wid * QW + q) * 2 + 0) * 64 + 4 * k4];
                o0[q][0] += (pa[0] * v[0][0] + pa[1] * v[1][0]) + (pa[2] * v[2][0] + pa[3] * v[3][0]); o0[q][1] += (pa[0] * v[0][1] + pa[1] * v[1][1]) + (pa[2] * v[2][1] + pa[3] * v[3][1]);
                if (DIFF) { const f32x4 pb = *(const LAS f32x4*)&Lp[((wid * QW + q) * 2 + 1) * 64 + 4 * k4];
                    o1[q][0] += (pb[0] * v[0][0] + pb[1] * v[1][0]) + (pb[2] * v[2][0] + pb[3] * v[3][0]); o1[q][1] += (pb[0] * v[0][1] + pb[1] * v[1][1]) + (pb[2] * v[2][1] + pb[3] * v[3][1]); } }
        }
    }
#pragma unroll
    for (int q = 0; q < QW; ++q) { const float L0 = wave_sum(l0[q]); float x = o0[q][0] / L0, y = o0[q][1] / L0;
        if (DIFF) { const float L1 = wave_sum(l1[q]); x -= lam * (o1[q][0] / L1); y -= lam * (o1[q][1] / L1);
            const float ss = wave_sum(x * x + y * y); const float rr = __builtin_amdgcn_rsqf(ss * (1.f / 128.f) + 1e-6f) * outmul; x *= rr * gout[2 * lane]; y *= rr * gout[2 * lane + 1]; }
        *(unsigned*)(Og + (size_t)(wid * QW + q) * ldo + 2 * lane) = pk_bf16(x, y); }
}
__device__ __forceinline__ void naive_pool_unit(LAS unsigned char* lds, int tid, const bf16_t* Pg  , bf16_t* Og  , const float* W  , const float* scale  , int tok0, int g) {
    LAS float* Lp = (LAS float*)lds; LAS float* Ld = Lp + 80 * 128;
    const int w = 2 << g, pos0 = tok0 & (SEQ - 1);
    __syncthreads();
    for (int i = tid; i < 80 * 8; i += NTHR) { const int rr = i >> 3, sg = i & 7; const int tpos = pos0 - 16 + rr;
        float f[16];
        if (tpos >= 0) unpack16(Pg + (size_t)(tok0 - 16 + rr) * 512 + g * 128 + sg * 16, f); else {
#pragma unroll
            for (int k = 0; k < 16; ++k) f[k] = 0.f; }
#pragma unroll
        for (int k = 0; k < 16; ++k) Lp[rr * 128 + sg * 16 + k] = f[k]; }
    __syncthreads();
    for (int i = tid; i < 64 * 128; i += NTHR) { const int t = i >> 7, c = i & 127; const int tpos = pos0 + t; const int lo = (tpos + 1 - w) > 0 ? (tpos + 1 - w) : 0; const int cnt = tpos + 1 - lo;
        float s = 0.f;
#pragma unroll 1
        for (int k = 0; k < cnt; ++k) s += Lp[(16 + t - k) * 128 + c];
        Ld[t * 128 + c] = s / (float)cnt - Lp[(16 + t) * 128 + c]; }
    __syncthreads();
    const int dout = tid & 127, tq = tid >> 7; float acc[16];
#pragma unroll
    for (int i = 0; i < 16; ++i) acc[i] = 0.f;
#pragma unroll 2
    for (int c = 0; c < 128; ++c) { const float wv = W[c * 128 + dout];
#pragma unroll
        for (int i = 0; i < 16; ++i) acc[i] += Ld[(tq * 16 + i) * 128 + c] * wv; }
    const float sc = scale[dout];
#pragma unroll
    for (int i = 0; i < 16; ++i) Og[(size_t)(tok0 + tq * 16 + i) * 512 + g * 128 + dout] = (bf16_t)(pk_bf16(acc[i] * sc, 0.f) & 0xffffu);
}

namespace mix {
typedef short bf16x8 __attribute__((ext_vector_type(8)));
typedef short s16x4 __attribute__((ext_vector_type(4)));
typedef float f32x16 __attribute__((ext_vector_type(16)));
typedef const LAS unsigned char* lptr;
#define SBAR() __builtin_amdgcn_sched_barrier(0)
__device__ __forceinline__ unsigned lds_addr(lptr p) { return (unsigned)(uintptr_t)p; }
__device__ __forceinline__ bf16x8 pack8(const f32x16& p, int b) {
    v4u w; w.x = pk_bf16(p[b], p[b + 1]); w.y = pk_bf16(p[b + 2], p[b + 3]); w.z = pk_bf16(p[b + 4], p[b + 5]); w.w = pk_bf16(p[b + 6], p[b + 7]);
    return __builtin_bit_cast(bf16x8, w);
}
__device__ __forceinline__ void glds16(const void* g, LAS unsigned char* l) { __builtin_amdgcn_global_load_lds((const unsigned*)g, (LAS unsigned*)l, 16, 0, 0); }
#define MFMA32(a, b, c) __builtin_amdgcn_mfma_f32_32x32x16_bf16(a, b, c, 0, 0, 0)

#define VRD(set, db) do { _Pragma("unroll") for (int t_ = 0; t_ < 4; ++t_) { \
        asm volatile("ds_read_b64_tr_b16 %0, %1 offset:%c2" : "=&v"(lo[set][t_]) : "v"(va[db]), "i"(t_ * 4096) : "memory"); \
        asm volatile("ds_read_b64_tr_b16 %0, %1 offset:%c2" : "=&v"(hi[set][t_]) : "v"(va[db]), "i"(t_ * 4096 + 2048) : "memory"); } } while (0)
#define VRT(set, t) do { _Pragma("unroll") for (int d_ = 0; d_ < 4; ++d_) { \
        asm volatile("ds_read_b64_tr_b16 %0, %1 offset:%c2" : "=&v"(lo[set][d_]) : "v"(va[d_]), "i"((t) * 4096) : "memory"); \
        asm volatile("ds_read_b64_tr_b16 %0, %1 offset:%c2" : "=&v"(hi[set][d_]) : "v"(va[d_]), "i"((t) * 4096 + 2048) : "memory"); } } while (0)
#define VPK(set, t) (bf16x8){lo[set][t][0], lo[set][t][1], lo[set][t][2], lo[set][t][3], hi[set][t][0], hi[set][t][1], hi[set][t][2], hi[set][t][3]}
__device__ __forceinline__ void pv_tile(f32x16 (&O)[4], const unsigned (&va)[4], const bf16x8 (&pb)[4]) {
    s16x4 lo[2][4], hi[2][4];
    VRD(0, 0);
    VRD(1, 1); asm volatile("s_waitcnt lgkmcnt(8)" ::: "memory"); SBAR();
#pragma unroll
    for (int t = 0; t < 4; ++t) O[0] = MFMA32(VPK(0, t), pb[t], O[0]);
    SBAR(); VRD(0, 2); asm volatile("s_waitcnt lgkmcnt(8)" ::: "memory"); SBAR();
#pragma unroll
    for (int t = 0; t < 4; ++t) O[1] = MFMA32(VPK(1, t), pb[t], O[1]);
    SBAR(); VRD(1, 3); asm volatile("s_waitcnt lgkmcnt(8)" ::: "memory"); SBAR();
#pragma unroll
    for (int t = 0; t < 4; ++t) O[2] = MFMA32(VPK(0, t), pb[t], O[2]);
    SBAR(); asm volatile("s_waitcnt lgkmcnt(0)" ::: "memory"); SBAR();
#pragma unroll
    for (int t = 0; t < 4; ++t) O[3] = MFMA32(VPK(1, t), pb[t], O[3]);
}
__device__ __forceinline__ void kread8_swz(bf16x8 (&kf)[8], const unsigned (&ka)[4]) {
#define KRD(i, a, off) asm volatile("ds_read_b128 %0, %1 offset:%c2" : "=&v"(kf[i]) : "v"(a), "i"(off) : "memory")
    KRD(0, ka[0], 0); KRD(1, ka[0], 8192); KRD(2, ka[1], 0); KRD(3, ka[1], 8192); KRD(4, ka[2], 0); KRD(5, ka[2], 8192); KRD(6, ka[3], 0); KRD(7, ka[3], 8192);
#undef KRD
}
__device__ __forceinline__ void kread8(bf16x8 (&kf)[8], unsigned ka) {
#define KRD(i, off) asm volatile("ds_read_b128 %0, %1 offset:%c2" : "=&v"(kf[i]) : "v"(ka), "i"(off) : "memory")
    KRD(0, 0); KRD(1, 512); KRD(2, 2048); KRD(3, 2560); KRD(4, 4096); KRD(5, 4608); KRD(6, 6144); KRD(7, 6656);
#undef KRD
}

__device__ __forceinline__ void da_bias(f32x16& p0, f32x16& p1, int jt, int cq, float xq, float sl2, float B2) {
    const float x = (float)(64 * jt) - xq;
    const float Be = (jt > cq) ? 1.0e30f : B2;
#pragma unroll
    for (int r = 0; r < 16; ++r) { const float kr = (float)((r & 3) + 8 * (r >> 2)); p0[r] = __builtin_fmaf(-sl2, __builtin_fabsf(x + kr), -Be); p1[r] = __builtin_fmaf(-sl2, __builtin_fabsf(x + (32.f + kr)), -Be); }
}
__device__ __forceinline__ void diffattn_unit(LAS unsigned char* lds, int tid, const bf16_t* Qg, const bf16_t* Kg, const bf16_t* Vg, bf16_t* Og, int b, int h, int u, bool desc, float sl2, float B2, float lam, const float* gout, float outmul) {
    asm volatile("" : "+v"(tid));
    const int lane = tid & 63, wid = __builtin_amdgcn_readfirstlane(tid >> 6), map = wid >> 2, wi = wid & 3, r32 = lane & 31, hi = lane >> 5;
    const int q0 = u * 128 + wi * 32, cq = q0 >> 6, NT = 2 * u + 2;
    const size_t rowb = (size_t)b * SEQ;
    const bf16_t* qrow = Qg + (rowb + q0 + r32) * 1024 + h * 128;
    bf16x8 qf[4];
#pragma unroll
    for (int s = 0; s < 4; ++s) qf[s] = *(const bf16x8*)(qrow + map * 64 + s * 16 + hi * 8);
    unsigned koff0, voff0;
    { const int row = 8 * wid + (lane >> 4), slot = lane & 15;
      koff0 = (unsigned)(row * 1024 + ((slot ^ (row & 15)) * 8));
      voff0 = (unsigned)(row * 1024 + (((slot >> 2) ^ (row & 3)) * 32 + (slot & 3) * 8)); }
    const bf16_t* Kbh = Kg + rowb * 1024 + h * 128; const bf16_t* Vbh = Vg + rowb * 1024 + h * 128;
#define JT(i) (desc ? NT - 1 - (i) : (i))
#define DA_DMA(i) do { const int j_ = JT(i), sl_ = (i) & 3; _Pragma("unroll") for (int i_ = 0; i_ < 2; ++i_) { \
        glds16(Kbh + (size_t)j_ * 65536 + (i_ ? (koff0 ^ 32u) + 4096u : koff0), lds + sl_ * 32768 + (2 * wid + i_) * 1024); \
        glds16(Vbh + (size_t)j_ * 65536 + (i_ ? voff0 + 4096u : voff0), lds + sl_ * 32768 + 16384 + (2 * wid + i_) * 1024); } } while (0)
    f32x16 O[4];
#pragma unroll
    for (int db = 0; db < 4; ++db)
#pragma unroll
        for (int r = 0; r < 16; ++r) O[db][r] = 0.f;
    float lsum = 0.f;
    const float xq = (float)(q0 + r32 - 4 * hi);
    unsigned ka_0, va_0;
    { const unsigned l0 = lds_addr((lptr)lds); const int qp = (lane & 15) >> 2;
      ka_0 = l0 + r32 * 256 + (((map * 8 + hi) ^ (r32 & 15)) << 4);
      va_0 = l0 + 16384 + (4 * hi + qp) * 256 + (qp << 6) + ((lane >> 4) & 1) * 32 + (lane & 3) * 8; }
    __syncthreads();
    asm volatile("" : "+v"(qf[0]), "+v"(qf[1]), "+v"(qf[2]), "+v"(qf[3]));
    DA_DMA(0); DA_DMA(1);
    if (NT > 2) { DA_DMA(2); asm volatile("s_waitcnt vmcnt(4)" ::: "memory"); } else asm volatile("s_waitcnt vmcnt(0)" ::: "memory");
    __builtin_amdgcn_s_barrier();
    f32x16 pA0, pA1, pB0, pB1;
    { da_bias(pA0, pA1, JT(0), cq, xq, sl2, B2);
      unsigned ka[4];
#pragma unroll
      for (int s = 0; s < 4; ++s) ka[s] = ka_0 ^ (s << 5);
      bf16x8 kf[8]; kread8_swz(kf, ka); asm volatile("s_waitcnt lgkmcnt(0)" ::: "memory"); SBAR();
#pragma unroll
      for (int s = 0; s < 4; ++s) { pA0 = MFMA32(kf[2 * s], qf[s], pA0); pA1 = MFMA32(kf[2 * s + 1], qf[s], pA1); }
      asm volatile("s_nop 15\n\ts_nop 15" : "+v"(pA0), "+v"(pA1)); }
    da_bias(pB0, pB1, JT(1), cq, xq, sl2, B2);
#define SM4(P, b_) do { P[b_] = __builtin_amdgcn_exp2f(P[b_]); P[b_ + 1] = __builtin_amdgcn_exp2f(P[b_ + 1]); P[b_ + 2] = __builtin_amdgcn_exp2f(P[b_ + 2]); P[b_ + 3] = __builtin_amdgcn_exp2f(P[b_ + 3]); \
        lsum += (P[b_] + P[b_ + 1]) + (P[b_ + 2] + P[b_ + 3]); } while (0)
#define MFMA_A(acc, a_, b_) asm volatile("v_mfma_f32_32x32x16_bf16 %0, %1, %2, %0" : "+v"(acc) : "v"(a_), "v"(b_))
#define PIN(x_) asm volatile("" : "+v"(x_))
#define FMK(dst, krv) do { float f_; asm volatile("v_fmamk_f32 %0, %1, %c2, %3" : "=v"(f_) : "v"(sl2), "i"(__builtin_bit_cast(int, (float)(krv))), "v"(c0_)); dst = f_; } while (0)
#define FM2(C0, C1, j) do { FMK(C0[j], ((j) & 3) + 8 * ((j) >> 2)); FMK(C1[j], 32 + ((j) & 3) + 8 * ((j) >> 2)); } while (0)
#define DA_STEP(C0, C1, N0, N1, i) do { \
        if ((i) + 3 < NT) DA_DMA((i) + 3); \
        bf16x8 pb[4]; \
        { unsigned ka[4]; _Pragma("unroll") for (int s_ = 0; s_ < 4; ++s_) ka[s_] = (ka_0 + (((i) + 1) & 3) * 32768) ^ (s_ << 5); \
          bf16x8 kf[8]; kread8_swz(kf, ka); \
          s16x4 lo[2][4], hi[2][4]; unsigned va[4]; _Pragma("unroll") for (int d_ = 0; d_ < 4; ++d_) va[d_] = (va_0 + ((i) & 3) * 32768) ^ (d_ << 6); \
          SM4(C0, 0);  PIN(C0); PIN(lsum); SM4(C0, 4);  PIN(C0); PIN(lsum);                        \
          asm volatile("s_waitcnt lgkmcnt(0)" ::: "memory"); \
          MFMA_A(N0, kf[0], qf[0]); SM4(C0, 8);  PIN(C0); PIN(lsum); \
          MFMA_A(N1, kf[1], qf[0]); SM4(C0, 12); PIN(C0); PIN(lsum); \
          MFMA_A(N0, kf[2], qf[1]); pb[0] = pack8(C0, 0); PIN(pb[0]); \
          MFMA_A(N1, kf[3], qf[1]); pb[1] = pack8(C0, 8); PIN(pb[1]); \
          MFMA_A(N0, kf[4], qf[2]); \
          MFMA_A(N1, kf[5], qf[2]); \
          VRT(0, 0);                                                                                    \
          MFMA_A(N0, kf[6], qf[3]); \
          MFMA_A(N1, kf[7], qf[3]); \
          const int jt2_ = JT((i) + 2); \
          float c0_ = __builtin_fmaf(sl2s, (float)(64 * jt2_) - xq, (jt2_ > cq) ? -1.0e30f : -B2); PIN(c0_); \
            \
          VRT(1, 1); asm volatile("s_waitcnt lgkmcnt(8)" ::: "memory"); \
          { const bf16x8 v0_ = VPK(0, 0); MFMA_A(O[0], v0_, pb[0]); SM4(C1, 0); PIN(C1); PIN(lsum); const bf16x8 v1_ = VPK(0, 1); MFMA_A(O[1], v1_, pb[0]); \
            const bf16x8 v2_ = VPK(0, 2); MFMA_A(O[2], v2_, pb[0]); SM4(C1, 4); PIN(C1); PIN(lsum); const bf16x8 v3_ = VPK(0, 3); MFMA_A(O[3], v3_, pb[0]); } \
          VRT(0, 2); asm volatile("s_waitcnt lgkmcnt(8)" ::: "memory"); \
          { const bf16x8 v0_ = VPK(1, 0); MFMA_A(O[0], v0_, pb[1]); SM4(C1, 8); PIN(C1); PIN(lsum); const bf16x8 v1_ = VPK(1, 1); MFMA_A(O[1], v1_, pb[1]); pb[2] = pack8(C1, 0); PIN(pb[2]); \
            const bf16x8 v2_ = VPK(1, 2); MFMA_A(O[2], v2_, pb[1]); SM4(C1, 12); PIN(C1); PIN(lsum); const bf16x8 v3_ = VPK(1, 3); MFMA_A(O[3], v3_, pb[1]); pb[3] = pack8(C1, 8); PIN(pb[3]); } \
          VRT(1, 3); asm volatile("s_waitcnt lgkmcnt(8)" ::: "memory"); \
          _Pragma("unroll") for (int d_ = 0; d_ < 4; ++d_) { const bf16x8 vf_ = VPK(0, d_); MFMA_A(O[d_], vf_, pb[2]); FM2(C0, C1, 4 * d_); FM2(C0, C1, 4 * d_ + 1); } \
          asm volatile("s_waitcnt lgkmcnt(0)" ::: "memory"); \
          _Pragma("unroll") for (int d_ = 0; d_ < 4; ++d_) { const bf16x8 vf_ = VPK(1, d_); MFMA_A(O[d_], vf_, pb[3]); FM2(C0, C1, 4 * d_ + 2); FM2(C0, C1, 4 * d_ + 3); } \
          PIN(C0); PIN(C1); \
          if (jt2_ == cq) { da_bias(C0, C1, jt2_, cq, xq, sl2, B2); PIN(C0); PIN(C1); } } \
        if ((i) + 3 < NT) asm volatile("s_waitcnt vmcnt(4) lgkmcnt(0)" ::: "memory"); else asm volatile("s_waitcnt vmcnt(0) lgkmcnt(0)" ::: "memory"); \
        __builtin_amdgcn_s_barrier(); \
    } while (0)
    const float sl2s = __builtin_bit_cast(float, __builtin_amdgcn_readfirstlane(__builtin_bit_cast(int, sl2)));
    asm volatile(DA_LOOP_ALIGN ::: "memory");
#pragma unroll 1
    for (int i = 0; i < NT; i += 2) {
        DA_STEP(pA0, pA1, pB0, pB1, i);
        DA_STEP(pB0, pB1, pA0, pA1, i + 1);
    }
#undef DA_STEP
#undef FM2
#undef FMK
#undef MFMA_A
#undef PIN
#undef SM4
    asm volatile("s_nop 15\n\ts_nop 15" : "+v"(O[0]), "+v"(O[1]), "+v"(O[2]), "+v"(O[3]));
#undef DA_DMA
#undef JT
    lsum += __shfl_xor(lsum, 32);
    const float inv = 1.0f / lsum;
    LAS f32x4* xch = (LAS f32x4*)(lds + wi * 16384) + lane;
    if (map == 1) {
        const float f = lam * inv;
#pragma unroll
        for (int db = 0; db < 4; ++db)
#pragma unroll
            for (int g = 0; g < 4; ++g) xch[(db * 4 + g) * 64] = (f32x4){O[db][4 * g] * f, O[db][4 * g + 1] * f, O[db][4 * g + 2] * f, O[db][4 * g + 3] * f};
    }
    __syncthreads();
    if (map == 0) {
        float ss = 0.f;
#pragma unroll
        for (int db = 0; db < 4; ++db)
#pragma unroll
            for (int g = 0; g < 4; ++g) { const f32x4 o1 = xch[(db * 4 + g) * 64];
#pragma unroll
                for (int i = 0; i < 4; ++i) { const float v = O[db][4 * g + i] * inv - o1[i]; O[db][4 * g + i] = v; ss += v * v; } }
        ss += __shfl_xor(ss, 32);
        const float rr = __builtin_amdgcn_rsqf(ss * (1.f / 128.f) + 1e-6f) * outmul;
        bf16_t* orow = Og + (rowb + q0 + r32) * 1024 + h * 128 + 4 * hi;
#pragma unroll
        for (int db = 0; db < 4; ++db)
#pragma unroll
            for (int g = 0; g < 4; ++g) { const f32x4 gv = *(const f32x4*)(gout + 32 * db + 8 * g + 4 * hi);
                const unsigned w0 = pk_bf16(O[db][4 * g] * rr * gv[0], O[db][4 * g + 1] * rr * gv[1]), w1 = pk_bf16(O[db][4 * g + 2] * rr * gv[2], O[db][4 * g + 3] * rr * gv[3]);
                *(unsigned long long*)(orow + 32 * db + 8 * g) = (unsigned long long)w0 | ((unsigned long long)w1 << 32); }
    }
    __syncthreads();
}

__device__ __forceinline__ void memattn_unit(LAS unsigned char* lds, int tid, bf16_t* MQg, bf16_t* Og, const bf16_t* KVg, const float* mqss, const float* qn, const float* kn, int pm, int hd, float Bm) {
    const int lane = tid & 63, wid = __builtin_amdgcn_readfirstlane(tid >> 6), r32 = lane & 31, hi = lane >> 5;
    const int b = pm >> 3; const size_t row = (size_t)pm * 256 + wid * 32 + r32;
    __syncthreads();
#pragma unroll
    for (int i = 0; i < 8; ++i) { const int p = 8 * wid + i, vrow = 4 * p + (lane >> 4), slot = lane & 15;
        glds16(KVg + ((size_t)b * MEML + vrow) * 2048 + 512 + hd * 128 + (((slot >> 2) ^ (vrow & 3)) * 32 + (slot & 3) * 8), lds + 65536 + p * 1024); }
    { const int key = tid >> 1, half = tid & 1; const bf16_t* src = KVg + ((size_t)b * MEML + key) * 2048 + hd * 128 + half * 64;
      v4u raw[8]; float s = 0.f;
#pragma unroll
      for (int c = 0; c < 8; ++c) { raw[c] = *(const v4u*)(src + c * 8);
          const float a0 = bf_lo(raw[c].x), a1 = bf_hi(raw[c].x), a2 = bf_lo(raw[c].y), a3 = bf_hi(raw[c].y), a4 = bf_lo(raw[c].z), a5 = bf_hi(raw[c].z), a6 = bf_lo(raw[c].w), a7 = bf_hi(raw[c].w);
          s += ((a0 * a0 + a1 * a1) + (a2 * a2 + a3 * a3)) + ((a4 * a4 + a5 * a5) + (a6 * a6 + a7 * a7)); }
      s += __shfl_xor(s, 1);
      const float rk = __builtin_amdgcn_rsqf(s * (1.f / 128.f) + 1e-6f) * MEMSCALE;
#pragma unroll
      for (int c = 0; c < 8; ++c) { const int d0 = half * 64 + c * 8; const f32x4 qa = *(const f32x4*)(qn + d0), qb = *(const f32x4*)(qn + d0 + 4), ka = *(const f32x4*)(kn + d0), kb = *(const f32x4*)(kn + d0 + 4);
          v4u w; w.x = pk_bf16(bf_lo(raw[c].x) * rk * qa[0] * ka[0], bf_hi(raw[c].x) * rk * qa[1] * ka[1]); w.y = pk_bf16(bf_lo(raw[c].y) * rk * qa[2] * ka[2], bf_hi(raw[c].y) * rk * qa[3] * ka[3]);
          w.z = pk_bf16(bf_lo(raw[c].z) * rk * qb[0] * kb[0], bf_hi(raw[c].z) * rk * qb[1] * kb[1]); w.w = pk_bf16(bf_lo(raw[c].w) * rk * qb[2] * kb[2], bf_hi(raw[c].w) * rk * qb[3] * kb[3]);
          *(LAS v4u*)(lds + (key >> 6) * 16384 + (half * 8 + c) * 1024 + (key & 63) * 16) = w; } }
    const bf16_t* qrow = MQg + row * 512 + hd * 128;
    bf16x8 qf[8];
#pragma unroll
    for (int s = 0; s < 8; ++s) qf[s] = *(const bf16x8*)(qrow + s * 16 + hi * 8);
    const float rq = __builtin_amdgcn_rsqf((mqss[row * 8 + hd * 2] + mqss[row * 8 + hd * 2 + 1]) * (1.f / 128.f) + 1e-6f);
    f32x16 O[4];
#pragma unroll
    for (int db = 0; db < 4; ++db)
#pragma unroll
        for (int r = 0; r < 16; ++r) O[db][r] = 0.f;
    float lsum = 0.f;
    const lptr kl0 = (lptr)lds + hi * 1024 + r32 * 16;
    unsigned va0[4];
    { const int qp = (lane & 15) >> 2;
#pragma unroll
      for (int db = 0; db < 4; ++db) va0[db] = lds_addr((lptr)lds) + 65536 + (4 * hi + qp) * 256 + ((db ^ qp) * 64) + ((lane >> 4) & 1) * 32 + (lane & 3) * 8; }
    __syncthreads();
#pragma unroll 1
    for (int tl = 0; tl < 4; ++tl) {
        f32x16 p0, p1;
#pragma unroll
        for (int r = 0; r < 16; ++r) { p0[r] = 0.f; p1[r] = 0.f; }
        bf16x8 kf[8], kg[8]; kread8(kf, lds_addr(kl0) + tl * 16384); kread8(kg, lds_addr(kl0) + tl * 16384 + 8192);
        asm volatile("s_waitcnt lgkmcnt(8)" ::: "memory"); SBAR();
#pragma unroll
        for (int s = 0; s < 4; ++s) { p0 = MFMA32(kf[2 * s], qf[s], p0); p1 = MFMA32(kf[2 * s + 1], qf[s], p1); }
        SBAR(); asm volatile("s_waitcnt lgkmcnt(0)" ::: "memory"); SBAR();
#pragma unroll
        for (int s = 0; s < 4; ++s) { p0 = MFMA32(kg[2 * s], qf[4 + s], p0); p1 = MFMA32(kg[2 * s + 1], qf[4 + s], p1); }
#pragma unroll
        for (int r = 0; r < 16; ++r) { p0[r] = __builtin_amdgcn_exp2f(__builtin_fmaf(p0[r], rq, -Bm)); p1[r] = __builtin_amdgcn_exp2f(__builtin_fmaf(p1[r], rq, -Bm)); lsum += p0[r] + p1[r]; }
        bf16x8 pb[4]; pb[0] = pack8(p0, 0); pb[1] = pack8(p0, 8); pb[2] = pack8(p1, 0); pb[3] = pack8(p1, 8);
        unsigned va[4];
#pragma unroll
        for (int db = 0; db < 4; ++db) va[db] = va0[db] + tl * 16384;
        pv_tile(O, va, pb);
    }
    lsum += __shfl_xor(lsum, 32);
    const float inv = 1.0f / lsum;
    bf16_t* orow = Og + row * 512 + hd * 128 + 4 * hi;
#pragma unroll
    for (int db = 0; db < 4; ++db)
#pragma unroll
        for (int g = 0; g < 4; ++g) { const unsigned w0 = pk_bf16(O[db][4 * g] * inv, O[db][4 * g + 1] * inv), w1 = pk_bf16(O[db][4 * g + 2] * inv, O[db][4 * g + 3] * inv);
            *(unsigned long long*)(orow + 32 * db + 8 * g) = (unsigned long long)w0 | ((unsigned long long)w1 << 32); }
}

__device__ __forceinline__ void pool_unit(LAS unsigned char* lds, int tid, const bf16_t* Pg, bf16_t* Og, const bf16_t* Wt, const float* scale, int tok0, int g) {
    const int lane = tid & 63, wid = __builtin_amdgcn_readfirstlane(tid >> 6), r32 = lane & 31, hi = lane >> 5;
    LAS unsigned char* Lp = lds; LAS unsigned char* Ld = lds + 272 * 256;
    const int w = 2 << g, pos0 = tok0 & (SEQ - 1);
    __syncthreads();
    { v4u st[9];
#pragma unroll
      for (int k = 0; k < 9; ++k) { const int i = tid + k * NTHR, ii = i < 272 * 16 ? i : tid, rr = ii >> 4, ch = ii & 15; const bool ok = pos0 - 16 + rr >= 0;
          const v4u v = *(const v4u*)(Pg + (size_t)(tok0 - 16 + (ok ? rr : 16)) * 512 + g * 128 + ch * 8); st[k].x = ok ? v.x : 0u; st[k].y = ok ? v.y : 0u; st[k].z = ok ? v.z : 0u; st[k].w = ok ? v.w : 0u; }
#pragma unroll
      for (int k = 0; k < 9; ++k) { const int i = tid + k * NTHR, rr = i >> 4, ch = i & 15; if (i < 272 * 16) *(LAS v4u*)(Lp + rr * 256 + ch * 16) = st[k]; } }
    bf16x8 wf[4][8];
#pragma unroll
    for (int db = 0; db < 4; ++db)
#pragma unroll
        for (int s = 0; s < 8; ++s) wf[db][s] = *(const bf16x8*)(Wt + (size_t)(32 * db + r32) * 128 + hi * 8 + s * 16);
    __syncthreads();
    { const int ch = tid & 15, t0 = (tid >> 4) * 8;
      float s[8];
#pragma unroll
      for (int i = 0; i < 8; ++i) s[i] = 0.f;
#pragma unroll 1
      for (int k = 1; k < w; ++k) { const v4u v = *(const LAS v4u*)(Lp + (16 + t0 - k) * 256 + ch * 16);
          s[0] += bf_lo(v.x); s[1] += bf_hi(v.x); s[2] += bf_lo(v.y); s[3] += bf_hi(v.y); s[4] += bf_lo(v.z); s[5] += bf_hi(v.z); s[6] += bf_lo(v.w); s[7] += bf_hi(v.w); }
#pragma unroll
      for (int tt = 0; tt < 8; ++tt) { const int t = t0 + tt, tpos = pos0 + t; const int cnt = (tpos + 1 < w) ? (tpos + 1) : w; const float ic = 1.0f / (float)cnt;
          const v4u v = *(const LAS v4u*)(Lp + (16 + t) * 256 + ch * 16), o = *(const LAS v4u*)(Lp + (16 + t - w + 1) * 256 + ch * 16);
          float p[8] = {bf_lo(v.x), bf_hi(v.x), bf_lo(v.y), bf_hi(v.y), bf_lo(v.z), bf_hi(v.z), bf_lo(v.w), bf_hi(v.w)};
          float q[8] = {bf_lo(o.x), bf_hi(o.x), bf_lo(o.y), bf_hi(o.y), bf_lo(o.z), bf_hi(o.z), bf_lo(o.w), bf_hi(o.w)};
          float d[8];
#pragma unroll
          for (int i = 0; i < 8; ++i) { s[i] += p[i]; d[i] = s[i] * ic - p[i]; s[i] -= q[i]; }
          v4u wv; wv.x = pk_bf16(d[0], d[1]); wv.y = pk_bf16(d[2], d[3]); wv.z = pk_bf16(d[4], d[5]); wv.w = pk_bf16(d[6], d[7]);
          *(LAS v4u*)(Ld + t * 256 + ((ch ^ (t & 15)) << 4)) = wv; } }
    __syncthreads();
    const int tok = wid * 32 + r32;
    bf16x8 df[8];
#pragma unroll
    for (int s = 0; s < 8; ++s) df[s] = *(const LAS bf16x8*)(Ld + tok * 256 + (((2 * s + hi) ^ (tok & 15)) << 4));
    bf16_t* orow = Og + (size_t)(tok0 + tok) * 512 + g * 128 + 4 * hi;
#pragma unroll
    for (int db = 0; db < 4; ++db) {
        f32x16 acc;
#pragma unroll
        for (int r = 0; r < 16; ++r) acc[r] = 0.f;
#pragma unroll
        for (int s = 0; s < 8; ++s) acc = MFMA32(wf[db][s], df[s], acc);
#pragma unroll
        for (int gq = 0; gq < 4; ++gq) { const f32x4 sc = *(const f32x4*)(scale + 32 * db + 8 * gq + 4 * hi);
            const unsigned w0 = pk_bf16(acc[4 * gq] * sc[0], acc[4 * gq + 1] * sc[1]), w1 = pk_bf16(acc[4 * gq + 2] * sc[2], acc[4 * gq + 3] * sc[3]);
            *(unsigned long long*)(orow + 32 * db + 8 * gq) = (unsigned long long)w0 | ((unsigned long long)w1 << 32); }
    }
}
#undef MFMA32
#undef VRD
#undef VPK
#undef SBAR
}

#ifndef MIX_NAIVE_DA
#define MIX_NAIVE_DA 0
#endif
#ifndef MIX_NAIVE_MEM
#define MIX_NAIVE_MEM 0
#endif
#ifndef MIX_NAIVE_POOL
#define MIX_NAIVE_POOL 0
#endif
__device__ __forceinline__ void phase_mixers(unsigned char* ws, LAS unsigned char* lds, int l, int tid) {
    const float* prm = (const float*)(ws + WS_PARAM); const float* sc = (const float*)(ws + WS_SC) + l * 8;
    const float lam = ld_f32_agent(sc + 0), bnd0 = ld_f32_agent(sc + 1), bnd1 = ld_f32_agent(sc + 2), bndm = ld_f32_agent(sc + 3), omul = ld_f32_agent(sc + 4);
    const int bx = blockIdx.x, vcu = (gridDim.x == 256) ? ((bx & 7) * 32 + (bx >> 3)) : bx;
    bf16_t* Q = (bf16_t*)(ws + WS_Q); const bf16_t* K = (const bf16_t*)(ws + WS_K); const bf16_t* V = (const bf16_t*)(ws + WS_V);
    bf16_t* MQ = (bf16_t*)(ws + WS_MQ); const bf16_t* KV = (const bf16_t*)(ws + WS_MEMKV) + l * 1024;     const float* mqss = (const float*)(ws + WS_MQSS);
#if MIX_NAIVE_DA
    for (int u = blockIdx.x; u < 4096; u += gridDim.x) { const int hc = 63 - (u >> 6), c = hc >> 1, bh = u & 63, b = bh >> 3, h = bh & 7;
        const size_t rowb = (size_t)b * SEQ; const float slope2 = exp2f(-(float)(h + 1)) * LOG2E;
        naive_attn_unit<true>(lds, tid, Q + (rowb + hc * 32) * 1024 + h * 128, 1024, K + rowb * 1024 + h * 128, 1024, V + rowb * 1024 + h * 128, 1024, (bf16_t*)(ws + WS_XB) + (rowb + hc * 32) * 1024 + h * 128, 1024,
                              c + 1, hc * 32, nullptr, nullptr, nullptr, slope2, bnd0, bnd1, lam, prm + PB_GOUT + l * 128, omul); }
#else
    {
        const float B2 = fmaxf(bnd0, bnd1);
        for (int rep_ = 0; rep_ < REP_DA; ++rep_)
        for (int w = vcu; w < 256; w += gridDim.x) { const int bh = w >> 2, s = w & 3, b = bh >> 3, h = bh & 7; const float sl2 = exp2f(-(float)(h + 1)) * LOG2E;
#pragma unroll 1
            for (int i = 0; i < 4; ++i) { const int u = (i == 0) ? 15 - s : (i == 1) ? 8 + s : (i == 2) ? 7 - s : s;
                mix::diffattn_unit(lds, tid, Q, K, V, (bf16_t*)(ws + WS_XB), b, h, u, (i & 1) != 0, sl2, B2, lam, prm + PB_GOUT + l * 128, omul); } }
    }
#endif
#if MIX_NAIVE_MEM
    for (int u = blockIdx.x; u < 2048; u += gridDim.x) { const int qt = u >> 2, hd = u & 3, b = qt >> 6; const size_t row0 = (size_t)qt * 32;
        naive_attn_unit<false>(lds, tid, MQ + row0 * 512 + hd * 128, 512, KV + (size_t)b * MEML * 2048 + hd * 128, 2048, KV + (size_t)b * MEML * 2048 + 512 + hd * 128, 2048, MQ + row0 * 512 + hd * 128, 512,
                               4, 0, prm + PB_MQN + l * 128, prm + PB_MKN + l * 128, mqss + row0 * 8 + hd * 2, 0.f, bndm, 0.f, 0.f, nullptr, 1.f); }
#else
    for (int rep_ = 0; rep_ < REP_MEM; ++rep_)
    for (int w = vcu; w < 256; w += gridDim.x) mix::memattn_unit(lds, tid, MQ, (rep_ + 1 < REP_MEM) ? (bf16_t*)(ws + WS_OPOOL) : MQ, KV, mqss, prm + PB_MQN + l * 128, prm + PB_MKN + l * 128, w >> 2, w & 3, bndm);
#endif
#if MIX_NAIVE_POOL
    for (int u = blockIdx.x; u < 1024; u += gridDim.x) { const int tt = u >> 2, g = u & 3;
        naive_pool_unit(lds, tid, (const bf16_t*)(ws + WS_P), (bf16_t*)(ws + WS_OPOOL), prm + PB_POOLW + (size_t)(l * 4 + g) * 128 * 128, prm + PB_POOLS + l * 512 + g * 128, tt * 64, g); }
#else
    for (int rep_ = 0; rep_ < REP_POOL; ++rep_)
    for (int w = vcu; w < 256; w += gridDim.x) { const int pm = w >> 2, g = w & 3;
        mix::pool_unit(lds, tid, (const bf16_t*)(ws + WS_P), (bf16_t*)(ws + WS_OPOOL), (const bf16_t*)(ws + WS_POOLWT) + (size_t)(l * 4 + g) * 128 * 128, prm + PB_POOLS + l * 512 + g * 128, pm * 256, g); }
#endif
}

__device__ __forceinline__ void phase_route(unsigned char* ws, const bf16_t* xin, LAS unsigned char* lds, int tid, int lane, int wave) {
    const float* gffn = (const float*)(ws + WS_PARAM) + PB_GFFN1; const float* wr = (const float*)(ws + WS_PARAM) + PB_WR;
    unsigned* cnt = (unsigned*)ws + CW_WCNT + 8 * blockIdx.x; int* toke = (int*)(ws + WS_TOKE); int* tokp = (int*)(ws + WS_TOKP); float* tokg = (float*)(ws + WS_TOKG); float* tokr = (float*)(ws + WS_TOKR);
    LAS unsigned* lcnt = (LAS unsigned*)lds; LAS unsigned* lbase = lcnt + 8; LAS int* linfo = (LAS int*)(lds + 64);
    const int per = T / gridDim.x;
    f32x4 wg0[16], wg1[16];
#pragma unroll
    for (int kk = 0; kk < 16; ++kk) { const int k = 16 * lane + kk; const float g = gffn[k]; wg0[kk] = *(const f32x4*)(wr + k * 8) * g; wg1[kk] = *(const f32x4*)(wr + k * 8 + 4) * g; }
    if (tid < 8) lbase[tid] = 0u;
    for (int c0 = 0; c0 < per; c0 += 64) {
        __syncthreads();
        if (tid < 8) lcnt[tid] = 0u;
        __syncthreads();
        v4u raw[8][2];
#pragma unroll
        for (int q = 0; q < 8; ++q) { const int i = wave + q * NWAVES; const int t = blockIdx.x * per + ((c0 + i < per) ? c0 + i : 0); const bf16_t* p = xin + (size_t)t * D + 16 * lane; raw[q][0] = *(const v4u*)p; raw[q][1] = *(const v4u*)(p + 8); }
#pragma unroll
        for (int q = 0; q < 8; ++q) { const int i = wave + q * NWAVES; if (c0 + i >= per) break;
            const int t = blockIdx.x * per + c0 + i;
            f32x4 v[4]; { const v4u a_ = raw[q][0], b_ = raw[q][1];
              v[0] = (f32x4){bf_lo(a_.x), bf_hi(a_.x), bf_lo(a_.y), bf_hi(a_.y)}; v[1] = (f32x4){bf_lo(a_.z), bf_hi(a_.z), bf_lo(a_.w), bf_hi(a_.w)};
              v[2] = (f32x4){bf_lo(b_.x), bf_hi(b_.x), bf_lo(b_.y), bf_hi(b_.y)}; v[3] = (f32x4){bf_lo(b_.z), bf_hi(b_.z), bf_lo(b_.w), bf_hi(b_.w)}; }
            float s = 0.f;
#pragma unroll
            for (int j = 0; j < 4; ++j) s += (v[j][0] * v[j][0] + v[j][1] * v[j][1]) + (v[j][2] * v[j][2] + v[j][3] * v[j][3]);
            const float rstd = __builtin_amdgcn_rsqf(wave_sum(s) * (1.f / 1024.f) + 1e-6f);
            float lg[8];
#pragma unroll
            for (int e = 0; e < 8; ++e) lg[e] = 0.f;
#pragma unroll
            for (int j = 0; j < 4; ++j)
#pragma unroll
                for (int k4 = 0; k4 < 4; ++k4) { const float xv = v[j][k4]; const f32x4 w0 = wg0[4 * j + k4], w1 = wg1[4 * j + k4];
                    lg[0] += xv * w0[0]; lg[1] += xv * w0[1]; lg[2] += xv * w0[2]; lg[3] += xv * w0[3]; lg[4] += xv * w1[0]; lg[5] += xv * w1[1]; lg[6] += xv * w1[2]; lg[7] += xv * w1[3]; }
#pragma unroll
            for (int e = 0; e < 8; ++e) lg[e] = wave_sum(lg[e]) * rstd;
            int i0 = 0; float b0 = lg[0];
#pragma unroll
            for (int e = 1; e < 8; ++e) if (lg[e] > b0) { b0 = lg[e]; i0 = e; }
            int i1 = -1; float b1 = -3.0e38f;
#pragma unroll
            for (int e = 0; e < 8; ++e) if (e != i0 && lg[e] > b1) { b1 = lg[e]; i1 = e; }
            const float g0 = 1.f / (1.f + __expf(b1 - b0)), g1 = 1.f - g0;
            if (lane == 0) { const unsigned p0 = __hip_atomic_fetch_add(lcnt + i0, 1u, __ATOMIC_RELAXED, __HIP_MEMORY_SCOPE_WORKGROUP), p1 = __hip_atomic_fetch_add(lcnt + i1, 1u, __ATOMIC_RELAXED, __HIP_MEMORY_SCOPE_WORKGROUP);
                linfo[i * 4 + 0] = i0; linfo[i * 4 + 1] = i1; linfo[i * 4 + 2] = (int)p0; linfo[i * 4 + 3] = (int)p1;
                toke[2 * t] = i0; toke[2 * t + 1] = i1; tokg[2 * t] = g0; tokg[2 * t + 1] = g1; tokr[t] = rstd; }
        }
        __syncthreads();
        if (tid < 64 && c0 + tid < per) { const int t = blockIdx.x * per + c0 + tid; tokp[2 * t] = (int)lbase[linfo[tid * 4 + 0]] + linfo[tid * 4 + 2]; tokp[2 * t + 1] = (int)lbase[linfo[tid * 4 + 1]] + linfo[tid * 4 + 3]; }
        __syncthreads();
        if (tid < 8) lbase[tid] += lcnt[tid];
    }
    __syncthreads();
    if (tid < 8) cnt[tid] = lbase[tid];
}
__device__ __forceinline__ void build_texp(unsigned char* ws, LAS int* texp, int tid) {
    const unsigned* cnt = (const unsigned*)ws + CW_CNT;
    __syncthreads();
    if (tid == 0) { int tb = 0; for (int e = 0; e < NEXP; ++e) { texp[160 + e] = tb; const int n = (int)__hip_atomic_load(cnt + 64 * e, RLX_AGENT); const int nt = (n + 255) >> 8; for (int i = 0; i < nt; ++i) texp[tb + i] = e; tb += nt; } texp[168] = tb; texp[169] = tb; }
    __syncthreads();
}
__device__ __forceinline__ void scan_counts(unsigned char* ws, LAS int* texp, LAS int* wbase, int tid, int lane, int wave) {
    const unsigned* wcnt = (const unsigned*)ws + CW_WCNT; const int G = gridDim.x;
    __syncthreads();
    { int c[4], s = 0;
#pragma unroll
      for (int i = 0; i < 4; ++i) { const int w = 4 * lane + i; c[i] = (w < G) ? (int)__hip_atomic_load(wcnt + 8 * w + wave, RLX_AGENT) : 0; s += c[i]; }
      int inc = s;
#pragma unroll
      for (int o = 1; o < 64; o <<= 1) { const int v = __shfl_up(inc, o); if (lane >= o) inc += v; }
      int ex = inc - s;
#pragma unroll
      for (int i = 0; i < 4; ++i) { wbase[(4 * lane + i) * 8 + wave] = ex; ex += c[i]; }
      if (lane == 63) { texp[176 + wave] = inc; if (blockIdx.x == 0) __hip_atomic_store((unsigned*)ws + CW_CNT + 64 * wave, (unsigned)inc, RLX_AGENT); } }
    __syncthreads();
    if (tid == 0) { int tb = 0; for (int e = 0; e < NEXP; ++e) { texp[160 + e] = tb; const int nt = (texp[176 + e] + 255) >> 8; for (int i = 0; i < nt; ++i) texp[tb + i] = e; tb += nt; } texp[168] = tb; texp[169] = tb; }
    __syncthreads();
}
__device__ __forceinline__ void phase_gather(unsigned char* ws, const bf16_t* xin, LAS int* texp, const LAS int* wbase, int lane, int wave) {
    const int* toke = (const int*)(ws + WS_TOKE); int* tokp = (int*)(ws + WS_TOKP); const float* tokr = (const float*)(ws + WS_TOKR); const int per = T / gridDim.x;
    unsigned char* xg = ws + WS_XGY; float* xgrs = (float*)(ws + WS_XGRS);
    const int gw = blockIdx.x * NWAVES + wave, NGW = gridDim.x * NWAVES;
    for (int t = gw; t < T; t += NGW) {
        f32x4 v[4]; ld16_bf16(xin + (size_t)t * D + 16 * lane, v); float mx = 0.f;
#pragma unroll
        for (int j = 0; j < 4; ++j) { mx = fmaxf(mx, fmaxf(fmaxf(fabsf(v[j][0]), fabsf(v[j][1])), fmaxf(fabsf(v[j][2]), fabsf(v[j][3])))); }
#pragma unroll
        for (int o = 1; o < 64; o <<= 1) mx = fmaxf(mx, __shfl_xor(mx, o));
        const float inv = mx > 0.f ? 127.0f / mx : 0.f, rs = mx * (1.0f / 127.0f) * tokr[t];
        v4u w; w.x = pk_i8x4(v[0][0] * inv, v[0][1] * inv, v[0][2] * inv, v[0][3] * inv); w.y = pk_i8x4(v[1][0] * inv, v[1][1] * inv, v[1][2] * inv, v[1][3] * inv);
        w.z = pk_i8x4(v[2][0] * inv, v[2][1] * inv, v[2][2] * inv, v[2][3] * inv); w.w = pk_i8x4(v[3][0] * inv, v[3][1] * inv, v[3][2] * inv, v[3][3] * inv);
#pragma unroll
        for (int k = 0; k < 2; ++k) { const int e = toke[2 * t + k], p = tokp[2 * t + k] + wbase[(t / per) * 8 + e]; const size_t row = (size_t)texp[160 + e] * 256 + p;
            *((v4u*)(xg + row * D) + lane) = w; if (lane == 0) { xgrs[row] = rs; tokp[2 * t + k] = p; } }
    }
}
__device__ __forceinline__ void phase_combine(unsigned char* ws, const bf16_t* xs, float* dst, LAS int* texp, int lane, int wave) {
    const int* toke = (const int*)(ws + WS_TOKE); const int* tokp = (const int*)(ws + WS_TOKP); const float* tokg = (const float*)(ws + WS_TOKG);
    const bf16_t* Y = (const bf16_t*)(ws + WS_Y);
    const int gw = blockIdx.x * NWAVES + wave, NGW = gridDim.x * NWAVES;
    for (int t = gw; t < T; t += NGW) {
        const size_t r0 = (size_t)texp[160 + toke[2 * t]] * 256 + tokp[2 * t], r1 = (size_t)texp[160 + toke[2 * t + 1]] * 256 + tokp[2 * t + 1]; const float g0 = tokg[2 * t], g1 = tokg[2 * t + 1];
        f32x4 xv[4]; ld16_bf16(xs + (size_t)t * D + 16 * lane, xv);
        const v4u* y0 = (const v4u*)(Y + r0 * D) + 2 * lane; const v4u* y1 = (const v4u*)(Y + r1 * D) + 2 * lane;
#pragma unroll
        for (int h = 0; h < 2; ++h) { const v4u p = y0[h], q = y1[h]; f32x4 xa = xv[2 * h], xc = xv[2 * h + 1];
            xa[0] += g0 * bf_lo(p.x) + g1 * bf_lo(q.x); xa[1] += g0 * bf_hi(p.x) + g1 * bf_hi(q.x); xa[2] += g0 * bf_lo(p.y) + g1 * bf_lo(q.y); xa[3] += g0 * bf_hi(p.y) + g1 * bf_hi(q.y);
            xc[0] += g0 * bf_lo(p.z) + g1 * bf_lo(q.z); xc[1] += g0 * bf_hi(p.z) + g1 * bf_hi(q.z); xc[2] += g0 * bf_lo(p.w) + g1 * bf_lo(q.w); xc[3] += g0 * bf_hi(p.w) + g1 * bf_hi(q.w);
            f32x4* xw = (f32x4*)(dst + (size_t)t * D) + 4 * lane; xw[2 * h] = xa; xw[2 * h + 1] = xc; }
    }
}

typedef pg8::EpiSwiglu<true, true> EpiSwigluF8;
#define GEMM_PHASE(EPI, g, S, E) do { S.prep(); __syncthreads(); pg8::gemm_phase<EPI, pg8::Sched2, true, true>(lds, g, S, E); } while (0)
__global__ void __launch_bounds__(NTHR, 2) fwd_kernel(Args args) {
    extern __shared__ __attribute__((aligned(16))) unsigned char lds_raw[];
    LAS unsigned char* lds = (LAS unsigned char*)lds_raw;
    volatile LAS unsigned* MISC = (volatile LAS unsigned*)(lds + MISC_OFF);
    LAS float* rstab = (LAS float*)(lds + RS_OFF); LAS int* texp = (LAS int*)(lds + TEXP_OFF);
    unsigned char* const ws0 = args.ws; int G = gridDim.x, bx = blockIdx.x;
#define PHASE_BEGIN() size_t z_ = 0; asm volatile("" : "+s"(z_), "+s"(G), "+s"(bx)); unsigned char* ws = args.ws + z_; float* out = args.out + z_; int tid = threadIdx.x; asm volatile("" : "+v"(tid)); const int lane = tid & 63, wave = __builtin_amdgcn_readfirstlane(tid >> 6); (void)lane; (void)wave; (void)out
    if (threadIdx.x < 64) MISC[threadIdx.x] = 0u;
    __syncthreads();
    XcdBarrier bar; bar.bar = (unsigned*)ws0 + CW_BAR; bar.x = 0; bar.st = nullptr;
    const int lo = args.ph_lo, hi = args.ph_hi;
    if (MK_N_LAUNCHES == 1 && hi - lo > 1) bar = xcd_barrier_post((unsigned*)ws0 + CW_BAR, MISC + 8);
#define IN(k) (lo <= (k) && (k) < hi)
#define SEAM(k) do { if (IN(k) && IN((k) + 1)) { size_t zb_ = 0; asm volatile("" : "+s"(zb_)); bar.bar = (unsigned*)args.ws + CW_BAR + zb_; xcd_barrier(bar); } } while (0)

    if (IN(0)) { PHASE_BEGIN(); phase_prologue(args, lds, tid, lane, wave); }
    SEAM(0);
    if (IN(0) && IN(2)) {}
    if (IN(2)) { PHASE_BEGIN();
        pg8::Gemm g{(const bf16_t*)(ws + WS_MEMBF), (const bf16_t*)(ws + WS_WMEMKV), NBATCH * MEML, 2048, D};
        pg8::Sched2 S; S.init2(g.M, g.N, G, bx, rstab); S.rsrc = (const float*)(ws + WS_SSM); S.rmode = 1;
        pg8::EpiStore<true> E{(bf16_t*)(ws + WS_MEMKV), 2048, rstab};
        GEMM_PHASE(pg8::EpiStore<true>, g, S, E);
        __syncthreads();
    }
    SEAM(2);
    for (int l = 0; l < 2; ++l) {
        const int pb = l == 0 ? 3 : 11;
        if (IN(pb)) { for (int rep_ = 0; rep_ < REP_A; ++rep_) { PHASE_BEGIN();
#if I8_A
            pg8::Gemm g{(const bf16_t*)(ws + WS_QX), (const bf16_t*)(ws + WS_W1T + (size_t)l * 14 * MiB), T, NGEMM1, D / 2};
            pg8::Sched2 S; S.init2(T, NGEMM1, G, bx, rstab); S.rsrc = (const float*)(ws + WS_SA); S.rmode = 2; S.wgm = 4;
            pg8::EpiA<true> E{ws, l, rstab};
            GEMM_PHASE(pg8::EpiA<true>, g, S, E); __syncthreads(); }
#else
            pg8::Gemm g{(const bf16_t*)(ws + WS_XB), (const bf16_t*)(ws + WS_W1T + (size_t)l * 14 * MiB), T, NGEMM1, D};
            pg8::Sched2 S; S.init2(T, NGEMM1, G, bx, rstab); S.rsrc = (const float*)(ws + WS_SS); S.rmode = 1; S.wgm = 4;
            pg8::EpiA<false> E{ws, l, rstab};
            GEMM_PHASE(pg8::EpiA<false>, g, S, E); __syncthreads(); }
#endif
        }
        SEAM(pb);
        if (IN(pb + 1)) { PHASE_BEGIN(); phase_mixers(ws, lds, l, tid); }
        SEAM(pb + 1);
        if (IN(pb + 2)) { for (int rep_ = 0; rep_ < REP_C; ++rep_) { PHASE_BEGIN();
            { pg8::Gemm g{(const bf16_t*)(ws + WS_XB), (const bf16_t*)(ws + WS_WBRDA + (size_t)l * 2 * MiB), T, D, 1024}; pg8::Sched2 S; S.init2(T, D, G, bx, rstab);
              pg8::EpiBr0 E{ws}; GEMM_PHASE(pg8::EpiBr0, g, S, E); }
            __syncthreads(); { size_t z2_ = 0; asm volatile("" : "+s"(z2_), "+s"(G), "+s"(bx)); ws = args.ws + z2_; }
            { pg8::Gemm g{(const bf16_t*)(ws + WS_OPOOL), (const bf16_t*)(ws + WS_WBRPOOL + (size_t)l * 1 * MiB), T, D, 512}; pg8::Sched2 S; S.init2(T, D, G, bx, rstab);
              S.chain = 2; S.A2 = (const bf16_t*)(ws + WS_MQ); S.B2 = (const bf16_t*)(ws + WS_WBRMEM + (size_t)l * 1 * MiB);
              pg8::EpiBrC E{ws}; GEMM_PHASE(pg8::EpiBrC, g, S, E); } __syncthreads(); }
        }
        SEAM(pb + 2);
        if (IN(pb + 3)) { PHASE_BEGIN();
            pg8::Gemm g{(const bf16_t*)(ws + WS_Q), (const bf16_t*)(ws + WS_WOUT + (size_t)l * 2 * MiB), T, D, D}; pg8::Sched2 S; S.init2(T, D, G, bx, rstab);
            pg8::EpiResB E{l == 0 ? (const float*)(args.in[0] + z_) : (const float*)nullptr, (bf16_t*)(ws + WS_XS)};
            GEMM_PHASE(pg8::EpiResB, g, S, E); __syncthreads();
        }
        SEAM(pb + 3);
        if (l == 0) {
            if (IN(7) && I8_E) { PHASE_BEGIN(); phase_quant_rows((const bf16_t*)(ws + WS_XS), ws, lane, wave); }
            SEAM(7);
            if (IN(8)) { for (int rep_ = 0; rep_ < REP_E; ++rep_) { PHASE_BEGIN();
#if I8_E
                pg8::Gemm g{(const bf16_t*)(ws + WS_QX), (const bf16_t*)(ws + WS_WFF13), T, 2 * FFD, D / 2}; pg8::Sched2 S; S.init2(T, 2 * FFD, G, bx, rstab); S.rsrc = (const float*)(ws + WS_SA); S.rmode = 2; S.wgm = 4;
                EpiSwigluF8 E{(bf16_t*)(ws + WS_HFF), FFD, rstab, (const float*)(ws + WS_SW) + SW_FF, FFD, nullptr, 0};
                GEMM_PHASE(EpiSwigluF8, g, S, E); __syncthreads(); }
#else
                pg8::Gemm g{(const bf16_t*)(ws + WS_X1B), (const bf16_t*)(ws + WS_WFF13), T, 2 * FFD, D}; pg8::Sched2 S; S.init2(T, 2 * FFD, G, bx, rstab); S.rsrc = (const float*)(ws + WS_SS); S.rmode = 1; S.wgm = 4;
                pg8::EpiSwiglu<false> E{(bf16_t*)(ws + WS_HFF), FFD, rstab, nullptr, 0, nullptr, 0};
                GEMM_PHASE(pg8::EpiSwiglu<false>, g, S, E); __syncthreads(); }
#endif
            }
            SEAM(8);
            if (IN(9)) { PHASE_BEGIN();
                pg8::Gemm g{(const bf16_t*)(ws + WS_HFF), (const bf16_t*)(ws + WS_WFF2), T, D, FFD / 2}; pg8::Sched2 S; S.init2(T, D, G, bx, rstab);
                pg8::EpiResB8 E{(bf16_t*)(ws + WS_XS), (const float*)(ws + WS_SW) + SW_W2 + 8 * 1024};
                GEMM_PHASE(pg8::EpiResB8, g, S, E); __syncthreads();
            }
            SEAM(9);
            if (IN(10) && I8_A) { PHASE_BEGIN(); phase_quant_rows((const bf16_t*)(ws + WS_XS), ws, lane, wave); }
            SEAM(10);
        }
    }
    if (IN(15)) { PHASE_BEGIN(); phase_route(ws, (const bf16_t*)(ws + WS_XS), lds, tid, lane, wave); }
    SEAM(15);
    if (IN(16)) { PHASE_BEGIN(); scan_counts(ws, texp, (LAS int*)lds, tid, lane, wave); phase_gather(ws, (const bf16_t*)(ws + WS_XS), texp, (const LAS int*)lds, lane, wave); }
    SEAM(16);
    for (int k = 0; k < 4; ++k) {
        if (IN(17 + k)) { PHASE_BEGIN();
            build_texp(ws, texp, tid);
            const int ntot = texp[169];
            const int kd = k - 1, ku = k;
            int ntd = 0, ntu = 0;
            if (kd >= 0) { ntd = ntot - MOE_CH * kd; const int cap = (kd == 2) ? MOE_CHL : MOE_CH; ntd = ntd < 0 ? 0 : (ntd > cap ? cap : ntd); }
            if (ku <= 2) { ntu = ntot - MOE_CH * ku; const int cap = (ku == 2) ? MOE_CHL : MOE_CH; ntu = ntu < 0 ? 0 : (ntu > cap ? cap : ntu); }
            const int nX = ntd * 4, nU = ntu * 28;
            const bool mixed = (nX > 0 && nU > 0);
            const int tf = (nU + DNW * nX) / 256, rem = (nU + DNW * nX) - 256 * tf;
            const bool weighted = mixed && tf >= DNW && nX <= 256 && G == 256;
            if (nX > 0) {
                const int t0 = MOE_CH * kd;
                pg8::Gemm g{(const bf16_t*)(ws + WS_HCH + (size_t)(kd & 1) * HCH_BYTES), (const bf16_t*)(ws + WS_WMOE2), ntd * 256, D, FFE / 2};
                pg8::Sched2 S; S.init2(ntd * 256, D, G, bx, rstab); S.texp = texp; S.estride = (size_t)7 * MiB; S.t0 = t0;
                if (weighted) { const int vc = (bx & 7) * 32 + (bx >> 3); S.rng = 1; S.rng_start = vc; S.rng_cnt = (vc < nX) ? 1 : 0; }
                pg8::EpiStoreF8 E{(bf16_t*)(ws + WS_Y) + (size_t)t0 * 256 * D, D, (const float*)(ws + WS_SW) + SW_W2, texp, t0};
                for (int rep_ = 0; rep_ < REP_DN; ++rep_) { GEMM_PHASE(pg8::EpiStoreF8, g, S, E); __syncthreads(); }
            }
            if (nU > 0) {
                size_t z3_ = 0; asm volatile("" : "+s"(z3_), "+s"(G), "+s"(bx)); ws = args.ws + z3_;
                const int t0 = MOE_CH * ku;
                pg8::Gemm g{(const bf16_t*)(ws + WS_XGY + (size_t)t0 * 256 * D), (const bf16_t*)(ws + WS_WMOE13), ntu * 256, 2 * FFE, D / 2};
                pg8::Sched2 S; S.init2(ntu * 256, 2 * FFE, G, bx, rstab); S.rsrc = (const float*)(ws + WS_XGRS); S.rmode = 2; S.rrow0 = t0 * 256; S.texp = texp; S.estride = (size_t)7 * MiB; S.t0 = t0;
                if (weighted) { const int vc = (bx & 7) * 32 + (bx >> 3); const int cmin = vc < nX ? vc : nX, over = vc - (256 - rem); S.rng = 1; S.rng_start = vc * tf - DNW * cmin + (over > 0 ? over : 0); S.rng_cnt = tf - (vc < nX ? DNW : 0) + (vc >= 256 - rem ? 1 : 0); }
                EpiSwigluF8 E{(bf16_t*)(ws + WS_HCH + (size_t)(ku & 1) * HCH_BYTES), FFE, rstab, (const float*)(ws + WS_SW) + SW_MOE, FFE, texp, t0};
                for (int rep_ = 0; rep_ < REP_UP; ++rep_) { GEMM_PHASE(EpiSwigluF8, g, S, E); __syncthreads(); }
            }
        }
        SEAM(17 + k);
    }
    if (IN(21)) { PHASE_BEGIN(); build_texp(ws, texp, tid); phase_combine(ws, (const bf16_t*)(ws + WS_XS), out, texp, lane, wave); }
#undef IN
#undef SEAM
}

extern "C" void kernel_launch(void* const* d_in, const int* in_sizes, int n_in, void* d_out, int out_size, void* d_ws, size_t ws_size, hipStream_t stream) {
    static int grid = 0;
    if (grid == 0) {
        if (n_in != 31 || out_size != T * D || ws_size < WS_END) { fprintf(stderr, "kernel_launch: unexpected problem (n_in %d, out %d, ws %zu < %zu)\n", n_in, out_size, ws_size, (size_t)WS_END); grid = -1; return; }
        int dev = 0, cus = 0, per_cu = 0;
        if (hipGetDevice(&dev) != hipSuccess || hipDeviceGetAttribute(&cus, hipDeviceAttributeMultiprocessorCount, dev) != hipSuccess) { grid = -1; return; }
        if (hipFuncSetAttribute((const void*)fwd_kernel, hipFuncAttributeMaxDynamicSharedMemorySize, LDS_BYTES) != hipSuccess) { fprintf(stderr, "kernel_launch: hipFuncSetAttribute failed\n"); grid = -1; return; }
        if (hipOccupancyMaxActiveBlocksPerMultiprocessor(&per_cu, (const void*)fwd_kernel, NTHR, LDS_BYTES) != hipSuccess || per_cu < 1) { fprintf(stderr, "kernel_launch: occupancy query says %d\n", per_cu); grid = -1; (void)hipGetLastError(); return; }
        grid = cus;
    }
    if (grid < 0) return;
    if (hipMemsetAsync(d_ws, 0, CTL_ZERO_BYTES, stream) != hipSuccess) return;
    Args a{};
    for (int i = 0; i < 31; ++i) a.in[i] = (const float*)d_in[i];
    a.out = (float*)d_out; a.ws = (unsigned char*)d_ws;
#ifndef PROBE_EXTRA_REPS
#define PROBE_EXTRA_REPS 1
#endif
#ifdef PROBE_EXTRA_PROLOGUE
    a.ph_lo = 0; a.ph_hi = 1; hipLaunchKernelGGL(fwd_kernel, dim3(grid), dim3(NTHR), LDS_BYTES, stream, a);
#endif
#ifdef PROBE_EXTRA_PHASE
    for (int r_ = 0; r_ < PROBE_EXTRA_REPS; ++r_) { a.ph_lo = PROBE_EXTRA_PHASE; a.ph_hi = PROBE_EXTRA_PHASE + 1; hipLaunchKernelGGL(fwd_kernel, dim3(grid), dim3(NTHR), LDS_BYTES, stream, a); }
#endif
    if (MK_N_LAUNCHES == 1) { a.ph_lo = 0; a.ph_hi = NPH; hipLaunchKernelGGL(fwd_kernel, dim3(grid), dim3(NTHR), LDS_BYTES, stream, a); }
    else for (int p = 0; p < NPH; ++p) { a.ph_lo = p; a.ph_hi = p + 1; hipLaunchKernelGGL(fwd_kernel, dim3(grid), dim3(NTHR), LDS_BYTES, stream, a); }
#ifdef PROBE_POST_PHASE
    for (int r_ = 0; r_ < PROBE_EXTRA_REPS; ++r_) { a.ph_lo = PROBE_POST_PHASE; a.ph_hi = PROBE_POST_PHASE + 1; hipLaunchKernelGGL(fwd_kernel, dim3(grid), dim3(NTHR), LDS_BYTES, stream, a); }
#endif
}
```

```cpp
#include <hip/hip_runtime.h>
#include <cstdio>
#include <cstdint>
#define MK_N_LAUNCHES 1
#ifndef USE_I8
#define USE_I8 1
#endif
#ifndef I8_A
#define I8_A 1
#endif
#ifndef I8_E
#define I8_E 1
#endif
#ifndef REP_MEM
#define REP_MEM 1
#endif
#ifndef REP_D
#define REP_D 1
#endif
#ifndef REP_F
#define REP_F 1
#endif
#ifndef REP_Z
#define REP_Z 1
#endif
#ifndef REP_E
#define REP_E 1
#endif
#ifndef REP_DN
#define REP_DN 1
#endif
#ifndef REP_MG
#define REP_MG 1
#endif
#ifndef REP_POOL
#define REP_POOL 1
#endif
#ifndef REP_GA
#define REP_GA 1
#endif
#ifndef REP_PRO
#define REP_PRO 1
#endif
#ifndef REP_A
#define REP_A 1
#endif
#ifndef REP_DA
#define REP_DA 1
#endif
#ifndef REP_C
#define REP_C 1
#endif
#ifndef REP_UP
#define REP_UP 1
#endif

constexpr int NWAVES = 8, NTHR = 512;
constexpr int T = 16384, D = 1024, SEQ = 2048, NBATCH = 8, MEML = 256;
constexpr int NGEMM1 = 7168, FFD = 2816, FFE = 3584, NEXP = 8;
constexpr float LOG2E = 1.4426950408889634f;
constexpr float QSCALE = 0.125f * LOG2E;
constexpr float MEMSCALE = 0.08838834764831845f * LOG2E;
#ifndef MK_N_LAUNCHES
#define MK_N_LAUNCHES 1
#endif
constexpr int NPH = 22;
constexpr int MOE_CH = 45, MOE_CHL = 46;

constexpr size_t MiB = 1u << 20;
constexpr size_t CTL_ZERO_BYTES = 1 * MiB;
constexpr size_t WS_SS = 1 * MiB;
constexpr size_t WS_MQSS = 2 * MiB;
constexpr size_t WS_SSM = 2 * MiB + 512 * 1024;
constexpr size_t WS_TOKE = WS_SSM + 128 * 1024;
constexpr size_t WS_TOKP = WS_TOKE + 128 * 1024;
constexpr size_t WS_TOKG = WS_TOKP + 128 * 1024;
constexpr size_t WS_TOKR = WS_TOKG + 128 * 1024;
constexpr size_t WS_SC = WS_TOKR + 64 * 1024;
constexpr size_t WS_XGRS = WS_SC + 4096;
constexpr size_t WS_PARAM = 3 * MiB + 256 * 1024;
constexpr int PB_BGATE = 0, PB_GQ = 6144, PB_GK = 6400, PB_GOUT = 6656, PB_POOLS = 6912, PB_MQN = 7936, PB_MKN = 8192, PB_GFFN1 = 8448, PB_WR = 9472, PB_POOLW = 17664, PB_END = 17664 + 131072;
constexpr size_t WS_W1T = 4 * MiB;
constexpr size_t WS_WMEMKV = 32 * MiB;
constexpr size_t WS_WBRDA = 36 * MiB;
constexpr size_t WS_WBRPOOL = 40 * MiB;
constexpr size_t WS_WBRMEM = 42 * MiB;
constexpr size_t WS_WOUT = 44 * MiB;
constexpr size_t WS_WFF13 = 48 * MiB;
constexpr size_t WS_WFF2 = 59 * MiB;
constexpr size_t WS_SW = WS_WFF13 + 6 * MiB;
constexpr int SW_G1 = 0, SW_FF = 2 * 7168, SW_MOE = SW_FF + 2 * 2816, SW_W2 = SW_MOE + 8 * 2 * 3584, SW_END = SW_W2 + 9 * 1024;
constexpr float H8_SCALE = 8.0f;
#ifndef DA_LOOP_ALIGN
#define DA_LOOP_ALIGN ".p2align 6"
#endif
#ifndef A_SKEW2
#define A_SKEW2 64
#endif
#ifndef SKEW_E
#define SKEW_E 0
#endif
#ifndef SKEW_M
#define SKEW_M 0
#endif
constexpr int DNW = 2;
constexpr size_t SW_BYTES = (size_t)SW_END * 4;
constexpr size_t WS_WMOE13 = 65 * MiB;
constexpr size_t WS_XS = WS_WMOE13 + 56 * MiB;
constexpr size_t WS_WMOE2 = 177 * MiB;
constexpr size_t WS_XB = 233 * MiB;
constexpr size_t WS_QX = WS_XB, WS_SA = 1 * MiB;
constexpr size_t WS_MEMKV = 265 * MiB;
constexpr size_t WS_R = 273 * MiB;
constexpr size_t WS_Q = WS_R, WS_K = WS_R + 32 * MiB, WS_V = WS_R + 64 * MiB, WS_P = WS_R + 96 * MiB, WS_MQ = WS_R + 112 * MiB, WS_OPOOL = WS_R + 128 * MiB, WS_G = WS_R + 144 * MiB, WS_MEMBF = WS_R + 240 * MiB, WS_POOLWT = WS_R + 244 * MiB;
constexpr size_t WS_MF = WS_K, WS_X1B = WS_K, WS_HFF = WS_R + 144 * MiB;
constexpr size_t WS_XGY = WS_MEMKV;
constexpr size_t WS_Y = WS_XGY + 34 * MiB;
constexpr size_t WS_HCH = WS_Y + 68 * MiB, HCH_BYTES = (size_t)MOE_CHL * 256 * 7168;
constexpr size_t WS_END = 529 * MiB;
static_assert(WS_XGRS + 34816 * 4 <= WS_PARAM && WS_PARAM + (size_t)PB_END * 4 <= WS_W1T && WS_HCH + 2 * HCH_BYTES <= WS_END && WS_SW + SW_BYTES <= WS_WFF2, "d_ws map");
constexpr int CW_CNT = 64;
constexpr int CW_WCNT = 1024;
constexpr int CW_BAR = 4096;

constexpr int RING_BYTES = 131072;
constexpr int RS_OFF = 131072, RS_UNITS = 16;
constexpr int TEXP_OFF = RS_OFF + RS_UNITS * 1024;
constexpr int LDS_BYTES = 155648;
constexpr int MISC_OFF = LDS_BYTES - 256;

namespace pg8 {
#define PG8_LAS __attribute__((address_space(3)))
typedef unsigned short bf16_t;
typedef short bf16x8 __attribute__((ext_vector_type(8)));
typedef float f32x4 __attribute__((ext_vector_type(4)));
typedef unsigned u32x4 __attribute__((ext_vector_type(4)));
constexpr int BM = 256, BK = 64, HALF = 128, HTB = HALF * BK * 2  , STAGE_BYTES = 8 * HTB, NXCD = 8, WGM = 8;

__host__ __device__ __forceinline__ int lds_byte(int r, int c) { const int st = (r >> 4) * 2 + (c >> 5), rr = r & 15, cc = c & 31, ob = rr * 64 + cc * 2; return st * 1024 + (ob ^ (((ob >> 9) & 1) << 5)); }
__host__ __device__ __forceinline__ void stage_rc(int b, int& R, int& C) { const int st = b / 1024, sb = b % 1024, swz = sb ^ (((sb >> 9) & 1) << 5); R = (st >> 1) * 16 + swz / 64; C = (st & 1) * 32 + (swz % 64) / 2; }
__host__ __device__ __forceinline__ int perm32(int rho) { const int n = rho >> 4, i = rho & 15; return 8 * (i >> 2) + 4 * n + (i & 3); }

struct Unit { int pm, pn, idx; };
struct Gemm { const bf16_t* A; const bf16_t* Bt; int M, N, K; };

struct StaticOrder {
    int nM, nN, nwg, G, c, wgm;
    __host__ __device__ void init(int M, int N, int G_, int c_) { nM = M / BM; nN = N / BM; nwg = nM * nN; G = G_; c = c_; wgm = WGM; }
    __host__ __device__ bool next(int i, Unit& u) const {
        const long L = (long)i * G + c; if (L >= nwg) return false;
        int wgid = (int)L; { const int q = nwg / NXCD, r = nwg % NXCD, xcd = wgid % NXCD, off = wgid / NXCD; wgid = (xcd < r ? xcd * (q + 1) : r * (q + 1) + (xcd - r) * q) + off; }
        const int nig = wgm * nN, gid = wgid / nig, fm = gid * wgm, gsz = (nM - fm) < wgm ? (nM - fm) : wgm;
        u.pm = fm + ((wgid % nig) % gsz); u.pn = (wgid % nig) / gsz; u.idx = i; return true;
    }
    __device__ __forceinline__ const char* bptr(const Gemm& g, const Unit& u, size_t tstep) const { return (const char*)g.Bt + (size_t)u.pn * tstep; }
    __device__ __forceinline__ const char* aptr(const Gemm& g, const Unit& u, size_t tstep) const { return (const char*)g.A + (size_t)u.pm * tstep; }
    __device__ __forceinline__ void a_ready(const Unit&) const {}
    __device__ __forceinline__ void done(const Unit&) const {}
};


typedef float f32x2 __attribute__((ext_vector_type(2)));
typedef __bf16 bf16x2_t __attribute__((ext_vector_type(2)));
__device__ __forceinline__ unsigned pk_bf16(float lo, float hi) { f32x2 v = {lo, hi}; bf16x2_t b = __builtin_convertvector(v, bf16x2_t); return __builtin_bit_cast(unsigned, b); }
__device__ __forceinline__ u32x4 pk8(const f32x4 a, const f32x4 b) { u32x4 w; w.x = pk_bf16(a[0], a[1]); w.y = pk_bf16(a[2], a[3]); w.z = pk_bf16(b[0], b[1]); w.w = pk_bf16(b[2], b[3]); return w; }
__device__ __forceinline__ float bf_lo(unsigned w) { return __builtin_bit_cast(float, w << 16); }
__device__ __forceinline__ float bf_hi(unsigned w) { return __builtin_bit_cast(float, w & 0xffff0000u); }
__device__ __forceinline__ float sigmoid_f(float x) { return __builtin_amdgcn_rcpf(1.0f + __builtin_amdgcn_exp2f(-1.4426950408889634f * x)); }
typedef int i32x8 __attribute__((ext_vector_type(8)));
typedef int i32x4 __attribute__((ext_vector_type(4)));
__device__ __forceinline__ f32x4 mma_f8(const i32x8 a, const i32x8 b, f32x4 c) { const int one = 0x7f7f7f7f; asm volatile("v_mfma_scale_f32_16x16x128_f8f6f4 %0, %1, %2, %0, %3, %3 op_sel_hi:[0,0,0]" : "+v"(c) : "v"(a), "v"(b), "v"(one)); return c; }
__device__ __forceinline__ unsigned pk_fp8x4(float a, float b, float c, float d) { int w = __builtin_amdgcn_cvt_pk_fp8_f32(a, b, 0, false); w = __builtin_amdgcn_cvt_pk_fp8_f32(c, d, w, true); return (unsigned)w; }
constexpr float RMS_EPS = 1e-6f;
typedef int i32x4 __attribute__((ext_vector_type(4)));
template <bool I8> __device__ __forceinline__ f32x4 mma16(const bf16x8 a, const bf16x8 b, const f32x4 c) {
    if constexpr (I8) return __builtin_bit_cast(f32x4, __builtin_amdgcn_mfma_i32_16x16x64_i8(__builtin_bit_cast(i32x4, a), __builtin_bit_cast(i32x4, b), __builtin_bit_cast(i32x4, c), 0, 0, 0));
    else return __builtin_amdgcn_mfma_f32_16x16x32_bf16(a, b, c, 0, 0, 0);
}
template <bool I8> __device__ __forceinline__ f32x4 accf(const f32x4 a) {
    if constexpr (I8) { const i32x4 v = __builtin_bit_cast(i32x4, a); return (f32x4){(float)v[0], (float)v[1], (float)v[2], (float)v[3]}; } else return a;
}


struct Sched2 : StaticOrder {
    const float* rsrc; int rmode;
    int rrow0;
    PG8_LAS float* rtab;
    const PG8_LAS int* texp; size_t estride; int t0;
    int rng, rng_start, rng_cnt;
    const bf16_t* A2; const bf16_t* B2; int chain;
    int skip;
    __device__ __forceinline__ void init2(int M, int N, int G_, int c_, PG8_LAS float* tab) { init(M, N, G_, c_); skip = 0; rsrc = nullptr; rmode = 0; rrow0 = 0; rtab = tab; texp = nullptr; estride = 0; t0 = 0; A2 = nullptr; B2 = nullptr; chain = 0; rng = 0; rng_start = 0; rng_cnt = 0; }
    __device__ __forceinline__ bool next(int i, Unit& u) const {
        if (rng != 0) { if (i >= rng_cnt) return false; const int q = rng_start + i; u.pm = q / nN; u.pn = q - u.pm * nN; u.idx = i; return true; }
        if (chain == 0) return StaticOrder::next(i, u); if (i >= chain || !StaticOrder::next(0, u)) return false; u.idx = i; return true; }
    __device__ __forceinline__ const char* aptr(const Gemm& g, const Unit& u, size_t tstep) const { return (const char*)((chain != 0 && u.idx == 1) ? A2 : g.A) + (size_t)u.pm * tstep; }
    __device__ __forceinline__ const char* bptr(const Gemm& g, const Unit& u, size_t tstep) const {
        const char* b = (const char*)((chain != 0 && u.idx == 1) ? B2 : g.Bt) + (size_t)u.pn * tstep;
        if (texp) b += (size_t)texp[t0 + u.pm] * estride;
        return b;
    }
    __device__ __forceinline__ void a_ready(const Unit&) const {}
    __device__ __forceinline__ void prep() const {
        if (rmode == 0) return;
        int tid = threadIdx.x; asm volatile("" : "+v"(tid));
        if (tid < 256) {
            Unit u;
#pragma unroll 1
            for (int i = 0; i < 16 && next(i, u); ++i) {
                const size_t row = (size_t)rrow0 + (size_t)u.pm * 256 + tid; float sc;
                if (rmode == 1) { const f32x4* p = (const f32x4*)(rsrc + row * 16); const f32x4 a = p[0], b = p[1], c = p[2], d = p[3];
                    const float s = ((a[0] + a[1]) + (a[2] + a[3])) + ((b[0] + b[1]) + (b[2] + b[3])) + ((c[0] + c[1]) + (c[2] + c[3])) + ((d[0] + d[1]) + (d[2] + d[3]));
                    sc = __builtin_amdgcn_rsqf(s * (1.0f / 1024.0f) + RMS_EPS); }
                else sc = rsrc[row];
                rtab[i * 256 + tid] = sc;
            }
        }
    }
    __device__ __forceinline__ void done(const Unit&) const {}
};

template <bool RS> struct EpiStore {
    static constexpr bool PERM = false, AFTER_DRAIN = false, I8 = false, F8 = false;
    bf16_t* O; int ldc; const PG8_LAS float* rs;
    __device__ __forceinline__ void operator()(const f32x4 (&acc)[2][2][4][2], const Unit& u, int wr, int wc, int fr, int fq) const {
        const int rl = wr * 64 + fr; const size_t row0 = (size_t)u.pm * BM + rl; const int col0 = u.pn * BM + 64 * wc + 8 * fq;
#pragma unroll
        for (int ai = 0; ai < 2; ++ai)
#pragma unroll
            for (int m = 0; m < 4; ++m) { const float sc = RS ? rs[u.idx * 256 + rl + ai * HALF + m * 16] : 1.f; bf16_t* rowp = O + (row0 + ai * HALF + m * 16) * ldc + col0;
#pragma unroll
                for (int bj = 0; bj < 2; ++bj) *(u32x4*)(rowp + 32 * bj) = pk8(acc[ai][bj][m][0] * sc, acc[ai][bj][m][1] * sc); }
    }
};

template <bool I8_> struct EpiA {
    static constexpr bool PERM = false, AFTER_DRAIN = false, I8 = I8_, F8 = false;
    unsigned char* ws; int l; const PG8_LAS float* rs;
    __device__ __forceinline__ void operator()(const f32x4 (&acc)[2][2][4][2], const Unit& u, int wr, int wc, int fr, int fq) const {
        const int pn = u.pn, rl = wr * 64 + fr; const size_t row0 = (size_t)u.pm * BM + rl; const PG8_LAS float* rsp = rs + u.idx * 256 + rl;
        const float* prm = (const float*)(ws + WS_PARAM);
        f32x4 cw[2][2];
#pragma unroll
        for (int bj = 0; bj < 2; ++bj)
#pragma unroll
            for (int n = 0; n < 2; ++n) { if constexpr (I8_) cw[bj][n] = *(const f32x4*)((const float*)(ws + WS_SW) + SW_G1 + l * 7168 + pn * 256 + 64 * wc + 32 * bj + 8 * fq + 4 * n) * (1.0f / 127.0f); else cw[bj][n] = (f32x4){1.f, 1.f, 1.f, 1.f}; }
#define EA_V(ai, bj, m, n) (accf<I8_>(acc[ai][bj][m][n]) * cw[bj][n])
        if (pn < 8) {
            const bool isq = pn < 4; const float* gg = prm + (isq ? PB_GQ : PB_GK) + l * 128 + (wc & 1) * 64 + 8 * fq; const float mul = isq ? QSCALE : 1.f;
            f32x4 gv[2][2];
#pragma unroll
            for (int bj = 0; bj < 2; ++bj)
#pragma unroll
                for (int n = 0; n < 2; ++n) gv[bj][n] = *(const f32x4*)(gg + 32 * bj + 4 * n);
            bf16_t* base = (bf16_t*)(ws + (isq ? WS_Q : WS_K)) + (pn & 3) * 256 + 64 * wc + 8 * fq;
#pragma unroll
            for (int ai = 0; ai < 2; ++ai)
#pragma unroll
                for (int m = 0; m < 4; ++m) { const float sc = rsp[ai * HALF + m * 16];
                    f32x4 v[2][2]; float ss = 0.f;
#pragma unroll
                    for (int bj = 0; bj < 2; ++bj)
#pragma unroll
                        for (int n = 0; n < 2; ++n) { v[bj][n] = EA_V(ai, bj, m, n) * sc; const f32x4 x = v[bj][n]; ss += (x[0] * x[0] + x[1] * x[1]) + (x[2] * x[2] + x[3] * x[3]); }
                    ss += __shfl_xor(ss, 16); ss += __shfl_xor(ss, 32);
                    const float r = __builtin_amdgcn_rsqf(ss * (1.0f / 64.0f) + RMS_EPS) * mul;
                    bf16_t* rowp = base + (row0 + ai * HALF + m * 16) * 1024;
#pragma unroll
                    for (int bj = 0; bj < 2; ++bj) *(u32x4*)(rowp + 32 * bj) = pk8(v[bj][0] * gv[bj][0] * r, v[bj][1] * gv[bj][1] * r); }
        } else if (pn < 14) {
            bf16_t* base; int ldc;
            if (pn < 12) { base = (bf16_t*)(ws + WS_V) + (pn - 8) * 256; ldc = 1024; } else { base = (bf16_t*)(ws + WS_P) + (pn - 12) * 256; ldc = 512; }
            base += 64 * wc + 8 * fq;
#pragma unroll
            for (int ai = 0; ai < 2; ++ai)
#pragma unroll
                for (int m = 0; m < 4; ++m) { const float sc = rsp[ai * HALF + m * 16]; bf16_t* rowp = base + (row0 + ai * HALF + m * 16) * ldc;
#pragma unroll
                    for (int bj = 0; bj < 2; ++bj) *(u32x4*)(rowp + 32 * bj) = pk8(EA_V(ai, bj, m, 0) * sc, EA_V(ai, bj, m, 1) * sc); }
        } else if (pn < 16) {
            bf16_t* base = (bf16_t*)(ws + WS_MQ) + (pn - 14) * 256 + 64 * wc + 8 * fq; float* mqss = (float*)(ws + WS_MQSS);
#pragma unroll
            for (int ai = 0; ai < 2; ++ai)
#pragma unroll
                for (int m = 0; m < 4; ++m) { const float sc = rsp[ai * HALF + m * 16]; const size_t row = row0 + ai * HALF + m * 16; bf16_t* rowp = base + row * 512; float ss = 0.f;
#pragma unroll
                    for (int bj = 0; bj < 2; ++bj) { const f32x4 a = EA_V(ai, bj, m, 0) * sc, b = EA_V(ai, bj, m, 1) * sc;
                        ss += ((a[0] * a[0] + a[1] * a[1]) + (a[2] * a[2] + a[3] * a[3])) + ((b[0] * b[0] + b[1] * b[1]) + (b[2] * b[2] + b[3] * b[3]));
                        *(u32x4*)(rowp + 32 * bj) = pk8(a, b); }
                    ss += __shfl_xor(ss, 16); ss += __shfl_xor(ss, 32);
                    if (fq == 0) mqss[row * 8 + (pn - 14) * 4 + wc] = ss; }
        } else {
            const int gcol = (pn - 16) * 256 + 64 * wc + 8 * fq; unsigned char* base = (unsigned char*)(ws + WS_G) + gcol; const float* bgate = prm + PB_BGATE + l * 3072 + gcol;
            f32x4 bv[2][2], cl[2][2];
#pragma unroll
            for (int bj = 0; bj < 2; ++bj)
#pragma unroll
                for (int n = 0; n < 2; ++n) { bv[bj][n] = *(const f32x4*)(bgate + 32 * bj + 4 * n) * (-1.4426950408889634f); cl[bj][n] = cw[bj][n] * (-1.4426950408889634f); }
#pragma unroll
            for (int ai = 0; ai < 2; ++ai)
#pragma unroll
                for (int m = 0; m < 4; ++m) { const float sc = rsp[ai * HALF + m * 16]; unsigned char* rowp = base + (row0 + ai * HALF + m * 16) * 3072;
#pragma unroll
                    for (int bj = 0; bj < 2; ++bj) { unsigned w[2];
#pragma unroll
                        for (int n = 0; n < 2; ++n) { const f32x4 u = accf<I8_>(acc[ai][bj][m][n]) * cl[bj][n] * sc + bv[bj][n]; unsigned pk = 0u;
#pragma unroll
                            for (int j = 0; j < 4; ++j) { const float s255 = __builtin_amdgcn_rcpf(__builtin_fmaf(__builtin_amdgcn_exp2f(u[j]), 1.0f / 255.0f, 1.0f / 255.0f)); pk = __builtin_amdgcn_cvt_pk_u8_f32(s255, j, pk); }
                            w[n] = pk; }
                        *(unsigned long long*)(rowp + 32 * bj) = (unsigned long long)w[0] | ((unsigned long long)w[1] << 32); } }
        }
    }
};
#undef EA_V

struct EpiBr0 {
    static constexpr bool PERM = false, AFTER_DRAIN = false, I8 = false, F8 = false;
    unsigned char* ws;
    __device__ __forceinline__ void operator()(const f32x4 (&acc)[2][2][4][2], const Unit& u, int wr, int wc, int fr, int fq) const {
        const size_t row0 = (size_t)u.pm * BM + wr * 64 + fr; const int col0 = u.pn * BM + 64 * wc + 8 * fq;
        const unsigned char* G = (const unsigned char*)(ws + WS_G); bf16_t* MFb = (bf16_t*)(ws + WS_MF);
#pragma unroll
        for (int ai = 0; ai < 2; ++ai) { unsigned long long gw[4][2];
#pragma unroll
            for (int m = 0; m < 4; ++m)
#pragma unroll
                for (int bj = 0; bj < 2; ++bj) gw[m][bj] = *(const unsigned long long*)(G + (row0 + ai * HALF + m * 16) * 3072 + col0 + 32 * bj);
#pragma unroll
            for (int m = 0; m < 4; ++m) { const size_t row = row0 + ai * HALF + m * 16;
#pragma unroll
                for (int bj = 0; bj < 2; ++bj) { const int col = col0 + 32 * bj;
                    const unsigned glo = (unsigned)gw[m][bj], ghi = (unsigned)(gw[m][bj] >> 32);
                    const f32x4 g0 = (f32x4){(float)(glo & 255u), (float)((glo >> 8) & 255u), (float)((glo >> 16) & 255u), (float)(glo >> 24)} * (1.0f / 255.0f), g1 = (f32x4){(float)(ghi & 255u), (float)((ghi >> 8) & 255u), (float)((ghi >> 16) & 255u), (float)(ghi >> 24)} * (1.0f / 255.0f);
                    *(u32x4*)(MFb + row * 1024 + col) = pk8(acc[ai][bj][m][0] * g0, acc[ai][bj][m][1] * g1); } } }
    }
};
struct EpiBrC {
    static constexpr bool PERM = false, AFTER_DRAIN = false, I8 = false, F8 = false;
    unsigned char* ws;
    __device__ __forceinline__ void operator()(const f32x4 (&acc)[2][2][4][2], const Unit& u, int wr, int wc, int fr, int fq) const {
        const size_t row0 = (size_t)u.pm * BM + wr * 64 + fr; const int col0 = u.pn * BM + 64 * wc + 8 * fq;
        const unsigned char* G = (const unsigned char*)(ws + WS_G) + (1 + u.idx) * 1024; const bf16_t* MFb = (const bf16_t*)(ws + WS_MF); bf16_t* O = (bf16_t*)(ws + (u.idx == 0 ? WS_MF : WS_Q));
#pragma unroll
        for (int ai = 0; ai < 2; ++ai) { unsigned long long gw[4][2]; u32x4 mw[4][2];
#pragma unroll
            for (int m = 0; m < 4; ++m)
#pragma unroll
                for (int bj = 0; bj < 2; ++bj) { const size_t row = row0 + ai * HALF + m * 16; const int col = col0 + 32 * bj;
                    gw[m][bj] = *(const unsigned long long*)(G + row * 3072 + col); mw[m][bj] = *(const u32x4*)(MFb + row * 1024 + col); }
#pragma unroll
            for (int m = 0; m < 4; ++m) { const size_t row = row0 + ai * HALF + m * 16;
#pragma unroll
                for (int bj = 0; bj < 2; ++bj) { const int col = col0 + 32 * bj;
                    const unsigned glo = (unsigned)gw[m][bj], ghi = (unsigned)(gw[m][bj] >> 32); const u32x4 w = mw[m][bj];
                    const f32x4 g0 = (f32x4){(float)(glo & 255u), (float)((glo >> 8) & 255u), (float)((glo >> 16) & 255u), (float)(glo >> 24)} * (1.0f / 255.0f), g1 = (f32x4){(float)(ghi & 255u), (float)((ghi >> 8) & 255u), (float)((ghi >> 16) & 255u), (float)(ghi >> 24)} * (1.0f / 255.0f);
                    const f32x4 m0 = {bf_lo(w.x), bf_hi(w.x), bf_lo(w.y), bf_hi(w.y)}, m1 = {bf_lo(w.z), bf_hi(w.z), bf_lo(w.w), bf_hi(w.w)};
                    *(u32x4*)(O + row * 1024 + col) = pk8(acc[ai][bj][m][0] * g0 + m0, acc[ai][bj][m][1] * g1 + m1); } } }
    }
};

struct EpiRes {
    static constexpr bool PERM = false, AFTER_DRAIN = false, I8 = false, F8 = false;
    const float* xin; float* x; unsigned char* ws; size_t xb_off; size_t dry_off;
    __device__ __forceinline__ void operator()(const f32x4 (&acc)[2][2][4][2], const Unit& u, int wr, int wc, int fr, int fq) const {
        const size_t row0 = (size_t)u.pm * BM + wr * 64 + fr; const int col0 = u.pn * BM + 64 * wc + 8 * fq;
        float* xout = dry_off ? (float*)(ws + dry_off) : x; bf16_t* xb = (bf16_t*)(ws + xb_off); float* ss = (float*)(ws + WS_SS);
#pragma unroll
        for (int ai = 0; ai < 2; ++ai)
#pragma unroll
            for (int m = 0; m < 4; ++m) { const size_t row = row0 + ai * HALF + m * 16; float s2 = 0.f;
#pragma unroll
                for (int bj = 0; bj < 2; ++bj) { const size_t off = row * 1024 + col0 + 32 * bj;
                    const f32x4 a = *(const f32x4*)(xin + off) + acc[ai][bj][m][0], b = *(const f32x4*)(xin + off + 4) + acc[ai][bj][m][1];
                    *(f32x4*)(xout + off) = a; *(f32x4*)(xout + off + 4) = b;
                    if (xb_off) { *(u32x4*)(xb + off) = pk8(a, b); s2 += ((a[0] * a[0] + a[1] * a[1]) + (a[2] * a[2] + a[3] * a[3])) + ((b[0] * b[0] + b[1] * b[1]) + (b[2] * b[2] + b[3] * b[3])); } }
                if (xb_off) { s2 += __shfl_xor(s2, 16); s2 += __shfl_xor(s2, 32); if (fq == 0) ss[row * 16 + u.pn * 4 + wc] = s2; } }
    }
};

struct EpiResB {
    static constexpr bool PERM = false, AFTER_DRAIN = false, I8 = false, F8 = false;
    const float* xf; bf16_t* xs;
    __device__ __forceinline__ void operator()(const f32x4 (&acc)[2][2][4][2], const Unit& u, int wr, int wc, int fr, int fq) const {
        const size_t row0 = (size_t)u.pm * BM + wr * 64 + fr; const int col0 = u.pn * BM + 64 * wc + 8 * fq;
#pragma unroll
        for (int ai = 0; ai < 2; ++ai)
#pragma unroll
            for (int m = 0; m < 4; ++m) { const size_t row = row0 + ai * HALF + m * 16;
#pragma unroll
                for (int bj = 0; bj < 2; ++bj) { const size_t off = row * 1024 + col0 + 32 * bj; f32x4 a, b;
                    if (xf) { a = *(const f32x4*)(xf + off); b = *(const f32x4*)(xf + off + 4); }
                    else { const u32x4 w = *(const u32x4*)(xs + off); a = (f32x4){bf_lo(w.x), bf_hi(w.x), bf_lo(w.y), bf_hi(w.y)}; b = (f32x4){bf_lo(w.z), bf_hi(w.z), bf_lo(w.w), bf_hi(w.w)}; }
                    *(u32x4*)(xs + off) = pk8(a + acc[ai][bj][m][0], b + acc[ai][bj][m][1]); } }
    }
};

template <bool I8_, bool OUT8 = false> struct EpiSwiglu {
    static constexpr bool PERM = false, AFTER_DRAIN = false, I8 = I8_, F8 = false;
    bf16_t* H; int ldc; const PG8_LAS float* rs; const float* cmax; int nh;
    const PG8_LAS int* texp; int t0;
    __device__ __forceinline__ void operator()(const f32x4 (&acc)[2][2][4][2], const Unit& u, int wr, int wc, int fr, int fq) const {
        const int rl = wr * 64 + fr; const size_t row0 = (size_t)u.pm * BM + rl; const int col0 = u.pn * 128 + 32 * wc + 8 * fq;
        f32x4 c1[2], c3[2];
#pragma unroll
        for (int bj = 0; bj < 2; ++bj) { if constexpr (I8_) { const float* cm = cmax + (texp ? (size_t)texp[t0 + u.pm] * 2 * nh : 0) + col0 + 4 * bj; c1[bj] = *(const f32x4*)cm * (1.0f / 127.0f); c3[bj] = *(const f32x4*)(cm + nh) * (OUT8 ? H8_SCALE / 127.0f : 1.0f / 127.0f); } else { c1[bj] = (f32x4){1.f, 1.f, 1.f, 1.f}; c3[bj] = c1[bj]; } }
#pragma unroll
        for (int ai = 0; ai < 2; ++ai)
#pragma unroll
            for (int m = 0; m < 4; ++m) { const float sc = rs[u.idx * 256 + rl + ai * HALF + m * 16]; f32x4 h[2];
#pragma unroll
                for (int bj = 0; bj < 2; ++bj) { const f32x4 a = accf<I8_>(acc[ai][bj][m][0]) * c1[bj] * sc, b = accf<I8_>(acc[ai][bj][m][1]) * c3[bj] * sc;
#pragma unroll
                    for (int j = 0; j < 4; ++j) h[bj][j] = a[j] * sigmoid_f(a[j]) * b[j]; }
                if constexpr (OUT8) {
#pragma unroll
                    for (int bj = 0; bj < 2; ++bj)
#pragma unroll
                        for (int j = 0; j < 4; ++j) h[bj][j] = __builtin_fminf(__builtin_fmaxf(h[bj][j], -448.0f), 448.0f);
                    const unsigned w0 = pk_fp8x4(h[0][0], h[0][1], h[0][2], h[0][3]), w1 = pk_fp8x4(h[1][0], h[1][1], h[1][2], h[1][3]);
                    *(unsigned long long*)((unsigned char*)H + (row0 + ai * HALF + m * 16) * ldc + col0) = (unsigned long long)w0 | ((unsigned long long)w1 << 32);
                } else *(u32x4*)(H + (row0 + ai * HALF + m * 16) * ldc + col0) = pk8(h[0], h[1]); }
    }
};

struct EpiStoreF8 {
    static constexpr bool PERM = false, AFTER_DRAIN = false, I8 = false, F8 = true;
    bf16_t* O; int ldc; const float* cs; const PG8_LAS int* texp; int t0;
    __device__ __forceinline__ void operator()(const f32x4 (&acc)[2][2][4][2], const Unit& u, int wr, int wc, int fr, int fq) const {
        const int rl = wr * 64 + fr; const size_t row0 = (size_t)u.pm * BM + rl; const int col0 = u.pn * BM + 64 * wc + 8 * fq;
        const float* c = cs + (texp ? (size_t)texp[t0 + u.pm] * 1024 : 0) + col0; f32x4 cw[2][2];
#pragma unroll
        for (int bj = 0; bj < 2; ++bj)
#pragma unroll
            for (int n = 0; n < 2; ++n) cw[bj][n] = *(const f32x4*)(c + 32 * bj + 4 * n);
#pragma unroll
        for (int ai = 0; ai < 2; ++ai)
#pragma unroll
            for (int m = 0; m < 4; ++m) { bf16_t* rowp = O + (row0 + ai * HALF + m * 16) * ldc + col0;
#pragma unroll
                for (int bj = 0; bj < 2; ++bj) *(u32x4*)(rowp + 32 * bj) = pk8(acc[ai][bj][m][0] * cw[bj][0], acc[ai][bj][m][1] * cw[bj][1]); }
    }
};
struct EpiResB8 {
    static constexpr bool PERM = false, AFTER_DRAIN = false, I8 = false, F8 = true;
    bf16_t* xs; const float* cs;
    __device__ __forceinline__ void operator()(const f32x4 (&acc)[2][2][4][2], const Unit& u, int wr, int wc, int fr, int fq) const {
        const size_t row0 = (size_t)u.pm * BM + wr * 64 + fr; const int col0 = u.pn * BM + 64 * wc + 8 * fq; f32x4 cw[2][2];
#pragma unroll
        for (int bj = 0; bj < 2; ++bj)
#pragma unroll
            for (int n = 0; n < 2; ++n) cw[bj][n] = *(const f32x4*)(cs + col0 + 32 * bj + 4 * n);
#pragma unroll
        for (int ai = 0; ai < 2; ++ai)
#pragma unroll
            for (int m = 0; m < 4; ++m) { const size_t row = row0 + ai * HALF + m * 16;
#pragma unroll
                for (int bj = 0; bj < 2; ++bj) { const size_t off = row * 1024 + col0 + 32 * bj; const u32x4 w = *(const u32x4*)(xs + off);
                    const f32x4 a = {bf_lo(w.x), bf_hi(w.x), bf_lo(w.y), bf_hi(w.y)}, b = {bf_lo(w.z), bf_hi(w.z), bf_lo(w.w), bf_hi(w.w)};
                    *(u32x4*)(xs + off) = pk8(a + acc[ai][bj][m][0] * cw[bj][0], b + acc[ai][bj][m][1] * cw[bj][1]); } }
    }
};
template <class Epi, class Sched, bool ALIGN_EPI = false, bool SP2 = false>
__device__ __forceinline__ void gemm_phase(PG8_LAS unsigned char* lds, const Gemm g, const Sched& S, const Epi& E) {
    int tid_ = threadIdx.x; asm volatile("" : "+v"(tid_));
    const int tid = tid_, wid = __builtin_amdgcn_readfirstlane(tid >> 6), lane = tid & 63, wr = wid >> 2, wc = wid & 3, fr = lane & 15, fq = lane >> 4;
    const int K = g.K, nt = K / BK;
    unsigned voffA[2], voffB[2];
#pragma unroll
    for (int i = 0; i < 2; ++i) { int R, C; stage_rc(tid * 16 + i * 8192, R, C); const int Rb = Epi::PERM ? ((R & ~31) + perm32(R & 31)) : R;
        voffA[i] = (unsigned)(R * K + C) * 2u; voffB[i] = (unsigned)(Rb * K + C) * 2u; }
    const size_t kstep = (size_t)(BK * 2);
    const size_t hstep = (size_t)HALF * K * 2;
    const size_t tstep = 2 * hstep;
    const unsigned ldsw = (unsigned)wid * 1024u;
    const int aoff = lds_byte(wr * 64 + fr, fq * 8), boff = lds_byte(wc * 32 + fr, fq * 8);
#define PG8_SA(b, h) (((b) * 2 + (h)) * HTB)
#define PG8_SB(b, h) ((4 + (b) * 2 + (h)) * HTB)
#define PG8_STAGE(bufoff, gbase, voff) do { _Pragma("unroll") for (int _i = 0; _i < 2; ++_i) \
        __builtin_amdgcn_global_load_lds((const unsigned*)((const char*)(gbase) + (voff)[_i]), (PG8_LAS unsigned*)(lds + (bufoff) + ldsw + _i * 8192), 16, 0, 0); } while (0)
#define PG8_LDA(dst, b, h) do { if constexpr (Epi::F8) { _Pragma("unroll") for (int m = 0; m < 4; ++m) { const i32x4 lo_ = *(const PG8_LAS i32x4*)(lds + PG8_SA(b, h) + aoff + m * 2048), hi_ = *(const PG8_LAS i32x4*)(lds + PG8_SA(b, h) + aoff + m * 2048 + 1024); dst##8[m] = __builtin_shufflevector(lo_, hi_, 0, 1, 2, 3, 4, 5, 6, 7); } } \
        else { _Pragma("unroll") for (int m = 0; m < 4; ++m) _Pragma("unroll") for (int k = 0; k < 2; ++k) dst[m][k] = *(const PG8_LAS bf16x8*)(lds + PG8_SA(b, h) + aoff + m * 2048 + k * 1024); } } while (0)
#define PG8_LDB(dst, b, h) do { if constexpr (Epi::F8) { _Pragma("unroll") for (int n = 0; n < 2; ++n) { const i32x4 lo_ = *(const PG8_LAS i32x4*)(lds + PG8_SB(b, h) + boff + n * 2048), hi_ = *(const PG8_LAS i32x4*)(lds + PG8_SB(b, h) + boff + n * 2048 + 1024); dst##8[n] = __builtin_shufflevector(lo_, hi_, 0, 1, 2, 3, 4, 5, 6, 7); } } \
        else { _Pragma("unroll") for (int n = 0; n < 2; ++n) _Pragma("unroll") for (int k = 0; k < 2; ++k) dst[n][k] = *(const PG8_LAS bf16x8*)(lds + PG8_SB(b, h) + boff + n * 2048 + k * 1024); } } while (0)
#define PG8_MMA(ai, bj, At, Bt) do { __builtin_amdgcn_s_setprio(1); if constexpr (Epi::F8) { _Pragma("unroll") for (int m = 0; m < 4; ++m) _Pragma("unroll") for (int n = 0; n < 2; ++n) acc[ai][bj][m][n] = mma_f8(Bt##8[n], At##8[m], acc[ai][bj][m][n]); } \
        else { _Pragma("unroll") for (int m = 0; m < 4; ++m) _Pragma("unroll") for (int n = 0; n < 2; ++n) _Pragma("unroll") for (int k = 0; k < 2; ++k) acc[ai][bj][m][n] = mma16<Epi::I8>(Bt[n][k], At[m][k], acc[ai][bj][m][n]); } __builtin_amdgcn_s_setprio(0); } while (0)
#define PG8_WAIT_V(n) asm volatile("s_waitcnt vmcnt(" #n ")" ::: "memory")
#define PG8_WAIT_L(n) asm volatile("s_waitcnt lgkmcnt(" #n ")" ::: "memory")
#define PG8_BAR __builtin_amdgcn_s_barrier()
#define PG8_SCHED __builtin_amdgcn_sched_barrier(0)
    Unit cur, nxt; int ui = 0;
    if (!S.next(0, cur)) return;
    f32x4 acc[2][2][4][2];
#pragma unroll
    for (int a = 0; a < 2; ++a)
#pragma unroll
        for (int b = 0; b < 2; ++b)
#pragma unroll
            for (int m = 0; m < 4; ++m)
#pragma unroll
                for (int n = 0; n < 2; ++n) acc[a][b][m][n] = (f32x4){0.f, 0.f, 0.f, 0.f};
    bf16x8 At[4][2], B0[2][2], B1[2][2];
    i32x8 At8[4], B08[2], B18[2];
    const char* cA = S.aptr(g, cur, tstep); const char* cB = S.bptr(g, cur, tstep);
    S.a_ready(cur);
    if constexpr (SP2) {
        PG8_STAGE(PG8_SB(0, 0), cB, voffB); PG8_STAGE(PG8_SB(0, 1), cB + hstep, voffB); PG8_STAGE(PG8_SA(0, 0), cA, voffA); PG8_STAGE(PG8_SA(0, 1), cA + hstep, voffA);
        if (wr == 1) PG8_BAR;
        PG8_WAIT_V(2); PG8_BAR;
        PG8_STAGE(PG8_SB(1, 0), cB + kstep, voffB); PG8_STAGE(PG8_SA(1, 0), cA + kstep, voffA); PG8_STAGE(PG8_SB(1, 1), cB + hstep + kstep, voffB);
        PG8_WAIT_V(6); PG8_BAR;
    } else {
        PG8_STAGE(PG8_SB(0, 0), cB, voffB); PG8_STAGE(PG8_SA(0, 0), cA, voffA); PG8_STAGE(PG8_SB(0, 1), cB + hstep, voffB); PG8_STAGE(PG8_SA(0, 1), cA + hstep, voffA);
        if (wr == 1) PG8_BAR;
        PG8_WAIT_V(4); PG8_BAR;
        PG8_STAGE(PG8_SB(1, 0), cB + kstep, voffB); PG8_STAGE(PG8_SA(1, 0), cA + kstep, voffA); PG8_STAGE(PG8_SB(1, 1), cB + hstep + kstep, voffB);
        PG8_WAIT_V(6); PG8_BAR;
    }
    for (;;) {
        const bool has_next = S.next(ui + 1, nxt);
        const char* nA = has_next ? S.aptr(g, nxt, tstep) : cA; const char* nB = has_next ? S.bptr(g, nxt, tstep) : cB;
        for (int t = 0; t < nt; t += 2) {
            const bool last = (t == nt - 2);
            const char* a1 = cA + (size_t)(t + 1) * kstep;
            const char* a2 = last ? nA : cA + (size_t)(t + 2) * kstep; const char* b2 = last ? nB : cB + (size_t)(t + 2) * kstep;
            const char* a3 = a2 + kstep; const char* b3 = b2 + kstep;
            if (last && has_next) S.a_ready(nxt);
            if constexpr (SP2) {
            PG8_LDB(B0, 0, 0); PG8_LDB(B1, 0, 1); PG8_SCHED; PG8_LDA(At, 0, 0); PG8_STAGE(PG8_SA(1, 1), a1 + hstep, voffA);
            PG8_WAIT_V(8); PG8_WAIT_L(0); PG8_BAR; PG8_MMA(0, 0, At, B0); PG8_MMA(0, 1, At, B1); PG8_BAR; PG8_SCHED;
            PG8_LDA(At, 0, 1); PG8_STAGE(PG8_SB(0, 0), b2, voffB); PG8_STAGE(PG8_SB(0, 1), b2 + hstep, voffB); PG8_STAGE(PG8_SA(0, 0), a2, voffA);
            PG8_WAIT_V(8); PG8_WAIT_L(0); PG8_BAR; PG8_MMA(1, 0, At, B0); PG8_MMA(1, 1, At, B1); PG8_BAR; PG8_SCHED;
            PG8_LDB(B0, 1, 0); PG8_LDB(B1, 1, 1); PG8_SCHED; PG8_LDA(At, 1, 0); PG8_STAGE(PG8_SA(0, 1), a2 + hstep, voffA);
            PG8_WAIT_V(8); PG8_WAIT_L(0); PG8_BAR; PG8_MMA(0, 0, At, B0); PG8_MMA(0, 1, At, B1); PG8_BAR; PG8_SCHED;
            PG8_LDA(At, 1, 1); PG8_STAGE(PG8_SB(1, 0), b3, voffB); PG8_STAGE(PG8_SB(1, 1), b3 + hstep, voffB); PG8_STAGE(PG8_SA(1, 0), a3, voffA);
            PG8_WAIT_V(8); PG8_WAIT_L(0); PG8_BAR; PG8_MMA(1, 0, At, B0); PG8_MMA(1, 1, At, B1); PG8_BAR; PG8_SCHED;
            } else {
            PG8_LDB(B0, 0, 0); PG8_SCHED; PG8_LDA(At, 0, 0); PG8_STAGE(PG8_SA(1, 1), a1 + hstep, voffA);
            PG8_WAIT_L(8); PG8_BAR; PG8_WAIT_L(0); PG8_MMA(0, 0, At, B0); PG8_BAR; PG8_SCHED;
            PG8_LDB(B1, 0, 1); PG8_STAGE(PG8_SB(0, 0), b2, voffB);
            PG8_BAR; PG8_WAIT_L(0); PG8_MMA(0, 1, At, B1); PG8_BAR;
            PG8_LDA(At, 0, 1); PG8_STAGE(PG8_SA(0, 0), a2, voffA);
            PG8_BAR; PG8_WAIT_L(0); PG8_MMA(1, 0, At, B0); PG8_BAR; PG8_SCHED;
            PG8_STAGE(PG8_SB(0, 1), b2 + hstep, voffB);
            PG8_WAIT_V(6); PG8_BAR; PG8_MMA(1, 1, At, B1); PG8_BAR;
            PG8_LDB(B0, 1, 0); PG8_SCHED; PG8_LDA(At, 1, 0); PG8_STAGE(PG8_SA(0, 1), a2 + hstep, voffA);
            PG8_WAIT_L(8); PG8_BAR; PG8_WAIT_L(0); PG8_MMA(0, 0, At, B0); PG8_BAR; PG8_SCHED;
            PG8_LDB(B1, 1, 1); PG8_STAGE(PG8_SB(1, 0), b3, voffB);
            PG8_BAR; PG8_WAIT_L(0); PG8_MMA(0, 1, At, B1); PG8_BAR;
            PG8_LDA(At, 1, 1); PG8_STAGE(PG8_SA(1, 0), a3, voffA);
            PG8_BAR; PG8_WAIT_L(0); PG8_MMA(1, 0, At, B0); PG8_BAR; PG8_SCHED;
            PG8_STAGE(PG8_SB(1, 1), b3 + hstep, voffB);
            PG8_WAIT_V(6); PG8_BAR; PG8_MMA(1, 1, At, B1); PG8_BAR;
            }
        }
        if constexpr (ALIGN_EPI) { if (wr == 0) PG8_BAR; }
        if constexpr (!Epi::AFTER_DRAIN) { if (!(S.skip & 1)) E(acc, cur, wr, wc, fr, fq); S.done(cur); }
        if (!has_next) break;
#pragma unroll
        for (int a = 0; a < 2; ++a)
#pragma unroll
            for (int b = 0; b < 2; ++b)
#pragma unroll
                for (int m = 0; m < 4; ++m)
#pragma unroll
                    for (int n = 0; n < 2; ++n) acc[a][b][m][n] = (f32x4){0.f, 0.f, 0.f, 0.f};
        cur = nxt; cA = nA; cB = nB; ++ui;
        if constexpr (ALIGN_EPI) { if (wr == 1) PG8_BAR; }
    }
    PG8_WAIT_V(0);
    if constexpr (!ALIGN_EPI) { if (wr == 0) PG8_BAR; }
    PG8_BAR;
    if constexpr (Epi::AFTER_DRAIN) { E.fused(acc, cur, wr, wc, fr, fq, lds, wid, lane); S.done(cur); }
#undef PG8_SA
#undef PG8_SB
#undef PG8_STAGE
#undef PG8_LDA
#undef PG8_LDB
#undef PG8_MMA
#undef PG8_WAIT_V
#undef PG8_WAIT_L
#undef PG8_BAR
#undef PG8_SCHED
}
}
#define GAS __attribute__((address_space(1)))
#define LAS __attribute__((address_space(3)))
typedef unsigned short bf16_t;
typedef unsigned v4u __attribute__((ext_vector_type(4)));
typedef float f32x4 __attribute__((ext_vector_type(4)));
typedef float f32x2 __attribute__((ext_vector_type(2)));
#define RLX_AGENT __ATOMIC_RELAXED, __HIP_MEMORY_SCOPE_AGENT
__device__ __forceinline__ float wave_sum(float v) {
#pragma unroll
    for (int o = 1; o < 64; o <<= 1) v += __shfl_xor(v, o);
    return v;
}
__device__ __forceinline__ float ld_f32_agent(const float* p) { return __builtin_bit_cast(float, __builtin_amdgcn_readfirstlane(__hip_atomic_load((const unsigned*)p, RLX_AGENT))); }
__device__ __forceinline__ float ld_f32_plain(const float* p) { return *(const GAS float*)p; }
__device__ __forceinline__ int ld_i32_agent(const int* p) { return (int)__hip_atomic_load((const unsigned*)p, RLX_AGENT); }
using pg8::pk_bf16; using pg8::bf_lo; using pg8::bf_hi;

#define XB_TMO      128
#define XB_XCNT(j)  (256  + 64 * (j))
#define XB_XSUB(j)  (1280 + 64 * (j))
#define XB_XGEN(j)  (2304 + 64 * (j))
#define XB_TOP      3328
#define XB_TOPGEN   3392
#define XCD_BAR_WORDS 3456
#define XB_SPIN_CAP (1u << 18)

__device__ __forceinline__ unsigned xb_ld(unsigned* p)              { return __hip_atomic_load(p, __ATOMIC_RELAXED, __HIP_MEMORY_SCOPE_AGENT); }
__device__ __forceinline__ unsigned xb_add(unsigned* p, unsigned v) { return __hip_atomic_fetch_add(p, v, __ATOMIC_RELAXED, __HIP_MEMORY_SCOPE_AGENT); }
__device__ __forceinline__ unsigned xb_xcc_id() { return (unsigned)__builtin_amdgcn_s_getreg((3 << 11) | 20) & 0xFu; }
#define XB_SPIN(cond, bar) do { unsigned _sp = 0; while (cond) { __builtin_amdgcn_s_sleep(1); \
    if ((++_sp & 255u) == 0u) { if (xb_ld(&(bar)[XB_TMO])) break; if (_sp > XB_SPIN_CAP) { atomicAdd(&(bar)[XB_TMO], 1u); break; } } } } while (0)

struct XcdBarrier {
    unsigned* bar; unsigned x;
    volatile LAS unsigned* st;
};

__device__ __forceinline__ XcdBarrier xcd_barrier_post(unsigned* bar, volatile LAS unsigned* st) {
    XcdBarrier b; b.bar = bar; b.x = xb_xcc_id(); b.st = st;
    if (threadIdx.x == 0) (void)xb_add(&bar[XB_XCNT(b.x)], 1u);
    return b;
}
__device__ __forceinline__ void xcd_barrier_complete(unsigned* bar, unsigned x, unsigned& nloc, unsigned& nx) {
    const unsigned G = gridDim.x * gridDim.y * gridDim.z;
    unsigned sum, cnt, mine, sp = 0u;
    for (;;) {
        sum = 0u; cnt = 0u; mine = 0u;
#pragma unroll
        for (unsigned j = 0; j < 16; ++j) { const unsigned c = xb_ld(&bar[XB_XCNT(j)]); sum += c; cnt += (c > 0u) ? 1u : 0u; mine = (j == x) ? c : mine; }
        if (sum == G) break;
        __builtin_amdgcn_s_sleep(1);
        if ((++sp & 255u) == 0u) { if (xb_ld(&bar[XB_TMO])) break; if (sp > XB_SPIN_CAP) { atomicAdd(&bar[XB_TMO], 1u); break; } }
    }
    nloc = mine > 0u ? mine : 1u; nx = cnt > 0u ? cnt : 1u;
}

__device__ __forceinline__ void xcd_barrier(const XcdBarrier& b) {
    asm volatile("s_waitcnt vmcnt(0)" ::: "memory");
    __syncthreads();
    if (threadIdx.x == 0) {
        unsigned* bar = b.bar;
        __builtin_amdgcn_s_waitcnt(0);
        unsigned nloc = b.st[0], nx = b.st[1];
        if (nloc == 0u) { xcd_barrier_complete(bar, b.x, nloc, nx); b.st[0] = nloc; b.st[1] = nx; }
        const unsigned old = xb_add(&bar[XB_XSUB(b.x)], 1u);
        const unsigned gen = old / nloc;
        if (old + 1u == (gen + 1u) * nloc) {
            __builtin_amdgcn_fence(__ATOMIC_RELEASE, "agent");
            asm volatile("s_waitcnt vmcnt(0)" ::: "memory");
            const unsigned og = xb_add(&bar[XB_TOP], 1u);
            const unsigned tg = og / nx;
            if (og + 1u == (tg + 1u) * nx) xb_add(&bar[XB_TOPGEN], 1u);
            else XB_SPIN(xb_ld(&bar[XB_TOPGEN]) == tg, bar);
            __builtin_amdgcn_fence(__ATOMIC_ACQUIRE, "agent");
            xb_add(&bar[XB_XGEN(b.x)], 1u);
            asm volatile("s_waitcnt vmcnt(0)" ::: "memory");
        } else {
            XB_SPIN(xb_ld(&bar[XB_XGEN(b.x)]) == gen, bar);
            __builtin_amdgcn_fence(__ATOMIC_ACQUIRE, "agent");
            asm volatile("s_waitcnt vmcnt(0)" ::: "memory");
        }
    }
    __syncthreads();
}


struct Args { const float* in[31]; float* out; unsigned char* ws; int ph_lo, ph_hi, flags, pad_; };

struct TJob { unsigned long long src, dst, gain; int K, N, ld, map, colbase, start, q8, smax, startq, f8, startf; };
constexpr int NJOBS = 41;
__device__ __forceinline__ void make_job(int j, const Args& a, TJob& o) {
    unsigned char* ws = a.ws; const float* src; void* dst; const float* gain = nullptr; o.map = 0; o.colbase = 0; o.q8 = 0; o.smax = 0; o.f8 = 0;
    if (j < 14) { const int l = j / 7, t = j % 7;
        if (t == 0)      { src = a.in[5] + (size_t)l * D * 4096; o.K = D; o.N = 4096; dst = ws + WS_W1T + l * 14 * MiB; gain = a.in[2] + l * D; o.q8 = I8_A; o.smax = SW_G1 + l * 7168; }
        else if (t == 1) { src = a.in[6] + (size_t)l * D * 3072; o.K = D; o.N = 3072; dst = ws + WS_W1T + l * 14 * MiB; gain = a.in[2] + l * D; o.colbase = 4096; o.q8 = I8_A; o.smax = SW_G1 + l * 7168 + 4096; }
        else if (t == 2) { src = a.in[19] + (size_t)l * D * 1024; o.K = D; o.N = 1024; dst = ws + WS_WMEMKV + l * 2 * MiB; gain = a.in[3] + l * D; }
        else if (t == 3) { src = a.in[20] + (size_t)l * 1024 * D; o.K = 1024; o.N = D; dst = ws + WS_WBRDA + l * 2 * MiB; }
        else if (t == 4) { src = a.in[21] + (size_t)l * 512 * D; o.K = 512; o.N = D; dst = ws + WS_WBRPOOL + l * 1 * MiB; }
        else if (t == 5) { src = a.in[22] + (size_t)l * 512 * D; o.K = 512; o.N = D; dst = ws + WS_WBRMEM + l * 1 * MiB; }
        else             { src = a.in[23] + (size_t)l * D * D; o.K = D; o.N = D; dst = ws + WS_WOUT + l * 2 * MiB; }
    } else if (j < 17) { const int t = j - 14;
        if (t < 2) { src = a.in[24 + t]; o.K = D; o.N = FFD; dst = ws + WS_WFF13; gain = a.in[4]; o.map = 1 + t; o.q8 = I8_E; o.smax = SW_FF + t * FFD; }
        else       { src = a.in[26]; o.K = FFD; o.N = D; dst = ws + WS_WFF2; o.f8 = 1; o.smax = SW_W2 + 8 * 1024; }
    } else { const int e = (j - 17) / 3, t = (j - 17) % 3;
        if (t < 2) { src = a.in[28 + t] + (size_t)e * D * FFE; o.K = D; o.N = FFE; dst = ws + WS_WMOE13 + (size_t)e * 7 * MiB; gain = a.in[4] + D; o.map = 1 + t; o.q8 = USE_I8; o.smax = SW_MOE + e * 2 * FFE + t * FFE; }
        else       { src = a.in[30] + (size_t)e * FFE * D; o.K = FFE; o.N = D; dst = ws + WS_WMOE2 + (size_t)e * 7 * MiB; o.f8 = 1; o.smax = SW_W2 + e * 1024; }
    }
    o.src = (unsigned long long)src; o.dst = (unsigned long long)dst; o.gain = (unsigned long long)gain; o.ld = o.N; o.start = 0; o.startq = 0; o.startf = 0;
}
__device__ __forceinline__ int bt_row_std(int C) { const int c = C & 255; return (C & ~255) + 128 * ((c >> 5) & 1) + 32 * (c >> 6) + 16 * ((c >> 2) & 1) + 4 * ((c >> 3) & 3) + (c & 3); }
__device__ __forceinline__ int bt_row_swiglu(int h, int which) { const int hl = h & 127; return 256 * (h >> 7) + 128 * ((hl >> 2) & 1) + 32 * (hl >> 5) + 16 * which + 4 * ((hl >> 3) & 3) + (hl & 3); }
struct TileRef { const GAS float* src; GAS bf16_t* dst; const GAS float* gain; int K, ld, map, colbase, k0, n0, q8, smax; };
template <bool QONLY> __device__ __forceinline__ void tile_decode(const LAS TJob* jobs, int& j, int it, TileRef& r) {
    if constexpr (QONLY) { while (it >= jobs[j + 1].startq) ++j; } else { while (it >= jobs[j + 1].start) ++j; }
    const LAS TJob* jb = jobs + j; const int item = it - (QONLY ? jb->startq : jb->start), nblk = jb->N >> 6;
    r.src = (const GAS float*)jb->src; r.dst = (GAS bf16_t*)jb->dst; r.gain = (const GAS float*)jb->gain; r.K = jb->K; r.ld = jb->ld; r.map = jb->map; r.colbase = jb->colbase; r.q8 = jb->q8; r.smax = jb->smax;
    r.k0 = (item / nblk) * 64; r.n0 = (item % nblk) * 64;
}
__device__ __forceinline__ void tile_load(const TileRef& r, int lane, f32x4 (&v)[16]) {
    const GAS float* p = r.src + (size_t)(r.k0 + (lane >> 4)) * r.ld + r.n0 + 4 * (lane & 15);
#pragma unroll
    for (int i = 0; i < 16; ++i) v[i] = __builtin_nontemporal_load((const GAS f32x4*)(p + (size_t)(4 * i) * r.ld));
}
__device__ __forceinline__ void tile_store(const TileRef& r, int lane, const f32x4 (&v)[16], LAS float* scr) {
#pragma unroll
    for (int i = 0; i < 16; ++i) { LAS float* d = scr + (4 * i + (lane >> 4)) * 65 + 4 * (lane & 15); d[0] = v[i][0]; d[1] = v[i][1]; d[2] = v[i][2]; d[3] = v[i][3]; }
    asm volatile("s_waitcnt lgkmcnt(0)" ::: "memory");
    const int kc = lane & 7;
    f32x4 g0 = {1.f, 1.f, 1.f, 1.f}, g1 = g0;
    if (r.gain) { g0 = *(const GAS f32x4*)(r.gain + r.k0 + 8 * kc); g1 = *(const GAS f32x4*)(r.gain + r.k0 + 8 * kc + 4); }
#pragma unroll
    for (int jj = 0; jj < 8; ++jj) { const int n = (lane >> 3) + 8 * jj; const LAS float* s = scr + (8 * kc) * 65 + n;
        v4u o; o.x = pk_bf16(s[0 * 65] * g0[0], s[1 * 65] * g0[1]); o.y = pk_bf16(s[2 * 65] * g0[2], s[3 * 65] * g0[3]); o.z = pk_bf16(s[4 * 65] * g1[0], s[5 * 65] * g1[1]); o.w = pk_bf16(s[6 * 65] * g1[2], s[7 * 65] * g1[3]);
        const int row = (r.map == 0) ? bt_row_std(r.colbase + r.n0 + n) : bt_row_swiglu(r.n0 + n, r.map - 1);
        *(GAS v4u*)(r.dst + (size_t)row * r.K + r.k0 + 8 * kc) = o; }
    asm volatile("s_waitcnt lgkmcnt(0)" ::: "memory");
}
__device__ __forceinline__ void tile_colmax(const TileRef& r, int lane, const f32x4 (&v)[16], float* cmaxbase) {
    float m0 = 0.f, m1 = 0.f, m2 = 0.f, m3 = 0.f;
#pragma unroll
    for (int i = 0; i < 16; ++i) { const float g = r.gain ? r.gain[r.k0 + 4 * i + (lane >> 4)] : 1.f;
        m0 = fmaxf(m0, fabsf(v[i][0] * g)); m1 = fmaxf(m1, fabsf(v[i][1] * g)); m2 = fmaxf(m2, fabsf(v[i][2] * g)); m3 = fmaxf(m3, fabsf(v[i][3] * g)); }
    m0 = fmaxf(m0, __shfl_xor(m0, 16)); m1 = fmaxf(m1, __shfl_xor(m1, 16)); m2 = fmaxf(m2, __shfl_xor(m2, 16)); m3 = fmaxf(m3, __shfl_xor(m3, 16));
    m0 = fmaxf(m0, __shfl_xor(m0, 32)); m1 = fmaxf(m1, __shfl_xor(m1, 32)); m2 = fmaxf(m2, __shfl_xor(m2, 32)); m3 = fmaxf(m3, __shfl_xor(m3, 32));
    if (lane < 16) { unsigned* p = (unsigned*)(cmaxbase + r.smax + r.n0 + 4 * lane);
        atomicMax(p, __float_as_uint(m0)); atomicMax(p + 1, __float_as_uint(m1)); atomicMax(p + 2, __float_as_uint(m2)); atomicMax(p + 3, __float_as_uint(m3)); }
}
__device__ __forceinline__ unsigned pk_i8x4(float a, float b, float c, float d) {
    const int ia = (int)__builtin_rintf(a), ib = (int)__builtin_rintf(b), ic = (int)__builtin_rintf(c), id = (int)__builtin_rintf(d);
    return (unsigned)(ia & 0xff) | ((unsigned)(ib & 0xff) << 8) | ((unsigned)(ic & 0xff) << 16) | ((unsigned)id << 24);
}
__device__ __forceinline__ void tile_store_q8(const TileRef& r, int lane, const f32x4 (&v)[16], LAS float* scr, const float* cmaxbase) {
#pragma unroll
    for (int i = 0; i < 16; ++i) { const float g = r.gain ? r.gain[r.k0 + 4 * i + (lane >> 4)] : 1.f; LAS float* d = scr + (4 * i + (lane >> 4)) * 65 + 4 * (lane & 15); d[0] = v[i][0] * g; d[1] = v[i][1] * g; d[2] = v[i][2] * g; d[3] = v[i][3] * g; }
    asm volatile("s_waitcnt lgkmcnt(0)" ::: "memory");
    const int kc = lane & 3;
#pragma unroll
    for (int jj = 0; jj < 4; ++jj) { const int n = (lane >> 2) + 16 * jj; const LAS float* s = scr + (16 * kc) * 65 + n;
        const float cm = ld_f32_plain(cmaxbase + r.smax + r.n0 + n), inv = cm > 0.f ? 127.0f / cm : 0.f;
        v4u o; o.x = pk_i8x4(s[0 * 65] * inv, s[1 * 65] * inv, s[2 * 65] * inv, s[3 * 65] * inv); o.y = pk_i8x4(s[4 * 65] * inv, s[5 * 65] * inv, s[6 * 65] * inv, s[7 * 65] * inv);
        o.z = pk_i8x4(s[8 * 65] * inv, s[9 * 65] * inv, s[10 * 65] * inv, s[11 * 65] * inv); o.w = pk_i8x4(s[12 * 65] * inv, s[13 * 65] * inv, s[14 * 65] * inv, s[15 * 65] * inv);
        const int row = (r.map == 0) ? bt_row_std(r.colbase + r.n0 + n) : bt_row_swiglu(r.n0 + n, r.map - 1);
        *(GAS v4u*)((GAS unsigned char*)r.dst + (size_t)row * r.K + r.k0 + 16 * kc) = o; }
    asm volatile("s_waitcnt lgkmcnt(0)" ::: "memory");
}
__device__ __forceinline__ void row_to_i8(const float* xrow, unsigned char* qrow, float* sa, int lane) {
    const f32x4* xr = (const f32x4*)xrow + 4 * lane; f32x4 v[4]; float s = 0.f, mx = 0.f;
#pragma unroll
    for (int j = 0; j < 4; ++j) { v[j] = xr[j]; s += (v[j][0] * v[j][0] + v[j][1] * v[j][1]) + (v[j][2] * v[j][2] + v[j][3] * v[j][3]);
        mx = fmaxf(mx, fmaxf(fmaxf(fabsf(v[j][0]), fabsf(v[j][1])), fmaxf(fabsf(v[j][2]), fabsf(v[j][3])))); }
    s = wave_sum(s);
#pragma unroll
    for (int o = 1; o < 64; o <<= 1) mx = fmaxf(mx, __shfl_xor(mx, o));
    const float inv = mx > 0.f ? 127.0f / mx : 0.f;
    v4u w; w.x = pk_i8x4(v[0][0] * inv, v[0][1] * inv, v[0][2] * inv, v[0][3] * inv); w.y = pk_i8x4(v[1][0] * inv, v[1][1] * inv, v[1][2] * inv, v[1][3] * inv);
    w.z = pk_i8x4(v[2][0] * inv, v[2][1] * inv, v[2][2] * inv, v[2][3] * inv); w.w = pk_i8x4(v[3][0] * inv, v[3][1] * inv, v[3][2] * inv, v[3][3] * inv);
    *((v4u*)qrow + lane) = w;
    if (lane == 0) *sa = mx * (1.0f / 127.0f) * __builtin_amdgcn_rsqf(s * (1.0f / 1024.0f) + 1e-6f);
}
__device__ __forceinline__ void ld16_bf16(const bf16_t* p, f32x4 (&v)[4]) {
    const v4u a = *(const v4u*)p, b = *(const v4u*)(p + 8);
    v[0] = (f32x4){bf_lo(a.x), bf_hi(a.x), bf_lo(a.y), bf_hi(a.y)}; v[1] = (f32x4){bf_lo(a.z), bf_hi(a.z), bf_lo(a.w), bf_hi(a.w)};
    v[2] = (f32x4){bf_lo(b.x), bf_hi(b.x), bf_lo(b.y), bf_hi(b.y)}; v[3] = (f32x4){bf_lo(b.z), bf_hi(b.z), bf_lo(b.w), bf_hi(b.w)};
}
__device__ __forceinline__ void rowb_to_i8(const bf16_t* xrow, unsigned char* qrow, float* sa, int lane) {
    f32x4 v[4]; ld16_bf16(xrow + 16 * lane, v); float s = 0.f, mx = 0.f;
#pragma unroll
    for (int j = 0; j < 4; ++j) { s += (v[j][0] * v[j][0] + v[j][1] * v[j][1]) + (v[j][2] * v[j][2] + v[j][3] * v[j][3]);
        mx = fmaxf(mx, fmaxf(fmaxf(fabsf(v[j][0]), fabsf(v[j][1])), fmaxf(fabsf(v[j][2]), fabsf(v[j][3])))); }
    s = wave_sum(s);
#pragma unroll
    for (int o = 1; o < 64; o <<= 1) mx = fmaxf(mx, __shfl_xor(mx, o));
    const float inv = mx > 0.f ? 127.0f / mx : 0.f;
    v4u w; w.x = pk_i8x4(v[0][0] * inv, v[0][1] * inv, v[0][2] * inv, v[0][3] * inv); w.y = pk_i8x4(v[1][0] * inv, v[1][1] * inv, v[1][2] * inv, v[1][3] * inv);
    w.z = pk_i8x4(v[2][0] * inv, v[2][1] * inv, v[2][2] * inv, v[2][3] * inv); w.w = pk_i8x4(v[3][0] * inv, v[3][1] * inv, v[3][2] * inv, v[3][3] * inv);
    *((v4u*)qrow + lane) = w;
    if (lane == 0) *sa = mx * (1.0f / 127.0f) * __builtin_amdgcn_rsqf(s * (1.0f / 1024.0f) + 1e-6f);
}
__device__ __forceinline__ void phase_quant_rows(const bf16_t* x, unsigned char* ws, int lane, int wave) {
    const int gw = blockIdx.x * NWAVES + wave, NGW = gridDim.x * NWAVES;
    for (int m = gw; m < T; m += NGW) rowb_to_i8(x + (size_t)m * D, ws + WS_QX + (size_t)m * D, (float*)(ws + WS_SA) + m, lane);
}
__device__ __forceinline__ void row_to_bf16_ss(const float* xrow, bf16_t* orow, float* ss16, float* fcopy, int lane) {
    const f32x4* xr = (const f32x4*)xrow + lane; f32x4 v[4]; float s = 0.f;
#pragma unroll
    for (int j = 0; j < 4; ++j) { v[j] = xr[64 * j]; s += (v[j][0] * v[j][0] + v[j][1] * v[j][1]) + (v[j][2] * v[j][2] + v[j][3] * v[j][3]); }
    s = wave_sum(s);
    if (fcopy) { f32x4* fc = (f32x4*)fcopy + lane;
#pragma unroll
        for (int j = 0; j < 4; ++j) fc[64 * j] = v[j]; }
    unsigned long long* o8 = (unsigned long long*)orow + lane;
#pragma unroll
    for (int j = 0; j < 4; ++j) o8[64 * j] = (unsigned long long)pk_bf16(v[j][0], v[j][1]) | ((unsigned long long)pk_bf16(v[j][2], v[j][3]) << 32);
    if (lane < 16) ss16[lane] = (lane == 0) ? s : 0.f;
}
__device__ __forceinline__ void build_jobs(const Args& a, LAS TJob* jobs, int tid) {
    if (tid < NJOBS) { TJob jb; make_job(tid, a, jb); LAS TJob* d = jobs + tid; d->src = jb.src; d->dst = jb.dst; d->gain = jb.gain; d->K = jb.K; d->N = jb.N; d->ld = jb.ld; d->map = jb.map; d->colbase = jb.colbase; d->q8 = jb.q8; d->smax = jb.smax; d->start = 0; d->startq = 0; d->f8 = jb.f8; d->startf = 0; }
    __syncthreads();
    if (tid == 0) { int s = 0, q = 0, f = 0; for (int j = 0; j < NJOBS; ++j) { jobs[j].start = s; jobs[j].startq = q; jobs[j].startf = f; if (jobs[j].q8) q += jobs[j].N / 64; else if (jobs[j].f8) f += jobs[j].N / 16; else s += (jobs[j].K / 64) * (jobs[j].N / 64); }
        jobs[NJOBS].start = s; jobs[NJOBS].startq = q; jobs[NJOBS].startf = f; }
    __syncthreads();
}
__device__ __forceinline__ void strip_q8(const LAS TJob* jobs, int& j, int st, LAS unsigned char* lds, int tid, int lane, int wave, float* cmaxbase) {
    while (st >= jobs[j + 1].startq) ++j;
    const LAS TJob* jb = jobs + j;
    TileRef r; r.src = (const GAS float*)jb->src; r.dst = (GAS bf16_t*)jb->dst; r.gain = (const GAS float*)jb->gain; r.K = jb->K; r.ld = jb->ld; r.map = jb->map; r.colbase = jb->colbase; r.q8 = 1; r.smax = jb->smax;
    r.n0 = (st - jb->startq) * 64; r.k0 = 128 * wave;
    LAS float* scr = (LAS float*)(lds + wave * 17408); LAS float* pmax = (LAS float*)(lds + 8 * 17408 + 4096); LAS float* cmf = pmax + 8 * 64;
    f32x4 v0[16], v1[16];
    tile_load(r, lane, v0); r.k0 += 64; tile_load(r, lane, v1); r.k0 -= 64;
    float m0 = 0.f, m1 = 0.f, m2 = 0.f, m3 = 0.f;
#pragma unroll
    for (int i = 0; i < 16; ++i) { const float g0 = r.gain ? r.gain[r.k0 + 4 * i + (lane >> 4)] : 1.f, g1 = r.gain ? r.gain[r.k0 + 64 + 4 * i + (lane >> 4)] : 1.f;
        v0[i] = v0[i] * g0; v1[i] = v1[i] * g1;
        m0 = fmaxf(m0, fmaxf(fabsf(v0[i][0]), fabsf(v1[i][0]))); m1 = fmaxf(m1, fmaxf(fabsf(v0[i][1]), fabsf(v1[i][1]))); m2 = fmaxf(m2, fmaxf(fabsf(v0[i][2]), fabsf(v1[i][2]))); m3 = fmaxf(m3, fmaxf(fabsf(v0[i][3]), fabsf(v1[i][3]))); }
    m0 = fmaxf(m0, __shfl_xor(m0, 16)); m1 = fmaxf(m1, __shfl_xor(m1, 16)); m2 = fmaxf(m2, __shfl_xor(m2, 16)); m3 = fmaxf(m3, __shfl_xor(m3, 16));
    m0 = fmaxf(m0, __shfl_xor(m0, 32)); m1 = fmaxf(m1, __shfl_xor(m1, 32)); m2 = fmaxf(m2, __shfl_xor(m2, 32)); m3 = fmaxf(m3, __shfl_xor(m3, 32));
    __syncthreads();
    if (lane < 16) *(LAS f32x4*)(pmax + wave * 64 + 4 * lane) = (f32x4){m0, m1, m2, m3};
    __syncthreads();
    if (tid < 64) { float m = pmax[tid];
#pragma unroll
        for (int w = 1; w < 8; ++w) m = fmaxf(m, pmax[w * 64 + tid]);
        cmf[tid] = m; cmaxbase[r.smax + r.n0 + tid] = m; }
    __syncthreads();
#pragma unroll
    for (int h = 0; h < 2; ++h) {
#pragma unroll
        for (int i = 0; i < 16; ++i) { LAS float* d = scr + (4 * i + (lane >> 4)) * 65 + 4 * (lane & 15); const f32x4 x = h ? v1[i] : v0[i]; d[0] = x[0]; d[1] = x[1]; d[2] = x[2]; d[3] = x[3]; }
        asm volatile("s_waitcnt lgkmcnt(0)" ::: "memory");
        const int kc = lane & 3;
#pragma unroll
        for (int jj = 0; jj < 4; ++jj) { const int n = (lane >> 2) + 16 * jj; const LAS float* s = scr + (16 * kc) * 65 + n;
            const float cm = cmf[n], inv = cm > 0.f ? 127.0f / cm : 0.f;
            v4u o; o.x = pk_i8x4(s[0 * 65] * inv, s[1 * 65] * inv, s[2 * 65] * inv, s[3 * 65] * inv); o.y = pk_i8x4(s[4 * 65] * inv, s[5 * 65] * inv, s[6 * 65] * inv, s[7 * 65] * inv);
            o.z = pk_i8x4(s[8 * 65] * inv, s[9 * 65] * inv, s[10 * 65] * inv, s[11 * 65] * inv); o.w = pk_i8x4(s[12 * 65] * inv, s[13 * 65] * inv, s[14 * 65] * inv, s[15 * 65] * inv);
            const int row = (r.map == 0) ? bt_row_std(r.colbase + r.n0 + n) : bt_row_swiglu(r.n0 + n, r.map - 1);
            *(GAS v4u*)((GAS unsigned char*)r.dst + (size_t)row * r.K + r.k0 + 64 * h + 16 * kc) = o; }
        asm volatile("s_waitcnt lgkmcnt(0)" ::: "memory");
    }
}
__device__ __forceinline__ void strip_f8(const LAS TJob* jobs, int& j, int st, LAS unsigned char* lds, int tid, int lane, int wave, float* cmaxbase) {
    while (st >= jobs[j + 1].startf) ++j;
    const LAS TJob* jb = jobs + j;
    const GAS float* src = (const GAS float*)jb->src; GAS unsigned char* dst = (GAS unsigned char*)jb->dst; const int K = jb->K, n0 = (st - jb->startf) * 16, smax = jb->smax, nq = K >> 2;
    const int c4 = tid & 3, q0 = tid >> 2;
    constexpr int RS8 = 3584 + 16;
    LAS float* pmax = (LAS float*)(lds + 8 * 17408 + 4096); LAS float* cmf = pmax + 8 * 16;
    f32x4 v[7][4];
#pragma unroll
    for (int i = 0; i < 7; ++i) { const int q = q0 + 128 * i; const GAS float* p = src + (size_t)(4 * q) * 1024 + n0 + 4 * c4;
#pragma unroll
        for (int kk = 0; kk < 4; ++kk) v[i][kk] = (q < nq) ? __builtin_nontemporal_load((const GAS f32x4*)(p + kk * 1024)) : (f32x4){0.f, 0.f, 0.f, 0.f}; }
    float m0 = 0.f, m1 = 0.f, m2 = 0.f, m3 = 0.f;
#pragma unroll
    for (int i = 0; i < 7; ++i)
#pragma unroll
        for (int kk = 0; kk < 4; ++kk) { m0 = fmaxf(m0, fabsf(v[i][kk][0])); m1 = fmaxf(m1, fabsf(v[i][kk][1])); m2 = fmaxf(m2, fabsf(v[i][kk][2])); m3 = fmaxf(m3, fabsf(v[i][kk][3])); }
#pragma unroll
    for (int o = 4; o < 64; o <<= 1) { m0 = fmaxf(m0, __shfl_xor(m0, o)); m1 = fmaxf(m1, __shfl_xor(m1, o)); m2 = fmaxf(m2, __shfl_xor(m2, o)); m3 = fmaxf(m3, __shfl_xor(m3, o)); }
    __syncthreads();
    if (lane < 4) *(LAS f32x4*)(pmax + wave * 16 + 4 * lane) = (f32x4){m0, m1, m2, m3};
    __syncthreads();
    if (tid < 16) { float m = pmax[tid];
#pragma unroll
        for (int w = 1; w < 8; ++w) m = fmaxf(m, pmax[w * 16 + tid]);
        cmf[tid] = m; cmaxbase[smax + n0 + tid] = m * (1.0f / (256.0f * H8_SCALE)); }
    __syncthreads();
    { const f32x4 cm = *(const LAS f32x4*)(cmf + 4 * c4); f32x4 inv;
#pragma unroll
      for (int jj = 0; jj < 4; ++jj) inv[jj] = cm[jj] > 0.f ? 256.0f / cm[jj] : 0.f;
#pragma unroll
      for (int i = 0; i < 7; ++i) { const int q = q0 + 128 * i;
          if (q < nq) {
#pragma unroll
              for (int jj = 0; jj < 4; ++jj) *(LAS unsigned*)(lds + (4 * c4 + jj) * RS8 + 4 * q) = pg8::pk_fp8x4(v[i][0][jj] * inv[jj], v[i][1][jj] * inv[jj], v[i][2][jj] * inv[jj], v[i][3][jj] * inv[jj]); } } }
    __syncthreads();
    { const int row = tid >> 5, t32 = tid & 31; GAS unsigned char* drow = dst + (size_t)bt_row_std(n0 + row) * K;
#pragma unroll
      for (int it = 0; it < 7; ++it) { const int ch = t32 + 32 * it; if (ch * 16 < K) *(GAS v4u*)(drow + ch * 16) = *(const LAS v4u*)(lds + row * RS8 + ch * 16); } }
}
__device__ __forceinline__ void phase_prologue(const Args& a, LAS unsigned char* lds, int tid, int lane, int wave) {
    unsigned char* ws = a.ws;
    LAS TJob* jobs = (LAS TJob*)(lds + 8 * 17408);
    build_jobs(a, jobs, tid);
    const int gw = blockIdx.x * NWAVES + wave, NGW = gridDim.x * NWAVES;
    { const int nstrip = jobs[NJOBS].startq; int js = 0;
      for (int st = blockIdx.x; st < nstrip; st += gridDim.x) strip_q8(jobs, js, st, lds, tid, lane, wave, (float*)(ws + WS_SW));
      __syncthreads(); }
    { const int nstrip = jobs[NJOBS].startf; int js = 0;
      const int first = (int)(((unsigned)blockIdx.x + gridDim.x - (unsigned)(jobs[NJOBS].startq % (int)gridDim.x)) % gridDim.x);
      for (int st = first; st < nstrip; st += gridDim.x) strip_f8(jobs, js, st, lds, tid, lane, wave, (float*)(ws + WS_SW));
      __syncthreads(); }
    {
        LAS float* scr = (LAS float*)(lds + wave * 17408);
        const int total = jobs[NJOBS].start; int j = 0;
        if (gw < total) {
            TileRef cur, nxt; f32x4 v[16], vn[16];
            tile_decode<false>(jobs, j, gw, cur); tile_load(cur, lane, v);
#pragma unroll 1
            for (int it = gw; it < total; it += NGW) {
                const bool more = it + NGW < total;
                if (more) { tile_decode<false>(jobs, j, it + NGW, nxt); tile_load(nxt, lane, vn); }
                tile_store(cur, lane, v, scr);
                if (more) { cur = nxt;
#pragma unroll
                    for (int i = 0; i < 16; ++i) v[i] = vn[i]; }
            }
        }
    }
#if I8_A
    for (int m = gw; m < T; m += NGW) row_to_i8(a.in[0] + (size_t)m * D, ws + WS_QX + (size_t)m * D, (float*)(ws + WS_SA) + m, lane);
#else
    for (int m = gw; m < T; m += NGW) row_to_bf16_ss(a.in[0] + (size_t)m * D, (bf16_t*)(ws + WS_XB) + (size_t)m * D, (float*)(ws + WS_SS) + (size_t)m * 16, nullptr, lane);
#endif
    for (int m = gw; m < NBATCH * MEML; m += NGW) row_to_bf16_ss(a.in[1] + (size_t)m * D, (bf16_t*)(ws + WS_MEMBF) + (size_t)m * D, (float*)(ws + WS_SSM) + (size_t)m * 16, nullptr, lane);
    {
        float* prm = (float*)(ws + WS_PARAM); const int gt = blockIdx.x * NTHR + tid, NGT = gridDim.x * NTHR;
        for (int i = gt; i < PB_END; i += NGT) { float v;
            if (i < PB_GQ) v = a.in[7][i]; else if (i < PB_GK) v = a.in[8][i - PB_GQ]; else if (i < PB_GOUT) v = a.in[9][i - PB_GK]; else if (i < PB_POOLS) v = a.in[14][i - PB_GOUT];
            else if (i < PB_MQN) v = a.in[16][i - PB_POOLS]; else if (i < PB_MKN) v = a.in[17][i - PB_MQN]; else if (i < PB_GFFN1) v = a.in[18][i - PB_MKN]; else if (i < PB_WR) v = a.in[4][D + i - PB_GFFN1];
            else if (i < PB_POOLW) v = a.in[27][i - PB_WR]; else v = a.in[15][i - PB_POOLW];
            prm[i] = v; }
        bf16_t* pwt = (bf16_t*)(ws + WS_POOLWT);
        for (int i = gt; i < 2 * 4 * 128 * 128; i += NGT) { const int lg = i >> 14, dout = (i >> 7) & 127, cc = i & 127; pwt[i] = (bf16_t)(pk_bf16(a.in[15][((size_t)lg * 128 + cc) * 128 + dout], 0.f) & 0xffffu); }
    }
    if (blockIdx.x == 0 && wave == 0) {
        float* sc = (float*)(ws + WS_SC);
        for (int l = 0; l < 2; ++l) {
            const float a1 = wave_sum(a.in[10][l * 64 + lane] * a.in[11][l * 64 + lane]), a2 = wave_sum(a.in[12][l * 64 + lane] * a.in[13][l * 64 + lane]);
            const float lam0 = (l == 0) ? 0.2f : (0.8f - 0.6f * 0.7408182206817179f);
            const float lam = __expf(a1) - __expf(a2) + lam0;
            float m0 = fabsf(a.in[8][l * 128 + lane] * a.in[9][l * 128 + lane]), m1 = fabsf(a.in[8][l * 128 + 64 + lane] * a.in[9][l * 128 + 64 + lane]);
            float mm = fmaxf(fabsf(a.in[17][l * 128 + lane] * a.in[18][l * 128 + lane]), fabsf(a.in[17][l * 128 + 64 + lane] * a.in[18][l * 128 + 64 + lane]));
#pragma unroll
            for (int o = 1; o < 64; o <<= 1) { m0 = fmaxf(m0, __shfl_xor(m0, o)); m1 = fmaxf(m1, __shfl_xor(m1, o)); mm = fmaxf(mm, __shfl_xor(mm, o)); }
            if (lane == 0) { sc[l * 8 + 0] = lam; sc[l * 8 + 1] = m0 * 64.f * QSCALE; sc[l * 8 + 2] = m1 * 64.f * QSCALE; sc[l * 8 + 3] = mm * 128.f * MEMSCALE; sc[l * 8 + 4] = 1.0f - lam0; }
        }
    }
}

__device__ __forceinline__ void unpack16(const bf16_t* src, float (&f)[16]) {
    const v4u a = *(const v4u*)src, b = *(const v4u*)(src + 8);
    f[0] = bf_lo(a.x); f[1] = bf_hi(a.x); f[2] = bf_lo(a.y); f[3] = bf_hi(a.y); f[4] = bf_lo(a.z); f[5] = bf_hi(a.z); f[6] = bf_lo(a.w); f[7] = bf_hi(a.w);
    f[8] = bf_lo(b.x); f[9] = bf_hi(b.x); f[10] = bf_lo(b.y); f[11] = bf_hi(b.y); f[12] = bf_lo(b.z); f[13] = bf_hi(b.z); f[14] = bf_lo(b.w); f[15] = bf_hi(b.w);
}
template <bool DIFF>
__device__ __forceinline__ void naive_attn_unit(LAS unsigned char* lds, int tid, const bf16_t* Qg, int ldq, const bf16_t* Kg, int ldk, const bf16_t* Vg, int ldv, bf16_t* Og, int ldo,
                                                int ntiles, int qpos0, const float* qmulA, const float* qmulB, const float* qss, float slope2, float bnd0, float bnd1, float lam, const float* gout, float outmul) {
    constexpr int QW = 4;
    LAS float* Lq = (LAS float*)lds; LAS float* Lk = Lq + 32 * 128; LAS float* Lv = Lk + 64 * 129; LAS float* Lp = Lv + 64 * 128; LAS float* Lrk = Lp + 8 * QW * 2 * 64;
    const int lane = tid & 63, wid = tid >> 6, r = tid >> 3, sg = tid & 7;
    __syncthreads();
    if (tid < 256) { float f[16]; unpack16(Qg + (size_t)r * ldq + sg * 16, f); float mul = 1.f;
      if (!DIFF) { const float s = qss[r * 8] + qss[r * 8 + 1]; mul = __builtin_amdgcn_rsqf(s * (1.f / 128.f) + 1e-6f) * MEMSCALE; }
#pragma unroll
      for (int i = 0; i < 16; ++i) Lq[r * 128 + sg * 16 + i] = DIFF ? f[i] : f[i] * mul * qmulA[sg * 16 + i] * qmulB[sg * 16 + i]; }
    float o0[QW][2], o1[QW][2], l0[QW], l1[QW];
#pragma unroll
    for (int q = 0; q < QW; ++q) { o0[q][0] = o0[q][1] = o1[q][0] = o1[q][1] = 0.f; l0[q] = l1[q] = 0.f; }
#pragma unroll 1
    for (int j = 0; j < ntiles; ++j) {
        __syncthreads();
        { float f[16]; unpack16(Kg + (size_t)(j * 64 + r) * ldk + sg * 16, f);
#pragma unroll
          for (int i = 0; i < 16; ++i) Lk[r * 129 + sg * 16 + i] = f[i];
          unpack16(Vg + (size_t)(j * 64 + r) * ldv + sg * 16, f);
#pragma unroll
          for (int i = 0; i < 16; ++i) Lv[r * 128 + sg * 16 + i] = f[i]; }
        __syncthreads();
        if (!DIFF) { if (tid < 64) { float s = 0.f;
#pragma unroll 4
            for (int d = 0; d < 128; ++d) { const float x = Lk[tid * 129 + d]; s += x * x; } Lrk[tid] = __builtin_amdgcn_rsqf(s * (1.f / 128.f) + 1e-6f); } __syncthreads(); }
        float s0[QW], s1[QW];
#pragma unroll
        for (int q = 0; q < QW; ++q) { s0[q] = 0.f; s1[q] = 0.f; }
#pragma unroll 1
        for (int d4 = 0; d4 < 16; ++d4) {
            const float k0 = Lk[lane * 129 + 4 * d4], k1 = Lk[lane * 129 + 4 * d4 + 1], k2 = Lk[lane * 129 + 4 * d4 + 2], k3 = Lk[lane * 129 + 4 * d4 + 3];
            const float e0 = Lk[lane * 129 + 64 + 4 * d4], e1 = Lk[lane * 129 + 64 + 4 * d4 + 1], e2 = Lk[lane * 129 + 64 + 4 * d4 + 2], e3 = Lk[lane * 129 + 64 + 4 * d4 + 3];
#pragma unroll
            for (int q = 0; q < QW; ++q) { const f32x4 qa = *(const LAS f32x4*)&Lq[(wid * QW + q) * 128 + 4 * d4], qb = *(const LAS f32x4*)&Lq[(wid * QW + q) * 128 + 64 + 4 * d4];
                s0[q] += (qa[0] * k0 + qa[1] * k1) + (qa[2] * k2 + qa[3] * k3); s1[q] += (qb[0] * e0 + qb[1] * e1) + (qb[2] * e2 + qb[3] * e3); }
        }
        const int kpos = j * 64 + lane;
#pragma unroll
        for (int q = 0; q < QW; ++q) { float p0, p1;
            if (DIFF) { const int qpos = qpos0 + wid * QW + q; const float bias = -slope2 * fabsf((float)(qpos - kpos)); p0 = __builtin_amdgcn_exp2f(s0[q] + bias - bnd0); p1 = __builtin_amdgcn_exp2f(s1[q] + bias - bnd1); }
            else { p0 = __builtin_amdgcn_exp2f((s0[q] + s1[q]) * Lrk[lane] - bnd0); p1 = 0.f; }
            l0[q] += p0; l1[q] += p1; Lp[((wid * QW + q) * 2 + 0) * 64 + lane] = p0; Lp[((wid * QW + q) * 2 + 1) * 64 + lane] = p1; }
        asm volatile("s_waitcnt lgkmcnt(0)" ::: "memory");
#pragma unroll 1
        for (int k4 = 0; k4 < 16; ++k4) {
            f32x2 v[4];
#pragma unroll
            for (int i = 0; i < 4; ++i) v[i] = *(const LAS f32x2*)&Lv[(4 * k4 + i) * 128 + 2 * lane];
#pragma unroll
            for (int q = 0; q < QW; ++q) { const f32x4 pa = *(const LAS f32x4*)&Lp[((wid * QW + q) * 2 + 0) * 64 + 4 * k4];
                o0[q][0] += (pa[0] * v[0][0] + pa[1] * v[1][0]) + (pa[2] * v[2][0] + pa[3] * v[3][0]); o0[q][1] += (pa[0] * v[0][1] + pa[1] * v[1][1]) + (pa[2] * v[2][1] + pa[3] * v[3][1]);
                if (DIFF) { const f32x4 pb = *(const LAS f32x4*)&Lp[((wid * QW + q) * 2 + 1) * 64 + 4 * k4];
                    o1[q][0] += (pb[0] * v[0][0] + pb[1] * v[1][0]) + (pb[2] * v[2][0] + pb[3] * v[3][0]); o1[q][1] += (pb[0] * v[0][1] + pb[1] * v[1][1]) + (pb[2] * v[2][1] + pb[3] * v[3][1]); } }
        }
    }
#pragma unroll
    for (int q = 0; q < QW; ++q) { const float L0 = wave_sum(l0[q]); float x = o0[q][0] / L0, y = o0[q][1] / L0;
        if (DIFF) { const float L1 = wave_sum(l1[q]); x -= lam * (o1[q][0] / L1); y -= lam * (o1[q][1] / L1);
            const float ss = wave_sum(x * x + y * y); const float rr = __builtin_amdgcn_rsqf(ss * (1.f / 128.f) + 1e-6f) * outmul; x *= rr * gout[2 * lane]; y *= rr * gout[2 * lane + 1]; }
        *(unsigned*)(Og + (size_t)(wid * QW + q) * ldo + 2 * lane) = pk_bf16(x, y); }
}
__device__ __forceinline__ void naive_pool_unit(LAS unsigned char* lds, int tid, const bf16_t* Pg  , bf16_t* Og  , const float* W  , const float* scale  , int tok0, int g) {
    LAS float* Lp = (LAS float*)lds; LAS float* Ld = Lp + 80 * 128;
    const int w = 2 << g, pos0 = tok0 & (SEQ - 1);
    __syncthreads();
    for (int i = tid; i < 80 * 8; i += NTHR) { const int rr = i >> 3, sg = i & 7; const int tpos = pos0 - 16 + rr;
        float f[16];
        if (tpos >= 0) unpack16(Pg + (size_t)(tok0 - 16 + rr) * 512 + g * 128 + sg * 16, f); else {
#pragma unroll
            for (int k = 0; k < 16; ++k) f[k] = 0.f; }
#pragma unroll
        for (int k = 0; k < 16; ++k) Lp[rr * 128 + sg * 16 + k] = f[k]; }
    __syncthreads();
    for (int i = tid; i < 64 * 128; i += NTHR) { const int t = i >> 7, c = i & 127; const int tpos = pos0 + t; const int lo = (tpos + 1 - w) > 0 ? (tpos + 1 - w) : 0; const int cnt = tpos + 1 - lo;
        float s = 0.f;
#pragma unroll 1
        for (int k = 0; k < cnt; ++k) s += Lp[(16 + t - k) * 128 + c];
        Ld[t * 128 + c] = s / (float)cnt - Lp[(16 + t) * 128 + c]; }
    __syncthreads();
    const int dout = tid & 127, tq = tid >> 7; float acc[16];
#pragma unroll
    for (int i = 0; i < 16; ++i) acc[i] = 0.f;
#pragma unroll 2
    for (int c = 0; c < 128; ++c) { const float wv = W[c * 128 + dout];
#pragma unroll
        for (int i = 0; i < 16; ++i) acc[i] += Ld[(tq * 16 + i) * 128 + c] * wv; }
    const float sc = scale[dout];
#pragma unroll
    for (int i = 0; i < 16; ++i) Og[(size_t)(tok0 + tq * 16 + i) * 512 + g * 128 + dout] = (bf16_t)(pk_bf16(acc[i] * sc, 0.f) & 0xffffu);
}

namespace mix {
typedef short bf16x8 __attribute__((ext_vector_type(8)));
typedef short s16x4 __attribute__((ext_vector_type(4)));
typedef float f32x16 __attribute__((ext_vector_type(16)));
typedef const LAS unsigned char* lptr;
#define SBAR() __builtin_amdgcn_sched_barrier(0)
__device__ __forceinline__ unsigned lds_addr(lptr p) { return (unsigned)(uintptr_t)p; }
__device__ __forceinline__ bf16x8 pack8(const f32x16& p, int b) {
    v4u w; w.x = pk_bf16(p[b], p[b + 1]); w.y = pk_bf16(p[b + 2], p[b + 3]); w.z = pk_bf16(p[b + 4], p[b + 5]); w.w = pk_bf16(p[b + 6], p[b + 7]);
    return __builtin_bit_cast(bf16x8, w);
}
__device__ __forceinline__ void glds16(const void* g, LAS unsigned char* l) { __builtin_amdgcn_global_load_lds((const unsigned*)g, (LAS unsigned*)l, 16, 0, 0); }
#define MFMA32(a, b, c) __builtin_amdgcn_mfma_f32_32x32x16_bf16(a, b, c, 0, 0, 0)

#define VRD(set, db) do { _Pragma("unroll") for (int t_ = 0; t_ < 4; ++t_) { \
        asm volatile("ds_read_b64_tr_b16 %0, %1 offset:%c2" : "=&v"(lo[set][t_]) : "v"(va[db]), "i"(t_ * 4096) : "memory"); \
        asm volatile("ds_read_b64_tr_b16 %0, %1 offset:%c2" : "=&v"(hi[set][t_]) : "v"(va[db]), "i"(t_ * 4096 + 2048) : "memory"); } } while (0)
#define VRT(set, t) do { _Pragma("unroll") for (int d_ = 0; d_ < 4; ++d_) { \
        asm volatile("ds_read_b64_tr_b16 %0, %1 offset:%c2" : "=&v"(lo[set][d_]) : "v"(va[d_]), "i"((t) * 4096) : "memory"); \
        asm volatile("ds_read_b64_tr_b16 %0, %1 offset:%c2" : "=&v"(hi[set][d_]) : "v"(va[d_]), "i"((t) * 4096 + 2048) : "memory"); } } while (0)
#define VPK(set, t) (bf16x8){lo[set][t][0], lo[set][t][1], lo[set][t][2], lo[set][t][3], hi[set][t][0], hi[set][t][1], hi[set][t][2], hi[set][t][3]}
__device__ __forceinline__ void pv_tile(f32x16 (&O)[4], const unsigned (&va)[4], const bf16x8 (&pb)[4]) {
    s16x4 lo[2][4], hi[2][4];
    VRD(0, 0);
    VRD(1, 1); asm volatile("s_waitcnt lgkmcnt(8)" ::: "memory"); SBAR();
#pragma unroll
    for (int t = 0; t < 4; ++t) O[0] = MFMA32(VPK(0, t), pb[t], O[0]);
    SBAR(); VRD(0, 2); asm volatile("s_waitcnt lgkmcnt(8)" ::: "memory"); SBAR();
#pragma unroll
    for (int t = 0; t < 4; ++t) O[1] = MFMA32(VPK(1, t), pb[t], O[1]);
    SBAR(); VRD(1, 3); asm volatile("s_waitcnt lgkmcnt(8)" ::: "memory"); SBAR();
#pragma unroll
    for (int t = 0; t < 4; ++t) O[2] = MFMA32(VPK(0, t), pb[t], O[2]);
    SBAR(); asm volatile("s_waitcnt lgkmcnt(0)" ::: "memory"); SBAR();
#pragma unroll
    for (int t = 0; t < 4; ++t) O[3] = MFMA32(VPK(1, t), pb[t], O[3]);
}
__device__ __forceinline__ void kread8_swz(bf16x8 (&kf)[8], const unsigned (&ka)[4]) {
#define KRD(i, a, off) asm volatile("ds_read_b128 %0, %1 offset:%c2" : "=&v"(kf[i]) : "v"(a), "i"(off) : "memory")
    KRD(0, ka[0], 0); KRD(1, ka[0], 8192); KRD(2, ka[1], 0); KRD(3, ka[1], 8192); KRD(4, ka[2], 0); KRD(5, ka[2], 8192); KRD(6, ka[3], 0); KRD(7, ka[3], 8192);
#undef KRD
}
__device__ __forceinline__ void kread8(bf16x8 (&kf)[8], unsigned ka) {
#define KRD(i, off) asm volatile("ds_read_b128 %0, %1 offset:%c2" : "=&v"(kf[i]) : "v"(ka), "i"(off) : "memory")
    KRD(0, 0); KRD(1, 512); KRD(2, 2048); KRD(3, 2560); KRD(4, 4096); KRD(5, 4608); KRD(6, 6144); KRD(7, 6656);
#undef KRD
}

__device__ __forceinline__ void da_bias(f32x16& p0, f32x16& p1, int jt, int cq, float xq, float sl2, float B2) {
    const float x = (float)(64 * jt) - xq;
    const float Be = (jt > cq) ? 1.0e30f : B2;
#pragma unroll
    for (int r = 0; r < 16; ++r) { const float kr = (float)((r & 3) + 8 * (r >> 2)); p0[r] = __builtin_fmaf(-sl2, __builtin_fabsf(x + kr), -Be); p1[r] = __builtin_fmaf(-sl2, __builtin_fabsf(x + (32.f + kr)), -Be); }
}
__device__ __forceinline__ void diffattn_unit(LAS unsigned char* lds, int tid, const bf16_t* Qg, const bf16_t* Kg, const bf16_t* Vg, bf16_t* Og, int b, int h, int u, bool desc, float sl2, float B2, float lam, const float* gout, float outmul) {
    asm volatile("" : "+v"(tid));
    const int lane = tid & 63, wid = __builtin_amdgcn_readfirstlane(tid >> 6), map = wid >> 2, wi = wid & 3, r32 = lane & 31, hi = lane >> 5;
    const int q0 = u * 128 + wi * 32, cq = q0 >> 6, NT = 2 * u + 2;
    const size_t rowb = (size_t)b * SEQ;
    const bf16_t* qrow = Qg + (rowb + q0 + r32) * 1024 + h * 128;
    bf16x8 qf[4];
#pragma unroll
    for (int s = 0; s < 4; ++s) qf[s] = *(const bf16x8*)(qrow + map * 64 + s * 16 + hi * 8);
    unsigned koff0, voff0;
    { const int row = 8 * wid + (lane >> 4), slot = lane & 15;
      koff0 = (unsigned)(row * 1024 + ((slot ^ (row & 15)) * 8));
      voff0 = (unsigned)(row * 1024 + (((slot >> 2) ^ (row & 3)) * 32 + (slot & 3) * 8)); }
    const bf16_t* Kbh = Kg + rowb * 1024 + h * 128; const bf16_t* Vbh = Vg + rowb * 1024 + h * 128;
#define JT(i) (desc ? NT - 1 - (i) : (i))
#define DA_DMA(i) do { const int j_ = JT(i), sl_ = (i) & 3; _Pragma("unroll") for (int i_ = 0; i_ < 2; ++i_) { \
        glds16(Kbh + (size_t)j_ * 65536 + (i_ ? (koff0 ^ 32u) + 4096u : koff0), lds + sl_ * 32768 + (2 * wid + i_) * 1024); \
        glds16(Vbh + (size_t)j_ * 65536 + (i_ ? voff0 + 4096u : voff0), lds + sl_ * 32768 + 16384 + (2 * wid + i_) * 1024); } } while (0)
    f32x16 O[4];
#pragma unroll
    for (int db = 0; db < 4; ++db)
#pragma unroll
        for (int r = 0; r < 16; ++r) O[db][r] = 0.f;
    float lsum = 0.f;
    const float xq = (float)(q0 + r32 - 4 * hi);
    unsigned ka_0, va_0;
    { const unsigned l0 = lds_addr((lptr)lds); const int qp = (lane & 15) >> 2;
      ka_0 = l0 + r32 * 256 + (((map * 8 + hi) ^ (r32 & 15)) << 4);
      va_0 = l0 + 16384 + (4 * hi + qp) * 256 + (qp << 6) + ((lane >> 4) & 1) * 32 + (lane & 3) * 8; }
    __syncthreads();
    asm volatile("" : "+v"(qf[0]), "+v"(qf[1]), "+v"(qf[2]), "+v"(qf[3]));
    DA_DMA(0); DA_DMA(1);
    if (NT > 2) { DA_DMA(2); asm volatile("s_waitcnt vmcnt(4)" ::: "memory"); } else asm volatile("s_waitcnt vmcnt(0)" ::: "memory");
    __builtin_amdgcn_s_barrier();
    f32x16 pA0, pA1, pB0, pB1;
    { da_bias(pA0, pA1, JT(0), cq, xq, sl2, B2);
      unsigned ka[4];
#pragma unroll
      for (int s = 0; s < 4; ++s) ka[s] = ka_0 ^ (s << 5);
      bf16x8 kf[8]; kread8_swz(kf, ka); asm volatile("s_waitcnt lgkmcnt(0)" ::: "memory"); SBAR();
#pragma unroll
      for (int s = 0; s < 4; ++s) { pA0 = MFMA32(kf[2 * s], qf[s], pA0); pA1 = MFMA32(kf[2 * s + 1], qf[s], pA1); }
      asm volatile("s_nop 15\n\ts_nop 15" : "+v"(pA0), "+v"(pA1)); }
    da_bias(pB0, pB1, JT(1), cq, xq, sl2, B2);
#define SM4(P, b_) do { P[b_] = __builtin_amdgcn_exp2f(P[b_]); P[b_ + 1] = __builtin_amdgcn_exp2f(P[b_ + 1]); P[b_ + 2] = __builtin_amdgcn_exp2f(P[b_ + 2]); P[b_ + 3] = __builtin_amdgcn_exp2f(P[b_ + 3]); \
        lsum += (P[b_] + P[b_ + 1]) + (P[b_ + 2] + P[b_ + 3]); } while (0)
#define MFMA_A(acc, a_, b_) asm volatile("v_mfma_f32_32x32x16_bf16 %0, %1, %2, %0" : "+v"(acc) : "v"(a_), "v"(b_))
#define PIN(x_) asm volatile("" : "+v"(x_))
#define FMK(dst, krv) do { float f_; asm volatile("v_fmamk_f32 %0, %1, %c2, %3" : "=v"(f_) : "v"(sl2), "i"(__builtin_bit_cast(int, (float)(krv))), "v"(c0_)); dst = f_; } while (0)
#define FM2(C0, C1, j) do { FMK(C0[j], ((j) & 3) + 8 * ((j) >> 2)); FMK(C1[j], 32 + ((j) & 3) + 8 * ((j) >> 2)); } while (0)
#define DA_STEP(C0, C1, N0, N1, i) do { \
        if ((i) + 3 < NT) DA_DMA((i) + 3); \
        bf16x8 pb[4]; \
        { unsigned ka[4]; _Pragma("unroll") for (int s_ = 0; s_ < 4; ++s_) ka[s_] = (ka_0 + (((i) + 1) & 3) * 32768) ^ (s_ << 5); \
          bf16x8 kf[8]; kread8_swz(kf, ka); \
          s16x4 lo[2][4], hi[2][4]; unsigned va[4]; _Pragma("unroll") for (int d_ = 0; d_ < 4; ++d_) va[d_] = (va_0 + ((i) & 3) * 32768) ^ (d_ << 6); \
          SM4(C0, 0);  PIN(C0); PIN(lsum); SM4(C0, 4);  PIN(C0); PIN(lsum);                        \
          asm volatile("s_waitcnt lgkmcnt(0)" ::: "memory"); \
          MFMA_A(N0, kf[0], qf[0]); SM4(C0, 8);  PIN(C0); PIN(lsum); \
          MFMA_A(N1, kf[1], qf[0]); SM4(C0, 12); PIN(C0); PIN(lsum); \
          MFMA_A(N0, kf[2], qf[1]); pb[0] = pack8(C0, 0); PIN(pb[0]); \
          MFMA_A(N1, kf[3], qf[1]); pb[1] = pack8(C0, 8); PIN(pb[1]); \
          MFMA_A(N0, kf[4], qf[2]); \
          MFMA_A(N1, kf[5], qf[2]); \
          VRT(0, 0);                                                                                    \
          MFMA_A(N0, kf[6], qf[3]); \
          MFMA_A(N1, kf[7], qf[3]); \
          const int jt2_ = JT((i) + 2); \
          float c0_ = __builtin_fmaf(sl2s, (float)(64 * jt2_) - xq, (jt2_ > cq) ? -1.0e30f : -B2); PIN(c0_); \
            \
          VRT(1, 1); asm volatile("s_waitcnt lgkmcnt(8)" ::: "memory"); \
          { const bf16x8 v0_ = VPK(0, 0); MFMA_A(O[0], v0_, pb[0]); SM4(C1, 0); PIN(C1); PIN(lsum); const bf16x8 v1_ = VPK(0, 1); MFMA_A(O[1], v1_, pb[0]); \
            const bf16x8 v2_ = VPK(0, 2); MFMA_A(O[2], v2_, pb[0]); SM4(C1, 4); PIN(C1); PIN(lsum); const bf16x8 v3_ = VPK(0, 3); MFMA_A(O[3], v3_, pb[0]); } \
          VRT(0, 2); asm volatile("s_waitcnt lgkmcnt(8)" ::: "memory"); \
          { const bf16x8 v0_ = VPK(1, 0); MFMA_A(O[0], v0_, pb[1]); SM4(C1, 8); PIN(C1); PIN(lsum); const bf16x8 v1_ = VPK(1, 1); MFMA_A(O[1], v1_, pb[1]); pb[2] = pack8(C1, 0); PIN(pb[2]); \
            const bf16x8 v2_ = VPK(1, 2); MFMA_A(O[2], v2_, pb[1]); SM4(C1, 12); PIN(C1); PIN(lsum); const bf16x8 v3_ = VPK(1, 3); MFMA_A(O[3], v3_, pb[1]); pb[3] = pack8(C1, 8); PIN(pb[3]); } \
          VRT(1, 3); asm volatile("s_waitcnt lgkmcnt(8)" ::: "memory"); \
          _Pragma("unroll") for (int d_ = 0; d_ < 4; ++d_) { const bf16x8 vf_ = VPK(0, d_); MFMA_A(O[d_], vf_, pb[2]); FM2(C0, C1, 4 * d_); FM2(C0, C1, 4 * d_ + 1); } \
          asm volatile("s_waitcnt lgkmcnt(0)" ::: "memory"); \
          _Pragma("unroll") for (int d_ = 0; d_ < 4; ++d_) { const bf16x8 vf_ = VPK(1, d_); MFMA_A(O[d_], vf_, pb[3]); FM2(C0, C1, 4 * d_ + 2); FM2(C0, C1, 4 * d_ + 3); } \
          PIN(C0); PIN(C1); \
          if (jt2_ == cq) { da_bias(C0, C1, jt2_, cq, xq, sl2, B2); PIN(C0); PIN(C1); } } \
        if ((i) + 3 < NT) asm volatile("s_waitcnt vmcnt(4) lgkmcnt(0)" ::: "memory"); else asm volatile("s_waitcnt vmcnt(0) lgkmcnt(0)" ::: "memory"); \
        __builtin_amdgcn_s_barrier(); \
    } while (0)
    const float sl2s = __builtin_bit_cast(float, __builtin_amdgcn_readfirstlane(__builtin_bit_cast(int, sl2)));
    asm volatile(DA_LOOP_ALIGN ::: "memory");
#pragma unroll 1
    for (int i = 0; i < NT; i += 2) {
        DA_STEP(pA0, pA1, pB0, pB1, i);
        DA_STEP(pB0, pB1, pA0, pA1, i + 1);
    }
#undef DA_STEP
#undef FM2
#undef FMK
#undef MFMA_A
#undef PIN
#undef SM4
    asm volatile("s_nop 15\n\ts_nop 15" : "+v"(O[0]), "+v"(O[1]), "+v"(O[2]), "+v"(O[3]));
#undef DA_DMA
#undef JT
    lsum += __shfl_xor(lsum, 32);
    const float inv = 1.0f / lsum;
    LAS f32x4* xch = (LAS f32x4*)(lds + wi * 16384) + lane;
    if (map == 1) {
        const float f = lam * inv;
#pragma unroll
        for (int db = 0; db < 4; ++db)
#pragma unroll
            for (int g = 0; g < 4; ++g) xch[(db * 4 + g) * 64] = (f32x4){O[db][4 * g] * f, O[db][4 * g + 1] * f, O[db][4 * g + 2] * f, O[db][4 * g + 3] * f};
    }
    __syncthreads();
    if (map == 0) {
        float ss = 0.f;
#pragma unroll
        for (int db = 0; db < 4; ++db)
#pragma unroll
            for (int g = 0; g < 4; ++g) { const f32x4 o1 = xch[(db * 4 + g) * 64];
#pragma unroll
                for (int i = 0; i < 4; ++i) { const float v = O[db][4 * g + i] * inv - o1[i]; O[db][4 * g + i] = v; ss += v * v; } }
        ss += __shfl_xor(ss, 32);
        const float rr = __builtin_amdgcn_rsqf(ss * (1.f / 128.f) + 1e-6f) * outmul;
        bf16_t* orow = Og + (rowb + q0 + r32) * 1024 + h * 128 + 4 * hi;
#pragma unroll
        for (int db = 0; db < 4; ++db)
#pragma unroll
            for (int g = 0; g < 4; ++g) { const f32x4 gv = *(const f32x4*)(gout + 32 * db + 8 * g + 4 * hi);
                const unsigned w0 = pk_bf16(O[db][4 * g] * rr * gv[0], O[db][4 * g + 1] * rr * gv[1]), w1 = pk_bf16(O[db][4 * g + 2] * rr * gv[2], O[db][4 * g + 3] * rr * gv[3]);
                *(unsigned long long*)(orow + 32 * db + 8 * g) = (unsigned long long)w0 | ((unsigned long long)w1 << 32); }
    }
    __syncthreads();
}

__device__ __forceinline__ void memattn_unit(LAS unsigned char* lds, int tid, bf16_t* MQg, bf16_t* Og, const bf16_t* KVg, const float* mqss, const float* qn, const float* kn, int pm, int hd, float Bm) {
    const int lane = tid & 63, wid = __builtin_amdgcn_readfirstlane(tid >> 6), r32 = lane & 31, hi = lane >> 5;
    const int b = pm >> 3; const size_t row = (size_t)pm * 256 + wid * 32 + r32;
    __syncthreads();
#pragma unroll
    for (int i = 0; i < 8; ++i) { const int p = 8 * wid + i, vrow = 4 * p + (lane >> 4), slot = lane & 15;
        glds16(KVg + ((size_t)b * MEML + vrow) * 2048 + 512 + hd * 128 + (((slot >> 2) ^ (vrow & 3)) * 32 + (slot & 3) * 8), lds + 65536 + p * 1024); }
    { const int key = tid >> 1, half = tid & 1; const bf16_t* src = KVg + ((size_t)b * MEML + key) * 2048 + hd * 128 + half * 64;
      v4u raw[8]; float s = 0.f;
#pragma unroll
      for (int c = 0; c < 8; ++c) { raw[c] = *(const v4u*)(src + c * 8);
          const float a0 = bf_lo(raw[c].x), a1 = bf_hi(raw[c].x), a2 = bf_lo(raw[c].y), a3 = bf_hi(raw[c].y), a4 = bf_lo(raw[c].z), a5 = bf_hi(raw[c].z), a6 = bf_lo(raw[c].w), a7 = bf_hi(raw[c].w);
          s += ((a0 * a0 + a1 * a1) + (a2 * a2 + a3 * a3)) + ((a4 * a4 + a5 * a5) + (a6 * a6 + a7 * a7)); }
      s += __shfl_xor(s, 1);
      const float rk = __builtin_amdgcn_rsqf(s * (1.f / 128.f) + 1e-6f) * MEMSCALE;
#pragma unroll
      for (int c = 0; c < 8; ++c) { const int d0 = half * 64 + c * 8; const f32x4 qa = *(const f32x4*)(qn + d0), qb = *(const f32x4*)(qn + d0 + 4), ka = *(const f32x4*)(kn + d0), kb = *(const f32x4*)(kn + d0 + 4);
          v4u w; w.x = pk_bf16(bf_lo(raw[c].x) * rk * qa[0] * ka[0], bf_hi(raw[c].x) * rk * qa[1] * ka[1]); w.y = pk_bf16(bf_lo(raw[c].y) * rk * qa[2] * ka[2], bf_hi(raw[c].y) * rk * qa[3] * ka[3]);
          w.z = pk_bf16(bf_lo(raw[c].z) * rk * qb[0] * kb[0], bf_hi(raw[c].z) * rk * qb[1] * kb[1]); w.w = pk_bf16(bf_lo(raw[c].w) * rk * qb[2] * kb[2], bf_hi(raw[c].w) * rk * qb[3] * kb[3]);
          *(LAS v4u*)(lds + (key >> 6) * 16384 + (half * 8 + c) * 1024 + (key & 63) * 16) = w; } }
    const bf16_t* qrow = MQg + row * 512 + hd * 128;
    bf16x8 qf[8];
#pragma unroll
    for (int s = 0; s < 8; ++s) qf[s] = *(const bf16x8*)(qrow + s * 16 + hi * 8);
    const float rq = __builtin_amdgcn_rsqf((mqss[row * 8 + hd * 2] + mqss[row * 8 + hd * 2 + 1]) * (1.f / 128.f) + 1e-6f);
    f32x16 O[4];
#pragma unroll
    for (int db = 0; db < 4; ++db)
#pragma unroll
        for (int r = 0; r < 16; ++r) O[db][r] = 0.f;
    float lsum = 0.f;
    const lptr kl0 = (lptr)lds + hi * 1024 + r32 * 16;
    unsigned va0[4];
    { const int qp = (lane & 15) >> 2;
#pragma unroll
      for (int db = 0; db < 4; ++db) va0[db] = lds_addr((lptr)lds) + 65536 + (4 * hi + qp) * 256 + ((db ^ qp) * 64) + ((lane >> 4) & 1) * 32 + (lane & 3) * 8; }
    __syncthreads();
#pragma unroll 1
    for (int tl = 0; tl < 4; ++tl) {
        f32x16 p0, p1;
#pragma unroll
        for (int r = 0; r < 16; ++r) { p0[r] = 0.f; p1[r] = 0.f; }
        bf16x8 kf[8], kg[8]; kread8(kf, lds_addr(kl0) + tl * 16384); kread8(kg, lds_addr(kl0) + tl * 16384 + 8192);
        asm volatile("s_waitcnt lgkmcnt(8)" ::: "memory"); SBAR();
#pragma unroll
        for (int s = 0; s < 4; ++s) { p0 = MFMA32(kf[2 * s], qf[s], p0); p1 = MFMA32(kf[2 * s + 1], qf[s], p1); }
        SBAR(); asm volatile("s_waitcnt lgkmcnt(0)" ::: "memory"); SBAR();
#pragma unroll
        for (int s = 0; s < 4; ++s) { p0 = MFMA32(kg[2 * s], qf[4 + s], p0); p1 = MFMA32(kg[2 * s + 1], qf[4 + s], p1); }
#pragma unroll
        for (int r = 0; r < 16; ++r) { p0[r] = __builtin_amdgcn_exp2f(__builtin_fmaf(p0[r], rq, -Bm)); p1[r] = __builtin_amdgcn_exp2f(__builtin_fmaf(p1[r], rq, -Bm)); lsum += p0[r] + p1[r]; }
        bf16x8 pb[4]; pb[0] = pack8(p0, 0); pb[1] = pack8(p0, 8); pb[2] = pack8(p1, 0); pb[3] = pack8(p1, 8);
        unsigned va[4];
#pragma unroll
        for (int db = 0; db < 4; ++db) va[db] = va0[db] + tl * 16384;
        pv_tile(O, va, pb);
    }
    lsum += __shfl_xor(lsum, 32);
    const float inv = 1.0f / lsum;
    bf16_t* orow = Og + row * 512 + hd * 128 + 4 * hi;
#pragma unroll
    for (int db = 0; db < 4; ++db)
#pragma unroll
        for (int g = 0; g < 4; ++g) { const unsigned w0 = pk_bf16(O[db][4 * g] * inv, O[db][4 * g + 1] * inv), w1 = pk_bf16(O[db][4 * g + 2] * inv, O[db][4 * g + 3] * inv);
            *(unsigned long long*)(orow + 32 * db + 8 * g) = (unsigned long long)w0 | ((unsigned long long)w1 << 32); }
}

__device__ __forceinline__ void pool_unit(LAS unsigned char* lds, int tid, const bf16_t* Pg, bf16_t* Og, const bf16_t* Wt, const float* scale, int tok0, int g) {
    const int lane = tid & 63, wid = __builtin_amdgcn_readfirstlane(tid >> 6), r32 = lane & 31, hi = lane >> 5;
    LAS unsigned char* Lp = lds; LAS unsigned char* Ld = lds + 272 * 256;
    const int w = 2 << g, pos0 = tok0 & (SEQ - 1);
    __syncthreads();
    { v4u st[9];
#pragma unroll
      for (int k = 0; k < 9; ++k) { const int i = tid + k * NTHR, ii = i < 272 * 16 ? i : tid, rr = ii >> 4, ch = ii & 15; const bool ok = pos0 - 16 + rr >= 0;
          const v4u v = *(const v4u*)(Pg + (size_t)(tok0 - 16 + (ok ? rr : 16)) * 512 + g * 128 + ch * 8); st[k].x = ok ? v.x : 0u; st[k].y = ok ? v.y : 0u; st[k].z = ok ? v.z : 0u; st[k].w = ok ? v.w : 0u; }
#pragma unroll
      for (int k = 0; k < 9; ++k) { const int i = tid + k * NTHR, rr = i >> 4, ch = i & 15; if (i < 272 * 16) *(LAS v4u*)(Lp + rr * 256 + ch * 16) = st[k]; } }
    bf16x8 wf[4][8];
#pragma unroll
    for (int db = 0; db < 4; ++db)
#pragma unroll
        for (int s = 0; s < 8; ++s) wf[db][s] = *(const bf16x8*)(Wt + (size_t)(32 * db + r32) * 128 + hi * 8 + s * 16);
    __syncthreads();
    { const int ch = tid & 15, t0 = (tid >> 4) * 8;
      float s[8];
#pragma unroll
      for (int i = 0; i < 8; ++i) s[i] = 0.f;
#pragma unroll 1
      for (int k = 1; k < w; ++k) { const v4u v = *(const LAS v4u*)(Lp + (16 + t0 - k) * 256 + ch * 16);
          s[0] += bf_lo(v.x); s[1] += bf_hi(v.x); s[2] += bf_lo(v.y); s[3] += bf_hi(v.y); s[4] += bf_lo(v.z); s[5] += bf_hi(v.z); s[6] += bf_lo(v.w); s[7] += bf_hi(v.w); }
#pragma unroll
      for (int tt = 0; tt < 8; ++tt) { const int t = t0 + tt, tpos = pos0 + t; const int cnt = (tpos + 1 < w) ? (tpos + 1) : w; const float ic = 1.0f / (float)cnt;
          const v4u v = *(const LAS v4u*)(Lp + (16 + t) * 256 + ch * 16), o = *(const LAS v4u*)(Lp + (16 + t - w + 1) * 256 + ch * 16);
          float p[8] = {bf_lo(v.x), bf_hi(v.x), bf_lo(v.y), bf_hi(v.y), bf_lo(v.z), bf_hi(v.z), bf_lo(v.w), bf_hi(v.w)};
          float q[8] = {bf_lo(o.x), bf_hi(o.x), bf_lo(o.y), bf_hi(o.y), bf_lo(o.z), bf_hi(o.z), bf_lo(o.w), bf_hi(o.w)};
          float d[8];
#pragma unroll
          for (int i = 0; i < 8; ++i) { s[i] += p[i]; d[i] = s[i] * ic - p[i]; s[i] -= q[i]; }
          v4u wv; wv.x = pk_bf16(d[0], d[1]); wv.y = pk_bf16(d[2], d[3]); wv.z = pk_bf16(d[4], d[5]); wv.w = pk_bf16(d[6], d[7]);
          *(LAS v4u*)(Ld + t * 256 + ((ch ^ (t & 15)) << 4)) = wv; } }
    __syncthreads();
    const int tok = wid * 32 + r32;
    bf16x8 df[8];
#pragma unroll
    for (int s = 0; s < 8; ++s) df[s] = *(const LAS bf16x8*)(Ld + tok * 256 + (((2 * s + hi) ^ (tok & 15)) << 4));
    bf16_t* orow = Og + (size_t)(tok0 + tok) * 512 + g * 128 + 4 * hi;
#pragma unroll
    for (int db = 0; db < 4; ++db) {
        f32x16 acc;
#pragma unroll
        for (int r = 0; r < 16; ++r) acc[r] = 0.f;
#pragma unroll
        for (int s = 0; s < 8; ++s) acc = MFMA32(wf[db][s], df[s], acc);
#pragma unroll
        for (int gq = 0; gq < 4; ++gq) { const f32x4 sc = *(const f32x4*)(scale + 32 * db + 8 * gq + 4 * hi);
            const unsigned w0 = pk_bf16(acc[4 * gq] * sc[0], acc[4 * gq + 1] * sc[1]), w1 = pk_bf16(acc[4 * gq + 2] * sc[2], acc[4 * gq + 3] * sc[3]);
            *(unsigned long long*)(orow + 32 * db + 8 * gq) = (unsigned long long)w0 | ((unsigned long long)w1 << 32); }
    }
}
#undef MFMA32
#undef VRD
#undef VPK
#undef SBAR
}

#ifndef MIX_NAIVE_DA
#define MIX_NAIVE_DA 0
#endif
#ifndef MIX_NAIVE_MEM
#define MIX_NAIVE_MEM 0
#endif
#ifndef MIX_NAIVE_POOL
#define MIX_NAIVE_POOL 0
#endif
__device__ __forceinline__ void phase_mixers(unsigned char* ws, LAS unsigned char* lds, int l, int tid) {
    const float* prm = (const float*)(ws + WS_PARAM); const float* sc = (const float*)(ws + WS_SC) + l * 8;
    const float lam = ld_f32_agent(sc + 0), bnd0 = ld_f32_agent(sc + 1), bnd1 = ld_f32_agent(sc + 2), bndm = ld_f32_agent(sc + 3), omul = ld_f32_agent(sc + 4);
    const int bx = blockIdx.x, vcu = (gridDim.x == 256) ? ((bx & 7) * 32 + (bx >> 3)) : bx;
    bf16_t* Q = (bf16_t*)(ws + WS_Q); const bf16_t* K = (const bf16_t*)(ws + WS_K); const bf16_t* V = (const bf16_t*)(ws + WS_V);
    bf16_t* MQ = (bf16_t*)(ws + WS_MQ); const bf16_t* KV = (const bf16_t*)(ws + WS_MEMKV) + l * 1024;     const float* mqss = (const float*)(ws + WS_MQSS);
#if MIX_NAIVE_DA
    for (int u = blockIdx.x; u < 4096; u += gridDim.x) { const int hc = 63 - (u >> 6), c = hc >> 1, bh = u & 63, b = bh >> 3, h = bh & 7;
        const size_t rowb = (size_t)b * SEQ; const float slope2 = exp2f(-(float)(h + 1)) * LOG2E;
        naive_attn_unit<true>(lds, tid, Q + (rowb + hc * 32) * 1024 + h * 128, 1024, K + rowb * 1024 + h * 128, 1024, V + rowb * 1024 + h * 128, 1024, (bf16_t*)(ws + WS_XB) + (rowb + hc * 32) * 1024 + h * 128, 1024,
                              c + 1, hc * 32, nullptr, nullptr, nullptr, slope2, bnd0, bnd1, lam, prm + PB_GOUT + l * 128, omul); }
#else
    {
        const float B2 = fmaxf(bnd0, bnd1);
        for (int rep_ = 0; rep_ < REP_DA; ++rep_)
        for (int w = vcu; w < 256; w += gridDim.x) { const int bh = w >> 2, s = w & 3, b = bh >> 3, h = bh & 7; const float sl2 = exp2f(-(float)(h + 1)) * LOG2E;
#pragma unroll 1
            for (int i = 0; i < 4; ++i) { const int u = (i == 0) ? 15 - s : (i == 1) ? 8 + s : (i == 2) ? 7 - s : s;
                mix::diffattn_unit(lds, tid, Q, K, V, (bf16_t*)(ws + WS_XB), b, h, u, (i & 1) != 0, sl2, B2, lam, prm + PB_GOUT + l * 128, omul); } }
    }
#endif
#if MIX_NAIVE_MEM
    for (int u = blockIdx.x; u < 2048; u += gridDim.x) { const int qt = u >> 2, hd = u & 3, b = qt >> 6; const size_t row0 = (size_t)qt * 32;
        naive_attn_unit<false>(lds, tid, MQ + row0 * 512 + hd * 128, 512, KV + (size_t)b * MEML * 2048 + hd * 128, 2048, KV + (size_t)b * MEML * 2048 + 512 + hd * 128, 2048, MQ + row0 * 512 + hd * 128, 512,
                               4, 0, prm + PB_MQN + l * 128, prm + PB_MKN + l * 128, mqss + row0 * 8 + hd * 2, 0.f, bndm, 0.f, 0.f, nullptr, 1.f); }
#else
    for (int rep_ = 0; rep_ < REP_MEM; ++rep_)
    for (int w = vcu; w < 256; w += gridDim.x) mix::memattn_unit(lds, tid, MQ, (rep_ + 1 < REP_MEM) ? (bf16_t*)(ws + WS_OPOOL) : MQ, KV, mqss, prm + PB_MQN + l * 128, prm + PB_MKN + l * 128, w >> 2, w & 3, bndm);
#endif
#if MIX_NAIVE_POOL
    for (int u = blockIdx.x; u < 1024; u += gridDim.x) { const int tt = u >> 2, g = u & 3;
        naive_pool_unit(lds, tid, (const bf16_t*)(ws + WS_P), (bf16_t*)(ws + WS_OPOOL), prm + PB_POOLW + (size_t)(l * 4 + g) * 128 * 128, prm + PB_POOLS + l * 512 + g * 128, tt * 64, g); }
#else
    for (int rep_ = 0; rep_ < REP_POOL; ++rep_)
    for (int w = vcu; w < 256; w += gridDim.x) { const int pm = w >> 2, g = w & 3;
        mix::pool_unit(lds, tid, (const bf16_t*)(ws + WS_P), (bf16_t*)(ws + WS_OPOOL), (const bf16_t*)(ws + WS_POOLWT) + (size_t)(l * 4 + g) * 128 * 128, prm + PB_POOLS + l * 512 + g * 128, pm * 256, g); }
#endif
}

__device__ __forceinline__ void phase_route(unsigned char* ws, const bf16_t* xin, LAS unsigned char* lds, int tid, int lane, int wave) {
    const float* gffn = (const float*)(ws + WS_PARAM) + PB_GFFN1; const float* wr = (const float*)(ws + WS_PARAM) + PB_WR;
    unsigned* cnt = (unsigned*)ws + CW_WCNT + 8 * blockIdx.x; int* toke = (int*)(ws + WS_TOKE); int* tokp = (int*)(ws + WS_TOKP); float* tokg = (float*)(ws + WS_TOKG); float* tokr = (float*)(ws + WS_TOKR);
    LAS unsigned* lcnt = (LAS unsigned*)lds; LAS unsigned* lbase = lcnt + 8; LAS int* linfo = (LAS int*)(lds + 64);
    const int per = T / gridDim.x;
    f32x4 wg0[16], wg1[16];
#pragma unroll
    for (int kk = 0; kk < 16; ++kk) { const int k = 16 * lane + kk; const float g = gffn[k]; wg0[kk] = *(const f32x4*)(wr + k * 8) * g; wg1[kk] = *(const f32x4*)(wr + k * 8 + 4) * g; }
    if (tid < 8) lbase[tid] = 0u;
    for (int c0 = 0; c0 < per; c0 += 64) {
        __syncthreads();
        if (tid < 8) lcnt[tid] = 0u;
        __syncthreads();
        v4u raw[8][2];
#pragma unroll
        for (int q = 0; q < 8; ++q) { const int i = wave + q * NWAVES; const int t = blockIdx.x * per + ((c0 + i < per) ? c0 + i : 0); const bf16_t* p = xin + (size_t)t * D + 16 * lane; raw[q][0] = *(const v4u*)p; raw[q][1] = *(const v4u*)(p + 8); }
#pragma unroll
        for (int q = 0; q < 8; ++q) { const int i = wave + q * NWAVES; if (c0 + i >= per) break;
            const int t = blockIdx.x * per + c0 + i;
            f32x4 v[4]; { const v4u a_ = raw[q][0], b_ = raw[q][1];
              v[0] = (f32x4){bf_lo(a_.x), bf_hi(a_.x), bf_lo(a_.y), bf_hi(a_.y)}; v[1] = (f32x4){bf_lo(a_.z), bf_hi(a_.z), bf_lo(a_.w), bf_hi(a_.w)};
              v[2] = (f32x4){bf_lo(b_.x), bf_hi(b_.x), bf_lo(b_.y), bf_hi(b_.y)}; v[3] = (f32x4){bf_lo(b_.z), bf_hi(b_.z), bf_lo(b_.w), bf_hi(b_.w)}; }
            float s = 0.f;
#pragma unroll
            for (int j = 0; j < 4; ++j) s += (v[j][0] * v[j][0] + v[j][1] * v[j][1]) + (v[j][2] * v[j][2] + v[j][3] * v[j][3]);
            const float rstd = __builtin_amdgcn_rsqf(wave_sum(s) * (1.f / 1024.f) + 1e-6f);
            float lg[8];
#pragma unroll
            for (int e = 0; e < 8; ++e) lg[e] = 0.f;
#pragma unroll
            for (int j = 0; j < 4; ++j)
#pragma unroll
                for (int k4 = 0; k4 < 4; ++k4) { const float xv = v[j][k4]; const f32x4 w0 = wg0[4 * j + k4], w1 = wg1[4 * j + k4];
                    lg[0] += xv * w0[0]; lg[1] += xv * w0[1]; lg[2] += xv * w0[2]; lg[3] += xv * w0[3]; lg[4] += xv * w1[0]; lg[5] += xv * w1[1]; lg[6] += xv * w1[2]; lg[7] += xv * w1[3]; }
#pragma unroll
            for (int e = 0; e < 8; ++e) lg[e] = wave_sum(lg[e]) * rstd;
            int i0 = 0; float b0 = lg[0];
#pragma unroll
            for (int e = 1; e < 8; ++e) if (lg[e] > b0) { b0 = lg[e]; i0 = e; }
            int i1 = -1; float b1 = -3.0e38f;
#pragma unroll
            for (int e = 0; e < 8; ++e) if (e != i0 && lg[e] > b1) { b1 = lg[e]; i1 = e; }
            const float g0 = 1.f / (1.f + __expf(b1 - b0)), g1 = 1.f - g0;
            if (lane == 0) { const unsigned p0 = __hip_atomic_fetch_add(lcnt + i0, 1u, __ATOMIC_RELAXED, __HIP_MEMORY_SCOPE_WORKGROUP), p1 = __hip_atomic_fetch_add(lcnt + i1, 1u, __ATOMIC_RELAXED, __HIP_MEMORY_SCOPE_WORKGROUP);
                linfo[i * 4 + 0] = i0; linfo[i * 4 + 1] = i1; linfo[i * 4 + 2] = (int)p0; linfo[i * 4 + 3] = (int)p1;
                toke[2 * t] = i0; toke[2 * t + 1] = i1; tokg[2 * t] = g0; tokg[2 * t + 1] = g1; tokr[t] = rstd; }
        }
        __syncthreads();
        if (tid < 64 && c0 + tid < per) { const int t = blockIdx.x * per + c0 + tid; tokp[2 * t] = (int)lbase[linfo[tid * 4 + 0]] + linfo[tid * 4 + 2]; tokp[2 * t + 1] = (int)lbase[linfo[tid * 4 + 1]] + linfo[tid * 4 + 3]; }
        __syncthreads();
        if (tid < 8) lbase[tid] += lcnt[tid];
    }
    __syncthreads();
    if (tid < 8) cnt[tid] = lbase[tid];
}
__device__ __forceinline__ void build_texp(unsigned char* ws, LAS int* texp, int tid) {
    const unsigned* cnt = (const unsigned*)ws + CW_CNT;
    __syncthreads();
    if (tid == 0) { int tb = 0; for (int e = 0; e < NEXP; ++e) { texp[160 + e] = tb; const int n = (int)__hip_atomic_load(cnt + 64 * e, RLX_AGENT); const int nt = (n + 255) >> 8; for (int i = 0; i < nt; ++i) texp[tb + i] = e; tb += nt; } texp[168] = tb; texp[169] = tb; }
    __syncthreads();
}
__device__ __forceinline__ void scan_counts(unsigned char* ws, LAS int* texp, LAS int* wbase, int tid, int lane, int wave) {
    const unsigned* wcnt = (const unsigned*)ws + CW_WCNT; const int G = gridDim.x;
    __syncthreads();
    { int c[4], s = 0;
#pragma unroll
      for (int i = 0; i < 4; ++i) { const int w = 4 * lane + i; c[i] = (w < G) ? (int)__hip_atomic_load(wcnt + 8 * w + wave, RLX_AGENT) : 0; s += c[i]; }
      int inc = s;
#pragma unroll
      for (int o = 1; o < 64; o <<= 1) { const int v = __shfl_up(inc, o); if (lane >= o) inc += v; }
      int ex = inc - s;
#pragma unroll
      for (int i = 0; i < 4; ++i) { wbase[(4 * lane + i) * 8 + wave] = ex; ex += c[i]; }
      if (lane == 63) { texp[176 + wave] = inc; if (blockIdx.x == 0) __hip_atomic_store((unsigned*)ws + CW_CNT + 64 * wave, (unsigned)inc, RLX_AGENT); } }
    __syncthreads();
    if (tid == 0) { int tb = 0; for (int e = 0; e < NEXP; ++e) { texp[160 + e] = tb; const int nt = (texp[176 + e] + 255) >> 8; for (int i = 0; i < nt; ++i) texp[tb + i] = e; tb += nt; } texp[168] = tb; texp[169] = tb; }
    __syncthreads();
}
__device__ __forceinline__ void phase_gather(unsigned char* ws, const bf16_t* xin, LAS int* texp, const LAS int* wbase, int lane, int wave) {
    const int* toke = (const int*)(ws + WS_TOKE); int* tokp = (int*)(ws + WS_TOKP); const float* tokr = (const float*)(ws + WS_TOKR); const int per = T / gridDim.x;
    unsigned char* xg = ws + WS_XGY; float* xgrs = (float*)(ws + WS_XGRS);
    const int gw = blockIdx.x * NWAVES + wave, NGW = gridDim.x * NWAVES;
    for (int t = gw; t < T; t += NGW) {
        f32x4 v[4]; ld16_bf16(xin + (size_t)t * D + 16 * lane, v); float mx = 0.f;
#pragma unroll
        for (int j = 0; j < 4; ++j) { mx = fmaxf(mx, fmaxf(fmaxf(fabsf(v[j][0]), fabsf(v[j][1])), fmaxf(fabsf(v[j][2]), fabsf(v[j][3])))); }
#pragma unroll
        for (int o = 1; o < 64; o <<= 1) mx = fmaxf(mx, __shfl_xor(mx, o));
        const float inv = mx > 0.f ? 127.0f / mx : 0.f, rs = mx * (1.0f / 127.0f) * tokr[t];
        v4u w; w.x = pk_i8x4(v[0][0] * inv, v[0][1] * inv, v[0][2] * inv, v[0][3] * inv); w.y = pk_i8x4(v[1][0] * inv, v[1][1] * inv, v[1][2] * inv, v[1][3] * inv);
        w.z = pk_i8x4(v[2][0] * inv, v[2][1] * inv, v[2][2] * inv, v[2][3] * inv); w.w = pk_i8x4(v[3][0] * inv, v[3][1] * inv, v[3][2] * inv, v[3][3] * inv);
#pragma unroll
        for (int k = 0; k < 2; ++k) { const int e = toke[2 * t + k], p = tokp[2 * t + k] + wbase[(t / per) * 8 + e]; const size_t row = (size_t)texp[160 + e] * 256 + p;
            *((v4u*)(xg + row * D) + lane) = w; if (lane == 0) { xgrs[row] = rs; tokp[2 * t + k] = p; } }
    }
}
__device__ __forceinline__ void phase_combine(unsigned char* ws, const bf16_t* xs, float* dst, LAS int* texp, int lane, int wave) {
    const int* toke = (const int*)(ws + WS_TOKE); const int* tokp = (const int*)(ws + WS_TOKP); const float* tokg = (const float*)(ws + WS_TOKG);
    const bf16_t* Y = (const bf16_t*)(ws + WS_Y);
    const int gw = blockIdx.x * NWAVES + wave, NGW = gridDim.x * NWAVES;
    for (int t = gw; t < T; t += NGW) {
        const size_t r0 = (size_t)texp[160 + toke[2 * t]] * 256 + tokp[2 * t], r1 = (size_t)texp[160 + toke[2 * t + 1]] * 256 + tokp[2 * t + 1]; const float g0 = tokg[2 * t], g1 = tokg[2 * t + 1];
        f32x4 xv[4]; ld16_bf16(xs + (size_t)t * D + 16 * lane, xv);
        const v4u* y0 = (const v4u*)(Y + r0 * D) + 2 * lane; const v4u* y1 = (const v4u*)(Y + r1 * D) + 2 * lane;
#pragma unroll
        for (int h = 0; h < 2; ++h) { const v4u p = y0[h], q = y1[h]; f32x4 xa = xv[2 * h], xc = xv[2 * h + 1];
            xa[0] += g0 * bf_lo(p.x) + g1 * bf_lo(q.x); xa[1] += g0 * bf_hi(p.x) + g1 * bf_hi(q.x); xa[2] += g0 * bf_lo(p.y) + g1 * bf_lo(q.y); xa[3] += g0 * bf_hi(p.y) + g1 * bf_hi(q.y);
            xc[0] += g0 * bf_lo(p.z) + g1 * bf_lo(q.z); xc[1] += g0 * bf_hi(p.z) + g1 * bf_hi(q.z); xc[2] += g0 * bf_lo(p.w) + g1 * bf_lo(q.w); xc[3] += g0 * bf_hi(p.w) + g1 * bf_hi(q.w);
            f32x4* xw = (f32x4*)(dst + (size_t)t * D) + 4 * lane; xw[2 * h] = xa; xw[2 * h + 1] = xc; }
    }
}

typedef pg8::EpiSwiglu<true, true> EpiSwigluF8;
#define PHASE_SKEW() do { if ((bx >> 3) & 1) { __builtin_amdgcn_s_sleep(127); __builtin_amdgcn_s_sleep(A_SKEW2); } } while (0)
#define GEMM_PHASE(EPI, g, S, E) do { S.skip = args.flags; S.prep(); __syncthreads(); pg8::gemm_phase<EPI, pg8::Sched2, true, true>(lds, g, S, E); } while (0)
__global__ void __launch_bounds__(NTHR, 2) fwd_kernel(Args args) {
    extern __shared__ __attribute__((aligned(16))) unsigned char lds_raw[];
    LAS unsigned char* lds = (LAS unsigned char*)lds_raw;
    volatile LAS unsigned* MISC = (volatile LAS unsigned*)(lds + MISC_OFF);
    LAS float* rstab = (LAS float*)(lds + RS_OFF); LAS int* texp = (LAS int*)(lds + TEXP_OFF);
    unsigned char* const ws0 = args.ws; int G = gridDim.x, bx = blockIdx.x;
#define PHASE_BEGIN() size_t z_ = 0; asm volatile("" : "+s"(z_), "+s"(G), "+s"(bx)); unsigned char* ws = args.ws + z_; float* out = args.out + z_; int tid = threadIdx.x; asm volatile("" : "+v"(tid)); const int lane = tid & 63, wave = __builtin_amdgcn_readfirstlane(tid >> 6); (void)lane; (void)wave; (void)out
    if (threadIdx.x < 64) MISC[threadIdx.x] = 0u;
    __syncthreads();
    XcdBarrier bar; bar.bar = (unsigned*)ws0 + CW_BAR; bar.x = 0; bar.st = nullptr;
    const int lo = args.ph_lo, hi = args.ph_hi;
    if (MK_N_LAUNCHES == 1 && hi - lo > 1) bar = xcd_barrier_post((unsigned*)ws0 + CW_BAR, MISC + 8);
#define IN(k) (lo <= (k) && (k) < hi)
#define SEAM(k) do { if (IN(k) && IN((k) + 1)) { size_t zb_ = 0; asm volatile("" : "+s"(zb_)); bar.bar = (unsigned*)args.ws + CW_BAR + zb_; xcd_barrier(bar); } } while (0)

    if (IN(0)) { PHASE_BEGIN(); phase_prologue(args, lds, tid, lane, wave); }
    SEAM(0);
    if (IN(0) && IN(2)) {}
    if (IN(2)) { PHASE_BEGIN();
        pg8::Gemm g{(const bf16_t*)(ws + WS_MEMBF), (const bf16_t*)(ws + WS_WMEMKV), NBATCH * MEML, 2048, D};
        pg8::Sched2 S; S.init2(g.M, g.N, G, bx, rstab); S.rsrc = (const float*)(ws + WS_SSM); S.rmode = 1;
        pg8::EpiStore<true> E{(bf16_t*)(ws + WS_MEMKV), 2048, rstab};
        GEMM_PHASE(pg8::EpiStore<true>, g, S, E);
        __syncthreads();
    }
    SEAM(2);
    for (int l = 0; l < 2; ++l) {
        const int pb = l == 0 ? 3 : 11;
        if (IN(pb)) { for (int rep_ = 0; rep_ < REP_A; ++rep_) { PHASE_BEGIN();
#if I8_A
            pg8::Gemm g{(const bf16_t*)(ws + WS_QX), (const bf16_t*)(ws + WS_W1T + (size_t)l * 14 * MiB), T, NGEMM1, D / 2};
            pg8::Sched2 S; S.init2(T, NGEMM1, G, bx, rstab); S.rsrc = (const float*)(ws + WS_SA); S.rmode = 2; S.wgm = 4;
            pg8::EpiA<true> E{ws, l, rstab};
            PHASE_SKEW();
            GEMM_PHASE(pg8::EpiA<true>, g, S, E); __syncthreads(); }
#else
            pg8::Gemm g{(const bf16_t*)(ws + WS_XB), (const bf16_t*)(ws + WS_W1T + (size_t)l * 14 * MiB), T, NGEMM1, D};
            pg8::Sched2 S; S.init2(T, NGEMM1, G, bx, rstab); S.rsrc = (const float*)(ws + WS_SS); S.rmode = 1; S.wgm = 4;
            pg8::EpiA<false> E{ws, l, rstab};
            GEMM_PHASE(pg8::EpiA<false>, g, S, E); __syncthreads(); }
#endif
        }
        SEAM(pb);
        if (IN(pb + 1)) { PHASE_BEGIN(); phase_mixers(ws, lds, l, tid); }
        SEAM(pb + 1);
        if (IN(pb + 2)) { for (int rep_ = 0; rep_ < REP_C; ++rep_) { PHASE_BEGIN();
            { pg8::Gemm g{(const bf16_t*)(ws + WS_XB), (const bf16_t*)(ws + WS_WBRDA + (size_t)l * 2 * MiB), T, D, 1024}; pg8::Sched2 S; S.init2(T, D, G, bx, rstab);
              pg8::EpiBr0 E{ws}; GEMM_PHASE(pg8::EpiBr0, g, S, E); }
            __syncthreads(); { size_t z2_ = 0; asm volatile("" : "+s"(z2_), "+s"(G), "+s"(bx)); ws = args.ws + z2_; }
            { pg8::Gemm g{(const bf16_t*)(ws + WS_OPOOL), (const bf16_t*)(ws + WS_WBRPOOL + (size_t)l * 1 * MiB), T, D, 512}; pg8::Sched2 S; S.init2(T, D, G, bx, rstab);
              S.chain = 2; S.A2 = (const bf16_t*)(ws + WS_MQ); S.B2 = (const bf16_t*)(ws + WS_WBRMEM + (size_t)l * 1 * MiB);
              pg8::EpiBrC E{ws}; GEMM_PHASE(pg8::EpiBrC, g, S, E); } __syncthreads(); }
        }
        SEAM(pb + 2);
        if (IN(pb + 3)) { PHASE_BEGIN();
            pg8::Gemm g{(const bf16_t*)(ws + WS_Q), (const bf16_t*)(ws + WS_WOUT + (size_t)l * 2 * MiB), T, D, D}; pg8::Sched2 S; S.init2(T, D, G, bx, rstab);
            pg8::EpiResB E{l == 0 ? (const float*)(args.in[0] + z_) : (const float*)nullptr, (bf16_t*)(ws + WS_XS)};
            GEMM_PHASE(pg8::EpiResB, g, S, E); __syncthreads();
        }
        SEAM(pb + 3);
        if (l == 0) {
            if (IN(7) && I8_E) { PHASE_BEGIN(); phase_quant_rows((const bf16_t*)(ws + WS_XS), ws, lane, wave); }
            SEAM(7);
            if (IN(8)) { for (int rep_ = 0; rep_ < REP_E; ++rep_) { PHASE_BEGIN();
#if I8_E
                pg8::Gemm g{(const bf16_t*)(ws + WS_QX), (const bf16_t*)(ws + WS_WFF13), T, 2 * FFD, D / 2}; pg8::Sched2 S; S.init2(T, 2 * FFD, G, bx, rstab); S.rsrc = (const float*)(ws + WS_SA); S.rmode = 2; S.wgm = 4;
                EpiSwigluF8 E{(bf16_t*)(ws + WS_HFF), FFD, rstab, (const float*)(ws + WS_SW) + SW_FF, FFD, nullptr, 0};
                if (SKEW_E) PHASE_SKEW();
                GEMM_PHASE(EpiSwigluF8, g, S, E); __syncthreads(); }
#else
                pg8::Gemm g{(const bf16_t*)(ws + WS_X1B), (const bf16_t*)(ws + WS_WFF13), T, 2 * FFD, D}; pg8::Sched2 S; S.init2(T, 2 * FFD, G, bx, rstab); S.rsrc = (const float*)(ws + WS_SS); S.rmode = 1; S.wgm = 4;
                pg8::EpiSwiglu<false> E{(bf16_t*)(ws + WS_HFF), FFD, rstab, nullptr, 0, nullptr, 0};
                GEMM_PHASE(pg8::EpiSwiglu<false>, g, S, E); __syncthreads(); }
#endif
            }
            SEAM(8);
            if (IN(9)) { PHASE_BEGIN();
                pg8::Gemm g{(const bf16_t*)(ws + WS_HFF), (const bf16_t*)(ws + WS_WFF2), T, D, FFD / 2}; pg8::Sched2 S; S.init2(T, D, G, bx, rstab);
                pg8::EpiResB8 E{(bf16_t*)(ws + WS_XS), (const float*)(ws + WS_SW) + SW_W2 + 8 * 1024};
                GEMM_PHASE(pg8::EpiResB8, g, S, E); __syncthreads();
            }
            SEAM(9);
            if (IN(10) && I8_A) { PHASE_BEGIN(); phase_quant_rows((const bf16_t*)(ws + WS_XS), ws, lane, wave); }
            SEAM(10);
        }
    }
    if (IN(15)) { PHASE_BEGIN(); phase_route(ws, (const bf16_t*)(ws + WS_XS), lds, tid, lane, wave); }
    SEAM(15);
    if (IN(16)) { PHASE_BEGIN(); scan_counts(ws, texp, (LAS int*)lds, tid, lane, wave); phase_gather(ws, (const bf16_t*)(ws + WS_XS), texp, (const LAS int*)lds, lane, wave); }
    SEAM(16);
    for (int k = 0; k < 4; ++k) {
        if (IN(17 + k)) { PHASE_BEGIN();
            build_texp(ws, texp, tid);
            const int ntot = texp[169];
            const int kd = k - 1, ku = k;
            int ntd = 0, ntu = 0;
            if (kd >= 0) { ntd = ntot - MOE_CH * kd; const int cap = (kd == 2) ? MOE_CHL : MOE_CH; ntd = ntd < 0 ? 0 : (ntd > cap ? cap : ntd); }
            if (ku <= 2) { ntu = ntot - MOE_CH * ku; const int cap = (ku == 2) ? MOE_CHL : MOE_CH; ntu = ntu < 0 ? 0 : (ntu > cap ? cap : ntu); }
            const int nX = ntd * 4, nU = ntu * 28;
            const bool mixed = (nX > 0 && nU > 0);
            const int tf = (nU + DNW * nX) / 256, rem = (nU + DNW * nX) - 256 * tf;
            const bool weighted = mixed && tf >= DNW && nX <= 256 && G == 256;
            if (SKEW_M) PHASE_SKEW();
            if (nX > 0) {
                const int t0 = MOE_CH * kd;
                pg8::Gemm g{(const bf16_t*)(ws + WS_HCH + (size_t)(kd & 1) * HCH_BYTES), (const bf16_t*)(ws + WS_WMOE2), ntd * 256, D, FFE / 2};
                pg8::Sched2 S; S.init2(ntd * 256, D, G, bx, rstab); S.texp = texp; S.estride = (size_t)7 * MiB; S.t0 = t0;
                if (weighted) { const int vc = (bx & 7) * 32 + (bx >> 3); S.rng = 1; S.rng_start = vc; S.rng_cnt = (vc < nX) ? 1 : 0; }
                pg8::EpiStoreF8 E{(bf16_t*)(ws + WS_Y) + (size_t)t0 * 256 * D, D, (const float*)(ws + WS_SW) + SW_W2, texp, t0};
                for (int rep_ = 0; rep_ < REP_DN; ++rep_) { GEMM_PHASE(pg8::EpiStoreF8, g, S, E); __syncthreads(); }
            }
            if (nU > 0) {
                size_t z3_ = 0; asm volatile("" : "+s"(z3_), "+s"(G), "+s"(bx)); ws = args.ws + z3_;
                const int t0 = MOE_CH * ku;
                pg8::Gemm g{(const bf16_t*)(ws + WS_XGY + (size_t)t0 * 256 * D), (const bf16_t*)(ws + WS_WMOE13), ntu * 256, 2 * FFE, D / 2};
                pg8::Sched2 S; S.init2(ntu * 256, 2 * FFE, G, bx, rstab); S.rsrc = (const float*)(ws + WS_XGRS); S.rmode = 2; S.rrow0 = t0 * 256; S.texp = texp; S.estride = (size_t)7 * MiB; S.t0 = t0;
                if (weighted) { const int vc = (bx & 7) * 32 + (bx >> 3); const int cmin = vc < nX ? vc : nX, over = vc - (256 - rem); S.rng = 1; S.rng_start = vc * tf - DNW * cmin + (over > 0 ? over : 0); S.rng_cnt = tf - (vc < nX ? DNW : 0) + (vc >= 256 - rem ? 1 : 0); }
                EpiSwigluF8 E{(bf16_t*)(ws + WS_HCH + (size_t)(ku & 1) * HCH_BYTES), FFE, rstab, (const float*)(ws + WS_SW) + SW_MOE, FFE, texp, t0};
                for (int rep_ = 0; rep_ < REP_UP; ++rep_) { GEMM_PHASE(EpiSwigluF8, g, S, E); __syncthreads(); }
            }
        }
        SEAM(17 + k);
    }
    if (IN(21)) { PHASE_BEGIN(); build_texp(ws, texp, tid); phase_combine(ws, (const bf16_t*)(ws + WS_XS), out, texp, lane, wave); }
#undef IN
#undef SEAM
}

extern "C" void kernel_launch(void* const* d_in, const int* in_sizes, int n_in, void* d_out, int out_size, void* d_ws, size_t ws_size, hipStream_t stream) {
    static int grid = 0;
    if (grid == 0) {
        if (n_in != 31 || out_size != T * D || ws_size < WS_END) { fprintf(stderr, "kernel_launch: unexpected problem (n_in %d, out %d, ws %zu < %zu)\n", n_in, out_size, ws_size, (size_t)WS_END); grid = -1; return; }
        int dev = 0, cus = 0, per_cu = 0;
        if (hipGetDevice(&dev) != hipSuccess || hipDeviceGetAttribute(&cus, hipDeviceAttributeMultiprocessorCount, dev) != hipSuccess) { grid = -1; return; }
        if (hipFuncSetAttribute((const void*)fwd_kernel, hipFuncAttributeMaxDynamicSharedMemorySize, LDS_BYTES) != hipSuccess) { fprintf(stderr, "kernel_launch: hipFuncSetAttribute failed\n"); grid = -1; return; }
        if (hipOccupancyMaxActiveBlocksPerMultiprocessor(&per_cu, (const void*)fwd_kernel, NTHR, LDS_BYTES) != hipSuccess || per_cu < 1) { fprintf(stderr, "kernel_launch: occupancy query says %d\n", per_cu); grid = -1; (void)hipGetLastError(); return; }
        grid = cus;
    }
    if (grid < 0) return;
    if (hipMemsetAsync(d_ws, 0, CTL_ZERO_BYTES, stream) != hipSuccess) return;
    Args a{};
    for (int i = 0; i < 31; ++i) a.in[i] = (const float*)d_in[i];
    a.out = (float*)d_out; a.ws = (unsigned char*)d_ws;
#ifndef PROBE_EXTRA_REPS
#define PROBE_EXTRA_REPS 1
#endif
#ifdef PROBE_EXTRA_PROLOGUE
    a.ph_lo = 0; a.ph_hi = 1; hipLaunchKernelGGL(fwd_kernel, dim3(grid), dim3(NTHR), LDS_BYTES, stream, a);
#endif
#ifdef PROBE_EXTRA_PHASE
    for (int r_ = 0; r_ < PROBE_EXTRA_REPS; ++r_) { a.ph_lo = PROBE_EXTRA_PHASE; a.ph_hi = PROBE_EXTRA_PHASE + 1; hipLaunchKernelGGL(fwd_kernel, dim3(grid), dim3(NTHR), LDS_BYTES, stream, a); }
#endif
    if (MK_N_LAUNCHES == 1) { a.ph_lo = 0; a.ph_hi = NPH; hipLaunchKernelGGL(fwd_kernel, dim3(grid), dim3(NTHR), LDS_BYTES, stream, a); }
    else for (int p = 0; p < NPH; ++p) { a.ph_lo = p; a.ph_hi = p + 1; hipLaunchKernelGGL(fwd_kernel, dim3(grid), dim3(NTHR), LDS_BYTES, stream, a); }
#ifdef PROBE_POST_PHASE
#ifdef PROBE_POST_FLAGS
    a.flags = PROBE_POST_FLAGS;
#endif
    for (int r_ = 0; r_ < PROBE_EXTRA_REPS; ++r_) { a.ph_lo = PROBE_POST_PHASE; a.ph_hi = PROBE_POST_PHASE + 1; hipLaunchKernelGGL(fwd_kernel, dim3(grid), dim3(NTHR), LDS_BYTES, stream, a); }
#endif
}
```

```cpp
#include <hip/hip_runtime.h>
#include <cstdio>
#include <cstdint>
#define MK_N_LAUNCHES 1
#ifndef USE_I8
#define USE_I8 1
#endif
#ifndef I8_A
#define I8_A 1
#endif
#ifndef I8_E
#define I8_E 1
#endif
#ifndef REP_MEM
#define REP_MEM 1
#endif
#ifndef REP_D
#define REP_D 1
#endif
#ifndef REP_F
#define REP_F 1
#endif
#ifndef REP_Z
#define REP_Z 1
#endif
#ifndef REP_E
#define REP_E 1
#endif
#ifndef REP_DN
#define REP_DN 1
#endif
#ifndef REP_MG
#define REP_MG 1
#endif
#ifndef REP_POOL
#define REP_POOL 1
#endif
#ifndef REP_GA
#define REP_GA 1
#endif
#ifndef REP_PRO
#define REP_PRO 1
#endif
#ifndef REP_A
#define REP_A 1
#endif
#ifndef REP_DA
#define REP_DA 1
#endif
#ifndef REP_C
#define REP_C 1
#endif
#ifndef REP_UP
#define REP_UP 1
#endif

constexpr int NWAVES = 8, NTHR = 512;
constexpr int T = 16384, D = 1024, SEQ = 2048, NBATCH = 8, MEML = 256;
constexpr int NGEMM1 = 7168, FFD = 2816, FFE = 3584, NEXP = 8;
constexpr float LOG2E = 1.4426950408889634f;
constexpr float QSCALE = 0.125f * LOG2E;
constexpr float MEMSCALE = 0.08838834764831845f * LOG2E;
#ifndef MK_N_LAUNCHES
#define MK_N_LAUNCHES 1
#endif
constexpr int NPH = 22;
constexpr int MOE_CH = 45, MOE_CHL = 46;

constexpr size_t MiB = 1u << 20;
constexpr size_t CTL_ZERO_BYTES = 1 * MiB;
constexpr size_t WS_SS = 1 * MiB;
constexpr size_t WS_MQSS = 2 * MiB;
constexpr size_t WS_SSM = 2 * MiB + 512 * 1024;
constexpr size_t WS_TOKE = WS_SSM + 128 * 1024;
constexpr size_t WS_TOKP = WS_TOKE + 128 * 1024;
constexpr size_t WS_TOKG = WS_TOKP + 128 * 1024;
constexpr size_t WS_TOKR = WS_TOKG + 128 * 1024;
constexpr size_t WS_SC = WS_TOKR + 64 * 1024;
constexpr size_t WS_XGRS = WS_SC + 4096;
constexpr size_t WS_PARAM = 3 * MiB + 256 * 1024;
constexpr int PB_BGATE = 0, PB_GQ = 6144, PB_GK = 6400, PB_GOUT = 6656, PB_POOLS = 6912, PB_MQN = 7936, PB_MKN = 8192, PB_GFFN1 = 8448, PB_WR = 9472, PB_POOLW = 17664, PB_END = 17664 + 131072;
constexpr size_t WS_W1T = 4 * MiB;
constexpr size_t WS_WMEMKV = 32 * MiB;
constexpr size_t WS_WBRDA = 36 * MiB;
constexpr size_t WS_WBRPOOL = 40 * MiB;
constexpr size_t WS_WBRMEM = 42 * MiB;
constexpr size_t WS_WOUT = 44 * MiB;
constexpr size_t WS_WFF13 = 48 * MiB;
constexpr size_t WS_WFF2 = 59 * MiB;
constexpr size_t WS_SW = WS_WFF13 + 6 * MiB;
constexpr int SW_G1 = 0, SW_FF = 2 * 7168, SW_MOE = SW_FF + 2 * 2816, SW_W2 = SW_MOE + 8 * 2 * 3584, SW_END = SW_W2 + 9 * 1024;
constexpr float H8_SCALE = 8.0f;
#ifndef DA_LOOP_ALIGN
#define DA_LOOP_ALIGN ".p2align 6"
#endif
#ifndef A_SKEW2
#define A_SKEW2 64
#endif
#ifndef SKEW_A
#define SKEW_A 0
#endif
#ifndef SKEW_E
#define SKEW_E 0
#endif
#ifndef SKEW_M
#define SKEW_M 0
#endif
#ifndef GROUP_SYNC
#define GROUP_SYNC 1
#endif
constexpr int DNW = 2;
constexpr size_t SW_BYTES = (size_t)SW_END * 4;
constexpr size_t WS_WMOE13 = 65 * MiB;
constexpr size_t WS_XS = WS_WMOE13 + 56 * MiB;
constexpr size_t WS_WMOE2 = 177 * MiB;
constexpr size_t WS_XB = 233 * MiB;
constexpr size_t WS_QX = WS_WMOE2 + 28 * MiB, WS_SA = 1 * MiB;
constexpr size_t WS_MEMKV = 265 * MiB;
constexpr size_t WS_R = 273 * MiB;
constexpr size_t WS_Q = WS_R, WS_K = WS_R + 32 * MiB, WS_V = WS_R + 64 * MiB, WS_P = WS_R + 96 * MiB, WS_MQ = WS_R + 112 * MiB, WS_OPOOL = WS_R + 128 * MiB, WS_G = WS_R + 144 * MiB, WS_MEMBF = WS_R + 240 * MiB, WS_POOLWT = WS_R + 244 * MiB;
constexpr size_t WS_MF = WS_K, WS_X1B = WS_K, WS_HFF = WS_R + 192 * MiB;
constexpr size_t WS_XGY = WS_MEMKV;
constexpr size_t WS_Y = WS_XGY + 34 * MiB;
constexpr size_t WS_HCH = WS_Y + 68 * MiB, HCH_BYTES = (size_t)MOE_CHL * 256 * 7168;
constexpr size_t WS_END = 529 * MiB;
static_assert(WS_XGRS + 34816 * 4 <= WS_PARAM && WS_PARAM + (size_t)PB_END * 4 <= WS_W1T && WS_HCH + 2 * HCH_BYTES <= WS_END && WS_SW + SW_BYTES <= WS_WFF2, "d_ws map");
constexpr int CW_CNT = 64;
constexpr int CW_WCNT = 1024;
constexpr int CW_GBAR = 3072;
constexpr int CW_GX = 3600;
constexpr int CW_W2MAX = 8192;
constexpr int CW_BAR = 4096;

constexpr int RING_BYTES = 131072;
constexpr int RS_OFF = 131072, RS_UNITS = 16;
constexpr int TEXP_OFF = RS_OFF + RS_UNITS * 1024;
constexpr int LDS_BYTES = 155648;
constexpr int MISC_OFF = LDS_BYTES - 256;

namespace pg8 {
#define PG8_LAS __attribute__((address_space(3)))
typedef unsigned short bf16_t;
typedef short bf16x8 __attribute__((ext_vector_type(8)));
typedef float f32x4 __attribute__((ext_vector_type(4)));
typedef unsigned u32x4 __attribute__((ext_vector_type(4)));
constexpr int BM = 256, BK = 64, HALF = 128, HTB = HALF * BK * 2  , STAGE_BYTES = 8 * HTB, NXCD = 8, WGM = 8;

__host__ __device__ __forceinline__ int lds_byte(int r, int c) { const int st = (r >> 4) * 2 + (c >> 5), rr = r & 15, cc = c & 31, ob = rr * 64 + cc * 2; return st * 1024 + (ob ^ (((ob >> 9) & 1) << 5)); }
__host__ __device__ __forceinline__ void stage_rc(int b, int& R, int& C) { const int st = b / 1024, sb = b % 1024, swz = sb ^ (((sb >> 9) & 1) << 5); R = (st >> 1) * 16 + swz / 64; C = (st & 1) * 32 + (swz % 64) / 2; }
__host__ __device__ __forceinline__ int perm32(int rho) { const int n = rho >> 4, i = rho & 15; return 8 * (i >> 2) + 4 * n + (i & 3); }

struct Unit { int pm, pn, idx; };
struct Gemm { const bf16_t* A; const bf16_t* Bt; int M, N, K; };

struct StaticOrder {
    int nM, nN, nwg, G, c, wgm;
    __host__ __device__ void init(int M, int N, int G_, int c_) { nM = M / BM; nN = N / BM; nwg = nM * nN; G = G_; c = c_; wgm = WGM; }
    __host__ __device__ bool next(int i, Unit& u) const {
        const long L = (long)i * G + c; if (L >= nwg) return false;
        int wgid = (int)L; { const int q = nwg / NXCD, r = nwg % NXCD, xcd = wgid % NXCD, off = wgid / NXCD; wgid = (xcd < r ? xcd * (q + 1) : r * (q + 1) + (xcd - r) * q) + off; }
        const int nig = wgm * nN, gid = wgid / nig, fm = gid * wgm, gsz = (nM - fm) < wgm ? (nM - fm) : wgm;
        u.pm = fm + ((wgid % nig) % gsz); u.pn = (wgid % nig) / gsz; u.idx = i; return true;
    }
    __device__ __forceinline__ const char* bptr(const Gemm& g, const Unit& u, size_t tstep) const { return (const char*)g.Bt + (size_t)u.pn * tstep; }
    __device__ __forceinline__ const char* aptr(const Gemm& g, const Unit& u, size_t tstep) const { return (const char*)g.A + (size_t)u.pm * tstep; }
    __device__ __forceinline__ void a_ready(const Unit&) const {}
    __device__ __forceinline__ void done(const Unit&) const {}
};


typedef float f32x2 __attribute__((ext_vector_type(2)));
typedef __bf16 bf16x2_t __attribute__((ext_vector_type(2)));
__device__ __forceinline__ unsigned pk_bf16(float lo, float hi) { f32x2 v = {lo, hi}; bf16x2_t b = __builtin_convertvector(v, bf16x2_t); return __builtin_bit_cast(unsigned, b); }
__device__ __forceinline__ u32x4 pk8(const f32x4 a, const f32x4 b) { u32x4 w; w.x = pk_bf16(a[0], a[1]); w.y = pk_bf16(a[2], a[3]); w.z = pk_bf16(b[0], b[1]); w.w = pk_bf16(b[2], b[3]); return w; }
__device__ __forceinline__ float bf_lo(unsigned w) { return __builtin_bit_cast(float, w << 16); }
__device__ __forceinline__ float bf_hi(unsigned w) { return __builtin_bit_cast(float, w & 0xffff0000u); }
__device__ __forceinline__ float sum_fq(float x) {
    float x2; asm volatile("v_mov_b32 %0, %1" : "=v"(x2) : "v"(x));
    asm volatile("s_nop 1\n\tv_permlane16_swap_b32 %0, %1" : "+v"(x), "+v"(x2));
    float y = x + x2, y2; asm volatile("v_mov_b32 %0, %1" : "=v"(y2) : "v"(y));
    asm volatile("s_nop 1\n\tv_permlane32_swap_b32 %0, %1" : "+v"(y), "+v"(y2));
    return y + y2;
}
__device__ __forceinline__ float sigmoid_f(float x) { return __builtin_amdgcn_rcpf(1.0f + __builtin_amdgcn_exp2f(-1.4426950408889634f * x)); }
typedef int i32x8 __attribute__((ext_vector_type(8)));
typedef int i32x4 __attribute__((ext_vector_type(4)));
__device__ __forceinline__ f32x4 mma_f8(const i32x8 a, const i32x8 b, f32x4 c) { const int one = 0x7f7f7f7f; asm volatile("v_mfma_scale_f32_16x16x128_f8f6f4 %0, %1, %2, %0, %3, %3 op_sel_hi:[0,0,0]" : "+v"(c) : "v"(a), "v"(b), "v"(one)); return c; }
__device__ __forceinline__ unsigned pk_fp8x4(float a, float b, float c, float d) { int w = __builtin_amdgcn_cvt_pk_fp8_f32(a, b, 0, false); w = __builtin_amdgcn_cvt_pk_fp8_f32(c, d, w, true); return (unsigned)w; }
constexpr float RMS_EPS = 1e-6f;
typedef int i32x4 __attribute__((ext_vector_type(4)));
template <bool I8> __device__ __forceinline__ f32x4 mma16(const bf16x8 a, const bf16x8 b, const f32x4 c) {
    if constexpr (I8) return __builtin_bit_cast(f32x4, __builtin_amdgcn_mfma_i32_16x16x64_i8(__builtin_bit_cast(i32x4, a), __builtin_bit_cast(i32x4, b), __builtin_bit_cast(i32x4, c), 0, 0, 0));
    else return __builtin_amdgcn_mfma_f32_16x16x32_bf16(a, b, c, 0, 0, 0);
}
template <bool I8> __device__ __forceinline__ f32x4 accf(const f32x4 a) {
    if constexpr (I8) { const i32x4 v = __builtin_bit_cast(i32x4, a); return (f32x4){(float)v[0], (float)v[1], (float)v[2], (float)v[3]}; } else return a;
}


struct Sched2 : StaticOrder {
    const float* rsrc; int rmode;
    int rrow0;
    PG8_LAS float* rtab;
    const PG8_LAS int* texp; size_t estride; int t0;
    int rng, rng_start, rng_cnt;
    const bf16_t* A3; const bf16_t* B3; int K2;
    const bf16_t* A2; const bf16_t* B2; int chain;
    int skip;
    __device__ __forceinline__ void init2(int M, int N, int G_, int c_, PG8_LAS float* tab) { init(M, N, G_, c_); skip = 0; rsrc = nullptr; rmode = 0; rrow0 = 0; rtab = tab; texp = nullptr; estride = 0; t0 = 0; A2 = nullptr; B2 = nullptr; A3 = nullptr; B3 = nullptr; K2 = 0; chain = 0; rng = 0; rng_start = 0; rng_cnt = 0; }
    __device__ __forceinline__ bool next(int i, Unit& u) const {
        if (rng != 0) { if (i >= rng_cnt) return false; const int q = rng_start + i; u.pm = q / nN; u.pn = q - u.pm * nN; u.idx = i; return true; }
        if (chain == 0) return StaticOrder::next(i, u); if (i >= chain || !StaticOrder::next(0, u)) return false; u.idx = i; return true; }
    __device__ __forceinline__ const char* aptr(const Gemm& g, const Unit& u, size_t tstep) const { return (const char*)((chain != 0 && u.idx == 1) ? A2 : (chain != 0 && u.idx == 2) ? A3 : g.A) + (size_t)u.pm * tstep; }
    __device__ __forceinline__ int kof(const Gemm& g, const Unit& u) const { return (K2 != 0 && u.idx >= 1) ? K2 : g.K; }
    __device__ __forceinline__ const char* bptr(const Gemm& g, const Unit& u, size_t tstep) const {
        const char* b = (const char*)((chain != 0 && u.idx == 1) ? B2 : (chain != 0 && u.idx == 2) ? B3 : g.Bt) + (size_t)u.pn * tstep;
        if (texp) b += (size_t)texp[t0 + u.pm] * estride;
        return b;
    }
    __device__ __forceinline__ void a_ready(const Unit&) const {}
    __device__ __forceinline__ void prep() const {
        if (rmode == 0) return;
        int tid = threadIdx.x; asm volatile("" : "+v"(tid));
        if (tid < 256 && rmode == 2) {
            float scv[16]; unsigned okm = 0u;
#pragma unroll
            for (int i = 0; i < 16; ++i) { Unit u; const bool ok = next(i, u); okm |= ok ? (1u << i) : 0u; scv[i] = rsrc[(size_t)rrow0 + (size_t)(ok ? u.pm : 0) * 256 + tid]; }
#pragma unroll
            for (int i = 0; i < 16; ++i) { if (okm & (1u << i)) rtab[i * 256 + tid] = scv[i]; }
        } else if (tid < 256) {
            Unit u;
#pragma unroll 1
            for (int i = 0; i < 16 && next(i, u); ++i) {
                const size_t row = (size_t)rrow0 + (size_t)u.pm * 256 + tid; float sc;
                if (rmode == 1) { const f32x4* p = (const f32x4*)(rsrc + row * 16); const f32x4 a = p[0], b = p[1], c = p[2], d = p[3];
                    const float s = ((a[0] + a[1]) + (a[2] + a[3])) + ((b[0] + b[1]) + (b[2] + b[3])) + ((c[0] + c[1]) + (c[2] + c[3])) + ((d[0] + d[1]) + (d[2] + d[3]));
                    sc = __builtin_amdgcn_rsqf(s * (1.0f / 1024.0f) + RMS_EPS); }
                else sc = rsrc[row];
                rtab[i * 256 + tid] = sc;
            }
        }
    }
    __device__ __forceinline__ void done(const Unit&) const {}
};

template <bool RS> struct EpiStore {
    static constexpr bool PERM = false, AFTER_DRAIN = false, I8 = false, F8 = false, MID = false;
    bf16_t* O; int ldc; const PG8_LAS float* rs;
    __device__ __forceinline__ void operator()(const f32x4 (&acc)[2][2][4][2], const Unit& u, int wr, int wc, int fr, int fq) const {
        const int rl = wr * 64 + fr; const size_t row0 = (size_t)u.pm * BM + rl; const int col0 = u.pn * BM + 64 * wc + 8 * fq;
#pragma unroll
        for (int ai = 0; ai < 2; ++ai)
#pragma unroll
            for (int m = 0; m < 4; ++m) { const float sc = RS ? rs[u.idx * 256 + rl + ai * HALF + m * 16] : 1.f; bf16_t* rowp = O + (row0 + ai * HALF + m * 16) * ldc + col0;
#pragma unroll
                for (int bj = 0; bj < 2; ++bj) *(u32x4*)(rowp + 32 * bj) = pk8(acc[ai][bj][m][0] * sc, acc[ai][bj][m][1] * sc); }
    }
};

template <bool I8_> struct EpiA {
    static constexpr bool PERM = false, AFTER_DRAIN = false, I8 = I8_, F8 = false, MID = false;
    unsigned char* ws; int l; const PG8_LAS float* rs;
    __device__ __forceinline__ void operator()(const f32x4 (&acc)[2][2][4][2], const Unit& u, int wr, int wc, int fr, int fq) const {
        const int pn = u.pn, rl = wr * 64 + fr; const size_t row0 = (size_t)u.pm * BM + rl; const PG8_LAS float* rsp = rs + u.idx * 256 + rl;
        const float* prm = (const float*)(ws + WS_PARAM);
        f32x4 cw[2][2];
#pragma unroll
        for (int bj = 0; bj < 2; ++bj)
#pragma unroll
            for (int n = 0; n < 2; ++n) { if constexpr (I8_) cw[bj][n] = *(const f32x4*)((const float*)(ws + WS_SW) + SW_G1 + l * 7168 + pn * 256 + 64 * wc + 32 * bj + 8 * fq + 4 * n) * (1.0f / 127.0f); else cw[bj][n] = (f32x4){1.f, 1.f, 1.f, 1.f}; }
#define EA_V(ai, bj, m, n) (accf<I8_>(acc[ai][bj][m][n]) * cw[bj][n])
        if (pn < 8) {
            const bool isq = pn < 4; const float* gg = prm + (isq ? PB_GQ : PB_GK) + l * 128 + (wc & 1) * 64 + 8 * fq; const float mul = isq ? QSCALE : 1.f;
            f32x4 gv[2][2];
#pragma unroll
            for (int bj = 0; bj < 2; ++bj)
#pragma unroll
                for (int n = 0; n < 2; ++n) gv[bj][n] = *(const f32x4*)(gg + 32 * bj + 4 * n);
            bf16_t* base = (bf16_t*)(ws + (isq ? WS_Q : WS_K)) + (pn & 3) * 256 + 64 * wc + 8 * fq;
#pragma unroll
            for (int ai = 0; ai < 2; ++ai)
#pragma unroll
                for (int m = 0; m < 4; ++m) { const float sc = rsp[ai * HALF + m * 16];
                    f32x4 v[2][2]; float ss = 0.f;
#pragma unroll
                    for (int bj = 0; bj < 2; ++bj)
#pragma unroll
                        for (int n = 0; n < 2; ++n) { v[bj][n] = EA_V(ai, bj, m, n) * sc; const f32x4 x = v[bj][n]; ss += (x[0] * x[0] + x[1] * x[1]) + (x[2] * x[2] + x[3] * x[3]); }
                    ss = sum_fq(ss);
                    const float r = __builtin_amdgcn_rsqf(ss * (1.0f / 64.0f) + RMS_EPS) * mul;
                    bf16_t* rowp = base + (row0 + ai * HALF + m * 16) * 1024;
#pragma unroll
                    for (int bj = 0; bj < 2; ++bj) *(u32x4*)(rowp + 32 * bj) = pk8(v[bj][0] * gv[bj][0] * r, v[bj][1] * gv[bj][1] * r); }
        } else if (pn < 14) {
            bf16_t* base; int ldc;
            if (pn < 12) { base = (bf16_t*)(ws + WS_V) + (pn - 8) * 256; ldc = 1024; } else { base = (bf16_t*)(ws + WS_P) + (pn - 12) * 256; ldc = 512; }
            base += 64 * wc + 8 * fq;
#pragma unroll
            for (int ai = 0; ai < 2; ++ai)
#pragma unroll
                for (int m = 0; m < 4; ++m) { const float sc = rsp[ai * HALF + m * 16]; bf16_t* rowp = base + (row0 + ai * HALF + m * 16) * ldc;
#pragma unroll
                    for (int bj = 0; bj < 2; ++bj) *(u32x4*)(rowp + 32 * bj) = pk8(EA_V(ai, bj, m, 0) * sc, EA_V(ai, bj, m, 1) * sc); }
        } else if (pn < 16) {
            bf16_t* base = (bf16_t*)(ws + WS_MQ) + (pn - 14) * 256 + 64 * wc + 8 * fq; float* mqss = (float*)(ws + WS_MQSS);
#pragma unroll
            for (int ai = 0; ai < 2; ++ai)
#pragma unroll
                for (int m = 0; m < 4; ++m) { const float sc = rsp[ai * HALF + m * 16]; const size_t row = row0 + ai * HALF + m * 16; bf16_t* rowp = base + row * 512; float ss = 0.f;
#pragma unroll
                    for (int bj = 0; bj < 2; ++bj) { const f32x4 a = EA_V(ai, bj, m, 0) * sc, b = EA_V(ai, bj, m, 1) * sc;
                        ss += ((a[0] * a[0] + a[1] * a[1]) + (a[2] * a[2] + a[3] * a[3])) + ((b[0] * b[0] + b[1] * b[1]) + (b[2] * b[2] + b[3] * b[3]));
                        *(u32x4*)(rowp + 32 * bj) = pk8(a, b); }
                    ss = sum_fq(ss);
                    if (fq == 0) mqss[row * 8 + (pn - 14) * 4 + wc] = ss; }
        } else {
            const int gcol = (pn - 16) * 256 + 64 * wc + 8 * fq; unsigned char* base = (unsigned char*)(ws + WS_G) + gcol; const int gsh = (fq & 1) ? 24 : 0;     const float* bgate = prm + PB_BGATE + l * 3072 + gcol;
            f32x4 bv[2][2], cl[2][2];
#pragma unroll
            for (int bj = 0; bj < 2; ++bj)
#pragma unroll
                for (int n = 0; n < 2; ++n) { bv[bj][n] = *(const f32x4*)(bgate + 32 * bj + 4 * n) * (-1.4426950408889634f); cl[bj][n] = cw[bj][n] * (-1.4426950408889634f); }
#pragma unroll
            for (int ai = 0; ai < 2; ++ai)
#pragma unroll
                for (int m = 0; m < 4; ++m) { const float sc = rsp[ai * HALF + m * 16]; unsigned char* rowp = base + (row0 + ai * HALF + m * 16) * 3072;
                    unsigned w[2][2];
#pragma unroll
                    for (int bj = 0; bj < 2; ++bj) {
#pragma unroll
                        for (int n = 0; n < 2; ++n) { const f32x4 u = accf<I8_>(acc[ai][bj][m][n]) * cl[bj][n] * sc + bv[bj][n]; unsigned pk = 0u;
#pragma unroll
                            for (int j = 0; j < 4; ++j) { const float s255 = __builtin_amdgcn_rcpf(__builtin_fmaf(__builtin_amdgcn_exp2f(u[j]), 1.0f / 255.0f, 1.0f / 255.0f)); pk = __builtin_amdgcn_cvt_pk_u8_f32(s255, j, pk); }
                            w[bj][n] = pk; } }
                    asm volatile("s_nop 1\n\tv_permlane16_swap_b32 %0, %1" : "+v"(w[0][0]), "+v"(w[1][0]));
                    asm volatile("s_nop 1\n\tv_permlane16_swap_b32 %0, %1" : "+v"(w[0][1]), "+v"(w[1][1]));
                    *(u32x4*)(rowp + gsh) = (u32x4){w[0][0], w[0][1], w[1][0], w[1][1]}; }
        }
    }
};
#undef EA_V

struct EpiBr0 {
    static constexpr bool PERM = false, AFTER_DRAIN = false, I8 = false, F8 = false, MID = false;
    unsigned char* ws;
    __device__ __forceinline__ void operator()(const f32x4 (&acc)[2][2][4][2], const Unit& u, int wr, int wc, int fr, int fq) const {
        const size_t row0 = (size_t)u.pm * BM + wr * 64 + fr; const int col0 = u.pn * BM + 64 * wc + 8 * fq;
        const unsigned char* G = (const unsigned char*)(ws + WS_G); bf16_t* MFb = (bf16_t*)(ws + WS_MF);
#pragma unroll
        for (int ai = 0; ai < 2; ++ai) { unsigned long long gw[4][2];
#pragma unroll
            for (int m = 0; m < 4; ++m)
#pragma unroll
                for (int bj = 0; bj < 2; ++bj) gw[m][bj] = *(const unsigned long long*)(G + (row0 + ai * HALF + m * 16) * 3072 + col0 + 32 * bj);
#pragma unroll
            for (int m = 0; m < 4; ++m) { const size_t row = row0 + ai * HALF + m * 16;
#pragma unroll
                for (int bj = 0; bj < 2; ++bj) { const int col = col0 + 32 * bj;
                    const unsigned glo = (unsigned)gw[m][bj], ghi = (unsigned)(gw[m][bj] >> 32);
                    const f32x4 g0 = (f32x4){(float)(glo & 255u), (float)((glo >> 8) & 255u), (float)((glo >> 16) & 255u), (float)(glo >> 24)} * (1.0f / 255.0f), g1 = (f32x4){(float)(ghi & 255u), (float)((ghi >> 8) & 255u), (float)((ghi >> 16) & 255u), (float)(ghi >> 24)} * (1.0f / 255.0f);
                    *(u32x4*)(MFb + row * 1024 + col) = pk8(acc[ai][bj][m][0] * g0, acc[ai][bj][m][1] * g1); } } }
    }
};
struct EpiBrC {
    static constexpr bool PERM = false, AFTER_DRAIN = false, I8 = false, F8 = false, MID = false;
    unsigned char* ws;
    __device__ __forceinline__ void operator()(const f32x4 (&acc)[2][2][4][2], const Unit& u, int wr, int wc, int fr, int fq) const {
        const size_t row0 = (size_t)u.pm * BM + wr * 64 + fr; const int col0 = u.pn * BM + 64 * wc + 8 * fq;
        const unsigned char* G = (const unsigned char*)(ws + WS_G) + (1 + u.idx) * 1024; const bf16_t* MFb = (const bf16_t*)(ws + WS_MF); bf16_t* O = (bf16_t*)(ws + (u.idx == 0 ? WS_MF : WS_Q));
#pragma unroll
        for (int ai = 0; ai < 2; ++ai) { unsigned long long gw[4][2]; u32x4 mw[4][2];
#pragma unroll
            for (int m = 0; m < 4; ++m)
#pragma unroll
                for (int bj = 0; bj < 2; ++bj) { const size_t row = row0 + ai * HALF + m * 16; const int col = col0 + 32 * bj;
                    gw[m][bj] = *(const unsigned long long*)(G + row * 3072 + col); mw[m][bj] = *(const u32x4*)(MFb + row * 1024 + col); }
#pragma unroll
            for (int m = 0; m < 4; ++m) { const size_t row = row0 + ai * HALF + m * 16;
#pragma unroll
                for (int bj = 0; bj < 2; ++bj) { const int col = col0 + 32 * bj;
                    const unsigned glo = (unsigned)gw[m][bj], ghi = (unsigned)(gw[m][bj] >> 32); const u32x4 w = mw[m][bj];
                    const f32x4 g0 = (f32x4){(float)(glo & 255u), (float)((glo >> 8) & 255u), (float)((glo >> 16) & 255u), (float)(glo >> 24)} * (1.0f / 255.0f), g1 = (f32x4){(float)(ghi & 255u), (float)((ghi >> 8) & 255u), (float)((ghi >> 16) & 255u), (float)(ghi >> 24)} * (1.0f / 255.0f);
                    const f32x4 m0 = {bf_lo(w.x), bf_hi(w.x), bf_lo(w.y), bf_hi(w.y)}, m1 = {bf_lo(w.z), bf_hi(w.z), bf_lo(w.w), bf_hi(w.w)};
                    *(u32x4*)(O + row * 1024 + col) = pk8(acc[ai][bj][m][0] * g0 + m0, acc[ai][bj][m][1] * g1 + m1); } } }
    }
};

struct EpiBrPM {
    static constexpr bool PERM = false, AFTER_DRAIN = false, I8 = false, F8 = false, MID = true;
    unsigned char* ws;
    static __device__ __forceinline__ f32x4 g4(unsigned w) { return (f32x4){(float)(w & 255u), (float)((w >> 8) & 255u), (float)((w >> 16) & 255u), (float)(w >> 24)} * (1.0f / 255.0f); }
    static __device__ __forceinline__ f32x4 nz(f32x4 g) { f32x4 r; r[0] = __builtin_fmaxf(g[0], 9.5367431640625e-7f); r[1] = __builtin_fmaxf(g[1], 9.5367431640625e-7f); r[2] = __builtin_fmaxf(g[2], 9.5367431640625e-7f); r[3] = __builtin_fmaxf(g[3], 9.5367431640625e-7f); return r; }
    static __device__ __forceinline__ void gsplit(const u32x4 v, unsigned long long& b0, unsigned long long& b1) {
        unsigned x0 = v.x, x1 = v.y, y0 = v.z, y1 = v.w;
        asm volatile("s_nop 1\n\tv_permlane16_swap_b32 %0, %1" : "+v"(x0), "+v"(y0));
        asm volatile("s_nop 1\n\tv_permlane16_swap_b32 %0, %1" : "+v"(x1), "+v"(y1));
        b0 = (unsigned long long)x0 | ((unsigned long long)x1 << 32); b1 = (unsigned long long)y0 | ((unsigned long long)y1 << 32);
    }
    __device__ __forceinline__ void mid(f32x4 (&acc)[2][2][4][2], const Unit& u, int wr, int wc, int fr, int fq) const {
        const size_t row0 = (size_t)u.pm * BM + wr * 64 + fr; const int col0 = u.pn * BM + 64 * wc + 8 * fq;
        const int gofs = u.pn * BM + 64 * wc + ((fq & 1) ? 32 + 8 * (fq - 1) : 8 * fq);
        const unsigned char* G1 = (const unsigned char*)(ws + WS_G) + u.idx * 1024 + gofs; const unsigned char* G2 = G1 + 1024;
#pragma unroll
        for (int ai = 0; ai < 2; ++ai) { u32x4 r1[4], r2[4];
#pragma unroll
            for (int m = 0; m < 4; ++m) { const size_t off = (row0 + ai * HALF + m * 16) * 3072; r1[m] = *(const u32x4*)(G1 + off); r2[m] = *(const u32x4*)(G2 + off); }
#pragma unroll
            for (int m = 0; m < 4; ++m) { unsigned long long a1[2], a2[2]; gsplit(r1[m], a1[0], a1[1]); gsplit(r2[m], a2[0], a2[1]);
#pragma unroll
                for (int bj = 0; bj < 2; ++bj) {
                    const f32x4 d0 = nz(g4((unsigned)a2[bj])), d1 = nz(g4((unsigned)(a2[bj] >> 32))), n0 = nz(g4((unsigned)a1[bj])), n1 = nz(g4((unsigned)(a1[bj] >> 32)));
                    const f32x4 r0 = {n0[0] * __builtin_amdgcn_rcpf(d0[0]), n0[1] * __builtin_amdgcn_rcpf(d0[1]), n0[2] * __builtin_amdgcn_rcpf(d0[2]), n0[3] * __builtin_amdgcn_rcpf(d0[3])}, rr1 = {n1[0] * __builtin_amdgcn_rcpf(d1[0]), n1[1] * __builtin_amdgcn_rcpf(d1[1]), n1[2] * __builtin_amdgcn_rcpf(d1[2]), n1[3] * __builtin_amdgcn_rcpf(d1[3])};
                    acc[ai][bj][m][0] = acc[ai][bj][m][0] * r0; acc[ai][bj][m][1] = acc[ai][bj][m][1] * rr1; } } }
    }
    __device__ __forceinline__ void operator()(const f32x4 (&acc)[2][2][4][2], const Unit& u, int wr, int wc, int fr, int fq) const {
        const size_t row0 = (size_t)u.pm * BM + wr * 64 + fr; const int col0 = u.pn * BM + 64 * wc + 8 * fq;
        const unsigned char* G2 = (const unsigned char*)(ws + WS_G) + u.idx * 1024 + u.pn * BM + 64 * wc + ((fq & 1) ? 32 + 8 * (fq - 1) : 8 * fq); bf16_t* O = (bf16_t*)(ws + WS_Q);
#pragma unroll
        for (int ai = 0; ai < 2; ++ai) { u32x4 rg[4];
#pragma unroll
            for (int m = 0; m < 4; ++m) rg[m] = *(const u32x4*)(G2 + (row0 + ai * HALF + m * 16) * 3072);
#pragma unroll
            for (int m = 0; m < 4; ++m) { const size_t row = row0 + ai * HALF + m * 16; unsigned long long gw[2]; gsplit(rg[m], gw[0], gw[1]);
#pragma unroll
                for (int bj = 0; bj < 2; ++bj) { const int col = col0 + 32 * bj;
                    const f32x4 g0 = nz(g4((unsigned)gw[bj])), g1 = nz(g4((unsigned)(gw[bj] >> 32)));
                    *(u32x4*)(O + row * 1024 + col) = pk8(acc[ai][bj][m][0] * g0, acc[ai][bj][m][1] * g1); } } }
    }
};

struct EpiRes {
    static constexpr bool PERM = false, AFTER_DRAIN = false, I8 = false, F8 = false, MID = false;
    const float* xin; float* x; unsigned char* ws; size_t xb_off; size_t dry_off;
    __device__ __forceinline__ void operator()(const f32x4 (&acc)[2][2][4][2], const Unit& u, int wr, int wc, int fr, int fq) const {
        const size_t row0 = (size_t)u.pm * BM + wr * 64 + fr; const int col0 = u.pn * BM + 64 * wc + 8 * fq;
        float* xout = dry_off ? (float*)(ws + dry_off) : x; bf16_t* xb = (bf16_t*)(ws + xb_off); float* ss = (float*)(ws + WS_SS);
#pragma unroll
        for (int ai = 0; ai < 2; ++ai)
#pragma unroll
            for (int m = 0; m < 4; ++m) { const size_t row = row0 + ai * HALF + m * 16; float s2 = 0.f;
#pragma unroll
                for (int bj = 0; bj < 2; ++bj) { const size_t off = row * 1024 + col0 + 32 * bj;
                    const f32x4 a = *(const f32x4*)(xin + off) + acc[ai][bj][m][0], b = *(const f32x4*)(xin + off + 4) + acc[ai][bj][m][1];
                    *(f32x4*)(xout + off) = a; *(f32x4*)(xout + off + 4) = b;
                    if (xb_off) { *(u32x4*)(xb + off) = pk8(a, b); s2 += ((a[0] * a[0] + a[1] * a[1]) + (a[2] * a[2] + a[3] * a[3])) + ((b[0] * b[0] + b[1] * b[1]) + (b[2] * b[2] + b[3] * b[3])); } }
                if (xb_off) { s2 += __shfl_xor(s2, 16); s2 += __shfl_xor(s2, 32); if (fq == 0) ss[row * 16 + u.pn * 4 + wc] = s2; } }
    }
};

struct EpiResB {
    static constexpr bool PERM = false, AFTER_DRAIN = false, I8 = false, F8 = false, MID = false;
    const float* xf; bf16_t* xs;
    __device__ __forceinline__ void operator()(const f32x4 (&acc)[2][2][4][2], const Unit& u, int wr, int wc, int fr, int fq) const {
        const size_t row0 = (size_t)u.pm * BM + wr * 64 + fr; const int col0 = u.pn * BM + 64 * wc + 8 * fq;
        if (xf) {
#pragma unroll
            for (int ai = 0; ai < 2; ++ai)
#pragma unroll
                for (int m = 0; m < 4; ++m) { const size_t row = row0 + ai * HALF + m * 16;
#pragma unroll
                    for (int bj = 0; bj < 2; ++bj) { const size_t off = row * 1024 + col0 + 32 * bj; const f32x4 a = *(const f32x4*)(xf + off), b = *(const f32x4*)(xf + off + 4);
                        *(u32x4*)(xs + off) = pk8(a + acc[ai][bj][m][0], b + acc[ai][bj][m][1]); } }
        } else {
#pragma unroll
            for (int ai = 0; ai < 2; ++ai) { u32x4 w[4][2];
#pragma unroll
                for (int m = 0; m < 4; ++m)
#pragma unroll
                    for (int bj = 0; bj < 2; ++bj) w[m][bj] = *(const u32x4*)(xs + (row0 + ai * HALF + m * 16) * 1024 + col0 + 32 * bj);
#pragma unroll
                for (int m = 0; m < 4; ++m)
#pragma unroll
                    for (int bj = 0; bj < 2; ++bj) { const size_t off = (row0 + ai * HALF + m * 16) * 1024 + col0 + 32 * bj; const u32x4 x = w[m][bj];
                        const f32x4 a = {bf_lo(x.x), bf_hi(x.x), bf_lo(x.y), bf_hi(x.y)}, b = {bf_lo(x.z), bf_hi(x.z), bf_lo(x.w), bf_hi(x.w)};
                        *(u32x4*)(xs + off) = pk8(a + acc[ai][bj][m][0], b + acc[ai][bj][m][1]); } }
        }
    }
};

template <bool I8_, bool OUT8 = false> struct EpiSwiglu {
    static constexpr bool PERM = false, AFTER_DRAIN = false, I8 = I8_, F8 = false, MID = false;
    bf16_t* H; int ldc; const PG8_LAS float* rs; const float* cmax; int nh;
    const PG8_LAS int* texp; int t0;
    __device__ __forceinline__ void operator()(const f32x4 (&acc)[2][2][4][2], const Unit& u, int wr, int wc, int fr, int fq) const {
        const int rl = wr * 64 + fr; const size_t row0 = (size_t)u.pm * BM + rl; const int col0 = u.pn * 128 + 32 * wc + 8 * fq;
        f32x4 c1[2], c3[2]; unsigned pw0 = 0u, pw1 = 0u;
#pragma unroll
        for (int bj = 0; bj < 2; ++bj) { if constexpr (I8_) { const float* cm = cmax + (texp ? (size_t)texp[t0 + u.pm] * 2 * nh : 0) + col0 + 4 * bj; c1[bj] = *(const f32x4*)cm * (-1.4426950408889634f / 127.0f); c3[bj] = *(const f32x4*)(cm + nh) * ((OUT8 ? H8_SCALE : 1.0f) * -0.6931471805599453f / 127.0f); } else { c1[bj] = (f32x4){-1.4426950408889634f, -1.4426950408889634f, -1.4426950408889634f, -1.4426950408889634f}; c3[bj] = (f32x4){-0.6931471805599453f, -0.6931471805599453f, -0.6931471805599453f, -0.6931471805599453f}; } }
#pragma unroll
        for (int ai = 0; ai < 2; ++ai)
#pragma unroll
            for (int m = 0; m < 4; ++m) { const float sc = rs[u.idx * 256 + rl + ai * HALF + m * 16]; f32x4 h[2];
#pragma unroll
                for (int bj = 0; bj < 2; ++bj) { const f32x4 a = accf<I8_>(acc[ai][bj][m][0]) * c1[bj] * sc, b = accf<I8_>(acc[ai][bj][m][1]) * c3[bj] * sc;
#pragma unroll
                    for (int j = 0; j < 4; ++j) h[bj][j] = a[j] * b[j] * __builtin_amdgcn_rcpf(1.0f + __builtin_amdgcn_exp2f(a[j])); }
                if constexpr (OUT8) {
#pragma unroll
                    for (int bj = 0; bj < 2; ++bj)
#pragma unroll
                        for (int j = 0; j < 4; ++j) h[bj][j] = __builtin_amdgcn_fmed3f(h[bj][j], -448.0f, 448.0f);
                    const unsigned w0 = pk_fp8x4(h[0][0], h[0][1], h[0][2], h[0][3]), w1 = pk_fp8x4(h[1][0], h[1][1], h[1][2], h[1][3]);
                    if ((m & 1) == 0) { pw0 = w0; pw1 = w1; }
                    else { unsigned q0 = w0, q1 = w1;
                        asm volatile("s_nop 1\n\tv_permlane16_swap_b32 %0, %1" : "+v"(pw0), "+v"(q0));
                        asm volatile("s_nop 1\n\tv_permlane16_swap_b32 %0, %1" : "+v"(pw1), "+v"(q1));
                        *(u32x4*)((unsigned char*)H + (row0 + ai * HALF + (m - 1 + (fq & 1)) * 16) * ldc + col0 - 8 * (fq & 1)) = (u32x4){pw0, pw1, q0, q1}; }
                } else *(u32x4*)(H + (row0 + ai * HALF + m * 16) * ldc + col0) = pk8(h[0], h[1]); }
    }
};

struct EpiStoreF8 {
    static constexpr bool PERM = false, AFTER_DRAIN = false, I8 = false, F8 = true, MID = false;
    bf16_t* O; int ldc; const float* cs; const PG8_LAS int* texp; int t0;
    __device__ __forceinline__ void operator()(const f32x4 (&acc)[2][2][4][2], const Unit& u, int wr, int wc, int fr, int fq) const {
        const int rl = wr * 64 + fr; const size_t row0 = (size_t)u.pm * BM + rl; const int col0 = u.pn * BM + 64 * wc + 8 * fq;
        const float* c = cs + (texp ? (size_t)texp[t0 + u.pm] * 1024 : 0) + col0; f32x4 cw[2][2];
#pragma unroll
        for (int bj = 0; bj < 2; ++bj)
#pragma unroll
            for (int n = 0; n < 2; ++n) cw[bj][n] = *(const f32x4*)(c + 32 * bj + 4 * n);
#pragma unroll
        for (int ai = 0; ai < 2; ++ai)
#pragma unroll
            for (int m = 0; m < 4; ++m) { bf16_t* rowp = O + (row0 + ai * HALF + m * 16) * ldc + col0;
#pragma unroll
                for (int bj = 0; bj < 2; ++bj) *(u32x4*)(rowp + 32 * bj) = pk8(acc[ai][bj][m][0] * cw[bj][0], acc[ai][bj][m][1] * cw[bj][1]); }
    }
};
struct EpiResB8 {
    static constexpr bool PERM = false, AFTER_DRAIN = false, I8 = false, F8 = true, MID = false;
    bf16_t* xs; const float* cs;
    __device__ __forceinline__ void operator()(const f32x4 (&acc)[2][2][4][2], const Unit& u, int wr, int wc, int fr, int fq) const {
        const size_t row0 = (size_t)u.pm * BM + wr * 64 + fr; const int col0 = u.pn * BM + 64 * wc + 8 * fq; f32x4 cw[2][2];
#pragma unroll
        for (int bj = 0; bj < 2; ++bj)
#pragma unroll
            for (int n = 0; n < 2; ++n) cw[bj][n] = *(const f32x4*)(cs + col0 + 32 * bj + 4 * n);
#pragma unroll
        for (int ai = 0; ai < 2; ++ai) { u32x4 w[4][2];
#pragma unroll
            for (int m = 0; m < 4; ++m)
#pragma unroll
                for (int bj = 0; bj < 2; ++bj) w[m][bj] = *(const u32x4*)(xs + (row0 + ai * HALF + m * 16) * 1024 + col0 + 32 * bj);
#pragma unroll
            for (int m = 0; m < 4; ++m)
#pragma unroll
                for (int bj = 0; bj < 2; ++bj) { const size_t off = (row0 + ai * HALF + m * 16) * 1024 + col0 + 32 * bj; const u32x4 x = w[m][bj];
                    const f32x4 a = {bf_lo(x.x), bf_hi(x.x), bf_lo(x.y), bf_hi(x.y)}, b = {bf_lo(x.z), bf_hi(x.z), bf_lo(x.w), bf_hi(x.w)};
                    *(u32x4*)(xs + off) = pk8(a + acc[ai][bj][m][0] * cw[bj][0], b + acc[ai][bj][m][1] * cw[bj][1]); } }
    }
};
template <class Epi, class Sched, bool ALIGN_EPI = false, bool SP2 = false>
__device__ __forceinline__ void gemm_phase(PG8_LAS unsigned char* lds, const Gemm g, const Sched& S, const Epi& E) {
    int tid_ = threadIdx.x; asm volatile("" : "+v"(tid_));
    const int tid = tid_, wid = __builtin_amdgcn_readfirstlane(tid >> 6), lane = tid & 63, wr = wid >> 2, wc = wid & 3, fr = lane & 15, fq = lane >> 4;
    int K = g.K, nt = K / BK;
    static_assert(!(Epi::MID && Epi::PERM), "MID: one offset set for A and B");
    unsigned voffA[2], voffB[2], r2_[2], c2_[2];
#pragma unroll
    for (int i = 0; i < 2; ++i) { int R, C; stage_rc(tid * 16 + i * 8192, R, C); const int Rb = Epi::PERM ? ((R & ~31) + perm32(R & 31)) : R;
        voffA[i] = (unsigned)(R * K + C) * 2u; voffB[i] = (unsigned)(Rb * K + C) * 2u; r2_[i] = (unsigned)R * 2u; c2_[i] = (unsigned)C * 2u; }
    const size_t kstep = (size_t)(BK * 2);
    size_t hstep = (size_t)HALF * K * 2;
    size_t tstep = 2 * hstep;
    const unsigned ldsw = (unsigned)wid * 1024u;
    const int aoff = lds_byte(wr * 64 + fr, fq * 8), boff = lds_byte(wc * 32 + fr, fq * 8);
#define PG8_SA(b, h) (((b) * 2 + (h)) * HTB)
#define PG8_SB(b, h) ((4 + (b) * 2 + (h)) * HTB)
#define PG8_STAGE(bufoff, gbase, voff) do { _Pragma("unroll") for (int _i = 0; _i < 2; ++_i) \
        __builtin_amdgcn_global_load_lds((const unsigned*)((const char*)(gbase) + (voff)[_i]), (PG8_LAS unsigned*)(lds + (bufoff) + ldsw + _i * 8192), 16, 0, 0); } while (0)
#define PG8_LDA(dst, b, h) do { if constexpr (Epi::F8) { _Pragma("unroll") for (int m = 0; m < 4; ++m) { const i32x4 lo_ = *(const PG8_LAS i32x4*)(lds + PG8_SA(b, h) + aoff + m * 2048), hi_ = *(const PG8_LAS i32x4*)(lds + PG8_SA(b, h) + aoff + m * 2048 + 1024); dst##8[m] = __builtin_shufflevector(lo_, hi_, 0, 1, 2, 3, 4, 5, 6, 7); } } \
        else { _Pragma("unroll") for (int m = 0; m < 4; ++m) _Pragma("unroll") for (int k = 0; k < 2; ++k) dst[m][k] = *(const PG8_LAS bf16x8*)(lds + PG8_SA(b, h) + aoff + m * 2048 + k * 1024); } } while (0)
#define PG8_LDB(dst, b, h) do { if constexpr (Epi::F8) { _Pragma("unroll") for (int n = 0; n < 2; ++n) { const i32x4 lo_ = *(const PG8_LAS i32x4*)(lds + PG8_SB(b, h) + boff + n * 2048), hi_ = *(const PG8_LAS i32x4*)(lds + PG8_SB(b, h) + boff + n * 2048 + 1024); dst##8[n] = __builtin_shufflevector(lo_, hi_, 0, 1, 2, 3, 4, 5, 6, 7); } } \
        else { _Pragma("unroll") for (int n = 0; n < 2; ++n) _Pragma("unroll") for (int k = 0; k < 2; ++k) dst[n][k] = *(const PG8_LAS bf16x8*)(lds + PG8_SB(b, h) + boff + n * 2048 + k * 1024); } } while (0)
#define PG8_MMA(ai, bj, At, Bt) do { __builtin_amdgcn_s_setprio(1); if constexpr (Epi::F8) { _Pragma("unroll") for (int m = 0; m < 4; ++m) _Pragma("unroll") for (int n = 0; n < 2; ++n) acc[ai][bj][m][n] = mma_f8(Bt##8[n], At##8[m], acc[ai][bj][m][n]); } \
        else { _Pragma("unroll") for (int m = 0; m < 4; ++m) _Pragma("unroll") for (int n = 0; n < 2; ++n) _Pragma("unroll") for (int k = 0; k < 2; ++k) acc[ai][bj][m][n] = mma16<Epi::I8>(Bt[n][k], At[m][k], acc[ai][bj][m][n]); } __builtin_amdgcn_s_setprio(0); } while (0)
#define PG8_WAIT_V(n) asm volatile("s_waitcnt vmcnt(" #n ")" ::: "memory")
#define PG8_WAIT_L(n) asm volatile("s_waitcnt lgkmcnt(" #n ")" ::: "memory")
#define PG8_BAR __builtin_amdgcn_s_barrier()
#define PG8_SCHED __builtin_amdgcn_sched_barrier(0)
    Unit cur, nxt; int ui = 0;
    if (!S.next(0, cur)) return;
    f32x4 acc[2][2][4][2];
#pragma unroll
    for (int a = 0; a < 2; ++a)
#pragma unroll
        for (int b = 0; b < 2; ++b)
#pragma unroll
            for (int m = 0; m < 4; ++m)
#pragma unroll
                for (int n = 0; n < 2; ++n) acc[a][b][m][n] = (f32x4){0.f, 0.f, 0.f, 0.f};
    bf16x8 At[4][2], B0[2][2], B1[2][2];
    i32x8 At8[4], B08[2], B18[2];
    const char* cA = S.aptr(g, cur, tstep); const char* cB = S.bptr(g, cur, tstep);
    S.a_ready(cur);
    if constexpr (SP2) {
        PG8_STAGE(PG8_SB(0, 0), cB, voffB); PG8_STAGE(PG8_SB(0, 1), cB + hstep, voffB); PG8_STAGE(PG8_SA(0, 0), cA, voffA); PG8_STAGE(PG8_SA(0, 1), cA + hstep, voffA);
        S.prep();
        if (wr == 1) PG8_BAR;
        PG8_WAIT_V(2); PG8_BAR;
        PG8_STAGE(PG8_SB(1, 0), cB + kstep, voffB); PG8_STAGE(PG8_SA(1, 0), cA + kstep, voffA); PG8_STAGE(PG8_SB(1, 1), cB + hstep + kstep, voffB);
        PG8_WAIT_V(6); PG8_BAR;
    } else {
        PG8_STAGE(PG8_SB(0, 0), cB, voffB); PG8_STAGE(PG8_SA(0, 0), cA, voffA); PG8_STAGE(PG8_SB(0, 1), cB + hstep, voffB); PG8_STAGE(PG8_SA(0, 1), cA + hstep, voffA);
        if (wr == 1) PG8_BAR;
        PG8_WAIT_V(4); PG8_BAR;
        PG8_STAGE(PG8_SB(1, 0), cB + kstep, voffB); PG8_STAGE(PG8_SA(1, 0), cA + kstep, voffA); PG8_STAGE(PG8_SB(1, 1), cB + hstep + kstep, voffB);
        PG8_WAIT_V(6); PG8_BAR;
    }
    for (;;) {
        const bool has_next = S.next(ui + 1, nxt);
        int Kn = K; unsigned vAn[2] = {voffA[0], voffA[1]}; size_t hsn = hstep, tsn = tstep;
        if constexpr (Epi::MID) { if (has_next) { Kn = S.kof(g, nxt); vAn[0] = r2_[0] * (unsigned)Kn + c2_[0]; vAn[1] = r2_[1] * (unsigned)Kn + c2_[1]; hsn = (size_t)HALF * Kn * 2; tsn = 2 * hsn; } }
        const char* nA = has_next ? S.aptr(g, nxt, tsn) : cA; const char* nB = has_next ? S.bptr(g, nxt, tsn) : cB;
        for (int t = 0; t < nt; t += 2) {
            const bool last = (t == nt - 2);
            const char* a1 = cA + (size_t)(t + 1) * kstep;
            const char* a2 = last ? nA : cA + (size_t)(t + 2) * kstep; const char* b2 = last ? nB : cB + (size_t)(t + 2) * kstep;
            const char* a3 = a2 + kstep; const char* b3 = b2 + kstep;
            if (last && has_next) S.a_ready(nxt);
            const bool nx_ = Epi::MID && last; const unsigned vA2[2] = {nx_ ? vAn[0] : voffA[0], nx_ ? vAn[1] : voffA[1]}, vB2[2] = {nx_ ? vAn[0] : voffB[0], nx_ ? vAn[1] : voffB[1]}; const size_t hs2 = nx_ ? hsn : hstep;
            if constexpr (SP2) {
            PG8_LDB(B0, 0, 0); PG8_LDB(B1, 0, 1); PG8_SCHED; PG8_LDA(At, 0, 0); PG8_STAGE(PG8_SA(1, 1), a1 + hstep, voffA);
            PG8_WAIT_V(8); PG8_WAIT_L(0); PG8_BAR; PG8_MMA(0, 0, At, B0); PG8_MMA(0, 1, At, B1); PG8_BAR; PG8_SCHED;
            PG8_LDA(At, 0, 1); PG8_STAGE(PG8_SB(0, 0), b2, vB2); PG8_STAGE(PG8_SB(0, 1), b2 + hs2, vB2); PG8_STAGE(PG8_SA(0, 0), a2, vA2);
            PG8_WAIT_V(8); PG8_WAIT_L(0); PG8_BAR; PG8_MMA(1, 0, At, B0); PG8_MMA(1, 1, At, B1); PG8_BAR; PG8_SCHED;
            PG8_LDB(B0, 1, 0); PG8_LDB(B1, 1, 1); PG8_SCHED; PG8_LDA(At, 1, 0); PG8_STAGE(PG8_SA(0, 1), a2 + hs2, vA2);
            PG8_WAIT_V(8); PG8_WAIT_L(0); PG8_BAR; PG8_MMA(0, 0, At, B0); PG8_MMA(0, 1, At, B1); PG8_BAR; PG8_SCHED;
            PG8_LDA(At, 1, 1); PG8_STAGE(PG8_SB(1, 0), b3, vB2); PG8_STAGE(PG8_SB(1, 1), b3 + hs2, vB2); PG8_STAGE(PG8_SA(1, 0), a3, vA2);
            PG8_WAIT_V(8); PG8_WAIT_L(0); PG8_BAR; PG8_MMA(1, 0, At, B0); PG8_MMA(1, 1, At, B1); PG8_BAR; PG8_SCHED;
            } else {
            PG8_LDB(B0, 0, 0); PG8_SCHED; PG8_LDA(At, 0, 0); PG8_STAGE(PG8_SA(1, 1), a1 + hstep, voffA);
            PG8_WAIT_L(8); PG8_BAR; PG8_WAIT_L(0); PG8_MMA(0, 0, At, B0); PG8_BAR; PG8_SCHED;
            PG8_LDB(B1, 0, 1); PG8_STAGE(PG8_SB(0, 0), b2, voffB);
            PG8_BAR; PG8_WAIT_L(0); PG8_MMA(0, 1, At, B1); PG8_BAR;
            PG8_LDA(At, 0, 1); PG8_STAGE(PG8_SA(0, 0), a2, voffA);
            PG8_BAR; PG8_WAIT_L(0); PG8_MMA(1, 0, At, B0); PG8_BAR; PG8_SCHED;
            PG8_STAGE(PG8_SB(0, 1), b2 + hstep, voffB);
            PG8_WAIT_V(6); PG8_BAR; PG8_MMA(1, 1, At, B1); PG8_BAR;
            PG8_LDB(B0, 1, 0); PG8_SCHED; PG8_LDA(At, 1, 0); PG8_STAGE(PG8_SA(0, 1), a2 + hstep, voffA);
            PG8_WAIT_L(8); PG8_BAR; PG8_WAIT_L(0); PG8_MMA(0, 0, At, B0); PG8_BAR; PG8_SCHED;
            PG8_LDB(B1, 1, 1); PG8_STAGE(PG8_SB(1, 0), b3, voffB);
            PG8_BAR; PG8_WAIT_L(0); PG8_MMA(0, 1, At, B1); PG8_BAR;
            PG8_LDA(At, 1, 1); PG8_STAGE(PG8_SA(1, 0), a3, voffA);
            PG8_BAR; PG8_WAIT_L(0); PG8_MMA(1, 0, At, B0); PG8_BAR; PG8_SCHED;
            PG8_STAGE(PG8_SB(1, 1), b3 + hstep, voffB);
            PG8_WAIT_V(6); PG8_BAR; PG8_MMA(1, 1, At, B1); PG8_BAR;
            }
        }
        if constexpr (ALIGN_EPI) { if (wr == 0) PG8_BAR; }
        asm volatile("" : "+s"(cur.pm), "+s"(cur.pn), "+s"(cur.idx));
        bool keep_ = false;
        if constexpr (Epi::MID) { if (has_next) { E.mid(acc, cur, wr, wc, fr, fq); keep_ = true; } }
        if constexpr (!Epi::AFTER_DRAIN) { if (!keep_ && !(S.skip & 1)) E(acc, cur, wr, wc, fr, fq); S.done(cur); }
        if (!has_next) break;
        if (!keep_)
#pragma unroll
        for (int a = 0; a < 2; ++a)
#pragma unroll
            for (int b = 0; b < 2; ++b)
#pragma unroll
                for (int m = 0; m < 4; ++m)
#pragma unroll
                    for (int n = 0; n < 2; ++n) acc[a][b][m][n] = (f32x4){0.f, 0.f, 0.f, 0.f};
        cur = nxt; cA = nA; cB = nB; ++ui;
        if constexpr (Epi::MID) { K = Kn; nt = K / BK; voffA[0] = vAn[0]; voffA[1] = vAn[1]; voffB[0] = vAn[0]; voffB[1] = vAn[1]; hstep = hsn; tstep = tsn; }
        if constexpr (ALIGN_EPI) { if (wr == 1) PG8_BAR; }
    }
    PG8_WAIT_V(0);
    if constexpr (!ALIGN_EPI) { if (wr == 0) PG8_BAR; }
    PG8_BAR;
    if constexpr (Epi::AFTER_DRAIN) { E.fused(acc, cur, wr, wc, fr, fq, lds, wid, lane); S.done(cur); }
#undef PG8_SA
#undef PG8_SB
#undef PG8_STAGE
#undef PG8_LDA
#undef PG8_LDB
#undef PG8_MMA
#undef PG8_WAIT_V
#undef PG8_WAIT_L
#undef PG8_BAR
#undef PG8_SCHED
}
}
#define GAS __attribute__((address_space(1)))
#define LAS __attribute__((address_space(3)))
typedef unsigned short bf16_t;
typedef unsigned v4u __attribute__((ext_vector_type(4)));
typedef float f32x4 __attribute__((ext_vector_type(4)));
typedef float f32x2 __attribute__((ext_vector_type(2)));
#define RLX_AGENT __ATOMIC_RELAXED, __HIP_MEMORY_SCOPE_AGENT
template <int CTRL> __device__ __forceinline__ float dppf(float v) { return __builtin_bit_cast(float, __builtin_amdgcn_update_dpp(0, __builtin_bit_cast(int, v), CTRL, 0xf, 0xf, true)); }
__device__ __forceinline__ float rdl(float v, int l) { return __builtin_bit_cast(float, __builtin_amdgcn_readlane(__builtin_bit_cast(int, v), l)); }
__device__ __forceinline__ float wave_sum(float v) {
    v += dppf<0xB1>(v); v += dppf<0x4E>(v); v += dppf<0x141>(v); v += dppf<0x140>(v);
    return (rdl(v, 0) + rdl(v, 16)) + (rdl(v, 32) + rdl(v, 48));
}
__device__ __forceinline__ float wave_max(float v) {
    v = fmaxf(v, dppf<0xB1>(v)); v = fmaxf(v, dppf<0x4E>(v)); v = fmaxf(v, dppf<0x141>(v)); v = fmaxf(v, dppf<0x140>(v));
    return fmaxf(fmaxf(rdl(v, 0), rdl(v, 16)), fmaxf(rdl(v, 32), rdl(v, 48)));
}
__device__ __forceinline__ float ld_f32_agent(const float* p) { return __builtin_bit_cast(float, __builtin_amdgcn_readfirstlane(__hip_atomic_load((const unsigned*)p, RLX_AGENT))); }
__device__ __forceinline__ float ld_f32_plain(const float* p) { return *(const GAS float*)p; }
__device__ __forceinline__ int ld_i32_agent(const int* p) { return (int)__hip_atomic_load((const unsigned*)p, RLX_AGENT); }
using pg8::pk_bf16; using pg8::bf_lo; using pg8::bf_hi;

#define XB_TMO      128
#define XB_XCNT(j)  (256  + 64 * (j))
#define XB_XSUB(j)  (1280 + 64 * (j))
#define XB_XGEN(j)  (2304 + 64 * (j))
#define XB_TOP      3328
#define XB_TOPGEN   3392
#define XCD_BAR_WORDS 3456
#define XB_SPIN_CAP (1u << 18)

__device__ __forceinline__ unsigned xb_ld(unsigned* p)              { return __hip_atomic_load(p, __ATOMIC_RELAXED, __HIP_MEMORY_SCOPE_AGENT); }
__device__ __forceinline__ unsigned xb_add(unsigned* p, unsigned v) { return __hip_atomic_fetch_add(p, v, __ATOMIC_RELAXED, __HIP_MEMORY_SCOPE_AGENT); }
__device__ __forceinline__ unsigned xb_xcc_id() { return (unsigned)__builtin_amdgcn_s_getreg((3 << 11) | 20) & 0xFu; }
#define XB_SPIN(cond, bar) do { unsigned _sp = 0; while (cond) { __builtin_amdgcn_s_sleep(1); \
    if ((++_sp & 255u) == 0u) { if (xb_ld(&(bar)[XB_TMO])) break; if (_sp > XB_SPIN_CAP) { atomicAdd(&(bar)[XB_TMO], 1u); break; } } } } while (0)

struct XcdBarrier {
    unsigned* bar; unsigned x;
    volatile LAS unsigned* st;
};

__device__ __forceinline__ XcdBarrier xcd_barrier_post(unsigned* bar, volatile LAS unsigned* st) {
    XcdBarrier b; b.bar = bar; b.x = xb_xcc_id(); b.st = st;
    if (threadIdx.x == 0) (void)xb_add(&bar[XB_XCNT(b.x)], 1u);
    return b;
}
__device__ __forceinline__ void xcd_barrier_complete(unsigned* bar, unsigned x, unsigned& nloc, unsigned& nx) {
    const unsigned G = gridDim.x * gridDim.y * gridDim.z;
    unsigned sum, cnt, mine, sp = 0u;
    for (;;) {
        sum = 0u; cnt = 0u; mine = 0u;
#pragma unroll
        for (unsigned j = 0; j < 16; ++j) { const unsigned c = xb_ld(&bar[XB_XCNT(j)]); sum += c; cnt += (c > 0u) ? 1u : 0u; mine = (j == x) ? c : mine; }
        if (sum == G) break;
        __builtin_amdgcn_s_sleep(1);
        if ((++sp & 255u) == 0u) { if (xb_ld(&bar[XB_TMO])) break; if (sp > XB_SPIN_CAP) { atomicAdd(&bar[XB_TMO], 1u); break; } }
    }
    nloc = mine > 0u ? mine : 1u; nx = cnt > 0u ? cnt : 1u;
}

__device__ __forceinline__ void xcd_barrier(const XcdBarrier& b) {
    asm volatile("s_waitcnt vmcnt(0)" ::: "memory");
    __syncthreads();
    if (threadIdx.x == 0) {
        unsigned* bar = b.bar;
        __builtin_amdgcn_s_waitcnt(0);
        unsigned nloc = b.st[0], nx = b.st[1];
        if (nloc == 0u) { xcd_barrier_complete(bar, b.x, nloc, nx); b.st[0] = nloc; b.st[1] = nx; }
        const unsigned old = xb_add(&bar[XB_XSUB(b.x)], 1u);
        const unsigned gen = old / nloc;
        if (old + 1u == (gen + 1u) * nloc) {
            __builtin_amdgcn_fence(__ATOMIC_RELEASE, "agent");
            asm volatile("s_waitcnt vmcnt(0)" ::: "memory");
            const unsigned og = xb_add(&bar[XB_TOP], 1u);
            const unsigned tg = og / nx;
            if (og + 1u == (tg + 1u) * nx) xb_add(&bar[XB_TOPGEN], 1u);
            else XB_SPIN(xb_ld(&bar[XB_TOPGEN]) == tg, bar);
            __builtin_amdgcn_fence(__ATOMIC_ACQUIRE, "agent");
            xb_add(&bar[XB_XGEN(b.x)], 1u);
            asm volatile("s_waitcnt vmcnt(0)" ::: "memory");
        } else {
            XB_SPIN(xb_ld(&bar[XB_XGEN(b.x)]) == gen, bar);
            __builtin_amdgcn_fence(__ATOMIC_ACQUIRE, "agent");
            asm volatile("s_waitcnt vmcnt(0)" ::: "memory");
        }
    }
    __syncthreads();
}

__device__ __forceinline__ void group_barrier(unsigned* ctr, unsigned target, unsigned* tmo, bool colo) {
    asm volatile("s_waitcnt vmcnt(0)" ::: "memory");
    __syncthreads();
    if (threadIdx.x == 0) {
        __builtin_amdgcn_s_waitcnt(0);
        if (!colo) { __builtin_amdgcn_fence(__ATOMIC_RELEASE, "agent"); asm volatile("s_waitcnt vmcnt(0)" ::: "memory"); }
        (void)xb_add(ctr, 1u);
        XB_SPIN(xb_ld(ctr) < target, tmo);
        __builtin_amdgcn_fence(__ATOMIC_ACQUIRE, "agent");
        asm volatile("s_waitcnt vmcnt(0)" ::: "memory");
    }
    __syncthreads();
}


struct Args { const float* in[31]; float* out; unsigned char* ws; int ph_lo, ph_hi, flags, pad_; };

struct TJob { unsigned long long src, dst, gain; int K, N, ld, map, colbase, start, q8, smax, startq, f8, startf, startw; };
constexpr int NJOBS = 41;
__device__ __forceinline__ void make_job(int j, const Args& a, TJob& o) {
    unsigned char* ws = a.ws; const float* src; void* dst; const float* gain = nullptr; o.map = 0; o.colbase = 0; o.q8 = 0; o.smax = 0; o.f8 = 0;
    if (j < 14) { const int l = j / 7, t = j % 7;
        if (t == 0)      { src = a.in[5] + (size_t)l * D * 4096; o.K = D; o.N = 4096; dst = ws + WS_W1T + l * 14 * MiB; gain = a.in[2] + l * D; o.q8 = I8_A; o.smax = SW_G1 + l * 7168; }
        else if (t == 1) { src = a.in[6] + (size_t)l * D * 3072; o.K = D; o.N = 3072; dst = ws + WS_W1T + l * 14 * MiB; gain = a.in[2] + l * D; o.colbase = 4096; o.q8 = I8_A; o.smax = SW_G1 + l * 7168 + 4096; }
        else if (t == 2) { src = a.in[19] + (size_t)l * D * 1024; o.K = D; o.N = 1024; dst = ws + WS_WMEMKV + l * 2 * MiB; gain = a.in[3] + l * D; }
        else if (t == 3) { src = a.in[20] + (size_t)l * 1024 * D; o.K = 1024; o.N = D; dst = ws + WS_WBRDA + l * 2 * MiB; }
        else if (t == 4) { src = a.in[21] + (size_t)l * 512 * D; o.K = 512; o.N = D; dst = ws + WS_WBRPOOL + l * 1 * MiB; }
        else if (t == 5) { src = a.in[22] + (size_t)l * 512 * D; o.K = 512; o.N = D; dst = ws + WS_WBRMEM + l * 1 * MiB; }
        else             { src = a.in[23] + (size_t)l * D * D; o.K = D; o.N = D; dst = ws + WS_WOUT + l * 2 * MiB; }
    } else if (j < 17) { const int t = j - 14;
        if (t < 2) { src = a.in[24 + t]; o.K = D; o.N = FFD; dst = ws + WS_WFF13; gain = a.in[4]; o.map = 1 + t; o.q8 = I8_E; o.smax = SW_FF + t * FFD; }
        else       { src = a.in[26]; o.K = FFD; o.N = D; dst = ws + WS_WFF2; o.f8 = 1; o.smax = SW_W2 + 8 * 1024; }
    } else { const int e = (j - 17) / 3, t = (j - 17) % 3;
        if (t < 2) { src = a.in[28 + t] + (size_t)e * D * FFE; o.K = D; o.N = FFE; dst = ws + WS_WMOE13 + (size_t)e * 7 * MiB; gain = a.in[4] + D; o.map = 1 + t; o.q8 = USE_I8; o.smax = SW_MOE + e * 2 * FFE + t * FFE; }
        else       { src = a.in[30] + (size_t)e * FFE * D; o.K = FFE; o.N = D; dst = ws + WS_WMOE2 + (size_t)e * (7 * MiB / 2); o.f8 = 1; o.smax = SW_W2 + e * 1024; }
    }
    o.src = (unsigned long long)src; o.dst = (unsigned long long)dst; o.gain = (unsigned long long)gain; o.ld = o.N; o.start = 0; o.startq = 0; o.startf = 0; o.startw = 0;
}
__device__ __forceinline__ int bt_row_std(int C) { const int c = C & 255; return (C & ~255) + 128 * ((c >> 5) & 1) + 32 * (c >> 6) + 16 * ((c >> 2) & 1) + 4 * ((c >> 3) & 3) + (c & 3); }
__device__ __forceinline__ int bt_row_swiglu(int h, int which) { const int hl = h & 127; return 256 * (h >> 7) + 128 * ((hl >> 2) & 1) + 32 * (hl >> 5) + 16 * which + 4 * ((hl >> 3) & 3) + (hl & 3); }
struct TileRef { const GAS float* src; GAS bf16_t* dst; const GAS float* gain; int K, ld, map, colbase, k0, n0, q8, smax; };
template <bool QONLY> __device__ __forceinline__ void tile_decode(const LAS TJob* jobs, int& j, int it, TileRef& r) {
    if constexpr (QONLY) { while (it >= jobs[j + 1].startq) ++j; } else { while (it >= jobs[j + 1].start) ++j; }
    const LAS TJob* jb = jobs + j; const int item = it - (QONLY ? jb->startq : jb->start), nblk = jb->N >> 6;
    r.src = (const GAS float*)jb->src; r.dst = (GAS bf16_t*)jb->dst; r.gain = (const GAS float*)jb->gain; r.K = jb->K; r.ld = jb->ld; r.map = jb->map; r.colbase = jb->colbase; r.q8 = jb->q8; r.smax = jb->smax;
    r.k0 = (item / nblk) * 64; r.n0 = (item % nblk) * 64;
}
__device__ __forceinline__ void tile_load(const TileRef& r, int lane, f32x4 (&v)[16]) {
    const GAS float* p = r.src + (size_t)(r.k0 + (lane >> 4)) * r.ld + r.n0 + 4 * (lane & 15);
#pragma unroll
    for (int i = 0; i < 16; ++i) v[i] = __builtin_nontemporal_load((const GAS f32x4*)(p + (size_t)(4 * i) * r.ld));
}
__device__ __forceinline__ void tile_store(const TileRef& r, int lane, const f32x4 (&v)[16], LAS float* scr) {
#pragma unroll
    for (int i = 0; i < 16; ++i) { LAS float* d = scr + (4 * i + (lane >> 4)) * 65 + 4 * (lane & 15); d[0] = v[i][0]; d[1] = v[i][1]; d[2] = v[i][2]; d[3] = v[i][3]; }
    asm volatile("s_waitcnt lgkmcnt(0)" ::: "memory");
    const int kc = lane & 7;
    f32x4 g0 = {1.f, 1.f, 1.f, 1.f}, g1 = g0;
    if (r.gain) { g0 = *(const GAS f32x4*)(r.gain + r.k0 + 8 * kc); g1 = *(const GAS f32x4*)(r.gain + r.k0 + 8 * kc + 4); }
#pragma unroll
    for (int jj = 0; jj < 8; ++jj) { const int n = (lane >> 3) + 8 * jj; const LAS float* s = scr + (8 * kc) * 65 + n;
        v4u o; o.x = pk_bf16(s[0 * 65] * g0[0], s[1 * 65] * g0[1]); o.y = pk_bf16(s[2 * 65] * g0[2], s[3 * 65] * g0[3]); o.z = pk_bf16(s[4 * 65] * g1[0], s[5 * 65] * g1[1]); o.w = pk_bf16(s[6 * 65] * g1[2], s[7 * 65] * g1[3]);
        const int row = (r.map == 0) ? bt_row_std(r.colbase + r.n0 + n) : bt_row_swiglu(r.n0 + n, r.map - 1);
        *(GAS v4u*)(r.dst + (size_t)row * r.K + r.k0 + 8 * kc) = o; }
    asm volatile("s_waitcnt lgkmcnt(0)" ::: "memory");
}
__device__ __forceinline__ void tile_colmax(const TileRef& r, int lane, const f32x4 (&v)[16], float* cmaxbase) {
    float m0 = 0.f, m1 = 0.f, m2 = 0.f, m3 = 0.f;
#pragma unroll
    for (int i = 0; i < 16; ++i) { const float g = r.gain ? r.gain[r.k0 + 4 * i + (lane >> 4)] : 1.f;
        m0 = fmaxf(m0, fabsf(v[i][0] * g)); m1 = fmaxf(m1, fabsf(v[i][1] * g)); m2 = fmaxf(m2, fabsf(v[i][2] * g)); m3 = fmaxf(m3, fabsf(v[i][3] * g)); }
    m0 = fmaxf(m0, __shfl_xor(m0, 16)); m1 = fmaxf(m1, __shfl_xor(m1, 16)); m2 = fmaxf(m2, __shfl_xor(m2, 16)); m3 = fmaxf(m3, __shfl_xor(m3, 16));
    m0 = fmaxf(m0, __shfl_xor(m0, 32)); m1 = fmaxf(m1, __shfl_xor(m1, 32)); m2 = fmaxf(m2, __shfl_xor(m2, 32)); m3 = fmaxf(m3, __shfl_xor(m3, 32));
    if (lane < 16) { unsigned* p = (unsigned*)(cmaxbase + r.smax + r.n0 + 4 * lane);
        atomicMax(p, __float_as_uint(m0)); atomicMax(p + 1, __float_as_uint(m1)); atomicMax(p + 2, __float_as_uint(m2)); atomicMax(p + 3, __float_as_uint(m3)); }
}
__device__ __forceinline__ unsigned pk_i8x4(float a, float b, float c, float d) {
    const int ia = (int)__builtin_rintf(a), ib = (int)__builtin_rintf(b), ic = (int)__builtin_rintf(c), id = (int)__builtin_rintf(d);
    return (unsigned)(ia & 0xff) | ((unsigned)(ib & 0xff) << 8) | ((unsigned)(ic & 0xff) << 16) | ((unsigned)id << 24);
}
__device__ __forceinline__ void tile_store_q8(const TileRef& r, int lane, const f32x4 (&v)[16], LAS float* scr, const float* cmaxbase) {
#pragma unroll
    for (int i = 0; i < 16; ++i) { const float g = r.gain ? r.gain[r.k0 + 4 * i + (lane >> 4)] : 1.f; LAS float* d = scr + (4 * i + (lane >> 4)) * 65 + 4 * (lane & 15); d[0] = v[i][0] * g; d[1] = v[i][1] * g; d[2] = v[i][2] * g; d[3] = v[i][3] * g; }
    asm volatile("s_waitcnt lgkmcnt(0)" ::: "memory");
    const int kc = lane & 3;
#pragma unroll
    for (int jj = 0; jj < 4; ++jj) { const int n = (lane >> 2) + 16 * jj; const LAS float* s = scr + (16 * kc) * 65 + n;
        const float cm = ld_f32_plain(cmaxbase + r.smax + r.n0 + n), inv = cm > 0.f ? 127.0f / cm : 0.f;
        v4u o; o.x = pk_i8x4(s[0 * 65] * inv, s[1 * 65] * inv, s[2 * 65] * inv, s[3 * 65] * inv); o.y = pk_i8x4(s[4 * 65] * inv, s[5 * 65] * inv, s[6 * 65] * inv, s[7 * 65] * inv);
        o.z = pk_i8x4(s[8 * 65] * inv, s[9 * 65] * inv, s[10 * 65] * inv, s[11 * 65] * inv); o.w = pk_i8x4(s[12 * 65] * inv, s[13 * 65] * inv, s[14 * 65] * inv, s[15 * 65] * inv);
        const int row = (r.map == 0) ? bt_row_std(r.colbase + r.n0 + n) : bt_row_swiglu(r.n0 + n, r.map - 1);
        *(GAS v4u*)((GAS unsigned char*)r.dst + (size_t)row * r.K + r.k0 + 16 * kc) = o; }
    asm volatile("s_waitcnt lgkmcnt(0)" ::: "memory");
}
__device__ __forceinline__ void row_to_i8(const float* xrow, unsigned char* qrow, float* sa, int lane) {
    const f32x4* xr = (const f32x4*)xrow + lane; f32x4 v[4]; float s = 0.f, mx = 0.f;
#pragma unroll
    for (int j = 0; j < 4; ++j) { v[j] = xr[64 * j]; s += (v[j][0] * v[j][0] + v[j][1] * v[j][1]) + (v[j][2] * v[j][2] + v[j][3] * v[j][3]);
        mx = fmaxf(mx, fmaxf(fmaxf(fabsf(v[j][0]), fabsf(v[j][1])), fmaxf(fabsf(v[j][2]), fabsf(v[j][3])))); }
    s = wave_sum(s);
    mx = wave_max(mx);
    const float inv = mx > 0.f ? 127.0f / mx : 0.f;
#pragma unroll
    for (int j = 0; j < 4; ++j) ((unsigned*)qrow)[64 * j + lane] = pk_i8x4(v[j][0] * inv, v[j][1] * inv, v[j][2] * inv, v[j][3] * inv);
    if (lane == 0) *sa = mx * (1.0f / 127.0f) * __builtin_amdgcn_rsqf(s * (1.0f / 1024.0f) + 1e-6f);
}
__device__ __forceinline__ void ld16_bf16(const bf16_t* p, f32x4 (&v)[4]) {
    const v4u a = *(const v4u*)p, b = *(const v4u*)(p + 8);
    v[0] = (f32x4){bf_lo(a.x), bf_hi(a.x), bf_lo(a.y), bf_hi(a.y)}; v[1] = (f32x4){bf_lo(a.z), bf_hi(a.z), bf_lo(a.w), bf_hi(a.w)};
    v[2] = (f32x4){bf_lo(b.x), bf_hi(b.x), bf_lo(b.y), bf_hi(b.y)}; v[3] = (f32x4){bf_lo(b.z), bf_hi(b.z), bf_lo(b.w), bf_hi(b.w)};
}
typedef unsigned v2u_s __attribute__((ext_vector_type(2)));
__device__ __forceinline__ void ld16s_bf16(const bf16_t* row, int lane, f32x4 (&v)[4]) {
    const v4u a = *((const v4u*)row + lane), b = *((const v4u*)row + 64 + lane);
    v[0] = (f32x4){bf_lo(a.x), bf_hi(a.x), bf_lo(a.y), bf_hi(a.y)}; v[1] = (f32x4){bf_lo(a.z), bf_hi(a.z), bf_lo(a.w), bf_hi(a.w)};
    v[2] = (f32x4){bf_lo(b.x), bf_hi(b.x), bf_lo(b.y), bf_hi(b.y)}; v[3] = (f32x4){bf_lo(b.z), bf_hi(b.z), bf_lo(b.w), bf_hi(b.w)};
}
__device__ __forceinline__ void st16s_i8(unsigned char* qrow, int lane, const v4u w) { *((v2u_s*)qrow + lane) = (v2u_s){w.x, w.y}; *((v2u_s*)qrow + 64 + lane) = (v2u_s){w.z, w.w}; }
__device__ __forceinline__ void rowb_to_i8_raw(const v4u a, const v4u b, unsigned char* qrow, float* sa, int lane);
__device__ __forceinline__ void rowb_to_i8(const bf16_t* xrow, unsigned char* qrow, float* sa, int lane) { const v4u a = *((const v4u*)xrow + lane), b = *((const v4u*)xrow + 64 + lane); rowb_to_i8_raw(a, b, qrow, sa, lane); }
__device__ __forceinline__ void rowb_to_i8_raw(const v4u a, const v4u b, unsigned char* qrow, float* sa, int lane) {
    f32x4 v[4]; float s = 0.f, mx = 0.f;
    v[0] = (f32x4){bf_lo(a.x), bf_hi(a.x), bf_lo(a.y), bf_hi(a.y)}; v[1] = (f32x4){bf_lo(a.z), bf_hi(a.z), bf_lo(a.w), bf_hi(a.w)};
    v[2] = (f32x4){bf_lo(b.x), bf_hi(b.x), bf_lo(b.y), bf_hi(b.y)}; v[3] = (f32x4){bf_lo(b.z), bf_hi(b.z), bf_lo(b.w), bf_hi(b.w)};
#pragma unroll
    for (int j = 0; j < 4; ++j) { s += (v[j][0] * v[j][0] + v[j][1] * v[j][1]) + (v[j][2] * v[j][2] + v[j][3] * v[j][3]);
        mx = fmaxf(mx, fmaxf(fmaxf(fabsf(v[j][0]), fabsf(v[j][1])), fmaxf(fabsf(v[j][2]), fabsf(v[j][3])))); }
    s = wave_sum(s);
    mx = wave_max(mx);
    const float inv = mx > 0.f ? 127.0f / mx : 0.f;
    v4u w; w.x = pk_i8x4(v[0][0] * inv, v[0][1] * inv, v[0][2] * inv, v[0][3] * inv); w.y = pk_i8x4(v[1][0] * inv, v[1][1] * inv, v[1][2] * inv, v[1][3] * inv);
    w.z = pk_i8x4(v[2][0] * inv, v[2][1] * inv, v[2][2] * inv, v[2][3] * inv); w.w = pk_i8x4(v[3][0] * inv, v[3][1] * inv, v[3][2] * inv, v[3][3] * inv);
    st16s_i8(qrow, lane, w);
    if (lane == 0) *sa = mx * (1.0f / 127.0f) * __builtin_amdgcn_rsqf(s * (1.0f / 1024.0f) + 1e-6f);
}
__device__ __forceinline__ void phase_quant_rows(const bf16_t* x, unsigned char* ws, int lane, int wave, bool grp) {
    if (grp) {
        const int g = blockIdx.x & 7, lw = (blockIdx.x >> 3) * NWAVES + wave;
        static_assert(SEQ == 8 * 32 * NWAVES, "8 rows per wave");
        v4u ra[8], rb[8];
#pragma unroll
        for (int i = 0; i < 8; ++i) { const int m = g * SEQ + lw + 32 * NWAVES * i; const v4u* p = (const v4u*)(x + (size_t)m * D) + lane; ra[i] = p[0]; rb[i] = p[64]; }
#pragma unroll
        for (int i = 0; i < 8; ++i) { const int m = g * SEQ + lw + 32 * NWAVES * i; rowb_to_i8_raw(ra[i], rb[i], ws + WS_QX + (size_t)m * D, (float*)(ws + WS_SA) + m, lane); }
        return;
    }
    const int gw = blockIdx.x * NWAVES + wave, NGW = gridDim.x * NWAVES;
    for (int m = gw; m < T; m += NGW) rowb_to_i8(x + (size_t)m * D, ws + WS_QX + (size_t)m * D, (float*)(ws + WS_SA) + m, lane);
}
__device__ __forceinline__ void row_to_bf16_ss(const float* xrow, bf16_t* orow, float* ss16, float* fcopy, int lane) {
    const f32x4* xr = (const f32x4*)xrow + lane; f32x4 v[4]; float s = 0.f;
#pragma unroll
    for (int j = 0; j < 4; ++j) { v[j] = xr[64 * j]; s += (v[j][0] * v[j][0] + v[j][1] * v[j][1]) + (v[j][2] * v[j][2] + v[j][3] * v[j][3]); }
    s = wave_sum(s);
    if (fcopy) { f32x4* fc = (f32x4*)fcopy + lane;
#pragma unroll
        for (int j = 0; j < 4; ++j) fc[64 * j] = v[j]; }
    unsigned long long* o8 = (unsigned long long*)orow + lane;
#pragma unroll
    for (int j = 0; j < 4; ++j) o8[64 * j] = (unsigned long long)pk_bf16(v[j][0], v[j][1]) | ((unsigned long long)pk_bf16(v[j][2], v[j][3]) << 32);
    if (lane < 16) ss16[lane] = (lane == 0) ? s : 0.f;
}
__device__ __forceinline__ void build_jobs(const Args& a, LAS TJob* jobs, int tid) {
    if (tid < NJOBS) { TJob jb; make_job(tid, a, jb); LAS TJob* d = jobs + tid; d->src = jb.src; d->dst = jb.dst; d->gain = jb.gain; d->K = jb.K; d->N = jb.N; d->ld = jb.ld; d->map = jb.map; d->colbase = jb.colbase; d->q8 = jb.q8; d->smax = jb.smax; d->start = 0; d->startq = 0; d->f8 = jb.f8; d->startf = 0; d->startw = 0; }
    __syncthreads();
    if (tid == 0) { int s = 0, q = 0, f = 0, w = 0; for (int j = 0; j < NJOBS; ++j) { jobs[j].start = s; jobs[j].startq = q; jobs[j].startf = f; jobs[j].startw = w; if (jobs[j].q8) q += jobs[j].N / 64; else if (jobs[j].f8) { f += jobs[j].N / 16; w += (jobs[j].K / 64) * (jobs[j].N / 64); } else s += (jobs[j].K / 64) * (jobs[j].N / 64); }
        jobs[NJOBS].start = s; jobs[NJOBS].startq = q; jobs[NJOBS].startf = f; jobs[NJOBS].startw = w; }
    __syncthreads();
}
__device__ __forceinline__ void tilew_decode(const LAS TJob* jobs, int& j, int it, TileRef& r) {
    while (it >= jobs[j + 1].startw) ++j;
    const LAS TJob* jb = jobs + j; const int item = it - jb->startw, nblk = jb->N >> 6;
    r.src = (const GAS float*)jb->src; r.dst = (GAS bf16_t*)jb->dst; r.gain = nullptr; r.K = jb->K; r.ld = jb->ld; r.map = 0; r.colbase = 0; r.q8 = 0; r.smax = jb->smax - SW_W2;
    r.k0 = (item / nblk) * 64; r.n0 = (item % nblk) * 64;
}
__device__ __forceinline__ void tile_store_f8(const TileRef& r, int lane, const f32x4 (&v)[16], LAS float* scr, const float* cmaxw, float* cs) {
#pragma unroll
    for (int i = 0; i < 16; ++i) { LAS float* d = scr + (4 * i + (lane >> 4)) * 65 + 4 * (lane & 15); d[0] = v[i][0]; d[1] = v[i][1]; d[2] = v[i][2]; d[3] = v[i][3]; }
    asm volatile("s_waitcnt lgkmcnt(0)" ::: "memory");
    const int kc = lane & 3;
#pragma unroll
    for (int jj = 0; jj < 4; ++jj) { const int n = (lane >> 2) + 16 * jj; const LAS float* s = scr + (16 * kc) * 65 + n;
        const float cm = ld_f32_plain(cmaxw + r.smax + r.n0 + n), inv = cm > 0.f ? 256.0f / cm : 0.f;
        v4u o; o.x = pg8::pk_fp8x4(s[0 * 65] * inv, s[1 * 65] * inv, s[2 * 65] * inv, s[3 * 65] * inv); o.y = pg8::pk_fp8x4(s[4 * 65] * inv, s[5 * 65] * inv, s[6 * 65] * inv, s[7 * 65] * inv);
        o.z = pg8::pk_fp8x4(s[8 * 65] * inv, s[9 * 65] * inv, s[10 * 65] * inv, s[11 * 65] * inv); o.w = pg8::pk_fp8x4(s[12 * 65] * inv, s[13 * 65] * inv, s[14 * 65] * inv, s[15 * 65] * inv);
        *(GAS v4u*)((GAS unsigned char*)r.dst + (size_t)bt_row_std(r.n0 + n) * r.K + r.k0 + 16 * kc) = o;
        if (r.k0 == 0 && kc == 0) cs[SW_W2 + r.smax + r.n0 + n] = cm * (1.0f / (256.0f * H8_SCALE)); }
    asm volatile("s_waitcnt lgkmcnt(0)" ::: "memory");
}
__device__ __forceinline__ void w2_quant_pass(const Args& a, LAS unsigned char* lds, int tid, int lane, int wave, int lw, int NW) {
    LAS TJob* jobs = (LAS TJob*)(lds + 8 * 17408);
    build_jobs(a, jobs, tid);
    LAS float* scr = (LAS float*)(lds + wave * 17408);
    const int total = jobs[NJOBS].startw; int j = 0;
    const float* cmaxw = (const float*)a.ws + CW_W2MAX; float* cs = (float*)(a.ws + WS_SW);
#pragma unroll 1
    for (int it = lw; it < total; it += NW) { TileRef r; f32x4 v[16]; tilew_decode(jobs, j, it, r); tile_load(r, lane, v); tile_store_f8(r, lane, v, scr, cmaxw, cs); }
}
__device__ __forceinline__ void strip_q8(const LAS TJob* jobs, int& j, int st, LAS unsigned char* lds, int tid, int lane, int wave, float* cmaxbase) {
    while (st >= jobs[j + 1].startq) ++j;
    const LAS TJob* jb = jobs + j;
    TileRef r; r.src = (const GAS float*)jb->src; r.dst = (GAS bf16_t*)jb->dst; r.gain = (const GAS float*)jb->gain; r.K = jb->K; r.ld = jb->ld; r.map = jb->map; r.colbase = jb->colbase; r.q8 = 1; r.smax = jb->smax;
    r.n0 = (st - jb->startq) * 64; r.k0 = 128 * wave;
    LAS float* scr = (LAS float*)(lds + wave * 17408); LAS float* pmax = (LAS float*)(lds + 8 * 17408 + 4096); LAS float* cmf = pmax + 8 * 64;
    f32x4 v0[16], v1[16];
    tile_load(r, lane, v0); r.k0 += 64; tile_load(r, lane, v1); r.k0 -= 64;
    float m0 = 0.f, m1 = 0.f, m2 = 0.f, m3 = 0.f;
#pragma unroll
    for (int i = 0; i < 16; ++i) { const float g0 = r.gain ? r.gain[r.k0 + 4 * i + (lane >> 4)] : 1.f, g1 = r.gain ? r.gain[r.k0 + 64 + 4 * i + (lane >> 4)] : 1.f;
        v0[i] = v0[i] * g0; v1[i] = v1[i] * g1;
        m0 = fmaxf(m0, fmaxf(fabsf(v0[i][0]), fabsf(v1[i][0]))); m1 = fmaxf(m1, fmaxf(fabsf(v0[i][1]), fabsf(v1[i][1]))); m2 = fmaxf(m2, fmaxf(fabsf(v0[i][2]), fabsf(v1[i][2]))); m3 = fmaxf(m3, fmaxf(fabsf(v0[i][3]), fabsf(v1[i][3]))); }
    m0 = fmaxf(m0, __shfl_xor(m0, 16)); m1 = fmaxf(m1, __shfl_xor(m1, 16)); m2 = fmaxf(m2, __shfl_xor(m2, 16)); m3 = fmaxf(m3, __shfl_xor(m3, 16));
    m0 = fmaxf(m0, __shfl_xor(m0, 32)); m1 = fmaxf(m1, __shfl_xor(m1, 32)); m2 = fmaxf(m2, __shfl_xor(m2, 32)); m3 = fmaxf(m3, __shfl_xor(m3, 32));
    __syncthreads();
    if (lane < 16) *(LAS f32x4*)(pmax + wave * 64 + 4 * lane) = (f32x4){m0, m1, m2, m3};
    __syncthreads();
    if (tid < 64) { float m = pmax[tid];
#pragma unroll
        for (int w = 1; w < 8; ++w) m = fmaxf(m, pmax[w * 64 + tid]);
        cmf[tid] = m; cmaxbase[r.smax + r.n0 + tid] = m; }
    __syncthreads();
#pragma unroll
    for (int h = 0; h < 2; ++h) {
#pragma unroll
        for (int i = 0; i < 16; ++i) { LAS float* d = scr + (4 * i + (lane >> 4)) * 65 + 4 * (lane & 15); const f32x4 x = h ? v1[i] : v0[i]; d[0] = x[0]; d[1] = x[1]; d[2] = x[2]; d[3] = x[3]; }
        asm volatile("s_waitcnt lgkmcnt(0)" ::: "memory");
        const int kc = lane & 3;
#pragma unroll
        for (int jj = 0; jj < 4; ++jj) { const int n = (lane >> 2) + 16 * jj; const LAS float* s = scr + (16 * kc) * 65 + n;
            const float cm = cmf[n], inv = cm > 0.f ? 127.0f / cm : 0.f;
            v4u o; o.x = pk_i8x4(s[0 * 65] * inv, s[1 * 65] * inv, s[2 * 65] * inv, s[3 * 65] * inv); o.y = pk_i8x4(s[4 * 65] * inv, s[5 * 65] * inv, s[6 * 65] * inv, s[7 * 65] * inv);
            o.z = pk_i8x4(s[8 * 65] * inv, s[9 * 65] * inv, s[10 * 65] * inv, s[11 * 65] * inv); o.w = pk_i8x4(s[12 * 65] * inv, s[13 * 65] * inv, s[14 * 65] * inv, s[15 * 65] * inv);
            const int row = (r.map == 0) ? bt_row_std(r.colbase + r.n0 + n) : bt_row_swiglu(r.n0 + n, r.map - 1);
            *(GAS v4u*)((GAS unsigned char*)r.dst + (size_t)row * r.K + r.k0 + 64 * h + 16 * kc) = o; }
        asm volatile("s_waitcnt lgkmcnt(0)" ::: "memory");
    }
}
__device__ __forceinline__ void strip_f8(const LAS TJob* jobs, int& j, int st, LAS unsigned char* lds, int tid, int lane, int wave, float* cmaxbase) {
    while (st >= jobs[j + 1].startf) ++j;
    const LAS TJob* jb = jobs + j;
    const GAS float* src = (const GAS float*)jb->src; GAS unsigned char* dst = (GAS unsigned char*)jb->dst; const int K = jb->K, n0 = (st - jb->startf) * 16, smax = jb->smax, nq = K >> 2;
    const int c4 = tid & 3, q0 = tid >> 2;
    constexpr int RS8 = 3584 + 16;
    LAS float* pmax = (LAS float*)(lds + 8 * 17408 + 4096); LAS float* cmf = pmax + 8 * 16;
    f32x4 v[7][4];
#pragma unroll
    for (int i = 0; i < 7; ++i) { const int q = q0 + 128 * i; const GAS float* p = src + (size_t)(4 * q) * 1024 + n0 + 4 * c4;
#pragma unroll
        for (int kk = 0; kk < 4; ++kk) v[i][kk] = (q < nq) ? __builtin_nontemporal_load((const GAS f32x4*)(p + kk * 1024)) : (f32x4){0.f, 0.f, 0.f, 0.f}; }
    float m0 = 0.f, m1 = 0.f, m2 = 0.f, m3 = 0.f;
#pragma unroll
    for (int i = 0; i < 7; ++i)
#pragma unroll
        for (int kk = 0; kk < 4; ++kk) { m0 = fmaxf(m0, fabsf(v[i][kk][0])); m1 = fmaxf(m1, fabsf(v[i][kk][1])); m2 = fmaxf(m2, fabsf(v[i][kk][2])); m3 = fmaxf(m3, fabsf(v[i][kk][3])); }
#pragma unroll
    for (int o = 4; o < 64; o <<= 1) { m0 = fmaxf(m0, __shfl_xor(m0, o)); m1 = fmaxf(m1, __shfl_xor(m1, o)); m2 = fmaxf(m2, __shfl_xor(m2, o)); m3 = fmaxf(m3, __shfl_xor(m3, o)); }
    __syncthreads();
    if (lane < 4) *(LAS f32x4*)(pmax + wave * 16 + 4 * lane) = (f32x4){m0, m1, m2, m3};
    __syncthreads();
    if (tid < 16) { float m = pmax[tid];
#pragma unroll
        for (int w = 1; w < 8; ++w) m = fmaxf(m, pmax[w * 16 + tid]);
        cmf[tid] = m; cmaxbase[smax + n0 + tid] = m * (1.0f / (256.0f * H8_SCALE)); }
    __syncthreads();
    { const f32x4 cm = *(const LAS f32x4*)(cmf + 4 * c4); f32x4 inv;
#pragma unroll
      for (int jj = 0; jj < 4; ++jj) inv[jj] = cm[jj] > 0.f ? 256.0f / cm[jj] : 0.f;
#pragma unroll
      for (int i = 0; i < 7; ++i) { const int q = q0 + 128 * i;
          if (q < nq) {
#pragma unroll
              for (int jj = 0; jj < 4; ++jj) *(LAS unsigned*)(lds + (4 * c4 + jj) * RS8 + 4 * q) = pg8::pk_fp8x4(v[i][0][jj] * inv[jj], v[i][1][jj] * inv[jj], v[i][2][jj] * inv[jj], v[i][3][jj] * inv[jj]); } } }
    __syncthreads();
    { const int row = tid >> 5, t32 = tid & 31; GAS unsigned char* drow = dst + (size_t)bt_row_std(n0 + row) * K;
#pragma unroll
      for (int it = 0; it < 7; ++it) { const int ch = t32 + 32 * it; if (ch * 16 < K) *(GAS v4u*)(drow + ch * 16) = *(const LAS v4u*)(lds + row * RS8 + ch * 16); } }
}
__device__ __forceinline__ void phase_prologue(const Args& a, LAS unsigned char* lds, int tid, int lane, int wave) {
    unsigned char* ws = a.ws;
    LAS TJob* jobs = (LAS TJob*)(lds + 8 * 17408);
    build_jobs(a, jobs, tid);
    const int gw = blockIdx.x * NWAVES + wave, NGW = gridDim.x * NWAVES;
    { const int nstrip = jobs[NJOBS].startq; int js = 0;
      for (int st = blockIdx.x; st < nstrip; st += gridDim.x) strip_q8(jobs, js, st, lds, tid, lane, wave, (float*)(ws + WS_SW));
      __syncthreads(); }
    {
        const int total = jobs[NJOBS].startw; int j = 0; float* cmaxw = (float*)ws + CW_W2MAX;
#pragma unroll 1
        for (int it = gw; it < total; it += NGW) { TileRef r; f32x4 v[16]; tilew_decode(jobs, j, it, r); tile_load(r, lane, v); tile_colmax(r, lane, v, cmaxw); }
    }
    {
        LAS float* scr = (LAS float*)(lds + wave * 17408);
        const int total = jobs[NJOBS].start; int j = 0;
        if (gw < total) {
            TileRef cur, nxt; f32x4 v[16], vn[16];
            tile_decode<false>(jobs, j, gw, cur); tile_load(cur, lane, v);
#pragma unroll 1
            for (int it = gw; it < total; it += NGW) {
                const bool more = it + NGW < total;
                if (more) { tile_decode<false>(jobs, j, it + NGW, nxt); tile_load(nxt, lane, vn); }
                tile_store(cur, lane, v, scr);
                if (more) { cur = nxt;
#pragma unroll
                    for (int i = 0; i < 16; ++i) v[i] = vn[i]; }
            }
        }
    }
#if I8_A
    for (int m = gw; m < T; m += NGW) row_to_i8(a.in[0] + (size_t)m * D, ws + WS_QX + (size_t)m * D, (float*)(ws + WS_SA) + m, lane);
#else
    for (int m = gw; m < T; m += NGW) row_to_bf16_ss(a.in[0] + (size_t)m * D, (bf16_t*)(ws + WS_XB) + (size_t)m * D, (float*)(ws + WS_SS) + (size_t)m * 16, nullptr, lane);
#endif
    for (int m = gw; m < NBATCH * MEML; m += NGW) row_to_bf16_ss(a.in[1] + (size_t)m * D, (bf16_t*)(ws + WS_MEMBF) + (size_t)m * D, (float*)(ws + WS_SSM) + (size_t)m * 16, nullptr, lane);
    {
        float* prm = (float*)(ws + WS_PARAM); const int gt = blockIdx.x * NTHR + tid, NGT = gridDim.x * NTHR;
        for (int i = gt; i < PB_END; i += NGT) { float v;
            if (i < PB_GQ) v = a.in[7][i]; else if (i < PB_GK) v = a.in[8][i - PB_GQ]; else if (i < PB_GOUT) v = a.in[9][i - PB_GK]; else if (i < PB_POOLS) v = a.in[14][i - PB_GOUT];
            else if (i < PB_MQN) v = a.in[16][i - PB_POOLS]; else if (i < PB_MKN) v = a.in[17][i - PB_MQN]; else if (i < PB_GFFN1) v = a.in[18][i - PB_MKN]; else if (i < PB_WR) v = a.in[4][D + i - PB_GFFN1];
            else if (i < PB_POOLW) v = a.in[27][i - PB_WR]; else v = a.in[15][i - PB_POOLW];
            prm[i] = v; }
        bf16_t* pwt = (bf16_t*)(ws + WS_POOLWT);
        for (int i = gt; i < 2 * 4 * 128 * 128; i += NGT) { const int lg = i >> 14, dout = (i >> 7) & 127, cc = i & 127; pwt[i] = (bf16_t)(pk_bf16(a.in[15][((size_t)lg * 128 + cc) * 128 + dout], 0.f) & 0xffffu); }
    }
    if (blockIdx.x == 0 && wave == 0) {
        float* sc = (float*)(ws + WS_SC);
        for (int l = 0; l < 2; ++l) {
            const float a1 = wave_sum(a.in[10][l * 64 + lane] * a.in[11][l * 64 + lane]), a2 = wave_sum(a.in[12][l * 64 + lane] * a.in[13][l * 64 + lane]);
            const float lam0 = (l == 0) ? 0.2f : (0.8f - 0.6f * 0.7408182206817179f);
            const float lam = __expf(a1) - __expf(a2) + lam0;
            float m0 = fabsf(a.in[8][l * 128 + lane] * a.in[9][l * 128 + lane]), m1 = fabsf(a.in[8][l * 128 + 64 + lane] * a.in[9][l * 128 + 64 + lane]);
            float mm = fmaxf(fabsf(a.in[17][l * 128 + lane] * a.in[18][l * 128 + lane]), fabsf(a.in[17][l * 128 + 64 + lane] * a.in[18][l * 128 + 64 + lane]));
#pragma unroll
            for (int o = 1; o < 64; o <<= 1) { m0 = fmaxf(m0, __shfl_xor(m0, o)); m1 = fmaxf(m1, __shfl_xor(m1, o)); mm = fmaxf(mm, __shfl_xor(mm, o)); }
            if (lane == 0) { sc[l * 8 + 0] = lam; sc[l * 8 + 1] = m0 * 64.f * QSCALE; sc[l * 8 + 2] = m1 * 64.f * QSCALE; sc[l * 8 + 3] = mm * 128.f * MEMSCALE; sc[l * 8 + 4] = 1.0f - lam0; }
        }
    }
}

__device__ __forceinline__ void unpack16(const bf16_t* src, float (&f)[16]) {
    const v4u a = *(const v4u*)src, b = *(const v4u*)(src + 8);
    f[0] = bf_lo(a.x); f[1] = bf_hi(a.x); f[2] = bf_lo(a.y); f[3] = bf_hi(a.y); f[4] = bf_lo(a.z); f[5] = bf_hi(a.z); f[6] = bf_lo(a.w); f[7] = bf_hi(a.w);
    f[8] = bf_lo(b.x); f[9] = bf_hi(b.x); f[10] = bf_lo(b.y); f[11] = bf_hi(b.y); f[12] = bf_lo(b.z); f[13] = bf_hi(b.z); f[14] = bf_lo(b.w); f[15] = bf_hi(b.w);
}
template <bool DIFF>
__device__ __forceinline__ void naive_attn_unit(LAS unsigned char* lds, int tid, const bf16_t* Qg, int ldq, const bf16_t* Kg, int ldk, const bf16_t* Vg, int ldv, bf16_t* Og, int ldo,
                                                int ntiles, int qpos0, const float* qmulA, const float* qmulB, const float* qss, float slope2, float bnd0, float bnd1, float lam, const float* gout, float outmul) {
    constexpr int QW = 4;
    LAS float* Lq = (LAS float*)lds; LAS float* Lk = Lq + 32 * 128; LAS float* Lv = Lk + 64 * 129; LAS float* Lp = Lv + 64 * 128; LAS float* Lrk = Lp + 8 * QW * 2 * 64;
    const int lane = tid & 63, wid = tid >> 6, r = tid >> 3, sg = tid & 7;
    __syncthreads();
    if (tid < 256) { float f[16]; unpack16(Qg + (size_t)r * ldq + sg * 16, f); float mul = 1.f;
      if (!DIFF) { const float s = qss[r * 8] + qss[r * 8 + 1]; mul = __builtin_amdgcn_rsqf(s * (1.f / 128.f) + 1e-6f) * MEMSCALE; }
#pragma unroll
      for (int i = 0; i < 16; ++i) Lq[r * 128 + sg * 16 + i] = DIFF ? f[i] : f[i] * mul * qmulA[sg * 16 + i] * qmulB[sg * 16 + i]; }
    float o0[QW][2], o1[QW][2], l0[QW], l1[QW];
#pragma unroll
    for (int q = 0; q < QW; ++q) { o0[q][0] = o0[q][1] = o1[q][0] = o1[q][1] = 0.f; l0[q] = l1[q] = 0.f; }
#pragma unroll 1
    for (int j = 0; j < ntiles; ++j) {
        __syncthreads();
        { float f[16]; unpack16(Kg + (size_t)(j * 64 + r) * ldk + sg * 16, f);
#pragma unroll
          for (int i = 0; i < 16; ++i) Lk[r * 129 + sg * 16 + i] = f[i];
          unpack16(Vg + (size_t)(j * 64 + r) * ldv + sg * 16, f);
#pragma unroll
          for (int i = 0; i < 16; ++i) Lv[r * 128 + sg * 16 + i] = f[i]; }
        __syncthreads();
        if (!DIFF) { if (tid < 64) { float s = 0.f;
#pragma unroll 4
            for (int d = 0; d < 128; ++d) { const float x = Lk[tid * 129 + d]; s += x * x; } Lrk[tid] = __builtin_amdgcn_rsqf(s * (1.f / 128.f) + 1e-6f); } __syncthreads(); }
        float s0[QW], s1[QW];
#pragma unroll
        for (int q = 0; q < QW; ++q) { s0[q] = 0.f; s1[q] = 0.f; }
#pragma unroll 1
        for (int d4 = 0; d4 < 16; ++d4) {
            const float k0 = Lk[lane * 129 + 4 * d4], k1 = Lk[lane * 129 + 4 * d4 + 1], k2 = Lk[lane * 129 + 4 * d4 + 2], k3 = Lk[lane * 129 + 4 * d4 + 3];
            const float e0 = Lk[lane * 129 + 64 + 4 * d4], e1 = Lk[lane * 129 + 64 + 4 * d4 + 1], e2 = Lk[lane * 129 + 64 + 4 * d4 + 2], e3 = Lk[lane * 129 + 64 + 4 * d4 + 3];
#pragma unroll
            for (int q = 0; q < QW; ++q) { const f32x4 qa = *(const LAS f32x4*)&Lq[(wid * QW + q) * 128 + 4 * d4], qb = *(const LAS f32x4*)&Lq[(wid * QW + q) * 128 + 64 + 4 * d4];
                s0[q] += (qa[0] * k0 + qa[1] * k1) + (qa[2] * k2 + qa[3] * k3); s1[q] += (qb[0] * e0 + qb[1] * e1) + (qb[2] * e2 + qb[3] * e3); }
        }
        const int kpos = j * 64 + lane;
#pragma unroll
        for (int q = 0; q < QW; ++q) { float p0, p1;
            if (DIFF) { const int qpos = qpos0 + wid * QW + q; const float bias = -slope2 * fabsf((float)(qpos - kpos)); p0 = __builtin_amdgcn_exp2f(s0[q] + bias - bnd0); p1 = __builtin_amdgcn_exp2f(s1[q] + bias - bnd1); }
            else { p0 = __builtin_amdgcn_exp2f((s0[q] + s1[q]) * Lrk[lane] - bnd0); p1 = 0.f; }
            l0[q] += p0; l1[q] += p1; Lp[((wid * QW + q) * 2 + 0) * 64 + lane] = p0; Lp[((wid * QW + q) * 2 + 1) * 64 + lane] = p1; }
        asm volatile("s_waitcnt lgkmcnt(0)" ::: "memory");
#pragma unroll 1
        for (int k4 = 0; k4 < 16; ++k4) {
            f32x2 v[4];
#pragma unroll
            for (int i = 0; i < 4; ++i) v[i] = *(const LAS f32x2*)&Lv[(4 * k4 + i) * 128 + 2 * lane];
#pragma unroll
            for (int q = 0; q < QW; ++q) { const f32x4 pa = *(const LAS f32x4*)&Lp[((wid * QW + q) * 2 + 0) * 64 + 4 * k4];
                o0[q][0] += (pa[0] * v[0][0] + pa[1] * v[1][0]) + (pa[2] * v[2][0] + pa[3] * v[3][0]); o0[q][1] += (pa[0] * v[0][1] + pa[1] * v[1][1]) + (pa[2] * v[2][1] + pa[3] * v[3][1]);
                if (DIFF) { const f32x4 pb = *(const LAS f32x4*)&Lp[((wid * QW + q) * 2 + 1) * 64 + 4 * k4];
                    o1[q][0] += (pb[0] * v[0][0] + pb[1] * v[1][0]) + (pb[2] * v[2][0] + pb[3] * v[3][0]); o1[q][1] += (pb[0] * v[0][1] + pb[1] * v[1][1]) + (pb[2] * v[2][1] + pb[3] * v[3][1]); } }
        }
    }
#pragma unroll
    for (int q = 0; q < QW; ++q) { const float L0 = wave_sum(l0[q]); float x = o0[q][0] / L0, y = o0[q][1] / L0;
        if (DIFF) { const float L1 = wave_sum(l1[q]); x -= lam * (o1[q][0] / L1); y -= lam * (o1[q][1] / L1);
            const float ss = wave_sum(x * x + y * y); const float rr = __builtin_amdgcn_rsqf(ss * (1.f / 128.f) + 1e-6f) * outmul; x *= rr * gout[2 * lane]; y *= rr * gout[2 * lane + 1]; }
        *(unsigned*)(Og + (size_t)(wid * QW + q) * ldo + 2 * lane) = pk_bf16(x, y); }
}
__device__ __forceinline__ void naive_pool_unit(LAS unsigned char* lds, int tid, const bf16_t* Pg  , bf16_t* Og  , const float* W  , const float* scale  , int tok0, int g) {
    LAS float* Lp = (LAS float*)lds; LAS float* Ld = Lp + 80 * 128;
    const int w = 2 << g, pos0 = tok0 & (SEQ - 1);
    __syncthreads();
    for (int i = tid; i < 80 * 8; i += NTHR) { const int rr = i >> 3, sg = i & 7; const int tpos = pos0 - 16 + rr;
        float f[16];
        if (tpos >= 0) unpack16(Pg + (size_t)(tok0 - 16 + rr) * 512 + g * 128 + sg * 16, f); else {
#pragma unroll
            for (int k = 0; k < 16; ++k) f[k] = 0.f; }
#pragma unroll
        for (int k = 0; k < 16; ++k) Lp[rr * 128 + sg * 16 + k] = f[k]; }
    __syncthreads();
    for (int i = tid; i < 64 * 128; i += NTHR) { const int t = i >> 7, c = i & 127; const int tpos = pos0 + t; const int lo = (tpos + 1 - w) > 0 ? (tpos + 1 - w) : 0; const int cnt = tpos + 1 - lo;
        float s = 0.f;
#pragma unroll 1
        for (int k = 0; k < cnt; ++k) s += Lp[(16 + t - k) * 128 + c];
        Ld[t * 128 + c] = s / (float)cnt - Lp[(16 + t) * 128 + c]; }
    __syncthreads();
    const int dout = tid & 127, tq = tid >> 7; float acc[16];
#pragma unroll
    for (int i = 0; i < 16; ++i) acc[i] = 0.f;
#pragma unroll 2
    for (int c = 0; c < 128; ++c) { const float wv = W[c * 128 + dout];
#pragma unroll
        for (int i = 0; i < 16; ++i) acc[i] += Ld[(tq * 16 + i) * 128 + c] * wv; }
    const float sc = scale[dout];
#pragma unroll
    for (int i = 0; i < 16; ++i) Og[(size_t)(tok0 + tq * 16 + i) * 512 + g * 128 + dout] = (bf16_t)(pk_bf16(acc[i] * sc, 0.f) & 0xffffu);
}

namespace mix {
typedef short bf16x8 __attribute__((ext_vector_type(8)));
typedef short s16x4 __attribute__((ext_vector_type(4)));
typedef float f32x16 __attribute__((ext_vector_type(16)));
typedef const LAS unsigned char* lptr;
#define SBAR() __builtin_amdgcn_sched_barrier(0)
__device__ __forceinline__ unsigned lds_addr(lptr p) { return (unsigned)(uintptr_t)p; }
__device__ __forceinline__ bf16x8 pack8(const f32x16& p, int b) {
    v4u w; w.x = pk_bf16(p[b], p[b + 1]); w.y = pk_bf16(p[b + 2], p[b + 3]); w.z = pk_bf16(p[b + 4], p[b + 5]); w.w = pk_bf16(p[b + 6], p[b + 7]);
    return __builtin_bit_cast(bf16x8, w);
}
__device__ __forceinline__ void glds16(const void* g, LAS unsigned char* l) { __builtin_amdgcn_global_load_lds((const unsigned*)g, (LAS unsigned*)l, 16, 0, 0); }
#define MFMA32(a, b, c) __builtin_amdgcn_mfma_f32_32x32x16_bf16(a, b, c, 0, 0, 0)

#define VRD(set, db) do { _Pragma("unroll") for (int t_ = 0; t_ < 4; ++t_) { \
        asm volatile("ds_read_b64_tr_b16 %0, %1 offset:%c2" : "=&v"(lo[set][t_]) : "v"(va[db]), "i"(t_ * 4096) : "memory"); \
        asm volatile("ds_read_b64_tr_b16 %0, %1 offset:%c2" : "=&v"(hi[set][t_]) : "v"(va[db]), "i"(t_ * 4096 + 2048) : "memory"); } } while (0)
#define VRT(set, t) do { _Pragma("unroll") for (int d_ = 0; d_ < 4; ++d_) { \
        asm volatile("ds_read_b64_tr_b16 %0, %1 offset:%c2" : "=&v"(lo[set][d_]) : "v"(va[d_]), "i"((t) * 4096) : "memory"); \
        asm volatile("ds_read_b64_tr_b16 %0, %1 offset:%c2" : "=&v"(hi[set][d_]) : "v"(va[d_]), "i"((t) * 4096 + 2048) : "memory"); } } while (0)
#define VPK(set, t) (bf16x8){lo[set][t][0], lo[set][t][1], lo[set][t][2], lo[set][t][3], hi[set][t][0], hi[set][t][1], hi[set][t][2], hi[set][t][3]}
__device__ __forceinline__ void pv_tile(f32x16 (&O)[4], const unsigned (&va)[4], const bf16x8 (&pb)[4]) {
    s16x4 lo[2][4], hi[2][4];
    VRD(0, 0);
    VRD(1, 1); asm volatile("s_waitcnt lgkmcnt(8)" ::: "memory"); SBAR();
#pragma unroll
    for (int t = 0; t < 4; ++t) O[0] = MFMA32(VPK(0, t), pb[t], O[0]);
    SBAR(); VRD(0, 2); asm volatile("s_waitcnt lgkmcnt(8)" ::: "memory"); SBAR();
#pragma unroll
    for (int t = 0; t < 4; ++t) O[1] = MFMA32(VPK(1, t), pb[t], O[1]);
    SBAR(); VRD(1, 3); asm volatile("s_waitcnt lgkmcnt(8)" ::: "memory"); SBAR();
#pragma unroll
    for (int t = 0; t < 4; ++t) O[2] = MFMA32(VPK(0, t), pb[t], O[2]);
    SBAR(); asm volatile("s_waitcnt lgkmcnt(0)" ::: "memory"); SBAR();
#pragma unroll
    for (int t = 0; t < 4; ++t) O[3] = MFMA32(VPK(1, t), pb[t], O[3]);
}
__device__ __forceinline__ void kread8_swz(bf16x8 (&kf)[8], const unsigned (&ka)[4]) {
#define KRD(i, a, off) asm volatile("ds_read_b128 %0, %1 offset:%c2" : "=&v"(kf[i]) : "v"(a), "i"(off) : "memory")
    KRD(0, ka[0], 0); KRD(1, ka[0], 8192); KRD(2, ka[1], 0); KRD(3, ka[1], 8192); KRD(4, ka[2], 0); KRD(5, ka[2], 8192); KRD(6, ka[3], 0); KRD(7, ka[3], 8192);
#undef KRD
}
__device__ __forceinline__ void kread8(bf16x8 (&kf)[8], unsigned ka) {
#define KRD(i, off) asm volatile("ds_read_b128 %0, %1 offset:%c2" : "=&v"(kf[i]) : "v"(ka), "i"(off) : "memory")
    KRD(0, 0); KRD(1, 512); KRD(2, 2048); KRD(3, 2560); KRD(4, 4096); KRD(5, 4608); KRD(6, 6144); KRD(7, 6656);
#undef KRD
}

__device__ __forceinline__ void da_bias(f32x16& p0, f32x16& p1, int jt, int cq, float xq, float sl2, float B2) {
    const float x = (float)(64 * jt) - xq;
    const float Be = (jt > cq) ? 1.0e30f : B2;
#pragma unroll
    for (int r = 0; r < 16; ++r) { const float kr = (float)((r & 3) + 8 * (r >> 2)); p0[r] = __builtin_fmaf(-sl2, __builtin_fabsf(x + kr), -Be); p1[r] = __builtin_fmaf(-sl2, __builtin_fabsf(x + (32.f + kr)), -Be); }
}
__device__ __forceinline__ void diffattn_unit(LAS unsigned char* lds, int tid, const bf16_t* Qg, const bf16_t* Kg, const bf16_t* Vg, bf16_t* Og, int b, int h, int u, bool desc, float sl2, float B2, float lam, const float* gout, float outmul) {
    asm volatile("" : "+v"(tid));
    const int lane = tid & 63, wid = __builtin_amdgcn_readfirstlane(tid >> 6), map = wid >> 2, wi = wid & 3, r32 = lane & 31, hi = lane >> 5;
    const int q0 = u * 128 + wi * 32, cq = q0 >> 6, NT = 2 * u + 2;
    const size_t rowb = (size_t)b * SEQ;
    const bf16_t* qrow = Qg + (rowb + q0 + r32) * 1024 + h * 128;
    bf16x8 qf[4];
    unsigned koff0, voff0;
    { const int row = 8 * wid + (lane >> 4), slot = lane & 15;
      koff0 = (unsigned)(row * 1024 + ((slot ^ (row & 15)) * 8));
      voff0 = (unsigned)(row * 1024 + (((slot >> 2) ^ (row & 3)) * 32 + (slot & 3) * 8)); }
    const bf16_t* Kbh = Kg + rowb * 1024 + h * 128; const bf16_t* Vbh = Vg + rowb * 1024 + h * 128;
#define JT(i) (desc ? NT - 1 - (i) : (i))
#define DA_DMA(i) do { const int j_ = JT(i), sl_ = (i) & 3; _Pragma("unroll") for (int i_ = 0; i_ < 2; ++i_) { \
        glds16(Kbh + (size_t)j_ * 65536 + (i_ ? (koff0 ^ 32u) + 4096u : koff0), lds + sl_ * 32768 + (2 * wid + i_) * 1024); \
        glds16(Vbh + (size_t)j_ * 65536 + (i_ ? voff0 + 4096u : voff0), lds + sl_ * 32768 + 16384 + (2 * wid + i_) * 1024); } } while (0)
    f32x16 O[4];
#pragma unroll
    for (int db = 0; db < 4; ++db)
#pragma unroll
        for (int r = 0; r < 16; ++r) O[db][r] = 0.f;
    float lsum = 0.f;
    const float xq = (float)(q0 + r32 - 4 * hi);
    unsigned ka_0, va_0;
    { const unsigned l0 = lds_addr((lptr)lds); const int qp = (lane & 15) >> 2;
      ka_0 = l0 + r32 * 256 + (((map * 8 + hi) ^ (r32 & 15)) << 4);
      va_0 = l0 + 16384 + (4 * hi + qp) * 256 + (qp << 6) + ((lane >> 4) & 1) * 32 + (lane & 3) * 8; }
    __syncthreads();
#pragma unroll
    for (int s = 0; s < 4; ++s) asm volatile("global_load_dwordx4 %0, %1, off" : "=v"(qf[s]) : "v"(qrow + map * 64 + s * 16 + hi * 8) : "memory");
    DA_DMA(0); DA_DMA(1);
    if (NT > 2) { DA_DMA(2); asm volatile("s_waitcnt vmcnt(4)" ::: "memory"); } else asm volatile("s_waitcnt vmcnt(0)" ::: "memory");
    __builtin_amdgcn_s_barrier();
    f32x16 pA0, pA1, pB0, pB1;
    { da_bias(pA0, pA1, JT(0), cq, xq, sl2, B2);
      unsigned ka[4];
#pragma unroll
      for (int s = 0; s < 4; ++s) ka[s] = ka_0 ^ (s << 5);
      bf16x8 kf[8]; kread8_swz(kf, ka); asm volatile("s_waitcnt lgkmcnt(0)" ::: "memory"); SBAR();
#pragma unroll
      for (int s = 0; s < 4; ++s) { pA0 = MFMA32(kf[2 * s], qf[s], pA0); pA1 = MFMA32(kf[2 * s + 1], qf[s], pA1); }
      asm volatile("s_nop 15\n\ts_nop 15" : "+v"(pA0), "+v"(pA1)); }
    da_bias(pB0, pB1, JT(1), cq, xq, sl2, B2);
#define SM4(P, b_) do { P[b_] = __builtin_amdgcn_exp2f(P[b_]); P[b_ + 1] = __builtin_amdgcn_exp2f(P[b_ + 1]); P[b_ + 2] = __builtin_amdgcn_exp2f(P[b_ + 2]); P[b_ + 3] = __builtin_amdgcn_exp2f(P[b_ + 3]); \
        lsum += (P[b_] + P[b_ + 1]) + (P[b_ + 2] + P[b_ + 3]); } while (0)
#define MFMA_A(acc, a_, b_) asm volatile("v_mfma_f32_32x32x16_bf16 %0, %1, %2, %0" : "+v"(acc) : "v"(a_), "v"(b_))
#define PIN(x_) asm volatile("" : "+v"(x_))
#define FMK(dst, krv) do { float f_; asm volatile("v_fmamk_f32 %0, %1, %c2, %3" : "=v"(f_) : "v"(sl2), "i"(__builtin_bit_cast(int, (float)(krv))), "v"(c0_)); dst = f_; } while (0)
#define FM2(C0, C1, j) do { FMK(C0[j], ((j) & 3) + 8 * ((j) >> 2)); FMK(C1[j], 32 + ((j) & 3) + 8 * ((j) >> 2)); } while (0)
#define DA_STEP(C0, C1, N0, N1, i) do { \
        if ((i) + 3 < NT) DA_DMA((i) + 3); \
        bf16x8 pb[4]; \
        { unsigned ka[4]; _Pragma("unroll") for (int s_ = 0; s_ < 4; ++s_) ka[s_] = (ka_0 + (((i) + 1) & 3) * 32768) ^ (s_ << 5); \
          bf16x8 kf[8]; kread8_swz(kf, ka); \
          s16x4 lo[2][4], hi[2][4]; unsigned va[4]; _Pragma("unroll") for (int d_ = 0; d_ < 4; ++d_) va[d_] = (va_0 + ((i) & 3) * 32768) ^ (d_ << 6); \
          SM4(C0, 0);  PIN(C0); PIN(lsum); SM4(C0, 4);  PIN(C0); PIN(lsum);                        \
          asm volatile("s_waitcnt lgkmcnt(0)" ::: "memory"); \
          MFMA_A(N0, kf[0], qf[0]); SM4(C0, 8);  PIN(C0); PIN(lsum); \
          MFMA_A(N1, kf[1], qf[0]); SM4(C0, 12); PIN(C0); PIN(lsum); \
          MFMA_A(N0, kf[2], qf[1]); pb[0] = pack8(C0, 0); PIN(pb[0]); \
          MFMA_A(N1, kf[3], qf[1]); pb[1] = pack8(C0, 8); PIN(pb[1]); \
          MFMA_A(N0, kf[4], qf[2]); \
          MFMA_A(N1, kf[5], qf[2]); \
          VRT(0, 0);                                                                                    \
          MFMA_A(N0, kf[6], qf[3]); \
          MFMA_A(N1, kf[7], qf[3]); \
          const int jt2_ = JT((i) + 2); \
          float c0_ = __builtin_fmaf(sl2s, (float)(64 * jt2_) - xq, (jt2_ > cq) ? -1.0e30f : -B2); PIN(c0_); \
            \
          VRT(1, 1); asm volatile("s_waitcnt lgkmcnt(8)" ::: "memory"); \
          { const bf16x8 v0_ = VPK(0, 0); MFMA_A(O[0], v0_, pb[0]); SM4(C1, 0); PIN(C1); PIN(lsum); const bf16x8 v1_ = VPK(0, 1); MFMA_A(O[1], v1_, pb[0]); \
            const bf16x8 v2_ = VPK(0, 2); MFMA_A(O[2], v2_, pb[0]); SM4(C1, 4); PIN(C1); PIN(lsum); const bf16x8 v3_ = VPK(0, 3); MFMA_A(O[3], v3_, pb[0]); } \
          VRT(0, 2); asm volatile("s_waitcnt lgkmcnt(8)" ::: "memory"); \
          { const bf16x8 v0_ = VPK(1, 0); MFMA_A(O[0], v0_, pb[1]); SM4(C1, 8); PIN(C1); PIN(lsum); const bf16x8 v1_ = VPK(1, 1); MFMA_A(O[1], v1_, pb[1]); pb[2] = pack8(C1, 0); PIN(pb[2]); \
            const bf16x8 v2_ = VPK(1, 2); MFMA_A(O[2], v2_, pb[1]); SM4(C1, 12); PIN(C1); PIN(lsum); const bf16x8 v3_ = VPK(1, 3); MFMA_A(O[3], v3_, pb[1]); pb[3] = pack8(C1, 8); PIN(pb[3]); } \
          VRT(1, 3); asm volatile("s_waitcnt lgkmcnt(8)" ::: "memory"); \
          _Pragma("unroll") for (int d_ = 0; d_ < 4; ++d_) { const bf16x8 vf_ = VPK(0, d_); MFMA_A(O[d_], vf_, pb[2]); FM2(C0, C1, 4 * d_); FM2(C0, C1, 4 * d_ + 1); } \
          asm volatile("s_waitcnt lgkmcnt(0)" ::: "memory"); \
          _Pragma("unroll") for (int d_ = 0; d_ < 4; ++d_) { const bf16x8 vf_ = VPK(1, d_); MFMA_A(O[d_], vf_, pb[3]); FM2(C0, C1, 4 * d_ + 2); FM2(C0, C1, 4 * d_ + 3); } \
          PIN(C0); PIN(C1); \
          if (jt2_ == cq) { da_bias(C0, C1, jt2_, cq, xq, sl2, B2); PIN(C0); PIN(C1); } } \
        if ((i) + 3 < NT) asm volatile("s_waitcnt vmcnt(4) lgkmcnt(0)" ::: "memory"); else asm volatile("s_waitcnt vmcnt(0) lgkmcnt(0)" ::: "memory"); \
        __builtin_amdgcn_s_barrier(); \
    } while (0)
    const float sl2s = __builtin_bit_cast(float, __builtin_amdgcn_readfirstlane(__builtin_bit_cast(int, sl2)));
    asm volatile(DA_LOOP_ALIGN ::: "memory");
#pragma unroll 1
    for (int i = 0; i < NT; i += 2) {
        DA_STEP(pA0, pA1, pB0, pB1, i);
        DA_STEP(pB0, pB1, pA0, pA1, i + 1);
    }
#undef DA_STEP
#undef FM2
#undef FMK
#undef MFMA_A
#undef PIN
#undef SM4
    asm volatile("s_nop 15\n\ts_nop 15" : "+v"(O[0]), "+v"(O[1]), "+v"(O[2]), "+v"(O[3]));
#undef DA_DMA
#undef JT
    lsum += __shfl_xor(lsum, 32);
    const float inv = 1.0f / lsum;
    LAS f32x4* xch = (LAS f32x4*)(lds + wi * 16384) + lane;
    if (map == 1) {
        const float f = lam * inv;
#pragma unroll
        for (int db = 0; db < 4; ++db)
#pragma unroll
            for (int g = 0; g < 4; ++g) xch[(db * 4 + g) * 64] = (f32x4){O[db][4 * g] * f, O[db][4 * g + 1] * f, O[db][4 * g + 2] * f, O[db][4 * g + 3] * f};
    }
    __syncthreads();
    if (map == 0) {
        float ss = 0.f;
#pragma unroll
        for (int db = 0; db < 4; ++db)
#pragma unroll
            for (int g = 0; g < 4; ++g) { const f32x4 o1 = xch[(db * 4 + g) * 64];
#pragma unroll
                for (int i = 0; i < 4; ++i) { const float v = O[db][4 * g + i] * inv - o1[i]; O[db][4 * g + i] = v; ss += v * v; } }
        ss += __shfl_xor(ss, 32);
        const float rr = __builtin_amdgcn_rsqf(ss * (1.f / 128.f) + 1e-6f) * outmul;
        bf16_t* orow = Og + (rowb + q0 + r32) * 1024 + h * 128 + 8 * hi;
        f32x4 gvv[16];
#pragma unroll
        for (int k = 0; k < 16; ++k) gvv[k] = *(const f32x4*)(gout + 8 * k + 4 * hi);
#pragma unroll
        for (int p = 0; p < 8; ++p) { unsigned w[2][2];
#pragma unroll
            for (int q = 0; q < 2; ++q) { const int k = 2 * p + q, db = k >> 2, g = k & 3; const f32x4 gv = gvv[k];
                w[q][0] = pk_bf16(O[db][4 * g] * rr * gv[0], O[db][4 * g + 1] * rr * gv[1]); w[q][1] = pk_bf16(O[db][4 * g + 2] * rr * gv[2], O[db][4 * g + 3] * rr * gv[3]); }
            asm volatile("s_nop 1\n\tv_permlane32_swap_b32 %0, %1" : "+v"(w[0][0]), "+v"(w[1][0]));
            asm volatile("s_nop 1\n\tv_permlane32_swap_b32 %0, %1" : "+v"(w[0][1]), "+v"(w[1][1]));
            *(v4u*)(orow + 16 * p) = (v4u){w[0][0], w[0][1], w[1][0], w[1][1]}; }
    }
    __syncthreads();
}

__device__ __forceinline__ void memattn_unit(LAS unsigned char* lds, int tid, bf16_t* MQg, bf16_t* Og, const bf16_t* KVg, const float* mqss, const float* qn, const float* kn, int pm, int hd, float Bm) {
    const int lane = tid & 63, wid = __builtin_amdgcn_readfirstlane(tid >> 6), r32 = lane & 31, hi = lane >> 5;
    const int b = pm >> 3; const size_t row = (size_t)pm * 256 + wid * 32 + r32;
    __syncthreads();
#pragma unroll
    for (int i = 0; i < 8; ++i) { const int p = 8 * wid + i, vrow = 4 * p + (lane >> 4), slot = lane & 15;
        glds16(KVg + ((size_t)b * MEML + vrow) * 2048 + 512 + hd * 128 + (((slot >> 2) ^ (vrow & 3)) * 32 + (slot & 3) * 8), lds + 65536 + p * 1024); }
    { const int kl = lane & 15, cq = lane >> 4;
      v4u raw[2][4]; float rk[2];
#pragma unroll
      for (int kg = 0; kg < 2; ++kg) { const bf16_t* src = KVg + ((size_t)b * MEML + 32 * wid + 16 * kg + kl) * 2048 + hd * 128 + cq * 8; float s = 0.f;
#pragma unroll
          for (int i = 0; i < 4; ++i) { raw[kg][i] = *(const v4u*)(src + i * 32); const v4u r_ = raw[kg][i];
              const float a0 = bf_lo(r_.x), a1 = bf_hi(r_.x), a2 = bf_lo(r_.y), a3 = bf_hi(r_.y), a4 = bf_lo(r_.z), a5 = bf_hi(r_.z), a6 = bf_lo(r_.w), a7 = bf_hi(r_.w);
              s += ((a0 * a0 + a1 * a1) + (a2 * a2 + a3 * a3)) + ((a4 * a4 + a5 * a5) + (a6 * a6 + a7 * a7)); }
          rk[kg] = __builtin_amdgcn_rsqf(pg8::sum_fq(s) * (1.f / 128.f) + 1e-6f) * MEMSCALE; }
#pragma unroll
      for (int i = 0; i < 4; ++i) { const int c = 4 * i + cq, d0 = c * 8; const f32x4 ga = *(const f32x4*)(qn + d0) * *(const f32x4*)(kn + d0), gb = *(const f32x4*)(qn + d0 + 4) * *(const f32x4*)(kn + d0 + 4);
#pragma unroll
          for (int kg = 0; kg < 2; ++kg) { const int key = 32 * wid + 16 * kg + kl; const v4u r_ = raw[kg][i]; const float k_ = rk[kg];
              v4u w; w.x = pk_bf16(bf_lo(r_.x) * k_ * ga[0], bf_hi(r_.x) * k_ * ga[1]); w.y = pk_bf16(bf_lo(r_.y) * k_ * ga[2], bf_hi(r_.y) * k_ * ga[3]);
              w.z = pk_bf16(bf_lo(r_.z) * k_ * gb[0], bf_hi(r_.z) * k_ * gb[1]); w.w = pk_bf16(bf_lo(r_.w) * k_ * gb[2], bf_hi(r_.w) * k_ * gb[3]);
              *(LAS v4u*)(lds + (key >> 6) * 16384 + c * 1024 + (key & 63) * 16) = w; } } }
    const bf16_t* qrow = MQg + row * 512 + hd * 128;
    bf16x8 qf[8];
#pragma unroll
    for (int s = 0; s < 8; ++s) qf[s] = *(const bf16x8*)(qrow + s * 16 + hi * 8);
    const float rq = __builtin_amdgcn_rsqf((mqss[row * 8 + hd * 2] + mqss[row * 8 + hd * 2 + 1]) * (1.f / 128.f) + 1e-6f);
    f32x16 O[4];
#pragma unroll
    for (int db = 0; db < 4; ++db)
#pragma unroll
        for (int r = 0; r < 16; ++r) O[db][r] = 0.f;
    float lsum = 0.f;
    const lptr kl0 = (lptr)lds + hi * 1024 + r32 * 16;
    unsigned va0[4];
    { const int qp = (lane & 15) >> 2;
#pragma unroll
      for (int db = 0; db < 4; ++db) va0[db] = lds_addr((lptr)lds) + 65536 + (4 * hi + qp) * 256 + ((db ^ qp) * 64) + ((lane >> 4) & 1) * 32 + (lane & 3) * 8; }
    __syncthreads();
#pragma unroll 1
    for (int tl = 0; tl < 4; ++tl) {
        f32x16 p0, p1;
#pragma unroll
        for (int r = 0; r < 16; ++r) { p0[r] = 0.f; p1[r] = 0.f; }
        bf16x8 kf[8], kg[8]; kread8(kf, lds_addr(kl0) + tl * 16384); kread8(kg, lds_addr(kl0) + tl * 16384 + 8192);
        asm volatile("s_waitcnt lgkmcnt(8)" ::: "memory"); SBAR();
#pragma unroll
        for (int s = 0; s < 4; ++s) { p0 = MFMA32(kf[2 * s], qf[s], p0); p1 = MFMA32(kf[2 * s + 1], qf[s], p1); }
        SBAR(); asm volatile("s_waitcnt lgkmcnt(0)" ::: "memory"); SBAR();
#pragma unroll
        for (int s = 0; s < 4; ++s) { p0 = MFMA32(kg[2 * s], qf[4 + s], p0); p1 = MFMA32(kg[2 * s + 1], qf[4 + s], p1); }
#pragma unroll
        for (int r = 0; r < 16; ++r) { p0[r] = __builtin_amdgcn_exp2f(__builtin_fmaf(p0[r], rq, -Bm)); p1[r] = __builtin_amdgcn_exp2f(__builtin_fmaf(p1[r], rq, -Bm)); lsum += p0[r] + p1[r]; }
        bf16x8 pb[4]; pb[0] = pack8(p0, 0); pb[1] = pack8(p0, 8); pb[2] = pack8(p1, 0); pb[3] = pack8(p1, 8);
        unsigned va[4];
#pragma unroll
        for (int db = 0; db < 4; ++db) va[db] = va0[db] + tl * 16384;
        pv_tile(O, va, pb);
    }
    lsum += __shfl_xor(lsum, 32);
    const float inv = 1.0f / lsum;
    bf16_t* orow = Og + row * 512 + hd * 128 + 8 * hi;
#pragma unroll
    for (int p = 0; p < 8; ++p) { unsigned w[2][2];
#pragma unroll
        for (int q = 0; q < 2; ++q) { const int k = 2 * p + q, db = k >> 2, g = k & 3;
            w[q][0] = pk_bf16(O[db][4 * g] * inv, O[db][4 * g + 1] * inv); w[q][1] = pk_bf16(O[db][4 * g + 2] * inv, O[db][4 * g + 3] * inv); }
        asm volatile("s_nop 1\n\tv_permlane32_swap_b32 %0, %1" : "+v"(w[0][0]), "+v"(w[1][0]));
        asm volatile("s_nop 1\n\tv_permlane32_swap_b32 %0, %1" : "+v"(w[0][1]), "+v"(w[1][1]));
        *(v4u*)(orow + 16 * p) = (v4u){w[0][0], w[0][1], w[1][0], w[1][1]}; }
}

__device__ __forceinline__ void pool_unit(LAS unsigned char* lds, int tid, const bf16_t* Pg, bf16_t* Og, const bf16_t* Wt, const float* scale, int tok0, int g) {
    const int lane = tid & 63, wid = __builtin_amdgcn_readfirstlane(tid >> 6), r32 = lane & 31, hi = lane >> 5;
    LAS unsigned char* Lp = lds; LAS unsigned char* Ld = lds + 272 * 256;
    const int w = 2 << g, pos0 = tok0 & (SEQ - 1);
    __syncthreads();
    { v4u st[9];
#pragma unroll
      for (int k = 0; k < 9; ++k) { const int i = tid + k * NTHR, ii = i < 272 * 16 ? i : tid, rr = ii >> 4, ch = ii & 15; const bool ok = pos0 - 16 + rr >= 0;
          const v4u v = *(const v4u*)(Pg + (size_t)(tok0 - 16 + (ok ? rr : 16)) * 512 + g * 128 + ch * 8); st[k].x = ok ? v.x : 0u; st[k].y = ok ? v.y : 0u; st[k].z = ok ? v.z : 0u; st[k].w = ok ? v.w : 0u; }
#pragma unroll
      for (int k = 0; k < 9; ++k) { const int i = tid + k * NTHR, rr = i >> 4, ch = i & 15; if (i < 272 * 16) *(LAS v4u*)(Lp + rr * 256 + ch * 16) = st[k]; } }
    bf16x8 wf[4][8];
#pragma unroll
    for (int db = 0; db < 4; ++db)
#pragma unroll
        for (int s = 0; s < 8; ++s) wf[db][s] = *(const bf16x8*)(Wt + (size_t)(32 * db + r32) * 128 + hi * 8 + s * 16);
    __syncthreads();
    { const int ch = tid & 15, t0 = (tid >> 4) * 8;
      float s[8];
#pragma unroll
      for (int i = 0; i < 8; ++i) s[i] = 0.f;
#pragma unroll 1
      for (int k = 1; k < w; ++k) { const v4u v = *(const LAS v4u*)(Lp + (16 + t0 - k) * 256 + ch * 16);
          s[0] += bf_lo(v.x); s[1] += bf_hi(v.x); s[2] += bf_lo(v.y); s[3] += bf_hi(v.y); s[4] += bf_lo(v.z); s[5] += bf_hi(v.z); s[6] += bf_lo(v.w); s[7] += bf_hi(v.w); }
#pragma unroll
      for (int tt = 0; tt < 8; ++tt) { const int t = t0 + tt, tpos = pos0 + t; const int cnt = (tpos + 1 < w) ? (tpos + 1) : w; const float ic = 1.0f / (float)cnt;
          const v4u v = *(const LAS v4u*)(Lp + (16 + t) * 256 + ch * 16), o = *(const LAS v4u*)(Lp + (16 + t - w + 1) * 256 + ch * 16);
          float p[8] = {bf_lo(v.x), bf_hi(v.x), bf_lo(v.y), bf_hi(v.y), bf_lo(v.z), bf_hi(v.z), bf_lo(v.w), bf_hi(v.w)};
          float q[8] = {bf_lo(o.x), bf_hi(o.x), bf_lo(o.y), bf_hi(o.y), bf_lo(o.z), bf_hi(o.z), bf_lo(o.w), bf_hi(o.w)};
          float d[8];
#pragma unroll
          for (int i = 0; i < 8; ++i) { s[i] += p[i]; d[i] = s[i] * ic - p[i]; s[i] -= q[i]; }
          v4u wv; wv.x = pk_bf16(d[0], d[1]); wv.y = pk_bf16(d[2], d[3]); wv.z = pk_bf16(d[4], d[5]); wv.w = pk_bf16(d[6], d[7]);
          *(LAS v4u*)(Ld + t * 256 + ((ch ^ (t & 15)) << 4)) = wv; } }
    __syncthreads();
    const int tok = wid * 32 + r32;
    bf16x8 df[8];
#pragma unroll
    for (int s = 0; s < 8; ++s) df[s] = *(const LAS bf16x8*)(Ld + tok * 256 + (((2 * s + hi) ^ (tok & 15)) << 4));
    bf16_t* orow = Og + (size_t)(tok0 + tok) * 512 + g * 128 + 8 * hi;
#pragma unroll
    for (int db = 0; db < 4; ++db) {
        f32x16 acc;
#pragma unroll
        for (int r = 0; r < 16; ++r) acc[r] = 0.f;
#pragma unroll
        for (int s = 0; s < 8; ++s) acc = MFMA32(wf[db][s], df[s], acc);
#pragma unroll
        for (int p = 0; p < 2; ++p) { unsigned w[2][2];
#pragma unroll
            for (int q = 0; q < 2; ++q) { const int gq = 2 * p + q; const f32x4 sc = *(const f32x4*)(scale + 32 * db + 8 * gq + 4 * hi);
                w[q][0] = pk_bf16(acc[4 * gq] * sc[0], acc[4 * gq + 1] * sc[1]); w[q][1] = pk_bf16(acc[4 * gq + 2] * sc[2], acc[4 * gq + 3] * sc[3]); }
            asm volatile("s_nop 1\n\tv_permlane32_swap_b32 %0, %1" : "+v"(w[0][0]), "+v"(w[1][0]));
            asm volatile("s_nop 1\n\tv_permlane32_swap_b32 %0, %1" : "+v"(w[0][1]), "+v"(w[1][1]));
            *(v4u*)(orow + 32 * db + 16 * p) = (v4u){w[0][0], w[0][1], w[1][0], w[1][1]}; }
    }
}
#undef MFMA32
#undef VRD
#undef VPK
#undef SBAR
}

#ifndef MIX_NAIVE_DA
#define MIX_NAIVE_DA 0
#endif
#ifndef MIX_NAIVE_MEM
#define MIX_NAIVE_MEM 0
#endif
#ifndef MIX_NAIVE_POOL
#define MIX_NAIVE_POOL 0
#endif
__device__ __forceinline__ void phase_mixers(unsigned char* ws, LAS unsigned char* lds, int l, int tid) {
    const float* prm = (const float*)(ws + WS_PARAM); const float* sc = (const float*)(ws + WS_SC) + l * 8;
    const float lam = ld_f32_agent(sc + 0), bnd0 = ld_f32_agent(sc + 1), bnd1 = ld_f32_agent(sc + 2), bndm = ld_f32_agent(sc + 3), omul = ld_f32_agent(sc + 4);
    const int bx = blockIdx.x, vcu = (gridDim.x == 256) ? ((bx & 7) * 32 + (bx >> 3)) : bx;
    bf16_t* Q = (bf16_t*)(ws + WS_Q); const bf16_t* K = (const bf16_t*)(ws + WS_K); const bf16_t* V = (const bf16_t*)(ws + WS_V);
    bf16_t* MQ = (bf16_t*)(ws + WS_MQ); const bf16_t* KV = (const bf16_t*)(ws + WS_MEMKV) + l * 1024;     const float* mqss = (const float*)(ws + WS_MQSS);
#if MIX_NAIVE_DA
    for (int u = blockIdx.x; u < 4096; u += gridDim.x) { const int hc = 63 - (u >> 6), c = hc >> 1, bh = u & 63, b = bh >> 3, h = bh & 7;
        const size_t rowb = (size_t)b * SEQ; const float slope2 = exp2f(-(float)(h + 1)) * LOG2E;
        naive_attn_unit<true>(lds, tid, Q + (rowb + hc * 32) * 1024 + h * 128, 1024, K + rowb * 1024 + h * 128, 1024, V + rowb * 1024 + h * 128, 1024, (bf16_t*)(ws + WS_XB) + (rowb + hc * 32) * 1024 + h * 128, 1024,
                              c + 1, hc * 32, nullptr, nullptr, nullptr, slope2, bnd0, bnd1, lam, prm + PB_GOUT + l * 128, omul); }
#else
    {
        const float B2 = fmaxf(bnd0, bnd1);
        for (int rep_ = 0; rep_ < REP_DA; ++rep_)
        for (int w = vcu; w < 256; w += gridDim.x) { const int bh = w >> 2, s = w & 3, b = bh >> 3, h = bh & 7; const float sl2 = exp2f(-(float)(h + 1)) * LOG2E;
#pragma unroll 1
            for (int i = 0; i < 4; ++i) { const int u = (i == 0) ? 15 - s : (i == 1) ? 8 + s : (i == 2) ? 7 - s : s;
                mix::diffattn_unit(lds, tid, Q, K, V, (bf16_t*)(ws + WS_XB), b, h, u, (i & 1) != 0, sl2, B2, lam, prm + PB_GOUT + l * 128, omul); } }
    }
#endif
#if MIX_NAIVE_MEM
    for (int u = blockIdx.x; u < 2048; u += gridDim.x) { const int qt = u >> 2, hd = u & 3, b = qt >> 6; const size_t row0 = (size_t)qt * 32;
        naive_attn_unit<false>(lds, tid, MQ + row0 * 512 + hd * 128, 512, KV + (size_t)b * MEML * 2048 + hd * 128, 2048, KV + (size_t)b * MEML * 2048 + 512 + hd * 128, 2048, MQ + row0 * 512 + hd * 128, 512,
                               4, 0, prm + PB_MQN + l * 128, prm + PB_MKN + l * 128, mqss + row0 * 8 + hd * 2, 0.f, bndm, 0.f, 0.f, nullptr, 1.f); }
#else
    for (int rep_ = 0; rep_ < REP_MEM; ++rep_)
    for (int w = vcu; w < 256; w += gridDim.x) mix::memattn_unit(lds, tid, MQ, (rep_ + 1 < REP_MEM) ? (bf16_t*)(ws + WS_OPOOL) : MQ, KV, mqss, prm + PB_MQN + l * 128, prm + PB_MKN + l * 128, w >> 2, w & 3, bndm);
#endif
#if MIX_NAIVE_POOL
    for (int u = blockIdx.x; u < 1024; u += gridDim.x) { const int tt = u >> 2, g = u & 3;
        naive_pool_unit(lds, tid, (const bf16_t*)(ws + WS_P), (bf16_t*)(ws + WS_OPOOL), prm + PB_POOLW + (size_t)(l * 4 + g) * 128 * 128, prm + PB_POOLS + l * 512 + g * 128, tt * 64, g); }
#else
    for (int rep_ = 0; rep_ < REP_POOL; ++rep_)
    for (int w = vcu; w < 256; w += gridDim.x) { const int pm = w >> 2, g = w & 3;
        mix::pool_unit(lds, tid, (const bf16_t*)(ws + WS_P), (bf16_t*)(ws + WS_OPOOL), (const bf16_t*)(ws + WS_POOLWT) + (size_t)(l * 4 + g) * 128 * 128, prm + PB_POOLS + l * 512 + g * 128, pm * 256, g); }
#endif
}

__device__ __forceinline__ void phase_route(unsigned char* ws, const bf16_t* xin, LAS unsigned char* lds, int tid, int lane, int wave, int wb) {
    const float* gffn = (const float*)(ws + WS_PARAM) + PB_GFFN1; const float* wr = (const float*)(ws + WS_PARAM) + PB_WR;
    unsigned* cnt = (unsigned*)ws + CW_WCNT + 8 * wb; int* toke = (int*)(ws + WS_TOKE); int* tokp = (int*)(ws + WS_TOKP); float* tokg = (float*)(ws + WS_TOKG); float* tokr = (float*)(ws + WS_TOKR);
    LAS unsigned* lcnt = (LAS unsigned*)lds; LAS unsigned* lbase = lcnt + 8; LAS int* linfo = (LAS int*)(lds + 64);
    const int per = T / gridDim.x;
    f32x4 wg0[16], wg1[16];
    { LAS unsigned char* wl = lds + 4096;
      __syncthreads();
#pragma unroll
      for (int r = 0; r < 2; ++r) { const int k = tid + 512 * r; const float g = gffn[k]; const f32x4 a = *(const f32x4*)(wr + k * 8) * g, b = *(const f32x4*)(wr + k * 8 + 4) * g;
          LAS f32x4* d = (LAS f32x4*)(wl + k * 32 + (k >> 4) * 16); d[0] = a; d[1] = b; }
      __syncthreads();
#pragma unroll
      for (int kk = 0; kk < 16; ++kk) { const LAS f32x4* p = (const LAS f32x4*)(wl + (16 * lane + kk) * 32 + lane * 16); wg0[kk] = p[0]; wg1[kk] = p[1]; }
      __syncthreads(); }
    if (tid < 8) lbase[tid] = 0u;
    for (int c0 = 0; c0 < per; c0 += 64) {
        __syncthreads();
        if (tid < 8) lcnt[tid] = 0u;
        __syncthreads();
        v4u raw[8][2];
#pragma unroll
        for (int q = 0; q < 8; ++q) { const int i = wave + q * NWAVES; const int t = wb * per + ((c0 + i < per) ? c0 + i : 0); const bf16_t* p = xin + (size_t)t * D + 16 * lane; raw[q][0] = *(const v4u*)p; raw[q][1] = *(const v4u*)(p + 8); }
#pragma unroll
        for (int q = 0; q < 8; ++q) { const int i = wave + q * NWAVES; if (c0 + i >= per) break;
            const int t = wb * per + c0 + i;
            f32x4 v[4]; { const v4u a_ = raw[q][0], b_ = raw[q][1];
              v[0] = (f32x4){bf_lo(a_.x), bf_hi(a_.x), bf_lo(a_.y), bf_hi(a_.y)}; v[1] = (f32x4){bf_lo(a_.z), bf_hi(a_.z), bf_lo(a_.w), bf_hi(a_.w)};
              v[2] = (f32x4){bf_lo(b_.x), bf_hi(b_.x), bf_lo(b_.y), bf_hi(b_.y)}; v[3] = (f32x4){bf_lo(b_.z), bf_hi(b_.z), bf_lo(b_.w), bf_hi(b_.w)}; }
            float s = 0.f;
#pragma unroll
            for (int j = 0; j < 4; ++j) s += (v[j][0] * v[j][0] + v[j][1] * v[j][1]) + (v[j][2] * v[j][2] + v[j][3] * v[j][3]);
            const float rstd = __builtin_amdgcn_rsqf(wave_sum(s) * (1.f / 1024.f) + 1e-6f);
            float lg[8];
#pragma unroll
            for (int e = 0; e < 8; ++e) lg[e] = 0.f;
#pragma unroll
            for (int j = 0; j < 4; ++j)
#pragma unroll
                for (int k4 = 0; k4 < 4; ++k4) { const float xv = v[j][k4]; const f32x4 w0 = wg0[4 * j + k4], w1 = wg1[4 * j + k4];
                    lg[0] += xv * w0[0]; lg[1] += xv * w0[1]; lg[2] += xv * w0[2]; lg[3] += xv * w0[3]; lg[4] += xv * w1[0]; lg[5] += xv * w1[1]; lg[6] += xv * w1[2]; lg[7] += xv * w1[3]; }
#pragma unroll
            for (int e = 0; e < 8; ++e) lg[e] = wave_sum(lg[e]) * rstd;
            int i0 = 0; float b0 = lg[0];
#pragma unroll
            for (int e = 1; e < 8; ++e) if (lg[e] > b0) { b0 = lg[e]; i0 = e; }
            int i1 = -1; float b1 = -3.0e38f;
#pragma unroll
            for (int e = 0; e < 8; ++e) if (e != i0 && lg[e] > b1) { b1 = lg[e]; i1 = e; }
            const float g0 = 1.f / (1.f + __expf(b1 - b0)), g1 = 1.f - g0;
            if (lane == 0) { const unsigned p0 = __hip_atomic_fetch_add(lcnt + i0, 1u, __ATOMIC_RELAXED, __HIP_MEMORY_SCOPE_WORKGROUP), p1 = __hip_atomic_fetch_add(lcnt + i1, 1u, __ATOMIC_RELAXED, __HIP_MEMORY_SCOPE_WORKGROUP);
                linfo[i * 4 + 0] = i0; linfo[i * 4 + 1] = i1; linfo[i * 4 + 2] = (int)p0; linfo[i * 4 + 3] = (int)p1;
                toke[2 * t] = i0; toke[2 * t + 1] = i1; tokg[2 * t] = g0; tokg[2 * t + 1] = g1; tokr[t] = rstd; }
        }
        __syncthreads();
        if (tid < 64 && c0 + tid < per) { const int t = wb * per + c0 + tid; tokp[2 * t] = (int)lbase[linfo[tid * 4 + 0]] + linfo[tid * 4 + 2]; tokp[2 * t + 1] = (int)lbase[linfo[tid * 4 + 1]] + linfo[tid * 4 + 3]; }
        __syncthreads();
        if (tid < 8) lbase[tid] += lcnt[tid];
    }
    __syncthreads();
    if (tid < 8) cnt[tid] = lbase[tid];
}
__device__ __forceinline__ void build_texp(unsigned char* ws, LAS int* texp, int tid) {
    const unsigned* cnt = (const unsigned*)ws + CW_CNT;
    __syncthreads();
    if (tid < NEXP) texp[184 + tid] = ((int)__hip_atomic_load(cnt + 64 * tid, RLX_AGENT) + 255) >> 8;
    __syncthreads();
    if (tid < 176) { int tb = 0, mine = 0, base = 0;
#pragma unroll
        for (int e = 0; e < NEXP; ++e) { const int nt = texp[184 + e]; if (tid >= tb && tid < tb + nt) mine = e; if (tid - 160 == e) base = tb; tb += nt; }
        if (tid < 160) { if (tid < tb) texp[tid] = mine; }
        else if (tid < 160 + NEXP) texp[tid] = base;
        else if (tid == 168 || tid == 169) texp[tid] = tb; }
    __syncthreads();
}
__device__ __forceinline__ void scan_counts(unsigned char* ws, LAS int* texp, LAS int* wbase, int tid, int lane, int wave) {
    const unsigned* wcnt = (const unsigned*)ws + CW_WCNT; const int G = gridDim.x;
    __syncthreads();
    { int c[4], s = 0;
#pragma unroll
      for (int i = 0; i < 4; ++i) { const int w = 4 * lane + i; c[i] = (w < G) ? (int)__hip_atomic_load(wcnt + 8 * w + wave, RLX_AGENT) : 0; s += c[i]; }
      int inc = s;
#pragma unroll
      for (int o = 1; o < 64; o <<= 1) { const int v = __shfl_up(inc, o); if (lane >= o) inc += v; }
      int ex = inc - s;
#pragma unroll
      for (int i = 0; i < 4; ++i) { wbase[(4 * lane + i) * 8 + wave] = ex; ex += c[i]; }
      if (lane == 63) { texp[176 + wave] = inc; if (blockIdx.x == 0) __hip_atomic_store((unsigned*)ws + CW_CNT + 64 * wave, (unsigned)inc, RLX_AGENT); } }
    __syncthreads();
    if (tid == 0) { int tb = 0; for (int e = 0; e < NEXP; ++e) { texp[160 + e] = tb; const int nt = (texp[176 + e] + 255) >> 8; for (int i = 0; i < nt; ++i) texp[tb + i] = e; tb += nt; } texp[168] = tb; texp[169] = tb; }
    __syncthreads();
}
__device__ __forceinline__ void phase_gather(unsigned char* ws, const bf16_t* xin, LAS int* texp, const LAS int* wbase, int lane, int wave) {
    const int* toke = (const int*)(ws + WS_TOKE); int* tokp = (int*)(ws + WS_TOKP); const float* tokr = (const float*)(ws + WS_TOKR); const int per = T / gridDim.x;
    unsigned char* xg = ws + WS_XGY; float* xgrs = (float*)(ws + WS_XGRS);
    const int gw = blockIdx.x * NWAVES + wave, NGW = gridDim.x * NWAVES;
    for (int t = gw; t < T; t += NGW) {
        f32x4 v[4]; ld16s_bf16(xin + (size_t)t * D, lane, v); float mx = 0.f;
#pragma unroll
        for (int j = 0; j < 4; ++j) { mx = fmaxf(mx, fmaxf(fmaxf(fabsf(v[j][0]), fabsf(v[j][1])), fmaxf(fabsf(v[j][2]), fabsf(v[j][3])))); }
        mx = wave_max(mx);
        const float inv = mx > 0.f ? 127.0f / mx : 0.f, rs = mx * (1.0f / 127.0f) * tokr[t];
        v4u w; w.x = pk_i8x4(v[0][0] * inv, v[0][1] * inv, v[0][2] * inv, v[0][3] * inv); w.y = pk_i8x4(v[1][0] * inv, v[1][1] * inv, v[1][2] * inv, v[1][3] * inv);
        w.z = pk_i8x4(v[2][0] * inv, v[2][1] * inv, v[2][2] * inv, v[2][3] * inv); w.w = pk_i8x4(v[3][0] * inv, v[3][1] * inv, v[3][2] * inv, v[3][3] * inv);
#pragma unroll
        for (int k = 0; k < 2; ++k) { const int e = toke[2 * t + k], p = tokp[2 * t + k] + wbase[(t / per) * 8 + e]; const size_t row = (size_t)texp[160 + e] * 256 + p;
            st16s_i8(xg + row * D, lane, w); if (lane == 0) { xgrs[row] = rs; tokp[2 * t + k] = p; } }
    }
}
__device__ __forceinline__ void phase_combine(unsigned char* ws, const bf16_t* xs, float* dst, LAS int* texp, int lane, int wave) {
    const int* toke = (const int*)(ws + WS_TOKE); const int* tokp = (const int*)(ws + WS_TOKP); const float* tokg = (const float*)(ws + WS_TOKG);
    const bf16_t* Y = (const bf16_t*)(ws + WS_Y);
    const int gw = blockIdx.x * NWAVES + wave, NGW = gridDim.x * NWAVES;
    for (int t = gw; t < T; t += NGW) {
        const size_t r0 = (size_t)texp[160 + toke[2 * t]] * 256 + tokp[2 * t], r1 = (size_t)texp[160 + toke[2 * t + 1]] * 256 + tokp[2 * t + 1]; const float g0 = tokg[2 * t], g1 = tokg[2 * t + 1];
        typedef unsigned v2u_ __attribute__((ext_vector_type(2)));
        const v2u_* xp = (const v2u_*)(xs + (size_t)t * D) + lane; const v2u_* y0 = (const v2u_*)(Y + r0 * D) + lane; const v2u_* y1 = (const v2u_*)(Y + r1 * D) + lane;
        f32x4* xw = (f32x4*)(dst + (size_t)t * D) + lane;
        v2u_ xr[4], p[4], q[4];
#pragma unroll
        for (int j = 0; j < 4; ++j) { xr[j] = xp[64 * j]; p[j] = y0[64 * j]; q[j] = y1[64 * j]; }
#pragma unroll
        for (int j = 0; j < 4; ++j) { f32x4 o;
            o[0] = bf_lo(xr[j].x) + (g0 * bf_lo(p[j].x) + g1 * bf_lo(q[j].x)); o[1] = bf_hi(xr[j].x) + (g0 * bf_hi(p[j].x) + g1 * bf_hi(q[j].x));
            o[2] = bf_lo(xr[j].y) + (g0 * bf_lo(p[j].y) + g1 * bf_lo(q[j].y)); o[3] = bf_hi(xr[j].y) + (g0 * bf_hi(p[j].y) + g1 * bf_hi(q[j].y));
            xw[64 * j] = o; }
    }
}

typedef pg8::EpiSwiglu<true, true> EpiSwigluF8;
#define PHASE_SKEW() do { if ((bx >> 3) & 1) { __builtin_amdgcn_s_sleep(127); __builtin_amdgcn_s_sleep(A_SKEW2); } } while (0)
#define GEMM_PHASE(EPI, g, S, E) do { S.skip = args.flags; __syncthreads();     pg8::gemm_phase<EPI, pg8::Sched2, true, true>(lds, g, S, E); } while (0)
__global__ void __launch_bounds__(NTHR, 2) fwd_kernel(Args args) {
    extern __shared__ __attribute__((aligned(16))) unsigned char lds_raw[];
    LAS unsigned char* lds = (LAS unsigned char*)lds_raw;
    volatile LAS unsigned* MISC = (volatile LAS unsigned*)(lds + MISC_OFF);
    LAS float* rstab = (LAS float*)(lds + RS_OFF); LAS int* texp = (LAS int*)(lds + TEXP_OFF);
    unsigned char* const ws0 = args.ws; int G = gridDim.x, bx = blockIdx.x;
#define PHASE_BEGIN() size_t z_ = 0; asm volatile("" : "+s"(z_), "+s"(G), "+s"(bx)); unsigned char* ws = args.ws + z_; float* out = args.out + z_; int tid = threadIdx.x; asm volatile("" : "+v"(tid)); const int lane = tid & 63, wave = __builtin_amdgcn_readfirstlane(tid >> 6); (void)lane; (void)wave; (void)out
    if (threadIdx.x < 64) MISC[threadIdx.x] = 0u;
    __syncthreads();
    XcdBarrier bar; bar.bar = (unsigned*)ws0 + CW_BAR; bar.x = 0; bar.st = nullptr;
    const int lo = args.ph_lo, hi = args.ph_hi;
    const bool grp = (gridDim.x == 256) && (GROUP_SYNC != 0); unsigned gep = 0u;
    if (MK_N_LAUNCHES == 1 && hi - lo > 1) bar = xcd_barrier_post((unsigned*)ws0 + CW_BAR, MISC + 8);
    if (threadIdx.x == 0 && hi - lo > 1) atomicOr((unsigned*)ws0 + CW_GX + (blockIdx.x & 7), 1u << xb_xcc_id());
    bool colo = false;
#define IN(k) (lo <= (k) && (k) < hi)
#define GSEAM(k) do { if (IN(k) && IN((k) + 1)) { size_t zb_ = 0; asm volatile("" : "+s"(zb_)); if (grp) { ++gep; group_barrier((unsigned*)args.ws + CW_GBAR + 64 * (bx & 7) + zb_, 32u * gep, (unsigned*)args.ws + CW_BAR + zb_, colo); } else { bar.bar = (unsigned*)args.ws + CW_BAR + zb_; xcd_barrier(bar); } } } while (0)
#define SEAM(k) do { if (IN(k) && IN((k) + 1)) { size_t zb_ = 0; asm volatile("" : "+s"(zb_)); bar.bar = (unsigned*)args.ws + CW_BAR + zb_; xcd_barrier(bar); } } while (0)

    if (IN(0)) { PHASE_BEGIN(); phase_prologue(args, lds, tid, lane, wave); }
    SEAM(0);
    if (IN(0) && IN(2)) {}
    if (IN(2)) { PHASE_BEGIN();
        pg8::Gemm g{(const bf16_t*)(ws + WS_MEMBF), (const bf16_t*)(ws + WS_WMEMKV), NBATCH * MEML, 2048, D};
        pg8::Sched2 S; S.init2(g.M, g.N, G, bx, rstab); S.rsrc = (const float*)(ws + WS_SSM); S.rmode = 1;
        pg8::EpiStore<true> E{(bf16_t*)(ws + WS_MEMKV), 2048, rstab};
        GEMM_PHASE(pg8::EpiStore<true>, g, S, E);
        __syncthreads();
        if (G == 256) { if (bx >= 64) w2_quant_pass(args, lds, tid, lane, wave, (bx - 64) * NWAVES + wave, 192 * NWAVES); }
        else w2_quant_pass(args, lds, tid, lane, wave, bx * NWAVES + wave, G * NWAVES);
    }
    SEAM(2);
    if (grp && IN(2) && IN(3)) { size_t zc_ = 0; asm volatile("" : "+s"(zc_)); const unsigned m_ = __builtin_amdgcn_readfirstlane(xb_ld((unsigned*)args.ws + CW_GX + (bx & 7) + zc_)); colo = (m_ & (m_ - 1u)) == 0u && m_ != 0u; }
    for (int l = 0; l < 2; ++l) {
        const int pb = l == 0 ? 3 : 11;
        if (IN(pb)) { for (int rep_ = 0; rep_ < REP_A; ++rep_) { PHASE_BEGIN();
#if I8_A
            pg8::Gemm g{(const bf16_t*)(ws + WS_QX), (const bf16_t*)(ws + WS_W1T + (size_t)l * 14 * MiB), T, NGEMM1, D / 2};
            pg8::Sched2 S; S.init2(T, NGEMM1, G, bx, rstab); S.rsrc = (const float*)(ws + WS_SA); S.rmode = 2; S.wgm = 4;
            pg8::EpiA<true> E{ws, l, rstab};
            if (SKEW_A) PHASE_SKEW();
            GEMM_PHASE(pg8::EpiA<true>, g, S, E); __syncthreads(); }
#else
            pg8::Gemm g{(const bf16_t*)(ws + WS_XB), (const bf16_t*)(ws + WS_W1T + (size_t)l * 14 * MiB), T, NGEMM1, D};
            pg8::Sched2 S; S.init2(T, NGEMM1, G, bx, rstab); S.rsrc = (const float*)(ws + WS_SS); S.rmode = 1; S.wgm = 4;
            pg8::EpiA<false> E{ws, l, rstab};
            GEMM_PHASE(pg8::EpiA<false>, g, S, E); __syncthreads(); }
#endif
        }
        GSEAM(pb);
        if (IN(pb + 1)) { PHASE_BEGIN(); phase_mixers(ws, lds, l, tid); }
        GSEAM(pb + 1);
        if (IN(pb + 2)) { for (int rep_ = 0; rep_ < REP_C; ++rep_) { PHASE_BEGIN();
            { pg8::Gemm g{(const bf16_t*)(ws + WS_XB), (const bf16_t*)(ws + WS_WBRDA + (size_t)l * 2 * MiB), T, D, 1024}; pg8::Sched2 S; S.init2(T, D, G, bx, rstab);
              S.chain = 3; S.K2 = 512; S.A2 = (const bf16_t*)(ws + WS_OPOOL); S.B2 = (const bf16_t*)(ws + WS_WBRPOOL + (size_t)l * 1 * MiB); S.A3 = (const bf16_t*)(ws + WS_MQ); S.B3 = (const bf16_t*)(ws + WS_WBRMEM + (size_t)l * 1 * MiB);
              pg8::EpiBrPM E{ws}; GEMM_PHASE(pg8::EpiBrPM, g, S, E); } __syncthreads(); }
        }
        GSEAM(pb + 2);
        if (IN(pb + 3)) { PHASE_BEGIN();
            pg8::Gemm g{(const bf16_t*)(ws + WS_Q), (const bf16_t*)(ws + WS_WOUT + (size_t)l * 2 * MiB), T, D, D}; pg8::Sched2 S; S.init2(T, D, G, bx, rstab);
            pg8::EpiResB E{l == 0 ? (const float*)(args.in[0] + z_) : (const float*)nullptr, (bf16_t*)(ws + WS_XS)};
            GEMM_PHASE(pg8::EpiResB, g, S, E); __syncthreads();
        }
        GSEAM(pb + 3);
        if (l == 0) {
            if (IN(7) && I8_E) { PHASE_BEGIN(); phase_quant_rows((const bf16_t*)(ws + WS_XS), ws, lane, wave, grp); }
            GSEAM(7);
            if (IN(8)) { for (int rep_ = 0; rep_ < REP_E; ++rep_) { PHASE_BEGIN();
#if I8_E
                pg8::Gemm g{(const bf16_t*)(ws + WS_QX), (const bf16_t*)(ws + WS_WFF13), T, 2 * FFD, D / 2}; pg8::Sched2 S; S.init2(T, 2 * FFD, G, bx, rstab); S.rsrc = (const float*)(ws + WS_SA); S.rmode = 2; S.wgm = 4;
                EpiSwigluF8 E{(bf16_t*)(ws + WS_HFF), FFD, rstab, (const float*)(ws + WS_SW) + SW_FF, FFD, nullptr, 0};
                if (SKEW_E) PHASE_SKEW();
                GEMM_PHASE(EpiSwigluF8, g, S, E); __syncthreads(); }
#else
                pg8::Gemm g{(const bf16_t*)(ws + WS_X1B), (const bf16_t*)(ws + WS_WFF13), T, 2 * FFD, D}; pg8::Sched2 S; S.init2(T, 2 * FFD, G, bx, rstab); S.rsrc = (const float*)(ws + WS_SS); S.rmode = 1; S.wgm = 4;
                pg8::EpiSwiglu<false> E{(bf16_t*)(ws + WS_HFF), FFD, rstab, nullptr, 0, nullptr, 0};
                GEMM_PHASE(pg8::EpiSwiglu<false>, g, S, E); __syncthreads(); }
#endif
            }
            GSEAM(8);
            if (IN(9)) { PHASE_BEGIN();
                pg8::Gemm g{(const bf16_t*)(ws + WS_HFF), (const bf16_t*)(ws + WS_WFF2), T, D, FFD / 2}; pg8::Sched2 S; S.init2(T, D, G, bx, rstab);
                pg8::EpiResB8 E{(bf16_t*)(ws + WS_XS), (const float*)(ws + WS_SW) + SW_W2 + 8 * 1024};
                GEMM_PHASE(pg8::EpiResB8, g, S, E); __syncthreads();
            }
            GSEAM(9);
            if (IN(10) && I8_A) { PHASE_BEGIN(); phase_quant_rows((const bf16_t*)(ws + WS_XS), ws, lane, wave, grp); }
            GSEAM(10);
        }
    }
    if (IN(15)) { PHASE_BEGIN(); phase_route(ws, (const bf16_t*)(ws + WS_XS), lds, tid, lane, wave, grp ? (bx & 7) * 32 + (bx >> 3) : bx); }
    SEAM(15);
    if (IN(16)) { PHASE_BEGIN(); scan_counts(ws, texp, (LAS int*)lds, tid, lane, wave); phase_gather(ws, (const bf16_t*)(ws + WS_XS), texp, (const LAS int*)lds, lane, wave); }
    SEAM(16);
    for (int k = 0; k < 4; ++k) {
        if (IN(17 + k)) { PHASE_BEGIN();
            build_texp(ws, texp, tid);
            const int ntot = texp[169];
            const int kd = k - 1, ku = k;
            int ntd = 0, ntu = 0;
            if (kd >= 0) { ntd = ntot - MOE_CH * kd; const int cap = (kd == 2) ? MOE_CHL : MOE_CH; ntd = ntd < 0 ? 0 : (ntd > cap ? cap : ntd); }
            if (ku <= 2) { ntu = ntot - MOE_CH * ku; const int cap = (ku == 2) ? MOE_CHL : MOE_CH; ntu = ntu < 0 ? 0 : (ntu > cap ? cap : ntu); }
            const int nX = ntd * 4, nU = ntu * 28;
            const bool mixed = (nX > 0 && nU > 0);
            const int tf = (nU + DNW * nX) / 256, rem = (nU + DNW * nX) - 256 * tf;
            const bool weighted = mixed && tf >= DNW && nX <= 256 && G == 256;
            if (SKEW_M) PHASE_SKEW();
            if (nX > 0) {
                const int t0 = MOE_CH * kd;
                pg8::Gemm g{(const bf16_t*)(ws + WS_HCH + (size_t)(kd & 1) * HCH_BYTES), (const bf16_t*)(ws + WS_WMOE2), ntd * 256, D, FFE / 2};
                pg8::Sched2 S; S.init2(ntd * 256, D, G, bx, rstab); S.texp = texp; S.estride = (size_t)(7 * MiB / 2); S.t0 = t0;
                if (weighted) { const int vc = (bx & 7) * 32 + (bx >> 3); S.rng = 1; S.rng_start = vc; S.rng_cnt = (vc < nX) ? 1 : 0; }
                pg8::EpiStoreF8 E{(bf16_t*)(ws + WS_Y) + (size_t)t0 * 256 * D, D, (const float*)(ws + WS_SW) + SW_W2, texp, t0};
                for (int rep_ = 0; rep_ < REP_DN; ++rep_) { GEMM_PHASE(pg8::EpiStoreF8, g, S, E); __syncthreads(); }
            }
            if (nU > 0) {
                size_t z3_ = 0; asm volatile("" : "+s"(z3_), "+s"(G), "+s"(bx)); ws = args.ws + z3_;
                const int t0 = MOE_CH * ku;
                pg8::Gemm g{(const bf16_t*)(ws + WS_XGY + (size_t)t0 * 256 * D), (const bf16_t*)(ws + WS_WMOE13), ntu * 256, 2 * FFE, D / 2};
                pg8::Sched2 S; S.init2(ntu * 256, 2 * FFE, G, bx, rstab); S.rsrc = (const float*)(ws + WS_XGRS); S.rmode = 2; S.rrow0 = t0 * 256; S.texp = texp; S.estride = (size_t)7 * MiB; S.t0 = t0;
                if (weighted) { const int vc = (bx & 7) * 32 + (bx >> 3); const int cmin = vc < nX ? vc : nX, over = vc - (256 - rem); S.rng = 1; S.rng_start = vc * tf - DNW * cmin + (over > 0 ? over : 0); S.rng_cnt = tf - (vc < nX ? DNW : 0) + (vc >= 256 - rem ? 1 : 0); }
                EpiSwigluF8 E{(bf16_t*)(ws + WS_HCH + (size_t)(ku & 1) * HCH_BYTES), FFE, rstab, (const float*)(ws + WS_SW) + SW_MOE, FFE, texp, t0};
                for (int rep_ = 0; rep_ < REP_UP; ++rep_) { GEMM_PHASE(EpiSwigluF8, g, S, E); __syncthreads(); }
            }
        }
        SEAM(17 + k);
    }
    if (IN(21)) { PHASE_BEGIN(); build_texp(ws, texp, tid); phase_combine(ws, (const bf16_t*)(ws + WS_XS), out, texp, lane, wave); }
#undef IN
#undef SEAM
}

extern "C" void kernel_launch(void* const* d_in, const int* in_sizes, int n_in, void* d_out, int out_size, void* d_ws, size_t ws_size, hipStream_t stream) {
    static int grid = 0;
    if (grid == 0) {
        if (n_in != 31 || out_size != T * D || ws_size < WS_END) { fprintf(stderr, "kernel_launch: unexpected problem (n_in %d, out %d, ws %zu < %zu)\n", n_in, out_size, ws_size, (size_t)WS_END); grid = -1; return; }
        int dev = 0, cus = 0, per_cu = 0;
        if (hipGetDevice(&dev) != hipSuccess || hipDeviceGetAttribute(&cus, hipDeviceAttributeMultiprocessorCount, dev) != hipSuccess) { grid = -1; return; }
        if (hipFuncSetAttribute((const void*)fwd_kernel, hipFuncAttributeMaxDynamicSharedMemorySize, LDS_BYTES) != hipSuccess) { fprintf(stderr, "kernel_launch: hipFuncSetAttribute failed\n"); grid = -1; return; }
        if (hipOccupancyMaxActiveBlocksPerMultiprocessor(&per_cu, (const void*)fwd_kernel, NTHR, LDS_BYTES) != hipSuccess || per_cu < 1) { fprintf(stderr, "kernel_launch: occupancy query says %d\n", per_cu); grid = -1; (void)hipGetLastError(); return; }
        grid = cus;
    }
    if (grid < 0) return;
    if (hipMemsetAsync(d_ws, 0, CTL_ZERO_BYTES, stream) != hipSuccess) return;
    Args a{};
    for (int i = 0; i < 31; ++i) a.in[i] = (const float*)d_in[i];
    a.out = (float*)d_out; a.ws = (unsigned char*)d_ws;
#ifndef PROBE_EXTRA_REPS
#define PROBE_EXTRA_REPS 1
#endif
#ifdef PROBE_EXTRA_PROLOGUE
    a.ph_lo = 0; a.ph_hi = 1; hipLaunchKernelGGL(fwd_kernel, dim3(grid), dim3(NTHR), LDS_BYTES, stream, a);
#endif
#ifdef PROBE_EXTRA_PHASE
    for (int r_ = 0; r_ < PROBE_EXTRA_REPS; ++r_) { a.ph_lo = PROBE_EXTRA_PHASE; a.ph_hi = PROBE_EXTRA_PHASE + 1; hipLaunchKernelGGL(fwd_kernel, dim3(grid), dim3(NTHR), LDS_BYTES, stream, a); }
#endif
    if (MK_N_LAUNCHES == 1) { a.ph_lo = 0; a.ph_hi = NPH; hipLaunchKernelGGL(fwd_kernel, dim3(grid), dim3(NTHR), LDS_BYTES, stream, a); }
    else for (int p = 0; p < NPH; ++p) { a.ph_lo = p; a.ph_hi = p + 1; hipLaunchKernelGGL(fwd_kernel, dim3(grid), dim3(NTHR), LDS_BYTES, stream, a); }
#ifdef PROBE_POST_PHASE
#ifdef PROBE_POST_FLAGS
    a.flags = PROBE_POST_FLAGS;
#endif
    for (int r_ = 0; r_ < PROBE_EXTRA_REPS; ++r_) { a.ph_lo = PROBE_POST_PHASE; a.ph_hi = PROBE_POST_PHASE + 1; hipLaunchKernelGGL(fwd_kernel, dim3(grid), dim3(NTHR), LDS_BYTES, stream, a); }
#endif
}
```
